# Optimizing an MI355X kernel written in HIP

```python
import jax
import jax.numpy as jnp
from jax import lax
import numpy as np


D_MODEL = 1024
BATCH = 8
SEQ = 4096
DEPTH = 1

GRID_W = 64
CTX_LEN = 256
D_MIX = D_MODEL
D_POOL = D_MIX // 2
POOL_WINDOWS = (2, 4, 8, 16)
POOL_GW = D_POOL // len(POOL_WINDOWS)
D_ATTN = D_MIX - D_POOL
NA_HEADS = 8
NA_HEAD_DIM = D_ATTN // NA_HEADS
NA_KH_MAX = 8
NA_KW = 16
D_IN = D_POOL + 3 * D_ATTN
PEER_HEADS = 8
PEER_NKEYS = 128
PEER_N_EXPERTS = PEER_NKEYS * PEER_NKEYS
PEER_TOPK = 16
PEER_DKEY = 256
PEER_TOKEN_BLOCK = 128
N_MOD = 6
EPS = 1e-6

kernel_name = 'hybrid_pool_natten_peer_dit_layer'


def rmsnorm(x, g):
    xf = x.astype(jnp.float32)
    y = xf * lax.rsqrt(jnp.mean(xf * xf, axis=-1, keepdims=True) + EPS)
    return (y * g.astype(jnp.float32)).astype(x.dtype)


def modulate(h, shift, scale):
    return h * (1 + scale) + shift


def multiscale_pool(p, w_grp, scale):
    B, L, _ = p.shape
    pf = p.astype(jnp.float32)
    cs = jnp.concatenate([jnp.zeros((B, 1, D_POOL), jnp.float32), jnp.cumsum(pf, axis=1)], axis=1)
    t = jnp.arange(L)
    outs = []
    for g, w in enumerate(POOL_WINDOWS):
        sl = slice(g * POOL_GW, (g + 1) * POOL_GW)
        lo = jnp.clip(t - w // 2, 0, L)
        hi = jnp.clip(t + w // 2, 0, L)
        csg = cs[..., sl]
        cnt = (hi - lo).astype(jnp.float32)[None, :, None]
        outs.append((jnp.take(csg, hi, axis=1) - jnp.take(csg, lo, axis=1)) / cnt - pf[..., sl])
    pooled = jnp.stack(outs, axis=2).astype(p.dtype)
    y = jnp.einsum('blgc,gcd->blgd', pooled, w_grp).reshape(B, L, D_POOL)
    return y * scale


def neighbourhood_attention(q, k, v, k_ctx, v_ctx, rpb):
    B, S, H, Dh = q.shape
    rows = S // GRID_W
    kh = min(NA_KH_MAX, rows)
    n_loc = kh * NA_KW
    qg = q.reshape(B, rows, GRID_W, H, Dh)
    kg = k.reshape(B, rows, GRID_W, H, Dh)
    vg = v.reshape(B, rows, GRID_W, H, Dh)
    col = jnp.arange(GRID_W)
    c0 = jnp.clip(col - NA_KW // 2, 0, GRID_W - NA_KW)
    col_idx = c0[:, None] + jnp.arange(NA_KW)[None, :]
    col_off = col_idx - col[:, None] + (NA_KW - 1)
    scale = Dh ** -0.5

    def row_block(r):
        r0 = jnp.clip(r - kh // 2, 0, rows - kh)
        k_rows = lax.dynamic_slice_in_dim(kg, r0, kh, axis=1)
        v_rows = lax.dynamic_slice_in_dim(vg, r0, kh, axis=1)
        k_win = k_rows[:, :, col_idx]
        v_win = v_rows[:, :, col_idx]
        q_r = lax.dynamic_index_in_dim(qg, r, axis=1, keepdims=False)
        row_off = r0 + jnp.arange(kh) - r + (NA_KH_MAX - 1)
        bias = rpb[:, row_off[None, :, None], col_off[:, None, :]].astype(jnp.float32)
        s_loc = jnp.einsum('bwhd,biwjhd->bhwij', q_r, k_win).astype(jnp.float32) * scale + bias
        s_ctx = jnp.einsum('bwhd,bchd->bhwc', q_r, k_ctx).astype(jnp.float32) * scale
        s_all = jnp.concatenate([s_loc.reshape(B, H, GRID_W, n_loc), s_ctx], axis=-1)
        prob = jax.nn.softmax(s_all, axis=-1)
        p_loc = prob[..., :n_loc].reshape(B, H, GRID_W, kh, NA_KW).astype(v.dtype)
        p_ctx = prob[..., n_loc:].astype(v.dtype)
        return (jnp.einsum('bhwij,biwjhd->bwhd', p_loc, v_win)
                + jnp.einsum('bhwc,bchd->bwhd', p_ctx, v_ctx))

    out = lax.map(row_block, jnp.arange(rows))
    return jnp.moveaxis(out, 0, 1).reshape(B, S, H * Dh)


def context_attention(q, k, v):
    B, C, H, Dh = q.shape
    s = jnp.einsum('bqhd,bkhd->bhqk', q, k).astype(jnp.float32) * (Dh ** -0.5)
    prob = jax.nn.softmax(s, axis=-1).astype(v.dtype)
    return jnp.einsum('bhqk,bkhd->bqhd', prob, v).reshape(B, C, H * Dh)


def peer(h, w_q, sub_keys, u, v):
    B, L, D = h.shape
    tok = h.reshape((B * L) // PEER_TOKEN_BLOCK, PEER_TOKEN_BLOCK, D)
    k = PEER_TOPK

    def block(xb):
        tb = xb.shape[0]
        q = (xb @ w_q).reshape(tb, PEER_HEADS, 2, PEER_DKEY // 2)
        s = jnp.einsum('thpd,hpnd->thpn', q, sub_keys).astype(jnp.float32)
        sv, si = lax.top_k(s, k)
        cand = (sv[:, :, 0, :, None] + sv[:, :, 1, None, :]).reshape(tb, PEER_HEADS, k * k)
        cand_idx = (si[:, :, 0, :, None] * PEER_NKEYS + si[:, :, 1, None, :]).reshape(tb, PEER_HEADS, k * k)
        top_v, top_i = lax.top_k(cand, k)
        experts = jnp.take_along_axis(cand_idx, top_i, axis=-1)
        g = jax.nn.softmax(top_v, axis=-1)
        u_e = u[experts]
        v_e = v[experts]
        a = jax.nn.gelu(jnp.einsum('td,thkd->thk', xb, u_e).astype(jnp.float32), approximate=False)
        return jnp.einsum('thk,thkd->td', (g * a).astype(xb.dtype), v_e)

    return lax.map(block, tok).reshape(B, L, D)


def split_heads(t):
    B, L, _ = t.shape
    return t.reshape(B, L, NA_HEADS, NA_HEAD_DIM)


def setup_inputs(seed: int = 0) -> dict:
    key = jax.random.key(seed)
    ks = jax.random.split(key, 18)
    f32 = jnp.float32
    D = D_MODEL

    def nrm(k, shape, s):
        return jax.random.normal(k, shape, f32) * s

    return {
        'x': nrm(ks[0], (BATCH, SEQ, D), 1.0),
        'c': nrm(ks[1], (BATCH, D), 1.0),
        'ctx': nrm(ks[2], (BATCH, CTX_LEN, D), 1.0),
        'c_ctx': nrm(ks[3], (D,), 1.0),
        'ada_w': nrm(ks[4], (DEPTH, D, N_MOD * D), 0.5 * D ** -0.5),
        'ada_b': nrm(ks[5], (DEPTH, N_MOD * D), 0.01),
        'norm1_g': 1.0 + nrm(ks[6], (DEPTH, D), 0.05),
        'w_in': nrm(ks[7], (DEPTH, D, D_IN), D ** -0.5),
        'pool_w': nrm(ks[8], (DEPTH, len(POOL_WINDOWS), POOL_GW, POOL_GW), POOL_GW ** -0.5),
        'pool_scale': 1.0 + nrm(ks[9], (DEPTH, D_POOL), 0.1),
        'na_rpb': nrm(ks[10], (DEPTH, NA_HEADS, 2 * NA_KH_MAX - 1, 2 * NA_KW - 1), 0.2),
        'w_out': nrm(ks[11], (DEPTH, D_MIX, D), D_MIX ** -0.5),
        'norm2_g': 1.0 + nrm(ks[12], (DEPTH, D), 0.05),
        'peer_wq': nrm(ks[13], (DEPTH, D, PEER_HEADS * PEER_DKEY), D ** -0.5),
        'peer_keys': nrm(ks[14], (DEPTH, PEER_HEADS, 2, PEER_NKEYS, PEER_DKEY // 2), (PEER_DKEY // 2) ** -0.5),
        'peer_u': nrm(ks[15], (DEPTH, PEER_N_EXPERTS, D), D ** -0.5),
        'peer_v': nrm(ks[16], (DEPTH, PEER_N_EXPERTS, D), 0.5),
        'final_g': 1.0 + nrm(ks[17], (D,), 0.05),
    }


def reference(x, c, ctx, c_ctx, ada_w, ada_b, norm1_g, w_in, pool_w, pool_scale, na_rpb, w_out,
              norm2_g, peer_wq, peer_keys, peer_u, peer_v, final_g):
    kv_cols = slice(D_POOL + D_ATTN, D_IN)
    for layer in range(DEPTH):
        last = layer == DEPTH - 1
        mod_x = (jax.nn.silu(c) @ ada_w[layer] + ada_b[layer])[:, None, :]
        mod_c = jax.nn.silu(c_ctx) @ ada_w[layer] + ada_b[layer]
        sh1, sc1, g1, sh2, sc2, g2 = jnp.split(mod_x, N_MOD, axis=-1)
        csh1, csc1, cg1, csh2, csc2, cg2 = jnp.split(mod_c, N_MOD, axis=-1)

        hx = modulate(rmsnorm(x, norm1_g[layer]), sh1, sc1)
        hc = modulate(rmsnorm(ctx, norm1_g[layer]), csh1, csc1)
        zx = hx @ w_in[layer]
        px = zx[..., :D_POOL]
        qx = split_heads(zx[..., D_POOL:D_POOL + D_ATTN])
        kx = split_heads(zx[..., D_POOL + D_ATTN:D_POOL + 2 * D_ATTN])
        vx = split_heads(zx[..., D_POOL + 2 * D_ATTN:])
        zc_kv = hc @ w_in[layer][:, kv_cols]
        kc = split_heads(zc_kv[..., :D_ATTN])
        vc = split_heads(zc_kv[..., D_ATTN:])

        pool_x = multiscale_pool(px, pool_w[layer], pool_scale[layer])
        attn_x = neighbourhood_attention(qx, kx, vx, kc, vc, na_rpb[layer])
        x = x + g1 * (jnp.concatenate([pool_x, attn_x], axis=-1) @ w_out[layer])

        if not last:
            zc_pq = hc @ w_in[layer][:, :D_POOL + D_ATTN]
            pool_c = multiscale_pool(zc_pq[..., :D_POOL], pool_w[layer], pool_scale[layer])
            attn_c = context_attention(split_heads(zc_pq[..., D_POOL:]), kc, vc)
            ctx = ctx + cg1 * (jnp.concatenate([pool_c, attn_c], axis=-1) @ w_out[layer])

        h2 = modulate(rmsnorm(x, norm2_g[layer]), sh2, sc2)
        x = x + g2 * peer(h2, peer_wq[layer], peer_keys[layer], peer_u[layer], peer_v[layer])
        if not last:
            h2c = modulate(rmsnorm(ctx, norm2_g[layer]), csh2, csc2)
            ctx = ctx + cg2 * peer(h2c, peer_wq[layer], peer_keys[layer], peer_u[layer], peer_v[layer])

    return rmsnorm(x, final_g)
```

```cpp
#include <hip/hip_runtime.h>
#include <cstdio>
#include <cstdint>
namespace pg8 {
#define PG8_LAS __attribute__((address_space(3)))
typedef unsigned short bf16_t;
typedef short bf16x8 __attribute__((ext_vector_type(8)));
typedef float f32x4 __attribute__((ext_vector_type(4)));
typedef unsigned u32x4 __attribute__((ext_vector_type(4)));
constexpr int BM = 256, BK = 64, HALF = 128, HTB = HALF * BK * 2  , STAGE_BYTES = 8 * HTB, NXCD = 8, WGM = 8;

__host__ __device__ __forceinline__ int lds_byte(int r, int c) { const int st = (r >> 4) * 2 + (c >> 5), rr = r & 15, cc = c & 31, ob = rr * 64 + cc * 2; return st * 1024 + (ob ^ (((ob >> 9) & 1) << 5)); }
__host__ __device__ __forceinline__ void stage_rc(int b, int& R, int& C) { const int st = b / 1024, sb = b % 1024, swz = sb ^ (((sb >> 9) & 1) << 5); R = (st >> 1) * 16 + swz / 64; C = (st & 1) * 32 + (swz % 64) / 2; }
__host__ __device__ __forceinline__ int perm32(int rho) { const int n = rho >> 4, i = rho & 15; return 8 * (i >> 2) + 4 * n + (i & 3); }

struct Unit { int pm, pn; };
struct Gemm { const bf16_t* A; const bf16_t* Bt; int M, N, K; };
struct StaticOrder {
    int nM, nN, nwg, G, c;
    __host__ __device__ void init(int M, int N, int G_, int c_) { nM = M / BM; nN = N / BM; nwg = nM * nN; G = G_; c = c_; }
    __host__ __device__ bool next(int i, Unit& u) const {
        const long L = (long)i * G + c; if (L >= nwg) return false;
        int wgid = (int)L; { const int q = nwg / NXCD, r = nwg % NXCD, xcd = wgid % NXCD, off = wgid / NXCD; wgid = (xcd < r ? xcd * (q + 1) : r * (q + 1) + (xcd - r) * q) + off; }
        const int nig = WGM * nN, gid = wgid / nig, fm = gid * WGM, gsz = (nM - fm) < WGM ? (nM - fm) : WGM;
        u.pm = fm + ((wgid % nig) % gsz); u.pn = (wgid % nig) / gsz; return true;
    }
    __device__ __forceinline__ void a_ready(const Unit&) const {}
    __device__ __forceinline__ void done(const Unit&) const {}
};

__device__ __forceinline__ unsigned cvt_pk_bf16(float lo, float hi) { unsigned r; asm volatile("v_cvt_pk_bf16_f32 %0, %1, %2" : "=v"(r) : "v"(lo), "v"(hi)); return r; }
struct EpiBf16 {
    static constexpr bool PERM = true, AFTER_DRAIN = false;
    bf16_t* O; int ldc;
    __device__ __forceinline__ void operator()(const f32x4 (&acc)[2][2][4][2], const Unit& u, int wr, int wc, int fr, int fq) const {
        const int row0 = u.pm * BM + wr * 64 + fr, col0 = u.pn * BM + wc * 32 + 8 * fq;
#pragma unroll
        for (int ai = 0; ai < 2; ++ai)
#pragma unroll
            for (int m = 0; m < 4; ++m) { bf16_t* rowp = O + (size_t)(row0 + ai * HALF + m * 16) * ldc + col0;
#pragma unroll
                for (int bj = 0; bj < 2; ++bj) { const f32x4 v0 = acc[ai][bj][m][0], v1 = acc[ai][bj][m][1];
                    u32x4 w; w.x = cvt_pk_bf16(v0[0], v0[1]); w.y = cvt_pk_bf16(v0[2], v0[3]); w.z = cvt_pk_bf16(v1[0], v1[1]); w.w = cvt_pk_bf16(v1[2], v1[3]);
                    *(u32x4*)(rowp + bj * HALF) = w; } }
    }
};
struct EpiX1 {
    static constexpr bool PERM = true, AFTER_DRAIN = false;
    const float* x; const float* mod; float* out;
    __device__ __forceinline__ void operator()(const f32x4 (&acc)[2][2][4][2], const Unit& u, int wr, int wc, int fr, int fq) const {
        const int row0 = u.pm * BM + wr * 64 + fr, col0 = u.pn * BM + wc * 32 + 8 * fq;
        const float* g1 = mod + (size_t)((u.pm * BM) >> 12) * 6144 + 2048 + col0;
        f32x4 gv[2][2];
#pragma unroll
        for (int bj = 0; bj < 2; ++bj)
#pragma unroll
            for (int n = 0; n < 2; ++n) gv[bj][n] = *(const f32x4*)(g1 + bj * HALF + 4 * n);
#pragma unroll
        for (int ai = 0; ai < 2; ++ai)
#pragma unroll
            for (int m = 0; m < 4; ++m) { const size_t off = (size_t)(row0 + ai * HALF + m * 16) * 1024 + col0;
#pragma unroll
                for (int bj = 0; bj < 2; ++bj)
#pragma unroll
                    for (int n = 0; n < 2; ++n) { const f32x4 xv = *(const f32x4*)(x + off + bj * HALF + 4 * n);
                        *(f32x4*)(out + off + bj * HALF + 4 * n) = xv + gv[bj][n] * acc[ai][bj][m][n]; } }
    }
};
template <class Epi, class Sched, bool ALIGN_EPI = false, bool SP2 = false>
__device__ __forceinline__ void gemm_phase(PG8_LAS unsigned char* lds, const Gemm g, const Sched& S, const Epi& E) {
    const int tid = threadIdx.x, wid = __builtin_amdgcn_readfirstlane(tid >> 6), lane = tid & 63, wr = wid >> 2, wc = wid & 3, fr = lane & 15, fq = lane >> 4;
    const int K = g.K, nt = K / BK;
    unsigned voffA[2], voffB[2];
#pragma unroll
    for (int i = 0; i < 2; ++i) { int R, C; stage_rc(tid * 16 + i * 8192, R, C); const int Rb = Epi::PERM ? ((R & ~31) + perm32(R & 31)) : R;
        voffA[i] = (unsigned)(R * K + C) * 2u; voffB[i] = (unsigned)(Rb * K + C) * 2u; }
    const size_t kstep = (size_t)(BK * 2);
    const size_t hstep = (size_t)HALF * K * 2;
    const size_t tstep = 2 * hstep;
    const unsigned ldsw = (unsigned)wid * 1024u;
    const int aoff = lds_byte(wr * 64 + fr, fq * 8), boff = lds_byte(wc * 32 + fr, fq * 8);
#define PG8_SA(b, h) (((b) * 2 + (h)) * HTB)
#define PG8_SB(b, h) ((4 + (b) * 2 + (h)) * HTB)
#define PG8_STAGE(bufoff, gbase, voff) do { _Pragma("unroll") for (int _i = 0; _i < 2; ++_i) \
        __builtin_amdgcn_global_load_lds((const unsigned*)((const char*)(gbase) + (voff)[_i]), (PG8_LAS unsigned*)(lds + (bufoff) + ldsw + _i * 8192), 16, 0, 0); } while (0)
#define PG8_LDA(dst, b, h) do { _Pragma("unroll") for (int m = 0; m < 4; ++m) _Pragma("unroll") for (int k = 0; k < 2; ++k) dst[m][k] = *(const PG8_LAS bf16x8*)(lds + PG8_SA(b, h) + aoff + m * 2048 + k * 1024); } while (0)
#define PG8_LDB(dst, b, h) do { _Pragma("unroll") for (int n = 0; n < 2; ++n) _Pragma("unroll") for (int k = 0; k < 2; ++k) dst[n][k] = *(const PG8_LAS bf16x8*)(lds + PG8_SB(b, h) + boff + n * 2048 + k * 1024); } while (0)
#define PG8_MMA(ai, bj, At, Bt) do { __builtin_amdgcn_s_setprio(1); _Pragma("unroll") for (int m = 0; m < 4; ++m) _Pragma("unroll") for (int n = 0; n < 2; ++n) _Pragma("unroll") for (int k = 0; k < 2; ++k) \
        acc[ai][bj][m][n] = __builtin_amdgcn_mfma_f32_16x16x32_bf16(Bt[n][k], At[m][k], acc[ai][bj][m][n], 0, 0, 0); __builtin_amdgcn_s_setprio(0); } while (0)
#define PG8_WAIT_V(n) asm volatile("s_waitcnt vmcnt(" #n ")" ::: "memory")
#define PG8_WAIT_L(n) asm volatile("s_waitcnt lgkmcnt(" #n ")" ::: "memory")
#define PG8_BAR __builtin_amdgcn_s_barrier()
#define PG8_SCHED __builtin_amdgcn_sched_barrier(0)
    Unit cur, nxt; int ui = 0;
    if (!S.next(0, cur)) return;
    f32x4 acc[2][2][4][2];
#pragma unroll
    for (int a = 0; a < 2; ++a)
#pragma unroll
        for (int b = 0; b < 2; ++b)
#pragma unroll
            for (int m = 0; m < 4; ++m)
#pragma unroll
                for (int n = 0; n < 2; ++n) acc[a][b][m][n] = (f32x4){0.f, 0.f, 0.f, 0.f};
    bf16x8 At[4][2], B0[2][2], B1[2][2];
    const char* cA = (const char*)g.A + (size_t)cur.pm * tstep; const char* cB = (const char*)g.Bt + (size_t)cur.pn * tstep;
    S.a_ready(cur);
    if constexpr (SP2) {
        PG8_STAGE(PG8_SB(0, 0), cB, voffB); PG8_STAGE(PG8_SB(0, 1), cB + hstep, voffB); PG8_STAGE(PG8_SA(0, 0), cA, voffA); PG8_STAGE(PG8_SA(0, 1), cA + hstep, voffA);
        if (wr == 1) PG8_BAR;
        PG8_WAIT_V(2); PG8_BAR;
        PG8_STAGE(PG8_SB(1, 0), cB + kstep, voffB); PG8_STAGE(PG8_SA(1, 0), cA + kstep, voffA); PG8_STAGE(PG8_SB(1, 1), cB + hstep + kstep, voffB);
        PG8_WAIT_V(6); PG8_BAR;
    } else {
        PG8_STAGE(PG8_SB(0, 0), cB, voffB); PG8_STAGE(PG8_SA(0, 0), cA, voffA); PG8_STAGE(PG8_SB(0, 1), cB + hstep, voffB); PG8_STAGE(PG8_SA(0, 1), cA + hstep, voffA);
        if (wr == 1) PG8_BAR;
        PG8_WAIT_V(4); PG8_BAR;
        PG8_STAGE(PG8_SB(1, 0), cB + kstep, voffB); PG8_STAGE(PG8_SA(1, 0), cA + kstep, voffA); PG8_STAGE(PG8_SB(1, 1), cB + hstep + kstep, voffB);
        PG8_WAIT_V(6); PG8_BAR;
    }
    for (;;) {
        const bool has_next = S.next(ui + 1, nxt);
        const char* nA = has_next ? (const char*)g.A + (size_t)nxt.pm * tstep : cA; const char* nB = has_next ? (const char*)g.Bt + (size_t)nxt.pn * tstep : cB;
        for (int t = 0; t < nt; t += 2) {
            const bool last = (t == nt - 2);
            const char* a1 = cA + (size_t)(t + 1) * kstep;
            const char* a2 = last ? nA : cA + (size_t)(t + 2) * kstep; const char* b2 = last ? nB : cB + (size_t)(t + 2) * kstep;
            const char* a3 = a2 + kstep; const char* b3 = b2 + kstep;
            if (last && has_next) S.a_ready(nxt);
            if constexpr (SP2) {
            PG8_LDB(B0, 0, 0); PG8_LDB(B1, 0, 1); PG8_SCHED; PG8_LDA(At, 0, 0); PG8_STAGE(PG8_SA(1, 1), a1 + hstep, voffA);
            PG8_WAIT_V(8); PG8_WAIT_L(0); PG8_BAR; PG8_MMA(0, 0, At, B0); PG8_MMA(0, 1, At, B1); PG8_BAR; PG8_SCHED;
            PG8_LDA(At, 0, 1); PG8_STAGE(PG8_SB(0, 0), b2, voffB); PG8_STAGE(PG8_SB(0, 1), b2 + hstep, voffB); PG8_STAGE(PG8_SA(0, 0), a2, voffA);
            PG8_WAIT_V(8); PG8_WAIT_L(0); PG8_BAR; PG8_MMA(1, 0, At, B0); PG8_MMA(1, 1, At, B1); PG8_BAR; PG8_SCHED;
            PG8_LDB(B0, 1, 0); PG8_LDB(B1, 1, 1); PG8_SCHED; PG8_LDA(At, 1, 0); PG8_STAGE(PG8_SA(0, 1), a2 + hstep, voffA);
            PG8_WAIT_V(8); PG8_WAIT_L(0); PG8_BAR; PG8_MMA(0, 0, At, B0); PG8_MMA(0, 1, At, B1); PG8_BAR; PG8_SCHED;
            PG8_LDA(At, 1, 1); PG8_STAGE(PG8_SB(1, 0), b3, voffB); PG8_STAGE(PG8_SB(1, 1), b3 + hstep, voffB); PG8_STAGE(PG8_SA(1, 0), a3, voffA);
            PG8_WAIT_V(8); PG8_WAIT_L(0); PG8_BAR; PG8_MMA(1, 0, At, B0); PG8_MMA(1, 1, At, B1); PG8_BAR; PG8_SCHED;
            } else {
            PG8_LDB(B0, 0, 0); PG8_SCHED; PG8_LDA(At, 0, 0); PG8_STAGE(PG8_SA(1, 1), a1 + hstep, voffA);
            PG8_WAIT_L(8); PG8_BAR; PG8_WAIT_L(0); PG8_MMA(0, 0, At, B0); PG8_BAR; PG8_SCHED;
            PG8_LDB(B1, 0, 1); PG8_STAGE(PG8_SB(0, 0), b2, voffB);
            PG8_BAR; PG8_WAIT_L(0); PG8_MMA(0, 1, At, B1); PG8_BAR;
            PG8_LDA(At, 0, 1); PG8_STAGE(PG8_SA(0, 0), a2, voffA);
            PG8_BAR; PG8_WAIT_L(0); PG8_MMA(1, 0, At, B0); PG8_BAR; PG8_SCHED;
            PG8_STAGE(PG8_SB(0, 1), b2 + hstep, voffB);
            PG8_WAIT_V(6); PG8_BAR; PG8_MMA(1, 1, At, B1); PG8_BAR;
            PG8_LDB(B0, 1, 0); PG8_SCHED; PG8_LDA(At, 1, 0); PG8_STAGE(PG8_SA(0, 1), a2 + hstep, voffA);
            PG8_WAIT_L(8); PG8_BAR; PG8_WAIT_L(0); PG8_MMA(0, 0, At, B0); PG8_BAR; PG8_SCHED;
            PG8_LDB(B1, 1, 1); PG8_STAGE(PG8_SB(1, 0), b3, voffB);
            PG8_BAR; PG8_WAIT_L(0); PG8_MMA(0, 1, At, B1); PG8_BAR;
            PG8_LDA(At, 1, 1); PG8_STAGE(PG8_SA(1, 0), a3, voffA);
            PG8_BAR; PG8_WAIT_L(0); PG8_MMA(1, 0, At, B0); PG8_BAR; PG8_SCHED;
            PG8_STAGE(PG8_SB(1, 1), b3 + hstep, voffB);
            PG8_WAIT_V(6); PG8_BAR; PG8_MMA(1, 1, At, B1); PG8_BAR;
            }
        }
        if constexpr (ALIGN_EPI) { if (wr == 0) PG8_BAR; }
        if constexpr (!Epi::AFTER_DRAIN) { E(acc, cur, wr, wc, fr, fq); S.done(cur); }
        if (!has_next) break;
#pragma unroll
        for (int a = 0; a < 2; ++a)
#pragma unroll
            for (int b = 0; b < 2; ++b)
#pragma unroll
                for (int m = 0; m < 4; ++m)
#pragma unroll
                    for (int n = 0; n < 2; ++n) acc[a][b][m][n] = (f32x4){0.f, 0.f, 0.f, 0.f};
        cur = nxt; cA = nA; cB = nB; ++ui;
        if constexpr (ALIGN_EPI) { if (wr == 1) PG8_BAR; }
    }
    PG8_WAIT_V(0);
    if constexpr (!ALIGN_EPI) { if (wr == 0) PG8_BAR; }
    PG8_BAR;
    if constexpr (Epi::AFTER_DRAIN) { E.fused(acc, cur, wr, wc, fr, fq, lds, wid, lane); S.done(cur); }
#undef PG8_SA
#undef PG8_SB
#undef PG8_STAGE
#undef PG8_LDA
#undef PG8_LDB
#undef PG8_MMA
#undef PG8_WAIT_V
#undef PG8_WAIT_L
#undef PG8_BAR
#undef PG8_SCHED
}
}

constexpr int DM = 1024, NBATCH = 8, SEQ = 4096, NTOK = NBATCH * SEQ, CTXL = 256, NCTX = NBATCH * CTXL, MROWS = NTOK + NCTX;
constexpr int DIN = 2048, NHEAD = 8, HD = 64, GRIDW = 64, NMOD = 6 * DM;
constexpr int NEXP = 16384;
constexpr float EPS = 1e-6f;
constexpr int NWAVES = 8;
constexpr int NPHASE = 8;
#ifndef MK_N_LAUNCHES
#define MK_N_LAUNCHES 8
#endif
constexpr int N_LAUNCHES = MK_N_LAUNCHES;

constexpr size_t MiB = 1u << 20;
constexpr size_t WS_CTL = 0, CTL_ZERO_BYTES = 64 * 1024;
constexpr size_t WS_WIN = 2 * MiB, WS_WOUT = 6 * MiB, WS_WQ = 8 * MiB, WS_KEYS = 12 * MiB, WS_POOLW = 12 * MiB + 512 * 1024, WS_MOD = 13 * MiB;
constexpr size_t WS_U = 14 * MiB, WS_V = 46 * MiB;
constexpr size_t WS_HX = 78 * MiB;
constexpr size_t WS_ZX = 146 * MiB;
constexpr size_t WS_MIX = 282 * MiB;
constexpr size_t WS_EXP = 346 * MiB, WS_GATE = 362 * MiB;
constexpr size_t WS_POOLED = 378 * MiB;
constexpr size_t WS_LISTS = 410 * MiB;
constexpr size_t WS_END = 442 * MiB;
constexpr int CW_BAR = 4096;

constexpr int RING_OFF = 0, RING_BYTES = 131072;
constexpr int LDSCTL_OFF = RING_BYTES, MISC_OFF = LDSCTL_OFF + 320;
constexpr int LDS_BYTES = 147456;

#define GAS __attribute__((address_space(1)))
#define LAS __attribute__((address_space(3)))
#define DI __device__ __forceinline__
typedef unsigned short bf16;
typedef unsigned v4u __attribute__((ext_vector_type(4)));
typedef unsigned v2u __attribute__((ext_vector_type(2)));
typedef float f32x4 __attribute__((ext_vector_type(4)));
typedef GAS unsigned gu32;
#define RLX_AGENT __ATOMIC_RELAXED, __HIP_MEMORY_SCOPE_AGENT
#define LDS_WAIT() asm volatile("s_waitcnt lgkmcnt(0)" ::: "memory")
#define VM_WAIT() asm volatile("s_waitcnt vmcnt(0)" ::: "memory")
DI unsigned f2bf(float f) { unsigned u = __builtin_bit_cast(unsigned, f); return (u + 0x7fffu + ((u >> 16) & 1u)) >> 16; }
DI unsigned pk2(float lo, float hi) { return f2bf(lo) | (f2bf(hi) << 16); }
DI float bflo(unsigned u) { return __uint_as_float(u << 16); }
DI float bfhi(unsigned u) { return __uint_as_float(u & 0xffff0000u); }
DI float wave_sum(float v) {
#pragma unroll
    for (int o = 1; o < 64; o <<= 1) v += __shfl_xor(v, o);
    return v;
}

#define XB_TMO      128
#define XB_XCNT(j)  (256  + 64 * (j))
#define XB_XSUB(j)  (1280 + 64 * (j))
#define XB_XGEN(j)  (2304 + 64 * (j))
#define XB_TOP      3328
#define XB_TOPGEN   3392
#define XCD_BAR_WORDS 3456
#define XB_SPIN_CAP (1u << 18)

__device__ __forceinline__ unsigned xb_ld(unsigned* p)              { return __hip_atomic_load(p, __ATOMIC_RELAXED, __HIP_MEMORY_SCOPE_AGENT); }
__device__ __forceinline__ unsigned xb_add(unsigned* p, unsigned v) { return __hip_atomic_fetch_add(p, v, __ATOMIC_RELAXED, __HIP_MEMORY_SCOPE_AGENT); }
__device__ __forceinline__ unsigned xb_xcc_id() { return (unsigned)__builtin_amdgcn_s_getreg((3 << 11) | 20) & 0xFu; }
#define XB_SPIN(cond, bar) do { unsigned _sp = 0; while (cond) { __builtin_amdgcn_s_sleep(1); \
    if ((++_sp & 255u) == 0u) { if (xb_ld(&(bar)[XB_TMO])) break; if (_sp > XB_SPIN_CAP) { atomicAdd(&(bar)[XB_TMO], 1u); break; } } } } while (0)

struct XcdBarrier {
    unsigned* bar; unsigned x;
    volatile LAS unsigned* st;
};

__device__ __forceinline__ XcdBarrier xcd_barrier_post(unsigned* bar, volatile LAS unsigned* st) {
    XcdBarrier b; b.bar = bar; b.x = xb_xcc_id(); b.st = st;
    if (threadIdx.x == 0) (void)xb_add(&bar[XB_XCNT(b.x)], 1u);
    return b;
}
__device__ __forceinline__ void xcd_barrier_complete(unsigned* bar, unsigned x, unsigned& nloc, unsigned& nx) {
    const unsigned G = gridDim.x * gridDim.y * gridDim.z;
    unsigned sum, cnt, mine, sp = 0u;
    for (;;) {
        sum = 0u; cnt = 0u; mine = 0u;
#pragma unroll
        for (unsigned j = 0; j < 16; ++j) { const unsigned c = xb_ld(&bar[XB_XCNT(j)]); sum += c; cnt += (c > 0u) ? 1u : 0u; mine = (j == x) ? c : mine; }
        if (sum == G) break;
        __builtin_amdgcn_s_sleep(1);
        if ((++sp & 255u) == 0u) { if (xb_ld(&bar[XB_TMO])) break; if (sp > XB_SPIN_CAP) { atomicAdd(&bar[XB_TMO], 1u); break; } }
    }
    nloc = mine > 0u ? mine : 1u; nx = cnt > 0u ? cnt : 1u;
}

__device__ __forceinline__ void xcd_barrier(const XcdBarrier& b) {
    asm volatile("s_waitcnt vmcnt(0)" ::: "memory");
    __syncthreads();
    if (threadIdx.x == 0) {
        unsigned* bar = b.bar;
        __builtin_amdgcn_s_waitcnt(0);
        unsigned nloc = b.st[0], nx = b.st[1];
        if (nloc == 0u) { xcd_barrier_complete(bar, b.x, nloc, nx); b.st[0] = nloc; b.st[1] = nx; }
        const unsigned old = xb_add(&bar[XB_XSUB(b.x)], 1u);
        const unsigned gen = old / nloc;
        if (old + 1u == (gen + 1u) * nloc) {
            __builtin_amdgcn_fence(__ATOMIC_RELEASE, "agent");
            asm volatile("s_waitcnt vmcnt(0)" ::: "memory");
            const unsigned og = xb_add(&bar[XB_TOP], 1u);
            const unsigned tg = og / nx;
            if (og + 1u == (tg + 1u) * nx) xb_add(&bar[XB_TOPGEN], 1u);
            else XB_SPIN(xb_ld(&bar[XB_TOPGEN]) == tg, bar);
            __builtin_amdgcn_fence(__ATOMIC_ACQUIRE, "agent");
            xb_add(&bar[XB_XGEN(b.x)], 1u);
            asm volatile("s_waitcnt vmcnt(0)" ::: "memory");
        } else {
            XB_SPIN(xb_ld(&bar[XB_XGEN(b.x)]) == gen, bar);
            __builtin_amdgcn_fence(__ATOMIC_ACQUIRE, "agent");
            asm volatile("s_waitcnt vmcnt(0)" ::: "memory");
        }
    }
    __syncthreads();
}


__device__ __forceinline__ void p0_transpose_item(const float* W, int K, int N, bf16* WT, int row_off, LAS float* scr, int item, int lane) {
    const int nblk = N / 32, kb = item / nblk, nb = item % nblk, k0 = 64 * kb, n0 = 32 * nb;
#pragma unroll 8
    for (int i = 0; i < 32; ++i) { const int kk = 2 * i + (lane >> 5); scr[kk * 33 + (lane & 31)] = W[(size_t)(k0 + kk) * N + n0 + (lane & 31)]; }
    LDS_WAIT(); asm volatile("" ::: "memory");
    const int c = lane & 7;
#pragma unroll
    for (int j = 0; j < 4; ++j) { const int n = (lane >> 3) + 8 * j; const LAS float* s = scr + (8 * c) * 33 + n;
        v4u o; o.x = pk2(s[0 * 33], s[1 * 33]); o.y = pk2(s[2 * 33], s[3 * 33]); o.z = pk2(s[4 * 33], s[5 * 33]); o.w = pk2(s[6 * 33], s[7 * 33]);
        *(GAS v4u*)(WT + (size_t)(row_off + n0 + n) * K + k0 + 8 * c) = o; }
    LDS_WAIT(); asm volatile("" ::: "memory");
}


struct Frame {
    LAS unsigned char* lds;
    int tid, lane, wave, vcu, G, gw, NGW;
    const float* in[18]; float* out; unsigned char* ws;
};

DI void p0_prologue(Frame& F) {
    const float* c = F.in[1]; const float* c_ctx = F.in[3]; const float* ada_w = F.in[4]; const float* ada_b = F.in[5];
    float* MOD = (float*)(F.ws + WS_MOD);
    LAS float* sl = (LAS float*)(F.lds + 73728);
    for (int i = F.tid; i < 9 * 1024; i += 512) { const int b = i >> 10, k = i & 1023; const float cv = (b < 8) ? c[b * 1024 + k] : c_ctx[k]; sl[i] = cv / (1.f + __expf(-cv)); }
    __syncthreads();
    for (int a = F.gw; a < NMOD / 16; a += F.NGW) {
        const int n = a * 16 + (F.lane & 15), kg = F.lane >> 4;
        float acc[9];
#pragma unroll
        for (int b = 0; b < 9; ++b) acc[b] = 0.f;
        const float* wp = ada_w + (size_t)(kg * 256) * NMOD + n; const LAS float* sp = sl + kg * 256;
#pragma unroll 8
        for (int i = 0; i < 256; ++i) { const float w = wp[(size_t)i * NMOD];
#pragma unroll
            for (int b = 0; b < 9; ++b) acc[b] += sp[b * 1024 + i] * w; }
#pragma unroll
        for (int b = 0; b < 9; ++b) { acc[b] += __shfl_xor(acc[b], 16); acc[b] += __shfl_xor(acc[b], 32); }
        if (kg == 0) { const float bb = ada_b[n];
#pragma unroll
            for (int b = 0; b < 9; ++b) MOD[b * NMOD + n] = acc[b] + bb; }
    }
    LAS float* scr = (LAS float*)(F.lds + F.wave * 9216);
    constexpr int I_IN = (DM / 64) * (DIN / 32), I_OUT = (DM / 64) * (DM / 32), I_Q = (DM / 64) * (2048 / 32), I_P = 4 * 8;
    for (int it = F.gw; it < I_IN + I_OUT + I_Q + I_P; it += F.NGW) {
        int r = it;
        if (r < I_IN) { p0_transpose_item(F.in[7], DM, DIN, (bf16*)(F.ws + WS_WIN), 0, scr, r, F.lane); continue; } r -= I_IN;
        if (r < I_OUT) { p0_transpose_item(F.in[11], DM, DM, (bf16*)(F.ws + WS_WOUT), 0, scr, r, F.lane); continue; } r -= I_OUT;
        if (r < I_Q) { p0_transpose_item(F.in[13], DM, 2048, (bf16*)(F.ws + WS_WQ), 0, scr, r, F.lane); continue; } r -= I_Q;
        { const int g = r >> 3; p0_transpose_item(F.in[8] + g * 16384, 128, 128, (bf16*)(F.ws + WS_POOLW) + g * 16384, 0, scr, r & 7, F.lane); }
    }
    { const float* kf = F.in[14]; bf16* kb = (bf16*)(F.ws + WS_KEYS);
      for (int it = F.gw; it < 262144 / 512; it += F.NGW) { const size_t o = (size_t)it * 512 + F.lane * 8;
          const f32x4 a = *(const f32x4*)(kf + o), b = *(const f32x4*)(kf + o + 4);
          v4u w; w.x = pk2(a.x, a.y); w.y = pk2(a.z, a.w); w.z = pk2(b.x, b.y); w.w = pk2(b.z, b.w); *(v4u*)(kb + o) = w; } }
    for (int it = F.gw; it < 2 * NEXP; it += F.NGW) {
        const float* src = (it < NEXP) ? F.in[15] + (size_t)it * 1024 : F.in[16] + (size_t)(it - NEXP) * 1024;
        bf16* dst = (it < NEXP) ? (bf16*)(F.ws + WS_U) + (size_t)it * 1024 : (bf16*)(F.ws + WS_V) + (size_t)(it - NEXP) * 1024;
#pragma unroll
        for (int p = 0; p < 2; ++p) { const int o = p * 512 + F.lane * 8;
            const f32x4 a = *(const f32x4*)(src + o), b = *(const f32x4*)(src + o + 4);
            v4u w; w.x = pk2(a.x, a.y); w.y = pk2(a.z, a.w); w.z = pk2(b.x, b.y); w.w = pk2(b.z, b.w); *(v4u*)(dst + o) = w; }
    }
}

DI void norm_rows(Frame& F, const float* src_x, const float* src_ctx, int nrows, const float* gain, int shift_off, int scale_off, bf16* dst) {
    const float* MOD = (const float*)(F.ws + WS_MOD);
    for (int m = F.gw; m < nrows; m += F.NGW) {
        const float* xrow; int b;
        if (m < NTOK) { xrow = src_x + (size_t)m * DM; b = m >> 12; } else { xrow = src_ctx + (size_t)(m - NTOK) * DM; b = 8; }
        const f32x4* xr = (const f32x4*)xrow + F.lane;
        f32x4 v[4]; float s = 0.f;
#pragma unroll
        for (int j = 0; j < 4; ++j) { v[j] = xr[64 * j]; s += (v[j].x * v[j].x + v[j].y * v[j].y) + (v[j].z * v[j].z + v[j].w * v[j].w); }
        const float rinv = 1.0f / sqrtf(wave_sum(s) * (1.f / DM) + EPS);
        const f32x4* gp = (const f32x4*)gain + F.lane; const f32x4* shp = (const f32x4*)(MOD + b * NMOD + shift_off) + F.lane; const f32x4* scp = (const f32x4*)(MOD + b * NMOD + scale_off) + F.lane;
        unsigned long long* o8 = (unsigned long long*)(dst + (size_t)m * DM) + F.lane;
#pragma unroll
        for (int j = 0; j < 4; ++j) { const f32x4 g = gp[64 * j], sh = shp[64 * j], sc = scp[64 * j];
            const f32x4 y = (v[j] * rinv) * g * (sc + 1.0f) + sh;
            o8[64 * j] = (unsigned long long)pk2(y.x, y.y) | ((unsigned long long)pk2(y.z, y.w) << 32); }
    }
}

DI void attn_key(const bf16* ZX, int h, int tok, float bias, const float (&q)[64], float (&o)[64], float& m, float& l) {
    const v4u* kp = (const v4u*)(ZX + (size_t)tok * DIN + 1024 + h * 64);
    float acc = 0.f;
#pragma unroll
    for (int cc = 0; cc < 8; ++cc) { const v4u kv = kp[cc];
        acc += q[8 * cc + 0] * bflo(kv.x) + q[8 * cc + 1] * bfhi(kv.x) + q[8 * cc + 2] * bflo(kv.y) + q[8 * cc + 3] * bfhi(kv.y)
             + q[8 * cc + 4] * bflo(kv.z) + q[8 * cc + 5] * bfhi(kv.z) + q[8 * cc + 6] * bflo(kv.w) + q[8 * cc + 7] * bfhi(kv.w); }
    const float s = acc + bias;
    const float mn = fmaxf(m, s), alpha = __expf(m - mn), p = __expf(s - mn);
    l = l * alpha + p; m = mn;
    const v4u* vp = (const v4u*)(ZX + (size_t)tok * DIN + 1536 + h * 64);
#pragma unroll
    for (int cc = 0; cc < 8; ++cc) { const v4u vv = vp[cc];
        o[8 * cc + 0] = o[8 * cc + 0] * alpha + p * bflo(vv.x); o[8 * cc + 1] = o[8 * cc + 1] * alpha + p * bfhi(vv.x); o[8 * cc + 2] = o[8 * cc + 2] * alpha + p * bflo(vv.y); o[8 * cc + 3] = o[8 * cc + 3] * alpha + p * bfhi(vv.y);
        o[8 * cc + 4] = o[8 * cc + 4] * alpha + p * bflo(vv.z); o[8 * cc + 5] = o[8 * cc + 5] * alpha + p * bfhi(vv.z); o[8 * cc + 6] = o[8 * cc + 6] * alpha + p * bflo(vv.w); o[8 * cc + 7] = o[8 * cc + 7] * alpha + p * bfhi(vv.w); }
}
DI void attn_naive(Frame& F) {
    const bf16* ZX = (const bf16*)(F.ws + WS_ZX); bf16* MIX = (bf16*)(F.ws + WS_MIX); const float* rpb = F.in[10];
    for (int unit = F.gw; unit < NBATCH * NHEAD * 64; unit += F.NGW) {
        const int r = unit & 63, h = (unit >> 6) & 7, b = unit >> 9, col = F.lane;
        const int tq = b * SEQ + r * GRIDW + col;
        float q[64], o[64];
        { const v4u* qp = (const v4u*)(ZX + (size_t)tq * DIN + 512 + h * 64);
#pragma unroll
          for (int cc = 0; cc < 8; ++cc) { const v4u qv = qp[cc];
              q[8 * cc + 0] = 0.125f * bflo(qv.x); q[8 * cc + 1] = 0.125f * bfhi(qv.x); q[8 * cc + 2] = 0.125f * bflo(qv.y); q[8 * cc + 3] = 0.125f * bfhi(qv.y);
              q[8 * cc + 4] = 0.125f * bflo(qv.z); q[8 * cc + 5] = 0.125f * bfhi(qv.z); q[8 * cc + 6] = 0.125f * bflo(qv.w); q[8 * cc + 7] = 0.125f * bfhi(qv.w); } }
#pragma unroll
        for (int d = 0; d < 64; ++d) o[d] = 0.f;
        float m = -1e30f, l = 0.f;
#pragma unroll 1
        for (int g = 0; g < CTXL; ++g) attn_key(ZX, h, NTOK + b * CTXL + g, 0.f, q, o, m, l);
        const int r0 = min(max(r - 4, 0), 56), c0 = min(max(col - 8, 0), 48);
#pragma unroll 1
        for (int ij = 0; ij < 128; ++ij) { const int i = ij >> 4, j = ij & 15;
            attn_key(ZX, h, b * SEQ + (r0 + i) * GRIDW + c0 + j, rpb[(h * 15 + (r0 + i - r + 7)) * 31 + (c0 + j - col + 15)], q, o, m, l); }
        const float il = 1.0f / l;
        v4u* op = (v4u*)(MIX + (size_t)tq * DM + 512 + h * 64);
#pragma unroll
        for (int cc = 0; cc < 8; ++cc) { v4u w; w.x = pk2(o[8 * cc] * il, o[8 * cc + 1] * il); w.y = pk2(o[8 * cc + 2] * il, o[8 * cc + 3] * il);
            w.z = pk2(o[8 * cc + 4] * il, o[8 * cc + 5] * il); w.w = pk2(o[8 * cc + 6] * il, o[8 * cc + 7] * il); op[cc] = w; }
    }
}
DI void pool_naive(Frame& F) {
    const bf16* ZX = (const bf16*)(F.ws + WS_ZX); bf16* MIX = (bf16*)(F.ws + WS_MIX); bf16* PO = (bf16*)(F.ws + WS_POOLED);
    const float* pool_w = F.in[8]; const float* pool_scale = F.in[9];
    for (int tile = F.vcu; tile < NTOK / 128; tile += F.G) {
        const int tok0 = tile * 128;
        for (int it = F.tid; it < 128 * 64; it += 512) {
            const int t = tok0 + (it >> 6), ch = (it & 63) * 8, g = ch >> 7, w = 2 << g, s = t & (SEQ - 1), tb = t - s;
            const int lo = max(s - w / 2, 0), hi = min(s + w / 2, SEQ);
            float acc[8];
#pragma unroll
            for (int i = 0; i < 8; ++i) acc[i] = 0.f;
            for (int p = lo; p < hi; ++p) { const v4u v = *(const v4u*)(ZX + (size_t)(tb + p) * DIN + ch);
                acc[0] += bflo(v.x); acc[1] += bfhi(v.x); acc[2] += bflo(v.y); acc[3] += bfhi(v.y); acc[4] += bflo(v.z); acc[5] += bfhi(v.z); acc[6] += bflo(v.w); acc[7] += bfhi(v.w); }
            const float inv = 1.0f / (float)(hi - lo);
            const v4u sv = *(const v4u*)(ZX + (size_t)t * DIN + ch);
            v4u wv; wv.x = pk2(acc[0] * inv - bflo(sv.x), acc[1] * inv - bfhi(sv.x)); wv.y = pk2(acc[2] * inv - bflo(sv.y), acc[3] * inv - bfhi(sv.y));
            wv.z = pk2(acc[4] * inv - bflo(sv.z), acc[5] * inv - bfhi(sv.z)); wv.w = pk2(acc[6] * inv - bflo(sv.w), acc[7] * inv - bfhi(sv.w));
            *(v4u*)(PO + (size_t)t * 512 + ch) = wv;
        }
        VM_WAIT(); __syncthreads();
        for (int it = F.wave; it < 1024; it += 8) {
            const int t = tok0 + (it >> 3), g = (it >> 1) & 3, d = (it & 1) * 64 + F.lane;
            const bf16* pr = PO + (size_t)t * 512 + g * 128; const float* wp = pool_w + g * 16384 + d;
            float acc = 0.f;
            for (int c8 = 0; c8 < 16; ++c8) { const v4u pv = *(const v4u*)(pr + c8 * 8); const float* w8 = wp + c8 * 8 * 128;
                acc += bflo(pv.x) * w8[0] + bfhi(pv.x) * w8[128] + bflo(pv.y) * w8[256] + bfhi(pv.y) * w8[384] + bflo(pv.z) * w8[512] + bfhi(pv.z) * w8[640] + bflo(pv.w) * w8[768] + bfhi(pv.w) * w8[896]; }
            MIX[(size_t)t * DM + g * 128 + d] = (bf16)f2bf(acc * pool_scale[g * 128 + d]);
        }
        __syncthreads();
    }
}

DI void peer_topk_naive(Frame& F, int tok0) {
    const bf16* Q = (const bf16*)(F.ws + WS_ZX); const float* keys = F.in[14]; float* LISTS = (float*)(F.ws + WS_LISTS);
    int* EXPERTS = (int*)(F.ws + WS_EXP); float* GATES = (float*)(F.ws + WS_GATE);
    for (int it = F.wave; it < 32; it += 8) {
        const int hp = it & 15, t = tok0 + (it >> 4) * 64 + F.lane;
        float q[128];
        { const v4u* qp = (const v4u*)(Q + (size_t)t * 2048 + hp * 128);
#pragma unroll
          for (int cc = 0; cc < 16; ++cc) { const v4u qv = qp[cc];
              q[8 * cc + 0] = bflo(qv.x); q[8 * cc + 1] = bfhi(qv.x); q[8 * cc + 2] = bflo(qv.y); q[8 * cc + 3] = bfhi(qv.y);
              q[8 * cc + 4] = bflo(qv.z); q[8 * cc + 5] = bfhi(qv.z); q[8 * cc + 6] = bflo(qv.w); q[8 * cc + 7] = bfhi(qv.w); } }
        float top[16];
#pragma unroll
        for (int i = 0; i < 16; ++i) top[i] = -INFINITY;
        const float* kb = keys + (size_t)hp * 16384;
        for (int n = 0; n < 128; ++n) {
            const f32x4* kr = (const f32x4*)(kb + n * 128);
            float acc = 0.f;
#pragma unroll
            for (int cc = 0; cc < 32; ++cc) { const f32x4 kv = kr[cc]; acc += q[4 * cc] * kv.x + q[4 * cc + 1] * kv.y + q[4 * cc + 2] * kv.z + q[4 * cc + 3] * kv.w; }
            float v = __uint_as_float((__float_as_uint(acc) & ~127u) | (unsigned)n);
#pragma unroll
            for (int i = 0; i < 16; ++i) { const float hi = fmaxf(top[i], v); v = fminf(top[i], v); top[i] = hi; }
        }
        f32x4* lp = (f32x4*)(LISTS + ((size_t)t * 16 + hp) * 16);
#pragma unroll
        for (int i = 0; i < 4; ++i) lp[i] = (f32x4){top[4 * i], top[4 * i + 1], top[4 * i + 2], top[4 * i + 3]};
    }
    VM_WAIT(); __syncthreads();
    for (int it = F.tid; it < 128 * 8; it += 512) {
        const int t = tok0 + (it >> 3), h = it & 7;
        float v0[16], v1[16]; int i0[16], i1[16];
        const f32x4* l0 = (const f32x4*)(LISTS + ((size_t)t * 16 + h * 2) * 16);
#pragma unroll
        for (int i = 0; i < 4; ++i) { const f32x4 a = l0[i], b = l0[4 + i];
#pragma unroll
            for (int e = 0; e < 4; ++e) { const unsigned ua = __float_as_uint(a[e]), ub = __float_as_uint(b[e]);
                v0[4 * i + e] = __uint_as_float(ua & ~127u); i0[4 * i + e] = (int)(ua & 127u); v1[4 * i + e] = __uint_as_float(ub & ~127u); i1[4 * i + e] = (int)(ub & 127u); } }
        float tv[16]; int ti[16];
#pragma unroll
        for (int i = 0; i < 16; ++i) { tv[i] = -INFINITY; ti[i] = 0; }
#pragma unroll
        for (int i = 0; i < 16; ++i)
#pragma unroll
            for (int j = 0; j < 16; ++j) if ((i + 1) * (j + 1) <= 16) {
                float cv = v0[i] + v1[j]; int ci = i0[i] * 128 + i1[j];
#pragma unroll
                for (int k = 0; k < 16; ++k) { const bool gt = cv > tv[k]; const float nv = gt ? cv : tv[k]; const int ni = gt ? ci : ti[k]; cv = gt ? tv[k] : cv; ci = gt ? ti[k] : ci; tv[k] = nv; ti[k] = ni; }
            }
        float e[16], sum = 0.f;
#pragma unroll
        for (int k = 0; k < 16; ++k) { e[k] = __expf(tv[k] - tv[0]); sum += e[k]; }
        const float is = 1.0f / sum;
        int* ep = EXPERTS + (size_t)t * 128 + h * 16; float* gp = GATES + (size_t)t * 128 + h * 16;
#pragma unroll
        for (int k = 0; k < 16; ++k) { ep[k] = ti[k]; gp[k] = e[k] * is; }
    }
    VM_WAIT(); __syncthreads();
}

DI float gelu_exact(float a) { return 0.5f * a * (1.0f + erff(a * 0.70710678118654752f)); }

DI void peer_gather_token(Frame& F, int t) {
    const bf16* H2 = (const bf16*)(F.ws + WS_HX); const bf16* U = (const bf16*)(F.ws + WS_U); const bf16* V = (const bf16*)(F.ws + WS_V);
    const int* EXPERTS = (const int*)(F.ws + WS_EXP); const float* GATES = (const float*)(F.ws + WS_GATE); const float* MOD = (const float*)(F.ws + WS_MOD);
    const int lane = F.lane;
    float hs[16];
    { const v4u a = *((const v4u*)(H2 + (size_t)t * DM) + lane), b = *((const v4u*)(H2 + (size_t)t * DM) + 64 + lane);
      hs[0] = bflo(a.x); hs[1] = bfhi(a.x); hs[2] = bflo(a.y); hs[3] = bfhi(a.y); hs[4] = bflo(a.z); hs[5] = bfhi(a.z); hs[6] = bflo(a.w); hs[7] = bfhi(a.w);
      hs[8] = bflo(b.x); hs[9] = bfhi(b.x); hs[10] = bflo(b.y); hs[11] = bfhi(b.y); hs[12] = bflo(b.z); hs[13] = bfhi(b.z); hs[14] = bflo(b.w); hs[15] = bfhi(b.w); }
    const int ev0 = EXPERTS[(size_t)t * 128 + lane], ev1 = EXPERTS[(size_t)t * 128 + 64 + lane];
    float out[16];
#pragma unroll
    for (int i = 0; i < 16; ++i) out[i] = 0.f;
    for (int bt = 0; bt < 16; ++bt) {
        const int evs = (bt < 8) ? ev0 : ev1;
        v4u ur[8][2], vr[8][2];
#pragma unroll
        for (int r = 0; r < 8; ++r) { const int e = __builtin_amdgcn_readlane(evs, (bt & 7) * 8 + r);
            const v4u* up = (const v4u*)(U + (size_t)e * DM); ur[r][0] = up[lane]; ur[r][1] = up[64 + lane];
            const v4u* vp = (const v4u*)(V + (size_t)e * DM); vr[r][0] = vp[lane]; vr[r][1] = vp[64 + lane]; }
        float p[8];
#pragma unroll
        for (int r = 0; r < 8; ++r) { const v4u a = ur[r][0], b = ur[r][1];
            p[r] = (hs[0] * bflo(a.x) + hs[1] * bfhi(a.x) + hs[2] * bflo(a.y) + hs[3] * bfhi(a.y)) + (hs[4] * bflo(a.z) + hs[5] * bfhi(a.z) + hs[6] * bflo(a.w) + hs[7] * bfhi(a.w))
                 + (hs[8] * bflo(b.x) + hs[9] * bfhi(b.x) + hs[10] * bflo(b.y) + hs[11] * bfhi(b.y)) + (hs[12] * bflo(b.z) + hs[13] * bfhi(b.z) + hs[14] * bflo(b.w) + hs[15] * bfhi(b.w)); }
        { const bool h5 = (lane & 32) != 0;
#pragma unroll
          for (int i = 0; i < 4; ++i) { const float send = h5 ? p[i] : p[i + 4], keep = h5 ? p[i + 4] : p[i]; p[i] = keep + __shfl_xor(send, 32); }
          const bool h4 = (lane & 16) != 0;
#pragma unroll
          for (int i = 0; i < 2; ++i) { const float send = h4 ? p[i] : p[i + 2], keep = h4 ? p[i + 2] : p[i]; p[i] = keep + __shfl_xor(send, 16); }
          const bool h3 = (lane & 8) != 0;
          { const float send = h3 ? p[0] : p[1], keep = h3 ? p[1] : p[0]; p[0] = keep + __shfl_xor(send, 8); }
          p[0] += __shfl_xor(p[0], 4); p[0] += __shfl_xor(p[0], 2); p[0] += __shfl_xor(p[0], 1); }
        const float gk = GATES[(size_t)t * 128 + bt * 8 + ((lane >> 3) & 7)];
        const float w = gk * gelu_exact(p[0]);
#pragma unroll
        for (int r = 0; r < 8; ++r) { const float wr = __builtin_bit_cast(float, __builtin_amdgcn_readlane(__builtin_bit_cast(int, w), r * 8)); const v4u a = vr[r][0], b = vr[r][1];
            out[0] += wr * bflo(a.x); out[1] += wr * bfhi(a.x); out[2] += wr * bflo(a.y); out[3] += wr * bfhi(a.y); out[4] += wr * bflo(a.z); out[5] += wr * bfhi(a.z); out[6] += wr * bflo(a.w); out[7] += wr * bfhi(a.w);
            out[8] += wr * bflo(b.x); out[9] += wr * bfhi(b.x); out[10] += wr * bflo(b.y); out[11] += wr * bfhi(b.y); out[12] += wr * bflo(b.z); out[13] += wr * bfhi(b.z); out[14] += wr * bflo(b.w); out[15] += wr * bfhi(b.w); }
    }
    const int b = t >> 12; const float* g2 = MOD + b * NMOD + 5 * DM; const float* fg = F.in[17]; float* xo = F.out + (size_t)t * DM;
    float x2[16]; float ss = 0.f;
#pragma unroll
    for (int gq = 0; gq < 2; ++gq)
#pragma unroll
        for (int hq = 0; hq < 2; ++hq) { const int c = gq * 512 + lane * 8 + hq * 4; const f32x4 xv = *(const f32x4*)(xo + c), gv = *(const f32x4*)(g2 + c);
#pragma unroll
            for (int e = 0; e < 4; ++e) { const float y = xv[e] + gv[e] * out[gq * 8 + hq * 4 + e]; x2[gq * 8 + hq * 4 + e] = y; ss += y * y; } }
    const float rinv = 1.0f / sqrtf(wave_sum(ss) * (1.f / DM) + EPS);
#pragma unroll
    for (int gq = 0; gq < 2; ++gq)
#pragma unroll
        for (int hq = 0; hq < 2; ++hq) { const int c = gq * 512 + lane * 8 + hq * 4; const f32x4 fv = *(const f32x4*)(fg + c);
            f32x4 y;
#pragma unroll
            for (int e = 0; e < 4; ++e) y[e] = x2[gq * 8 + hq * 4 + e] * rinv * fv[e];
            *(f32x4*)(xo + c) = y; }
}

struct Args { const float* in[18]; float* out; unsigned char* ws; int ph_lo, ph_hi, li, pad; };
__global__ void __launch_bounds__(NWAVES * 64, 2) mk_fwd(Args args) {
    extern __shared__ __attribute__((aligned(16))) unsigned char lds[];
    Frame F;
    F.lds = (LAS unsigned char*)lds;
    F.tid = threadIdx.x; F.lane = F.tid & 63; F.wave = __builtin_amdgcn_readfirstlane(F.tid >> 6);
    F.G = gridDim.x; { const int bx = blockIdx.x; F.vcu = (F.G % 8 == 0) ? (bx % 8) * (F.G / 8) + bx / 8 : bx; }
    F.gw = F.vcu * NWAVES + F.wave; F.NGW = F.G * NWAVES;
#pragma unroll
    for (int i = 0; i < 18; ++i) F.in[i] = args.in[i];
    F.out = args.out; F.ws = args.ws;
    volatile LAS unsigned* MISC = (volatile LAS unsigned*)(F.lds + MISC_OFF);
    for (int u = F.tid; u < (LDS_BYTES - LDSCTL_OFF) / 4; u += NWAVES * 64) ((LAS unsigned*)(F.lds + LDSCTL_OFF))[u] = 0u;
    __syncthreads();
    gu32* ctl = (gu32*)(F.ws + WS_CTL);
    XcdBarrier bar; bar.bar = (unsigned*)(ctl + CW_BAR) + args.li * XCD_BAR_WORDS; bar.x = 0; bar.st = nullptr;
    const int lo = args.ph_lo, hi = args.ph_hi;
    if (hi - lo > 1) bar = xcd_barrier_post((unsigned*)(ctl + CW_BAR) + args.li * XCD_BAR_WORDS, MISC + 8);
#define IN(k) (lo <= (k) && (k) < hi)
#define SEAM(k) do { if (IN(k) && IN((k) + 1)) xcd_barrier(bar); } while (0)

#ifndef SKIP0
    if (IN(0)) { p0_prologue(F); SEAM(0); }
#endif
    if (IN(1)) { norm_rows(F, F.in[0], F.in[2], MROWS, F.in[6], 0, DM, (bf16*)(F.ws + WS_HX)); SEAM(1); }
    if (IN(2)) {
        pg8::Gemm g{(const bf16*)(F.ws + WS_HX), (const bf16*)(F.ws + WS_WIN), MROWS, DIN, DM}; pg8::StaticOrder S; S.init(MROWS, DIN, F.G, (int)blockIdx.x);
        pg8::EpiBf16 E{(bf16*)(F.ws + WS_ZX), DIN};
        pg8::gemm_phase<pg8::EpiBf16, pg8::StaticOrder, true, true>(F.lds + RING_OFF, g, S, E);
        SEAM(2);
    }
    if (IN(3)) {
#ifndef SKIP3A
 attn_naive(F);
#endif
#ifndef SKIP3B
 pool_naive(F);
#endif
 SEAM(3); }
    if (IN(4)) {
        pg8::Gemm g{(const bf16*)(F.ws + WS_MIX), (const bf16*)(F.ws + WS_WOUT), NTOK, DM, DM}; pg8::StaticOrder S; S.init(NTOK, DM, F.G, (int)blockIdx.x);
        pg8::EpiX1 E{F.in[0], (const float*)(F.ws + WS_MOD), F.out};
        pg8::gemm_phase<pg8::EpiX1, pg8::StaticOrder, true, true>(F.lds + RING_OFF, g, S, E);
        SEAM(4);
    }
    if (IN(5)) { norm_rows(F, F.out, F.out, NTOK, F.in[12], 3 * DM, 4 * DM, (bf16*)(F.ws + WS_HX)); SEAM(5); }
    if (IN(6)) {
        pg8::Gemm g{(const bf16*)(F.ws + WS_HX), (const bf16*)(F.ws + WS_WQ), NTOK, 2048, DM}; pg8::StaticOrder S; S.init(NTOK, 2048, F.G, (int)blockIdx.x);
        pg8::EpiBf16 E{(bf16*)(F.ws + WS_ZX), 2048};
        pg8::gemm_phase<pg8::EpiBf16, pg8::StaticOrder, true, true>(F.lds + RING_OFF, g, S, E);
        SEAM(6);
    }
    if (IN(7)) {
        for (int tile = F.vcu; tile < NTOK / 128; tile += F.G) {
            const int tok0 = tile * 128;
#ifndef SKIP7A
            peer_topk_naive(F, tok0);
#endif
#ifndef SKIP7B
            for (int i = F.wave; i < 128; i += 8) peer_gather_token(F, tok0 + i);
#endif
        }
    }
#undef IN
#undef SEAM
}

extern "C" void kernel_launch(void* const* d_in, const int* in_sizes, int n_in, void* d_out, int out_size, void* d_ws, size_t ws_size, hipStream_t stream) {
    static int grid = 0;
    if (grid == 0) {
        if (n_in != 18 || in_sizes[0] != NTOK * DM || out_size != NTOK * DM || ws_size < WS_END) { fprintf(stderr, "kernel_launch: unexpected shapes / workspace (n_in %d, ws %zu); nothing launched\n", n_in, ws_size); grid = -1; return; }
        int dev = 0, cus = 0;
        if (hipGetDevice(&dev) != hipSuccess || hipDeviceGetAttribute(&cus, hipDeviceAttributeMultiprocessorCount, dev) != hipSuccess) { grid = -1; return; }
        if (hipFuncSetAttribute((const void*)mk_fwd, hipFuncAttributeMaxDynamicSharedMemorySize, LDS_BYTES) != hipSuccess) { fprintf(stderr, "kernel_launch: hipFuncSetAttribute failed\n"); grid = -1; return; }
        int per_cu = 0;
        if (hipOccupancyMaxActiveBlocksPerMultiprocessor(&per_cu, (const void*)mk_fwd, NWAVES * 64, LDS_BYTES) != hipSuccess || per_cu < 1) fprintf(stderr, "kernel_launch: note: occupancy query reports %d blocks per CU\n", per_cu);
        (void)hipGetLastError();
        grid = cus;
    }
    if (grid < 0) return;
    (void)hipMemsetAsync((char*)d_ws + WS_CTL, 0, CTL_ZERO_BYTES, stream);
    Args a{};
    for (int i = 0; i < 18; ++i) a.in[i] = (const float*)d_in[i];
    a.out = (float*)d_out; a.ws = (unsigned char*)d_ws;
    for (int li = 0; li < N_LAUNCHES; ++li) {
        if (N_LAUNCHES == 1) { a.ph_lo = 0; a.ph_hi = NPHASE; } else { a.ph_lo = li; a.ph_hi = li + 1; }
        a.li = (N_LAUNCHES == 1) ? 0 : 0;
        hipLaunchKernelGGL(mk_fwd, dim3(grid), dim3(NWAVES * 64), LDS_BYTES, stream, a);
    }
}
```

```cpp
#include <hip/hip_runtime.h>
#include <cstdio>
#include <cstdint>
namespace pg8 {
#define PG8_LAS __attribute__((address_space(3)))
typedef unsigned short bf16_t;
typedef short bf16x8 __attribute__((ext_vector_type(8)));
typedef float f32x4 __attribute__((ext_vector_type(4)));
typedef unsigned u32x4 __attribute__((ext_vector_type(4)));
constexpr int BM = 256, BK = 64, HALF = 128, HTB = HALF * BK * 2  , STAGE_BYTES = 8 * HTB, NXCD = 8, WGM = 8;

__host__ __device__ __forceinline__ int lds_byte(int r, int c) { const int st = (r >> 4) * 2 + (c >> 5), rr = r & 15, cc = c & 31, ob = rr * 64 + cc * 2; return st * 1024 + (ob ^ (((ob >> 9) & 1) << 5)); }
__host__ __device__ __forceinline__ void stage_rc(int b, int& R, int& C) { const int st = b / 1024, sb = b % 1024, swz = sb ^ (((sb >> 9) & 1) << 5); R = (st >> 1) * 16 + swz / 64; C = (st & 1) * 32 + (swz % 64) / 2; }
__host__ __device__ __forceinline__ int perm32(int rho) { const int n = rho >> 4, i = rho & 15; return 8 * (i >> 2) + 4 * n + (i & 3); }

struct Unit { int pm, pn; };
struct Gemm { const bf16_t* A; const bf16_t* Bt; int M, N, K; };
struct StaticOrder {
    int nM, nN, nwg, G, c;
    __host__ __device__ void init(int M, int N, int G_, int c_) { nM = M / BM; nN = N / BM; nwg = nM * nN; G = G_; c = c_; }
    __host__ __device__ bool next(int i, Unit& u) const {
        const long L = (long)i * G + c; if (L >= nwg) return false;
        int wgid = (int)L; { const int q = nwg / NXCD, r = nwg % NXCD, xcd = wgid % NXCD, off = wgid / NXCD; wgid = (xcd < r ? xcd * (q + 1) : r * (q + 1) + (xcd - r) * q) + off; }
        const int nig = WGM * nN, gid = wgid / nig, fm = gid * WGM, gsz = (nM - fm) < WGM ? (nM - fm) : WGM;
        u.pm = fm + ((wgid % nig) % gsz); u.pn = (wgid % nig) / gsz; return true;
    }
    __device__ __forceinline__ void a_ready(const Unit&) const {}
    __device__ __forceinline__ void done(const Unit&) const {}
};

__device__ __forceinline__ unsigned cvt_pk_bf16(float lo, float hi) { unsigned r; asm volatile("v_cvt_pk_bf16_f32 %0, %1, %2" : "=v"(r) : "v"(lo), "v"(hi)); return r; }
struct EpiBf16 {
    static constexpr bool PERM = true, AFTER_DRAIN = false;
    bf16_t* O; int ldc;
    __device__ __forceinline__ void operator()(const f32x4 (&acc)[2][2][4][2], const Unit& u, int wr, int wc, int fr, int fq) const {
        const int row0 = u.pm * BM + wr * 64 + fr, col0 = u.pn * BM + wc * 32 + 8 * fq;
#pragma unroll
        for (int ai = 0; ai < 2; ++ai)
#pragma unroll
            for (int m = 0; m < 4; ++m) { bf16_t* rowp = O + (size_t)(row0 + ai * HALF + m * 16) * ldc + col0;
#pragma unroll
                for (int bj = 0; bj < 2; ++bj) { const f32x4 v0 = acc[ai][bj][m][0], v1 = acc[ai][bj][m][1];
                    u32x4 w; w.x = cvt_pk_bf16(v0[0], v0[1]); w.y = cvt_pk_bf16(v0[2], v0[3]); w.z = cvt_pk_bf16(v1[0], v1[1]); w.w = cvt_pk_bf16(v1[2], v1[3]);
                    *(u32x4*)(rowp + bj * HALF) = w; } }
    }
};
struct EpiX1 {
    static constexpr bool PERM = true, AFTER_DRAIN = false;
    const float* x; const float* mod; float* out;
    __device__ __forceinline__ void operator()(const f32x4 (&acc)[2][2][4][2], const Unit& u, int wr, int wc, int fr, int fq) const {
        const int row0 = u.pm * BM + wr * 64 + fr, col0 = u.pn * BM + wc * 32 + 8 * fq;
        const float* g1 = mod + (size_t)((u.pm * BM) >> 12) * 6144 + 2048 + col0;
        f32x4 gv[2][2];
#pragma unroll
        for (int bj = 0; bj < 2; ++bj)
#pragma unroll
            for (int n = 0; n < 2; ++n) gv[bj][n] = *(const f32x4*)(g1 + bj * HALF + 4 * n);
#pragma unroll
        for (int ai = 0; ai < 2; ++ai)
#pragma unroll
            for (int m = 0; m < 4; ++m) { const size_t off = (size_t)(row0 + ai * HALF + m * 16) * 1024 + col0;
#pragma unroll
                for (int bj = 0; bj < 2; ++bj)
#pragma unroll
                    for (int n = 0; n < 2; ++n) { const f32x4 xv = *(const f32x4*)(x + off + bj * HALF + 4 * n);
                        *(f32x4*)(out + off + bj * HALF + 4 * n) = xv + gv[bj][n] * acc[ai][bj][m][n]; } }
    }
};
template <class Epi, class Sched, bool ALIGN_EPI = false, bool SP2 = false>
__device__ __forceinline__ void gemm_phase(PG8_LAS unsigned char* lds, const Gemm g, const Sched& S, const Epi& E) {
    const int tid = threadIdx.x, wid = __builtin_amdgcn_readfirstlane(tid >> 6), lane = tid & 63, wr = wid >> 2, wc = wid & 3, fr = lane & 15, fq = lane >> 4;
    const int K = g.K, nt = K / BK;
    unsigned voffA[2], voffB[2];
#pragma unroll
    for (int i = 0; i < 2; ++i) { int R, C; stage_rc(tid * 16 + i * 8192, R, C); const int Rb = Epi::PERM ? ((R & ~31) + perm32(R & 31)) : R;
        voffA[i] = (unsigned)(R * K + C) * 2u; voffB[i] = (unsigned)(Rb * K + C) * 2u; }
    const size_t kstep = (size_t)(BK * 2);
    const size_t hstep = (size_t)HALF * K * 2;
    const size_t tstep = 2 * hstep;
    const unsigned ldsw = (unsigned)wid * 1024u;
    const int aoff = lds_byte(wr * 64 + fr, fq * 8), boff = lds_byte(wc * 32 + fr, fq * 8);
#define PG8_SA(b, h) (((b) * 2 + (h)) * HTB)
#define PG8_SB(b, h) ((4 + (b) * 2 + (h)) * HTB)
#define PG8_STAGE(bufoff, gbase, voff) do { _Pragma("unroll") for (int _i = 0; _i < 2; ++_i) \
        __builtin_amdgcn_global_load_lds((const unsigned*)((const char*)(gbase) + (voff)[_i]), (PG8_LAS unsigned*)(lds + (bufoff) + ldsw + _i * 8192), 16, 0, 0); } while (0)
#define PG8_LDA(dst, b, h) do { _Pragma("unroll") for (int m = 0; m < 4; ++m) _Pragma("unroll") for (int k = 0; k < 2; ++k) dst[m][k] = *(const PG8_LAS bf16x8*)(lds + PG8_SA(b, h) + aoff + m * 2048 + k * 1024); } while (0)
#define PG8_LDB(dst, b, h) do { _Pragma("unroll") for (int n = 0; n < 2; ++n) _Pragma("unroll") for (int k = 0; k < 2; ++k) dst[n][k] = *(const PG8_LAS bf16x8*)(lds + PG8_SB(b, h) + boff + n * 2048 + k * 1024); } while (0)
#define PG8_MMA(ai, bj, At, Bt) do { __builtin_amdgcn_s_setprio(1); _Pragma("unroll") for (int m = 0; m < 4; ++m) _Pragma("unroll") for (int n = 0; n < 2; ++n) _Pragma("unroll") for (int k = 0; k < 2; ++k) \
        acc[ai][bj][m][n] = __builtin_amdgcn_mfma_f32_16x16x32_bf16(Bt[n][k], At[m][k], acc[ai][bj][m][n], 0, 0, 0); __builtin_amdgcn_s_setprio(0); } while (0)
#define PG8_WAIT_V(n) asm volatile("s_waitcnt vmcnt(" #n ")" ::: "memory")
#define PG8_WAIT_L(n) asm volatile("s_waitcnt lgkmcnt(" #n ")" ::: "memory")
#define PG8_BAR __builtin_amdgcn_s_barrier()
#define PG8_SCHED __builtin_amdgcn_sched_barrier(0)
    Unit cur, nxt; int ui = 0;
    if (!S.next(0, cur)) return;
    f32x4 acc[2][2][4][2];
#pragma unroll
    for (int a = 0; a < 2; ++a)
#pragma unroll
        for (int b = 0; b < 2; ++b)
#pragma unroll
            for (int m = 0; m < 4; ++m)
#pragma unroll
                for (int n = 0; n < 2; ++n) acc[a][b][m][n] = (f32x4){0.f, 0.f, 0.f, 0.f};
    bf16x8 At[4][2], B0[2][2], B1[2][2];
    const char* cA = (const char*)g.A + (size_t)cur.pm * tstep; const char* cB = (const char*)g.Bt + (size_t)cur.pn * tstep;
    S.a_ready(cur);
    if constexpr (SP2) {
        PG8_STAGE(PG8_SB(0, 0), cB, voffB); PG8_STAGE(PG8_SB(0, 1), cB + hstep, voffB); PG8_STAGE(PG8_SA(0, 0), cA, voffA); PG8_STAGE(PG8_SA(0, 1), cA + hstep, voffA);
        if (wr == 1) PG8_BAR;
        PG8_WAIT_V(2); PG8_BAR;
        PG8_STAGE(PG8_SB(1, 0), cB + kstep, voffB); PG8_STAGE(PG8_SA(1, 0), cA + kstep, voffA); PG8_STAGE(PG8_SB(1, 1), cB + hstep + kstep, voffB);
        PG8_WAIT_V(6); PG8_BAR;
    } else {
        PG8_STAGE(PG8_SB(0, 0), cB, voffB); PG8_STAGE(PG8_SA(0, 0), cA, voffA); PG8_STAGE(PG8_SB(0, 1), cB + hstep, voffB); PG8_STAGE(PG8_SA(0, 1), cA + hstep, voffA);
        if (wr == 1) PG8_BAR;
        PG8_WAIT_V(4); PG8_BAR;
        PG8_STAGE(PG8_SB(1, 0), cB + kstep, voffB); PG8_STAGE(PG8_SA(1, 0), cA + kstep, voffA); PG8_STAGE(PG8_SB(1, 1), cB + hstep + kstep, voffB);
        PG8_WAIT_V(6); PG8_BAR;
    }
    for (;;) {
        const bool has_next = S.next(ui + 1, nxt);
        const char* nA = has_next ? (const char*)g.A + (size_t)nxt.pm * tstep : cA; const char* nB = has_next ? (const char*)g.Bt + (size_t)nxt.pn * tstep : cB;
        for (int t = 0; t < nt; t += 2) {
            const bool last = (t == nt - 2);
            const char* a1 = cA + (size_t)(t + 1) * kstep;
            const char* a2 = last ? nA : cA + (size_t)(t + 2) * kstep; const char* b2 = last ? nB : cB + (size_t)(t + 2) * kstep;
            const char* a3 = a2 + kstep; const char* b3 = b2 + kstep;
            if (last && has_next) S.a_ready(nxt);
            if constexpr (SP2) {
            PG8_LDB(B0, 0, 0); PG8_LDB(B1, 0, 1); PG8_SCHED; PG8_LDA(At, 0, 0); PG8_STAGE(PG8_SA(1, 1), a1 + hstep, voffA);
            PG8_WAIT_V(8); PG8_WAIT_L(0); PG8_BAR; PG8_MMA(0, 0, At, B0); PG8_MMA(0, 1, At, B1); PG8_BAR; PG8_SCHED;
            PG8_LDA(At, 0, 1); PG8_STAGE(PG8_SB(0, 0), b2, voffB); PG8_STAGE(PG8_SB(0, 1), b2 + hstep, voffB); PG8_STAGE(PG8_SA(0, 0), a2, voffA);
            PG8_WAIT_V(8); PG8_WAIT_L(0); PG8_BAR; PG8_MMA(1, 0, At, B0); PG8_MMA(1, 1, At, B1); PG8_BAR; PG8_SCHED;
            PG8_LDB(B0, 1, 0); PG8_LDB(B1, 1, 1); PG8_SCHED; PG8_LDA(At, 1, 0); PG8_STAGE(PG8_SA(0, 1), a2 + hstep, voffA);
            PG8_WAIT_V(8); PG8_WAIT_L(0); PG8_BAR; PG8_MMA(0, 0, At, B0); PG8_MMA(0, 1, At, B1); PG8_BAR; PG8_SCHED;
            PG8_LDA(At, 1, 1); PG8_STAGE(PG8_SB(1, 0), b3, voffB); PG8_STAGE(PG8_SB(1, 1), b3 + hstep, voffB); PG8_STAGE(PG8_SA(1, 0), a3, voffA);
            PG8_WAIT_V(8); PG8_WAIT_L(0); PG8_BAR; PG8_MMA(1, 0, At, B0); PG8_MMA(1, 1, At, B1); PG8_BAR; PG8_SCHED;
            } else {
            PG8_LDB(B0, 0, 0); PG8_SCHED; PG8_LDA(At, 0, 0); PG8_STAGE(PG8_SA(1, 1), a1 + hstep, voffA);
            PG8_WAIT_L(8); PG8_BAR; PG8_WAIT_L(0); PG8_MMA(0, 0, At, B0); PG8_BAR; PG8_SCHED;
            PG8_LDB(B1, 0, 1); PG8_STAGE(PG8_SB(0, 0), b2, voffB);
            PG8_BAR; PG8_WAIT_L(0); PG8_MMA(0, 1, At, B1); PG8_BAR;
            PG8_LDA(At, 0, 1); PG8_STAGE(PG8_SA(0, 0), a2, voffA);
            PG8_BAR; PG8_WAIT_L(0); PG8_MMA(1, 0, At, B0); PG8_BAR; PG8_SCHED;
            PG8_STAGE(PG8_SB(0, 1), b2 + hstep, voffB);
            PG8_WAIT_V(6); PG8_BAR; PG8_MMA(1, 1, At, B1); PG8_BAR;
            PG8_LDB(B0, 1, 0); PG8_SCHED; PG8_LDA(At, 1, 0); PG8_STAGE(PG8_SA(0, 1), a2 + hstep, voffA);
            PG8_WAIT_L(8); PG8_BAR; PG8_WAIT_L(0); PG8_MMA(0, 0, At, B0); PG8_BAR; PG8_SCHED;
            PG8_LDB(B1, 1, 1); PG8_STAGE(PG8_SB(1, 0), b3, voffB);
            PG8_BAR; PG8_WAIT_L(0); PG8_MMA(0, 1, At, B1); PG8_BAR;
            PG8_LDA(At, 1, 1); PG8_STAGE(PG8_SA(1, 0), a3, voffA);
            PG8_BAR; PG8_WAIT_L(0); PG8_MMA(1, 0, At, B0); PG8_BAR; PG8_SCHED;
            PG8_STAGE(PG8_SB(1, 1), b3 + hstep, voffB);
            PG8_WAIT_V(6); PG8_BAR; PG8_MMA(1, 1, At, B1); PG8_BAR;
            }
        }
        if constexpr (ALIGN_EPI) { if (wr == 0) PG8_BAR; }
        if constexpr (!Epi::AFTER_DRAIN) { E(acc, cur, wr, wc, fr, fq); S.done(cur); }
        if (!has_next) break;
#pragma unroll
        for (int a = 0; a < 2; ++a)
#pragma unroll
            for (int b = 0; b < 2; ++b)
#pragma unroll
                for (int m = 0; m < 4; ++m)
#pragma unroll
                    for (int n = 0; n < 2; ++n) acc[a][b][m][n] = (f32x4){0.f, 0.f, 0.f, 0.f};
        cur = nxt; cA = nA; cB = nB; ++ui;
        if constexpr (ALIGN_EPI) { if (wr == 1) PG8_BAR; }
    }
    PG8_WAIT_V(0);
    if constexpr (!ALIGN_EPI) { if (wr == 0) PG8_BAR; }
    PG8_BAR;
    if constexpr (Epi::AFTER_DRAIN) { E.fused(acc, cur, wr, wc, fr, fq, lds, wid, lane); S.done(cur); }
#undef PG8_SA
#undef PG8_SB
#undef PG8_STAGE
#undef PG8_LDA
#undef PG8_LDB
#undef PG8_MMA
#undef PG8_WAIT_V
#undef PG8_WAIT_L
#undef PG8_BAR
#undef PG8_SCHED
}
}

constexpr int DM = 1024, NBATCH = 8, SEQ = 4096, NTOK = NBATCH * SEQ, CTXL = 256, NCTX = NBATCH * CTXL, MROWS = NTOK + NCTX;
constexpr int DIN = 2048, NHEAD = 8, HD = 64, GRIDW = 64, NMOD = 6 * DM;
constexpr int NEXP = 16384;
constexpr float EPS = 1e-6f;
constexpr int NWAVES = 8;
constexpr int NPHASE = 8;
#ifndef MK_N_LAUNCHES
#define MK_N_LAUNCHES 1
#endif
constexpr int N_LAUNCHES = MK_N_LAUNCHES;

constexpr size_t MiB = 1u << 20;
constexpr size_t WS_CTL = 0, CTL_ZERO_BYTES = 64 * 1024;
constexpr size_t WS_WIN = 2 * MiB, WS_WOUT = 6 * MiB, WS_WQ = 8 * MiB, WS_KEYS = 12 * MiB, WS_POOLW = 12 * MiB + 512 * 1024, WS_MOD = 13 * MiB;
constexpr size_t WS_U = 14 * MiB, WS_V = 46 * MiB;
constexpr size_t WS_HX = 78 * MiB;
constexpr size_t WS_ZX = 146 * MiB;
constexpr size_t WS_MIX = 282 * MiB;
constexpr size_t WS_EXP = 346 * MiB, WS_GATE = 362 * MiB;
constexpr size_t WS_POOLED = 378 * MiB;
constexpr size_t WS_LISTS = 410 * MiB;
constexpr size_t WS_END = 442 * MiB;
constexpr int CW_BAR = 4096;

constexpr int RING_OFF = 0, RING_BYTES = 131072;
constexpr int LDSCTL_OFF = RING_BYTES, MISC_OFF = LDSCTL_OFF + 320;
constexpr int LDS_BYTES = 147456;

#define GAS __attribute__((address_space(1)))
#define LAS __attribute__((address_space(3)))
#define DI __device__ __forceinline__
typedef unsigned short bf16;
typedef unsigned v4u __attribute__((ext_vector_type(4)));
typedef unsigned v2u __attribute__((ext_vector_type(2)));
typedef float f32x4 __attribute__((ext_vector_type(4)));
typedef GAS unsigned gu32;
#define RLX_AGENT __ATOMIC_RELAXED, __HIP_MEMORY_SCOPE_AGENT
#define LDS_WAIT() asm volatile("s_waitcnt lgkmcnt(0)" ::: "memory")
#define VM_WAIT() asm volatile("s_waitcnt vmcnt(0)" ::: "memory")
DI unsigned f2bf(float f) { unsigned u = __builtin_bit_cast(unsigned, f); return (u + 0x7fffu + ((u >> 16) & 1u)) >> 16; }
DI unsigned pk2(float lo, float hi) { return f2bf(lo) | (f2bf(hi) << 16); }
DI float bflo(unsigned u) { return __uint_as_float(u << 16); }
DI float bfhi(unsigned u) { return __uint_as_float(u & 0xffff0000u); }
DI float wave_sum(float v) {
#pragma unroll
    for (int o = 1; o < 64; o <<= 1) v += __shfl_xor(v, o);
    return v;
}

#define XB_TMO      128
#define XB_XCNT(j)  (256  + 64 * (j))
#define XB_XSUB(j)  (1280 + 64 * (j))
#define XB_XGEN(j)  (2304 + 64 * (j))
#define XB_TOP      3328
#define XB_TOPGEN   3392
#define XCD_BAR_WORDS 3456
#define XB_SPIN_CAP (1u << 18)

__device__ __forceinline__ unsigned xb_ld(unsigned* p)              { return __hip_atomic_load(p, __ATOMIC_RELAXED, __HIP_MEMORY_SCOPE_AGENT); }
__device__ __forceinline__ unsigned xb_add(unsigned* p, unsigned v) { return __hip_atomic_fetch_add(p, v, __ATOMIC_RELAXED, __HIP_MEMORY_SCOPE_AGENT); }
__device__ __forceinline__ unsigned xb_xcc_id() { return (unsigned)__builtin_amdgcn_s_getreg((3 << 11) | 20) & 0xFu; }
#define XB_SPIN(cond, bar) do { unsigned _sp = 0; while (cond) { __builtin_amdgcn_s_sleep(1); \
    if ((++_sp & 255u) == 0u) { if (xb_ld(&(bar)[XB_TMO])) break; if (_sp > XB_SPIN_CAP) { atomicAdd(&(bar)[XB_TMO], 1u); break; } } } } while (0)

struct XcdBarrier {
    unsigned* bar; unsigned x;
    volatile LAS unsigned* st;
};

__device__ __forceinline__ XcdBarrier xcd_barrier_post(unsigned* bar, volatile LAS unsigned* st) {
    XcdBarrier b; b.bar = bar; b.x = xb_xcc_id(); b.st = st;
    if (threadIdx.x == 0) (void)xb_add(&bar[XB_XCNT(b.x)], 1u);
    return b;
}
__device__ __forceinline__ void xcd_barrier_complete(unsigned* bar, unsigned x, unsigned& nloc, unsigned& nx) {
    const unsigned G = gridDim.x * gridDim.y * gridDim.z;
    unsigned sum, cnt, mine, sp = 0u;
    for (;;) {
        sum = 0u; cnt = 0u; mine = 0u;
#pragma unroll
        for (unsigned j = 0; j < 16; ++j) { const unsigned c = xb_ld(&bar[XB_XCNT(j)]); sum += c; cnt += (c > 0u) ? 1u : 0u; mine = (j == x) ? c : mine; }
        if (sum == G) break;
        __builtin_amdgcn_s_sleep(1);
        if ((++sp & 255u) == 0u) { if (xb_ld(&bar[XB_TMO])) break; if (sp > XB_SPIN_CAP) { atomicAdd(&bar[XB_TMO], 1u); break; } }
    }
    nloc = mine > 0u ? mine : 1u; nx = cnt > 0u ? cnt : 1u;
}

__device__ __forceinline__ void xcd_barrier(const XcdBarrier& b) {
    asm volatile("s_waitcnt vmcnt(0)" ::: "memory");
    __syncthreads();
    if (threadIdx.x == 0) {
        unsigned* bar = b.bar;
        __builtin_amdgcn_s_waitcnt(0);
        unsigned nloc = b.st[0], nx = b.st[1];
        if (nloc == 0u) { xcd_barrier_complete(bar, b.x, nloc, nx); b.st[0] = nloc; b.st[1] = nx; }
        const unsigned old = xb_add(&bar[XB_XSUB(b.x)], 1u);
        const unsigned gen = old / nloc;
        if (old + 1u == (gen + 1u) * nloc) {
            __builtin_amdgcn_fence(__ATOMIC_RELEASE, "agent");
            asm volatile("s_waitcnt vmcnt(0)" ::: "memory");
            const unsigned og = xb_add(&bar[XB_TOP], 1u);
            const unsigned tg = og / nx;
            if (og + 1u == (tg + 1u) * nx) xb_add(&bar[XB_TOPGEN], 1u);
            else XB_SPIN(xb_ld(&bar[XB_TOPGEN]) == tg, bar);
            __builtin_amdgcn_fence(__ATOMIC_ACQUIRE, "agent");
            xb_add(&bar[XB_XGEN(b.x)], 1u);
            asm volatile("s_waitcnt vmcnt(0)" ::: "memory");
        } else {
            XB_SPIN(xb_ld(&bar[XB_XGEN(b.x)]) == gen, bar);
            __builtin_amdgcn_fence(__ATOMIC_ACQUIRE, "agent");
            asm volatile("s_waitcnt vmcnt(0)" ::: "memory");
        }
    }
    __syncthreads();
}


__device__ __forceinline__ void p0_transpose_item(const float* W, int K, int N, bf16* WT, int row_off, LAS float* scr, int item, int lane) {
    const int nblk = N / 32, kb = item / nblk, nb = item % nblk, k0 = 64 * kb, n0 = 32 * nb;
#pragma unroll 8
    for (int i = 0; i < 32; ++i) { const int kk = 2 * i + (lane >> 5); scr[kk * 33 + (lane & 31)] = W[(size_t)(k0 + kk) * N + n0 + (lane & 31)]; }
    LDS_WAIT(); asm volatile("" ::: "memory");
    const int c = lane & 7;
#pragma unroll
    for (int j = 0; j < 4; ++j) { const int n = (lane >> 3) + 8 * j; const LAS float* s = scr + (8 * c) * 33 + n;
        v4u o; o.x = pk2(s[0 * 33], s[1 * 33]); o.y = pk2(s[2 * 33], s[3 * 33]); o.z = pk2(s[4 * 33], s[5 * 33]); o.w = pk2(s[6 * 33], s[7 * 33]);
        *(GAS v4u*)(WT + (size_t)(row_off + n0 + n) * K + k0 + 8 * c) = o; }
    LDS_WAIT(); asm volatile("" ::: "memory");
}


struct Frame {
    LAS unsigned char* lds;
    int tid, lane, wave, vcu, G, gw, NGW;
    const float* in[18]; float* out; unsigned char* ws;
};

DI void p0_prologue(Frame& F) {
    const float* c = F.in[1]; const float* c_ctx = F.in[3]; const float* ada_w = F.in[4]; const float* ada_b = F.in[5];
    float* MOD = (float*)(F.ws + WS_MOD);
    LAS float* sl = (LAS float*)(F.lds + 73728);
    for (int i = F.tid; i < 9 * 1024; i += 512) { const int b = i >> 10, k = i & 1023; const float cv = (b < 8) ? c[b * 1024 + k] : c_ctx[k]; sl[i] = cv / (1.f + __expf(-cv)); }
    __syncthreads();
    for (int a = F.gw; a < NMOD / 16; a += F.NGW) {
        const int n = a * 16 + (F.lane & 15), kg = F.lane >> 4;
        float acc[9];
#pragma unroll
        for (int b = 0; b < 9; ++b) acc[b] = 0.f;
        const float* wp = ada_w + (size_t)(kg * 256) * NMOD + n; const LAS float* sp = sl + kg * 256;
#pragma unroll 8
        for (int i = 0; i < 256; ++i) { const float w = wp[(size_t)i * NMOD];
#pragma unroll
            for (int b = 0; b < 9; ++b) acc[b] += sp[b * 1024 + i] * w; }
#pragma unroll
        for (int b = 0; b < 9; ++b) { acc[b] += __shfl_xor(acc[b], 16); acc[b] += __shfl_xor(acc[b], 32); }
        if (kg == 0) { const float bb = ada_b[n];
#pragma unroll
            for (int b = 0; b < 9; ++b) MOD[b * NMOD + n] = acc[b] + bb; }
    }
    LAS float* scr = (LAS float*)(F.lds + F.wave * 9216);
    constexpr int I_IN = (DM / 64) * (DIN / 32), I_OUT = (DM / 64) * (DM / 32), I_Q = (DM / 64) * (2048 / 32), I_P = 4 * 8;
    for (int it = F.gw; it < I_IN + I_OUT + I_Q + I_P; it += F.NGW) {
        int r = it;
        if (r < I_IN) { p0_transpose_item(F.in[7], DM, DIN, (bf16*)(F.ws + WS_WIN), 0, scr, r, F.lane); continue; } r -= I_IN;
        if (r < I_OUT) { p0_transpose_item(F.in[11], DM, DM, (bf16*)(F.ws + WS_WOUT), 0, scr, r, F.lane); continue; } r -= I_OUT;
        if (r < I_Q) { p0_transpose_item(F.in[13], DM, 2048, (bf16*)(F.ws + WS_WQ), 0, scr, r, F.lane); continue; } r -= I_Q;
        { const int g = r >> 3; p0_transpose_item(F.in[8] + g * 16384, 128, 128, (bf16*)(F.ws + WS_POOLW) + g * 16384, 0, scr, r & 7, F.lane); }
    }
    { const float* kf = F.in[14]; bf16* kb = (bf16*)(F.ws + WS_KEYS);
      for (int it = F.gw; it < 262144 / 512; it += F.NGW) { const size_t o = (size_t)it * 512 + F.lane * 8;
          const f32x4 a = *(const f32x4*)(kf + o), b = *(const f32x4*)(kf + o + 4);
          v4u w; w.x = pk2(a.x, a.y); w.y = pk2(a.z, a.w); w.z = pk2(b.x, b.y); w.w = pk2(b.z, b.w); *(v4u*)(kb + o) = w; } }
    for (int it = F.gw; it < 2 * NEXP; it += F.NGW) {
        const float* src = (it < NEXP) ? F.in[15] + (size_t)it * 1024 : F.in[16] + (size_t)(it - NEXP) * 1024;
        bf16* dst = (it < NEXP) ? (bf16*)(F.ws + WS_U) + (size_t)it * 1024 : (bf16*)(F.ws + WS_V) + (size_t)(it - NEXP) * 1024;
#pragma unroll
        for (int p = 0; p < 2; ++p) { const int o = p * 512 + F.lane * 8;
            const f32x4 a = *(const f32x4*)(src + o), b = *(const f32x4*)(src + o + 4);
            v4u w; w.x = pk2(a.x, a.y); w.y = pk2(a.z, a.w); w.z = pk2(b.x, b.y); w.w = pk2(b.z, b.w); *(v4u*)(dst + o) = w; }
    }
}

DI void norm_rows(Frame& F, const float* src_x, const float* src_ctx, int nrows, const float* gain, int shift_off, int scale_off, bf16* dst) {
    const float* MOD = (const float*)(F.ws + WS_MOD);
    for (int m = F.gw; m < nrows; m += F.NGW) {
        const float* xrow; int b;
        if (m < NTOK) { xrow = src_x + (size_t)m * DM; b = m >> 12; } else { xrow = src_ctx + (size_t)(m - NTOK) * DM; b = 8; }
        const f32x4* xr = (const f32x4*)xrow + F.lane;
        f32x4 v[4]; float s = 0.f;
#pragma unroll
        for (int j = 0; j < 4; ++j) { v[j] = xr[64 * j]; s += (v[j].x * v[j].x + v[j].y * v[j].y) + (v[j].z * v[j].z + v[j].w * v[j].w); }
        const float rinv = 1.0f / sqrtf(wave_sum(s) * (1.f / DM) + EPS);
        const f32x4* gp = (const f32x4*)gain + F.lane; const f32x4* shp = (const f32x4*)(MOD + b * NMOD + shift_off) + F.lane; const f32x4* scp = (const f32x4*)(MOD + b * NMOD + scale_off) + F.lane;
        unsigned long long* o8 = (unsigned long long*)(dst + (size_t)m * DM) + F.lane;
#pragma unroll
        for (int j = 0; j < 4; ++j) { const f32x4 g = gp[64 * j], sh = shp[64 * j], sc = scp[64 * j];
            const f32x4 y = (v[j] * rinv) * g * (sc + 1.0f) + sh;
            o8[64 * j] = (unsigned long long)pk2(y.x, y.y) | ((unsigned long long)pk2(y.z, y.w) << 32); }
    }
}

DI void attn_key(const bf16* ZX, int h, int tok, float bias, const float (&q)[64], float (&o)[64], float& m, float& l) {
    const v4u* kp = (const v4u*)(ZX + (size_t)tok * DIN + 1024 + h * 64);
    float acc = 0.f;
#pragma unroll
    for (int cc = 0; cc < 8; ++cc) { const v4u kv = kp[cc];
        acc += q[8 * cc + 0] * bflo(kv.x) + q[8 * cc + 1] * bfhi(kv.x) + q[8 * cc + 2] * bflo(kv.y) + q[8 * cc + 3] * bfhi(kv.y)
             + q[8 * cc + 4] * bflo(kv.z) + q[8 * cc + 5] * bfhi(kv.z) + q[8 * cc + 6] * bflo(kv.w) + q[8 * cc + 7] * bfhi(kv.w); }
    const float s = acc + bias;
    const float mn = fmaxf(m, s), alpha = __expf(m - mn), p = __expf(s - mn);
    l = l * alpha + p; m = mn;
    const v4u* vp = (const v4u*)(ZX + (size_t)tok * DIN + 1536 + h * 64);
#pragma unroll
    for (int cc = 0; cc < 8; ++cc) { const v4u vv = vp[cc];
        o[8 * cc + 0] = o[8 * cc + 0] * alpha + p * bflo(vv.x); o[8 * cc + 1] = o[8 * cc + 1] * alpha + p * bfhi(vv.x); o[8 * cc + 2] = o[8 * cc + 2] * alpha + p * bflo(vv.y); o[8 * cc + 3] = o[8 * cc + 3] * alpha + p * bfhi(vv.y);
        o[8 * cc + 4] = o[8 * cc + 4] * alpha + p * bflo(vv.z); o[8 * cc + 5] = o[8 * cc + 5] * alpha + p * bfhi(vv.z); o[8 * cc + 6] = o[8 * cc + 6] * alpha + p * bflo(vv.w); o[8 * cc + 7] = o[8 * cc + 7] * alpha + p * bfhi(vv.w); }
}
DI void attn_naive(Frame& F) {
    const bf16* ZX = (const bf16*)(F.ws + WS_ZX); bf16* MIX = (bf16*)(F.ws + WS_MIX); const float* rpb = F.in[10];
    for (int unit = F.gw; unit < NBATCH * NHEAD * 64; unit += F.NGW) {
        const int r = unit & 63, h = (unit >> 6) & 7, b = unit >> 9, col = F.lane;
        const int tq = b * SEQ + r * GRIDW + col;
        float q[64], o[64];
        { const v4u* qp = (const v4u*)(ZX + (size_t)tq * DIN + 512 + h * 64);
#pragma unroll
          for (int cc = 0; cc < 8; ++cc) { const v4u qv = qp[cc];
              q[8 * cc + 0] = 0.125f * bflo(qv.x); q[8 * cc + 1] = 0.125f * bfhi(qv.x); q[8 * cc + 2] = 0.125f * bflo(qv.y); q[8 * cc + 3] = 0.125f * bfhi(qv.y);
              q[8 * cc + 4] = 0.125f * bflo(qv.z); q[8 * cc + 5] = 0.125f * bfhi(qv.z); q[8 * cc + 6] = 0.125f * bflo(qv.w); q[8 * cc + 7] = 0.125f * bfhi(qv.w); } }
#pragma unroll
        for (int d = 0; d < 64; ++d) o[d] = 0.f;
        float m = -1e30f, l = 0.f;
#pragma unroll 1
        for (int g = 0; g < CTXL; ++g) attn_key(ZX, h, NTOK + b * CTXL + g, 0.f, q, o, m, l);
        const int r0 = min(max(r - 4, 0), 56), c0 = min(max(col - 8, 0), 48);
#pragma unroll 1
        for (int ij = 0; ij < 128; ++ij) { const int i = ij >> 4, j = ij & 15;
            attn_key(ZX, h, b * SEQ + (r0 + i) * GRIDW + c0 + j, rpb[(h * 15 + (r0 + i - r + 7)) * 31 + (c0 + j - col + 15)], q, o, m, l); }
        const float il = 1.0f / l;
        v4u* op = (v4u*)(MIX + (size_t)tq * DM + 512 + h * 64);
#pragma unroll
        for (int cc = 0; cc < 8; ++cc) { v4u w; w.x = pk2(o[8 * cc] * il, o[8 * cc + 1] * il); w.y = pk2(o[8 * cc + 2] * il, o[8 * cc + 3] * il);
            w.z = pk2(o[8 * cc + 4] * il, o[8 * cc + 5] * il); w.w = pk2(o[8 * cc + 6] * il, o[8 * cc + 7] * il); op[cc] = w; }
    }
}
DI void pool_naive(Frame& F) {
    const bf16* ZX = (const bf16*)(F.ws + WS_ZX); bf16* MIX = (bf16*)(F.ws + WS_MIX); bf16* PO = (bf16*)(F.ws + WS_POOLED);
    const float* pool_w = F.in[8]; const float* pool_scale = F.in[9];
    for (int tile = F.vcu; tile < NTOK / 128; tile += F.G) {
        const int tok0 = tile * 128;
        for (int it = F.tid; it < 128 * 64; it += 512) {
            const int t = tok0 + (it >> 6), ch = (it & 63) * 8, g = ch >> 7, w = 2 << g, s = t & (SEQ - 1), tb = t - s;
            const int lo = max(s - w / 2, 0), hi = min(s + w / 2, SEQ);
            float acc[8];
#pragma unroll
            for (int i = 0; i < 8; ++i) acc[i] = 0.f;
            for (int p = lo; p < hi; ++p) { const v4u v = *(const v4u*)(ZX + (size_t)(tb + p) * DIN + ch);
                acc[0] += bflo(v.x); acc[1] += bfhi(v.x); acc[2] += bflo(v.y); acc[3] += bfhi(v.y); acc[4] += bflo(v.z); acc[5] += bfhi(v.z); acc[6] += bflo(v.w); acc[7] += bfhi(v.w); }
            const float inv = 1.0f / (float)(hi - lo);
            const v4u sv = *(const v4u*)(ZX + (size_t)t * DIN + ch);
            v4u wv; wv.x = pk2(acc[0] * inv - bflo(sv.x), acc[1] * inv - bfhi(sv.x)); wv.y = pk2(acc[2] * inv - bflo(sv.y), acc[3] * inv - bfhi(sv.y));
            wv.z = pk2(acc[4] * inv - bflo(sv.z), acc[5] * inv - bfhi(sv.z)); wv.w = pk2(acc[6] * inv - bflo(sv.w), acc[7] * inv - bfhi(sv.w));
            *(v4u*)(PO + (size_t)t * 512 + ch) = wv;
        }
        VM_WAIT(); __syncthreads();
        for (int it = F.wave; it < 1024; it += 8) {
            const int t = tok0 + (it >> 3), g = (it >> 1) & 3, d = (it & 1) * 64 + F.lane;
            const bf16* pr = PO + (size_t)t * 512 + g * 128; const float* wp = pool_w + g * 16384 + d;
            float acc = 0.f;
            for (int c8 = 0; c8 < 16; ++c8) { const v4u pv = *(const v4u*)(pr + c8 * 8); const float* w8 = wp + c8 * 8 * 128;
                acc += bflo(pv.x) * w8[0] + bfhi(pv.x) * w8[128] + bflo(pv.y) * w8[256] + bfhi(pv.y) * w8[384] + bflo(pv.z) * w8[512] + bfhi(pv.z) * w8[640] + bflo(pv.w) * w8[768] + bfhi(pv.w) * w8[896]; }
            MIX[(size_t)t * DM + g * 128 + d] = (bf16)f2bf(acc * pool_scale[g * 128 + d]);
        }
        __syncthreads();
    }
}

DI void peer_topk_naive(Frame& F, int tok0) {
    const bf16* Q = (const bf16*)(F.ws + WS_ZX); const float* keys = F.in[14]; float* LISTS = (float*)(F.ws + WS_LISTS);
    int* EXPERTS = (int*)(F.ws + WS_EXP); float* GATES = (float*)(F.ws + WS_GATE);
    for (int it = F.wave; it < 32; it += 8) {
        const int hp = it & 15, t = tok0 + (it >> 4) * 64 + F.lane;
        float q[128];
        { const v4u* qp = (const v4u*)(Q + (size_t)t * 2048 + hp * 128);
#pragma unroll
          for (int cc = 0; cc < 16; ++cc) { const v4u qv = qp[cc];
              q[8 * cc + 0] = bflo(qv.x); q[8 * cc + 1] = bfhi(qv.x); q[8 * cc + 2] = bflo(qv.y); q[8 * cc + 3] = bfhi(qv.y);
              q[8 * cc + 4] = bflo(qv.z); q[8 * cc + 5] = bfhi(qv.z); q[8 * cc + 6] = bflo(qv.w); q[8 * cc + 7] = bfhi(qv.w); } }
        float top[16];
#pragma unroll
        for (int i = 0; i < 16; ++i) top[i] = -INFINITY;
        const float* kb = keys + (size_t)hp * 16384;
        for (int n = 0; n < 128; ++n) {
            const f32x4* kr = (const f32x4*)(kb + n * 128);
            float acc = 0.f;
#pragma unroll
            for (int cc = 0; cc < 32; ++cc) { const f32x4 kv = kr[cc]; acc += q[4 * cc] * kv.x + q[4 * cc + 1] * kv.y + q[4 * cc + 2] * kv.z + q[4 * cc + 3] * kv.w; }
            float v = __uint_as_float((__float_as_uint(acc) & ~127u) | (unsigned)n);
#pragma unroll
            for (int i = 0; i < 16; ++i) { const float hi = fmaxf(top[i], v); v = fminf(top[i], v); top[i] = hi; }
        }
        f32x4* lp = (f32x4*)(LISTS + ((size_t)t * 16 + hp) * 16);
#pragma unroll
        for (int i = 0; i < 4; ++i) lp[i] = (f32x4){top[4 * i], top[4 * i + 1], top[4 * i + 2], top[4 * i + 3]};
    }
    VM_WAIT(); __syncthreads();
    for (int it = F.tid; it < 128 * 8; it += 512) {
        const int t = tok0 + (it >> 3), h = it & 7;
        float v0[16], v1[16]; int i0[16], i1[16];
        const f32x4* l0 = (const f32x4*)(LISTS + ((size_t)t * 16 + h * 2) * 16);
#pragma unroll
        for (int i = 0; i < 4; ++i) { const f32x4 a = l0[i], b = l0[4 + i];
#pragma unroll
            for (int e = 0; e < 4; ++e) { const unsigned ua = __float_as_uint(a[e]), ub = __float_as_uint(b[e]);
                v0[4 * i + e] = __uint_as_float(ua & ~127u); i0[4 * i + e] = (int)(ua & 127u); v1[4 * i + e] = __uint_as_float(ub & ~127u); i1[4 * i + e] = (int)(ub & 127u); } }
        float tv[16]; int ti[16];
#pragma unroll
        for (int i = 0; i < 16; ++i) { tv[i] = -INFINITY; ti[i] = 0; }
#pragma unroll
        for (int i = 0; i < 16; ++i)
#pragma unroll
            for (int j = 0; j < 16; ++j) if ((i + 1) * (j + 1) <= 16) {
                float cv = v0[i] + v1[j]; int ci = i0[i] * 128 + i1[j];
#pragma unroll
                for (int k = 0; k < 16; ++k) { const bool gt = cv > tv[k]; const float nv = gt ? cv : tv[k]; const int ni = gt ? ci : ti[k]; cv = gt ? tv[k] : cv; ci = gt ? ti[k] : ci; tv[k] = nv; ti[k] = ni; }
            }
        float e[16], sum = 0.f;
#pragma unroll
        for (int k = 0; k < 16; ++k) { e[k] = __expf(tv[k] - tv[0]); sum += e[k]; }
        const float is = 1.0f / sum;
        int* ep = EXPERTS + (size_t)t * 128 + h * 16; float* gp = GATES + (size_t)t * 128 + h * 16;
#pragma unroll
        for (int k = 0; k < 16; ++k) { ep[k] = ti[k]; gp[k] = e[k] * is; }
    }
    VM_WAIT(); __syncthreads();
}

DI float gelu_exact(float a) { return 0.5f * a * (1.0f + erff(a * 0.70710678118654752f)); }

DI void peer_gather_token(Frame& F, int t) {
    const bf16* H2 = (const bf16*)(F.ws + WS_HX); const bf16* U = (const bf16*)(F.ws + WS_U); const bf16* V = (const bf16*)(F.ws + WS_V);
    const int* EXPERTS = (const int*)(F.ws + WS_EXP); const float* GATES = (const float*)(F.ws + WS_GATE); const float* MOD = (const float*)(F.ws + WS_MOD);
    const int lane = F.lane;
    float hs[16];
    { const v4u a = *((const v4u*)(H2 + (size_t)t * DM) + lane), b = *((const v4u*)(H2 + (size_t)t * DM) + 64 + lane);
      hs[0] = bflo(a.x); hs[1] = bfhi(a.x); hs[2] = bflo(a.y); hs[3] = bfhi(a.y); hs[4] = bflo(a.z); hs[5] = bfhi(a.z); hs[6] = bflo(a.w); hs[7] = bfhi(a.w);
      hs[8] = bflo(b.x); hs[9] = bfhi(b.x); hs[10] = bflo(b.y); hs[11] = bfhi(b.y); hs[12] = bflo(b.z); hs[13] = bfhi(b.z); hs[14] = bflo(b.w); hs[15] = bfhi(b.w); }
    const int ev0 = EXPERTS[(size_t)t * 128 + lane], ev1 = EXPERTS[(size_t)t * 128 + 64 + lane];
    float out[16];
#pragma unroll
    for (int i = 0; i < 16; ++i) out[i] = 0.f;
    for (int bt = 0; bt < 16; ++bt) {
        const int evs = (bt < 8) ? ev0 : ev1;
        v4u ur[8][2], vr[8][2];
#pragma unroll
        for (int r = 0; r < 8; ++r) { const int e = __builtin_amdgcn_readlane(evs, (bt & 7) * 8 + r);
            const v4u* up = (const v4u*)(U + (size_t)e * DM); ur[r][0] = up[lane]; ur[r][1] = up[64 + lane];
            const v4u* vp = (const v4u*)(V + (size_t)e * DM); vr[r][0] = vp[lane]; vr[r][1] = vp[64 + lane]; }
        float p[8];
#pragma unroll
        for (int r = 0; r < 8; ++r) { const v4u a = ur[r][0], b = ur[r][1];
            p[r] = (hs[0] * bflo(a.x) + hs[1] * bfhi(a.x) + hs[2] * bflo(a.y) + hs[3] * bfhi(a.y)) + (hs[4] * bflo(a.z) + hs[5] * bfhi(a.z) + hs[6] * bflo(a.w) + hs[7] * bfhi(a.w))
                 + (hs[8] * bflo(b.x) + hs[9] * bfhi(b.x) + hs[10] * bflo(b.y) + hs[11] * bfhi(b.y)) + (hs[12] * bflo(b.z) + hs[13] * bfhi(b.z) + hs[14] * bflo(b.w) + hs[15] * bfhi(b.w)); }
        { const bool h5 = (lane & 32) != 0;
#pragma unroll
          for (int i = 0; i < 4; ++i) { const float send = h5 ? p[i] : p[i + 4], keep = h5 ? p[i + 4] : p[i]; p[i] = keep + __shfl_xor(send, 32); }
          const bool h4 = (lane & 16) != 0;
#pragma unroll
          for (int i = 0; i < 2; ++i) { const float send = h4 ? p[i] : p[i + 2], keep = h4 ? p[i + 2] : p[i]; p[i] = keep + __shfl_xor(send, 16); }
          const bool h3 = (lane & 8) != 0;
          { const float send = h3 ? p[0] : p[1], keep = h3 ? p[1] : p[0]; p[0] = keep + __shfl_xor(send, 8); }
          p[0] += __shfl_xor(p[0], 4); p[0] += __shfl_xor(p[0], 2); p[0] += __shfl_xor(p[0], 1); }
        const float gk = GATES[(size_t)t * 128 + bt * 8 + ((lane >> 3) & 7)];
        const float w = gk * gelu_exact(p[0]);
#pragma unroll
        for (int r = 0; r < 8; ++r) { const float wr = __builtin_bit_cast(float, __builtin_amdgcn_readlane(__builtin_bit_cast(int, w), r * 8)); const v4u a = vr[r][0], b = vr[r][1];
            out[0] += wr * bflo(a.x); out[1] += wr * bfhi(a.x); out[2] += wr * bflo(a.y); out[3] += wr * bfhi(a.y); out[4] += wr * bflo(a.z); out[5] += wr * bfhi(a.z); out[6] += wr * bflo(a.w); out[7] += wr * bfhi(a.w);
            out[8] += wr * bflo(b.x); out[9] += wr * bfhi(b.x); out[10] += wr * bflo(b.y); out[11] += wr * bfhi(b.y); out[12] += wr * bflo(b.z); out[13] += wr * bfhi(b.z); out[14] += wr * bflo(b.w); out[15] += wr * bfhi(b.w); }
    }
    const int b = t >> 12; const float* g2 = MOD + b * NMOD + 5 * DM; const float* fg = F.in[17]; float* xo = F.out + (size_t)t * DM;
    float x2[16]; float ss = 0.f;
#pragma unroll
    for (int gq = 0; gq < 2; ++gq)
#pragma unroll
        for (int hq = 0; hq < 2; ++hq) { const int c = gq * 512 + lane * 8 + hq * 4; const f32x4 xv = *(const f32x4*)(xo + c), gv = *(const f32x4*)(g2 + c);
#pragma unroll
            for (int e = 0; e < 4; ++e) { const float y = xv[e] + gv[e] * out[gq * 8 + hq * 4 + e]; x2[gq * 8 + hq * 4 + e] = y; ss += y * y; } }
    const float rinv = 1.0f / sqrtf(wave_sum(ss) * (1.f / DM) + EPS);
#pragma unroll
    for (int gq = 0; gq < 2; ++gq)
#pragma unroll
        for (int hq = 0; hq < 2; ++hq) { const int c = gq * 512 + lane * 8 + hq * 4; const f32x4 fv = *(const f32x4*)(fg + c);
            f32x4 y;
#pragma unroll
            for (int e = 0; e < 4; ++e) y[e] = x2[gq * 8 + hq * 4 + e] * rinv * fv[e];
            *(f32x4*)(xo + c) = y; }
}

struct Args { const float* in[18]; float* out; unsigned char* ws; int ph_lo, ph_hi, li, pad; };
__global__ void __launch_bounds__(NWAVES * 64, 2) mk_fwd(Args args) {
    extern __shared__ __attribute__((aligned(16))) unsigned char lds[];
    Frame F;
    F.lds = (LAS unsigned char*)lds;
    F.tid = threadIdx.x; F.lane = F.tid & 63; F.wave = __builtin_amdgcn_readfirstlane(F.tid >> 6);
    F.G = gridDim.x; { const int bx = blockIdx.x; F.vcu = (F.G % 8 == 0) ? (bx % 8) * (F.G / 8) + bx / 8 : bx; }
    F.gw = F.vcu * NWAVES + F.wave; F.NGW = F.G * NWAVES;
#pragma unroll
    for (int i = 0; i < 18; ++i) F.in[i] = args.in[i];
    F.out = args.out; F.ws = args.ws;
    volatile LAS unsigned* MISC = (volatile LAS unsigned*)(F.lds + MISC_OFF);
    for (int u = F.tid; u < (LDS_BYTES - LDSCTL_OFF) / 4; u += NWAVES * 64) ((LAS unsigned*)(F.lds + LDSCTL_OFF))[u] = 0u;
    __syncthreads();
    gu32* ctl = (gu32*)(F.ws + WS_CTL);
    XcdBarrier bar; bar.bar = (unsigned*)(ctl + CW_BAR) + args.li * XCD_BAR_WORDS; bar.x = 0; bar.st = nullptr;
    const int lo = args.ph_lo, hi = args.ph_hi;
    if (hi - lo > 1) bar = xcd_barrier_post((unsigned*)(ctl + CW_BAR) + args.li * XCD_BAR_WORDS, MISC + 8);
#define IN(k) (lo <= (k) && (k) < hi)
#define SEAM(k) do { if (IN(k) && IN((k) + 1)) xcd_barrier(bar); } while (0)

#ifndef SKIP0
    if (IN(0)) { p0_prologue(F); SEAM(0); }
#endif
    if (IN(1)) { norm_rows(F, F.in[0], F.in[2], MROWS, F.in[6], 0, DM, (bf16*)(F.ws + WS_HX)); SEAM(1); }
    if (IN(2)) {
        pg8::Gemm g{(const bf16*)(F.ws + WS_HX), (const bf16*)(F.ws + WS_WIN), MROWS, DIN, DM}; pg8::StaticOrder S; S.init(MROWS, DIN, F.G, (int)blockIdx.x);
        pg8::EpiBf16 E{(bf16*)(F.ws + WS_ZX), DIN};
        pg8::gemm_phase<pg8::EpiBf16, pg8::StaticOrder, true, true>(F.lds + RING_OFF, g, S, E);
        SEAM(2);
    }
    if (IN(3)) {
#ifndef SKIP3A
 attn_naive(F);
#endif
#ifndef SKIP3B
 pool_naive(F);
#endif
 SEAM(3); }
    if (IN(4)) {
        pg8::Gemm g{(const bf16*)(F.ws + WS_MIX), (const bf16*)(F.ws + WS_WOUT), NTOK, DM, DM}; pg8::StaticOrder S; S.init(NTOK, DM, F.G, (int)blockIdx.x);
        pg8::EpiX1 E{F.in[0], (const float*)(F.ws + WS_MOD), F.out};
        pg8::gemm_phase<pg8::EpiX1, pg8::StaticOrder, true, true>(F.lds + RING_OFF, g, S, E);
        SEAM(4);
    }
    if (IN(5)) { norm_rows(F, F.out, F.out, NTOK, F.in[12], 3 * DM, 4 * DM, (bf16*)(F.ws + WS_HX)); SEAM(5); }
    if (IN(6)) {
        pg8::Gemm g{(const bf16*)(F.ws + WS_HX), (const bf16*)(F.ws + WS_WQ), NTOK, 2048, DM}; pg8::StaticOrder S; S.init(NTOK, 2048, F.G, (int)blockIdx.x);
        pg8::EpiBf16 E{(bf16*)(F.ws + WS_ZX), 2048};
        pg8::gemm_phase<pg8::EpiBf16, pg8::StaticOrder, true, true>(F.lds + RING_OFF, g, S, E);
        SEAM(6);
    }
    if (IN(7)) {
        for (int tile = F.vcu; tile < NTOK / 128; tile += F.G) {
            const int tok0 = tile * 128;
#ifndef SKIP7A
            peer_topk_naive(F, tok0);
#endif
#ifndef SKIP7B
            for (int i = F.wave; i < 128; i += 8) peer_gather_token(F, tok0 + i);
#endif
        }
    }
#undef IN
#undef SEAM
}

extern "C" void kernel_launch(void* const* d_in, const int* in_sizes, int n_in, void* d_out, int out_size, void* d_ws, size_t ws_size, hipStream_t stream) {
    static int grid = 0;
    if (grid == 0) {
        if (n_in != 18 || in_sizes[0] != NTOK * DM || out_size != NTOK * DM || ws_size < WS_END) { fprintf(stderr, "kernel_launch: unexpected shapes / workspace (n_in %d, ws %zu); nothing launched\n", n_in, ws_size); grid = -1; return; }
        int dev = 0, cus = 0;
        if (hipGetDevice(&dev) != hipSuccess || hipDeviceGetAttribute(&cus, hipDeviceAttributeMultiprocessorCount, dev) != hipSuccess) { grid = -1; return; }
        if (hipFuncSetAttribute((const void*)mk_fwd, hipFuncAttributeMaxDynamicSharedMemorySize, LDS_BYTES) != hipSuccess) { fprintf(stderr, "kernel_launch: hipFuncSetAttribute failed\n"); grid = -1; return; }
        int per_cu = 0;
        if (hipOccupancyMaxActiveBlocksPerMultiprocessor(&per_cu, (const void*)mk_fwd, NWAVES * 64, LDS_BYTES) != hipSuccess || per_cu < 1) fprintf(stderr, "kernel_launch: note: occupancy query reports %d blocks per CU\n", per_cu);
        (void)hipGetLastError();
        grid = cus;
    }
    if (grid < 0) return;
    (void)hipMemsetAsync((char*)d_ws + WS_CTL, 0, CTL_ZERO_BYTES, stream);
    Args a{};
    for (int i = 0; i < 18; ++i) a.in[i] = (const float*)d_in[i];
    a.out = (float*)d_out; a.ws = (unsigned char*)d_ws;
    for (int li = 0; li < N_LAUNCHES; ++li) {
        if (N_LAUNCHES == 1) { a.ph_lo = 0; a.ph_hi = NPHASE; } else { a.ph_lo = li; a.ph_hi = li + 1; }
        a.li = (N_LAUNCHES == 1) ? 0 : 0;
        hipLaunchKernelGGL(mk_fwd, dim3(grid), dim3(NWAVES * 64), LDS_BYTES, stream, a);
    }
}
```

```cpp
#include <hip/hip_runtime.h>
#include <cstdio>
#include <cstdint>
namespace pg8 {
#define PG8_LAS __attribute__((address_space(3)))
typedef unsigned short bf16_t;
typedef short bf16x8 __attribute__((ext_vector_type(8)));
typedef float f32x4 __attribute__((ext_vector_type(4)));
typedef unsigned u32x4 __attribute__((ext_vector_type(4)));
constexpr int BM = 256, BK = 64, HALF = 128, HTB = HALF * BK * 2  , STAGE_BYTES = 8 * HTB, NXCD = 8, WGM = 8;

__host__ __device__ __forceinline__ int lds_byte(int r, int c) { const int st = (r >> 4) * 2 + (c >> 5), rr = r & 15, cc = c & 31, ob = rr * 64 + cc * 2; return st * 1024 + (ob ^ (((ob >> 9) & 1) << 5)); }
__host__ __device__ __forceinline__ void stage_rc(int b, int& R, int& C) { const int st = b / 1024, sb = b % 1024, swz = sb ^ (((sb >> 9) & 1) << 5); R = (st >> 1) * 16 + swz / 64; C = (st & 1) * 32 + (swz % 64) / 2; }
__host__ __device__ __forceinline__ int perm32(int rho) { const int n = rho >> 4, i = rho & 15; return 8 * (i >> 2) + 4 * n + (i & 3); }

struct Unit { int pm, pn; };
struct Gemm { const bf16_t* A; const bf16_t* Bt; int M, N, K; };
struct StaticOrder {
    int nM, nN, nwg, G, c;
    __host__ __device__ void init(int M, int N, int G_, int c_) { nM = M / BM; nN = N / BM; nwg = nM * nN; G = G_; c = c_; }
    __host__ __device__ bool next(int i, Unit& u) const {
        const long L = (long)i * G + c; if (L >= nwg) return false;
        int wgid = (int)L; { const int q = nwg / NXCD, r = nwg % NXCD, xcd = wgid % NXCD, off = wgid / NXCD; wgid = (xcd < r ? xcd * (q + 1) : r * (q + 1) + (xcd - r) * q) + off; }
        const int nig = WGM * nN, gid = wgid / nig, fm = gid * WGM, gsz = (nM - fm) < WGM ? (nM - fm) : WGM;
        u.pm = fm + ((wgid % nig) % gsz); u.pn = (wgid % nig) / gsz; return true;
    }
    __device__ __forceinline__ void a_ready(const Unit&) const {}
    __device__ __forceinline__ void done(const Unit&) const {}
    __device__ __forceinline__ const char* pa(const Gemm& g, const Unit& u) const { return (const char*)g.A + (size_t)u.pm * ((size_t)BM * g.K * 2); }
    __device__ __forceinline__ const char* pb(const Gemm& g, const Unit& u) const { return (const char*)g.Bt + (size_t)u.pn * ((size_t)BM * g.K * 2); }
};
struct InProjOrder {
    StaticOrder so;
    __host__ __device__ void init(int G_, int c_) { so.init(136 * BM, 8 * BM, G_, c_); }
    __host__ __device__ bool next(int i, Unit& u) const { int cnt = -1; for (int j = 0; ; ++j) { if (!so.next(j, u)) return false; if (!(u.pm >= 128 && u.pn < 4)) { if (++cnt == i) return true; } } }
    __device__ __forceinline__ void a_ready(const Unit&) const {}
    __device__ __forceinline__ void done(const Unit&) const {}
    __device__ __forceinline__ const char* pa(const Gemm& g, const Unit& u) const { return u.pn < 6 ? (const char*)g.A + (size_t)u.pm * ((size_t)BM * g.K * 2) : (const char*)g.Bt + (size_t)u.pn * ((size_t)BM * g.K * 2); }
    __device__ __forceinline__ const char* pb(const Gemm& g, const Unit& u) const { return u.pn < 6 ? (const char*)g.Bt + (size_t)u.pn * ((size_t)BM * g.K * 2) : (const char*)g.A + (size_t)u.pm * ((size_t)BM * g.K * 2); }
};

__device__ __forceinline__ unsigned cvt_pk_bf16(float lo, float hi) { unsigned r; asm volatile("v_cvt_pk_bf16_f32 %0, %1, %2" : "=v"(r) : "v"(lo), "v"(hi)); return r; }
struct EpiBf16 {
    static constexpr bool PERM = true, AFTER_DRAIN = false;
    bf16_t* O; int ldc;
    __device__ __forceinline__ void operator()(const f32x4 (&acc)[2][2][4][2], const Unit& u, int wr, int wc, int fr, int fq) const {
        const int row0 = u.pm * BM + wr * 64 + fr, col0 = u.pn * BM + wc * 32 + 8 * fq;
#pragma unroll
        for (int ai = 0; ai < 2; ++ai)
#pragma unroll
            for (int m = 0; m < 4; ++m) { bf16_t* rowp = O + (size_t)(row0 + ai * HALF + m * 16) * ldc + col0;
#pragma unroll
                for (int bj = 0; bj < 2; ++bj) { const f32x4 v0 = acc[ai][bj][m][0], v1 = acc[ai][bj][m][1];
                    u32x4 w; w.x = cvt_pk_bf16(v0[0], v0[1]); w.y = cvt_pk_bf16(v0[2], v0[3]); w.z = cvt_pk_bf16(v1[0], v1[1]); w.w = cvt_pk_bf16(v1[2], v1[3]);
                    *(u32x4*)(rowp + bj * HALF) = w; } }
    }
};
struct EpiX1 {
    static constexpr bool PERM = true, AFTER_DRAIN = false;
    const float* x; const float* mod; float* out;
    __device__ __forceinline__ void operator()(const f32x4 (&acc)[2][2][4][2], const Unit& u, int wr, int wc, int fr, int fq) const {
        const int row0 = u.pm * BM + wr * 64 + fr, col0 = u.pn * BM + wc * 32 + 8 * fq;
        const float* g1 = mod + (size_t)((u.pm * BM) >> 12) * 6144 + 2048 + col0;
        f32x4 gv[2][2];
#pragma unroll
        for (int bj = 0; bj < 2; ++bj)
#pragma unroll
            for (int n = 0; n < 2; ++n) gv[bj][n] = *(const f32x4*)(g1 + bj * HALF + 4 * n);
#pragma unroll
        for (int ai = 0; ai < 2; ++ai)
#pragma unroll
            for (int m = 0; m < 4; ++m) { const size_t off = (size_t)(row0 + ai * HALF + m * 16) * 1024 + col0;
#pragma unroll
                for (int bj = 0; bj < 2; ++bj)
#pragma unroll
                    for (int n = 0; n < 2; ++n) { const f32x4 xv = *(const f32x4*)(x + off + bj * HALF + 4 * n);
                        *(f32x4*)(out + off + bj * HALF + 4 * n) = xv + gv[bj][n] * acc[ai][bj][m][n]; } }
    }
};

struct EpiInProj {
    static constexpr bool PERM = true, AFTER_DRAIN = false;
    bf16_t *PB, *QF, *KF, *VF;
    __device__ __forceinline__ void operator()(const f32x4 (&acc)[2][2][4][2], const Unit& u, int wr, int wc, int fr, int fq) const {
        if (u.pn < 6) {
            const int sec = u.pn >> 1, cbase = (u.pn & 1) * 256 + wc * 32 + 8 * fq;
#pragma unroll
            for (int ai = 0; ai < 2; ++ai)
#pragma unroll
                for (int m = 0; m < 4; ++m) { const int T = u.pm * BM + ai * HALF + wr * 64 + m * 16 + fr;
                    int bb, blk; if (T < 32768) { bb = T >> 12; blk = (T & 4095) >> 5; } else { const int cc = T - 32768; bb = cc >> 8; blk = 128 + ((cc & 255) >> 5); }
                    const int tl = T & 31;
#pragma unroll
                    for (int bj = 0; bj < 2; ++bj) { const int c = cbase + HALF * bj; const f32x4 v0 = acc[ai][bj][m][0], v1 = acc[ai][bj][m][1];
                        u32x4 w; w.x = cvt_pk_bf16(v0[0], v0[1]); w.y = cvt_pk_bf16(v0[2], v0[3]); w.z = cvt_pk_bf16(v1[0], v1[1]); w.w = cvt_pk_bf16(v1[2], v1[3]);
                        if (sec == 0) *(u32x4*)(PB + (size_t)T * 512 + c) = w;
                        else { const int h = c >> 6, d0 = c & 63, fo = ((d0 >> 4) * 64 + ((d0 >> 3) & 1) * 32 + tl) * 8;
                            bf16_t* dst = (sec == 1) ? QF + (size_t)((bb * 8 + h) * 128 + blk) * 2048 + fo : KF + (size_t)((bb * 8 + h) * 136 + blk) * 2048 + fo;
                            *(u32x4*)dst = w; } } }
        } else {
            typedef unsigned u32x2 __attribute__((ext_vector_type(2)));
#pragma unroll
            for (int ai = 0; ai < 2; ++ai)
#pragma unroll
                for (int m = 0; m < 4; ++m) { const int vc = (u.pn - 6) * BM + ai * HALF + wr * 64 + m * 16 + fr, h = vc >> 6, dt = (vc >> 5) & 1, dl = vc & 31;
#pragma unroll
                    for (int bj = 0; bj < 2; ++bj) { const int T0 = u.pm * BM + bj * HALF + wc * 32 + 8 * fq;
                        int bb, blk; if (T0 < 32768) { bb = T0 >> 12; blk = (T0 & 4095) >> 5; } else { const int cc = T0 - 32768; bb = cc >> 8; blk = 128 + ((cc & 255) >> 5); }
                        bf16_t* base = VF + ((size_t)(((bb * 8 + h) * 136 + blk) * 2 + dt) * 2 + (fq >> 1)) * 512 + 4 * (fq & 1);
                        const f32x4 v0 = acc[ai][bj][m][0], v1 = acc[ai][bj][m][1];
                        u32x2 w0, w1; w0.x = cvt_pk_bf16(v0[0], v0[1]); w0.y = cvt_pk_bf16(v0[2], v0[3]); w1.x = cvt_pk_bf16(v1[0], v1[1]); w1.y = cvt_pk_bf16(v1[2], v1[3]);
                        *(u32x2*)(base + dl * 8) = w0; *(u32x2*)(base + (32 + dl) * 8) = w1; } }
        }
    }
};
template <class Epi, class Sched, bool ALIGN_EPI = false, bool SP2 = false>
__device__ __forceinline__ void gemm_phase(PG8_LAS unsigned char* lds, const Gemm g, const Sched& S, const Epi& E) {
    const int tid = threadIdx.x, wid = __builtin_amdgcn_readfirstlane(tid >> 6), lane = tid & 63, wr = wid >> 2, wc = wid & 3, fr = lane & 15, fq = lane >> 4;
    const int K = g.K, nt = K / BK;
    unsigned voffA[2], voffB[2];
#pragma unroll
    for (int i = 0; i < 2; ++i) { int R, C; stage_rc(tid * 16 + i * 8192, R, C); const int Rb = Epi::PERM ? ((R & ~31) + perm32(R & 31)) : R;
        voffA[i] = (unsigned)(R * K + C) * 2u; voffB[i] = (unsigned)(Rb * K + C) * 2u; }
    const size_t kstep = (size_t)(BK * 2);
    const size_t hstep = (size_t)HALF * K * 2;
    const size_t tstep = 2 * hstep;
    const unsigned ldsw = (unsigned)wid * 1024u;
    const int aoff = lds_byte(wr * 64 + fr, fq * 8), boff = lds_byte(wc * 32 + fr, fq * 8);
#define PG8_SA(b, h) (((b) * 2 + (h)) * HTB)
#define PG8_SB(b, h) ((4 + (b) * 2 + (h)) * HTB)
#define PG8_STAGE(bufoff, gbase, voff) do { _Pragma("unroll") for (int _i = 0; _i < 2; ++_i) \
        __builtin_amdgcn_global_load_lds((const unsigned*)((const char*)(gbase) + (voff)[_i]), (PG8_LAS unsigned*)(lds + (bufoff) + ldsw + _i * 8192), 16, 0, 0); } while (0)
#define PG8_LDA(dst, b, h) do { _Pragma("unroll") for (int m = 0; m < 4; ++m) _Pragma("unroll") for (int k = 0; k < 2; ++k) dst[m][k] = *(const PG8_LAS bf16x8*)(lds + PG8_SA(b, h) + aoff + m * 2048 + k * 1024); } while (0)
#define PG8_LDB(dst, b, h) do { _Pragma("unroll") for (int n = 0; n < 2; ++n) _Pragma("unroll") for (int k = 0; k < 2; ++k) dst[n][k] = *(const PG8_LAS bf16x8*)(lds + PG8_SB(b, h) + boff + n * 2048 + k * 1024); } while (0)
#define PG8_MMA(ai, bj, At, Bt) do { __builtin_amdgcn_s_setprio(1); _Pragma("unroll") for (int m = 0; m < 4; ++m) _Pragma("unroll") for (int n = 0; n < 2; ++n) _Pragma("unroll") for (int k = 0; k < 2; ++k) \
        acc[ai][bj][m][n] = __builtin_amdgcn_mfma_f32_16x16x32_bf16(Bt[n][k], At[m][k], acc[ai][bj][m][n], 0, 0, 0); __builtin_amdgcn_s_setprio(0); } while (0)
#define PG8_WAIT_V(n) asm volatile("s_waitcnt vmcnt(" #n ")" ::: "memory")
#define PG8_WAIT_L(n) asm volatile("s_waitcnt lgkmcnt(" #n ")" ::: "memory")
#define PG8_BAR __builtin_amdgcn_s_barrier()
#define PG8_SCHED __builtin_amdgcn_sched_barrier(0)
    Unit cur, nxt; int ui = 0;
    if (!S.next(0, cur)) return;
    f32x4 acc[2][2][4][2];
#pragma unroll
    for (int a = 0; a < 2; ++a)
#pragma unroll
        for (int b = 0; b < 2; ++b)
#pragma unroll
            for (int m = 0; m < 4; ++m)
#pragma unroll
                for (int n = 0; n < 2; ++n) acc[a][b][m][n] = (f32x4){0.f, 0.f, 0.f, 0.f};
    bf16x8 At[4][2], B0[2][2], B1[2][2];
    const char* cA = S.pa(g, cur); const char* cB = S.pb(g, cur);
    S.a_ready(cur);
    if constexpr (SP2) {
        PG8_STAGE(PG8_SB(0, 0), cB, voffB); PG8_STAGE(PG8_SB(0, 1), cB + hstep, voffB); PG8_STAGE(PG8_SA(0, 0), cA, voffA); PG8_STAGE(PG8_SA(0, 1), cA + hstep, voffA);
        if (wr == 1) PG8_BAR;
        PG8_WAIT_V(2); PG8_BAR;
        PG8_STAGE(PG8_SB(1, 0), cB + kstep, voffB); PG8_STAGE(PG8_SA(1, 0), cA + kstep, voffA); PG8_STAGE(PG8_SB(1, 1), cB + hstep + kstep, voffB);
        PG8_WAIT_V(6); PG8_BAR;
    } else {
        PG8_STAGE(PG8_SB(0, 0), cB, voffB); PG8_STAGE(PG8_SA(0, 0), cA, voffA); PG8_STAGE(PG8_SB(0, 1), cB + hstep, voffB); PG8_STAGE(PG8_SA(0, 1), cA + hstep, voffA);
        if (wr == 1) PG8_BAR;
        PG8_WAIT_V(4); PG8_BAR;
        PG8_STAGE(PG8_SB(1, 0), cB + kstep, voffB); PG8_STAGE(PG8_SA(1, 0), cA + kstep, voffA); PG8_STAGE(PG8_SB(1, 1), cB + hstep + kstep, voffB);
        PG8_WAIT_V(6); PG8_BAR;
    }
    for (;;) {
        const bool has_next = S.next(ui + 1, nxt);
        const char* nA = has_next ? S.pa(g, nxt) : cA; const char* nB = has_next ? S.pb(g, nxt) : cB;
        for (int t = 0; t < nt; t += 2) {
            const bool last = (t == nt - 2);
            const char* a1 = cA + (size_t)(t + 1) * kstep;
            const char* a2 = last ? nA : cA + (size_t)(t + 2) * kstep; const char* b2 = last ? nB : cB + (size_t)(t + 2) * kstep;
            const char* a3 = a2 + kstep; const char* b3 = b2 + kstep;
            if (last && has_next) S.a_ready(nxt);
            if constexpr (SP2) {
            PG8_LDB(B0, 0, 0); PG8_LDB(B1, 0, 1); PG8_SCHED; PG8_LDA(At, 0, 0); PG8_STAGE(PG8_SA(1, 1), a1 + hstep, voffA);
            PG8_WAIT_V(8); PG8_WAIT_L(0); PG8_BAR; PG8_MMA(0, 0, At, B0); PG8_MMA(0, 1, At, B1); PG8_BAR; PG8_SCHED;
            PG8_LDA(At, 0, 1); PG8_STAGE(PG8_SB(0, 0), b2, voffB); PG8_STAGE(PG8_SB(0, 1), b2 + hstep, voffB); PG8_STAGE(PG8_SA(0, 0), a2, voffA);
            PG8_WAIT_V(8); PG8_WAIT_L(0); PG8_BAR; PG8_MMA(1, 0, At, B0); PG8_MMA(1, 1, At, B1); PG8_BAR; PG8_SCHED;
            PG8_LDB(B0, 1, 0); PG8_LDB(B1, 1, 1); PG8_SCHED; PG8_LDA(At, 1, 0); PG8_STAGE(PG8_SA(0, 1), a2 + hstep, voffA);
            PG8_WAIT_V(8); PG8_WAIT_L(0); PG8_BAR; PG8_MMA(0, 0, At, B0); PG8_MMA(0, 1, At, B1); PG8_BAR; PG8_SCHED;
            PG8_LDA(At, 1, 1); PG8_STAGE(PG8_SB(1, 0), b3, voffB); PG8_STAGE(PG8_SB(1, 1), b3 + hstep, voffB); PG8_STAGE(PG8_SA(1, 0), a3, voffA);
            PG8_WAIT_V(8); PG8_WAIT_L(0); PG8_BAR; PG8_MMA(1, 0, At, B0); PG8_MMA(1, 1, At, B1); PG8_BAR; PG8_SCHED;
            } else {
            PG8_LDB(B0, 0, 0); PG8_SCHED; PG8_LDA(At, 0, 0); PG8_STAGE(PG8_SA(1, 1), a1 + hstep, voffA);
            PG8_WAIT_L(8); PG8_BAR; PG8_WAIT_L(0); PG8_MMA(0, 0, At, B0); PG8_BAR; PG8_SCHED;
            PG8_LDB(B1, 0, 1); PG8_STAGE(PG8_SB(0, 0), b2, voffB);
            PG8_BAR; PG8_WAIT_L(0); PG8_MMA(0, 1, At, B1); PG8_BAR;
            PG8_LDA(At, 0, 1); PG8_STAGE(PG8_SA(0, 0), a2, voffA);
            PG8_BAR; PG8_WAIT_L(0); PG8_MMA(1, 0, At, B0); PG8_BAR; PG8_SCHED;
            PG8_STAGE(PG8_SB(0, 1), b2 + hstep, voffB);
            PG8_WAIT_V(6); PG8_BAR; PG8_MMA(1, 1, At, B1); PG8_BAR;
            PG8_LDB(B0, 1, 0); PG8_SCHED; PG8_LDA(At, 1, 0); PG8_STAGE(PG8_SA(0, 1), a2 + hstep, voffA);
            PG8_WAIT_L(8); PG8_BAR; PG8_WAIT_L(0); PG8_MMA(0, 0, At, B0); PG8_BAR; PG8_SCHED;
            PG8_LDB(B1, 1, 1); PG8_STAGE(PG8_SB(1, 0), b3, voffB);
            PG8_BAR; PG8_WAIT_L(0); PG8_MMA(0, 1, At, B1); PG8_BAR;
            PG8_LDA(At, 1, 1); PG8_STAGE(PG8_SA(1, 0), a3, voffA);
            PG8_BAR; PG8_WAIT_L(0); PG8_MMA(1, 0, At, B0); PG8_BAR; PG8_SCHED;
            PG8_STAGE(PG8_SB(1, 1), b3 + hstep, voffB);
            PG8_WAIT_V(6); PG8_BAR; PG8_MMA(1, 1, At, B1); PG8_BAR;
            }
        }
        if constexpr (ALIGN_EPI) { if (wr == 0) PG8_BAR; }
        if constexpr (!Epi::AFTER_DRAIN) { E(acc, cur, wr, wc, fr, fq); S.done(cur); }
        if (!has_next) break;
#pragma unroll
        for (int a = 0; a < 2; ++a)
#pragma unroll
            for (int b = 0; b < 2; ++b)
#pragma unroll
                for (int m = 0; m < 4; ++m)
#pragma unroll
                    for (int n = 0; n < 2; ++n) acc[a][b][m][n] = (f32x4){0.f, 0.f, 0.f, 0.f};
        cur = nxt; cA = nA; cB = nB; ++ui;
        if constexpr (ALIGN_EPI) { if (wr == 1) PG8_BAR; }
    }
    PG8_WAIT_V(0);
    if constexpr (!ALIGN_EPI) { if (wr == 0) PG8_BAR; }
    PG8_BAR;
    if constexpr (Epi::AFTER_DRAIN) { E.fused(acc, cur, wr, wc, fr, fq, lds, wid, lane); S.done(cur); }
#undef PG8_SA
#undef PG8_SB
#undef PG8_STAGE
#undef PG8_LDA
#undef PG8_LDB
#undef PG8_MMA
#undef PG8_WAIT_V
#undef PG8_WAIT_L
#undef PG8_BAR
#undef PG8_SCHED
}
}

constexpr int DM = 1024, NBATCH = 8, SEQ = 4096, NTOK = NBATCH * SEQ, CTXL = 256, NCTX = NBATCH * CTXL, MROWS = NTOK + NCTX;
constexpr int DIN = 2048, NHEAD = 8, HD = 64, GRIDW = 64, NMOD = 6 * DM;
constexpr int NEXP = 16384;
constexpr float EPS = 1e-6f;
constexpr int NWAVES = 8;
constexpr int NPHASE = 8;
constexpr float U_SCALE = 64.f, V_SCALE = 4.f;
#ifndef MK_N_LAUNCHES
#define MK_N_LAUNCHES 1
#endif
constexpr int N_LAUNCHES = MK_N_LAUNCHES;

constexpr size_t MiB = 1u << 20;
constexpr size_t WS_CTL = 0, CTL_ZERO_BYTES = 64 * 1024;
constexpr size_t WS_WIN = 2 * MiB, WS_WOUT = 6 * MiB, WS_WQ = 8 * MiB, WS_KEYS = 12 * MiB, WS_POOLW = 12 * MiB + 512 * 1024, WS_MOD = 13 * MiB;
constexpr size_t WS_U = 14 * MiB, WS_V = 46 * MiB;
constexpr size_t WS_HX = 78 * MiB;
constexpr size_t WS_ZX = 146 * MiB;
constexpr size_t WS_PB = 146 * MiB, WS_QF = 178 * MiB, WS_KF = 210 * MiB, WS_VF = 244 * MiB;
constexpr size_t WS_MIX = 282 * MiB;
constexpr size_t WS_EXP = 346 * MiB, WS_GATE = 362 * MiB;
constexpr size_t WS_POOLED = 378 * MiB;
constexpr size_t WS_LISTS = 410 * MiB;
constexpr size_t WS_END = 442 * MiB;
constexpr int CW_BAR = 4096;

constexpr int RING_OFF = 0, RING_BYTES = 131072;
constexpr int LDSCTL_OFF = RING_BYTES, MISC_OFF = LDSCTL_OFF + 320;
constexpr int LDS_BYTES = 147456;

#define GAS __attribute__((address_space(1)))
#define LAS __attribute__((address_space(3)))
#define DI __device__ __forceinline__
typedef unsigned short bf16;
typedef unsigned v4u __attribute__((ext_vector_type(4)));
typedef unsigned v2u __attribute__((ext_vector_type(2)));
typedef float f32x4 __attribute__((ext_vector_type(4)));
typedef float f32x2 __attribute__((ext_vector_type(2)));
typedef GAS unsigned gu32;
#define RLX_AGENT __ATOMIC_RELAXED, __HIP_MEMORY_SCOPE_AGENT
#define LDS_WAIT() asm volatile("s_waitcnt lgkmcnt(0)" ::: "memory")
#define VM_WAIT() asm volatile("s_waitcnt vmcnt(0)" ::: "memory")
DI unsigned f2bf(float f) { unsigned u = __builtin_bit_cast(unsigned, f); return (u + 0x7fffu + ((u >> 16) & 1u)) >> 16; }
DI unsigned pk2(float lo, float hi) { return f2bf(lo) | (f2bf(hi) << 16); }
DI float bflo(unsigned u) { return __uint_as_float(u << 16); }
DI float bfhi(unsigned u) { return __uint_as_float(u & 0xffff0000u); }
DI float wave_sum(float v) {
#pragma unroll
    for (int o = 1; o < 64; o <<= 1) v += __shfl_xor(v, o);
    return v;
}

#define XB_TMO      128
#define XB_XCNT(j)  (256  + 64 * (j))
#define XB_XSUB(j)  (1280 + 64 * (j))
#define XB_XGEN(j)  (2304 + 64 * (j))
#define XB_TOP      3328
#define XB_TOPGEN   3392
#define XCD_BAR_WORDS 3456
#define XB_SPIN_CAP (1u << 18)

__device__ __forceinline__ unsigned xb_ld(unsigned* p)              { return __hip_atomic_load(p, __ATOMIC_RELAXED, __HIP_MEMORY_SCOPE_AGENT); }
__device__ __forceinline__ unsigned xb_add(unsigned* p, unsigned v) { return __hip_atomic_fetch_add(p, v, __ATOMIC_RELAXED, __HIP_MEMORY_SCOPE_AGENT); }
__device__ __forceinline__ unsigned xb_xcc_id() { return (unsigned)__builtin_amdgcn_s_getreg((3 << 11) | 20) & 0xFu; }
#define XB_SPIN(cond, bar) do { unsigned _sp = 0; while (cond) { __builtin_amdgcn_s_sleep(1); \
    if ((++_sp & 255u) == 0u) { if (xb_ld(&(bar)[XB_TMO])) break; if (_sp > XB_SPIN_CAP) { atomicAdd(&(bar)[XB_TMO], 1u); break; } } } } while (0)

struct XcdBarrier {
    unsigned* bar; unsigned x;
    volatile LAS unsigned* st;
};

__device__ __forceinline__ XcdBarrier xcd_barrier_post(unsigned* bar, volatile LAS unsigned* st) {
    XcdBarrier b; b.bar = bar; b.x = xb_xcc_id(); b.st = st;
    if (threadIdx.x == 0) (void)xb_add(&bar[XB_XCNT(b.x)], 1u);
    return b;
}
__device__ __forceinline__ void xcd_barrier_complete(unsigned* bar, unsigned x, unsigned& nloc, unsigned& nx) {
    const unsigned G = gridDim.x * gridDim.y * gridDim.z;
    unsigned sum, cnt, mine, sp = 0u;
    for (;;) {
        sum = 0u; cnt = 0u; mine = 0u;
#pragma unroll
        for (unsigned j = 0; j < 16; ++j) { const unsigned c = xb_ld(&bar[XB_XCNT(j)]); sum += c; cnt += (c > 0u) ? 1u : 0u; mine = (j == x) ? c : mine; }
        if (sum == G) break;
        __builtin_amdgcn_s_sleep(1);
        if ((++sp & 255u) == 0u) { if (xb_ld(&bar[XB_TMO])) break; if (sp > XB_SPIN_CAP) { atomicAdd(&bar[XB_TMO], 1u); break; } }
    }
    nloc = mine > 0u ? mine : 1u; nx = cnt > 0u ? cnt : 1u;
}

__device__ __forceinline__ void xcd_barrier(const XcdBarrier& b) {
    asm volatile("s_waitcnt vmcnt(0)" ::: "memory");
    __syncthreads();
    if (threadIdx.x == 0) {
        unsigned* bar = b.bar;
        __builtin_amdgcn_s_waitcnt(0);
        unsigned nloc = b.st[0], nx = b.st[1];
        if (nloc == 0u) { xcd_barrier_complete(bar, b.x, nloc, nx); b.st[0] = nloc; b.st[1] = nx; }
        const unsigned old = xb_add(&bar[XB_XSUB(b.x)], 1u);
        const unsigned gen = old / nloc;
        if (old + 1u == (gen + 1u) * nloc) {
            __builtin_amdgcn_fence(__ATOMIC_RELEASE, "agent");
            asm volatile("s_waitcnt vmcnt(0)" ::: "memory");
            const unsigned og = xb_add(&bar[XB_TOP], 1u);
            const unsigned tg = og / nx;
            if (og + 1u == (tg + 1u) * nx) xb_add(&bar[XB_TOPGEN], 1u);
            else XB_SPIN(xb_ld(&bar[XB_TOPGEN]) == tg, bar);
            __builtin_amdgcn_fence(__ATOMIC_ACQUIRE, "agent");
            xb_add(&bar[XB_XGEN(b.x)], 1u);
            asm volatile("s_waitcnt vmcnt(0)" ::: "memory");
        } else {
            XB_SPIN(xb_ld(&bar[XB_XGEN(b.x)]) == gen, bar);
            __builtin_amdgcn_fence(__ATOMIC_ACQUIRE, "agent");
            asm volatile("s_waitcnt vmcnt(0)" ::: "memory");
        }
    }
    __syncthreads();
}


__device__ __forceinline__ void p0_transpose_item(const float* W, int K, int N, bf16* WT, int row_off, LAS float* scr, int item, int lane) {
    const int nblk = N / 32, kb = item / nblk, nb = item % nblk, k0 = 64 * kb, n0 = 32 * nb;
#pragma unroll 8
    for (int i = 0; i < 32; ++i) { const int kk = 2 * i + (lane >> 5); scr[kk * 33 + (lane & 31)] = W[(size_t)(k0 + kk) * N + n0 + (lane & 31)]; }
    LDS_WAIT(); asm volatile("" ::: "memory");
    const int c = lane & 7;
#pragma unroll
    for (int j = 0; j < 4; ++j) { const int n = (lane >> 3) + 8 * j; const LAS float* s = scr + (8 * c) * 33 + n;
        v4u o; o.x = pk2(s[0 * 33], s[1 * 33]); o.y = pk2(s[2 * 33], s[3 * 33]); o.z = pk2(s[4 * 33], s[5 * 33]); o.w = pk2(s[6 * 33], s[7 * 33]);
        *(GAS v4u*)(WT + (size_t)(row_off + n0 + n) * K + k0 + 8 * c) = o; }
    LDS_WAIT(); asm volatile("" ::: "memory");
}


struct Frame {
    LAS unsigned char* lds;
    int tid, lane, wave, vcu, G, gw, NGW;
    const float* in[18]; float* out; unsigned char* ws;
};

DI void p0_prologue(Frame& F) {
    const float* c = F.in[1]; const float* c_ctx = F.in[3]; const float* ada_w = F.in[4]; const float* ada_b = F.in[5];
    float* MOD = (float*)(F.ws + WS_MOD);
    LAS float* sl = (LAS float*)(F.lds + 73728);
    for (int i = F.tid; i < 9 * 1024; i += 512) { const int b = i >> 10, k = i & 1023; const float cv = (b < 8) ? c[b * 1024 + k] : c_ctx[k]; sl[i] = cv / (1.f + __expf(-cv)); }
    __syncthreads();
    for (int a = F.gw; a < NMOD / 16; a += F.NGW) {
        const int n = a * 16 + (F.lane & 15), kg = F.lane >> 4;
        float acc[9];
#pragma unroll
        for (int b = 0; b < 9; ++b) acc[b] = 0.f;
        const float* wp = ada_w + (size_t)(kg * 256) * NMOD + n; const LAS float* sp = sl + kg * 256;
#pragma unroll 8
        for (int i = 0; i < 256; ++i) { const float w = wp[(size_t)i * NMOD];
#pragma unroll
            for (int b = 0; b < 9; ++b) acc[b] += sp[b * 1024 + i] * w; }
#pragma unroll
        for (int b = 0; b < 9; ++b) { acc[b] += __shfl_xor(acc[b], 16); acc[b] += __shfl_xor(acc[b], 32); }
        if (kg == 0) { const float bb = ada_b[n];
#pragma unroll
            for (int b = 0; b < 9; ++b) MOD[b * NMOD + n] = acc[b] + bb; }
    }
    LAS float* scr = (LAS float*)(F.lds + F.wave * 9216);
    constexpr int I_IN = (DM / 64) * (DIN / 32), I_OUT = (DM / 64) * (DM / 32), I_Q = (DM / 64) * (2048 / 32), I_P = 4 * 8;
    for (int it = F.gw; it < I_IN + I_OUT + I_Q + I_P; it += F.NGW) {
        int r = it;
        if (r < I_IN) { p0_transpose_item(F.in[7], DM, DIN, (bf16*)(F.ws + WS_WIN), 0, scr, r, F.lane); continue; } r -= I_IN;
        if (r < I_OUT) { p0_transpose_item(F.in[11], DM, DM, (bf16*)(F.ws + WS_WOUT), 0, scr, r, F.lane); continue; } r -= I_OUT;
        if (r < I_Q) { p0_transpose_item(F.in[13], DM, 2048, (bf16*)(F.ws + WS_WQ), 0, scr, r, F.lane); continue; } r -= I_Q;
        { const int g = r >> 3; p0_transpose_item(F.in[8] + g * 16384, 128, 128, (bf16*)(F.ws + WS_POOLW) + g * 16384, 0, scr, r & 7, F.lane); }
    }
    { const float* kf = F.in[14]; bf16* kb = (bf16*)(F.ws + WS_KEYS);
      for (int it = F.gw; it < 262144 / 512; it += F.NGW) { const size_t o = (size_t)it * 512 + F.lane * 8;
          const f32x4 a = *(const f32x4*)(kf + o), b = *(const f32x4*)(kf + o + 4);
          v4u w; w.x = pk2(a.x, a.y); w.y = pk2(a.z, a.w); w.z = pk2(b.x, b.y); w.w = pk2(b.z, b.w); *(v4u*)(kb + o) = w; } }
    for (int it = F.gw; it < 2 * NEXP; it += F.NGW) {
        const bool isu = it < NEXP;
        const float* src = isu ? F.in[15] + (size_t)it * 1024 : F.in[16] + (size_t)(it - NEXP) * 1024;
        unsigned char* dst = isu ? F.ws + WS_U + (size_t)it * 1024 : F.ws + WS_V + (size_t)(it - NEXP) * 1024;
        const float sc = isu ? U_SCALE : V_SCALE;
        const f32x4* sp = (const f32x4*)(src + F.lane * 16);
        v4u w;
#pragma unroll
        for (int j = 0; j < 4; ++j) { const f32x4 a = sp[j] * sc; int pk = 0; pk = __builtin_amdgcn_cvt_pk_fp8_f32(a.x, a.y, pk, false); pk = __builtin_amdgcn_cvt_pk_fp8_f32(a.z, a.w, pk, true); w[j] = (unsigned)pk; }
        *(v4u*)(dst + F.lane * 16) = w;
    }
}

DI void norm_rows(Frame& F, const float* src_x, const float* src_ctx, int nrows, const float* gain, int shift_off, int scale_off, bf16* dst) {
    const float* MOD = (const float*)(F.ws + WS_MOD);
    for (int m = F.gw; m < nrows; m += F.NGW) {
        const float* xrow; int b;
        if (m < NTOK) { xrow = src_x + (size_t)m * DM; b = m >> 12; } else { xrow = src_ctx + (size_t)(m - NTOK) * DM; b = 8; }
        const f32x4* xr = (const f32x4*)xrow + F.lane;
        f32x4 v[4]; float s = 0.f;
#pragma unroll
        for (int j = 0; j < 4; ++j) { v[j] = xr[64 * j]; s += (v[j].x * v[j].x + v[j].y * v[j].y) + (v[j].z * v[j].z + v[j].w * v[j].w); }
        const float rinv = 1.0f / sqrtf(wave_sum(s) * (1.f / DM) + EPS);
        const f32x4* gp = (const f32x4*)gain + F.lane; const f32x4* shp = (const f32x4*)(MOD + b * NMOD + shift_off) + F.lane; const f32x4* scp = (const f32x4*)(MOD + b * NMOD + scale_off) + F.lane;
        unsigned long long* o8 = (unsigned long long*)(dst + (size_t)m * DM) + F.lane;
#pragma unroll
        for (int j = 0; j < 4; ++j) { const f32x4 g = gp[64 * j], sh = shp[64 * j], sc = scp[64 * j];
            const f32x4 y = (v[j] * rinv) * g * (sc + 1.0f) + sh;
            o8[64 * j] = (unsigned long long)pk2(y.x, y.y) | ((unsigned long long)pk2(y.z, y.w) << 32); }
    }
}

DI void attn_key(const bf16* KF, const bf16* VF, int blkbase, int kk, int dt, float bias, const float (&q)[64], float (&o)[32], float& m, float& l) {
    const bf16* kp = KF + (size_t)blkbase * 2048 + kk * 8;
    float acc = 0.f;
#pragma unroll
    for (int cc = 0; cc < 8; ++cc) { const v4u kv = *(const v4u*)(kp + ((cc >> 1) * 64 + (cc & 1) * 32) * 8);
        acc += q[8 * cc + 0] * bflo(kv.x) + q[8 * cc + 1] * bfhi(kv.x) + q[8 * cc + 2] * bflo(kv.y) + q[8 * cc + 3] * bfhi(kv.y)
             + q[8 * cc + 4] * bflo(kv.z) + q[8 * cc + 5] * bfhi(kv.z) + q[8 * cc + 6] * bflo(kv.w) + q[8 * cc + 7] * bfhi(kv.w); }
    const float s = acc + bias;
    const float mn = fmaxf(m, s), alpha = __expf(m - mn), p = __expf(s - mn);
    l = l * alpha + p; m = mn;
    const bf16* vp = VF + (size_t)blkbase * 2048 + dt * 1024 + (kk >> 4) * 512 + (((kk >> 2) & 1) * 32) * 8 + 4 * ((kk >> 3) & 1) + (kk & 3);
#pragma unroll
    for (int d = 0; d < 32; ++d) o[d] = o[d] * alpha + p * __uint_as_float((unsigned)vp[d * 8] << 16);
}
DI void attn_naive(Frame& F) {
    const bf16* QF = (const bf16*)(F.ws + WS_QF); const bf16* KF = (const bf16*)(F.ws + WS_KF); const bf16* VF = (const bf16*)(F.ws + WS_VF);
    bf16* MIX = (bf16*)(F.ws + WS_MIX); const float* rpb = F.in[10];
    for (int unit2 = F.gw; unit2 < 2 * NBATCH * NHEAD * 64; unit2 += F.NGW) {
        const int unit = unit2 >> 1, dt = unit2 & 1;
        const int r = unit & 63, h = (unit >> 6) & 7, b = unit >> 9, col = F.lane;
        const int tq = b * SEQ + r * GRIDW + col;
        float q[64], o[32];
        { const bf16* qp = QF + (size_t)((b * 8 + h) * 128 + 2 * r + (col >> 5)) * 2048 + (col & 31) * 8;
#pragma unroll
          for (int cc = 0; cc < 8; ++cc) { const v4u qv = *(const v4u*)(qp + ((cc >> 1) * 64 + (cc & 1) * 32) * 8);
              q[8 * cc + 0] = 0.125f * bflo(qv.x); q[8 * cc + 1] = 0.125f * bfhi(qv.x); q[8 * cc + 2] = 0.125f * bflo(qv.y); q[8 * cc + 3] = 0.125f * bfhi(qv.y);
              q[8 * cc + 4] = 0.125f * bflo(qv.z); q[8 * cc + 5] = 0.125f * bfhi(qv.z); q[8 * cc + 6] = 0.125f * bflo(qv.w); q[8 * cc + 7] = 0.125f * bfhi(qv.w); } }
#pragma unroll
        for (int d = 0; d < 32; ++d) o[d] = 0.f;
        float m = -1e30f, l = 0.f;
#pragma unroll 1
        for (int g = 0; g < CTXL; ++g) attn_key(KF, VF, (b * 8 + h) * 136 + 128 + (g >> 5), g & 31, dt, 0.f, q, o, m, l);
        const int r0 = min(max(r - 4, 0), 56), c0 = min(max(col - 8, 0), 48);
#pragma unroll 1
        for (int ij = 0; ij < 128; ++ij) { const int i = ij >> 4, j = ij & 15, kc = c0 + j;
            attn_key(KF, VF, (b * 8 + h) * 136 + 2 * (r0 + i) + (kc >> 5), kc & 31, dt, rpb[(h * 15 + (r0 + i - r + 7)) * 31 + (kc - col + 15)], q, o, m, l); }
        const float il = 1.0f / l;
        v4u* op = (v4u*)(MIX + (size_t)tq * DM + 512 + h * 64 + dt * 32);
#pragma unroll
        for (int cc = 0; cc < 4; ++cc) { v4u w; w.x = pk2(o[8 * cc] * il, o[8 * cc + 1] * il); w.y = pk2(o[8 * cc + 2] * il, o[8 * cc + 3] * il);
            w.z = pk2(o[8 * cc + 4] * il, o[8 * cc + 5] * il); w.w = pk2(o[8 * cc + 6] * il, o[8 * cc + 7] * il); op[cc] = w; }
    }
}
typedef float f32x16 __attribute__((ext_vector_type(16)));
typedef short s16x8 __attribute__((ext_vector_type(8)));
typedef __bf16 bf16x2_t __attribute__((ext_vector_type(2)));
#define MFMA32(a, b, c) __builtin_amdgcn_mfma_f32_32x32x16_bf16((a), (b), (c), 0, 0, 0)
DI unsigned cvtpk(float lo, float hi) { f32x2 v = {lo, hi}; bf16x2_t bb = __builtin_convertvector(v, bf16x2_t); return __builtin_bit_cast(unsigned, bb); }
DI float pairmax(float v) { auto rr = __builtin_amdgcn_permlane32_swap(__float_as_uint(v), __float_as_uint(v), false, false); return fmaxf(__uint_as_float(rr[0]), __uint_as_float(rr[1])); }
constexpr float LOG2E = 1.4426950408889634f, ATT_C2 = 0.125f * LOG2E, ATT_THR = 6.0f;
template <int QMASK, bool LOCAL>
DI void attn_tile(const s16x8 (&kf)[4], const s16x8 (&vf)[4], const LAS s16x8* qfp, f32x16 (&o)[2], float& m, float& l, const LAS float* brow, int djb, int lo) {
    f32x16 s; s16x8 qf[4];
#pragma unroll
    for (int ks = 0; ks < 4; ++ks) qf[ks] = qfp[ks * 64];
#pragma unroll
    for (int i = 0; i < 16; ++i) s[i] = 0.f;
#pragma unroll
    for (int ks = 0; ks < 4; ++ks) s = MFMA32(kf[ks], qf[ks], s);
    float sv[16]; float tmax = -INFINITY;
#pragma unroll
    for (int i = 0; i < 16; ++i) {
        if (!((QMASK >> (i >> 2)) & 1)) { sv[i] = -INFINITY; continue; }
        if (LOCAL) { const int dj = djb + (i & 3) + 8 * (i >> 2); const bool valid = (unsigned)(dj - lo) < 16u;
            const float x = s[i] * ATT_C2 + brow[valid ? dj : 0]; sv[i] = valid ? x : -INFINITY; }
        else sv[i] = s[i] * ATT_C2;
        tmax = fmaxf(tmax, sv[i]);
    }
    tmax = pairmax(tmax);
    if (__any(tmax > m + ATT_THR)) { const float mn = fmaxf(m, tmax), alpha = __builtin_amdgcn_exp2f(m - mn); o[0] *= alpha; o[1] *= alpha; l *= alpha; m = mn; }
    float p[16];
#pragma unroll
    for (int i = 0; i < 16; ++i) { if ((QMASK >> (i >> 2)) & 1) { p[i] = __builtin_amdgcn_exp2f(sv[i] - m); l += p[i]; } else p[i] = 0.f; }
#pragma unroll
    for (int s2 = 0; s2 < 2; ++s2) if (QMASK & (3 << (2 * s2))) {
        v4u pk; pk.x = cvtpk(p[8 * s2], p[8 * s2 + 1]); pk.y = cvtpk(p[8 * s2 + 2], p[8 * s2 + 3]); pk.z = cvtpk(p[8 * s2 + 4], p[8 * s2 + 5]); pk.w = cvtpk(p[8 * s2 + 6], p[8 * s2 + 7]);
        const s16x8 pf = __builtin_bit_cast(s16x8, pk);
        o[0] = MFMA32(vf[s2], pf, o[0]); o[1] = MFMA32(vf[2 + s2], pf, o[1]);
    }
}
DI void attn_mfma(Frame& F) {
    const bf16* QF = (const bf16*)(F.ws + WS_QF); const bf16* KF = (const bf16*)(F.ws + WS_KF); const bf16* VF = (const bf16*)(F.ws + WS_VF);
    bf16* MIX = (bf16*)(F.ws + WS_MIX); const float* rpb = F.in[10];
    LAS float* rp = (LAS float*)(F.lds);
    for (int i = F.tid; i < NHEAD * 15 * 31; i += 512) rp[i] = rpb[i] * LOG2E;
    __syncthreads();
    const int lane = F.lane, hh = lane >> 5, ql = lane & 31;
    int lo[2], djb[2][2];
#pragma unroll
    for (int qb = 0; qb < 2; ++qb) { const int qc = 32 * qb + ql, c0 = min(max(qc - 8, 0), 48); lo[qb] = c0 - qc + 15;
#pragma unroll
        for (int jb = 0; jb < 2; ++jb) djb[qb][jb] = 32 * (jb - qb) + 4 * hh - ql + 15; }
    for (int unit = F.gw; unit < NBATCH * NHEAD * 64; unit += F.NGW) {
        const int r = unit & 63, h = (unit >> 6) & 7, b = unit >> 9, bh = b * 8 + h;
        LAS s16x8* qfl = (LAS s16x8*)(F.lds + 16384 + F.wave * 8192) + lane;
#pragma unroll
        for (int qb = 0; qb < 2; ++qb)
#pragma unroll
            for (int ks = 0; ks < 4; ++ks) qfl[(qb * 4 + ks) * 64] = ((const s16x8*)(QF + (size_t)(bh * 128 + 2 * r + qb) * 2048))[ks * 64 + lane];
        f32x16 o[2][2]; float m[2], l[2];
#pragma unroll
        for (int qb = 0; qb < 2; ++qb) { m[qb] = -1e30f; l[qb] = 0.f;
#pragma unroll
            for (int dt = 0; dt < 2; ++dt)
#pragma unroll
                for (int i = 0; i < 16; ++i) o[qb][dt][i] = 0.f; }
        s16x8 kf[4], vf[4];
#pragma unroll 1
        for (int kb = 0; kb < 8; ++kb) {
            const s16x8* kp = (const s16x8*)(KF + (size_t)(bh * 136 + 128 + kb) * 2048) + lane; const s16x8* vp = (const s16x8*)(VF + (size_t)(bh * 136 + 128 + kb) * 2048) + lane;
#pragma unroll
            for (int j = 0; j < 4; ++j) { kf[j] = kp[j * 64]; vf[j] = vp[j * 64]; }
            attn_tile<15, false>(kf, vf, qfl, o[0], m[0], l[0], rp, 0, 0); __builtin_amdgcn_sched_barrier(0);
            attn_tile<15, false>(kf, vf, qfl + 256, o[1], m[1], l[1], rp, 0, 0); __builtin_amdgcn_sched_barrier(0);
        }
        const int r0 = min(max(r - 4, 0), 56);
#pragma unroll 1
        for (int i = 0; i < 8; ++i) {
            const LAS float* brow = rp + (h * 15 + (r0 + i - r + 7)) * 31;
            { const s16x8* kp = (const s16x8*)(KF + (size_t)(bh * 136 + 2 * (r0 + i)) * 2048) + lane; const s16x8* vp = (const s16x8*)(VF + (size_t)(bh * 136 + 2 * (r0 + i)) * 2048) + lane;
#pragma unroll
              for (int j = 0; j < 4; ++j) { kf[j] = kp[j * 64]; vf[j] = vp[j * 64]; } }
            attn_tile<15, true>(kf, vf, qfl, o[0], m[0], l[0], brow, djb[0][0], lo[0]); __builtin_amdgcn_sched_barrier(0);
            attn_tile<8, true>(kf, vf, qfl + 256, o[1], m[1], l[1], brow, djb[1][0], lo[1]); __builtin_amdgcn_sched_barrier(0);
            { const s16x8* kp = (const s16x8*)(KF + (size_t)(bh * 136 + 2 * (r0 + i) + 1) * 2048) + lane; const s16x8* vp = (const s16x8*)(VF + (size_t)(bh * 136 + 2 * (r0 + i) + 1) * 2048) + lane;
#pragma unroll
              for (int j = 0; j < 4; ++j) { kf[j] = kp[j * 64]; vf[j] = vp[j * 64]; } }
            attn_tile<1, true>(kf, vf, qfl, o[0], m[0], l[0], brow, djb[0][1], lo[0]); __builtin_amdgcn_sched_barrier(0);
            attn_tile<15, true>(kf, vf, qfl + 256, o[1], m[1], l[1], brow, djb[1][1], lo[1]); __builtin_amdgcn_sched_barrier(0);
        }
#pragma unroll
        for (int qb = 0; qb < 2; ++qb) {
            const float lt = l[qb] + __shfl_xor(l[qb], 32), inv = 1.0f / lt;
            bf16* orow = MIX + (size_t)(b * SEQ + r * GRIDW + 32 * qb + ql) * DM + 512 + h * 64 + 4 * hh;
#pragma unroll
            for (int dt = 0; dt < 2; ++dt)
#pragma unroll
                for (int g = 0; g < 4; ++g) { v2u w; w.x = pk2(o[qb][dt][4 * g] * inv, o[qb][dt][4 * g + 1] * inv); w.y = pk2(o[qb][dt][4 * g + 2] * inv, o[qb][dt][4 * g + 3] * inv);
                    *(v2u*)(orow + 32 * dt + 8 * g) = w; }
        }
    }
    __syncthreads();
}
DI void pool_naive(Frame& F) {
    const bf16* PBF = (const bf16*)(F.ws + WS_PB); bf16* MIX = (bf16*)(F.ws + WS_MIX); bf16* PO = (bf16*)(F.ws + WS_POOLED);
    const float* pool_w = F.in[8]; const float* pool_scale = F.in[9];
    for (int tile = F.vcu; tile < NTOK / 128; tile += F.G) {
        const int tok0 = tile * 128;
        for (int it = F.tid; it < 128 * 64; it += 512) {
            const int t = tok0 + (it >> 6), ch = (it & 63) * 8, g = ch >> 7, w = 2 << g, s = t & (SEQ - 1), tb = t - s;
            const int lo = max(s - w / 2, 0), hi = min(s + w / 2, SEQ);
            float acc[8];
#pragma unroll
            for (int i = 0; i < 8; ++i) acc[i] = 0.f;
            for (int p = lo; p < hi; ++p) { const v4u v = *(const v4u*)(PBF + (size_t)(tb + p) * 512 + ch);
                acc[0] += bflo(v.x); acc[1] += bfhi(v.x); acc[2] += bflo(v.y); acc[3] += bfhi(v.y); acc[4] += bflo(v.z); acc[5] += bfhi(v.z); acc[6] += bflo(v.w); acc[7] += bfhi(v.w); }
            const float inv = 1.0f / (float)(hi - lo);
            const v4u sv = *(const v4u*)(PBF + (size_t)t * 512 + ch);
            v4u wv; wv.x = pk2(acc[0] * inv - bflo(sv.x), acc[1] * inv - bfhi(sv.x)); wv.y = pk2(acc[2] * inv - bflo(sv.y), acc[3] * inv - bfhi(sv.y));
            wv.z = pk2(acc[4] * inv - bflo(sv.z), acc[5] * inv - bfhi(sv.z)); wv.w = pk2(acc[6] * inv - bflo(sv.w), acc[7] * inv - bfhi(sv.w));
            *(v4u*)(PO + (size_t)t * 512 + ch) = wv;
        }
        VM_WAIT(); __syncthreads();
        for (int it = F.wave; it < 1024; it += 8) {
            const int t = tok0 + (it >> 3), g = (it >> 1) & 3, d = (it & 1) * 64 + F.lane;
            const bf16* pr = PO + (size_t)t * 512 + g * 128; const float* wp = pool_w + g * 16384 + d;
            float acc = 0.f;
            for (int c8 = 0; c8 < 16; ++c8) { const v4u pv = *(const v4u*)(pr + c8 * 8); const float* w8 = wp + c8 * 8 * 128;
                acc += bflo(pv.x) * w8[0] + bfhi(pv.x) * w8[128] + bflo(pv.y) * w8[256] + bfhi(pv.y) * w8[384] + bflo(pv.z) * w8[512] + bfhi(pv.z) * w8[640] + bflo(pv.w) * w8[768] + bfhi(pv.w) * w8[896]; }
            MIX[(size_t)t * DM + g * 128 + d] = (bf16)f2bf(acc * pool_scale[g * 128 + d]);
        }
        __syncthreads();
    }
}

DI void peer_topk_naive(Frame& F, int tok0) {
    const bf16* Q = (const bf16*)(F.ws + WS_ZX); const float* keys = F.in[14]; float* LISTS = (float*)(F.ws + WS_LISTS);
    int* EXPERTS = (int*)(F.ws + WS_EXP); float* GATES = (float*)(F.ws + WS_GATE);
    for (int it = F.wave; it < 32; it += 8) {
        const int hp = it & 15, t = tok0 + (it >> 4) * 64 + F.lane;
        float q[128];
        { const v4u* qp = (const v4u*)(Q + (size_t)t * 2048 + hp * 128);
#pragma unroll
          for (int cc = 0; cc < 16; ++cc) { const v4u qv = qp[cc];
              q[8 * cc + 0] = bflo(qv.x); q[8 * cc + 1] = bfhi(qv.x); q[8 * cc + 2] = bflo(qv.y); q[8 * cc + 3] = bfhi(qv.y);
              q[8 * cc + 4] = bflo(qv.z); q[8 * cc + 5] = bfhi(qv.z); q[8 * cc + 6] = bflo(qv.w); q[8 * cc + 7] = bfhi(qv.w); } }
        float top[16];
#pragma unroll
        for (int i = 0; i < 16; ++i) top[i] = -INFINITY;
        const float* kb = keys + (size_t)hp * 16384;
        for (int n = 0; n < 128; ++n) {
            const f32x4* kr = (const f32x4*)(kb + n * 128);
            float acc = 0.f;
#pragma unroll
            for (int cc = 0; cc < 32; ++cc) { const f32x4 kv = kr[cc]; acc += q[4 * cc] * kv.x + q[4 * cc + 1] * kv.y + q[4 * cc + 2] * kv.z + q[4 * cc + 3] * kv.w; }
            float v = __uint_as_float((__float_as_uint(acc) & ~127u) | (unsigned)n);
#pragma unroll
            for (int i = 0; i < 16; ++i) { const float hi = fmaxf(top[i], v); v = fminf(top[i], v); top[i] = hi; }
        }
        f32x4* lp = (f32x4*)(LISTS + ((size_t)t * 16 + hp) * 16);
#pragma unroll
        for (int i = 0; i < 4; ++i) lp[i] = (f32x4){top[4 * i], top[4 * i + 1], top[4 * i + 2], top[4 * i + 3]};
    }
    VM_WAIT(); __syncthreads();
    for (int it = F.tid; it < 128 * 8; it += 512) {
        const int t = tok0 + (it >> 3), h = it & 7;
        float v0[16], v1[16]; int i0[16], i1[16];
        const f32x4* l0 = (const f32x4*)(LISTS + ((size_t)t * 16 + h * 2) * 16);
#pragma unroll
        for (int i = 0; i < 4; ++i) { const f32x4 a = l0[i], b = l0[4 + i];
#pragma unroll
            for (int e = 0; e < 4; ++e) { const unsigned ua = __float_as_uint(a[e]), ub = __float_as_uint(b[e]);
                v0[4 * i + e] = __uint_as_float(ua & ~127u); i0[4 * i + e] = (int)(ua & 127u); v1[4 * i + e] = __uint_as_float(ub & ~127u); i1[4 * i + e] = (int)(ub & 127u); } }
        float tv[16]; int ti[16];
#pragma unroll
        for (int i = 0; i < 16; ++i) { tv[i] = -INFINITY; ti[i] = 0; }
#pragma unroll
        for (int i = 0; i < 16; ++i)
#pragma unroll
            for (int j = 0; j < 16; ++j) if ((i + 1) * (j + 1) <= 16) {
                float cv = v0[i] + v1[j]; int ci = i0[i] * 128 + i1[j];
#pragma unroll
                for (int k = 0; k < 16; ++k) { const bool gt = cv > tv[k]; const float nv = gt ? cv : tv[k]; const int ni = gt ? ci : ti[k]; cv = gt ? tv[k] : cv; ci = gt ? ti[k] : ci; tv[k] = nv; ti[k] = ni; }
            }
        float e[16], sum = 0.f;
#pragma unroll
        for (int k = 0; k < 16; ++k) { e[k] = __expf(tv[k] - tv[0]); sum += e[k]; }
        const float is = 1.0f / sum;
        int* ep = EXPERTS + (size_t)t * 128 + h * 16; float* gp = GATES + (size_t)t * 128 + h * 16;
#pragma unroll
        for (int k = 0; k < 16; ++k) { ep[k] = ti[k]; gp[k] = e[k] * is; }
    }
    VM_WAIT(); __syncthreads();
}

DI float gelu_exact(float a) { return 0.5f * a * (1.0f + erff(a * 0.70710678118654752f)); }

DI void fp8x16_to_f32(const v4u r, float (&f)[16]) {
#pragma unroll
    for (int j = 0; j < 4; ++j) { const f32x2 lo = __builtin_amdgcn_cvt_pk_f32_fp8((int)r[j], false), hi = __builtin_amdgcn_cvt_pk_f32_fp8((int)r[j], true);
        f[4 * j] = lo.x; f[4 * j + 1] = lo.y; f[4 * j + 2] = hi.x; f[4 * j + 3] = hi.y; }
}
DI void peer_gather_token(Frame& F, int t) {
    const bf16* H2 = (const bf16*)(F.ws + WS_HX); const unsigned char* U = F.ws + WS_U; const unsigned char* V = F.ws + WS_V;
    const int* EXPERTS = (const int*)(F.ws + WS_EXP); const float* GATES = (const float*)(F.ws + WS_GATE); const float* MOD = (const float*)(F.ws + WS_MOD);
    const int lane = F.lane;
    float hs[16];
    { const v4u a = *((const v4u*)(H2 + (size_t)t * DM + lane * 16)), b = *((const v4u*)(H2 + (size_t)t * DM + lane * 16 + 8));
      hs[0] = bflo(a.x); hs[1] = bfhi(a.x); hs[2] = bflo(a.y); hs[3] = bfhi(a.y); hs[4] = bflo(a.z); hs[5] = bfhi(a.z); hs[6] = bflo(a.w); hs[7] = bfhi(a.w);
      hs[8] = bflo(b.x); hs[9] = bfhi(b.x); hs[10] = bflo(b.y); hs[11] = bfhi(b.y); hs[12] = bflo(b.z); hs[13] = bfhi(b.z); hs[14] = bflo(b.w); hs[15] = bfhi(b.w); }
    const int ev0 = EXPERTS[(size_t)t * 128 + lane], ev1 = EXPERTS[(size_t)t * 128 + 64 + lane];
    const float gv0 = GATES[(size_t)t * 128 + lane], gv1 = GATES[(size_t)t * 128 + 64 + lane];
    float out[16];
#pragma unroll
    for (int i = 0; i < 16; ++i) out[i] = 0.f;
    v4u ucur[8];
#pragma unroll
    for (int r = 0; r < 8; ++r) { const int e = __builtin_amdgcn_readlane(ev0, r); ucur[r] = *((const v4u*)(U + (size_t)e * 1024) + lane); }
#pragma unroll 1
    for (int bt = 0; bt < 16; ++bt) {
        const int evs = (bt < 8) ? ev0 : ev1; const float gvs = (bt < 8) ? gv0 : gv1;
        v4u vcur[8];
#pragma unroll
        for (int r = 0; r < 8; ++r) { const int e = __builtin_amdgcn_readlane(evs, (bt & 7) * 8 + r); vcur[r] = *((const v4u*)(V + (size_t)e * 1024) + lane); }
        float p[8];
#pragma unroll
        for (int r = 0; r < 8; ++r) { float f[16]; fp8x16_to_f32(ucur[r], f);
            p[r] = ((hs[0] * f[0] + hs[1] * f[1]) + (hs[2] * f[2] + hs[3] * f[3])) + ((hs[4] * f[4] + hs[5] * f[5]) + (hs[6] * f[6] + hs[7] * f[7]))
                 + ((hs[8] * f[8] + hs[9] * f[9]) + (hs[10] * f[10] + hs[11] * f[11])) + ((hs[12] * f[12] + hs[13] * f[13]) + (hs[14] * f[14] + hs[15] * f[15])); }
        { const int evn = (bt + 1 < 8) ? ev0 : ev1; const int bn = (bt + 1) & 15;
#pragma unroll
          for (int r = 0; r < 8; ++r) { const int e = __builtin_amdgcn_readlane(evn, (bn & 7) * 8 + r); ucur[r] = *((const v4u*)(U + (size_t)e * 1024) + lane); } }
        { const bool h5 = (lane & 32) != 0;
#pragma unroll
          for (int i = 0; i < 4; ++i) { const float send = h5 ? p[i] : p[i + 4], keep = h5 ? p[i + 4] : p[i]; p[i] = keep + __shfl_xor(send, 32); }
          const bool h4 = (lane & 16) != 0;
#pragma unroll
          for (int i = 0; i < 2; ++i) { const float send = h4 ? p[i] : p[i + 2], keep = h4 ? p[i + 2] : p[i]; p[i] = keep + __shfl_xor(send, 16); }
          const bool h3 = (lane & 8) != 0;
          { const float send = h3 ? p[0] : p[1], keep = h3 ? p[1] : p[0]; p[0] = keep + __shfl_xor(send, 8); }
          p[0] += __shfl_xor(p[0], 4); p[0] += __shfl_xor(p[0], 2); p[0] += __shfl_xor(p[0], 1); }
        const float gk = __shfl(gvs, (bt & 7) * 8 + ((lane >> 3) & 7));
        const float w = gk * gelu_exact(p[0] * (1.0f / U_SCALE));
#pragma unroll
        for (int r = 0; r < 8; ++r) { const float wr = __builtin_bit_cast(float, __builtin_amdgcn_readlane(__builtin_bit_cast(int, w), r * 8)); float f[16]; fp8x16_to_f32(vcur[r], f);
#pragma unroll
            for (int i = 0; i < 16; ++i) out[i] += wr * f[i]; }
    }
    const int b = t >> 12; const float* g2 = MOD + b * NMOD + 5 * DM; const float* fg = F.in[17]; float* xo = F.out + (size_t)t * DM;
    float x2[16]; float ss = 0.f;
#pragma unroll
    for (int hq = 0; hq < 4; ++hq) { const int c = lane * 16 + hq * 4; const f32x4 xv = *(const f32x4*)(xo + c), gv = *(const f32x4*)(g2 + c);
#pragma unroll
        for (int e = 0; e < 4; ++e) { const float y = xv[e] + gv[e] * (out[hq * 4 + e] * (1.0f / V_SCALE)); x2[hq * 4 + e] = y; ss += y * y; } }
    const float rinv = 1.0f / sqrtf(wave_sum(ss) * (1.f / DM) + EPS);
#pragma unroll
    for (int hq = 0; hq < 4; ++hq) { const int c = lane * 16 + hq * 4; const f32x4 fv = *(const f32x4*)(fg + c);
        f32x4 y;
#pragma unroll
        for (int e = 0; e < 4; ++e) y[e] = x2[hq * 4 + e] * rinv * fv[e];
        *(f32x4*)(xo + c) = y; }
}

struct Args { const float* in[18]; float* out; unsigned char* ws; int ph_lo, ph_hi, li, pad; };
__global__ void __launch_bounds__(NWAVES * 64, 2) mk_fwd(Args args) {
    extern __shared__ __attribute__((aligned(16))) unsigned char lds[];
    Frame F;
    F.lds = (LAS unsigned char*)lds;
    F.tid = threadIdx.x; F.lane = F.tid & 63; F.wave = __builtin_amdgcn_readfirstlane(F.tid >> 6);
    F.G = gridDim.x; { const int bx = blockIdx.x; F.vcu = (F.G % 8 == 0) ? (bx % 8) * (F.G / 8) + bx / 8 : bx; }
    F.gw = F.vcu * NWAVES + F.wave; F.NGW = F.G * NWAVES;
#pragma unroll
    for (int i = 0; i < 18; ++i) F.in[i] = args.in[i];
    F.out = args.out; F.ws = args.ws;
    volatile LAS unsigned* MISC = (volatile LAS unsigned*)(F.lds + MISC_OFF);
    for (int u = F.tid; u < (LDS_BYTES - LDSCTL_OFF) / 4; u += NWAVES * 64) ((LAS unsigned*)(F.lds + LDSCTL_OFF))[u] = 0u;
    __syncthreads();
    gu32* ctl = (gu32*)(F.ws + WS_CTL);
    XcdBarrier bar; bar.bar = (unsigned*)(ctl + CW_BAR) + args.li * XCD_BAR_WORDS; bar.x = 0; bar.st = nullptr;
    const int lo = args.ph_lo, hi = args.ph_hi;
    if (hi - lo > 1) bar = xcd_barrier_post((unsigned*)(ctl + CW_BAR) + args.li * XCD_BAR_WORDS, MISC + 8);
#define IN(k) (lo <= (k) && (k) < hi)
#define SEAM(k) do { if (IN(k) && IN((k) + 1)) xcd_barrier(bar); } while (0)

#ifndef SKIP0
    if (IN(0)) { p0_prologue(F); SEAM(0); }
#endif
    if (IN(1)) { norm_rows(F, F.in[0], F.in[2], MROWS, F.in[6], 0, DM, (bf16*)(F.ws + WS_HX)); SEAM(1); }
    if (IN(2)) {
        pg8::Gemm g{(const bf16*)(F.ws + WS_HX), (const bf16*)(F.ws + WS_WIN), MROWS, DIN, DM}; pg8::InProjOrder S; S.init(F.G, (int)blockIdx.x);
        pg8::EpiInProj E{(bf16*)(F.ws + WS_PB), (bf16*)(F.ws + WS_QF), (bf16*)(F.ws + WS_KF), (bf16*)(F.ws + WS_VF)};
        pg8::gemm_phase<pg8::EpiInProj, pg8::InProjOrder, true, true>(F.lds + RING_OFF, g, S, E);
        SEAM(2);
    }
    if (IN(3)) {
#ifndef SKIP3A
#ifdef ATT_NAIVE
 attn_naive(F);
#else
 attn_mfma(F);
#endif
#endif
#ifndef SKIP3B
 pool_naive(F);
#endif
 SEAM(3); }
    if (IN(4)) {
        pg8::Gemm g{(const bf16*)(F.ws + WS_MIX), (const bf16*)(F.ws + WS_WOUT), NTOK, DM, DM}; pg8::StaticOrder S; S.init(NTOK, DM, F.G, (int)blockIdx.x);
        pg8::EpiX1 E{F.in[0], (const float*)(F.ws + WS_MOD), F.out};
        pg8::gemm_phase<pg8::EpiX1, pg8::StaticOrder, true, true>(F.lds + RING_OFF, g, S, E);
        SEAM(4);
    }
    if (IN(5)) { norm_rows(F, F.out, F.out, NTOK, F.in[12], 3 * DM, 4 * DM, (bf16*)(F.ws + WS_HX)); SEAM(5); }
    if (IN(6)) {
        pg8::Gemm g{(const bf16*)(F.ws + WS_HX), (const bf16*)(F.ws + WS_WQ), NTOK, 2048, DM}; pg8::StaticOrder S; S.init(NTOK, 2048, F.G, (int)blockIdx.x);
        pg8::EpiBf16 E{(bf16*)(F.ws + WS_ZX), 2048};
        pg8::gemm_phase<pg8::EpiBf16, pg8::StaticOrder, true, true>(F.lds + RING_OFF, g, S, E);
        SEAM(6);
    }
    if (IN(7)) {
        for (int tile = F.vcu; tile < NTOK / 128; tile += F.G) {
            const int tok0 = tile * 128;
#ifndef SKIP7A
            peer_topk_naive(F, tok0);
#endif
#ifndef SKIP7B
            for (int i = F.wave; i < 128; i += 8) peer_gather_token(F, tok0 + i);
#endif
        }
    }
#undef IN
#undef SEAM
}

extern "C" void kernel_launch(void* const* d_in, const int* in_sizes, int n_in, void* d_out, int out_size, void* d_ws, size_t ws_size, hipStream_t stream) {
    static int grid = 0;
    if (grid == 0) {
        if (n_in != 18 || in_sizes[0] != NTOK * DM || out_size != NTOK * DM || ws_size < WS_END) { fprintf(stderr, "kernel_launch: unexpected shapes / workspace (n_in %d, ws %zu); nothing launched\n", n_in, ws_size); grid = -1; return; }
        int dev = 0, cus = 0;
        if (hipGetDevice(&dev) != hipSuccess || hipDeviceGetAttribute(&cus, hipDeviceAttributeMultiprocessorCount, dev) != hipSuccess) { grid = -1; return; }
        if (hipFuncSetAttribute((const void*)mk_fwd, hipFuncAttributeMaxDynamicSharedMemorySize, LDS_BYTES) != hipSuccess) { fprintf(stderr, "kernel_launch: hipFuncSetAttribute failed\n"); grid = -1; return; }
        int per_cu = 0;
        if (hipOccupancyMaxActiveBlocksPerMultiprocessor(&per_cu, (const void*)mk_fwd, NWAVES * 64, LDS_BYTES) != hipSuccess || per_cu < 1) fprintf(stderr, "kernel_launch: note: occupancy query reports %d blocks per CU\n", per_cu);
        (void)hipGetLastError();
        grid = cus;
    }
    if (grid < 0) return;
    (void)hipMemsetAsync((char*)d_ws + WS_CTL, 0, CTL_ZERO_BYTES, stream);
    Args a{};
    for (int i = 0; i < 18; ++i) a.in[i] = (const float*)d_in[i];
    a.out = (float*)d_out; a.ws = (unsigned char*)d_ws;
    for (int li = 0; li < N_LAUNCHES; ++li) {
        if (N_LAUNCHES == 1) { a.ph_lo = 0; a.ph_hi = NPHASE; } else { a.ph_lo = li; a.ph_hi = li + 1; }
        a.li = (N_LAUNCHES == 1) ? 0 : 0;
        hipLaunchKernelGGL(mk_fwd, dim3(grid), dim3(NWAVES * 64), LDS_BYTES, stream, a);
    }
}
```

```cpp
#include <hip/hip_runtime.h>
#include <cstdio>
#include <cstdint>
namespace pg8 {
#define PG8_LAS __attribute__((address_space(3)))
typedef unsigned short bf16_t;
typedef short bf16x8 __attribute__((ext_vector_type(8)));
typedef float f32x4 __attribute__((ext_vector_type(4)));
typedef unsigned u32x4 __attribute__((ext_vector_type(4)));
constexpr int BM = 256, BK = 64, HALF = 128, HTB = HALF * BK * 2  , STAGE_BYTES = 8 * HTB, NXCD = 8, WGM = 8;

__host__ __device__ __forceinline__ int lds_byte(int r, int c) { const int st = (r >> 4) * 2 + (c >> 5), rr = r & 15, cc = c & 31, ob = rr * 64 + cc * 2; return st * 1024 + (ob ^ (((ob >> 9) & 1) << 5)); }
__host__ __device__ __forceinline__ void stage_rc(int b, int& R, int& C) { const int st = b / 1024, sb = b % 1024, swz = sb ^ (((sb >> 9) & 1) << 5); R = (st >> 1) * 16 + swz / 64; C = (st & 1) * 32 + (swz % 64) / 2; }
__host__ __device__ __forceinline__ int perm32(int rho) { const int n = rho >> 4, i = rho & 15; return 8 * (i >> 2) + 4 * n + (i & 3); }

struct Unit { int pm, pn; };
struct Gemm { const bf16_t* A; const bf16_t* Bt; int M, N, K; };
struct StaticOrder {
    int nM, nN, nwg, G, c;
    __host__ __device__ void init(int M, int N, int G_, int c_) { nM = M / BM; nN = N / BM; nwg = nM * nN; G = G_; c = c_; }
    __host__ __device__ bool next(int i, Unit& u) const {
        const long L = (long)i * G + c; if (L >= nwg) return false;
        int wgid = (int)L; { const int q = nwg / NXCD, r = nwg % NXCD, xcd = wgid % NXCD, off = wgid / NXCD; wgid = (xcd < r ? xcd * (q + 1) : r * (q + 1) + (xcd - r) * q) + off; }
        const int nig = WGM * nN, gid = wgid / nig, fm = gid * WGM, gsz = (nM - fm) < WGM ? (nM - fm) : WGM;
        u.pm = fm + ((wgid % nig) % gsz); u.pn = (wgid % nig) / gsz; return true;
    }
    __device__ __forceinline__ void a_ready(const Unit&) const {}
    __device__ __forceinline__ void done(const Unit&) const {}
    __device__ __forceinline__ const char* pa(const Gemm& g, const Unit& u) const { return (const char*)g.A + (size_t)u.pm * ((size_t)BM * g.K * 2); }
    __device__ __forceinline__ const char* pb(const Gemm& g, const Unit& u) const { return (const char*)g.Bt + (size_t)u.pn * ((size_t)BM * g.K * 2); }
};
struct InProjOrder {
    StaticOrder so;
    __host__ __device__ void init(int G_, int c_) { so.init(136 * BM, 8 * BM, G_, c_); }
    __host__ __device__ bool next(int i, Unit& u) const { int cnt = -1; for (int j = 0; ; ++j) { if (!so.next(j, u)) return false; if (!(u.pm >= 128 && u.pn < 4)) { if (++cnt == i) return true; } } }
    __device__ __forceinline__ void a_ready(const Unit&) const {}
    __device__ __forceinline__ void done(const Unit&) const {}
    __device__ __forceinline__ const char* pa(const Gemm& g, const Unit& u) const { return u.pn < 6 ? (const char*)g.A + (size_t)u.pm * ((size_t)BM * g.K * 2) : (const char*)g.Bt + (size_t)u.pn * ((size_t)BM * g.K * 2); }
    __device__ __forceinline__ const char* pb(const Gemm& g, const Unit& u) const { return u.pn < 6 ? (const char*)g.Bt + (size_t)u.pn * ((size_t)BM * g.K * 2) : (const char*)g.A + (size_t)u.pm * ((size_t)BM * g.K * 2); }
};

__device__ __forceinline__ unsigned cvt_pk_bf16(float lo, float hi) { unsigned r; asm volatile("v_cvt_pk_bf16_f32 %0, %1, %2" : "=v"(r) : "v"(lo), "v"(hi)); return r; }
struct EpiBf16 {
    static constexpr bool PERM = true, AFTER_DRAIN = false;
    bf16_t* O; int ldc;
    __device__ __forceinline__ void operator()(const f32x4 (&acc)[2][2][4][2], const Unit& u, int wr, int wc, int fr, int fq) const {
        const int row0 = u.pm * BM + wr * 64 + fr, col0 = u.pn * BM + wc * 32 + 8 * fq;
#pragma unroll
        for (int ai = 0; ai < 2; ++ai)
#pragma unroll
            for (int m = 0; m < 4; ++m) { bf16_t* rowp = O + (size_t)(row0 + ai * HALF + m * 16) * ldc + col0;
#pragma unroll
                for (int bj = 0; bj < 2; ++bj) { const f32x4 v0 = acc[ai][bj][m][0], v1 = acc[ai][bj][m][1];
                    u32x4 w; w.x = cvt_pk_bf16(v0[0], v0[1]); w.y = cvt_pk_bf16(v0[2], v0[3]); w.z = cvt_pk_bf16(v1[0], v1[1]); w.w = cvt_pk_bf16(v1[2], v1[3]);
                    *(u32x4*)(rowp + bj * HALF) = w; } }
    }
};
struct EpiX1 {
    static constexpr bool PERM = true, AFTER_DRAIN = false;
    const float* x; const float* mod; float* out;
    __device__ __forceinline__ void operator()(const f32x4 (&acc)[2][2][4][2], const Unit& u, int wr, int wc, int fr, int fq) const {
        const int row0 = u.pm * BM + wr * 64 + fr, col0 = u.pn * BM + wc * 32 + 8 * fq;
        const float* g1 = mod + (size_t)((u.pm * BM) >> 12) * 6144 + 2048 + col0;
        f32x4 gv[2][2];
#pragma unroll
        for (int bj = 0; bj < 2; ++bj)
#pragma unroll
            for (int n = 0; n < 2; ++n) gv[bj][n] = *(const f32x4*)(g1 + bj * HALF + 4 * n);
#pragma unroll
        for (int ai = 0; ai < 2; ++ai)
#pragma unroll
            for (int m = 0; m < 4; ++m) { const size_t off = (size_t)(row0 + ai * HALF + m * 16) * 1024 + col0;
#pragma unroll
                for (int bj = 0; bj < 2; ++bj)
#pragma unroll
                    for (int n = 0; n < 2; ++n) { const f32x4 xv = *(const f32x4*)(x + off + bj * HALF + 4 * n);
                        *(f32x4*)(out + off + bj * HALF + 4 * n) = xv + gv[bj][n] * acc[ai][bj][m][n]; } }
    }
};

struct EpiInProj {
    static constexpr bool PERM = true, AFTER_DRAIN = false;
    bf16_t *PB, *QF, *KF, *VF;
    __device__ __forceinline__ void operator()(const f32x4 (&acc)[2][2][4][2], const Unit& u, int wr, int wc, int fr, int fq) const {
        if (u.pn < 6) {
            const int sec = u.pn >> 1, cbase = (u.pn & 1) * 256 + wc * 32 + 8 * fq;
#pragma unroll
            for (int ai = 0; ai < 2; ++ai)
#pragma unroll
                for (int m = 0; m < 4; ++m) { const int T = u.pm * BM + ai * HALF + wr * 64 + m * 16 + fr;
                    int bb, blk; if (T < 32768) { bb = T >> 12; blk = (T & 4095) >> 5; } else { const int cc = T - 32768; bb = cc >> 8; blk = 128 + ((cc & 255) >> 5); }
                    const int tl = T & 31;
#pragma unroll
                    for (int bj = 0; bj < 2; ++bj) { const int c = cbase + HALF * bj; const f32x4 v0 = acc[ai][bj][m][0], v1 = acc[ai][bj][m][1];
                        u32x4 w; w.x = cvt_pk_bf16(v0[0], v0[1]); w.y = cvt_pk_bf16(v0[2], v0[3]); w.z = cvt_pk_bf16(v1[0], v1[1]); w.w = cvt_pk_bf16(v1[2], v1[3]);
                        if (sec == 0) *(u32x4*)(PB + (size_t)T * 512 + c) = w;
                        else { const int h = c >> 6, d0 = c & 63, fo = ((d0 >> 4) * 64 + ((d0 >> 3) & 1) * 32 + tl) * 8;
                            bf16_t* dst = (sec == 1) ? QF + (size_t)((bb * 8 + h) * 128 + blk) * 2048 + fo : KF + (size_t)((bb * 8 + h) * 136 + blk) * 2048 + fo;
                            *(u32x4*)dst = w; } } }
        } else {
            typedef unsigned u32x2 __attribute__((ext_vector_type(2)));
#pragma unroll
            for (int ai = 0; ai < 2; ++ai)
#pragma unroll
                for (int m = 0; m < 4; ++m) { const int vc = (u.pn - 6) * BM + ai * HALF + wr * 64 + m * 16 + fr, h = vc >> 6, dt = (vc >> 5) & 1, dl = vc & 31;
#pragma unroll
                    for (int bj = 0; bj < 2; ++bj) { const int T0 = u.pm * BM + bj * HALF + wc * 32 + 8 * fq;
                        int bb, blk; if (T0 < 32768) { bb = T0 >> 12; blk = (T0 & 4095) >> 5; } else { const int cc = T0 - 32768; bb = cc >> 8; blk = 128 + ((cc & 255) >> 5); }
                        bf16_t* base = VF + ((size_t)(((bb * 8 + h) * 136 + blk) * 2 + dt) * 2 + (fq >> 1)) * 512 + 4 * (fq & 1);
                        const f32x4 v0 = acc[ai][bj][m][0], v1 = acc[ai][bj][m][1];
                        u32x2 w0, w1; w0.x = cvt_pk_bf16(v0[0], v0[1]); w0.y = cvt_pk_bf16(v0[2], v0[3]); w1.x = cvt_pk_bf16(v1[0], v1[1]); w1.y = cvt_pk_bf16(v1[2], v1[3]);
                        *(u32x2*)(base + dl * 8) = w0; *(u32x2*)(base + (32 + dl) * 8) = w1; } }
        }
    }
};

struct EpiQP {
    static constexpr bool PERM = true, AFTER_DRAIN = false;
    bf16_t* QP;
    __device__ __forceinline__ void operator()(const f32x4 (&acc)[2][2][4][2], const Unit& u, int wr, int wc, int fr, int fq) const {
#pragma unroll
        for (int ai = 0; ai < 2; ++ai)
#pragma unroll
            for (int m = 0; m < 4; ++m) { const int T = u.pm * BM + ai * HALF + wr * 64 + m * 16 + fr;
#pragma unroll
                for (int bj = 0; bj < 2; ++bj) { const int hp = 2 * u.pn + bj, ks = 2 * wc + (fq >> 1), hh = fq & 1;
                    const f32x4 v0 = acc[ai][bj][m][0], v1 = acc[ai][bj][m][1];
                    u32x4 w; w.x = cvt_pk_bf16(v0[0], v0[1]); w.y = cvt_pk_bf16(v0[2], v0[3]); w.z = cvt_pk_bf16(v1[0], v1[1]); w.w = cvt_pk_bf16(v1[2], v1[3]);
                    *(u32x4*)(QP + ((size_t)(T >> 5) * 16 + hp) * 4096 + (ks * 64 + hh * 32 + (T & 31)) * 8) = w; } }
    }
};
template <class Epi, class Sched, bool ALIGN_EPI = false, bool SP2 = false>
__device__ __forceinline__ void gemm_phase(PG8_LAS unsigned char* lds, const Gemm g, const Sched& S, const Epi& E) {
    const int tid = threadIdx.x, wid = __builtin_amdgcn_readfirstlane(tid >> 6), lane = tid & 63, wr = wid >> 2, wc = wid & 3, fr = lane & 15, fq = lane >> 4;
    const int K = g.K, nt = K / BK;
    unsigned voffA[2], voffB[2];
#pragma unroll
    for (int i = 0; i < 2; ++i) { int R, C; stage_rc(tid * 16 + i * 8192, R, C); const int Rb = Epi::PERM ? ((R & ~31) + perm32(R & 31)) : R;
        voffA[i] = (unsigned)(R * K + C) * 2u; voffB[i] = (unsigned)(Rb * K + C) * 2u; }
    const size_t kstep = (size_t)(BK * 2);
    const size_t hstep = (size_t)HALF * K * 2;
    const size_t tstep = 2 * hstep;
    const unsigned ldsw = (unsigned)wid * 1024u;
    const int aoff = lds_byte(wr * 64 + fr, fq * 8), boff = lds_byte(wc * 32 + fr, fq * 8);
#define PG8_SA(b, h) (((b) * 2 + (h)) * HTB)
#define PG8_SB(b, h) ((4 + (b) * 2 + (h)) * HTB)
#define PG8_STAGE(bufoff, gbase, voff) do { _Pragma("unroll") for (int _i = 0; _i < 2; ++_i) \
        __builtin_amdgcn_global_load_lds((const unsigned*)((const char*)(gbase) + (voff)[_i]), (PG8_LAS unsigned*)(lds + (bufoff) + ldsw + _i * 8192), 16, 0, 0); } while (0)
#define PG8_LDA(dst, b, h) do { _Pragma("unroll") for (int m = 0; m < 4; ++m) _Pragma("unroll") for (int k = 0; k < 2; ++k) dst[m][k] = *(const PG8_LAS bf16x8*)(lds + PG8_SA(b, h) + aoff + m * 2048 + k * 1024); } while (0)
#define PG8_LDB(dst, b, h) do { _Pragma("unroll") for (int n = 0; n < 2; ++n) _Pragma("unroll") for (int k = 0; k < 2; ++k) dst[n][k] = *(const PG8_LAS bf16x8*)(lds + PG8_SB(b, h) + boff + n * 2048 + k * 1024); } while (0)
#define PG8_MMA(ai, bj, At, Bt) do { __builtin_amdgcn_s_setprio(1); _Pragma("unroll") for (int m = 0; m < 4; ++m) _Pragma("unroll") for (int n = 0; n < 2; ++n) _Pragma("unroll") for (int k = 0; k < 2; ++k) \
        acc[ai][bj][m][n] = __builtin_amdgcn_mfma_f32_16x16x32_bf16(Bt[n][k], At[m][k], acc[ai][bj][m][n], 0, 0, 0); __builtin_amdgcn_s_setprio(0); } while (0)
#define PG8_WAIT_V(n) asm volatile("s_waitcnt vmcnt(" #n ")" ::: "memory")
#define PG8_WAIT_L(n) asm volatile("s_waitcnt lgkmcnt(" #n ")" ::: "memory")
#define PG8_BAR __builtin_amdgcn_s_barrier()
#define PG8_SCHED __builtin_amdgcn_sched_barrier(0)
    Unit cur, nxt; int ui = 0;
    if (!S.next(0, cur)) return;
    f32x4 acc[2][2][4][2];
#pragma unroll
    for (int a = 0; a < 2; ++a)
#pragma unroll
        for (int b = 0; b < 2; ++b)
#pragma unroll
            for (int m = 0; m < 4; ++m)
#pragma unroll
                for (int n = 0; n < 2; ++n) acc[a][b][m][n] = (f32x4){0.f, 0.f, 0.f, 0.f};
    bf16x8 At[4][2], B0[2][2], B1[2][2];
    const char* cA = S.pa(g, cur); const char* cB = S.pb(g, cur);
    S.a_ready(cur);
    if constexpr (SP2) {
        PG8_STAGE(PG8_SB(0, 0), cB, voffB); PG8_STAGE(PG8_SB(0, 1), cB + hstep, voffB); PG8_STAGE(PG8_SA(0, 0), cA, voffA); PG8_STAGE(PG8_SA(0, 1), cA + hstep, voffA);
        if (wr == 1) PG8_BAR;
        PG8_WAIT_V(2); PG8_BAR;
        PG8_STAGE(PG8_SB(1, 0), cB + kstep, voffB); PG8_STAGE(PG8_SA(1, 0), cA + kstep, voffA); PG8_STAGE(PG8_SB(1, 1), cB + hstep + kstep, voffB);
        PG8_WAIT_V(6); PG8_BAR;
    } else {
        PG8_STAGE(PG8_SB(0, 0), cB, voffB); PG8_STAGE(PG8_SA(0, 0), cA, voffA); PG8_STAGE(PG8_SB(0, 1), cB + hstep, voffB); PG8_STAGE(PG8_SA(0, 1), cA + hstep, voffA);
        if (wr == 1) PG8_BAR;
        PG8_WAIT_V(4); PG8_BAR;
        PG8_STAGE(PG8_SB(1, 0), cB + kstep, voffB); PG8_STAGE(PG8_SA(1, 0), cA + kstep, voffA); PG8_STAGE(PG8_SB(1, 1), cB + hstep + kstep, voffB);
        PG8_WAIT_V(6); PG8_BAR;
    }
    for (;;) {
        const bool has_next = S.next(ui + 1, nxt);
        const char* nA = has_next ? S.pa(g, nxt) : cA; const char* nB = has_next ? S.pb(g, nxt) : cB;
        for (int t = 0; t < nt; t += 2) {
            const bool last = (t == nt - 2);
            const char* a1 = cA + (size_t)(t + 1) * kstep;
            const char* a2 = last ? nA : cA + (size_t)(t + 2) * kstep; const char* b2 = last ? nB : cB + (size_t)(t + 2) * kstep;
            const char* a3 = a2 + kstep; const char* b3 = b2 + kstep;
            if (last && has_next) S.a_ready(nxt);
            if constexpr (SP2) {
            PG8_LDB(B0, 0, 0); PG8_LDB(B1, 0, 1); PG8_SCHED; PG8_LDA(At, 0, 0); PG8_STAGE(PG8_SA(1, 1), a1 + hstep, voffA);
            PG8_WAIT_V(8); PG8_WAIT_L(0); PG8_BAR; PG8_MMA(0, 0, At, B0); PG8_MMA(0, 1, At, B1); PG8_BAR; PG8_SCHED;
            PG8_LDA(At, 0, 1); PG8_STAGE(PG8_SB(0, 0), b2, voffB); PG8_STAGE(PG8_SB(0, 1), b2 + hstep, voffB); PG8_STAGE(PG8_SA(0, 0), a2, voffA);
            PG8_WAIT_V(8); PG8_WAIT_L(0); PG8_BAR; PG8_MMA(1, 0, At, B0); PG8_MMA(1, 1, At, B1); PG8_BAR; PG8_SCHED;
            PG8_LDB(B0, 1, 0); PG8_LDB(B1, 1, 1); PG8_SCHED; PG8_LDA(At, 1, 0); PG8_STAGE(PG8_SA(0, 1), a2 + hstep, voffA);
            PG8_WAIT_V(8); PG8_WAIT_L(0); PG8_BAR; PG8_MMA(0, 0, At, B0); PG8_MMA(0, 1, At, B1); PG8_BAR; PG8_SCHED;
            PG8_LDA(At, 1, 1); PG8_STAGE(PG8_SB(1, 0), b3, voffB); PG8_STAGE(PG8_SB(1, 1), b3 + hstep, voffB); PG8_STAGE(PG8_SA(1, 0), a3, voffA);
            PG8_WAIT_V(8); PG8_WAIT_L(0); PG8_BAR; PG8_MMA(1, 0, At, B0); PG8_MMA(1, 1, At, B1); PG8_BAR; PG8_SCHED;
            } else {
            PG8_LDB(B0, 0, 0); PG8_SCHED; PG8_LDA(At, 0, 0); PG8_STAGE(PG8_SA(1, 1), a1 + hstep, voffA);
            PG8_WAIT_L(8); PG8_BAR; PG8_WAIT_L(0); PG8_MMA(0, 0, At, B0); PG8_BAR; PG8_SCHED;
            PG8_LDB(B1, 0, 1); PG8_STAGE(PG8_SB(0, 0), b2, voffB);
            PG8_BAR; PG8_WAIT_L(0); PG8_MMA(0, 1, At, B1); PG8_BAR;
            PG8_LDA(At, 0, 1); PG8_STAGE(PG8_SA(0, 0), a2, voffA);
            PG8_BAR; PG8_WAIT_L(0); PG8_MMA(1, 0, At, B0); PG8_BAR; PG8_SCHED;
            PG8_STAGE(PG8_SB(0, 1), b2 + hstep, voffB);
            PG8_WAIT_V(6); PG8_BAR; PG8_MMA(1, 1, At, B1); PG8_BAR;
            PG8_LDB(B0, 1, 0); PG8_SCHED; PG8_LDA(At, 1, 0); PG8_STAGE(PG8_SA(0, 1), a2 + hstep, voffA);
            PG8_WAIT_L(8); PG8_BAR; PG8_WAIT_L(0); PG8_MMA(0, 0, At, B0); PG8_BAR; PG8_SCHED;
            PG8_LDB(B1, 1, 1); PG8_STAGE(PG8_SB(1, 0), b3, voffB);
            PG8_BAR; PG8_WAIT_L(0); PG8_MMA(0, 1, At, B1); PG8_BAR;
            PG8_LDA(At, 1, 1); PG8_STAGE(PG8_SA(1, 0), a3, voffA);
            PG8_BAR; PG8_WAIT_L(0); PG8_MMA(1, 0, At, B0); PG8_BAR; PG8_SCHED;
            PG8_STAGE(PG8_SB(1, 1), b3 + hstep, voffB);
            PG8_WAIT_V(6); PG8_BAR; PG8_MMA(1, 1, At, B1); PG8_BAR;
            }
        }
        if constexpr (ALIGN_EPI) { if (wr == 0) PG8_BAR; }
        if constexpr (!Epi::AFTER_DRAIN) { E(acc, cur, wr, wc, fr, fq); S.done(cur); }
        if (!has_next) break;
#pragma unroll
        for (int a = 0; a < 2; ++a)
#pragma unroll
            for (int b = 0; b < 2; ++b)
#pragma unroll
                for (int m = 0; m < 4; ++m)
#pragma unroll
                    for (int n = 0; n < 2; ++n) acc[a][b][m][n] = (f32x4){0.f, 0.f, 0.f, 0.f};
        cur = nxt; cA = nA; cB = nB; ++ui;
        if constexpr (ALIGN_EPI) { if (wr == 1) PG8_BAR; }
    }
    PG8_WAIT_V(0);
    if constexpr (!ALIGN_EPI) { if (wr == 0) PG8_BAR; }
    PG8_BAR;
    if constexpr (Epi::AFTER_DRAIN) { E.fused(acc, cur, wr, wc, fr, fq, lds, wid, lane); S.done(cur); }
#undef PG8_SA
#undef PG8_SB
#undef PG8_STAGE
#undef PG8_LDA
#undef PG8_LDB
#undef PG8_MMA
#undef PG8_WAIT_V
#undef PG8_WAIT_L
#undef PG8_BAR
#undef PG8_SCHED
}
}

constexpr int DM = 1024, NBATCH = 8, SEQ = 4096, NTOK = NBATCH * SEQ, CTXL = 256, NCTX = NBATCH * CTXL, MROWS = NTOK + NCTX;
constexpr int DIN = 2048, NHEAD = 8, HD = 64, GRIDW = 64, NMOD = 6 * DM;
constexpr int NEXP = 16384;
constexpr float EPS = 1e-6f;
constexpr int NWAVES = 8;
constexpr int NPHASE = 8;
constexpr float U_SCALE = 64.f, V_SCALE = 4.f;
#ifndef MK_N_LAUNCHES
#define MK_N_LAUNCHES 1
#endif
constexpr int N_LAUNCHES = MK_N_LAUNCHES;

constexpr size_t MiB = 1u << 20;
constexpr size_t WS_CTL = 0, CTL_ZERO_BYTES = 64 * 1024;
constexpr size_t WS_WIN = 2 * MiB, WS_WOUT = 6 * MiB, WS_WQ = 8 * MiB, WS_KEYS = 12 * MiB, WS_POOLW = 12 * MiB + 512 * 1024, WS_MOD = 13 * MiB;
constexpr size_t WS_U = 14 * MiB, WS_V = 46 * MiB;
constexpr size_t WS_HX = 78 * MiB;
constexpr size_t WS_ZX = 146 * MiB;
constexpr size_t WS_PB = 146 * MiB, WS_QF = 178 * MiB, WS_KF = 210 * MiB, WS_VF = 244 * MiB;
constexpr size_t WS_MIX = 282 * MiB;
constexpr size_t WS_EXP = 346 * MiB, WS_GATE = 362 * MiB;
constexpr size_t WS_POOLED = 378 * MiB;
constexpr size_t WS_LISTS = 410 * MiB;
constexpr size_t WS_END = 442 * MiB;
constexpr int CW_BAR = 4096;

constexpr int RING_OFF = 0, RING_BYTES = 131072;
constexpr int LDSCTL_OFF = RING_BYTES, MISC_OFF = LDSCTL_OFF + 320;
constexpr int LDS_BYTES = 147456;

#define GAS __attribute__((address_space(1)))
#define LAS __attribute__((address_space(3)))
#define DI __device__ __forceinline__
typedef unsigned short bf16;
typedef unsigned v4u __attribute__((ext_vector_type(4)));
typedef unsigned v2u __attribute__((ext_vector_type(2)));
typedef float f32x4 __attribute__((ext_vector_type(4)));
typedef float f32x2 __attribute__((ext_vector_type(2)));
typedef GAS unsigned gu32;
#define RLX_AGENT __ATOMIC_RELAXED, __HIP_MEMORY_SCOPE_AGENT
#define LDS_WAIT() asm volatile("s_waitcnt lgkmcnt(0)" ::: "memory")
#define VM_WAIT() asm volatile("s_waitcnt vmcnt(0)" ::: "memory")
DI unsigned f2bf(float f) { unsigned u = __builtin_bit_cast(unsigned, f); return (u + 0x7fffu + ((u >> 16) & 1u)) >> 16; }
DI unsigned pk2(float lo, float hi) { return f2bf(lo) | (f2bf(hi) << 16); }
DI float bflo(unsigned u) { return __uint_as_float(u << 16); }
DI float bfhi(unsigned u) { return __uint_as_float(u & 0xffff0000u); }
DI float wave_sum(float v) {
#pragma unroll
    for (int o = 1; o < 64; o <<= 1) v += __shfl_xor(v, o);
    return v;
}

#define XB_TMO      128
#define XB_XCNT(j)  (256  + 64 * (j))
#define XB_XSUB(j)  (1280 + 64 * (j))
#define XB_XGEN(j)  (2304 + 64 * (j))
#define XB_TOP      3328
#define XB_TOPGEN   3392
#define XCD_BAR_WORDS 3456
#define XB_SPIN_CAP (1u << 18)

__device__ __forceinline__ unsigned xb_ld(unsigned* p)              { return __hip_atomic_load(p, __ATOMIC_RELAXED, __HIP_MEMORY_SCOPE_AGENT); }
__device__ __forceinline__ unsigned xb_add(unsigned* p, unsigned v) { return __hip_atomic_fetch_add(p, v, __ATOMIC_RELAXED, __HIP_MEMORY_SCOPE_AGENT); }
__device__ __forceinline__ unsigned xb_xcc_id() { return (unsigned)__builtin_amdgcn_s_getreg((3 << 11) | 20) & 0xFu; }
#define XB_SPIN(cond, bar) do { unsigned _sp = 0; while (cond) { __builtin_amdgcn_s_sleep(1); \
    if ((++_sp & 255u) == 0u) { if (xb_ld(&(bar)[XB_TMO])) break; if (_sp > XB_SPIN_CAP) { atomicAdd(&(bar)[XB_TMO], 1u); break; } } } } while (0)

struct XcdBarrier {
    unsigned* bar; unsigned x;
    volatile LAS unsigned* st;
};

__device__ __forceinline__ XcdBarrier xcd_barrier_post(unsigned* bar, volatile LAS unsigned* st) {
    XcdBarrier b; b.bar = bar; b.x = xb_xcc_id(); b.st = st;
    if (threadIdx.x == 0) (void)xb_add(&bar[XB_XCNT(b.x)], 1u);
    return b;
}
__device__ __forceinline__ void xcd_barrier_complete(unsigned* bar, unsigned x, unsigned& nloc, unsigned& nx) {
    const unsigned G = gridDim.x * gridDim.y * gridDim.z;
    unsigned sum, cnt, mine, sp = 0u;
    for (;;) {
        sum = 0u; cnt = 0u; mine = 0u;
#pragma unroll
        for (unsigned j = 0; j < 16; ++j) { const unsigned c = xb_ld(&bar[XB_XCNT(j)]); sum += c; cnt += (c > 0u) ? 1u : 0u; mine = (j == x) ? c : mine; }
        if (sum == G) break;
        __builtin_amdgcn_s_sleep(1);
        if ((++sp & 255u) == 0u) { if (xb_ld(&bar[XB_TMO])) break; if (sp > XB_SPIN_CAP) { atomicAdd(&bar[XB_TMO], 1u); break; } }
    }
    nloc = mine > 0u ? mine : 1u; nx = cnt > 0u ? cnt : 1u;
}

__device__ __forceinline__ void xcd_barrier(const XcdBarrier& b) {
    asm volatile("s_waitcnt vmcnt(0)" ::: "memory");
    __syncthreads();
    if (threadIdx.x == 0) {
        unsigned* bar = b.bar;
        __builtin_amdgcn_s_waitcnt(0);
        unsigned nloc = b.st[0], nx = b.st[1];
        if (nloc == 0u) { xcd_barrier_complete(bar, b.x, nloc, nx); b.st[0] = nloc; b.st[1] = nx; }
        const unsigned old = xb_add(&bar[XB_XSUB(b.x)], 1u);
        const unsigned gen = old / nloc;
        if (old + 1u == (gen + 1u) * nloc) {
            __builtin_amdgcn_fence(__ATOMIC_RELEASE, "agent");
            asm volatile("s_waitcnt vmcnt(0)" ::: "memory");
            const unsigned og = xb_add(&bar[XB_TOP], 1u);
            const unsigned tg = og / nx;
            if (og + 1u == (tg + 1u) * nx) xb_add(&bar[XB_TOPGEN], 1u);
            else XB_SPIN(xb_ld(&bar[XB_TOPGEN]) == tg, bar);
            __builtin_amdgcn_fence(__ATOMIC_ACQUIRE, "agent");
            xb_add(&bar[XB_XGEN(b.x)], 1u);
            asm volatile("s_waitcnt vmcnt(0)" ::: "memory");
        } else {
            XB_SPIN(xb_ld(&bar[XB_XGEN(b.x)]) == gen, bar);
            __builtin_amdgcn_fence(__ATOMIC_ACQUIRE, "agent");
            asm volatile("s_waitcnt vmcnt(0)" ::: "memory");
        }
    }
    __syncthreads();
}


__device__ __forceinline__ void p0_transpose_item(const float* W, int K, int N, bf16* WT, int row_off, LAS float* scr, int item, int lane) {
    const int nblk = N / 32, kb = item / nblk, nb = item % nblk, k0 = 64 * kb, n0 = 32 * nb;
#pragma unroll 8
    for (int i = 0; i < 32; ++i) { const int kk = 2 * i + (lane >> 5); scr[kk * 33 + (lane & 31)] = W[(size_t)(k0 + kk) * N + n0 + (lane & 31)]; }
    LDS_WAIT(); asm volatile("" ::: "memory");
    const int c = lane & 7;
#pragma unroll
    for (int j = 0; j < 4; ++j) { const int n = (lane >> 3) + 8 * j; const LAS float* s = scr + (8 * c) * 33 + n;
        v4u o; o.x = pk2(s[0 * 33], s[1 * 33]); o.y = pk2(s[2 * 33], s[3 * 33]); o.z = pk2(s[4 * 33], s[5 * 33]); o.w = pk2(s[6 * 33], s[7 * 33]);
        *(GAS v4u*)(WT + (size_t)(row_off + n0 + n) * K + k0 + 8 * c) = o; }
    LDS_WAIT(); asm volatile("" ::: "memory");
}


struct Frame {
    LAS unsigned char* lds;
    int tid, lane, wave, vcu, G, gw, NGW;
    const float* in[18]; float* out; unsigned char* ws;
};

DI void p0_prologue(Frame& F) {
    const float* c = F.in[1]; const float* c_ctx = F.in[3]; const float* ada_w = F.in[4]; const float* ada_b = F.in[5];
    float* MOD = (float*)(F.ws + WS_MOD);
    LAS float* sl = (LAS float*)(F.lds + 73728);
    for (int i = F.tid; i < 9 * 1024; i += 512) { const int b = i >> 10, k = i & 1023; const float cv = (b < 8) ? c[b * 1024 + k] : c_ctx[k]; sl[i] = cv / (1.f + __expf(-cv)); }
    __syncthreads();
    for (int a = F.gw; a < NMOD / 16; a += F.NGW) {
        const int n = a * 16 + (F.lane & 15), kg = F.lane >> 4;
        float acc[9];
#pragma unroll
        for (int b = 0; b < 9; ++b) acc[b] = 0.f;
        const float* wp = ada_w + (size_t)(kg * 256) * NMOD + n; const LAS float* sp = sl + kg * 256;
#pragma unroll 8
        for (int i = 0; i < 256; ++i) { const float w = wp[(size_t)i * NMOD];
#pragma unroll
            for (int b = 0; b < 9; ++b) acc[b] += sp[b * 1024 + i] * w; }
#pragma unroll
        for (int b = 0; b < 9; ++b) { acc[b] += __shfl_xor(acc[b], 16); acc[b] += __shfl_xor(acc[b], 32); }
        if (kg == 0) { const float bb = ada_b[n];
#pragma unroll
            for (int b = 0; b < 9; ++b) MOD[b * NMOD + n] = acc[b] + bb; }
    }
    LAS float* scr = (LAS float*)(F.lds + F.wave * 9216);
    constexpr int I_IN = (DM / 64) * (DIN / 32), I_OUT = (DM / 64) * (DM / 32), I_Q = (DM / 64) * (2048 / 32), I_P = 4 * 8;
    for (int it = F.gw; it < I_IN + I_OUT + I_Q + I_P; it += F.NGW) {
        int r = it;
        if (r < I_IN) { p0_transpose_item(F.in[7], DM, DIN, (bf16*)(F.ws + WS_WIN), 0, scr, r, F.lane); continue; } r -= I_IN;
        if (r < I_OUT) { p0_transpose_item(F.in[11], DM, DM, (bf16*)(F.ws + WS_WOUT), 0, scr, r, F.lane); continue; } r -= I_OUT;
        if (r < I_Q) { p0_transpose_item(F.in[13], DM, 2048, (bf16*)(F.ws + WS_WQ), 0, scr, r, F.lane); continue; } r -= I_Q;
        { const int g = r >> 3; p0_transpose_item(F.in[8] + g * 16384, 128, 128, (bf16*)(F.ws + WS_POOLW) + g * 16384, 0, scr, r & 7, F.lane); }
    }
    { const float* kf = F.in[14]; bf16* kb = (bf16*)(F.ws + WS_KEYS);
      for (int it = F.gw; it < 16 * 32; it += F.NGW) { const int hp = it >> 5, nt = (it >> 3) & 3, ks = it & 7;
          const float* src = kf + ((size_t)hp * 128 + 32 * nt + (F.lane & 31)) * 128 + 16 * ks + 8 * (F.lane >> 5);
          const f32x4 a = *(const f32x4*)(src), b = *(const f32x4*)(src + 4);
          v4u w; w.x = pk2(a.x, a.y); w.y = pk2(a.z, a.w); w.z = pk2(b.x, b.y); w.w = pk2(b.z, b.w); *(v4u*)(kb + ((size_t)it * 64 + F.lane) * 8) = w; } }
    for (int it = F.gw; it < 2 * NEXP; it += F.NGW) {
        const bool isu = it < NEXP;
        const float* src = isu ? F.in[15] + (size_t)it * 1024 : F.in[16] + (size_t)(it - NEXP) * 1024;
        unsigned char* dst = isu ? F.ws + WS_U + (size_t)it * 1024 : F.ws + WS_V + (size_t)(it - NEXP) * 1024;
        const float sc = isu ? U_SCALE : V_SCALE;
        const f32x4* sp = (const f32x4*)(src + F.lane * 16);
        v4u w;
#pragma unroll
        for (int j = 0; j < 4; ++j) { const f32x4 a = sp[j] * sc; int pk = 0; pk = __builtin_amdgcn_cvt_pk_fp8_f32(a.x, a.y, pk, false); pk = __builtin_amdgcn_cvt_pk_fp8_f32(a.z, a.w, pk, true); w[j] = (unsigned)pk; }
        *(v4u*)(dst + F.lane * 16) = w;
    }
}

DI void norm_rows(Frame& F, const float* src_x, const float* src_ctx, int nrows, const float* gain, int shift_off, int scale_off, bf16* dst) {
    const float* MOD = (const float*)(F.ws + WS_MOD);
    for (int m = F.gw; m < nrows; m += F.NGW) {
        const float* xrow; int b;
        if (m < NTOK) { xrow = src_x + (size_t)m * DM; b = m >> 12; } else { xrow = src_ctx + (size_t)(m - NTOK) * DM; b = 8; }
        const f32x4* xr = (const f32x4*)xrow + F.lane;
        f32x4 v[4]; float s = 0.f;
#pragma unroll
        for (int j = 0; j < 4; ++j) { v[j] = xr[64 * j]; s += (v[j].x * v[j].x + v[j].y * v[j].y) + (v[j].z * v[j].z + v[j].w * v[j].w); }
        const float rinv = 1.0f / sqrtf(wave_sum(s) * (1.f / DM) + EPS);
        const f32x4* gp = (const f32x4*)gain + F.lane; const f32x4* shp = (const f32x4*)(MOD + b * NMOD + shift_off) + F.lane; const f32x4* scp = (const f32x4*)(MOD + b * NMOD + scale_off) + F.lane;
        unsigned long long* o8 = (unsigned long long*)(dst + (size_t)m * DM) + F.lane;
#pragma unroll
        for (int j = 0; j < 4; ++j) { const f32x4 g = gp[64 * j], sh = shp[64 * j], sc = scp[64 * j];
            const f32x4 y = (v[j] * rinv) * g * (sc + 1.0f) + sh;
            o8[64 * j] = (unsigned long long)pk2(y.x, y.y) | ((unsigned long long)pk2(y.z, y.w) << 32); }
    }
}

DI void attn_key(const bf16* KF, const bf16* VF, int blkbase, int kk, int dt, float bias, const float (&q)[64], float (&o)[32], float& m, float& l) {
    const bf16* kp = KF + (size_t)blkbase * 2048 + kk * 8;
    float acc = 0.f;
#pragma unroll
    for (int cc = 0; cc < 8; ++cc) { const v4u kv = *(const v4u*)(kp + ((cc >> 1) * 64 + (cc & 1) * 32) * 8);
        acc += q[8 * cc + 0] * bflo(kv.x) + q[8 * cc + 1] * bfhi(kv.x) + q[8 * cc + 2] * bflo(kv.y) + q[8 * cc + 3] * bfhi(kv.y)
             + q[8 * cc + 4] * bflo(kv.z) + q[8 * cc + 5] * bfhi(kv.z) + q[8 * cc + 6] * bflo(kv.w) + q[8 * cc + 7] * bfhi(kv.w); }
    const float s = acc + bias;
    const float mn = fmaxf(m, s), alpha = __expf(m - mn), p = __expf(s - mn);
    l = l * alpha + p; m = mn;
    const bf16* vp = VF + (size_t)blkbase * 2048 + dt * 1024 + (kk >> 4) * 512 + (((kk >> 2) & 1) * 32) * 8 + 4 * ((kk >> 3) & 1) + (kk & 3);
#pragma unroll
    for (int d = 0; d < 32; ++d) o[d] = o[d] * alpha + p * __uint_as_float((unsigned)vp[d * 8] << 16);
}
DI void attn_naive(Frame& F) {
    const bf16* QF = (const bf16*)(F.ws + WS_QF); const bf16* KF = (const bf16*)(F.ws + WS_KF); const bf16* VF = (const bf16*)(F.ws + WS_VF);
    bf16* MIX = (bf16*)(F.ws + WS_MIX); const float* rpb = F.in[10];
    for (int unit2 = F.gw; unit2 < 2 * NBATCH * NHEAD * 64; unit2 += F.NGW) {
        const int unit = unit2 >> 1, dt = unit2 & 1;
        const int r = unit & 63, h = (unit >> 6) & 7, b = unit >> 9, col = F.lane;
        const int tq = b * SEQ + r * GRIDW + col;
        float q[64], o[32];
        { const bf16* qp = QF + (size_t)((b * 8 + h) * 128 + 2 * r + (col >> 5)) * 2048 + (col & 31) * 8;
#pragma unroll
          for (int cc = 0; cc < 8; ++cc) { const v4u qv = *(const v4u*)(qp + ((cc >> 1) * 64 + (cc & 1) * 32) * 8);
              q[8 * cc + 0] = 0.125f * bflo(qv.x); q[8 * cc + 1] = 0.125f * bfhi(qv.x); q[8 * cc + 2] = 0.125f * bflo(qv.y); q[8 * cc + 3] = 0.125f * bfhi(qv.y);
              q[8 * cc + 4] = 0.125f * bflo(qv.z); q[8 * cc + 5] = 0.125f * bfhi(qv.z); q[8 * cc + 6] = 0.125f * bflo(qv.w); q[8 * cc + 7] = 0.125f * bfhi(qv.w); } }
#pragma unroll
        for (int d = 0; d < 32; ++d) o[d] = 0.f;
        float m = -1e30f, l = 0.f;
#pragma unroll 1
        for (int g = 0; g < CTXL; ++g) attn_key(KF, VF, (b * 8 + h) * 136 + 128 + (g >> 5), g & 31, dt, 0.f, q, o, m, l);
        const int r0 = min(max(r - 4, 0), 56), c0 = min(max(col - 8, 0), 48);
#pragma unroll 1
        for (int ij = 0; ij < 128; ++ij) { const int i = ij >> 4, j = ij & 15, kc = c0 + j;
            attn_key(KF, VF, (b * 8 + h) * 136 + 2 * (r0 + i) + (kc >> 5), kc & 31, dt, rpb[(h * 15 + (r0 + i - r + 7)) * 31 + (kc - col + 15)], q, o, m, l); }
        const float il = 1.0f / l;
        v4u* op = (v4u*)(MIX + (size_t)tq * DM + 512 + h * 64 + dt * 32);
#pragma unroll
        for (int cc = 0; cc < 4; ++cc) { v4u w; w.x = pk2(o[8 * cc] * il, o[8 * cc + 1] * il); w.y = pk2(o[8 * cc + 2] * il, o[8 * cc + 3] * il);
            w.z = pk2(o[8 * cc + 4] * il, o[8 * cc + 5] * il); w.w = pk2(o[8 * cc + 6] * il, o[8 * cc + 7] * il); op[cc] = w; }
    }
}
typedef float f32x16 __attribute__((ext_vector_type(16)));
typedef short s16x8 __attribute__((ext_vector_type(8)));
typedef __bf16 bf16x2_t __attribute__((ext_vector_type(2)));
#define MFMA32(a, b, c) __builtin_amdgcn_mfma_f32_32x32x16_bf16((a), (b), (c), 0, 0, 0)
DI unsigned cvtpk(float lo, float hi) { f32x2 v = {lo, hi}; bf16x2_t bb = __builtin_convertvector(v, bf16x2_t); return __builtin_bit_cast(unsigned, bb); }
DI float pairmax(float v) { auto rr = __builtin_amdgcn_permlane32_swap(__float_as_uint(v), __float_as_uint(v), false, false); return fmaxf(__uint_as_float(rr[0]), __uint_as_float(rr[1])); }
constexpr float LOG2E = 1.4426950408889634f, ATT_C2 = 0.125f * LOG2E, ATT_THR = 6.0f;
template <int QMASK, bool LOCAL>
DI void attn_tile(const s16x8 (&kf)[4], const s16x8 (&vf)[4], const LAS s16x8* qfp, f32x16 (&o)[2], float& m, float& l, const LAS float* brow, int djb, int lo) {
    f32x16 s; s16x8 qf[4];
#pragma unroll
    for (int ks = 0; ks < 4; ++ks) qf[ks] = qfp[ks * 64];
#pragma unroll
    for (int i = 0; i < 16; ++i) s[i] = 0.f;
#pragma unroll
    for (int ks = 0; ks < 4; ++ks) s = MFMA32(kf[ks], qf[ks], s);
    float sv[16]; float tmax = -INFINITY;
#pragma unroll
    for (int i = 0; i < 16; ++i) {
        if (!((QMASK >> (i >> 2)) & 1)) { sv[i] = -INFINITY; continue; }
        if (LOCAL) { const int dj = djb + (i & 3) + 8 * (i >> 2); const bool valid = (unsigned)(dj - lo) < 16u;
            const float x = s[i] * ATT_C2 + brow[valid ? dj : 0]; sv[i] = valid ? x : -INFINITY; }
        else sv[i] = s[i] * ATT_C2;
        tmax = fmaxf(tmax, sv[i]);
    }
    tmax = pairmax(tmax);
    if (__any(tmax > m + ATT_THR)) { const float mn = fmaxf(m, tmax), alpha = __builtin_amdgcn_exp2f(m - mn); o[0] *= alpha; o[1] *= alpha; l *= alpha; m = mn; }
    float p[16];
#pragma unroll
    for (int i = 0; i < 16; ++i) { if ((QMASK >> (i >> 2)) & 1) { p[i] = __builtin_amdgcn_exp2f(sv[i] - m); l += p[i]; } else p[i] = 0.f; }
#pragma unroll
    for (int s2 = 0; s2 < 2; ++s2) if (QMASK & (3 << (2 * s2))) {
        v4u pk; pk.x = cvtpk(p[8 * s2], p[8 * s2 + 1]); pk.y = cvtpk(p[8 * s2 + 2], p[8 * s2 + 3]); pk.z = cvtpk(p[8 * s2 + 4], p[8 * s2 + 5]); pk.w = cvtpk(p[8 * s2 + 6], p[8 * s2 + 7]);
        const s16x8 pf = __builtin_bit_cast(s16x8, pk);
        o[0] = MFMA32(vf[s2], pf, o[0]); o[1] = MFMA32(vf[2 + s2], pf, o[1]);
    }
}
DI void attn_mfma(Frame& F) {
    const bf16* QF = (const bf16*)(F.ws + WS_QF); const bf16* KF = (const bf16*)(F.ws + WS_KF); const bf16* VF = (const bf16*)(F.ws + WS_VF);
    bf16* MIX = (bf16*)(F.ws + WS_MIX); const float* rpb = F.in[10];
    LAS float* rp = (LAS float*)(F.lds);
    for (int i = F.tid; i < NHEAD * 15 * 31; i += 512) rp[i] = rpb[i] * LOG2E;
    __syncthreads();
    const int lane = F.lane, hh = lane >> 5, ql = lane & 31;
    int lo[2], djb[2][2];
#pragma unroll
    for (int qb = 0; qb < 2; ++qb) { const int qc = 32 * qb + ql, c0 = min(max(qc - 8, 0), 48); lo[qb] = c0 - qc + 15;
#pragma unroll
        for (int jb = 0; jb < 2; ++jb) djb[qb][jb] = 32 * (jb - qb) + 4 * hh - ql + 15; }
    for (int unit = F.gw; unit < NBATCH * NHEAD * 64; unit += F.NGW) {
        const int r = unit & 63, h = (unit >> 6) & 7, b = unit >> 9, bh = b * 8 + h;
        LAS s16x8* qfl = (LAS s16x8*)(F.lds + 16384 + F.wave * 8192) + lane;
#pragma unroll
        for (int qb = 0; qb < 2; ++qb)
#pragma unroll
            for (int ks = 0; ks < 4; ++ks) qfl[(qb * 4 + ks) * 64] = ((const s16x8*)(QF + (size_t)(bh * 128 + 2 * r + qb) * 2048))[ks * 64 + lane];
        f32x16 o[2][2]; float m[2], l[2];
#pragma unroll
        for (int qb = 0; qb < 2; ++qb) { m[qb] = -1e30f; l[qb] = 0.f;
#pragma unroll
            for (int dt = 0; dt < 2; ++dt)
#pragma unroll
                for (int i = 0; i < 16; ++i) o[qb][dt][i] = 0.f; }
        s16x8 kf[4], vf[4];
#pragma unroll 1
        for (int kb = 0; kb < 8; ++kb) {
            const s16x8* kp = (const s16x8*)(KF + (size_t)(bh * 136 + 128 + kb) * 2048) + lane; const s16x8* vp = (const s16x8*)(VF + (size_t)(bh * 136 + 128 + kb) * 2048) + lane;
#pragma unroll
            for (int j = 0; j < 4; ++j) { kf[j] = kp[j * 64]; vf[j] = vp[j * 64]; }
            attn_tile<15, false>(kf, vf, qfl, o[0], m[0], l[0], rp, 0, 0); __builtin_amdgcn_sched_barrier(0);
            attn_tile<15, false>(kf, vf, qfl + 256, o[1], m[1], l[1], rp, 0, 0); __builtin_amdgcn_sched_barrier(0);
        }
        const int r0 = min(max(r - 4, 0), 56);
#pragma unroll 1
        for (int i = 0; i < 8; ++i) {
            const LAS float* brow = rp + (h * 15 + (r0 + i - r + 7)) * 31;
            { const s16x8* kp = (const s16x8*)(KF + (size_t)(bh * 136 + 2 * (r0 + i)) * 2048) + lane; const s16x8* vp = (const s16x8*)(VF + (size_t)(bh * 136 + 2 * (r0 + i)) * 2048) + lane;
#pragma unroll
              for (int j = 0; j < 4; ++j) { kf[j] = kp[j * 64]; vf[j] = vp[j * 64]; } }
            attn_tile<15, true>(kf, vf, qfl, o[0], m[0], l[0], brow, djb[0][0], lo[0]); __builtin_amdgcn_sched_barrier(0);
            attn_tile<8, true>(kf, vf, qfl + 256, o[1], m[1], l[1], brow, djb[1][0], lo[1]); __builtin_amdgcn_sched_barrier(0);
            { const s16x8* kp = (const s16x8*)(KF + (size_t)(bh * 136 + 2 * (r0 + i) + 1) * 2048) + lane; const s16x8* vp = (const s16x8*)(VF + (size_t)(bh * 136 + 2 * (r0 + i) + 1) * 2048) + lane;
#pragma unroll
              for (int j = 0; j < 4; ++j) { kf[j] = kp[j * 64]; vf[j] = vp[j * 64]; } }
            attn_tile<1, true>(kf, vf, qfl, o[0], m[0], l[0], brow, djb[0][1], lo[0]); __builtin_amdgcn_sched_barrier(0);
            attn_tile<15, true>(kf, vf, qfl + 256, o[1], m[1], l[1], brow, djb[1][1], lo[1]); __builtin_amdgcn_sched_barrier(0);
        }
#pragma unroll
        for (int qb = 0; qb < 2; ++qb) {
            const float lt = l[qb] + __shfl_xor(l[qb], 32), inv = 1.0f / lt;
            bf16* orow = MIX + (size_t)(b * SEQ + r * GRIDW + 32 * qb + ql) * DM + 512 + h * 64 + 4 * hh;
#pragma unroll
            for (int dt = 0; dt < 2; ++dt)
#pragma unroll
                for (int g = 0; g < 4; ++g) { v2u w; w.x = pk2(o[qb][dt][4 * g] * inv, o[qb][dt][4 * g + 1] * inv); w.y = pk2(o[qb][dt][4 * g + 2] * inv, o[qb][dt][4 * g + 3] * inv);
                    *(v2u*)(orow + 32 * dt + 8 * g) = w; }
        }
    }
    __syncthreads();
}
DI void pool_mfma(Frame& F) {
    const bf16* PBF = (const bf16*)(F.ws + WS_PB); bf16* MIX = (bf16*)(F.ws + WS_MIX); const bf16* PW = (const bf16*)(F.ws + WS_POOLW); const float* pool_scale = F.in[9];
    constexpr int RS = 272;
    LAS unsigned char* ptile = F.lds + 32768;
    LAS unsigned char* atile = F.lds + 32768 + 144 * RS;
    const int lane = F.lane, hh = lane >> 5, ql = lane & 31;
    for (int tile = F.vcu; tile < NTOK / 128; tile += F.G) {
        const int tok0 = tile * 128, bstart = tok0 & ~(SEQ - 1);
#pragma unroll 1
        for (int g = 0; g < 4; ++g) {
            for (int it = F.tid; it < 144 * 16; it += 512) { const int rr = it >> 4, ch = it & 15, t = tok0 - 8 + rr;
                v4u v = (v4u){0u, 0u, 0u, 0u};
                if (t >= bstart && t < bstart + SEQ) v = *(const v4u*)(PBF + (size_t)t * 512 + g * 128 + ch * 8);
                *(LAS v4u*)(ptile + rr * RS + ch * 16) = v; }
            __syncthreads();
            { const int cp = F.tid & 63, sg = F.tid >> 6, w = 2 << g, hw = w >> 1;
              const LAS unsigned char* col = ptile + cp * 4;
              float s0 = 0.f, s1 = 0.f;
              const int tl0 = sg * 16;
              for (int rr = tl0 + 8 - hw; rr < tl0 + 8 + hw; ++rr) { const unsigned u = *(const LAS unsigned*)(col + rr * RS); s0 += bflo(u); s1 += bfhi(u); }
#pragma unroll 4
              for (int i = 0; i < 16; ++i) { const int tl = tl0 + i, sp = (tok0 + tl) & (SEQ - 1);
                  const int cnt = min(sp + hw, SEQ) - max(sp - hw, 0); const float inv = 1.0f / (float)cnt;
                  const unsigned self = *(const LAS unsigned*)(col + (tl + 8) * RS);
                  *(LAS unsigned*)(atile + tl * RS + cp * 4) = pk2(s0 * inv - bflo(self), s1 * inv - bfhi(self));
                  const unsigned un = *(const LAS unsigned*)(col + (tl + 8 + hw) * RS), uo = *(const LAS unsigned*)(col + (tl + 8 - hw) * RS);
                  s0 += bflo(un) - bflo(uo); s1 += bfhi(un) - bfhi(uo); } }
            __syncthreads();
            { const int tb = F.wave >> 1, dt0 = (F.wave & 1) * 2;
              f32x16 acc[2];
#pragma unroll
              for (int j = 0; j < 2; ++j)
#pragma unroll
                  for (int i = 0; i < 16; ++i) acc[j][i] = 0.f;
#pragma unroll
              for (int ks = 0; ks < 8; ++ks) {
                  const s16x8 bfr = *(const LAS s16x8*)(atile + (32 * tb + ql) * RS + (16 * ks + 8 * hh) * 2);
#pragma unroll
                  for (int j = 0; j < 2; ++j) { const s16x8 afr = *(const s16x8*)(PW + (size_t)g * 16384 + (32 * (dt0 + j) + ql) * 128 + 16 * ks + 8 * hh);
                      acc[j] = MFMA32(afr, bfr, acc[j]); } }
              bf16* orow = MIX + (size_t)(tok0 + 32 * tb + ql) * DM + g * 128 + 4 * hh;
#pragma unroll
              for (int j = 0; j < 2; ++j)
#pragma unroll
                  for (int q = 0; q < 4; ++q) { const int d = 32 * (dt0 + j) + 8 * q; const f32x4 sc = *(const f32x4*)(pool_scale + g * 128 + d + 4 * hh);
                      v2u wv; wv.x = pk2(acc[j][4 * q] * sc.x, acc[j][4 * q + 1] * sc.y); wv.y = pk2(acc[j][4 * q + 2] * sc.z, acc[j][4 * q + 3] * sc.w);
                      *(v2u*)(orow + d) = wv; } }
            __syncthreads();
        }
    }
}
DI void pool_naive(Frame& F) {
    const bf16* PBF = (const bf16*)(F.ws + WS_PB); bf16* MIX = (bf16*)(F.ws + WS_MIX); bf16* PO = (bf16*)(F.ws + WS_POOLED);
    const float* pool_w = F.in[8]; const float* pool_scale = F.in[9];
    for (int tile = F.vcu; tile < NTOK / 128; tile += F.G) {
        const int tok0 = tile * 128;
        for (int it = F.tid; it < 128 * 64; it += 512) {
            const int t = tok0 + (it >> 6), ch = (it & 63) * 8, g = ch >> 7, w = 2 << g, s = t & (SEQ - 1), tb = t - s;
            const int lo = max(s - w / 2, 0), hi = min(s + w / 2, SEQ);
            float acc[8];
#pragma unroll
            for (int i = 0; i < 8; ++i) acc[i] = 0.f;
            for (int p = lo; p < hi; ++p) { const v4u v = *(const v4u*)(PBF + (size_t)(tb + p) * 512 + ch);
                acc[0] += bflo(v.x); acc[1] += bfhi(v.x); acc[2] += bflo(v.y); acc[3] += bfhi(v.y); acc[4] += bflo(v.z); acc[5] += bfhi(v.z); acc[6] += bflo(v.w); acc[7] += bfhi(v.w); }
            const float inv = 1.0f / (float)(hi - lo);
            const v4u sv = *(const v4u*)(PBF + (size_t)t * 512 + ch);
            v4u wv; wv.x = pk2(acc[0] * inv - bflo(sv.x), acc[1] * inv - bfhi(sv.x)); wv.y = pk2(acc[2] * inv - bflo(sv.y), acc[3] * inv - bfhi(sv.y));
            wv.z = pk2(acc[4] * inv - bflo(sv.z), acc[5] * inv - bfhi(sv.z)); wv.w = pk2(acc[6] * inv - bflo(sv.w), acc[7] * inv - bfhi(sv.w));
            *(v4u*)(PO + (size_t)t * 512 + ch) = wv;
        }
        VM_WAIT(); __syncthreads();
        for (int it = F.wave; it < 1024; it += 8) {
            const int t = tok0 + (it >> 3), g = (it >> 1) & 3, d = (it & 1) * 64 + F.lane;
            const bf16* pr = PO + (size_t)t * 512 + g * 128; const float* wp = pool_w + g * 16384 + d;
            float acc = 0.f;
            for (int c8 = 0; c8 < 16; ++c8) { const v4u pv = *(const v4u*)(pr + c8 * 8); const float* w8 = wp + c8 * 8 * 128;
                acc += bflo(pv.x) * w8[0] + bfhi(pv.x) * w8[128] + bflo(pv.y) * w8[256] + bfhi(pv.y) * w8[384] + bflo(pv.z) * w8[512] + bfhi(pv.z) * w8[640] + bflo(pv.w) * w8[768] + bfhi(pv.w) * w8[896]; }
            MIX[(size_t)t * DM + g * 128 + d] = (bf16)f2bf(acc * pool_scale[g * 128 + d]);
        }
        __syncthreads();
    }
}

DI void peer_topk_naive(Frame& F, int tok0) {
    const bf16* Q = (const bf16*)(F.ws + WS_ZX); const float* keys = F.in[14]; float* LISTS = (float*)(F.ws + WS_LISTS);
    int* EXPERTS = (int*)(F.ws + WS_EXP); float* GATES = (float*)(F.ws + WS_GATE);
    for (int it = F.wave; it < 32; it += 8) {
        const int hp = it & 15, t = tok0 + (it >> 4) * 64 + F.lane;
        float q[128];
        { const v4u* qp = (const v4u*)(Q + (size_t)t * 2048 + hp * 128);
#pragma unroll
          for (int cc = 0; cc < 16; ++cc) { const v4u qv = qp[cc];
              q[8 * cc + 0] = bflo(qv.x); q[8 * cc + 1] = bfhi(qv.x); q[8 * cc + 2] = bflo(qv.y); q[8 * cc + 3] = bfhi(qv.y);
              q[8 * cc + 4] = bflo(qv.z); q[8 * cc + 5] = bfhi(qv.z); q[8 * cc + 6] = bflo(qv.w); q[8 * cc + 7] = bfhi(qv.w); } }
        float top[16];
#pragma unroll
        for (int i = 0; i < 16; ++i) top[i] = -INFINITY;
        const float* kb = keys + (size_t)hp * 16384;
        for (int n = 0; n < 128; ++n) {
            const f32x4* kr = (const f32x4*)(kb + n * 128);
            float acc = 0.f;
#pragma unroll
            for (int cc = 0; cc < 32; ++cc) { const f32x4 kv = kr[cc]; acc += q[4 * cc] * kv.x + q[4 * cc + 1] * kv.y + q[4 * cc + 2] * kv.z + q[4 * cc + 3] * kv.w; }
            float v = __uint_as_float((__float_as_uint(acc) & ~127u) | (unsigned)n);
#pragma unroll
            for (int i = 0; i < 16; ++i) { const float hi = fmaxf(top[i], v); v = fminf(top[i], v); top[i] = hi; }
        }
        f32x4* lp = (f32x4*)(LISTS + ((size_t)t * 16 + hp) * 16);
#pragma unroll
        for (int i = 0; i < 4; ++i) lp[i] = (f32x4){top[4 * i], top[4 * i + 1], top[4 * i + 2], top[4 * i + 3]};
    }
    VM_WAIT(); __syncthreads();
    for (int it = F.tid; it < 128 * 8; it += 512) {
        const int t = tok0 + (it >> 3), h = it & 7;
        float v0[16], v1[16]; int i0[16], i1[16];
        const f32x4* l0 = (const f32x4*)(LISTS + ((size_t)t * 16 + h * 2) * 16);
#pragma unroll
        for (int i = 0; i < 4; ++i) { const f32x4 a = l0[i], b = l0[4 + i];
#pragma unroll
            for (int e = 0; e < 4; ++e) { const unsigned ua = __float_as_uint(a[e]), ub = __float_as_uint(b[e]);
                v0[4 * i + e] = __uint_as_float(ua & ~127u); i0[4 * i + e] = (int)(ua & 127u); v1[4 * i + e] = __uint_as_float(ub & ~127u); i1[4 * i + e] = (int)(ub & 127u); } }
        float tv[16]; int ti[16];
#pragma unroll
        for (int i = 0; i < 16; ++i) { tv[i] = -INFINITY; ti[i] = 0; }
#pragma unroll
        for (int i = 0; i < 16; ++i)
#pragma unroll
            for (int j = 0; j < 16; ++j) if ((i + 1) * (j + 1) <= 16) {
                float cv = v0[i] + v1[j]; int ci = i0[i] * 128 + i1[j];
#pragma unroll
                for (int k = 0; k < 16; ++k) { const bool gt = cv > tv[k]; const float nv = gt ? cv : tv[k]; const int ni = gt ? ci : ti[k]; cv = gt ? tv[k] : cv; ci = gt ? ti[k] : ci; tv[k] = nv; ti[k] = ni; }
            }
        float e[16], sum = 0.f;
#pragma unroll
        for (int k = 0; k < 16; ++k) { e[k] = __expf(tv[k] - tv[0]); sum += e[k]; }
        const float is = 1.0f / sum;
        int* ep = EXPERTS + (size_t)t * 128 + h * 16; float* gp = GATES + (size_t)t * 128 + h * 16;
#pragma unroll
        for (int k = 0; k < 16; ++k) { ep[k] = ti[k]; gp[k] = e[k] * is; }
    }
    VM_WAIT(); __syncthreads();
}

DI int f2key(float f) { const int b = __float_as_int(f); return b ^ ((b >> 31) & 0x7fffffff); }
DI float key2f(int k) { return __int_as_float(k ^ ((k >> 31) & 0x7fffffff)); }
DI void ce_desc(int& x, int& y) { const int hi = max(x, y), lo = min(x, y); x = hi; y = lo; }
DI void sort16_desc(int (&a)[16]) {
#pragma unroll
    for (int k = 2; k <= 16; k <<= 1)
#pragma unroll
        for (int j = k >> 1; j > 0; j >>= 1)
#pragma unroll
            for (int i = 0; i < 16; ++i) { const int l = i ^ j; if (l > i) { if ((i & k) == 0) ce_desc(a[i], a[l]); else ce_desc(a[l], a[i]); } }
}
DI void merge16_desc(int (&a)[16], const int (&b)[16]) {
#pragma unroll
    for (int i = 0; i < 16; ++i) a[i] = max(a[i], b[15 - i]);
#pragma unroll
    for (int j = 8; j > 0; j >>= 1)
#pragma unroll
        for (int i = 0; i < 16; ++i) if ((i & j) == 0) ce_desc(a[i], a[i + j]);
}
DI void peer_topk_mfma(Frame& F, int tile) {
    const bf16* QP = (const bf16*)(F.ws + WS_ZX); const bf16* KEYF = (const bf16*)(F.ws + WS_KEYS);
    int* EXPERTS = (int*)(F.ws + WS_EXP); float* GATES = (float*)(F.ws + WS_GATE);
    const int lane = F.lane, hh = lane >> 5, ql = lane & 31, tb = F.wave >> 1, p = F.wave & 1;
    const int tokblk = tile * 4 + tb, tok = tokblk * 32 + ql;
#pragma unroll 1
    for (int h = 0; h < 8; ++h) {
        const int hp = 2 * h + p;
        s16x8 qf[8];
#pragma unroll
        for (int ks = 0; ks < 8; ++ks) qf[ks] = ((const s16x8*)(QP + ((size_t)tokblk * 16 + hp) * 4096))[ks * 64 + lane];
        const s16x8* kfp = (const s16x8*)(KEYF + (size_t)hp * 16384) + lane;
        int top[16];
#pragma unroll
        for (int nt = 0; nt < 4; ++nt) {
            f32x16 acc;
#pragma unroll
            for (int i = 0; i < 16; ++i) acc[i] = 0.f;
#pragma unroll
            for (int ks = 0; ks < 8; ++ks) acc = MFMA32(kfp[(nt * 8 + ks) * 64], qf[ks], acc);
            int a[16];
#pragma unroll
            for (int i = 0; i < 16; ++i) { const int n = 32 * nt + (i & 3) + 8 * (i >> 2) + 4 * hh; a[i] = f2key(__int_as_float((__float_as_int(acc[i]) & ~127) | n)); }
            sort16_desc(a);
            if (nt == 0) {
#pragma unroll
                for (int i = 0; i < 16; ++i) top[i] = a[i];
            } else merge16_desc(top, a);
        }
        { int oth[16];
#pragma unroll
          for (int i = 0; i < 16; ++i) oth[i] = __shfl_xor(top[i], 32);
          merge16_desc(top, oth); }
        LAS float* L = (LAS float*)(F.lds) + (h & 1) * 4096 + (tb * 2) * 512;
        if (hh == 0) {
#pragma unroll
            for (int i = 0; i < 16; ++i) L[p * 512 + i * 32 + ql] = key2f(top[i]);
        }
        __syncthreads();
        if (p == 0 && hh == 0) {
            float v0[16], v1[16];
#pragma unroll
            for (int i = 0; i < 16; ++i) { v0[i] = __int_as_float(__float_as_int(L[i * 32 + ql]) & ~127); v1[i] = __int_as_float(__float_as_int(L[512 + i * 32 + ql]) & ~127); }
            int grp[4][16]; int cnt = 0;
#pragma unroll
            for (int g = 0; g < 4; ++g)
#pragma unroll
                for (int i = 0; i < 16; ++i) grp[g][i] = (int)0x80000000;
#pragma unroll
            for (int i = 0; i < 16; ++i)
#pragma unroll
                for (int j = 0; j < 16; ++j) if ((i + 1) * (j + 1) <= 16) {
                    grp[cnt >> 4][cnt & 15] = f2key(__int_as_float((__float_as_int(v0[i] + v1[j]) & ~255) | (i * 16 + j))); ++cnt; }
#pragma unroll
            for (int g = 0; g < 4; ++g) sort16_desc(grp[g]);
            merge16_desc(grp[0], grp[1]); merge16_desc(grp[2], grp[3]); merge16_desc(grp[0], grp[2]);
            float tv[16]; float e[16]; float sum = 0.f; int eid[16];
#pragma unroll
            for (int k = 0; k < 16; ++k) { const int bits = __float_as_int(key2f(grp[0][k])); const int code = bits & 255; tv[k] = __int_as_float(bits & ~255);
                const int n0 = __float_as_int(L[(code >> 4) * 32 + ql]) & 127, n1 = __float_as_int(L[512 + (code & 15) * 32 + ql]) & 127; eid[k] = n0 * 128 + n1; }
#pragma unroll
            for (int k = 0; k < 16; ++k) { e[k] = __expf(tv[k] - tv[0]); sum += e[k]; }
            const float is = 1.0f / sum;
            int* ep = EXPERTS + (size_t)tok * 128 + h * 16; float* gp = GATES + (size_t)tok * 128 + h * 16;
#pragma unroll
            for (int k4 = 0; k4 < 4; ++k4) { *(v4u*)(ep + 4 * k4) = (v4u){(unsigned)eid[4 * k4], (unsigned)eid[4 * k4 + 1], (unsigned)eid[4 * k4 + 2], (unsigned)eid[4 * k4 + 3]};
                *(f32x4*)(gp + 4 * k4) = (f32x4){e[4 * k4] * is, e[4 * k4 + 1] * is, e[4 * k4 + 2] * is, e[4 * k4 + 3] * is}; }
        }
    }
    VM_WAIT(); __syncthreads();
}

DI float gelu_exact(float a) { return 0.5f * a * (1.0f + erff(a * 0.70710678118654752f)); }

DI void fp8x16_to_f32(const v4u r, float (&f)[16]) {
#pragma unroll
    for (int j = 0; j < 4; ++j) { const f32x2 lo = __builtin_amdgcn_cvt_pk_f32_fp8((int)r[j], false), hi = __builtin_amdgcn_cvt_pk_f32_fp8((int)r[j], true);
        f[4 * j] = lo.x; f[4 * j + 1] = lo.y; f[4 * j + 2] = hi.x; f[4 * j + 3] = hi.y; }
}
DI void peer_gather_token(Frame& F, int t) {
    const bf16* H2 = (const bf16*)(F.ws + WS_HX); const unsigned char* U = F.ws + WS_U; const unsigned char* V = F.ws + WS_V;
    const int* EXPERTS = (const int*)(F.ws + WS_EXP); const float* GATES = (const float*)(F.ws + WS_GATE); const float* MOD = (const float*)(F.ws + WS_MOD);
    const int lane = F.lane;
    float hs[16];
    { const v4u a = *((const v4u*)(H2 + (size_t)t * DM + lane * 16)), b = *((const v4u*)(H2 + (size_t)t * DM + lane * 16 + 8));
      hs[0] = bflo(a.x); hs[1] = bfhi(a.x); hs[2] = bflo(a.y); hs[3] = bfhi(a.y); hs[4] = bflo(a.z); hs[5] = bfhi(a.z); hs[6] = bflo(a.w); hs[7] = bfhi(a.w);
      hs[8] = bflo(b.x); hs[9] = bfhi(b.x); hs[10] = bflo(b.y); hs[11] = bfhi(b.y); hs[12] = bflo(b.z); hs[13] = bfhi(b.z); hs[14] = bflo(b.w); hs[15] = bfhi(b.w); }
    const int ev0 = EXPERTS[(size_t)t * 128 + lane], ev1 = EXPERTS[(size_t)t * 128 + 64 + lane];
    const float gv0 = GATES[(size_t)t * 128 + lane], gv1 = GATES[(size_t)t * 128 + 64 + lane];
    float out[16];
#pragma unroll
    for (int i = 0; i < 16; ++i) out[i] = 0.f;
    v4u ucur[8];
#pragma unroll
    for (int r = 0; r < 8; ++r) { const int e = __builtin_amdgcn_readlane(ev0, r); ucur[r] = *((const v4u*)(U + (size_t)e * 1024) + lane); }
#pragma unroll 1
    for (int bt = 0; bt < 16; ++bt) {
        const int evs = (bt < 8) ? ev0 : ev1; const float gvs = (bt < 8) ? gv0 : gv1;
        v4u vcur[8];
#pragma unroll
        for (int r = 0; r < 8; ++r) { const int e = __builtin_amdgcn_readlane(evs, (bt & 7) * 8 + r); vcur[r] = *((const v4u*)(V + (size_t)e * 1024) + lane); }
        float p[8];
#pragma unroll
        for (int r = 0; r < 8; ++r) { float f[16]; fp8x16_to_f32(ucur[r], f);
            p[r] = ((hs[0] * f[0] + hs[1] * f[1]) + (hs[2] * f[2] + hs[3] * f[3])) + ((hs[4] * f[4] + hs[5] * f[5]) + (hs[6] * f[6] + hs[7] * f[7]))
                 + ((hs[8] * f[8] + hs[9] * f[9]) + (hs[10] * f[10] + hs[11] * f[11])) + ((hs[12] * f[12] + hs[13] * f[13]) + (hs[14] * f[14] + hs[15] * f[15])); }
        { const int evn = (bt + 1 < 8) ? ev0 : ev1; const int bn = (bt + 1) & 15;
#pragma unroll
          for (int r = 0; r < 8; ++r) { const int e = __builtin_amdgcn_readlane(evn, (bn & 7) * 8 + r); ucur[r] = *((const v4u*)(U + (size_t)e * 1024) + lane); } }
        { const bool h5 = (lane & 32) != 0;
#pragma unroll
          for (int i = 0; i < 4; ++i) { const float send = h5 ? p[i] : p[i + 4], keep = h5 ? p[i + 4] : p[i]; p[i] = keep + __shfl_xor(send, 32); }
          const bool h4 = (lane & 16) != 0;
#pragma unroll
          for (int i = 0; i < 2; ++i) { const float send = h4 ? p[i] : p[i + 2], keep = h4 ? p[i + 2] : p[i]; p[i] = keep + __shfl_xor(send, 16); }
          const bool h3 = (lane & 8) != 0;
          { const float send = h3 ? p[0] : p[1], keep = h3 ? p[1] : p[0]; p[0] = keep + __shfl_xor(send, 8); }
          p[0] += __shfl_xor(p[0], 4); p[0] += __shfl_xor(p[0], 2); p[0] += __shfl_xor(p[0], 1); }
        const float gk = __shfl(gvs, (bt & 7) * 8 + ((lane >> 3) & 7));
        const float w = gk * gelu_exact(p[0] * (1.0f / U_SCALE));
#pragma unroll
        for (int r = 0; r < 8; ++r) { const float wr = __builtin_bit_cast(float, __builtin_amdgcn_readlane(__builtin_bit_cast(int, w), r * 8)); float f[16]; fp8x16_to_f32(vcur[r], f);
#pragma unroll
            for (int i = 0; i < 16; ++i) out[i] += wr * f[i]; }
    }
    const int b = t >> 12; const float* g2 = MOD + b * NMOD + 5 * DM; const float* fg = F.in[17]; float* xo = F.out + (size_t)t * DM;
    float x2[16]; float ss = 0.f;
#pragma unroll
    for (int hq = 0; hq < 4; ++hq) { const int c = lane * 16 + hq * 4; const f32x4 xv = *(const f32x4*)(xo + c), gv = *(const f32x4*)(g2 + c);
#pragma unroll
        for (int e = 0; e < 4; ++e) { const float y = xv[e] + gv[e] * (out[hq * 4 + e] * (1.0f / V_SCALE)); x2[hq * 4 + e] = y; ss += y * y; } }
    const float rinv = 1.0f / sqrtf(wave_sum(ss) * (1.f / DM) + EPS);
#pragma unroll
    for (int hq = 0; hq < 4; ++hq) { const int c = lane * 16 + hq * 4; const f32x4 fv = *(const f32x4*)(fg + c);
        f32x4 y;
#pragma unroll
        for (int e = 0; e < 4; ++e) y[e] = x2[hq * 4 + e] * rinv * fv[e];
        *(f32x4*)(xo + c) = y; }
}

struct Args { const float* in[18]; float* out; unsigned char* ws; int ph_lo, ph_hi, li, pad; };
__global__ void __launch_bounds__(NWAVES * 64, 2) mk_fwd(Args args) {
    extern __shared__ __attribute__((aligned(16))) unsigned char lds[];
    Frame F;
    F.lds = (LAS unsigned char*)lds;
    F.tid = threadIdx.x; F.lane = F.tid & 63; F.wave = __builtin_amdgcn_readfirstlane(F.tid >> 6);
    F.G = gridDim.x; { const int bx = blockIdx.x; F.vcu = (F.G % 8 == 0) ? (bx % 8) * (F.G / 8) + bx / 8 : bx; }
    F.gw = F.vcu * NWAVES + F.wave; F.NGW = F.G * NWAVES;
#pragma unroll
    for (int i = 0; i < 18; ++i) F.in[i] = args.in[i];
    F.out = args.out; F.ws = args.ws;
    volatile LAS unsigned* MISC = (volatile LAS unsigned*)(F.lds + MISC_OFF);
    for (int u = F.tid; u < (LDS_BYTES - LDSCTL_OFF) / 4; u += NWAVES * 64) ((LAS unsigned*)(F.lds + LDSCTL_OFF))[u] = 0u;
    __syncthreads();
    gu32* ctl = (gu32*)(F.ws + WS_CTL);
    XcdBarrier bar; bar.bar = (unsigned*)(ctl + CW_BAR) + args.li * XCD_BAR_WORDS; bar.x = 0; bar.st = nullptr;
    const int lo = args.ph_lo, hi = args.ph_hi;
    if (hi - lo > 1) bar = xcd_barrier_post((unsigned*)(ctl + CW_BAR) + args.li * XCD_BAR_WORDS, MISC + 8);
#define IN(k) (lo <= (k) && (k) < hi)
#define SEAM(k) do { if (IN(k) && IN((k) + 1)) xcd_barrier(bar); } while (0)

#ifndef SKIP0
    if (IN(0)) { p0_prologue(F); SEAM(0); }
#endif
    if (IN(1)) { norm_rows(F, F.in[0], F.in[2], MROWS, F.in[6], 0, DM, (bf16*)(F.ws + WS_HX)); SEAM(1); }
    if (IN(2)) {
        pg8::Gemm g{(const bf16*)(F.ws + WS_HX), (const bf16*)(F.ws + WS_WIN), MROWS, DIN, DM}; pg8::InProjOrder S; S.init(F.G, (int)blockIdx.x);
        pg8::EpiInProj E{(bf16*)(F.ws + WS_PB), (bf16*)(F.ws + WS_QF), (bf16*)(F.ws + WS_KF), (bf16*)(F.ws + WS_VF)};
        pg8::gemm_phase<pg8::EpiInProj, pg8::InProjOrder, true, true>(F.lds + RING_OFF, g, S, E);
        SEAM(2);
    }
    if (IN(3)) {
#ifndef SKIP3A
#ifdef ATT_NAIVE
 attn_naive(F);
#else
 attn_mfma(F);
#endif
#endif
#ifndef SKIP3B
#ifdef POOL_NAIVE
 pool_naive(F);
#else
 pool_mfma(F);
#endif
#endif
 SEAM(3); }
    if (IN(4)) {
        pg8::Gemm g{(const bf16*)(F.ws + WS_MIX), (const bf16*)(F.ws + WS_WOUT), NTOK, DM, DM}; pg8::StaticOrder S; S.init(NTOK, DM, F.G, (int)blockIdx.x);
        pg8::EpiX1 E{F.in[0], (const float*)(F.ws + WS_MOD), F.out};
        pg8::gemm_phase<pg8::EpiX1, pg8::StaticOrder, true, true>(F.lds + RING_OFF, g, S, E);
        SEAM(4);
    }
    if (IN(5)) { norm_rows(F, F.out, F.out, NTOK, F.in[12], 3 * DM, 4 * DM, (bf16*)(F.ws + WS_HX)); SEAM(5); }
    if (IN(6)) {
        pg8::Gemm g{(const bf16*)(F.ws + WS_HX), (const bf16*)(F.ws + WS_WQ), NTOK, 2048, DM}; pg8::StaticOrder S; S.init(NTOK, 2048, F.G, (int)blockIdx.x);
#ifdef TOPK_NAIVE
        pg8::EpiBf16 E{(bf16*)(F.ws + WS_ZX), 2048};
        pg8::gemm_phase<pg8::EpiBf16, pg8::StaticOrder, true, true>(F.lds + RING_OFF, g, S, E);
#else
        pg8::EpiQP E{(bf16*)(F.ws + WS_ZX)};
        pg8::gemm_phase<pg8::EpiQP, pg8::StaticOrder, true, true>(F.lds + RING_OFF, g, S, E);
#endif
        SEAM(6);
    }
    if (IN(7)) {
        for (int tile = F.vcu; tile < NTOK / 128; tile += F.G) {
            const int tok0 = tile * 128;
#ifndef SKIP7A
#ifdef TOPK_NAIVE
            peer_topk_naive(F, tok0);
#else
            peer_topk_mfma(F, tile);
#endif
#endif
#ifndef SKIP7B
            for (int i = F.wave; i < 128; i += 8) peer_gather_token(F, tok0 + i);
#endif
        }
    }
#undef IN
#undef SEAM
}

extern "C" void kernel_launch(void* const* d_in, const int* in_sizes, int n_in, void* d_out, int out_size, void* d_ws, size_t ws_size, hipStream_t stream) {
    static int grid = 0;
    if (grid == 0) {
        if (n_in != 18 || in_sizes[0] != NTOK * DM || out_size != NTOK * DM || ws_size < WS_END) { fprintf(stderr, "kernel_launch: unexpected shapes / workspace (n_in %d, ws %zu); nothing launched\n", n_in, ws_size); grid = -1; return; }
        int dev = 0, cus = 0;
        if (hipGetDevice(&dev) != hipSuccess || hipDeviceGetAttribute(&cus, hipDeviceAttributeMultiprocessorCount, dev) != hipSuccess) { grid = -1; return; }
        if (hipFuncSetAttribute((const void*)mk_fwd, hipFuncAttributeMaxDynamicSharedMemorySize, LDS_BYTES) != hipSuccess) { fprintf(stderr, "kernel_launch: hipFuncSetAttribute failed\n"); grid = -1; return; }
        int per_cu = 0;
        if (hipOccupancyMaxActiveBlocksPerMultiprocessor(&per_cu, (const void*)mk_fwd, NWAVES * 64, LDS_BYTES) != hipSuccess || per_cu < 1) fprintf(stderr, "kernel_launch: note: occupancy query reports %d blocks per CU\n", per_cu);
        (void)hipGetLastError();
        grid = cus;
    }
    if (grid < 0) return;
    (void)hipMemsetAsync((char*)d_ws + WS_CTL, 0, CTL_ZERO_BYTES, stream);
    Args a{};
    for (int i = 0; i < 18; ++i) a.in[i] = (const float*)d_in[i];
    a.out = (float*)d_out; a.ws = (unsigned char*)d_ws;
    for (int li = 0; li < N_LAUNCHES; ++li) {
        if (N_LAUNCHES == 1) { a.ph_lo = 0; a.ph_hi = NPHASE; } else { a.ph_lo = li; a.ph_hi = li + 1; }
        a.li = (N_LAUNCHES == 1) ? 0 : 0;
        hipLaunchKernelGGL(mk_fwd, dim3(grid), dim3(NWAVES * 64), LDS_BYTES, stream, a);
    }
}
```

```cpp
#include <hip/hip_runtime.h>
#include <cstdio>
#include <cstdint>
namespace pg8 {
#define PG8_LAS __attribute__((address_space(3)))
typedef unsigned short bf16_t;
typedef short bf16x8 __attribute__((ext_vector_type(8)));
typedef float f32x4 __attribute__((ext_vector_type(4)));
typedef unsigned u32x4 __attribute__((ext_vector_type(4)));
constexpr int BM = 256, BK = 64, HALF = 128, HTB = HALF * BK * 2  , STAGE_BYTES = 8 * HTB, NXCD = 8, WGM = 8;

__host__ __device__ __forceinline__ int lds_byte(int r, int c) { const int st = (r >> 4) * 2 + (c >> 5), rr = r & 15, cc = c & 31, ob = rr * 64 + cc * 2; return st * 1024 + (ob ^ (((ob >> 9) & 1) << 5)); }
__host__ __device__ __forceinline__ void stage_rc(int b, int& R, int& C) { const int st = b / 1024, sb = b % 1024, swz = sb ^ (((sb >> 9) & 1) << 5); R = (st >> 1) * 16 + swz / 64; C = (st & 1) * 32 + (swz % 64) / 2; }
__host__ __device__ __forceinline__ int perm32(int rho) { const int n = rho >> 4, i = rho & 15; return 8 * (i >> 2) + 4 * n + (i & 3); }

struct Unit { int pm, pn; };
struct Gemm { const bf16_t* A; const bf16_t* Bt; int M, N, K; };
struct StaticOrder {
    int nM, nN, nwg, G, c;
    __host__ __device__ void init(int M, int N, int G_, int c_) { nM = M / BM; nN = N / BM; nwg = nM * nN; G = G_; c = c_; }
    __host__ __device__ bool next(int i, Unit& u) const {
        const long L = (long)i * G + c; if (L >= nwg) return false;
        int wgid = (int)L; { const int q = nwg / NXCD, r = nwg % NXCD, xcd = wgid % NXCD, off = wgid / NXCD; wgid = (xcd < r ? xcd * (q + 1) : r * (q + 1) + (xcd - r) * q) + off; }
        const int nig = WGM * nN, gid = wgid / nig, fm = gid * WGM, gsz = (nM - fm) < WGM ? (nM - fm) : WGM;
        u.pm = fm + ((wgid % nig) % gsz); u.pn = (wgid % nig) / gsz; return true;
    }
    __device__ __forceinline__ void a_ready(const Unit&) const {}
    __device__ __forceinline__ void done(const Unit&) const {}
    __device__ __forceinline__ const char* pa(const Gemm& g, const Unit& u) const { return (const char*)g.A + (size_t)u.pm * ((size_t)BM * g.K * 2); }
    __device__ __forceinline__ const char* pb(const Gemm& g, const Unit& u) const { return (const char*)g.Bt + (size_t)u.pn * ((size_t)BM * g.K * 2); }
};
struct InProjOrder {
    StaticOrder so;
    __host__ __device__ void init(int G_, int c_) { so.init(136 * BM, 8 * BM, G_, c_); }
    __host__ __device__ bool next(int i, Unit& u) const { int cnt = -1; for (int j = 0; ; ++j) { if (!so.next(j, u)) return false; if (!(u.pm >= 128 && u.pn < 4)) { if (++cnt == i) return true; } } }
    __device__ __forceinline__ void a_ready(const Unit&) const {}
    __device__ __forceinline__ void done(const Unit&) const {}
    __device__ __forceinline__ const char* pa(const Gemm& g, const Unit& u) const { return u.pn < 6 ? (const char*)g.A + (size_t)u.pm * ((size_t)BM * g.K * 2) : (const char*)g.Bt + (size_t)u.pn * ((size_t)BM * g.K * 2); }
    __device__ __forceinline__ const char* pb(const Gemm& g, const Unit& u) const { return u.pn < 6 ? (const char*)g.Bt + (size_t)u.pn * ((size_t)BM * g.K * 2) : (const char*)g.A + (size_t)u.pm * ((size_t)BM * g.K * 2); }
};

__device__ __forceinline__ unsigned cvt_pk_bf16(float lo, float hi) { unsigned r; asm volatile("v_cvt_pk_bf16_f32 %0, %1, %2" : "=v"(r) : "v"(lo), "v"(hi)); return r; }
struct EpiBf16 {
    static constexpr bool PERM = true, AFTER_DRAIN = false;
    bf16_t* O; int ldc;
    __device__ __forceinline__ void operator()(const f32x4 (&acc)[2][2][4][2], const Unit& u, int wr, int wc, int fr, int fq) const {
        const int row0 = u.pm * BM + wr * 64 + fr, col0 = u.pn * BM + wc * 32 + 8 * fq;
#pragma unroll
        for (int ai = 0; ai < 2; ++ai)
#pragma unroll
            for (int m = 0; m < 4; ++m) { bf16_t* rowp = O + (size_t)(row0 + ai * HALF + m * 16) * ldc + col0;
#pragma unroll
                for (int bj = 0; bj < 2; ++bj) { const f32x4 v0 = acc[ai][bj][m][0], v1 = acc[ai][bj][m][1];
                    u32x4 w; w.x = cvt_pk_bf16(v0[0], v0[1]); w.y = cvt_pk_bf16(v0[2], v0[3]); w.z = cvt_pk_bf16(v1[0], v1[1]); w.w = cvt_pk_bf16(v1[2], v1[3]);
                    *(u32x4*)(rowp + bj * HALF) = w; } }
    }
};
struct EpiX1 {
    static constexpr bool PERM = true, AFTER_DRAIN = false;
    const float* x; const float* mod; float* out;
    __device__ __forceinline__ void operator()(const f32x4 (&acc)[2][2][4][2], const Unit& u, int wr, int wc, int fr, int fq) const {
        const int row0 = u.pm * BM + wr * 64 + fr, col0 = u.pn * BM + wc * 32 + 8 * fq;
        const float* g1 = mod + (size_t)((u.pm * BM) >> 12) * 6144 + 2048 + col0;
        f32x4 gv[2][2];
#pragma unroll
        for (int bj = 0; bj < 2; ++bj)
#pragma unroll
            for (int n = 0; n < 2; ++n) gv[bj][n] = *(const f32x4*)(g1 + bj * HALF + 4 * n);
#pragma unroll
        for (int ai = 0; ai < 2; ++ai)
#pragma unroll
            for (int m = 0; m < 4; ++m) { const size_t off = (size_t)(row0 + ai * HALF + m * 16) * 1024 + col0;
#pragma unroll
                for (int bj = 0; bj < 2; ++bj)
#pragma unroll
                    for (int n = 0; n < 2; ++n) { const f32x4 xv = *(const f32x4*)(x + off + bj * HALF + 4 * n);
                        *(f32x4*)(out + off + bj * HALF + 4 * n) = xv + gv[bj][n] * acc[ai][bj][m][n]; } }
    }
};

struct EpiInProj {
    static constexpr bool PERM = true, AFTER_DRAIN = false;
    bf16_t *PB, *QF, *KF, *VF;
    __device__ __forceinline__ void operator()(const f32x4 (&acc)[2][2][4][2], const Unit& u, int wr, int wc, int fr, int fq) const {
        if (u.pn < 6) {
            const int sec = u.pn >> 1, cbase = (u.pn & 1) * 256 + wc * 32 + 8 * fq;
#pragma unroll
            for (int ai = 0; ai < 2; ++ai)
#pragma unroll
                for (int m = 0; m < 4; ++m) { const int T = u.pm * BM + ai * HALF + wr * 64 + m * 16 + fr;
                    int bb, blk; if (T < 32768) { bb = T >> 12; blk = (T & 4095) >> 5; } else { const int cc = T - 32768; bb = cc >> 8; blk = 128 + ((cc & 255) >> 5); }
                    const int tl = T & 31;
#pragma unroll
                    for (int bj = 0; bj < 2; ++bj) { const int c = cbase + HALF * bj; const f32x4 v0 = acc[ai][bj][m][0], v1 = acc[ai][bj][m][1];
                        u32x4 w; w.x = cvt_pk_bf16(v0[0], v0[1]); w.y = cvt_pk_bf16(v0[2], v0[3]); w.z = cvt_pk_bf16(v1[0], v1[1]); w.w = cvt_pk_bf16(v1[2], v1[3]);
                        if (sec == 0) *(u32x4*)(PB + (size_t)T * 512 + c) = w;
                        else { const int h = c >> 6, d0 = c & 63, fo = ((d0 >> 4) * 64 + ((d0 >> 3) & 1) * 32 + tl) * 8;
                            bf16_t* dst = (sec == 1) ? QF + (size_t)((bb * 8 + h) * 128 + blk) * 2048 + fo : KF + (size_t)((bb * 8 + h) * 136 + blk) * 2048 + fo;
                            *(u32x4*)dst = w; } } }
        } else {
            typedef unsigned u32x2 __attribute__((ext_vector_type(2)));
#pragma unroll
            for (int ai = 0; ai < 2; ++ai)
#pragma unroll
                for (int m = 0; m < 4; ++m) { const int vc = (u.pn - 6) * BM + ai * HALF + wr * 64 + m * 16 + fr, h = vc >> 6, dt = (vc >> 5) & 1, dl = vc & 31;
#pragma unroll
                    for (int bj = 0; bj < 2; ++bj) { const int T0 = u.pm * BM + bj * HALF + wc * 32 + 8 * fq;
                        int bb, blk; if (T0 < 32768) { bb = T0 >> 12; blk = (T0 & 4095) >> 5; } else { const int cc = T0 - 32768; bb = cc >> 8; blk = 128 + ((cc & 255) >> 5); }
                        bf16_t* base = VF + ((size_t)(((bb * 8 + h) * 136 + blk) * 2 + dt) * 2 + (fq >> 1)) * 512 + 4 * (fq & 1);
                        const f32x4 v0 = acc[ai][bj][m][0], v1 = acc[ai][bj][m][1];
                        u32x2 w0, w1; w0.x = cvt_pk_bf16(v0[0], v0[1]); w0.y = cvt_pk_bf16(v0[2], v0[3]); w1.x = cvt_pk_bf16(v1[0], v1[1]); w1.y = cvt_pk_bf16(v1[2], v1[3]);
                        *(u32x2*)(base + dl * 8) = w0; *(u32x2*)(base + (32 + dl) * 8) = w1; } }
        }
    }
};

struct EpiQP {
    static constexpr bool PERM = true, AFTER_DRAIN = false;
    bf16_t* QP;
    __device__ __forceinline__ void operator()(const f32x4 (&acc)[2][2][4][2], const Unit& u, int wr, int wc, int fr, int fq) const {
#pragma unroll
        for (int ai = 0; ai < 2; ++ai)
#pragma unroll
            for (int m = 0; m < 4; ++m) { const int T = u.pm * BM + ai * HALF + wr * 64 + m * 16 + fr;
#pragma unroll
                for (int bj = 0; bj < 2; ++bj) { const int hp = 2 * u.pn + bj, ks = 2 * wc + (fq >> 1), hh = fq & 1;
                    const f32x4 v0 = acc[ai][bj][m][0], v1 = acc[ai][bj][m][1];
                    u32x4 w; w.x = cvt_pk_bf16(v0[0], v0[1]); w.y = cvt_pk_bf16(v0[2], v0[3]); w.z = cvt_pk_bf16(v1[0], v1[1]); w.w = cvt_pk_bf16(v1[2], v1[3]);
                    *(u32x4*)(QP + ((size_t)(T >> 5) * 16 + hp) * 4096 + (ks * 64 + hh * 32 + (T & 31)) * 8) = w; } }
    }
};
template <class Epi, class Sched, bool ALIGN_EPI = false, bool SP2 = false>
__device__ __forceinline__ void gemm_phase(PG8_LAS unsigned char* lds, const Gemm g, const Sched& S, const Epi& E) {
    const int tid = threadIdx.x, wid = __builtin_amdgcn_readfirstlane(tid >> 6), lane = tid & 63, wr = wid >> 2, wc = wid & 3, fr = lane & 15, fq = lane >> 4;
    const int K = g.K, nt = K / BK;
    unsigned voffA[2], voffB[2];
#pragma unroll
    for (int i = 0; i < 2; ++i) { int R, C; stage_rc(tid * 16 + i * 8192, R, C); const int Rb = Epi::PERM ? ((R & ~31) + perm32(R & 31)) : R;
        voffA[i] = (unsigned)(R * K + C) * 2u; voffB[i] = (unsigned)(Rb * K + C) * 2u; }
    const size_t kstep = (size_t)(BK * 2);
    const size_t hstep = (size_t)HALF * K * 2;
    const size_t tstep = 2 * hstep;
    const unsigned ldsw = (unsigned)wid * 1024u;
    const int aoff = lds_byte(wr * 64 + fr, fq * 8), boff = lds_byte(wc * 32 + fr, fq * 8);
#define PG8_SA(b, h) (((b) * 2 + (h)) * HTB)
#define PG8_SB(b, h) ((4 + (b) * 2 + (h)) * HTB)
#define PG8_STAGE(bufoff, gbase, voff) do { _Pragma("unroll") for (int _i = 0; _i < 2; ++_i) \
        __builtin_amdgcn_global_load_lds((const unsigned*)((const char*)(gbase) + (voff)[_i]), (PG8_LAS unsigned*)(lds + (bufoff) + ldsw + _i * 8192), 16, 0, 0); } while (0)
#define PG8_LDA(dst, b, h) do { _Pragma("unroll") for (int m = 0; m < 4; ++m) _Pragma("unroll") for (int k = 0; k < 2; ++k) dst[m][k] = *(const PG8_LAS bf16x8*)(lds + PG8_SA(b, h) + aoff + m * 2048 + k * 1024); } while (0)
#define PG8_LDB(dst, b, h) do { _Pragma("unroll") for (int n = 0; n < 2; ++n) _Pragma("unroll") for (int k = 0; k < 2; ++k) dst[n][k] = *(const PG8_LAS bf16x8*)(lds + PG8_SB(b, h) + boff + n * 2048 + k * 1024); } while (0)
#define PG8_MMA(ai, bj, At, Bt) do { __builtin_amdgcn_s_setprio(1); _Pragma("unroll") for (int m = 0; m < 4; ++m) _Pragma("unroll") for (int n = 0; n < 2; ++n) _Pragma("unroll") for (int k = 0; k < 2; ++k) \
        acc[ai][bj][m][n] = __builtin_amdgcn_mfma_f32_16x16x32_bf16(Bt[n][k], At[m][k], acc[ai][bj][m][n], 0, 0, 0); __builtin_amdgcn_s_setprio(0); } while (0)
#define PG8_WAIT_V(n) asm volatile("s_waitcnt vmcnt(" #n ")" ::: "memory")
#define PG8_WAIT_L(n) asm volatile("s_waitcnt lgkmcnt(" #n ")" ::: "memory")
#define PG8_BAR __builtin_amdgcn_s_barrier()
#define PG8_SCHED __builtin_amdgcn_sched_barrier(0)
    Unit cur, nxt; int ui = 0;
    if (!S.next(0, cur)) return;
    f32x4 acc[2][2][4][2];
#pragma unroll
    for (int a = 0; a < 2; ++a)
#pragma unroll
        for (int b = 0; b < 2; ++b)
#pragma unroll
            for (int m = 0; m < 4; ++m)
#pragma unroll
                for (int n = 0; n < 2; ++n) acc[a][b][m][n] = (f32x4){0.f, 0.f, 0.f, 0.f};
    bf16x8 At[4][2], B0[2][2], B1[2][2];
    const char* cA = S.pa(g, cur); const char* cB = S.pb(g, cur);
    S.a_ready(cur);
    if constexpr (SP2) {
        PG8_STAGE(PG8_SB(0, 0), cB, voffB); PG8_STAGE(PG8_SB(0, 1), cB + hstep, voffB); PG8_STAGE(PG8_SA(0, 0), cA, voffA); PG8_STAGE(PG8_SA(0, 1), cA + hstep, voffA);
        if (wr == 1) PG8_BAR;
        PG8_WAIT_V(2); PG8_BAR;
        PG8_STAGE(PG8_SB(1, 0), cB + kstep, voffB); PG8_STAGE(PG8_SA(1, 0), cA + kstep, voffA); PG8_STAGE(PG8_SB(1, 1), cB + hstep + kstep, voffB);
        PG8_WAIT_V(6); PG8_BAR;
    } else {
        PG8_STAGE(PG8_SB(0, 0), cB, voffB); PG8_STAGE(PG8_SA(0, 0), cA, voffA); PG8_STAGE(PG8_SB(0, 1), cB + hstep, voffB); PG8_STAGE(PG8_SA(0, 1), cA + hstep, voffA);
        if (wr == 1) PG8_BAR;
        PG8_WAIT_V(4); PG8_BAR;
        PG8_STAGE(PG8_SB(1, 0), cB + kstep, voffB); PG8_STAGE(PG8_SA(1, 0), cA + kstep, voffA); PG8_STAGE(PG8_SB(1, 1), cB + hstep + kstep, voffB);
        PG8_WAIT_V(6); PG8_BAR;
    }
    for (;;) {
        const bool has_next = S.next(ui + 1, nxt);
        const char* nA = has_next ? S.pa(g, nxt) : cA; const char* nB = has_next ? S.pb(g, nxt) : cB;
        for (int t = 0; t < nt; t += 2) {
            const bool last = (t == nt - 2);
            const char* a1 = cA + (size_t)(t + 1) * kstep;
            const char* a2 = last ? nA : cA + (size_t)(t + 2) * kstep; const char* b2 = last ? nB : cB + (size_t)(t + 2) * kstep;
            const char* a3 = a2 + kstep; const char* b3 = b2 + kstep;
            if (last && has_next) S.a_ready(nxt);
            if constexpr (SP2) {
            PG8_LDB(B0, 0, 0); PG8_LDB(B1, 0, 1); PG8_SCHED; PG8_LDA(At, 0, 0); PG8_STAGE(PG8_SA(1, 1), a1 + hstep, voffA);
            PG8_WAIT_V(8); PG8_WAIT_L(0); PG8_BAR; PG8_MMA(0, 0, At, B0); PG8_MMA(0, 1, At, B1); PG8_BAR; PG8_SCHED;
            PG8_LDA(At, 0, 1); PG8_STAGE(PG8_SB(0, 0), b2, voffB); PG8_STAGE(PG8_SB(0, 1), b2 + hstep, voffB); PG8_STAGE(PG8_SA(0, 0), a2, voffA);
            PG8_WAIT_V(8); PG8_WAIT_L(0); PG8_BAR; PG8_MMA(1, 0, At, B0); PG8_MMA(1, 1, At, B1); PG8_BAR; PG8_SCHED;
            PG8_LDB(B0, 1, 0); PG8_LDB(B1, 1, 1); PG8_SCHED; PG8_LDA(At, 1, 0); PG8_STAGE(PG8_SA(0, 1), a2 + hstep, voffA);
            PG8_WAIT_V(8); PG8_WAIT_L(0); PG8_BAR; PG8_MMA(0, 0, At, B0); PG8_MMA(0, 1, At, B1); PG8_BAR; PG8_SCHED;
            PG8_LDA(At, 1, 1); PG8_STAGE(PG8_SB(1, 0), b3, voffB); PG8_STAGE(PG8_SB(1, 1), b3 + hstep, voffB); PG8_STAGE(PG8_SA(1, 0), a3, voffA);
            PG8_WAIT_V(8); PG8_WAIT_L(0); PG8_BAR; PG8_MMA(1, 0, At, B0); PG8_MMA(1, 1, At, B1); PG8_BAR; PG8_SCHED;
            } else {
            PG8_LDB(B0, 0, 0); PG8_SCHED; PG8_LDA(At, 0, 0); PG8_STAGE(PG8_SA(1, 1), a1 + hstep, voffA);
            PG8_WAIT_L(8); PG8_BAR; PG8_WAIT_L(0); PG8_MMA(0, 0, At, B0); PG8_BAR; PG8_SCHED;
            PG8_LDB(B1, 0, 1); PG8_STAGE(PG8_SB(0, 0), b2, voffB);
            PG8_BAR; PG8_WAIT_L(0); PG8_MMA(0, 1, At, B1); PG8_BAR;
            PG8_LDA(At, 0, 1); PG8_STAGE(PG8_SA(0, 0), a2, voffA);
            PG8_BAR; PG8_WAIT_L(0); PG8_MMA(1, 0, At, B0); PG8_BAR; PG8_SCHED;
            PG8_STAGE(PG8_SB(0, 1), b2 + hstep, voffB);
            PG8_WAIT_V(6); PG8_BAR; PG8_MMA(1, 1, At, B1); PG8_BAR;
            PG8_LDB(B0, 1, 0); PG8_SCHED; PG8_LDA(At, 1, 0); PG8_STAGE(PG8_SA(0, 1), a2 + hstep, voffA);
            PG8_WAIT_L(8); PG8_BAR; PG8_WAIT_L(0); PG8_MMA(0, 0, At, B0); PG8_BAR; PG8_SCHED;
            PG8_LDB(B1, 1, 1); PG8_STAGE(PG8_SB(1, 0), b3, voffB);
            PG8_BAR; PG8_WAIT_L(0); PG8_MMA(0, 1, At, B1); PG8_BAR;
            PG8_LDA(At, 1, 1); PG8_STAGE(PG8_SA(1, 0), a3, voffA);
            PG8_BAR; PG8_WAIT_L(0); PG8_MMA(1, 0, At, B0); PG8_BAR; PG8_SCHED;
            PG8_STAGE(PG8_SB(1, 1), b3 + hstep, voffB);
            PG8_WAIT_V(6); PG8_BAR; PG8_MMA(1, 1, At, B1); PG8_BAR;
            }
        }
        if constexpr (ALIGN_EPI) { if (wr == 0) PG8_BAR; }
        if constexpr (!Epi::AFTER_DRAIN) { E(acc, cur, wr, wc, fr, fq); S.done(cur); }
        if (!has_next) break;
#pragma unroll
        for (int a = 0; a < 2; ++a)
#pragma unroll
            for (int b = 0; b < 2; ++b)
#pragma unroll
                for (int m = 0; m < 4; ++m)
#pragma unroll
                    for (int n = 0; n < 2; ++n) acc[a][b][m][n] = (f32x4){0.f, 0.f, 0.f, 0.f};
        cur = nxt; cA = nA; cB = nB; ++ui;
        if constexpr (ALIGN_EPI) { if (wr == 1) PG8_BAR; }
    }
    PG8_WAIT_V(0);
    if constexpr (!ALIGN_EPI) { if (wr == 0) PG8_BAR; }
    PG8_BAR;
    if constexpr (Epi::AFTER_DRAIN) { E.fused(acc, cur, wr, wc, fr, fq, lds, wid, lane); S.done(cur); }
#undef PG8_SA
#undef PG8_SB
#undef PG8_STAGE
#undef PG8_LDA
#undef PG8_LDB
#undef PG8_MMA
#undef PG8_WAIT_V
#undef PG8_WAIT_L
#undef PG8_BAR
#undef PG8_SCHED
}
}

constexpr int DM = 1024, NBATCH = 8, SEQ = 4096, NTOK = NBATCH * SEQ, CTXL = 256, NCTX = NBATCH * CTXL, MROWS = NTOK + NCTX;
constexpr int DIN = 2048, NHEAD = 8, HD = 64, GRIDW = 64, NMOD = 6 * DM;
constexpr int NEXP = 16384;
constexpr float EPS = 1e-6f;
constexpr int NWAVES = 8;
constexpr int NPHASE = 8;
constexpr float U_SCALE = 64.f, V_SCALE = 4.f;
#ifndef GATHER_NT
#define GATHER_NT 4
#endif
#ifndef MK_N_LAUNCHES
#define MK_N_LAUNCHES 1
#endif
constexpr int N_LAUNCHES = MK_N_LAUNCHES;

constexpr size_t MiB = 1u << 20;
constexpr size_t WS_CTL = 0, CTL_ZERO_BYTES = 64 * 1024;
constexpr size_t WS_WIN = 2 * MiB, WS_WOUT = 6 * MiB, WS_WQ = 8 * MiB, WS_KEYS = 12 * MiB, WS_POOLW = 12 * MiB + 512 * 1024, WS_MOD = 13 * MiB;
constexpr size_t WS_U = 14 * MiB, WS_V = 46 * MiB;
constexpr size_t WS_HX = 78 * MiB;
constexpr size_t WS_ZX = 146 * MiB;
constexpr size_t WS_PB = 146 * MiB, WS_QF = 178 * MiB, WS_KF = 210 * MiB, WS_VF = 244 * MiB;
constexpr size_t WS_MIX = 282 * MiB;
constexpr size_t WS_EXP = 346 * MiB, WS_GATE = 362 * MiB;
constexpr size_t WS_POOLED = 378 * MiB;
constexpr size_t WS_LISTS = 410 * MiB;
constexpr size_t WS_END = 442 * MiB;
constexpr int CW_BAR = 4096;

constexpr int RING_OFF = 0, RING_BYTES = 131072;
constexpr int LDSCTL_OFF = RING_BYTES, MISC_OFF = LDSCTL_OFF + 320;
constexpr int LDS_BYTES = 147456;

#define GAS __attribute__((address_space(1)))
#define LAS __attribute__((address_space(3)))
#define DI __device__ __forceinline__
typedef unsigned short bf16;
typedef unsigned v4u __attribute__((ext_vector_type(4)));
typedef unsigned v2u __attribute__((ext_vector_type(2)));
typedef float f32x4 __attribute__((ext_vector_type(4)));
typedef float f32x2 __attribute__((ext_vector_type(2)));
typedef GAS unsigned gu32;
#define RLX_AGENT __ATOMIC_RELAXED, __HIP_MEMORY_SCOPE_AGENT
#define LDS_WAIT() asm volatile("s_waitcnt lgkmcnt(0)" ::: "memory")
#define VM_WAIT() asm volatile("s_waitcnt vmcnt(0)" ::: "memory")
DI unsigned f2bf(float f) { unsigned u = __builtin_bit_cast(unsigned, f); return (u + 0x7fffu + ((u >> 16) & 1u)) >> 16; }
DI unsigned pk2(float lo, float hi) { return f2bf(lo) | (f2bf(hi) << 16); }
DI float bflo(unsigned u) { return __uint_as_float(u << 16); }
DI float bfhi(unsigned u) { return __uint_as_float(u & 0xffff0000u); }
DI float wave_sum(float v) {
#pragma unroll
    for (int o = 1; o < 64; o <<= 1) v += __shfl_xor(v, o);
    return v;
}

#define XB_TMO      128
#define XB_XCNT(j)  (256  + 64 * (j))
#define XB_XSUB(j)  (1280 + 64 * (j))
#define XB_XGEN(j)  (2304 + 64 * (j))
#define XB_TOP      3328
#define XB_TOPGEN   3392
#define XCD_BAR_WORDS 3456
#define XB_SPIN_CAP (1u << 18)

__device__ __forceinline__ unsigned xb_ld(unsigned* p)              { return __hip_atomic_load(p, __ATOMIC_RELAXED, __HIP_MEMORY_SCOPE_AGENT); }
__device__ __forceinline__ unsigned xb_add(unsigned* p, unsigned v) { return __hip_atomic_fetch_add(p, v, __ATOMIC_RELAXED, __HIP_MEMORY_SCOPE_AGENT); }
__device__ __forceinline__ unsigned xb_xcc_id() { return (unsigned)__builtin_amdgcn_s_getreg((3 << 11) | 20) & 0xFu; }
#define XB_SPIN(cond, bar) do { unsigned _sp = 0; while (cond) { __builtin_amdgcn_s_sleep(1); \
    if ((++_sp & 255u) == 0u) { if (xb_ld(&(bar)[XB_TMO])) break; if (_sp > XB_SPIN_CAP) { atomicAdd(&(bar)[XB_TMO], 1u); break; } } } } while (0)

struct XcdBarrier {
    unsigned* bar; unsigned x;
    volatile LAS unsigned* st;
};

__device__ __forceinline__ XcdBarrier xcd_barrier_post(unsigned* bar, volatile LAS unsigned* st) {
    XcdBarrier b; b.bar = bar; b.x = xb_xcc_id(); b.st = st;
    if (threadIdx.x == 0) (void)xb_add(&bar[XB_XCNT(b.x)], 1u);
    return b;
}
__device__ __forceinline__ void xcd_barrier_complete(unsigned* bar, unsigned x, unsigned& nloc, unsigned& nx) {
    const unsigned G = gridDim.x * gridDim.y * gridDim.z;
    unsigned sum, cnt, mine, sp = 0u;
    for (;;) {
        sum = 0u; cnt = 0u; mine = 0u;
#pragma unroll
        for (unsigned j = 0; j < 16; ++j) { const unsigned c = xb_ld(&bar[XB_XCNT(j)]); sum += c; cnt += (c > 0u) ? 1u : 0u; mine = (j == x) ? c : mine; }
        if (sum == G) break;
        __builtin_amdgcn_s_sleep(1);
        if ((++sp & 255u) == 0u) { if (xb_ld(&bar[XB_TMO])) break; if (sp > XB_SPIN_CAP) { atomicAdd(&bar[XB_TMO], 1u); break; } }
    }
    nloc = mine > 0u ? mine : 1u; nx = cnt > 0u ? cnt : 1u;
}

__device__ __forceinline__ void xcd_barrier(const XcdBarrier& b) {
    asm volatile("s_waitcnt vmcnt(0)" ::: "memory");
    __syncthreads();
    if (threadIdx.x == 0) {
        unsigned* bar = b.bar;
        __builtin_amdgcn_s_waitcnt(0);
        unsigned nloc = b.st[0], nx = b.st[1];
        if (nloc == 0u) { xcd_barrier_complete(bar, b.x, nloc, nx); b.st[0] = nloc; b.st[1] = nx; }
        const unsigned old = xb_add(&bar[XB_XSUB(b.x)], 1u);
        const unsigned gen = old / nloc;
        if (old + 1u == (gen + 1u) * nloc) {
            __builtin_amdgcn_fence(__ATOMIC_RELEASE, "agent");
            asm volatile("s_waitcnt vmcnt(0)" ::: "memory");
            const unsigned og = xb_add(&bar[XB_TOP], 1u);
            const unsigned tg = og / nx;
            if (og + 1u == (tg + 1u) * nx) xb_add(&bar[XB_TOPGEN], 1u);
            else XB_SPIN(xb_ld(&bar[XB_TOPGEN]) == tg, bar);
            __builtin_amdgcn_fence(__ATOMIC_ACQUIRE, "agent");
            xb_add(&bar[XB_XGEN(b.x)], 1u);
            asm volatile("s_waitcnt vmcnt(0)" ::: "memory");
        } else {
            XB_SPIN(xb_ld(&bar[XB_XGEN(b.x)]) == gen, bar);
            __builtin_amdgcn_fence(__ATOMIC_ACQUIRE, "agent");
            asm volatile("s_waitcnt vmcnt(0)" ::: "memory");
        }
    }
    __syncthreads();
}


__device__ __forceinline__ void p0_transpose_item(const float* W, int K, int N, bf16* WT, int row_off, LAS float* scr, int item, int lane) {
    const int nblk = N / 32, kb = item / nblk, nb = item % nblk, k0 = 64 * kb, n0 = 32 * nb;
#pragma unroll 8
    for (int i = 0; i < 32; ++i) { const int kk = 2 * i + (lane >> 5); scr[kk * 33 + (lane & 31)] = W[(size_t)(k0 + kk) * N + n0 + (lane & 31)]; }
    LDS_WAIT(); asm volatile("" ::: "memory");
    const int c = lane & 7;
#pragma unroll
    for (int j = 0; j < 4; ++j) { const int n = (lane >> 3) + 8 * j; const LAS float* s = scr + (8 * c) * 33 + n;
        v4u o; o.x = pk2(s[0 * 33], s[1 * 33]); o.y = pk2(s[2 * 33], s[3 * 33]); o.z = pk2(s[4 * 33], s[5 * 33]); o.w = pk2(s[6 * 33], s[7 * 33]);
        *(GAS v4u*)(WT + (size_t)(row_off + n0 + n) * K + k0 + 8 * c) = o; }
    LDS_WAIT(); asm volatile("" ::: "memory");
}


struct Frame {
    LAS unsigned char* lds;
    int tid, lane, wave, vcu, G, gw, NGW;
    const float* in[18]; float* out; unsigned char* ws;
};

DI void p0_prologue(Frame& F) {
    const float* c = F.in[1]; const float* c_ctx = F.in[3]; const float* ada_w = F.in[4]; const float* ada_b = F.in[5];
    float* MOD = (float*)(F.ws + WS_MOD);
    LAS float* sl = (LAS float*)(F.lds + 73728);
    for (int i = F.tid; i < 9 * 1024; i += 512) { const int b = i >> 10, k = i & 1023; const float cv = (b < 8) ? c[b * 1024 + k] : c_ctx[k]; sl[i] = cv / (1.f + __expf(-cv)); }
    __syncthreads();
    for (int a = F.gw; a < NMOD / 16; a += F.NGW) {
        const int n = a * 16 + (F.lane & 15), kg = F.lane >> 4;
        float acc[9];
#pragma unroll
        for (int b = 0; b < 9; ++b) acc[b] = 0.f;
        const float* wp = ada_w + (size_t)(kg * 256) * NMOD + n; const LAS float* sp = sl + kg * 256;
#pragma unroll 8
        for (int i = 0; i < 256; ++i) { const float w = wp[(size_t)i * NMOD];
#pragma unroll
            for (int b = 0; b < 9; ++b) acc[b] += sp[b * 1024 + i] * w; }
#pragma unroll
        for (int b = 0; b < 9; ++b) { acc[b] += __shfl_xor(acc[b], 16); acc[b] += __shfl_xor(acc[b], 32); }
        if (kg == 0) { const float bb = ada_b[n];
#pragma unroll
            for (int b = 0; b < 9; ++b) MOD[b * NMOD + n] = acc[b] + bb; }
    }
    LAS float* scr = (LAS float*)(F.lds + F.wave * 9216);
    constexpr int I_IN = (DM / 64) * (DIN / 32), I_OUT = (DM / 64) * (DM / 32), I_Q = (DM / 64) * (2048 / 32), I_P = 4 * 8;
    for (int it = F.gw; it < I_IN + I_OUT + I_Q + I_P; it += F.NGW) {
        int r = it;
        if (r < I_IN) { p0_transpose_item(F.in[7], DM, DIN, (bf16*)(F.ws + WS_WIN), 0, scr, r, F.lane); continue; } r -= I_IN;
        if (r < I_OUT) { p0_transpose_item(F.in[11], DM, DM, (bf16*)(F.ws + WS_WOUT), 0, scr, r, F.lane); continue; } r -= I_OUT;
        if (r < I_Q) { p0_transpose_item(F.in[13], DM, 2048, (bf16*)(F.ws + WS_WQ), 0, scr, r, F.lane); continue; } r -= I_Q;
        { const int g = r >> 3; p0_transpose_item(F.in[8] + g * 16384, 128, 128, (bf16*)(F.ws + WS_POOLW) + g * 16384, 0, scr, r & 7, F.lane); }
    }
    { const float* kf = F.in[14]; bf16* kb = (bf16*)(F.ws + WS_KEYS);
      for (int it = F.gw; it < 16 * 32; it += F.NGW) { const int hp = it >> 5, nt = (it >> 3) & 3, ks = it & 7;
          const float* src = kf + ((size_t)hp * 128 + 32 * nt + (F.lane & 31)) * 128 + 16 * ks + 8 * (F.lane >> 5);
          const f32x4 a = *(const f32x4*)(src), b = *(const f32x4*)(src + 4);
          v4u w; w.x = pk2(a.x, a.y); w.y = pk2(a.z, a.w); w.z = pk2(b.x, b.y); w.w = pk2(b.z, b.w); *(v4u*)(kb + ((size_t)it * 64 + F.lane) * 8) = w; } }
    for (int it = F.gw; it < 2 * NEXP; it += F.NGW) {
        const bool isu = it < NEXP;
        const float* src = isu ? F.in[15] + (size_t)it * 1024 : F.in[16] + (size_t)(it - NEXP) * 1024;
        unsigned char* dst = isu ? F.ws + WS_U + (size_t)it * 1024 : F.ws + WS_V + (size_t)(it - NEXP) * 1024;
        const float sc = isu ? U_SCALE : V_SCALE;
        const f32x4* sp = (const f32x4*)(src + F.lane * 16);
        v4u w;
#pragma unroll
        for (int j = 0; j < 4; ++j) { const f32x4 a = sp[j] * sc; int pk = 0; pk = __builtin_amdgcn_cvt_pk_fp8_f32(a.x, a.y, pk, false); pk = __builtin_amdgcn_cvt_pk_fp8_f32(a.z, a.w, pk, true); w[j] = (unsigned)pk; }
        *(v4u*)(dst + F.lane * 16) = w;
    }
}

DI void norm_rows(Frame& F, const float* src_x, const float* src_ctx, int nrows, const float* gain, int shift_off, int scale_off, bf16* dst) {
    const float* MOD = (const float*)(F.ws + WS_MOD);
    for (int m = F.gw; m < nrows; m += F.NGW) {
        const float* xrow; int b;
        if (m < NTOK) { xrow = src_x + (size_t)m * DM; b = m >> 12; } else { xrow = src_ctx + (size_t)(m - NTOK) * DM; b = 8; }
        const f32x4* xr = (const f32x4*)xrow + F.lane;
        f32x4 v[4]; float s = 0.f;
#pragma unroll
        for (int j = 0; j < 4; ++j) { v[j] = xr[64 * j]; s += (v[j].x * v[j].x + v[j].y * v[j].y) + (v[j].z * v[j].z + v[j].w * v[j].w); }
        const float rinv = 1.0f / sqrtf(wave_sum(s) * (1.f / DM) + EPS);
        const f32x4* gp = (const f32x4*)gain + F.lane; const f32x4* shp = (const f32x4*)(MOD + b * NMOD + shift_off) + F.lane; const f32x4* scp = (const f32x4*)(MOD + b * NMOD + scale_off) + F.lane;
        unsigned long long* o8 = (unsigned long long*)(dst + (size_t)m * DM) + F.lane;
#pragma unroll
        for (int j = 0; j < 4; ++j) { const f32x4 g = gp[64 * j], sh = shp[64 * j], sc = scp[64 * j];
            const f32x4 y = (v[j] * rinv) * g * (sc + 1.0f) + sh;
            o8[64 * j] = (unsigned long long)pk2(y.x, y.y) | ((unsigned long long)pk2(y.z, y.w) << 32); }
    }
}

DI void attn_key(const bf16* KF, const bf16* VF, int blkbase, int kk, int dt, float bias, const float (&q)[64], float (&o)[32], float& m, float& l) {
    const bf16* kp = KF + (size_t)blkbase * 2048 + kk * 8;
    float acc = 0.f;
#pragma unroll
    for (int cc = 0; cc < 8; ++cc) { const v4u kv = *(const v4u*)(kp + ((cc >> 1) * 64 + (cc & 1) * 32) * 8);
        acc += q[8 * cc + 0] * bflo(kv.x) + q[8 * cc + 1] * bfhi(kv.x) + q[8 * cc + 2] * bflo(kv.y) + q[8 * cc + 3] * bfhi(kv.y)
             + q[8 * cc + 4] * bflo(kv.z) + q[8 * cc + 5] * bfhi(kv.z) + q[8 * cc + 6] * bflo(kv.w) + q[8 * cc + 7] * bfhi(kv.w); }
    const float s = acc + bias;
    const float mn = fmaxf(m, s), alpha = __expf(m - mn), p = __expf(s - mn);
    l = l * alpha + p; m = mn;
    const bf16* vp = VF + (size_t)blkbase * 2048 + dt * 1024 + (kk >> 4) * 512 + (((kk >> 2) & 1) * 32) * 8 + 4 * ((kk >> 3) & 1) + (kk & 3);
#pragma unroll
    for (int d = 0; d < 32; ++d) o[d] = o[d] * alpha + p * __uint_as_float((unsigned)vp[d * 8] << 16);
}
DI void attn_naive(Frame& F) {
    const bf16* QF = (const bf16*)(F.ws + WS_QF); const bf16* KF = (const bf16*)(F.ws + WS_KF); const bf16* VF = (const bf16*)(F.ws + WS_VF);
    bf16* MIX = (bf16*)(F.ws + WS_MIX); const float* rpb = F.in[10];
    for (int unit2 = F.gw; unit2 < 2 * NBATCH * NHEAD * 64; unit2 += F.NGW) {
        const int unit = unit2 >> 1, dt = unit2 & 1;
        const int r = unit & 63, h = (unit >> 6) & 7, b = unit >> 9, col = F.lane;
        const int tq = b * SEQ + r * GRIDW + col;
        float q[64], o[32];
        { const bf16* qp = QF + (size_t)((b * 8 + h) * 128 + 2 * r + (col >> 5)) * 2048 + (col & 31) * 8;
#pragma unroll
          for (int cc = 0; cc < 8; ++cc) { const v4u qv = *(const v4u*)(qp + ((cc >> 1) * 64 + (cc & 1) * 32) * 8);
              q[8 * cc + 0] = 0.125f * bflo(qv.x); q[8 * cc + 1] = 0.125f * bfhi(qv.x); q[8 * cc + 2] = 0.125f * bflo(qv.y); q[8 * cc + 3] = 0.125f * bfhi(qv.y);
              q[8 * cc + 4] = 0.125f * bflo(qv.z); q[8 * cc + 5] = 0.125f * bfhi(qv.z); q[8 * cc + 6] = 0.125f * bflo(qv.w); q[8 * cc + 7] = 0.125f * bfhi(qv.w); } }
#pragma unroll
        for (int d = 0; d < 32; ++d) o[d] = 0.f;
        float m = -1e30f, l = 0.f;
#pragma unroll 1
        for (int g = 0; g < CTXL; ++g) attn_key(KF, VF, (b * 8 + h) * 136 + 128 + (g >> 5), g & 31, dt, 0.f, q, o, m, l);
        const int r0 = min(max(r - 4, 0), 56), c0 = min(max(col - 8, 0), 48);
#pragma unroll 1
        for (int ij = 0; ij < 128; ++ij) { const int i = ij >> 4, j = ij & 15, kc = c0 + j;
            attn_key(KF, VF, (b * 8 + h) * 136 + 2 * (r0 + i) + (kc >> 5), kc & 31, dt, rpb[(h * 15 + (r0 + i - r + 7)) * 31 + (kc - col + 15)], q, o, m, l); }
        const float il = 1.0f / l;
        v4u* op = (v4u*)(MIX + (size_t)tq * DM + 512 + h * 64 + dt * 32);
#pragma unroll
        for (int cc = 0; cc < 4; ++cc) { v4u w; w.x = pk2(o[8 * cc] * il, o[8 * cc + 1] * il); w.y = pk2(o[8 * cc + 2] * il, o[8 * cc + 3] * il);
            w.z = pk2(o[8 * cc + 4] * il, o[8 * cc + 5] * il); w.w = pk2(o[8 * cc + 6] * il, o[8 * cc + 7] * il); op[cc] = w; }
    }
}
typedef float f32x16 __attribute__((ext_vector_type(16)));
typedef short s16x8 __attribute__((ext_vector_type(8)));
typedef __bf16 bf16x2_t __attribute__((ext_vector_type(2)));
#define MFMA32(a, b, c) __builtin_amdgcn_mfma_f32_32x32x16_bf16((a), (b), (c), 0, 0, 0)
DI unsigned cvtpk(float lo, float hi) { f32x2 v = {lo, hi}; bf16x2_t bb = __builtin_convertvector(v, bf16x2_t); return __builtin_bit_cast(unsigned, bb); }
DI float pairmax(float v) { auto rr = __builtin_amdgcn_permlane32_swap(__float_as_uint(v), __float_as_uint(v), false, false); return fmaxf(__uint_as_float(rr[0]), __uint_as_float(rr[1])); }
constexpr float LOG2E = 1.4426950408889634f, ATT_C2 = 0.125f * LOG2E, ATT_THR = 6.0f;
template <int QMASK, bool LOCAL>
DI void attn_tile(const s16x8 (&kf)[4], const s16x8 (&vf)[4], const LAS s16x8* qfp, f32x16 (&o)[2], float& m, float& l, const LAS float* brow, int djb, int lo) {
    f32x16 s; s16x8 qf[4];
#pragma unroll
    for (int ks = 0; ks < 4; ++ks) qf[ks] = qfp[ks * 64];
#pragma unroll
    for (int i = 0; i < 16; ++i) s[i] = 0.f;
#pragma unroll
    for (int ks = 0; ks < 4; ++ks) s = MFMA32(kf[ks], qf[ks], s);
    float sv[16]; float tmax = -INFINITY;
#pragma unroll
    for (int i = 0; i < 16; ++i) {
        if (!((QMASK >> (i >> 2)) & 1)) { sv[i] = -INFINITY; continue; }
        if (LOCAL) { const int dj = djb + (i & 3) + 8 * (i >> 2); const bool valid = (unsigned)(dj - lo) < 16u;
            const float x = s[i] * ATT_C2 + brow[valid ? dj : 0]; sv[i] = valid ? x : -INFINITY; }
        else sv[i] = s[i] * ATT_C2;
        tmax = fmaxf(tmax, sv[i]);
    }
    tmax = pairmax(tmax);
    if (__any(tmax > m + ATT_THR)) { const float mn = fmaxf(m, tmax), alpha = __builtin_amdgcn_exp2f(m - mn); o[0] *= alpha; o[1] *= alpha; l *= alpha; m = mn; }
    float p[16];
#pragma unroll
    for (int i = 0; i < 16; ++i) { if ((QMASK >> (i >> 2)) & 1) { p[i] = __builtin_amdgcn_exp2f(sv[i] - m); l += p[i]; } else p[i] = 0.f; }
#pragma unroll
    for (int s2 = 0; s2 < 2; ++s2) if (QMASK & (3 << (2 * s2))) {
        v4u pk; pk.x = cvtpk(p[8 * s2], p[8 * s2 + 1]); pk.y = cvtpk(p[8 * s2 + 2], p[8 * s2 + 3]); pk.z = cvtpk(p[8 * s2 + 4], p[8 * s2 + 5]); pk.w = cvtpk(p[8 * s2 + 6], p[8 * s2 + 7]);
        const s16x8 pf = __builtin_bit_cast(s16x8, pk);
        o[0] = MFMA32(vf[s2], pf, o[0]); o[1] = MFMA32(vf[2 + s2], pf, o[1]);
    }
}
DI void attn_mfma(Frame& F) {
    const bf16* QF = (const bf16*)(F.ws + WS_QF); const bf16* KF = (const bf16*)(F.ws + WS_KF); const bf16* VF = (const bf16*)(F.ws + WS_VF);
    bf16* MIX = (bf16*)(F.ws + WS_MIX); const float* rpb = F.in[10];
    LAS float* rp = (LAS float*)(F.lds);
    for (int i = F.tid; i < NHEAD * 15 * 31; i += 512) rp[i] = rpb[i] * LOG2E;
    __syncthreads();
    const int lane = F.lane, hh = lane >> 5, ql = lane & 31;
    int lo[2], djb[2][2];
#pragma unroll
    for (int qb = 0; qb < 2; ++qb) { const int qc = 32 * qb + ql, c0 = min(max(qc - 8, 0), 48); lo[qb] = c0 - qc + 15;
#pragma unroll
        for (int jb = 0; jb < 2; ++jb) djb[qb][jb] = 32 * (jb - qb) + 4 * hh - ql + 15; }
    for (int unit = F.gw; unit < NBATCH * NHEAD * 64; unit += F.NGW) {
        const int r = unit & 63, h = (unit >> 6) & 7, b = unit >> 9, bh = b * 8 + h;
        LAS s16x8* qfl = (LAS s16x8*)(F.lds + 16384 + F.wave * 8192) + lane;
#pragma unroll
        for (int qb = 0; qb < 2; ++qb)
#pragma unroll
            for (int ks = 0; ks < 4; ++ks) qfl[(qb * 4 + ks) * 64] = ((const s16x8*)(QF + (size_t)(bh * 128 + 2 * r + qb) * 2048))[ks * 64 + lane];
        f32x16 o[2][2]; float m[2], l[2];
#pragma unroll
        for (int qb = 0; qb < 2; ++qb) { m[qb] = -1e30f; l[qb] = 0.f;
#pragma unroll
            for (int dt = 0; dt < 2; ++dt)
#pragma unroll
                for (int i = 0; i < 16; ++i) o[qb][dt][i] = 0.f; }
        s16x8 kf[4], vf[4];
#pragma unroll 1
        for (int kb = 0; kb < 8; ++kb) {
            const s16x8* kp = (const s16x8*)(KF + (size_t)(bh * 136 + 128 + kb) * 2048) + lane; const s16x8* vp = (const s16x8*)(VF + (size_t)(bh * 136 + 128 + kb) * 2048) + lane;
#pragma unroll
            for (int j = 0; j < 4; ++j) { kf[j] = kp[j * 64]; vf[j] = vp[j * 64]; }
            attn_tile<15, false>(kf, vf, qfl, o[0], m[0], l[0], rp, 0, 0); __builtin_amdgcn_sched_barrier(0);
            attn_tile<15, false>(kf, vf, qfl + 256, o[1], m[1], l[1], rp, 0, 0); __builtin_amdgcn_sched_barrier(0);
        }
        const int r0 = min(max(r - 4, 0), 56);
#pragma unroll 1
        for (int i = 0; i < 8; ++i) {
            const LAS float* brow = rp + (h * 15 + (r0 + i - r + 7)) * 31;
            { const s16x8* kp = (const s16x8*)(KF + (size_t)(bh * 136 + 2 * (r0 + i)) * 2048) + lane; const s16x8* vp = (const s16x8*)(VF + (size_t)(bh * 136 + 2 * (r0 + i)) * 2048) + lane;
#pragma unroll
              for (int j = 0; j < 4; ++j) { kf[j] = kp[j * 64]; vf[j] = vp[j * 64]; } }
            attn_tile<15, true>(kf, vf, qfl, o[0], m[0], l[0], brow, djb[0][0], lo[0]); __builtin_amdgcn_sched_barrier(0);
            attn_tile<8, true>(kf, vf, qfl + 256, o[1], m[1], l[1], brow, djb[1][0], lo[1]); __builtin_amdgcn_sched_barrier(0);
            { const s16x8* kp = (const s16x8*)(KF + (size_t)(bh * 136 + 2 * (r0 + i) + 1) * 2048) + lane; const s16x8* vp = (const s16x8*)(VF + (size_t)(bh * 136 + 2 * (r0 + i) + 1) * 2048) + lane;
#pragma unroll
              for (int j = 0; j < 4; ++j) { kf[j] = kp[j * 64]; vf[j] = vp[j * 64]; } }
            attn_tile<1, true>(kf, vf, qfl, o[0], m[0], l[0], brow, djb[0][1], lo[0]); __builtin_amdgcn_sched_barrier(0);
            attn_tile<15, true>(kf, vf, qfl + 256, o[1], m[1], l[1], brow, djb[1][1], lo[1]); __builtin_amdgcn_sched_barrier(0);
        }
#pragma unroll
        for (int qb = 0; qb < 2; ++qb) {
            const float lt = l[qb] + __shfl_xor(l[qb], 32), inv = 1.0f / lt;
            bf16* orow = MIX + (size_t)(b * SEQ + r * GRIDW + 32 * qb + ql) * DM + 512 + h * 64 + 4 * hh;
#pragma unroll
            for (int dt = 0; dt < 2; ++dt)
#pragma unroll
                for (int g = 0; g < 4; ++g) { v2u w; w.x = pk2(o[qb][dt][4 * g] * inv, o[qb][dt][4 * g + 1] * inv); w.y = pk2(o[qb][dt][4 * g + 2] * inv, o[qb][dt][4 * g + 3] * inv);
                    *(v2u*)(orow + 32 * dt + 8 * g) = w; }
        }
    }
    __syncthreads();
}
DI void pool_mfma(Frame& F) {
    const bf16* PBF = (const bf16*)(F.ws + WS_PB); bf16* MIX = (bf16*)(F.ws + WS_MIX); const bf16* PW = (const bf16*)(F.ws + WS_POOLW); const float* pool_scale = F.in[9];
    constexpr int RS = 272;
    LAS unsigned char* ptile = F.lds + 32768;
    LAS unsigned char* atile = F.lds + 32768 + 144 * RS;
    const int lane = F.lane, hh = lane >> 5, ql = lane & 31;
    for (int tile = F.vcu; tile < NTOK / 128; tile += F.G) {
        const int tok0 = tile * 128, bstart = tok0 & ~(SEQ - 1);
#pragma unroll 1
        for (int g = 0; g < 4; ++g) {
            for (int it = F.tid; it < 144 * 16; it += 512) { const int rr = it >> 4, ch = it & 15, t = tok0 - 8 + rr;
                v4u v = (v4u){0u, 0u, 0u, 0u};
                if (t >= bstart && t < bstart + SEQ) v = *(const v4u*)(PBF + (size_t)t * 512 + g * 128 + ch * 8);
                *(LAS v4u*)(ptile + rr * RS + ch * 16) = v; }
            __syncthreads();
            { const int cp = F.tid & 63, sg = F.tid >> 6, w = 2 << g, hw = w >> 1;
              const LAS unsigned char* col = ptile + cp * 4;
              float s0 = 0.f, s1 = 0.f;
              const int tl0 = sg * 16;
              for (int rr = tl0 + 8 - hw; rr < tl0 + 8 + hw; ++rr) { const unsigned u = *(const LAS unsigned*)(col + rr * RS); s0 += bflo(u); s1 += bfhi(u); }
#pragma unroll 4
              for (int i = 0; i < 16; ++i) { const int tl = tl0 + i, sp = (tok0 + tl) & (SEQ - 1);
                  const int cnt = min(sp + hw, SEQ) - max(sp - hw, 0); const float inv = 1.0f / (float)cnt;
                  const unsigned self = *(const LAS unsigned*)(col + (tl + 8) * RS);
                  *(LAS unsigned*)(atile + tl * RS + cp * 4) = pk2(s0 * inv - bflo(self), s1 * inv - bfhi(self));
                  const unsigned un = *(const LAS unsigned*)(col + (tl + 8 + hw) * RS), uo = *(const LAS unsigned*)(col + (tl + 8 - hw) * RS);
                  s0 += bflo(un) - bflo(uo); s1 += bfhi(un) - bfhi(uo); } }
            __syncthreads();
            { const int tb = F.wave >> 1, dt0 = (F.wave & 1) * 2;
              f32x16 acc[2];
#pragma unroll
              for (int j = 0; j < 2; ++j)
#pragma unroll
                  for (int i = 0; i < 16; ++i) acc[j][i] = 0.f;
#pragma unroll
              for (int ks = 0; ks < 8; ++ks) {
                  const s16x8 bfr = *(const LAS s16x8*)(atile + (32 * tb + ql) * RS + (16 * ks + 8 * hh) * 2);
#pragma unroll
                  for (int j = 0; j < 2; ++j) { const s16x8 afr = *(const s16x8*)(PW + (size_t)g * 16384 + (32 * (dt0 + j) + ql) * 128 + 16 * ks + 8 * hh);
                      acc[j] = MFMA32(afr, bfr, acc[j]); } }
              bf16* orow = MIX + (size_t)(tok0 + 32 * tb + ql) * DM + g * 128 + 4 * hh;
#pragma unroll
              for (int j = 0; j < 2; ++j)
#pragma unroll
                  for (int q = 0; q < 4; ++q) { const int d = 32 * (dt0 + j) + 8 * q; const f32x4 sc = *(const f32x4*)(pool_scale + g * 128 + d + 4 * hh);
                      v2u wv; wv.x = pk2(acc[j][4 * q] * sc.x, acc[j][4 * q + 1] * sc.y); wv.y = pk2(acc[j][4 * q + 2] * sc.z, acc[j][4 * q + 3] * sc.w);
                      *(v2u*)(orow + d) = wv; } }
            __syncthreads();
        }
    }
}
DI void pool_naive(Frame& F) {
    const bf16* PBF = (const bf16*)(F.ws + WS_PB); bf16* MIX = (bf16*)(F.ws + WS_MIX); bf16* PO = (bf16*)(F.ws + WS_POOLED);
    const float* pool_w = F.in[8]; const float* pool_scale = F.in[9];
    for (int tile = F.vcu; tile < NTOK / 128; tile += F.G) {
        const int tok0 = tile * 128;
        for (int it = F.tid; it < 128 * 64; it += 512) {
            const int t = tok0 + (it >> 6), ch = (it & 63) * 8, g = ch >> 7, w = 2 << g, s = t & (SEQ - 1), tb = t - s;
            const int lo = max(s - w / 2, 0), hi = min(s + w / 2, SEQ);
            float acc[8];
#pragma unroll
            for (int i = 0; i < 8; ++i) acc[i] = 0.f;
            for (int p = lo; p < hi; ++p) { const v4u v = *(const v4u*)(PBF + (size_t)(tb + p) * 512 + ch);
                acc[0] += bflo(v.x); acc[1] += bfhi(v.x); acc[2] += bflo(v.y); acc[3] += bfhi(v.y); acc[4] += bflo(v.z); acc[5] += bfhi(v.z); acc[6] += bflo(v.w); acc[7] += bfhi(v.w); }
            const float inv = 1.0f / (float)(hi - lo);
            const v4u sv = *(const v4u*)(PBF + (size_t)t * 512 + ch);
            v4u wv; wv.x = pk2(acc[0] * inv - bflo(sv.x), acc[1] * inv - bfhi(sv.x)); wv.y = pk2(acc[2] * inv - bflo(sv.y), acc[3] * inv - bfhi(sv.y));
            wv.z = pk2(acc[4] * inv - bflo(sv.z), acc[5] * inv - bfhi(sv.z)); wv.w = pk2(acc[6] * inv - bflo(sv.w), acc[7] * inv - bfhi(sv.w));
            *(v4u*)(PO + (size_t)t * 512 + ch) = wv;
        }
        VM_WAIT(); __syncthreads();
        for (int it = F.wave; it < 1024; it += 8) {
            const int t = tok0 + (it >> 3), g = (it >> 1) & 3, d = (it & 1) * 64 + F.lane;
            const bf16* pr = PO + (size_t)t * 512 + g * 128; const float* wp = pool_w + g * 16384 + d;
            float acc = 0.f;
            for (int c8 = 0; c8 < 16; ++c8) { const v4u pv = *(const v4u*)(pr + c8 * 8); const float* w8 = wp + c8 * 8 * 128;
                acc += bflo(pv.x) * w8[0] + bfhi(pv.x) * w8[128] + bflo(pv.y) * w8[256] + bfhi(pv.y) * w8[384] + bflo(pv.z) * w8[512] + bfhi(pv.z) * w8[640] + bflo(pv.w) * w8[768] + bfhi(pv.w) * w8[896]; }
            MIX[(size_t)t * DM + g * 128 + d] = (bf16)f2bf(acc * pool_scale[g * 128 + d]);
        }
        __syncthreads();
    }
}

DI void peer_topk_naive(Frame& F, int tok0) {
    const bf16* Q = (const bf16*)(F.ws + WS_ZX); const float* keys = F.in[14]; float* LISTS = (float*)(F.ws + WS_LISTS);
    int* EXPERTS = (int*)(F.ws + WS_EXP); float* GATES = (float*)(F.ws + WS_GATE);
    for (int it = F.wave; it < 32; it += 8) {
        const int hp = it & 15, t = tok0 + (it >> 4) * 64 + F.lane;
        float q[128];
        { const v4u* qp = (const v4u*)(Q + (size_t)t * 2048 + hp * 128);
#pragma unroll
          for (int cc = 0; cc < 16; ++cc) { const v4u qv = qp[cc];
              q[8 * cc + 0] = bflo(qv.x); q[8 * cc + 1] = bfhi(qv.x); q[8 * cc + 2] = bflo(qv.y); q[8 * cc + 3] = bfhi(qv.y);
              q[8 * cc + 4] = bflo(qv.z); q[8 * cc + 5] = bfhi(qv.z); q[8 * cc + 6] = bflo(qv.w); q[8 * cc + 7] = bfhi(qv.w); } }
        float top[16];
#pragma unroll
        for (int i = 0; i < 16; ++i) top[i] = -INFINITY;
        const float* kb = keys + (size_t)hp * 16384;
        for (int n = 0; n < 128; ++n) {
            const f32x4* kr = (const f32x4*)(kb + n * 128);
            float acc = 0.f;
#pragma unroll
            for (int cc = 0; cc < 32; ++cc) { const f32x4 kv = kr[cc]; acc += q[4 * cc] * kv.x + q[4 * cc + 1] * kv.y + q[4 * cc + 2] * kv.z + q[4 * cc + 3] * kv.w; }
            float v = __uint_as_float((__float_as_uint(acc) & ~127u) | (unsigned)n);
#pragma unroll
            for (int i = 0; i < 16; ++i) { const float hi = fmaxf(top[i], v); v = fminf(top[i], v); top[i] = hi; }
        }
        f32x4* lp = (f32x4*)(LISTS + ((size_t)t * 16 + hp) * 16);
#pragma unroll
        for (int i = 0; i < 4; ++i) lp[i] = (f32x4){top[4 * i], top[4 * i + 1], top[4 * i + 2], top[4 * i + 3]};
    }
    VM_WAIT(); __syncthreads();
    for (int it = F.tid; it < 128 * 8; it += 512) {
        const int t = tok0 + (it >> 3), h = it & 7;
        float v0[16], v1[16]; int i0[16], i1[16];
        const f32x4* l0 = (const f32x4*)(LISTS + ((size_t)t * 16 + h * 2) * 16);
#pragma unroll
        for (int i = 0; i < 4; ++i) { const f32x4 a = l0[i], b = l0[4 + i];
#pragma unroll
            for (int e = 0; e < 4; ++e) { const unsigned ua = __float_as_uint(a[e]), ub = __float_as_uint(b[e]);
                v0[4 * i + e] = __uint_as_float(ua & ~127u); i0[4 * i + e] = (int)(ua & 127u); v1[4 * i + e] = __uint_as_float(ub & ~127u); i1[4 * i + e] = (int)(ub & 127u); } }
        float tv[16]; int ti[16];
#pragma unroll
        for (int i = 0; i < 16; ++i) { tv[i] = -INFINITY; ti[i] = 0; }
#pragma unroll
        for (int i = 0; i < 16; ++i)
#pragma unroll
            for (int j = 0; j < 16; ++j) if ((i + 1) * (j + 1) <= 16) {
                float cv = v0[i] + v1[j]; int ci = i0[i] * 128 + i1[j];
#pragma unroll
                for (int k = 0; k < 16; ++k) { const bool gt = cv > tv[k]; const float nv = gt ? cv : tv[k]; const int ni = gt ? ci : ti[k]; cv = gt ? tv[k] : cv; ci = gt ? ti[k] : ci; tv[k] = nv; ti[k] = ni; }
            }
        float e[16], sum = 0.f;
#pragma unroll
        for (int k = 0; k < 16; ++k) { e[k] = __expf(tv[k] - tv[0]); sum += e[k]; }
        const float is = 1.0f / sum;
        int* ep = EXPERTS + (size_t)t * 128 + h * 16; float* gp = GATES + (size_t)t * 128 + h * 16;
#pragma unroll
        for (int k = 0; k < 16; ++k) { ep[k] = ti[k]; gp[k] = e[k] * is; }
    }
    VM_WAIT(); __syncthreads();
}

DI int f2key(float f) { const int b = __float_as_int(f); return b ^ ((b >> 31) & 0x7fffffff); }
DI float key2f(int k) { return __int_as_float(k ^ ((k >> 31) & 0x7fffffff)); }
DI void ce_desc(int& x, int& y) { const int hi = max(x, y), lo = min(x, y); x = hi; y = lo; }
DI void sort16_desc(int (&a)[16]) {
#pragma unroll
    for (int k = 2; k <= 16; k <<= 1)
#pragma unroll
        for (int j = k >> 1; j > 0; j >>= 1)
#pragma unroll
            for (int i = 0; i < 16; ++i) { const int l = i ^ j; if (l > i) { if ((i & k) == 0) ce_desc(a[i], a[l]); else ce_desc(a[l], a[i]); } }
}
DI void merge16_desc(int (&a)[16], const int (&b)[16]) {
#pragma unroll
    for (int i = 0; i < 16; ++i) a[i] = max(a[i], b[15 - i]);
#pragma unroll
    for (int j = 8; j > 0; j >>= 1)
#pragma unroll
        for (int i = 0; i < 16; ++i) if ((i & j) == 0) ce_desc(a[i], a[i + j]);
}
DI void peer_topk_mfma(Frame& F, int tile) {
    const bf16* QP = (const bf16*)(F.ws + WS_ZX); const bf16* KEYF = (const bf16*)(F.ws + WS_KEYS);
    int* EXPERTS = (int*)(F.ws + WS_EXP); float* GATES = (float*)(F.ws + WS_GATE);
    const int lane = F.lane, hh = lane >> 5, ql = lane & 31, tb = F.wave >> 1, p = F.wave & 1;
    const int tokblk = tile * 4 + tb, tok = tokblk * 32 + ql;
#pragma unroll 1
    for (int h = 0; h < 8; ++h) {
        const int hp = 2 * h + p;
        s16x8 qf[8];
#pragma unroll
        for (int ks = 0; ks < 8; ++ks) qf[ks] = ((const s16x8*)(QP + ((size_t)tokblk * 16 + hp) * 4096))[ks * 64 + lane];
        const s16x8* kfp = (const s16x8*)(KEYF + (size_t)hp * 16384) + lane;
        int top[16];
#pragma unroll
        for (int i = 0; i < 16; ++i) top[i] = (int)0x80000000;
#pragma unroll 1
        for (int nt = 0; nt < 4; ++nt) {
            f32x16 acc;
#pragma unroll
            for (int i = 0; i < 16; ++i) acc[i] = 0.f;
#pragma unroll
            for (int ks = 0; ks < 8; ++ks) acc = MFMA32(kfp[(nt * 8 + ks) * 64], qf[ks], acc);
            int a[16];
#pragma unroll
            for (int i = 0; i < 16; ++i) { const int n = 32 * nt + (i & 3) + 8 * (i >> 2) + 4 * hh; a[i] = f2key(__int_as_float((__float_as_int(acc[i]) & ~127) | n)); }
            sort16_desc(a);
            merge16_desc(top, a);
        }
        { int oth[16];
#pragma unroll
          for (int i = 0; i < 16; ++i) oth[i] = __shfl_xor(top[i], 32);
          merge16_desc(top, oth); }
        LAS float* L = (LAS float*)(F.lds) + (h & 1) * 4096 + (tb * 2) * 512;
        if (hh == 0) {
#pragma unroll
            for (int i = 0; i < 16; ++i) L[p * 512 + i * 32 + ql] = key2f(top[i]);
        }
        __syncthreads();
        if (p == 0 && hh == 0) {
            float v0[16], v1[16];
#pragma unroll
            for (int i = 0; i < 16; ++i) { v0[i] = __int_as_float(__float_as_int(L[i * 32 + ql]) & ~127); v1[i] = __int_as_float(__float_as_int(L[512 + i * 32 + ql]) & ~127); }
            int grp[4][16]; int cnt = 0;
#pragma unroll
            for (int g = 0; g < 4; ++g)
#pragma unroll
                for (int i = 0; i < 16; ++i) grp[g][i] = (int)0x80000000;
#pragma unroll
            for (int i = 0; i < 16; ++i)
#pragma unroll
                for (int j = 0; j < 16; ++j) if ((i + 1) * (j + 1) <= 16) {
                    grp[cnt >> 4][cnt & 15] = f2key(__int_as_float((__float_as_int(v0[i] + v1[j]) & ~255) | (i * 16 + j))); ++cnt; }
#pragma unroll
            for (int g = 0; g < 4; ++g) sort16_desc(grp[g]);
            merge16_desc(grp[0], grp[1]); merge16_desc(grp[2], grp[3]); merge16_desc(grp[0], grp[2]);
            float tv[16]; float e[16]; float sum = 0.f; int eid[16];
#pragma unroll
            for (int k = 0; k < 16; ++k) { const int bits = __float_as_int(key2f(grp[0][k])); const int code = bits & 255; tv[k] = __int_as_float(bits & ~255);
                const int n0 = __float_as_int(L[(code >> 4) * 32 + ql]) & 127, n1 = __float_as_int(L[512 + (code & 15) * 32 + ql]) & 127; eid[k] = n0 * 128 + n1; }
#pragma unroll
            for (int k = 0; k < 16; ++k) { e[k] = __expf(tv[k] - tv[0]); sum += e[k]; }
            const float is = 1.0f / sum;
            int* ep = EXPERTS + (size_t)tok * 128 + h * 16; float* gp = GATES + (size_t)tok * 128 + h * 16;
#pragma unroll
            for (int k4 = 0; k4 < 4; ++k4) { *(v4u*)(ep + 4 * k4) = (v4u){(unsigned)eid[4 * k4], (unsigned)eid[4 * k4 + 1], (unsigned)eid[4 * k4 + 2], (unsigned)eid[4 * k4 + 3]};
                *(f32x4*)(gp + 4 * k4) = (f32x4){e[4 * k4] * is, e[4 * k4 + 1] * is, e[4 * k4 + 2] * is, e[4 * k4 + 3] * is}; }
        }
    }
    VM_WAIT(); __syncthreads();
}

DI float gelu_exact(float a) { return 0.5f * a * (1.0f + erff(a * 0.70710678118654752f)); }

DI void fp8x16_to_f32(const v4u r, float (&f)[16]) {
#pragma unroll
    for (int j = 0; j < 4; ++j) { const f32x2 lo = __builtin_amdgcn_cvt_pk_f32_fp8((int)r[j], false), hi = __builtin_amdgcn_cvt_pk_f32_fp8((int)r[j], true);
        f[4 * j] = lo.x; f[4 * j + 1] = lo.y; f[4 * j + 2] = hi.x; f[4 * j + 3] = hi.y; }
}
template <bool STORE> DI void peer_gather_token(Frame& F, int t) {
    const bf16* H2 = (const bf16*)(F.ws + WS_HX); const unsigned char* U = F.ws + WS_U; const unsigned char* V = F.ws + WS_V;
    const int* EXPERTS = (const int*)(F.ws + WS_EXP); const float* GATES = (const float*)(F.ws + WS_GATE); const float* MOD = (const float*)(F.ws + WS_MOD);
    const int lane = F.lane;
    float hs[16];
    { const v4u a = *((const v4u*)(H2 + (size_t)t * DM + lane * 16)), b = *((const v4u*)(H2 + (size_t)t * DM + lane * 16 + 8));
      hs[0] = bflo(a.x); hs[1] = bfhi(a.x); hs[2] = bflo(a.y); hs[3] = bfhi(a.y); hs[4] = bflo(a.z); hs[5] = bfhi(a.z); hs[6] = bflo(a.w); hs[7] = bfhi(a.w);
      hs[8] = bflo(b.x); hs[9] = bfhi(b.x); hs[10] = bflo(b.y); hs[11] = bfhi(b.y); hs[12] = bflo(b.z); hs[13] = bfhi(b.z); hs[14] = bflo(b.w); hs[15] = bfhi(b.w); }
    const int ev0 = EXPERTS[(size_t)t * 128 + lane], ev1 = EXPERTS[(size_t)t * 128 + 64 + lane];
    const float gv0 = GATES[(size_t)t * 128 + lane], gv1 = GATES[(size_t)t * 128 + 64 + lane];
    float out[16];
#pragma unroll
    for (int i = 0; i < 16; ++i) out[i] = 0.f;
    v4u ucur[8];
#pragma unroll
    for (int r = 0; r < 8; ++r) { const int e = __builtin_amdgcn_readlane(ev0, r); ucur[r] = *((const v4u*)(U + (size_t)e * 1024) + lane); }
#pragma unroll 1
    for (int bt = 0; bt < 16; ++bt) {
        const int evs = (bt < 8) ? ev0 : ev1; const float gvs = (bt < 8) ? gv0 : gv1;
        v4u vcur[8];
#pragma unroll
        for (int r = 0; r < 8; ++r) { const int e = __builtin_amdgcn_readlane(evs, (bt & 7) * 8 + r); vcur[r] = *((const v4u*)(V + (size_t)e * 1024) + lane); }
        float p[8];
#pragma unroll
        for (int r = 0; r < 8; ++r) { float f[16]; fp8x16_to_f32(ucur[r], f);
            p[r] = ((hs[0] * f[0] + hs[1] * f[1]) + (hs[2] * f[2] + hs[3] * f[3])) + ((hs[4] * f[4] + hs[5] * f[5]) + (hs[6] * f[6] + hs[7] * f[7]))
                 + ((hs[8] * f[8] + hs[9] * f[9]) + (hs[10] * f[10] + hs[11] * f[11])) + ((hs[12] * f[12] + hs[13] * f[13]) + (hs[14] * f[14] + hs[15] * f[15])); }
        { const int evn = (bt + 1 < 8) ? ev0 : ev1; const int bn = (bt + 1) & 15;
#pragma unroll
          for (int r = 0; r < 8; ++r) { const int e = __builtin_amdgcn_readlane(evn, (bn & 7) * 8 + r); ucur[r] = *((const v4u*)(U + (size_t)e * 1024) + lane); } }
        { const bool h5 = (lane & 32) != 0;
#pragma unroll
          for (int i = 0; i < 4; ++i) { const float send = h5 ? p[i] : p[i + 4], keep = h5 ? p[i + 4] : p[i]; p[i] = keep + __shfl_xor(send, 32); }
          const bool h4 = (lane & 16) != 0;
#pragma unroll
          for (int i = 0; i < 2; ++i) { const float send = h4 ? p[i] : p[i + 2], keep = h4 ? p[i + 2] : p[i]; p[i] = keep + __shfl_xor(send, 16); }
          const bool h3 = (lane & 8) != 0;
          { const float send = h3 ? p[0] : p[1], keep = h3 ? p[1] : p[0]; p[0] = keep + __shfl_xor(send, 8); }
          p[0] += __shfl_xor(p[0], 4); p[0] += __shfl_xor(p[0], 2); p[0] += __shfl_xor(p[0], 1); }
        const float gk = __shfl(gvs, (bt & 7) * 8 + ((lane >> 3) & 7));
        const float w = gk * gelu_exact(p[0] * (1.0f / U_SCALE));
#pragma unroll
        for (int r = 0; r < 8; ++r) { const float wr = __builtin_bit_cast(float, __builtin_amdgcn_readlane(__builtin_bit_cast(int, w), r * 8)); float f[16]; fp8x16_to_f32(vcur[r], f);
#pragma unroll
            for (int i = 0; i < 16; ++i) out[i] += wr * f[i]; }
    }
    const int b = t >> 12; const float* g2 = MOD + b * NMOD + 5 * DM; const float* fg = F.in[17]; float* xo = F.out + (size_t)t * DM;
    float x2[16]; float ss = 0.f;
#pragma unroll
    for (int hq = 0; hq < 4; ++hq) { const int c = lane * 16 + hq * 4; const f32x4 xv = *(const f32x4*)(xo + c), gv = *(const f32x4*)(g2 + c);
#pragma unroll
        for (int e = 0; e < 4; ++e) { const float y = xv[e] + gv[e] * (out[hq * 4 + e] * (1.0f / V_SCALE)); x2[hq * 4 + e] = y; ss += y * y; } }
    const float rinv = 1.0f / sqrtf(wave_sum(ss) * (1.f / DM) + EPS);
#pragma unroll
    for (int hq = 0; hq < 4; ++hq) { const int c = lane * 16 + hq * 4; const f32x4 fv = *(const f32x4*)(fg + c);
        f32x4 y;
#pragma unroll
        for (int e = 0; e < 4; ++e) y[e] = x2[hq * 4 + e] * rinv * fv[e];
        if (STORE || rinv == 12345.678f) *(f32x4*)(xo + c) = y; }
}

typedef __bf16 bf16x2v __attribute__((ext_vector_type(2)));
template <int NT> DI void gather_round(Frame& F, int tbase) {
    constexpr int NK = 2 * NT, N = 128 * NT, NB = N / 8, LPB = 8 / NK;
    const bf16* H2 = (const bf16*)(F.ws + WS_HX); const unsigned char* U = F.ws + WS_U; const unsigned char* V = F.ws + WS_V;
    const int* EXPERTS = (const int*)(F.ws + WS_EXP); const float* GATES = (const float*)(F.ws + WS_GATE); const float* MOD = (const float*)(F.ws + WS_MOD);
    const int lane = F.lane;
    int key[NK];
#pragma unroll
    for (int j = 0; j < NT; ++j)
#pragma unroll
        for (int hf = 0; hf < 2; ++hf) { const int k = hf * 64 + lane; key[j * 2 + hf] = (EXPERTS[(size_t)(tbase + j) * 128 + k] << 9) | (j << 7) | k; }
#pragma unroll
    for (int k = 2; k <= N; k <<= 1)
#pragma unroll
        for (int j = k >> 1; j > 0; j >>= 1) {
            if (j < NK) {
#pragma unroll
                for (int r = 0; r < NK; ++r) if ((r & j) == 0) { const bool asc = (((lane * NK + r) & k) == 0); const int x = key[r], y = key[r | j], lo = min(x, y), hi = max(x, y);
                    key[r] = asc ? lo : hi; key[r | j] = asc ? hi : lo; }
            } else {
                const bool asc = (((lane * NK) & k) == 0), lower = ((lane & (j / NK)) == 0), takemin = (asc == lower);
#pragma unroll
                for (int r = 0; r < NK; ++r) { const int o = __shfl_xor(key[r], j / NK); key[r] = takemin ? min(key[r], o) : max(key[r], o); }
            }
        }
    LAS float* sgL = (LAS float*)(F.lds + 65536) + F.wave * N;
#pragma unroll
    for (int r = 0; r < NK; ++r) sgL[lane * NK + r] = GATES[(size_t)(tbase + ((key[r] >> 7) & 3)) * 128 + (key[r] & 127)];
    unsigned hsp[NT][8]; float out[NT][16];
#pragma unroll
    for (int j = 0; j < NT; ++j) { const v4u a = *((const v4u*)(H2 + (size_t)(tbase + j) * DM + lane * 16)), b = *((const v4u*)(H2 + (size_t)(tbase + j) * DM + lane * 16 + 8));
        hsp[j][0] = a.x; hsp[j][1] = a.y; hsp[j][2] = a.z; hsp[j][3] = a.w; hsp[j][4] = b.x; hsp[j][5] = b.y; hsp[j][6] = b.z; hsp[j][7] = b.w;
#pragma unroll
        for (int i = 0; i < 16; ++i) out[j][i] = 0.f; }
    v4u ucur[8];
#pragma unroll
    for (int r = 0; r < 8; ++r) { const int kk = __builtin_amdgcn_readlane(key[r % NK], r / NK); ucur[r] = *((const v4u*)(U + (size_t)(kk >> 9) * 1024) + lane); }
#pragma unroll 1
    for (int b = 0; b < NB; ++b) {
        int kk[8]; v4u vcur[8];
#pragma unroll
        for (int r = 0; r < 8; ++r) { kk[r] = __builtin_amdgcn_readlane(key[r % NK], b * LPB + r / NK); vcur[r] = *((const v4u*)(V + (size_t)(kk[r] >> 9) * 1024) + lane); }
        float p[8];
#pragma unroll
        for (int r = 0; r < 8; ++r) { const int tk = (kk[r] >> 7) & 3; float acc = 0.f;
#pragma unroll
            for (int j = 0; j < NT; ++j) if (tk == j) {
#pragma unroll
                for (int q = 0; q < 4; ++q) { const bf16x2v lo = __builtin_amdgcn_cvt_scalef32_pk_bf16_fp8((int)ucur[r][q], 1.0f, false), hi = __builtin_amdgcn_cvt_scalef32_pk_bf16_fp8((int)ucur[r][q], 1.0f, true);
                    acc = __builtin_amdgcn_fdot2_f32_bf16(lo, __builtin_bit_cast(bf16x2v, hsp[j][2 * q]), acc, false); acc = __builtin_amdgcn_fdot2_f32_bf16(hi, __builtin_bit_cast(bf16x2v, hsp[j][2 * q + 1]), acc, false); } }
            p[r] = acc; }
        { const int bn = (b + 1 < NB) ? b + 1 : 0;
#pragma unroll
          for (int r = 0; r < 8; ++r) { const int kn = __builtin_amdgcn_readlane(key[r % NK], bn * LPB + r / NK); ucur[r] = *((const v4u*)(U + (size_t)(kn >> 9) * 1024) + lane); } }
        { const bool h5 = (lane & 32) != 0;
#pragma unroll
          for (int i = 0; i < 4; ++i) { const float send = h5 ? p[i] : p[i + 4], keep = h5 ? p[i + 4] : p[i]; p[i] = keep + __shfl_xor(send, 32); }
          const bool h4 = (lane & 16) != 0;
#pragma unroll
          for (int i = 0; i < 2; ++i) { const float send = h4 ? p[i] : p[i + 2], keep = h4 ? p[i + 2] : p[i]; p[i] = keep + __shfl_xor(send, 16); }
          const bool h3 = (lane & 8) != 0;
          { const float send = h3 ? p[0] : p[1], keep = h3 ? p[1] : p[0]; p[0] = keep + __shfl_xor(send, 8); }
          p[0] += __shfl_xor(p[0], 4); p[0] += __shfl_xor(p[0], 2); p[0] += __shfl_xor(p[0], 1); }
        const float w = sgL[b * 8 + ((lane >> 3) & 7)] * gelu_exact(p[0] * (1.0f / U_SCALE));
#pragma unroll
        for (int r = 0; r < 8; ++r) { const float wr = __builtin_bit_cast(float, __builtin_amdgcn_readlane(__builtin_bit_cast(int, w), r * 8)); float f[16]; fp8x16_to_f32(vcur[r], f);
            const int tk = (kk[r] >> 7) & 3;
#pragma unroll
            for (int j = 0; j < NT; ++j) if (tk == j) {
#pragma unroll
                for (int i = 0; i < 16; ++i) out[j][i] += wr * f[i]; } }
    }
    const float* fg = F.in[17];
#pragma unroll
    for (int j = 0; j < NT; ++j) {
        const int t = tbase + j, bb = t >> 12; const float* g2 = MOD + bb * NMOD + 5 * DM; float* xo = F.out + (size_t)t * DM;
        float x2[16]; float ss = 0.f;
#pragma unroll
        for (int hq = 0; hq < 4; ++hq) { const int c = lane * 16 + hq * 4; const f32x4 xv = *(const f32x4*)(xo + c), gv = *(const f32x4*)(g2 + c);
#pragma unroll
            for (int e = 0; e < 4; ++e) { const float y = xv[e] + gv[e] * (out[j][hq * 4 + e] * (1.0f / V_SCALE)); x2[hq * 4 + e] = y; ss += y * y; } }
        const float rinv = 1.0f / sqrtf(wave_sum(ss) * (1.f / DM) + EPS);
#pragma unroll
        for (int hq = 0; hq < 4; ++hq) { const int c = lane * 16 + hq * 4; const f32x4 fv = *(const f32x4*)(fg + c);
            f32x4 y;
#pragma unroll
            for (int e = 0; e < 4; ++e) y[e] = x2[hq * 4 + e] * rinv * fv[e];
            *(f32x4*)(xo + c) = y; }
    }
}

struct Args { const float* in[18]; float* out; unsigned char* ws; int ph_lo, ph_hi, li, pad; };
__global__ void __launch_bounds__(NWAVES * 64, 2) mk_fwd(Args args) {
    extern __shared__ __attribute__((aligned(16))) unsigned char lds[];
    Frame F;
    F.lds = (LAS unsigned char*)lds;
    F.tid = threadIdx.x; F.lane = F.tid & 63; F.wave = __builtin_amdgcn_readfirstlane(F.tid >> 6);
    F.G = gridDim.x; { const int bx = blockIdx.x; F.vcu = (F.G % 8 == 0) ? (bx % 8) * (F.G / 8) + bx / 8 : bx; }
    F.gw = F.vcu * NWAVES + F.wave; F.NGW = F.G * NWAVES;
#pragma unroll
    for (int i = 0; i < 18; ++i) F.in[i] = args.in[i];
    F.out = args.out; F.ws = args.ws;
    volatile LAS unsigned* MISC = (volatile LAS unsigned*)(F.lds + MISC_OFF);
    for (int u = F.tid; u < (LDS_BYTES - LDSCTL_OFF) / 4; u += NWAVES * 64) ((LAS unsigned*)(F.lds + LDSCTL_OFF))[u] = 0u;
    __syncthreads();
    gu32* ctl = (gu32*)(F.ws + WS_CTL);
    XcdBarrier bar; bar.bar = (unsigned*)(ctl + CW_BAR) + args.li * XCD_BAR_WORDS; bar.x = 0; bar.st = nullptr;
    const int lo = args.ph_lo, hi = args.ph_hi;
    if (hi - lo > 1) bar = xcd_barrier_post((unsigned*)(ctl + CW_BAR) + args.li * XCD_BAR_WORDS, MISC + 8);
#ifndef PROBE_MASK
#define PROBE_MASK 0
#endif
#define REP(k) for (int rep_ = 0; rep_ < 1 + ((PROBE_MASK >> (k)) & 1); ++rep_)
#define IN(k) (lo <= (k) && (k) < hi)
#ifndef PROBE_SEAMS
#define PROBE_SEAMS 1
#endif
#define SEAM(k) do { if (IN(k) && IN((k) + 1)) for (int s_ = 0; s_ < PROBE_SEAMS; ++s_) xcd_barrier(bar); } while (0)

#ifndef SKIP0
    if (IN(0)) { REP(0) { p0_prologue(F); __syncthreads(); } SEAM(0); }
#endif
    if (IN(1)) { REP(1) norm_rows(F, F.in[0], F.in[2], MROWS, F.in[6], 0, DM, (bf16*)(F.ws + WS_HX)); SEAM(1); }
    if (IN(2)) {
        pg8::Gemm g{(const bf16*)(F.ws + WS_HX), (const bf16*)(F.ws + WS_WIN), MROWS, DIN, DM}; pg8::InProjOrder S; S.init(F.G, (int)blockIdx.x);
        pg8::EpiInProj E{(bf16*)(F.ws + WS_PB), (bf16*)(F.ws + WS_QF), (bf16*)(F.ws + WS_KF), (bf16*)(F.ws + WS_VF)};
        REP(2) pg8::gemm_phase<pg8::EpiInProj, pg8::InProjOrder, true, true>(F.lds + RING_OFF, g, S, E);
        SEAM(2);
    }
    if (IN(3)) {
#ifndef SKIP3A
#ifdef ATT_NAIVE
 attn_naive(F);
#else
 REP(3) attn_mfma(F);
#endif
#endif
#ifndef SKIP3B
#ifdef POOL_NAIVE
 pool_naive(F);
#else
 REP(9) pool_mfma(F);
#endif
#endif
 SEAM(3); }
    if (IN(4)) {
        pg8::Gemm g{(const bf16*)(F.ws + WS_MIX), (const bf16*)(F.ws + WS_WOUT), NTOK, DM, DM}; pg8::StaticOrder S; S.init(NTOK, DM, F.G, (int)blockIdx.x);
        pg8::EpiX1 E{F.in[0], (const float*)(F.ws + WS_MOD), F.out};
        REP(4) pg8::gemm_phase<pg8::EpiX1, pg8::StaticOrder, true, true>(F.lds + RING_OFF, g, S, E);
        SEAM(4);
    }
    if (IN(5)) { REP(5) norm_rows(F, F.out, F.out, NTOK, F.in[12], 3 * DM, 4 * DM, (bf16*)(F.ws + WS_HX)); SEAM(5); }
    if (IN(6)) {
        pg8::Gemm g{(const bf16*)(F.ws + WS_HX), (const bf16*)(F.ws + WS_WQ), NTOK, 2048, DM}; pg8::StaticOrder S; S.init(NTOK, 2048, F.G, (int)blockIdx.x);
#ifdef TOPK_NAIVE
        pg8::EpiBf16 E{(bf16*)(F.ws + WS_ZX), 2048};
        pg8::gemm_phase<pg8::EpiBf16, pg8::StaticOrder, true, true>(F.lds + RING_OFF, g, S, E);
#else
        pg8::EpiQP E{(bf16*)(F.ws + WS_ZX)};
        REP(6) pg8::gemm_phase<pg8::EpiQP, pg8::StaticOrder, true, true>(F.lds + RING_OFF, g, S, E);
#endif
        SEAM(6);
    }
    if (IN(7)) {
        for (int tile = F.vcu; tile < NTOK / 128; tile += F.G) {
            const int tok0 = tile * 128;
#ifndef SKIP7A
#ifdef TOPK_NAIVE
            peer_topk_naive(F, tok0);
#else
            REP(7) peer_topk_mfma(F, tile);
#endif
#endif
#ifndef SKIP7B
#ifdef GATHER_V1
            if ((PROBE_MASK >> 8) & 1) for (int i = F.wave; i < 128; i += 8) peer_gather_token<false>(F, tok0 + i);
            for (int i = F.wave; i < 128; i += 8) peer_gather_token<true>(F, tok0 + i);
#else
            for (int rd = 0; rd < 128 / (8 * GATHER_NT); ++rd) {
#ifdef GATHER_SYNC
                if (F.G == 256 && hi - lo > 1) xcd_barrier(bar);
#endif
                gather_round<GATHER_NT>(F, tok0 + rd * 8 * GATHER_NT + F.wave * GATHER_NT); }
#endif
#endif
        }
    }
#undef IN
#undef SEAM
}

extern "C" void kernel_launch(void* const* d_in, const int* in_sizes, int n_in, void* d_out, int out_size, void* d_ws, size_t ws_size, hipStream_t stream) {
    static int grid = 0;
    if (grid == 0) {
        if (n_in != 18 || in_sizes[0] != NTOK * DM || out_size != NTOK * DM || ws_size < WS_END) { fprintf(stderr, "kernel_launch: unexpected shapes / workspace (n_in %d, ws %zu); nothing launched\n", n_in, ws_size); grid = -1; return; }
        int dev = 0, cus = 0;
        if (hipGetDevice(&dev) != hipSuccess || hipDeviceGetAttribute(&cus, hipDeviceAttributeMultiprocessorCount, dev) != hipSuccess) { grid = -1; return; }
        if (hipFuncSetAttribute((const void*)mk_fwd, hipFuncAttributeMaxDynamicSharedMemorySize, LDS_BYTES) != hipSuccess) { fprintf(stderr, "kernel_launch: hipFuncSetAttribute failed\n"); grid = -1; return; }
        int per_cu = 0;
        if (hipOccupancyMaxActiveBlocksPerMultiprocessor(&per_cu, (const void*)mk_fwd, NWAVES * 64, LDS_BYTES) != hipSuccess || per_cu < 1) fprintf(stderr, "kernel_launch: note: occupancy query reports %d blocks per CU\n", per_cu);
        (void)hipGetLastError();
        grid = cus;
    }
    if (grid < 0) return;
    (void)hipMemsetAsync((char*)d_ws + WS_CTL, 0, CTL_ZERO_BYTES, stream);
    Args a{};
    for (int i = 0; i < 18; ++i) a.in[i] = (const float*)d_in[i];
    a.out = (float*)d_out; a.ws = (unsigned char*)d_ws;
    for (int li = 0; li < N_LAUNCHES; ++li) {
        if (N_LAUNCHES == 1) { a.ph_lo = 0; a.ph_hi = NPHASE; } else { a.ph_lo = li; a.ph_hi = li + 1; }
        a.li = (N_LAUNCHES == 1) ? 0 : 0;
        hipLaunchKernelGGL(mk_fwd, dim3(grid), dim3(NWAVES * 64), LDS_BYTES, stream, a);
    }
}
```

```cpp
#include <hip/hip_runtime.h>
#include <cstdio>
#include <cstdint>
#include <type_traits>
namespace pg8 {
#define PG8_LAS __attribute__((address_space(3)))
typedef unsigned short bf16_t;
typedef short bf16x8 __attribute__((ext_vector_type(8)));
typedef float f32x4 __attribute__((ext_vector_type(4)));
typedef unsigned u32x4 __attribute__((ext_vector_type(4)));
constexpr int BM = 256, BK = 64, HALF = 128, HTB = HALF * BK * 2  , STAGE_BYTES = 8 * HTB, NXCD = 8, WGM = 8;

__host__ __device__ __forceinline__ int lds_byte(int r, int c) { const int st = (r >> 4) * 2 + (c >> 5), rr = r & 15, cc = c & 31, ob = rr * 64 + cc * 2; return st * 1024 + (ob ^ (((ob >> 9) & 1) << 5)); }
__host__ __device__ __forceinline__ void stage_rc(int b, int& R, int& C) { const int st = b / 1024, sb = b % 1024, swz = sb ^ (((sb >> 9) & 1) << 5); R = (st >> 1) * 16 + swz / 64; C = (st & 1) * 32 + (swz % 64) / 2; }
__host__ __device__ __forceinline__ int perm32(int rho) { const int n = rho >> 4, i = rho & 15; return 8 * (i >> 2) + 4 * n + (i & 3); }

struct Unit { int pm, pn; };
struct Gemm { const bf16_t* A; const bf16_t* Bt; int M, N, K; };
struct StaticOrder {
    int nM, nN, nwg, G, c;
    __host__ __device__ void init(int M, int N, int G_, int c_) { nM = M / BM; nN = N / BM; nwg = nM * nN; G = G_; c = c_; }
    __host__ __device__ bool next(int i, Unit& u) const {
        const long L = (long)i * G + c; if (L >= nwg) return false;
        int wgid = (int)L; { const int q = nwg / NXCD, r = nwg % NXCD, xcd = wgid % NXCD, off = wgid / NXCD; wgid = (xcd < r ? xcd * (q + 1) : r * (q + 1) + (xcd - r) * q) + off; }
        const int nig = WGM * nN, gid = wgid / nig, fm = gid * WGM, gsz = (nM - fm) < WGM ? (nM - fm) : WGM;
        u.pm = fm + ((wgid % nig) % gsz); u.pn = (wgid % nig) / gsz; return true;
    }
    __device__ __forceinline__ void a_ready(const Unit&) const {}
    __device__ __forceinline__ void done(const Unit&) const {}
    __device__ __forceinline__ const char* pa(const Gemm& g, const Unit& u) const { return (const char*)g.A + (size_t)u.pm * ((size_t)BM * g.K * 2); }
    __device__ __forceinline__ const char* pb(const Gemm& g, const Unit& u) const { return (const char*)g.Bt + (size_t)u.pn * ((size_t)BM * g.K * 2); }
};
struct InProjOrder {
    StaticOrder so;
    __host__ __device__ void init(int G_, int c_) { so.init(136 * BM, 8 * BM, G_, c_); }
    __host__ __device__ bool next(int i, Unit& u) const { int cnt = -1; for (int j = 0; ; ++j) { if (!so.next(j, u)) return false; if (!(u.pm >= 128 && u.pn < 4)) { if (++cnt == i) return true; } } }
    __device__ __forceinline__ void a_ready(const Unit&) const {}
    __device__ __forceinline__ void done(const Unit&) const {}
    __device__ __forceinline__ const char* pa(const Gemm& g, const Unit& u) const { return u.pn < 6 ? (const char*)g.A + (size_t)u.pm * ((size_t)BM * g.K * 2) : (const char*)g.Bt + (size_t)u.pn * ((size_t)BM * g.K * 2); }
    __device__ __forceinline__ const char* pb(const Gemm& g, const Unit& u) const { return u.pn < 6 ? (const char*)g.Bt + (size_t)u.pn * ((size_t)BM * g.K * 2) : (const char*)g.A + (size_t)u.pm * ((size_t)BM * g.K * 2); }
};

__device__ __forceinline__ unsigned cvt_pk_bf16(float lo, float hi) { unsigned r; asm volatile("v_cvt_pk_bf16_f32 %0, %1, %2" : "=v"(r) : "v"(lo), "v"(hi)); return r; }
struct EpiBf16 {
    static constexpr bool PERM = true, AFTER_DRAIN = false;
    bf16_t* O; int ldc;
    __device__ __forceinline__ void operator()(const f32x4 (&acc)[2][2][4][2], const Unit& u, int wr, int wc, int fr, int fq) const {
        const int row0 = u.pm * BM + wr * 64 + fr, col0 = u.pn * BM + wc * 32 + 8 * fq;
#pragma unroll
        for (int ai = 0; ai < 2; ++ai)
#pragma unroll
            for (int m = 0; m < 4; ++m) { bf16_t* rowp = O + (size_t)(row0 + ai * HALF + m * 16) * ldc + col0;
#pragma unroll
                for (int bj = 0; bj < 2; ++bj) { const f32x4 v0 = acc[ai][bj][m][0], v1 = acc[ai][bj][m][1];
                    u32x4 w; w.x = cvt_pk_bf16(v0[0], v0[1]); w.y = cvt_pk_bf16(v0[2], v0[3]); w.z = cvt_pk_bf16(v1[0], v1[1]); w.w = cvt_pk_bf16(v1[2], v1[3]);
                    *(u32x4*)(rowp + bj * HALF) = w; } }
    }
};
struct EpiX1 {
    static constexpr bool PERM = true, AFTER_DRAIN = false;
    const float* x; const float* mod; bf16_t* out;
    __device__ __forceinline__ void operator()(const f32x4 (&acc)[2][2][4][2], const Unit& u, int wr, int wc, int fr, int fq) const {
        const int row0 = u.pm * BM + wr * 64 + fr, col0 = u.pn * BM + wc * 32 + 8 * fq;
        const float* g1 = mod + (size_t)((u.pm * BM) >> 12) * 6144 + 2048 + col0;
        f32x4 gv[2][2];
#pragma unroll
        for (int bj = 0; bj < 2; ++bj)
#pragma unroll
            for (int n = 0; n < 2; ++n) gv[bj][n] = *(const f32x4*)(g1 + bj * HALF + 4 * n);
#pragma unroll
        for (int ai = 0; ai < 2; ++ai)
#pragma unroll
            for (int m = 0; m < 4; ++m) { const size_t off = (size_t)(row0 + ai * HALF + m * 16) * 1024 + col0;
#pragma unroll
                for (int bj = 0; bj < 2; ++bj) { const f32x4 x0 = *(const f32x4*)(x + off + bj * HALF), x1 = *(const f32x4*)(x + off + bj * HALF + 4);
                    const f32x4 v0 = x0 + gv[bj][0] * acc[ai][bj][m][0], v1 = x1 + gv[bj][1] * acc[ai][bj][m][1];
                    u32x4 w; w.x = cvt_pk_bf16(v0[0], v0[1]); w.y = cvt_pk_bf16(v0[2], v0[3]); w.z = cvt_pk_bf16(v1[0], v1[1]); w.w = cvt_pk_bf16(v1[2], v1[3]);
                    *(u32x4*)(out + off + bj * HALF) = w; } }
    }
};


struct EpiInProj {
    static constexpr bool PERM = true, AFTER_DRAIN = false;
    bf16_t *PB, *QF, *KF, *VF;
    __device__ __forceinline__ void operator()(const f32x4 (&acc)[2][2][4][2], const Unit& u, int wr, int wc, int fr, int fq) const {
        if (u.pn < 6) {
            const int sec = u.pn >> 1, cbase = (u.pn & 1) * 256 + wc * 32 + 8 * fq;
#pragma unroll
            for (int ai = 0; ai < 2; ++ai)
#pragma unroll
                for (int m = 0; m < 4; ++m) { const int T = u.pm * BM + ai * HALF + wr * 64 + m * 16 + fr;
                    int bb, blk; if (T < 32768) { bb = T >> 12; blk = (T & 4095) >> 5; } else { const int cc = T - 32768; bb = cc >> 8; blk = 128 + ((cc & 255) >> 5); }
                    const int tl = T & 31;
#pragma unroll
                    for (int bj = 0; bj < 2; ++bj) { const int c = cbase + HALF * bj; const f32x4 v0 = acc[ai][bj][m][0], v1 = acc[ai][bj][m][1];
                        u32x4 w; w.x = cvt_pk_bf16(v0[0], v0[1]); w.y = cvt_pk_bf16(v0[2], v0[3]); w.z = cvt_pk_bf16(v1[0], v1[1]); w.w = cvt_pk_bf16(v1[2], v1[3]);
                        if (sec == 0) *(u32x4*)(PB + (size_t)T * 512 + c) = w;
                        else { const int h = c >> 6, d0 = c & 63, fo = ((d0 >> 4) * 64 + ((d0 >> 3) & 1) * 32 + tl) * 8;
                            bf16_t* dst = (sec == 1) ? QF + (size_t)((bb * 8 + h) * 128 + blk) * 2048 + fo : KF + (size_t)((bb * 8 + h) * 136 + blk) * 2048 + fo;
                            *(u32x4*)dst = w; } } }
        } else {
            typedef unsigned u32x2 __attribute__((ext_vector_type(2)));
#pragma unroll
            for (int ai = 0; ai < 2; ++ai)
#pragma unroll
                for (int m = 0; m < 4; ++m) { const int vc = (u.pn - 6) * BM + ai * HALF + wr * 64 + m * 16 + fr, h = vc >> 6, dt = (vc >> 5) & 1, dl = vc & 31;
#pragma unroll
                    for (int bj = 0; bj < 2; ++bj) { const int T0 = u.pm * BM + bj * HALF + wc * 32 + 8 * fq;
                        int bb, blk; if (T0 < 32768) { bb = T0 >> 12; blk = (T0 & 4095) >> 5; } else { const int cc = T0 - 32768; bb = cc >> 8; blk = 128 + ((cc & 255) >> 5); }
                        bf16_t* base = VF + ((size_t)(((bb * 8 + h) * 136 + blk) * 2 + dt) * 2 + (fq >> 1)) * 512 + 4 * (fq & 1);
                        const f32x4 v0 = acc[ai][bj][m][0], v1 = acc[ai][bj][m][1];
                        u32x2 w0, w1; w0.x = cvt_pk_bf16(v0[0], v0[1]); w0.y = cvt_pk_bf16(v0[2], v0[3]); w1.x = cvt_pk_bf16(v1[0], v1[1]); w1.y = cvt_pk_bf16(v1[2], v1[3]);
                        *(u32x2*)(base + dl * 8) = w0; *(u32x2*)(base + (32 + dl) * 8) = w1; } }
        }
    }
};

struct EpiQP {
    static constexpr bool PERM = true, AFTER_DRAIN = false;
    bf16_t* QP;
    __device__ __forceinline__ void operator()(const f32x4 (&acc)[2][2][4][2], const Unit& u, int wr, int wc, int fr, int fq) const {
#pragma unroll
        for (int ai = 0; ai < 2; ++ai)
#pragma unroll
            for (int m = 0; m < 4; ++m) { const int T = u.pm * BM + ai * HALF + wr * 64 + m * 16 + fr;
#pragma unroll
                for (int bj = 0; bj < 2; ++bj) { const int hp = 2 * u.pn + bj, ks = 2 * wc + (fq >> 1), hh = fq & 1;
                    const f32x4 v0 = acc[ai][bj][m][0], v1 = acc[ai][bj][m][1];
                    u32x4 w; w.x = cvt_pk_bf16(v0[0], v0[1]); w.y = cvt_pk_bf16(v0[2], v0[3]); w.z = cvt_pk_bf16(v1[0], v1[1]); w.w = cvt_pk_bf16(v1[2], v1[3]);
                    *(u32x4*)(QP + ((size_t)(T >> 5) * 16 + hp) * 4096 + (ks * 64 + hh * 32 + (T & 31)) * 8) = w; } }
    }
};
template <class Epi, class Sched, bool ALIGN_EPI = false, bool SP2 = false>
__device__ __forceinline__ void gemm_phase(PG8_LAS unsigned char* lds, const Gemm g, const Sched& S, const Epi& E) {
    const int tid = threadIdx.x, wid = __builtin_amdgcn_readfirstlane(tid >> 6), lane = tid & 63, wr = wid >> 2, wc = wid & 3, fr = lane & 15, fq = lane >> 4;
    const int K = g.K, nt = K / BK;
    unsigned voffA[2], voffB[2];
#pragma unroll
    for (int i = 0; i < 2; ++i) { int R, C; stage_rc(tid * 16 + i * 8192, R, C); const int Rb = Epi::PERM ? ((R & ~31) + perm32(R & 31)) : R;
        voffA[i] = (unsigned)(R * K + C) * 2u; voffB[i] = (unsigned)(Rb * K + C) * 2u; }
    const size_t kstep = (size_t)(BK * 2);
    const size_t hstep = (size_t)HALF * K * 2;
    const size_t tstep = 2 * hstep;
    const unsigned ldsw = (unsigned)wid * 1024u;
    const int aoff = lds_byte(wr * 64 + fr, fq * 8), boff = lds_byte(wc * 32 + fr, fq * 8);
#define PG8_SA(b, h) (((b) * 2 + (h)) * HTB)
#define PG8_SB(b, h) ((4 + (b) * 2 + (h)) * HTB)
#define PG8_STAGE(bufoff, gbase, voff) do { _Pragma("unroll") for (int _i = 0; _i < 2; ++_i) \
        __builtin_amdgcn_global_load_lds((const unsigned*)((const char*)(gbase) + (voff)[_i]), (PG8_LAS unsigned*)(lds + (bufoff) + ldsw + _i * 8192), 16, 0, 0); } while (0)
#define PG8_LDA(dst, b, h) do { _Pragma("unroll") for (int m = 0; m < 4; ++m) _Pragma("unroll") for (int k = 0; k < 2; ++k) dst[m][k] = *(const PG8_LAS bf16x8*)(lds + PG8_SA(b, h) + aoff + m * 2048 + k * 1024); } while (0)
#define PG8_LDB(dst, b, h) do { _Pragma("unroll") for (int n = 0; n < 2; ++n) _Pragma("unroll") for (int k = 0; k < 2; ++k) dst[n][k] = *(const PG8_LAS bf16x8*)(lds + PG8_SB(b, h) + boff + n * 2048 + k * 1024); } while (0)
#define PG8_MMA(ai, bj, At, Bt) do { __builtin_amdgcn_s_setprio(1); _Pragma("unroll") for (int m = 0; m < 4; ++m) _Pragma("unroll") for (int n = 0; n < 2; ++n) _Pragma("unroll") for (int k = 0; k < 2; ++k) \
        acc[ai][bj][m][n] = __builtin_amdgcn_mfma_f32_16x16x32_bf16(Bt[n][k], At[m][k], acc[ai][bj][m][n], 0, 0, 0); __builtin_amdgcn_s_setprio(0); } while (0)
#define PG8_WAIT_V(n) asm volatile("s_waitcnt vmcnt(" #n ")" ::: "memory")
#define PG8_WAIT_L(n) asm volatile("s_waitcnt lgkmcnt(" #n ")" ::: "memory")
#define PG8_BAR __builtin_amdgcn_s_barrier()
#define PG8_SCHED __builtin_amdgcn_sched_barrier(0)
    Unit cur, nxt; int ui = 0;
    if (!S.next(0, cur)) return;
    f32x4 acc[2][2][4][2];
#pragma unroll
    for (int a = 0; a < 2; ++a)
#pragma unroll
        for (int b = 0; b < 2; ++b)
#pragma unroll
            for (int m = 0; m < 4; ++m)
#pragma unroll
                for (int n = 0; n < 2; ++n) acc[a][b][m][n] = (f32x4){0.f, 0.f, 0.f, 0.f};
    bf16x8 At[4][2], B0[2][2], B1[2][2];
    const char* cA = S.pa(g, cur); const char* cB = S.pb(g, cur);
    S.a_ready(cur);
    if constexpr (SP2) {
        PG8_STAGE(PG8_SB(0, 0), cB, voffB); PG8_STAGE(PG8_SB(0, 1), cB + hstep, voffB); PG8_STAGE(PG8_SA(0, 0), cA, voffA); PG8_STAGE(PG8_SA(0, 1), cA + hstep, voffA);
        if (wr == 1) PG8_BAR;
        PG8_WAIT_V(2); PG8_BAR;
        PG8_STAGE(PG8_SB(1, 0), cB + kstep, voffB); PG8_STAGE(PG8_SA(1, 0), cA + kstep, voffA); PG8_STAGE(PG8_SB(1, 1), cB + hstep + kstep, voffB);
        PG8_WAIT_V(6); PG8_BAR;
    } else {
        PG8_STAGE(PG8_SB(0, 0), cB, voffB); PG8_STAGE(PG8_SA(0, 0), cA, voffA); PG8_STAGE(PG8_SB(0, 1), cB + hstep, voffB); PG8_STAGE(PG8_SA(0, 1), cA + hstep, voffA);
        if (wr == 1) PG8_BAR;
        PG8_WAIT_V(4); PG8_BAR;
        PG8_STAGE(PG8_SB(1, 0), cB + kstep, voffB); PG8_STAGE(PG8_SA(1, 0), cA + kstep, voffA); PG8_STAGE(PG8_SB(1, 1), cB + hstep + kstep, voffB);
        PG8_WAIT_V(6); PG8_BAR;
    }
    for (;;) {
        const bool has_next = S.next(ui + 1, nxt);
        const char* nA = has_next ? S.pa(g, nxt) : cA; const char* nB = has_next ? S.pb(g, nxt) : cB;
        for (int t = 0; t < nt; t += 2) {
            const bool last = (t == nt - 2);
            const char* a1 = cA + (size_t)(t + 1) * kstep;
            const char* a2 = last ? nA : cA + (size_t)(t + 2) * kstep; const char* b2 = last ? nB : cB + (size_t)(t + 2) * kstep;
            const char* a3 = a2 + kstep; const char* b3 = b2 + kstep;
            if (last && has_next) S.a_ready(nxt);
            if constexpr (SP2) {
            PG8_LDB(B0, 0, 0); PG8_LDB(B1, 0, 1); PG8_SCHED; PG8_LDA(At, 0, 0); PG8_STAGE(PG8_SA(1, 1), a1 + hstep, voffA);
            PG8_WAIT_V(8); PG8_WAIT_L(0); PG8_BAR; PG8_MMA(0, 0, At, B0); PG8_MMA(0, 1, At, B1); PG8_BAR; PG8_SCHED;
            PG8_LDA(At, 0, 1); PG8_STAGE(PG8_SB(0, 0), b2, voffB); PG8_STAGE(PG8_SB(0, 1), b2 + hstep, voffB); PG8_STAGE(PG8_SA(0, 0), a2, voffA);
            PG8_WAIT_V(8); PG8_WAIT_L(0); PG8_BAR; PG8_MMA(1, 0, At, B0); PG8_MMA(1, 1, At, B1); PG8_BAR; PG8_SCHED;
            PG8_LDB(B0, 1, 0); PG8_LDB(B1, 1, 1); PG8_SCHED; PG8_LDA(At, 1, 0); PG8_STAGE(PG8_SA(0, 1), a2 + hstep, voffA);
            PG8_WAIT_V(8); PG8_WAIT_L(0); PG8_BAR; PG8_MMA(0, 0, At, B0); PG8_MMA(0, 1, At, B1); PG8_BAR; PG8_SCHED;
            PG8_LDA(At, 1, 1); PG8_STAGE(PG8_SB(1, 0), b3, voffB); PG8_STAGE(PG8_SB(1, 1), b3 + hstep, voffB); PG8_STAGE(PG8_SA(1, 0), a3, voffA);
            PG8_WAIT_V(8); PG8_WAIT_L(0); PG8_BAR; PG8_MMA(1, 0, At, B0); PG8_MMA(1, 1, At, B1); PG8_BAR; PG8_SCHED;
            } else {
            PG8_LDB(B0, 0, 0); PG8_SCHED; PG8_LDA(At, 0, 0); PG8_STAGE(PG8_SA(1, 1), a1 + hstep, voffA);
            PG8_WAIT_L(8); PG8_BAR; PG8_WAIT_L(0); PG8_MMA(0, 0, At, B0); PG8_BAR; PG8_SCHED;
            PG8_LDB(B1, 0, 1); PG8_STAGE(PG8_SB(0, 0), b2, voffB);
            PG8_BAR; PG8_WAIT_L(0); PG8_MMA(0, 1, At, B1); PG8_BAR;
            PG8_LDA(At, 0, 1); PG8_STAGE(PG8_SA(0, 0), a2, voffA);
            PG8_BAR; PG8_WAIT_L(0); PG8_MMA(1, 0, At, B0); PG8_BAR; PG8_SCHED;
            PG8_STAGE(PG8_SB(0, 1), b2 + hstep, voffB);
            PG8_WAIT_V(6); PG8_BAR; PG8_MMA(1, 1, At, B1); PG8_BAR;
            PG8_LDB(B0, 1, 0); PG8_SCHED; PG8_LDA(At, 1, 0); PG8_STAGE(PG8_SA(0, 1), a2 + hstep, voffA);
            PG8_WAIT_L(8); PG8_BAR; PG8_WAIT_L(0); PG8_MMA(0, 0, At, B0); PG8_BAR; PG8_SCHED;
            PG8_LDB(B1, 1, 1); PG8_STAGE(PG8_SB(1, 0), b3, voffB);
            PG8_BAR; PG8_WAIT_L(0); PG8_MMA(0, 1, At, B1); PG8_BAR;
            PG8_LDA(At, 1, 1); PG8_STAGE(PG8_SA(1, 0), a3, voffA);
            PG8_BAR; PG8_WAIT_L(0); PG8_MMA(1, 0, At, B0); PG8_BAR; PG8_SCHED;
            PG8_STAGE(PG8_SB(1, 1), b3 + hstep, voffB);
            PG8_WAIT_V(6); PG8_BAR; PG8_MMA(1, 1, At, B1); PG8_BAR;
            }
        }
        if constexpr (ALIGN_EPI) { if (wr == 0) PG8_BAR; }
        if constexpr (!Epi::AFTER_DRAIN) { E(acc, cur, wr, wc, fr, fq); S.done(cur); }
        if (!has_next) break;
#pragma unroll
        for (int a = 0; a < 2; ++a)
#pragma unroll
            for (int b = 0; b < 2; ++b)
#pragma unroll
                for (int m = 0; m < 4; ++m)
#pragma unroll
                    for (int n = 0; n < 2; ++n) acc[a][b][m][n] = (f32x4){0.f, 0.f, 0.f, 0.f};
        cur = nxt; cA = nA; cB = nB; ++ui;
        if constexpr (ALIGN_EPI) { if (wr == 1) PG8_BAR; }
    }
    PG8_WAIT_V(0);
    if constexpr (!ALIGN_EPI) { if (wr == 0) PG8_BAR; }
    PG8_BAR;
    if constexpr (Epi::AFTER_DRAIN) { E.fused(acc, cur, wr, wc, fr, fq, lds, wid, lane); S.done(cur); }
#undef PG8_SA
#undef PG8_SB
#undef PG8_STAGE
#undef PG8_LDA
#undef PG8_LDB
#undef PG8_MMA
#undef PG8_WAIT_V
#undef PG8_WAIT_L
#undef PG8_BAR
#undef PG8_SCHED
}
}

constexpr int DM = 1024, NBATCH = 8, SEQ = 4096, NTOK = NBATCH * SEQ, CTXL = 256, NCTX = NBATCH * CTXL, MROWS = NTOK + NCTX;
constexpr int DIN = 2048, NHEAD = 8, HD = 64, GRIDW = 64, NMOD = 6 * DM;
constexpr int NEXP = 16384;
constexpr float EPS = 1e-6f;
constexpr int NWAVES = 8;
constexpr int NPHASE = 8;
constexpr float U_SCALE = 64.f, V_SCALE = 4.f;
#ifndef GATHER_NT
#define GATHER_NT 4
#endif
#ifndef MK_N_LAUNCHES
#define MK_N_LAUNCHES 1
#endif
constexpr int N_LAUNCHES = MK_N_LAUNCHES;

constexpr size_t MiB = 1u << 20;
constexpr size_t WS_CTL = 0, CTL_ZERO_BYTES = 64 * 1024;
constexpr size_t WS_WIN = 2 * MiB, WS_WOUT = 6 * MiB, WS_WQ = 8 * MiB, WS_KEYS = 12 * MiB, WS_POOLW = 12 * MiB + 512 * 1024, WS_MOD = 13 * MiB;
constexpr size_t WS_U = 14 * MiB, WS_V = 46 * MiB;
constexpr size_t WS_HX = 78 * MiB;
constexpr size_t WS_ZX = 146 * MiB;
constexpr size_t WS_PB = 146 * MiB, WS_QF = 178 * MiB, WS_KF = 210 * MiB, WS_VF = 244 * MiB;
constexpr size_t WS_MIX = 282 * MiB;
constexpr size_t WS_EXP = 346 * MiB, WS_GATE = 362 * MiB;
constexpr size_t WS_POOLED = 378 * MiB;
constexpr size_t WS_X1 = 378 * MiB;
constexpr size_t WS_LISTS = 410 * MiB;
constexpr size_t WS_END = 442 * MiB;
constexpr int CW_BAR = 4096;

constexpr int RING_OFF = 0, RING_BYTES = 131072;
constexpr int LDSCTL_OFF = RING_BYTES, MISC_OFF = LDSCTL_OFF + 320;
constexpr int LDS_BYTES = 147456;

#define GAS __attribute__((address_space(1)))
#define LAS __attribute__((address_space(3)))
#define DI __device__ __forceinline__
typedef unsigned short bf16;
typedef unsigned v4u __attribute__((ext_vector_type(4)));
typedef unsigned v2u __attribute__((ext_vector_type(2)));
typedef float f32x4 __attribute__((ext_vector_type(4)));
typedef float f32x2 __attribute__((ext_vector_type(2)));
typedef GAS unsigned gu32;
#define RLX_AGENT __ATOMIC_RELAXED, __HIP_MEMORY_SCOPE_AGENT
#define LDS_WAIT() asm volatile("s_waitcnt lgkmcnt(0)" ::: "memory")
#define VM_WAIT() asm volatile("s_waitcnt vmcnt(0)" ::: "memory")
DI unsigned f2bf(float f) { unsigned u = __builtin_bit_cast(unsigned, f); return (u + 0x7fffu + ((u >> 16) & 1u)) >> 16; }
DI unsigned pk2(float lo, float hi) { return f2bf(lo) | (f2bf(hi) << 16); }
DI float bflo(unsigned u) { return __uint_as_float(u << 16); }
DI float bfhi(unsigned u) { return __uint_as_float(u & 0xffff0000u); }
DI float wave_sum(float v) {
#pragma unroll
    for (int o = 1; o < 64; o <<= 1) v += __shfl_xor(v, o);
    return v;
}

#define XB_TMO      128
#define XB_XCNT(j)  (256  + 64 * (j))
#define XB_XSUB(j)  (1280 + 64 * (j))
#define XB_XGEN(j)  (2304 + 64 * (j))
#define XB_TOP      3328
#define XB_TOPGEN   3392
#define XCD_BAR_WORDS 3456
#define XB_SPIN_CAP (1u << 18)

__device__ __forceinline__ unsigned xb_ld(unsigned* p)              { return __hip_atomic_load(p, __ATOMIC_RELAXED, __HIP_MEMORY_SCOPE_AGENT); }
__device__ __forceinline__ unsigned xb_add(unsigned* p, unsigned v) { return __hip_atomic_fetch_add(p, v, __ATOMIC_RELAXED, __HIP_MEMORY_SCOPE_AGENT); }
__device__ __forceinline__ unsigned xb_xcc_id() { return (unsigned)__builtin_amdgcn_s_getreg((3 << 11) | 20) & 0xFu; }
#define XB_SPIN(cond, bar) do { unsigned _sp = 0; while (cond) { __builtin_amdgcn_s_sleep(1); \
    if ((++_sp & 255u) == 0u) { if (xb_ld(&(bar)[XB_TMO])) break; if (_sp > XB_SPIN_CAP) { atomicAdd(&(bar)[XB_TMO], 1u); break; } } } } while (0)

struct XcdBarrier {
    unsigned* bar; unsigned x;
    volatile LAS unsigned* st;
};

__device__ __forceinline__ XcdBarrier xcd_barrier_post(unsigned* bar, volatile LAS unsigned* st) {
    XcdBarrier b; b.bar = bar; b.x = xb_xcc_id(); b.st = st;
    if (threadIdx.x == 0) (void)xb_add(&bar[XB_XCNT(b.x)], 1u);
    return b;
}
__device__ __forceinline__ void xcd_barrier_complete(unsigned* bar, unsigned x, unsigned& nloc, unsigned& nx) {
    const unsigned G = gridDim.x * gridDim.y * gridDim.z;
    unsigned sum, cnt, mine, sp = 0u;
    for (;;) {
        sum = 0u; cnt = 0u; mine = 0u;
#pragma unroll
        for (unsigned j = 0; j < 16; ++j) { const unsigned c = xb_ld(&bar[XB_XCNT(j)]); sum += c; cnt += (c > 0u) ? 1u : 0u; mine = (j == x) ? c : mine; }
        if (sum == G) break;
        __builtin_amdgcn_s_sleep(1);
        if ((++sp & 255u) == 0u) { if (xb_ld(&bar[XB_TMO])) break; if (sp > XB_SPIN_CAP) { atomicAdd(&bar[XB_TMO], 1u); break; } }
    }
    nloc = mine > 0u ? mine : 1u; nx = cnt > 0u ? cnt : 1u;
}

__device__ __forceinline__ void xcd_barrier(const XcdBarrier& b) {
    asm volatile("s_waitcnt vmcnt(0)" ::: "memory");
    __syncthreads();
    if (threadIdx.x == 0) {
        unsigned* bar = b.bar;
        __builtin_amdgcn_s_waitcnt(0);
        unsigned nloc = b.st[0], nx = b.st[1];
        if (nloc == 0u) { xcd_barrier_complete(bar, b.x, nloc, nx); b.st[0] = nloc; b.st[1] = nx; }
        const unsigned old = xb_add(&bar[XB_XSUB(b.x)], 1u);
        const unsigned gen = old / nloc;
        if (old + 1u == (gen + 1u) * nloc) {
            __builtin_amdgcn_fence(__ATOMIC_RELEASE, "agent");
            asm volatile("s_waitcnt vmcnt(0)" ::: "memory");
            const unsigned og = xb_add(&bar[XB_TOP], 1u);
            const unsigned tg = og / nx;
            if (og + 1u == (tg + 1u) * nx) xb_add(&bar[XB_TOPGEN], 1u);
            else XB_SPIN(xb_ld(&bar[XB_TOPGEN]) == tg, bar);
            __builtin_amdgcn_fence(__ATOMIC_ACQUIRE, "agent");
            xb_add(&bar[XB_XGEN(b.x)], 1u);
            asm volatile("s_waitcnt vmcnt(0)" ::: "memory");
        } else {
            XB_SPIN(xb_ld(&bar[XB_XGEN(b.x)]) == gen, bar);
            __builtin_amdgcn_fence(__ATOMIC_ACQUIRE, "agent");
            asm volatile("s_waitcnt vmcnt(0)" ::: "memory");
        }
    }
    __syncthreads();
}


__device__ __forceinline__ void p0_transpose_item(const float* W, int K, int N, bf16* WT, int row_off, LAS float* scr, int item, int lane) {
    const int nblk = N / 32, kb = item / nblk, nb = item % nblk, k0 = 64 * kb, n0 = 32 * nb;
#pragma unroll 8
    for (int i = 0; i < 32; ++i) { const int kk = 2 * i + (lane >> 5); scr[kk * 33 + (lane & 31)] = W[(size_t)(k0 + kk) * N + n0 + (lane & 31)]; }
    LDS_WAIT(); asm volatile("" ::: "memory");
    const int c = lane & 7;
#pragma unroll
    for (int j = 0; j < 4; ++j) { const int n = (lane >> 3) + 8 * j; const LAS float* s = scr + (8 * c) * 33 + n;
        v4u o; o.x = pk2(s[0 * 33], s[1 * 33]); o.y = pk2(s[2 * 33], s[3 * 33]); o.z = pk2(s[4 * 33], s[5 * 33]); o.w = pk2(s[6 * 33], s[7 * 33]);
        *(GAS v4u*)(WT + (size_t)(row_off + n0 + n) * K + k0 + 8 * c) = o; }
    LDS_WAIT(); asm volatile("" ::: "memory");
}


struct Frame {
    LAS unsigned char* lds;
    int tid, lane, wave, vcu, G, gw, NGW;
    const float* in[18]; float* out; unsigned char* ws;
};

DI void p0_prologue(Frame& F) {
    const float* c = F.in[1]; const float* c_ctx = F.in[3]; const float* ada_w = F.in[4]; const float* ada_b = F.in[5];
    float* MOD = (float*)(F.ws + WS_MOD);
    LAS float* sl = (LAS float*)(F.lds + 73728);
    for (int i = F.tid; i < 9 * 1024; i += 512) { const int b = i >> 10, k = i & 1023; const float cv = (b < 8) ? c[b * 1024 + k] : c_ctx[k]; sl[i] = cv / (1.f + __expf(-cv)); }
    __syncthreads();
    for (int a = F.gw; a < NMOD / 16; a += F.NGW) {
        const int n = a * 16 + (F.lane & 15), kg = F.lane >> 4;
        float acc[9];
#pragma unroll
        for (int b = 0; b < 9; ++b) acc[b] = 0.f;
        const float* wp = ada_w + (size_t)(kg * 256) * NMOD + n; const LAS float* sp = sl + kg * 256;
#pragma unroll 8
        for (int i = 0; i < 256; ++i) { const float w = wp[(size_t)i * NMOD];
#pragma unroll
            for (int b = 0; b < 9; ++b) acc[b] += sp[b * 1024 + i] * w; }
#pragma unroll
        for (int b = 0; b < 9; ++b) { acc[b] += __shfl_xor(acc[b], 16); acc[b] += __shfl_xor(acc[b], 32); }
        if (kg == 0) { const float bb = ada_b[n];
#pragma unroll
            for (int b = 0; b < 9; ++b) MOD[b * NMOD + n] = acc[b] + bb; }
    }
    LAS float* scr = (LAS float*)(F.lds + F.wave * 9216);
    constexpr int I_IN = (DM / 64) * (DIN / 32), I_OUT = (DM / 64) * (DM / 32), I_Q = (DM / 64) * (2048 / 32), I_P = 4 * 8;
    for (int it = F.gw; it < I_IN + I_OUT + I_Q + I_P; it += F.NGW) {
        int r = it;
        if (r < I_IN) { p0_transpose_item(F.in[7], DM, DIN, (bf16*)(F.ws + WS_WIN), 0, scr, r, F.lane); continue; } r -= I_IN;
        if (r < I_OUT) { p0_transpose_item(F.in[11], DM, DM, (bf16*)(F.ws + WS_WOUT), 0, scr, r, F.lane); continue; } r -= I_OUT;
        if (r < I_Q) { p0_transpose_item(F.in[13], DM, 2048, (bf16*)(F.ws + WS_WQ), 0, scr, r, F.lane); continue; } r -= I_Q;
        { const int g = r >> 3; p0_transpose_item(F.in[8] + g * 16384, 128, 128, (bf16*)(F.ws + WS_POOLW) + g * 16384, 0, scr, r & 7, F.lane); }
    }
    { const float* kf = F.in[14]; bf16* kb = (bf16*)(F.ws + WS_KEYS);
      for (int it = F.gw; it < 16 * 32; it += F.NGW) { const int hp = it >> 5, nt = (it >> 3) & 3, ks = it & 7;
          const float* src = kf + ((size_t)hp * 128 + 32 * nt + (F.lane & 31)) * 128 + 16 * ks + 8 * (F.lane >> 5);
          const f32x4 a = *(const f32x4*)(src), b = *(const f32x4*)(src + 4);
          v4u w; w.x = pk2(a.x, a.y); w.y = pk2(a.z, a.w); w.z = pk2(b.x, b.y); w.w = pk2(b.z, b.w); *(v4u*)(kb + ((size_t)it * 64 + F.lane) * 8) = w; } }
    for (int it = F.gw; it < 2 * NEXP; it += F.NGW) {
        const bool isu = it < NEXP;
        const float* src = isu ? F.in[15] + (size_t)it * 1024 : F.in[16] + (size_t)(it - NEXP) * 1024;
        unsigned char* dst = isu ? F.ws + WS_U + (size_t)it * 1024 : F.ws + WS_V + (size_t)(it - NEXP) * 1024;
        const float sc = isu ? U_SCALE : V_SCALE;
        const f32x4* sp = (const f32x4*)(src + F.lane * 16);
        v4u w;
#pragma unroll
        for (int j = 0; j < 4; ++j) { const f32x4 a = sp[j] * sc; int pk = 0; pk = __builtin_amdgcn_cvt_pk_fp8_f32(a.x, a.y, pk, false); pk = __builtin_amdgcn_cvt_pk_fp8_f32(a.z, a.w, pk, true); w[j] = (unsigned)pk; }
        *(v4u*)(dst + F.lane * 16) = w;
    }
}

template <bool SRC_BF16> DI void norm_rows(Frame& F, const float* src_x, const float* src_ctx, int nrows, const float* gain, int shift_off, int scale_off, bf16* dst) {
    const float* MOD = (const float*)(F.ws + WS_MOD);
    for (int m = F.gw; m < nrows; m += F.NGW) {
        const float* xrow; int b;
        if (m < NTOK) { xrow = src_x + (size_t)m * DM; b = m >> 12; } else { xrow = src_ctx + (size_t)(m - NTOK) * DM; b = 8; }
        f32x4 v[4]; float s = 0.f;
        if (SRC_BF16) { const v2u* xr = (const v2u*)((const bf16*)src_x + (size_t)m * DM) + F.lane;
#pragma unroll
            for (int j = 0; j < 4; ++j) { const v2u w = xr[64 * j]; v[j] = (f32x4){bflo(w.x), bfhi(w.x), bflo(w.y), bfhi(w.y)}; }
        } else { const f32x4* xr = (const f32x4*)xrow + F.lane;
#pragma unroll
            for (int j = 0; j < 4; ++j) v[j] = xr[64 * j]; }
#pragma unroll
        for (int j = 0; j < 4; ++j) s += (v[j].x * v[j].x + v[j].y * v[j].y) + (v[j].z * v[j].z + v[j].w * v[j].w);
        const float rinv = 1.0f / sqrtf(wave_sum(s) * (1.f / DM) + EPS);
        const f32x4* gp = (const f32x4*)gain + F.lane; const f32x4* shp = (const f32x4*)(MOD + b * NMOD + shift_off) + F.lane; const f32x4* scp = (const f32x4*)(MOD + b * NMOD + scale_off) + F.lane;
        unsigned long long* o8 = (unsigned long long*)(dst + (size_t)m * DM) + F.lane;
#pragma unroll
        for (int j = 0; j < 4; ++j) { const f32x4 g = gp[64 * j], sh = shp[64 * j], sc = scp[64 * j];
            const f32x4 y = (v[j] * rinv) * g * (sc + 1.0f) + sh;
            o8[64 * j] = (unsigned long long)pk2(y.x, y.y) | ((unsigned long long)pk2(y.z, y.w) << 32); }
    }
}

DI void attn_key(const bf16* KF, const bf16* VF, int blkbase, int kk, int dt, float bias, const float (&q)[64], float (&o)[32], float& m, float& l) {
    const bf16* kp = KF + (size_t)blkbase * 2048 + kk * 8;
    float acc = 0.f;
#pragma unroll
    for (int cc = 0; cc < 8; ++cc) { const v4u kv = *(const v4u*)(kp + ((cc >> 1) * 64 + (cc & 1) * 32) * 8);
        acc += q[8 * cc + 0] * bflo(kv.x) + q[8 * cc + 1] * bfhi(kv.x) + q[8 * cc + 2] * bflo(kv.y) + q[8 * cc + 3] * bfhi(kv.y)
             + q[8 * cc + 4] * bflo(kv.z) + q[8 * cc + 5] * bfhi(kv.z) + q[8 * cc + 6] * bflo(kv.w) + q[8 * cc + 7] * bfhi(kv.w); }
    const float s = acc + bias;
    const float mn = fmaxf(m, s), alpha = __expf(m - mn), p = __expf(s - mn);
    l = l * alpha + p; m = mn;
    const bf16* vp = VF + (size_t)blkbase * 2048 + dt * 1024 + (kk >> 4) * 512 + (((kk >> 2) & 1) * 32) * 8 + 4 * ((kk >> 3) & 1) + (kk & 3);
#pragma unroll
    for (int d = 0; d < 32; ++d) o[d] = o[d] * alpha + p * __uint_as_float((unsigned)vp[d * 8] << 16);
}
DI void attn_naive(Frame& F) {
    const bf16* QF = (const bf16*)(F.ws + WS_QF); const bf16* KF = (const bf16*)(F.ws + WS_KF); const bf16* VF = (const bf16*)(F.ws + WS_VF);
    bf16* MIX = (bf16*)(F.ws + WS_MIX); const float* rpb = F.in[10];
    for (int unit2 = F.gw; unit2 < 2 * NBATCH * NHEAD * 64; unit2 += F.NGW) {
        const int unit = unit2 >> 1, dt = unit2 & 1;
        const int r = unit & 63, h = (unit >> 6) & 7, b = unit >> 9, col = F.lane;
        const int tq = b * SEQ + r * GRIDW + col;
        float q[64], o[32];
        { const bf16* qp = QF + (size_t)((b * 8 + h) * 128 + 2 * r + (col >> 5)) * 2048 + (col & 31) * 8;
#pragma unroll
          for (int cc = 0; cc < 8; ++cc) { const v4u qv = *(const v4u*)(qp + ((cc >> 1) * 64 + (cc & 1) * 32) * 8);
              q[8 * cc + 0] = 0.125f * bflo(qv.x); q[8 * cc + 1] = 0.125f * bfhi(qv.x); q[8 * cc + 2] = 0.125f * bflo(qv.y); q[8 * cc + 3] = 0.125f * bfhi(qv.y);
              q[8 * cc + 4] = 0.125f * bflo(qv.z); q[8 * cc + 5] = 0.125f * bfhi(qv.z); q[8 * cc + 6] = 0.125f * bflo(qv.w); q[8 * cc + 7] = 0.125f * bfhi(qv.w); } }
#pragma unroll
        for (int d = 0; d < 32; ++d) o[d] = 0.f;
        float m = -1e30f, l = 0.f;
#pragma unroll 1
        for (int g = 0; g < CTXL; ++g) attn_key(KF, VF, (b * 8 + h) * 136 + 128 + (g >> 5), g & 31, dt, 0.f, q, o, m, l);
        const int r0 = min(max(r - 4, 0), 56), c0 = min(max(col - 8, 0), 48);
#pragma unroll 1
        for (int ij = 0; ij < 128; ++ij) { const int i = ij >> 4, j = ij & 15, kc = c0 + j;
            attn_key(KF, VF, (b * 8 + h) * 136 + 2 * (r0 + i) + (kc >> 5), kc & 31, dt, rpb[(h * 15 + (r0 + i - r + 7)) * 31 + (kc - col + 15)], q, o, m, l); }
        const float il = 1.0f / l;
        v4u* op = (v4u*)(MIX + (size_t)tq * DM + 512 + h * 64 + dt * 32);
#pragma unroll
        for (int cc = 0; cc < 4; ++cc) { v4u w; w.x = pk2(o[8 * cc] * il, o[8 * cc + 1] * il); w.y = pk2(o[8 * cc + 2] * il, o[8 * cc + 3] * il);
            w.z = pk2(o[8 * cc + 4] * il, o[8 * cc + 5] * il); w.w = pk2(o[8 * cc + 6] * il, o[8 * cc + 7] * il); op[cc] = w; }
    }
}
typedef float f32x16 __attribute__((ext_vector_type(16)));
typedef short s16x8 __attribute__((ext_vector_type(8)));
typedef __bf16 bf16x2_t __attribute__((ext_vector_type(2)));
#define MFMA32(a, b, c) __builtin_amdgcn_mfma_f32_32x32x16_bf16((a), (b), (c), 0, 0, 0)
DI unsigned cvtpk(float lo, float hi) { f32x2 v = {lo, hi}; bf16x2_t bb = __builtin_convertvector(v, bf16x2_t); return __builtin_bit_cast(unsigned, bb); }
DI float pairmax(float v) { auto rr = __builtin_amdgcn_permlane32_swap(__float_as_uint(v), __float_as_uint(v), false, false); return fmaxf(__uint_as_float(rr[0]), __uint_as_float(rr[1])); }
constexpr float LOG2E = 1.4426950408889634f, ATT_C2 = 0.125f * LOG2E, ATT_THR = 6.0f;
template <int QMASK, bool LOCAL>
DI void attn_tile(const s16x8 (&kf)[4], const s16x8 (&vf)[4], const LAS s16x8* qfp, f32x16 (&o)[2], float& m, float& l, const LAS float* brow, int djb, int lo) {
    f32x16 s; s16x8 qf[4];
#pragma unroll
    for (int ks = 0; ks < 4; ++ks) qf[ks] = qfp[ks * 64];
#pragma unroll
    for (int i = 0; i < 16; ++i) s[i] = 0.f;
#pragma unroll
    for (int ks = 0; ks < 4; ++ks) s = MFMA32(kf[ks], qf[ks], s);
    float sv[16]; float tmax = -INFINITY;
#pragma unroll
    for (int i = 0; i < 16; ++i) {
        if (!((QMASK >> (i >> 2)) & 1)) { sv[i] = -INFINITY; continue; }
        if (LOCAL) { const int dj = djb + (i & 3) + 8 * (i >> 2); const bool valid = (unsigned)(dj - lo) < 16u;
            const float x = s[i] * ATT_C2 + brow[valid ? dj : 0]; sv[i] = valid ? x : -INFINITY; }
        else sv[i] = s[i] * ATT_C2;
        tmax = fmaxf(tmax, sv[i]);
    }
    tmax = pairmax(tmax);
    if (__any(tmax > m + ATT_THR)) { const float mn = fmaxf(m, tmax), alpha = __builtin_amdgcn_exp2f(m - mn); o[0] *= alpha; o[1] *= alpha; l *= alpha; m = mn; }
    float p[16];
#pragma unroll
    for (int i = 0; i < 16; ++i) { if ((QMASK >> (i >> 2)) & 1) { p[i] = __builtin_amdgcn_exp2f(sv[i] - m); l += p[i]; } else p[i] = 0.f; }
#pragma unroll
    for (int s2 = 0; s2 < 2; ++s2) if (QMASK & (3 << (2 * s2))) {
        v4u pk; pk.x = cvtpk(p[8 * s2], p[8 * s2 + 1]); pk.y = cvtpk(p[8 * s2 + 2], p[8 * s2 + 3]); pk.z = cvtpk(p[8 * s2 + 4], p[8 * s2 + 5]); pk.w = cvtpk(p[8 * s2 + 6], p[8 * s2 + 7]);
        const s16x8 pf = __builtin_bit_cast(s16x8, pk);
        o[0] = MFMA32(vf[s2], pf, o[0]); o[1] = MFMA32(vf[2 + s2], pf, o[1]);
    }
}
DI void attn_mfma(Frame& F) {
    const bf16* QF = (const bf16*)(F.ws + WS_QF); const bf16* KF = (const bf16*)(F.ws + WS_KF); const bf16* VF = (const bf16*)(F.ws + WS_VF);
    bf16* MIX = (bf16*)(F.ws + WS_MIX); const float* rpb = F.in[10];
    LAS float* rp = (LAS float*)(F.lds);
    for (int i = F.tid; i < NHEAD * 15 * 31; i += 512) rp[i] = rpb[i] * LOG2E;
    __syncthreads();
    const int lane = F.lane, hh = lane >> 5, ql = lane & 31;
    int lo[2], djb[2][2];
#pragma unroll
    for (int qb = 0; qb < 2; ++qb) { const int qc = 32 * qb + ql, c0 = min(max(qc - 8, 0), 48); lo[qb] = c0 - qc + 15;
#pragma unroll
        for (int jb = 0; jb < 2; ++jb) djb[qb][jb] = 32 * (jb - qb) + 4 * hh - ql + 15; }
    for (int unit = F.gw; unit < NBATCH * NHEAD * 64; unit += F.NGW) {
        const int r = unit & 63, h = (unit >> 6) & 7, b = unit >> 9, bh = b * 8 + h;
        LAS s16x8* qfl = (LAS s16x8*)(F.lds + 16384 + F.wave * 8192) + lane;
#pragma unroll
        for (int qb = 0; qb < 2; ++qb)
#pragma unroll
            for (int ks = 0; ks < 4; ++ks) qfl[(qb * 4 + ks) * 64] = ((const s16x8*)(QF + (size_t)(bh * 128 + 2 * r + qb) * 2048))[ks * 64 + lane];
        f32x16 o[2][2]; float m[2], l[2];
#pragma unroll
        for (int qb = 0; qb < 2; ++qb) { m[qb] = -1e30f; l[qb] = 0.f;
#pragma unroll
            for (int dt = 0; dt < 2; ++dt)
#pragma unroll
                for (int i = 0; i < 16; ++i) o[qb][dt][i] = 0.f; }
        s16x8 kf[4], vf[4];
#pragma unroll 1
        for (int kb = 0; kb < 8; ++kb) {
            const s16x8* kp = (const s16x8*)(KF + (size_t)(bh * 136 + 128 + kb) * 2048) + lane; const s16x8* vp = (const s16x8*)(VF + (size_t)(bh * 136 + 128 + kb) * 2048) + lane;
#pragma unroll
            for (int j = 0; j < 4; ++j) { kf[j] = kp[j * 64]; vf[j] = vp[j * 64]; }
            attn_tile<15, false>(kf, vf, qfl, o[0], m[0], l[0], rp, 0, 0); __builtin_amdgcn_sched_barrier(0);
            attn_tile<15, false>(kf, vf, qfl + 256, o[1], m[1], l[1], rp, 0, 0); __builtin_amdgcn_sched_barrier(0);
        }
        const int r0 = min(max(r - 4, 0), 56);
#pragma unroll 1
        for (int i = 0; i < 8; ++i) {
            const LAS float* brow = rp + (h * 15 + (r0 + i - r + 7)) * 31;
            { const s16x8* kp = (const s16x8*)(KF + (size_t)(bh * 136 + 2 * (r0 + i)) * 2048) + lane; const s16x8* vp = (const s16x8*)(VF + (size_t)(bh * 136 + 2 * (r0 + i)) * 2048) + lane;
#pragma unroll
              for (int j = 0; j < 4; ++j) { kf[j] = kp[j * 64]; vf[j] = vp[j * 64]; } }
            attn_tile<15, true>(kf, vf, qfl, o[0], m[0], l[0], brow, djb[0][0], lo[0]); __builtin_amdgcn_sched_barrier(0);
            attn_tile<8, true>(kf, vf, qfl + 256, o[1], m[1], l[1], brow, djb[1][0], lo[1]); __builtin_amdgcn_sched_barrier(0);
            { const s16x8* kp = (const s16x8*)(KF + (size_t)(bh * 136 + 2 * (r0 + i) + 1) * 2048) + lane; const s16x8* vp = (const s16x8*)(VF + (size_t)(bh * 136 + 2 * (r0 + i) + 1) * 2048) + lane;
#pragma unroll
              for (int j = 0; j < 4; ++j) { kf[j] = kp[j * 64]; vf[j] = vp[j * 64]; } }
            attn_tile<1, true>(kf, vf, qfl, o[0], m[0], l[0], brow, djb[0][1], lo[0]); __builtin_amdgcn_sched_barrier(0);
            attn_tile<15, true>(kf, vf, qfl + 256, o[1], m[1], l[1], brow, djb[1][1], lo[1]); __builtin_amdgcn_sched_barrier(0);
        }
#pragma unroll
        for (int qb = 0; qb < 2; ++qb) {
            const float lt = l[qb] + __shfl_xor(l[qb], 32), inv = 1.0f / lt;
            bf16* orow = MIX + (size_t)(b * SEQ + r * GRIDW + 32 * qb + ql) * DM + 512 + h * 64 + 4 * hh;
#pragma unroll
            for (int dt = 0; dt < 2; ++dt)
#pragma unroll
                for (int g = 0; g < 4; ++g) { v2u w; w.x = pk2(o[qb][dt][4 * g] * inv, o[qb][dt][4 * g + 1] * inv); w.y = pk2(o[qb][dt][4 * g + 2] * inv, o[qb][dt][4 * g + 3] * inv);
                    *(v2u*)(orow + 32 * dt + 8 * g) = w; }
        }
    }
    __syncthreads();
}
DI void pool_mfma(Frame& F) {
    const bf16* PBF = (const bf16*)(F.ws + WS_PB); bf16* MIX = (bf16*)(F.ws + WS_MIX); const bf16* PW = (const bf16*)(F.ws + WS_POOLW); const float* pool_scale = F.in[9];
    constexpr int RS = 272;
    LAS unsigned char* ptile = F.lds + 32768;
    LAS unsigned char* atile = F.lds + 32768 + 144 * RS;
    const int lane = F.lane, hh = lane >> 5, ql = lane & 31;
    for (int tile = F.vcu; tile < NTOK / 128; tile += F.G) {
        const int tok0 = tile * 128, bstart = tok0 & ~(SEQ - 1);
#pragma unroll 1
        for (int g = 0; g < 4; ++g) {
            for (int it = F.tid; it < 144 * 16; it += 512) { const int rr = it >> 4, ch = it & 15, t = tok0 - 8 + rr;
                v4u v = (v4u){0u, 0u, 0u, 0u};
                if (t >= bstart && t < bstart + SEQ) v = *(const v4u*)(PBF + (size_t)t * 512 + g * 128 + ch * 8);
                *(LAS v4u*)(ptile + rr * RS + ch * 16) = v; }
            __syncthreads();
            { const int cp = F.tid & 63, sg = F.tid >> 6, w = 2 << g, hw = w >> 1;
              const LAS unsigned char* col = ptile + cp * 4;
              float s0 = 0.f, s1 = 0.f;
              const int tl0 = sg * 16;
              for (int rr = tl0 + 8 - hw; rr < tl0 + 8 + hw; ++rr) { const unsigned u = *(const LAS unsigned*)(col + rr * RS); s0 += bflo(u); s1 += bfhi(u); }
#pragma unroll 4
              for (int i = 0; i < 16; ++i) { const int tl = tl0 + i, sp = (tok0 + tl) & (SEQ - 1);
                  const int cnt = min(sp + hw, SEQ) - max(sp - hw, 0); const float inv = 1.0f / (float)cnt;
                  const unsigned self = *(const LAS unsigned*)(col + (tl + 8) * RS);
                  *(LAS unsigned*)(atile + tl * RS + cp * 4) = pk2(s0 * inv - bflo(self), s1 * inv - bfhi(self));
                  const unsigned un = *(const LAS unsigned*)(col + (tl + 8 + hw) * RS), uo = *(const LAS unsigned*)(col + (tl + 8 - hw) * RS);
                  s0 += bflo(un) - bflo(uo); s1 += bfhi(un) - bfhi(uo); } }
            __syncthreads();
            { const int tb = F.wave >> 1, dt0 = (F.wave & 1) * 2;
              f32x16 acc[2];
#pragma unroll
              for (int j = 0; j < 2; ++j)
#pragma unroll
                  for (int i = 0; i < 16; ++i) acc[j][i] = 0.f;
#pragma unroll
              for (int ks = 0; ks < 8; ++ks) {
                  const s16x8 bfr = *(const LAS s16x8*)(atile + (32 * tb + ql) * RS + (16 * ks + 8 * hh) * 2);
#pragma unroll
                  for (int j = 0; j < 2; ++j) { const s16x8 afr = *(const s16x8*)(PW + (size_t)g * 16384 + (32 * (dt0 + j) + ql) * 128 + 16 * ks + 8 * hh);
                      acc[j] = MFMA32(afr, bfr, acc[j]); } }
              bf16* orow = MIX + (size_t)(tok0 + 32 * tb + ql) * DM + g * 128 + 4 * hh;
#pragma unroll
              for (int j = 0; j < 2; ++j)
#pragma unroll
                  for (int q = 0; q < 4; ++q) { const int d = 32 * (dt0 + j) + 8 * q; const f32x4 sc = *(const f32x4*)(pool_scale + g * 128 + d + 4 * hh);
                      v2u wv; wv.x = pk2(acc[j][4 * q] * sc.x, acc[j][4 * q + 1] * sc.y); wv.y = pk2(acc[j][4 * q + 2] * sc.z, acc[j][4 * q + 3] * sc.w);
                      *(v2u*)(orow + d) = wv; } }
            __syncthreads();
        }
    }
}
DI void pool_naive(Frame& F) {
    const bf16* PBF = (const bf16*)(F.ws + WS_PB); bf16* MIX = (bf16*)(F.ws + WS_MIX); bf16* PO = (bf16*)(F.ws + WS_POOLED);
    const float* pool_w = F.in[8]; const float* pool_scale = F.in[9];
    for (int tile = F.vcu; tile < NTOK / 128; tile += F.G) {
        const int tok0 = tile * 128;
        for (int it = F.tid; it < 128 * 64; it += 512) {
            const int t = tok0 + (it >> 6), ch = (it & 63) * 8, g = ch >> 7, w = 2 << g, s = t & (SEQ - 1), tb = t - s;
            const int lo = max(s - w / 2, 0), hi = min(s + w / 2, SEQ);
            float acc[8];
#pragma unroll
            for (int i = 0; i < 8; ++i) acc[i] = 0.f;
            for (int p = lo; p < hi; ++p) { const v4u v = *(const v4u*)(PBF + (size_t)(tb + p) * 512 + ch);
                acc[0] += bflo(v.x); acc[1] += bfhi(v.x); acc[2] += bflo(v.y); acc[3] += bfhi(v.y); acc[4] += bflo(v.z); acc[5] += bfhi(v.z); acc[6] += bflo(v.w); acc[7] += bfhi(v.w); }
            const float inv = 1.0f / (float)(hi - lo);
            const v4u sv = *(const v4u*)(PBF + (size_t)t * 512 + ch);
            v4u wv; wv.x = pk2(acc[0] * inv - bflo(sv.x), acc[1] * inv - bfhi(sv.x)); wv.y = pk2(acc[2] * inv - bflo(sv.y), acc[3] * inv - bfhi(sv.y));
            wv.z = pk2(acc[4] * inv - bflo(sv.z), acc[5] * inv - bfhi(sv.z)); wv.w = pk2(acc[6] * inv - bflo(sv.w), acc[7] * inv - bfhi(sv.w));
            *(v4u*)(PO + (size_t)t * 512 + ch) = wv;
        }
        VM_WAIT(); __syncthreads();
        for (int it = F.wave; it < 1024; it += 8) {
            const int t = tok0 + (it >> 3), g = (it >> 1) & 3, d = (it & 1) * 64 + F.lane;
            const bf16* pr = PO + (size_t)t * 512 + g * 128; const float* wp = pool_w + g * 16384 + d;
            float acc = 0.f;
            for (int c8 = 0; c8 < 16; ++c8) { const v4u pv = *(const v4u*)(pr + c8 * 8); const float* w8 = wp + c8 * 8 * 128;
                acc += bflo(pv.x) * w8[0] + bfhi(pv.x) * w8[128] + bflo(pv.y) * w8[256] + bfhi(pv.y) * w8[384] + bflo(pv.z) * w8[512] + bfhi(pv.z) * w8[640] + bflo(pv.w) * w8[768] + bfhi(pv.w) * w8[896]; }
            MIX[(size_t)t * DM + g * 128 + d] = (bf16)f2bf(acc * pool_scale[g * 128 + d]);
        }
        __syncthreads();
    }
}

DI void peer_topk_naive(Frame& F, int tok0) {
    const bf16* Q = (const bf16*)(F.ws + WS_ZX); const float* keys = F.in[14]; float* LISTS = (float*)(F.ws + WS_LISTS);
    int* EXPERTS = (int*)(F.ws + WS_EXP); float* GATES = (float*)(F.ws + WS_GATE);
    for (int it = F.wave; it < 32; it += 8) {
        const int hp = it & 15, t = tok0 + (it >> 4) * 64 + F.lane;
        float q[128];
        { const v4u* qp = (const v4u*)(Q + (size_t)t * 2048 + hp * 128);
#pragma unroll
          for (int cc = 0; cc < 16; ++cc) { const v4u qv = qp[cc];
              q[8 * cc + 0] = bflo(qv.x); q[8 * cc + 1] = bfhi(qv.x); q[8 * cc + 2] = bflo(qv.y); q[8 * cc + 3] = bfhi(qv.y);
              q[8 * cc + 4] = bflo(qv.z); q[8 * cc + 5] = bfhi(qv.z); q[8 * cc + 6] = bflo(qv.w); q[8 * cc + 7] = bfhi(qv.w); } }
        float top[16];
#pragma unroll
        for (int i = 0; i < 16; ++i) top[i] = -INFINITY;
        const float* kb = keys + (size_t)hp * 16384;
        for (int n = 0; n < 128; ++n) {
            const f32x4* kr = (const f32x4*)(kb + n * 128);
            float acc = 0.f;
#pragma unroll
            for (int cc = 0; cc < 32; ++cc) { const f32x4 kv = kr[cc]; acc += q[4 * cc] * kv.x + q[4 * cc + 1] * kv.y + q[4 * cc + 2] * kv.z + q[4 * cc + 3] * kv.w; }
            float v = __uint_as_float((__float_as_uint(acc) & ~127u) | (unsigned)n);
#pragma unroll
            for (int i = 0; i < 16; ++i) { const float hi = fmaxf(top[i], v); v = fminf(top[i], v); top[i] = hi; }
        }
        f32x4* lp = (f32x4*)(LISTS + ((size_t)t * 16 + hp) * 16);
#pragma unroll
        for (int i = 0; i < 4; ++i) lp[i] = (f32x4){top[4 * i], top[4 * i + 1], top[4 * i + 2], top[4 * i + 3]};
    }
    VM_WAIT(); __syncthreads();
    for (int it = F.tid; it < 128 * 8; it += 512) {
        const int t = tok0 + (it >> 3), h = it & 7;
        float v0[16], v1[16]; int i0[16], i1[16];
        const f32x4* l0 = (const f32x4*)(LISTS + ((size_t)t * 16 + h * 2) * 16);
#pragma unroll
        for (int i = 0; i < 4; ++i) { const f32x4 a = l0[i], b = l0[4 + i];
#pragma unroll
            for (int e = 0; e < 4; ++e) { const unsigned ua = __float_as_uint(a[e]), ub = __float_as_uint(b[e]);
                v0[4 * i + e] = __uint_as_float(ua & ~127u); i0[4 * i + e] = (int)(ua & 127u); v1[4 * i + e] = __uint_as_float(ub & ~127u); i1[4 * i + e] = (int)(ub & 127u); } }
        float tv[16]; int ti[16];
#pragma unroll
        for (int i = 0; i < 16; ++i) { tv[i] = -INFINITY; ti[i] = 0; }
#pragma unroll
        for (int i = 0; i < 16; ++i)
#pragma unroll
            for (int j = 0; j < 16; ++j) if ((i + 1) * (j + 1) <= 16) {
                float cv = v0[i] + v1[j]; int ci = i0[i] * 128 + i1[j];
#pragma unroll
                for (int k = 0; k < 16; ++k) { const bool gt = cv > tv[k]; const float nv = gt ? cv : tv[k]; const int ni = gt ? ci : ti[k]; cv = gt ? tv[k] : cv; ci = gt ? ti[k] : ci; tv[k] = nv; ti[k] = ni; }
            }
        float e[16], sum = 0.f;
#pragma unroll
        for (int k = 0; k < 16; ++k) { e[k] = __expf(tv[k] - tv[0]); sum += e[k]; }
        const float is = 1.0f / sum;
        int* ep = EXPERTS + (size_t)t * 128 + h * 16; float* gp = GATES + (size_t)t * 128 + h * 16;
#pragma unroll
        for (int k = 0; k < 16; ++k) { ep[k] = ti[k]; gp[k] = e[k] * is; }
    }
    VM_WAIT(); __syncthreads();
}

DI int f2key(float f) { const int b = __float_as_int(f); return b ^ ((b >> 31) & 0x7fffffff); }
DI float key2f(int k) { return __int_as_float(k ^ ((k >> 31) & 0x7fffffff)); }
DI void ce_desc(int& x, int& y) { const int hi = max(x, y), lo = min(x, y); x = hi; y = lo; }
DI void sort16_desc(int (&a)[16]) {
#pragma unroll
    for (int k = 2; k <= 16; k <<= 1)
#pragma unroll
        for (int j = k >> 1; j > 0; j >>= 1)
#pragma unroll
            for (int i = 0; i < 16; ++i) { const int l = i ^ j; if (l > i) { if ((i & k) == 0) ce_desc(a[i], a[l]); else ce_desc(a[l], a[i]); } }
}
DI void merge16_desc(int (&a)[16], const int (&b)[16]) {
#pragma unroll
    for (int i = 0; i < 16; ++i) a[i] = max(a[i], b[15 - i]);
#pragma unroll
    for (int j = 8; j > 0; j >>= 1)
#pragma unroll
        for (int i = 0; i < 16; ++i) if ((i & j) == 0) ce_desc(a[i], a[i + j]);
}
DI void peer_topk_mfma(Frame& F, int tile) {
    const bf16* QP = (const bf16*)(F.ws + WS_ZX); const bf16* KEYF = (const bf16*)(F.ws + WS_KEYS);
    int* EXPERTS = (int*)(F.ws + WS_EXP); float* GATES = (float*)(F.ws + WS_GATE);
    const int lane = F.lane, hh = lane >> 5, ql = lane & 31, tb = F.wave >> 1, p = F.wave & 1;
    const int tokblk = tile * 4 + tb, tok = tokblk * 32 + ql;
#pragma unroll 1
    for (int h = 0; h < 8; ++h) {
        const int hp = 2 * h + p;
        s16x8 qf[8];
#pragma unroll
        for (int ks = 0; ks < 8; ++ks) qf[ks] = ((const s16x8*)(QP + ((size_t)tokblk * 16 + hp) * 4096))[ks * 64 + lane];
        const s16x8* kfp = (const s16x8*)(KEYF + (size_t)hp * 16384) + lane;
        int top[16];
#pragma unroll
        for (int i = 0; i < 16; ++i) top[i] = (int)0x80000000;
#pragma unroll 1
        for (int nt = 0; nt < 4; ++nt) {
            f32x16 acc;
#pragma unroll
            for (int i = 0; i < 16; ++i) acc[i] = 0.f;
#pragma unroll
            for (int ks = 0; ks < 8; ++ks) acc = MFMA32(kfp[(nt * 8 + ks) * 64], qf[ks], acc);
            int a[16];
#pragma unroll
            for (int i = 0; i < 16; ++i) { const int n = 32 * nt + (i & 3) + 8 * (i >> 2) + 4 * hh; a[i] = f2key(__int_as_float((__float_as_int(acc[i]) & ~127) | n)); }
            sort16_desc(a);
            merge16_desc(top, a);
        }
        { int oth[16];
#pragma unroll
          for (int i = 0; i < 16; ++i) oth[i] = __shfl_xor(top[i], 32);
          merge16_desc(top, oth); }
        LAS float* L = (LAS float*)(F.lds) + (h & 1) * 4096 + (tb * 2) * 512;
        if (hh == 0) {
#pragma unroll
            for (int i = 0; i < 16; ++i) L[p * 512 + i * 32 + ql] = key2f(top[i]);
        }
        __syncthreads();
        if (p == 0 && hh == 0) {
            float v0[16], v1[16];
#pragma unroll
            for (int i = 0; i < 16; ++i) { v0[i] = __int_as_float(__float_as_int(L[i * 32 + ql]) & ~127); v1[i] = __int_as_float(__float_as_int(L[512 + i * 32 + ql]) & ~127); }
            int grp[4][16]; int cnt = 0;
#pragma unroll
            for (int g = 0; g < 4; ++g)
#pragma unroll
                for (int i = 0; i < 16; ++i) grp[g][i] = (int)0x80000000;
#pragma unroll
            for (int i = 0; i < 16; ++i)
#pragma unroll
                for (int j = 0; j < 16; ++j) if ((i + 1) * (j + 1) <= 16) {
                    grp[cnt >> 4][cnt & 15] = f2key(__int_as_float((__float_as_int(v0[i] + v1[j]) & ~255) | (i * 16 + j))); ++cnt; }
#pragma unroll
            for (int g = 0; g < 4; ++g) sort16_desc(grp[g]);
            merge16_desc(grp[0], grp[1]); merge16_desc(grp[2], grp[3]); merge16_desc(grp[0], grp[2]);
            float tv[16]; float e[16]; float sum = 0.f; int eid[16];
#pragma unroll
            for (int k = 0; k < 16; ++k) { const int bits = __float_as_int(key2f(grp[0][k])); const int code = bits & 255; tv[k] = __int_as_float(bits & ~255);
                const int n0 = __float_as_int(L[(code >> 4) * 32 + ql]) & 127, n1 = __float_as_int(L[512 + (code & 15) * 32 + ql]) & 127; eid[k] = n0 * 128 + n1; }
#pragma unroll
            for (int k = 0; k < 16; ++k) { e[k] = __expf(tv[k] - tv[0]); sum += e[k]; }
            const float is = 1.0f / sum;
            int* ep = EXPERTS + (size_t)tok * 128 + h * 16; float* gp = GATES + (size_t)tok * 128 + h * 16;
#pragma unroll
            for (int k4 = 0; k4 < 4; ++k4) { *(v4u*)(ep + 4 * k4) = (v4u){(unsigned)eid[4 * k4], (unsigned)eid[4 * k4 + 1], (unsigned)eid[4 * k4 + 2], (unsigned)eid[4 * k4 + 3]};
                *(f32x4*)(gp + 4 * k4) = (f32x4){e[4 * k4] * is, e[4 * k4 + 1] * is, e[4 * k4 + 2] * is, e[4 * k4 + 3] * is}; }
        }
    }
    VM_WAIT(); __syncthreads();
}

DI float gelu_exact(float a) { return 0.5f * a * (1.0f + erff(a * 0.70710678118654752f)); }

DI void fp8x16_to_f32(const v4u r, float (&f)[16]) {
#pragma unroll
    for (int j = 0; j < 4; ++j) { const f32x2 lo = __builtin_amdgcn_cvt_pk_f32_fp8((int)r[j], false), hi = __builtin_amdgcn_cvt_pk_f32_fp8((int)r[j], true);
        f[4 * j] = lo.x; f[4 * j + 1] = lo.y; f[4 * j + 2] = hi.x; f[4 * j + 3] = hi.y; }
}
typedef __bf16 bf16x2v __attribute__((ext_vector_type(2)));
#ifndef G2_NOSORT
#define G2_NOSORT 0
#endif
template <int NT, bool FAKE = false> DI void gather_round(Frame& F, int tbase, volatile LAS int* prog, int pbase) {
    constexpr int NK = 2 * NT, N = 128 * NT, NB = N / 8, LPB = 8 / NK;
    const bf16* H2 = (const bf16*)(F.ws + WS_HX); const unsigned char* U = F.ws + WS_U; const unsigned char* V = F.ws + WS_V;
    const int* EXPERTS = (const int*)(F.ws + WS_EXP); const float* GATES = (const float*)(F.ws + WS_GATE); const float* MOD = (const float*)(F.ws + WS_MOD);
    const int lane = F.lane;
    int key[NK];
#pragma unroll
    for (int j = 0; j < NT; ++j)
#pragma unroll
        for (int hf = 0; hf < 2; ++hf) { const int k = hf * 64 + lane; key[j * 2 + hf] = (EXPERTS[(size_t)(tbase + j) * 128 + k] << 9) | (j << 7) | k; }
#pragma unroll
    for (int k = 2; k <= (G2_NOSORT ? 1 : N); k <<= 1)
#pragma unroll
        for (int j = k >> 1; j > 0; j >>= 1) {
            if (j < NK) {
#pragma unroll
                for (int r = 0; r < NK; ++r) if ((r & j) == 0) { const bool asc = (((lane * NK + r) & k) == 0); const int x = key[r], y = key[r | j], lo = min(x, y), hi = max(x, y);
                    key[r] = asc ? lo : hi; key[r | j] = asc ? hi : lo; }
            } else {
                const bool asc = (((lane * NK) & k) == 0), lower = ((lane & (j / NK)) == 0), takemin = (asc == lower);
#pragma unroll
                for (int r = 0; r < NK; ++r) { const int o = __shfl_xor(key[r], j / NK); key[r] = takemin ? min(key[r], o) : max(key[r], o); }
            }
        }
    LAS float* sgL = (LAS float*)(F.lds + 65536) + F.wave * N;
#pragma unroll
    for (int r = 0; r < NK; ++r) sgL[lane * NK + r] = GATES[(size_t)(tbase + ((key[r] >> 7) & 3)) * 128 + (key[r] & 127)];
    unsigned hsp[NT][8]; float out[NT][16];
#pragma unroll
    for (int j = 0; j < NT; ++j) { const v4u a = *((const v4u*)(H2 + (size_t)(tbase + j) * DM + lane * 16)), b = *((const v4u*)(H2 + (size_t)(tbase + j) * DM + lane * 16 + 8));
        hsp[j][0] = a.x; hsp[j][1] = a.y; hsp[j][2] = a.z; hsp[j][3] = a.w; hsp[j][4] = b.x; hsp[j][5] = b.y; hsp[j][6] = b.z; hsp[j][7] = b.w;
#pragma unroll
        for (int i = 0; i < 16; ++i) out[j][i] = 0.f; }
    v4u ucur[8];
#pragma unroll
    for (int r = 0; r < 8; ++r) { const int kk = __builtin_amdgcn_readlane(key[r % NK], r / NK); ucur[r] = *((const v4u*)(U + (size_t)((kk >> 9) & (FAKE ? 7 : 16383)) * 1024) + lane); }
#pragma unroll 1
    for (int b = 0; b < NB; ++b) {
        int kk[8]; v4u vcur[8];
#pragma unroll
        for (int r = 0; r < 8; ++r) { kk[r] = __builtin_amdgcn_readlane(key[r % NK], b * LPB + r / NK); vcur[r] = *((const v4u*)(V + (size_t)((kk[r] >> 9) & (FAKE ? 7 : 16383)) * 1024) + lane); }
        if (lane == 0) *prog = pbase + (kk[0] >> 9);
        float p[8];
#pragma unroll
        for (int r = 0; r < 8; ++r) { const int tk = (kk[r] >> 7) & 3; float acc = 0.f;
#pragma unroll
            for (int j = 0; j < NT; ++j) if (tk == j) {
#pragma unroll
                for (int q = 0; q < 4; ++q) { const bf16x2v lo = __builtin_amdgcn_cvt_scalef32_pk_bf16_fp8((int)ucur[r][q], 1.0f, false), hi = __builtin_amdgcn_cvt_scalef32_pk_bf16_fp8((int)ucur[r][q], 1.0f, true);
                    acc = __builtin_amdgcn_fdot2_f32_bf16(lo, __builtin_bit_cast(bf16x2v, hsp[j][2 * q]), acc, false); acc = __builtin_amdgcn_fdot2_f32_bf16(hi, __builtin_bit_cast(bf16x2v, hsp[j][2 * q + 1]), acc, false); } }
            p[r] = acc; }
        { const int bn = (b + 1 < NB) ? b + 1 : 0;
#pragma unroll
          for (int r = 0; r < 8; ++r) { const int kn = __builtin_amdgcn_readlane(key[r % NK], bn * LPB + r / NK); ucur[r] = *((const v4u*)(U + (size_t)((kn >> 9) & (FAKE ? 7 : 16383)) * 1024) + lane); } }
        { const bool h5 = (lane & 32) != 0;
#pragma unroll
          for (int i = 0; i < 4; ++i) { const float send = h5 ? p[i] : p[i + 4], keep = h5 ? p[i + 4] : p[i]; p[i] = keep + __shfl_xor(send, 32); }
          const bool h4 = (lane & 16) != 0;
#pragma unroll
          for (int i = 0; i < 2; ++i) { const float send = h4 ? p[i] : p[i + 2], keep = h4 ? p[i + 2] : p[i]; p[i] = keep + __shfl_xor(send, 16); }
          const bool h3 = (lane & 8) != 0;
          { const float send = h3 ? p[0] : p[1], keep = h3 ? p[1] : p[0]; p[0] = keep + __shfl_xor(send, 8); }
          p[0] += __shfl_xor(p[0], 4); p[0] += __shfl_xor(p[0], 2); p[0] += __shfl_xor(p[0], 1); }
        const float w = sgL[b * 8 + ((lane >> 3) & 7)] * gelu_exact(p[0] * (1.0f / U_SCALE));
#pragma unroll
        for (int r = 0; r < 8; ++r) { const float wr = __builtin_bit_cast(float, __builtin_amdgcn_readlane(__builtin_bit_cast(int, w), r * 8)); float f[16]; fp8x16_to_f32(vcur[r], f);
            const int tk = (kk[r] >> 7) & 3;
#pragma unroll
            for (int j = 0; j < NT; ++j) if (tk == j) {
#pragma unroll
                for (int i = 0; i < 16; ++i) out[j][i] += wr * f[i]; } }
    }
    const float* fg = F.in[17];
#pragma unroll
    for (int j = 0; j < NT; ++j) {
        const int t = tbase + j, bb = t >> 12; const float* g2 = MOD + bb * NMOD + 5 * DM; float* xo = F.out + (size_t)t * DM;
        const bf16* x1r = (const bf16*)(F.ws + WS_X1) + (size_t)t * DM + lane * 16;
        float x2[16]; float ss = 0.f;
#pragma unroll
        for (int hq = 0; hq < 4; ++hq) { const int c = lane * 16 + hq * 4; const v2u xw = *(const v2u*)(x1r + hq * 4); const f32x4 xv = (f32x4){bflo(xw.x), bfhi(xw.x), bflo(xw.y), bfhi(xw.y)}, gv = *(const f32x4*)(g2 + c);
#pragma unroll
            for (int e = 0; e < 4; ++e) { const float y = xv[e] + gv[e] * (out[j][hq * 4 + e] * (1.0f / V_SCALE)); x2[hq * 4 + e] = y; ss += y * y; } }
        const float rinv = 1.0f / sqrtf(wave_sum(ss) * (1.f / DM) + EPS);
#pragma unroll
        for (int hq = 0; hq < 4; ++hq) { const int c = lane * 16 + hq * 4; const f32x4 fv = *(const f32x4*)(fg + c);
            f32x4 y;
#pragma unroll
            for (int e = 0; e < 4; ++e) y[e] = x2[hq * 4 + e] * rinv * fv[e];
            if (!FAKE || rinv == 12345.678f) *(f32x4*)(xo + c) = y; }
    }
}

#ifdef MB_OP
DI void mb_probe(Frame& F) {
    unsigned x[32];
#pragma unroll
    for (int i = 0; i < 32; ++i) x[i] = F.lane * 2654435761u + i * 40503u + 0x3f800000u;
    const unsigned kc = 0x3c003c00u + F.wave;
#pragma unroll 1
    for (int it = 0; it < MB_ITERS; ++it) {
#pragma unroll
        for (int i = 0; i < 32; ++i) {
#if MB_OP == 0
            asm volatile("v_fmac_f32 %0, %1, %2" : "+v"(x[i]) : "v"(kc), "v"(x[(i + 1) & 31]));
#elif MB_OP == 1
            asm volatile("v_pk_fma_f32 %0, %1, %2, %0" : "+v"(*(unsigned long long*)&x[i & 30]) : "v"(*(unsigned long long*)&x[(i + 2) & 30]), "v"(*(unsigned long long*)&x[(i + 4) & 30]));
#elif MB_OP == 2
            asm volatile("v_cvt_pk_f32_fp8 %0, %1" : "=v"(*(unsigned long long*)&x[i & 30]) : "v"(x[(i + 3) & 31]));
#elif MB_OP == 3
            asm volatile("v_cvt_scalef32_pk_bf16_fp8 %0, %1, 1.0" : "=v"(x[i]) : "v"(x[(i + 3) & 31]));
#elif MB_OP == 4
            asm volatile("v_dot2c_f32_bf16 %0, %1, %2" : "+v"(x[i]) : "v"(kc), "v"(x[(i + 1) & 31]));
#elif MB_OP == 5
            asm volatile("v_dot4_i32_i8 %0, %1, %2, %0" : "+v"(x[i]) : "v"(kc), "v"(x[(i + 1) & 31]));
#elif MB_OP == 6
            asm volatile("v_perm_b32 %0, %1, %2, %3" : "=v"(x[i]) : "v"(x[(i + 1) & 31]), "v"(x[(i + 2) & 31]), "v"(kc));
#elif MB_OP == 7
            asm volatile("v_cvt_f32_ubyte1 %0, %1" : "=v"(x[i]) : "v"(x[(i + 3) & 31]));
#endif
        }
    }
    unsigned acc = 0;
#pragma unroll
    for (int i = 0; i < 32; ++i) acc ^= x[i];
    if (acc == 0x12345u) *(volatile unsigned*)(F.ws + WS_CTL + 32768) = acc;
}
#endif
struct Args { const float* in[18]; float* out; unsigned char* ws; int ph_lo, ph_hi, li, pad; };
__global__ void __launch_bounds__(NWAVES * 64, 2) mk_fwd(Args args) {
    extern __shared__ __attribute__((aligned(16))) unsigned char lds[];
    Frame F;
    F.lds = (LAS unsigned char*)lds;
    F.tid = threadIdx.x; F.lane = F.tid & 63; F.wave = __builtin_amdgcn_readfirstlane(F.tid >> 6);
    F.G = gridDim.x; { const int bx = blockIdx.x; F.vcu = (F.G % 8 == 0) ? (bx % 8) * (F.G / 8) + bx / 8 : bx; }
    F.gw = F.vcu * NWAVES + F.wave; F.NGW = F.G * NWAVES;
#pragma unroll
    for (int i = 0; i < 18; ++i) F.in[i] = args.in[i];
    F.out = args.out; F.ws = args.ws;
    volatile LAS unsigned* MISC = (volatile LAS unsigned*)(F.lds + MISC_OFF);
    for (int u = F.tid; u < (LDS_BYTES - LDSCTL_OFF) / 4; u += NWAVES * 64) ((LAS unsigned*)(F.lds + LDSCTL_OFF))[u] = 0u;
    __syncthreads();
    gu32* ctl = (gu32*)(F.ws + WS_CTL);
    XcdBarrier bar; bar.bar = (unsigned*)(ctl + CW_BAR) + args.li * XCD_BAR_WORDS; bar.x = 0; bar.st = nullptr;
    const int lo = args.ph_lo, hi = args.ph_hi;
    if (hi - lo > 1) bar = xcd_barrier_post((unsigned*)(ctl + CW_BAR) + args.li * XCD_BAR_WORDS, MISC + 8);
#ifndef PROBE_MASK
#define PROBE_MASK 0
#endif
#define REP(k) for (int rep_ = 0; rep_ < 1 + ((PROBE_MASK >> (k)) & 1); ++rep_)
#define IN(k) (lo <= (k) && (k) < hi)
#ifndef PROBE_SEAMS
#define PROBE_SEAMS 1
#endif
#define SEAM(k) do { if (IN(k) && IN((k) + 1)) for (int s_ = 0; s_ < PROBE_SEAMS; ++s_) xcd_barrier(bar); } while (0)

#ifndef SKIP0
    if (IN(0)) { REP(0) { p0_prologue(F); __syncthreads(); } SEAM(0); }
#endif
#ifdef MB_OP
    if (IN(1)) mb_probe(F);
#endif
    if (IN(1)) { REP(1) norm_rows<false>(F, F.in[0], F.in[2], MROWS, F.in[6], 0, DM, (bf16*)(F.ws + WS_HX)); SEAM(1); }
    if (IN(2)) {
        pg8::Gemm g{(const bf16*)(F.ws + WS_HX), (const bf16*)(F.ws + WS_WIN), MROWS, DIN, DM}; pg8::InProjOrder S; S.init(F.G, (int)blockIdx.x);
        pg8::EpiInProj E{(bf16*)(F.ws + WS_PB), (bf16*)(F.ws + WS_QF), (bf16*)(F.ws + WS_KF), (bf16*)(F.ws + WS_VF)};
        REP(2) pg8::gemm_phase<pg8::EpiInProj, pg8::InProjOrder, true, true>(F.lds + RING_OFF, g, S, E);
        SEAM(2);
    }
    if (IN(3)) {
#ifndef SKIP3A
#ifdef ATT_NAIVE
 attn_naive(F);
#else
 REP(3) attn_mfma(F);
#endif
#endif
#ifndef SKIP3B
#ifdef POOL_NAIVE
 pool_naive(F);
#else
 REP(9) pool_mfma(F);
#endif
#endif
 SEAM(3); }
    if (IN(4)) {
        pg8::Gemm g{(const bf16*)(F.ws + WS_MIX), (const bf16*)(F.ws + WS_WOUT), NTOK, DM, DM}; pg8::StaticOrder S; S.init(NTOK, DM, F.G, (int)blockIdx.x);
        pg8::EpiX1 E{F.in[0], (const float*)(F.ws + WS_MOD), (bf16*)(F.ws + WS_X1)};
        REP(4) pg8::gemm_phase<pg8::EpiX1, pg8::StaticOrder, true, true>(F.lds + RING_OFF, g, S, E);
        SEAM(4);
    }
    if (IN(5)) { REP(5) norm_rows<true>(F, (const float*)(F.ws + WS_X1), nullptr, NTOK, F.in[12], 3 * DM, 4 * DM, (bf16*)(F.ws + WS_HX)); SEAM(5); }
    if (IN(6)) {
        pg8::Gemm g{(const bf16*)(F.ws + WS_HX), (const bf16*)(F.ws + WS_WQ), NTOK, 2048, DM}; pg8::StaticOrder S; S.init(NTOK, 2048, F.G, (int)blockIdx.x);
#ifdef TOPK_NAIVE
        pg8::EpiBf16 E{(bf16*)(F.ws + WS_ZX), 2048};
        pg8::gemm_phase<pg8::EpiBf16, pg8::StaticOrder, true, true>(F.lds + RING_OFF, g, S, E);
#else
        pg8::EpiQP E{(bf16*)(F.ws + WS_ZX)};
        REP(6) pg8::gemm_phase<pg8::EpiQP, pg8::StaticOrder, true, true>(F.lds + RING_OFF, g, S, E);
#endif
        SEAM(6);
    }
    if (IN(7)) {
        for (int tile = F.vcu; tile < NTOK / 128; tile += F.G) {
            const int tok0 = tile * 128;
#ifndef SKIP7A
#ifdef TOPK_NAIVE
            peer_topk_naive(F, tok0);
#else
            REP(7) peer_topk_mfma(F, tile);
#endif
#endif
#ifndef SKIP7B
            { volatile LAS int* prog = (volatile LAS int*)(F.lds + 98304);
              if ((PROBE_MASK >> 8) & 1) for (int rd = 0; rd < 4; ++rd) gather_round<4, true>(F, tok0 + rd * 32 + F.wave * 4, prog + F.wave, rd * 16384);
              for (int rd = 0; rd < 4; ++rd) gather_round<4>(F, tok0 + rd * 32 + F.wave * 4, prog + F.wave, rd * 16384); }
#endif
        }
    }
#undef IN
#undef SEAM
}

extern "C" void kernel_launch(void* const* d_in, const int* in_sizes, int n_in, void* d_out, int out_size, void* d_ws, size_t ws_size, hipStream_t stream) {
    static int grid = 0;
    if (grid == 0) {
        if (n_in != 18 || in_sizes[0] != NTOK * DM || out_size != NTOK * DM || ws_size < WS_END) { fprintf(stderr, "kernel_launch: unexpected shapes / workspace (n_in %d, ws %zu); nothing launched\n", n_in, ws_size); grid = -1; return; }
        int dev = 0, cus = 0;
        if (hipGetDevice(&dev) != hipSuccess || hipDeviceGetAttribute(&cus, hipDeviceAttributeMultiprocessorCount, dev) != hipSuccess) { grid = -1; return; }
        if (hipFuncSetAttribute((const void*)mk_fwd, hipFuncAttributeMaxDynamicSharedMemorySize, LDS_BYTES) != hipSuccess) { fprintf(stderr, "kernel_launch: hipFuncSetAttribute failed\n"); grid = -1; return; }
        int per_cu = 0;
        if (hipOccupancyMaxActiveBlocksPerMultiprocessor(&per_cu, (const void*)mk_fwd, NWAVES * 64, LDS_BYTES) != hipSuccess || per_cu < 1) fprintf(stderr, "kernel_launch: note: occupancy query reports %d blocks per CU\n", per_cu);
        (void)hipGetLastError();
        grid = cus;
    }
    if (grid < 0) return;
    (void)hipMemsetAsync((char*)d_ws + WS_CTL, 0, CTL_ZERO_BYTES, stream);
    Args a{};
    for (int i = 0; i < 18; ++i) a.in[i] = (const float*)d_in[i];
    a.out = (float*)d_out; a.ws = (unsigned char*)d_ws;
    for (int li = 0; li < N_LAUNCHES; ++li) {
        if (N_LAUNCHES == 1) { a.ph_lo = 0; a.ph_hi = NPHASE; } else { a.ph_lo = li; a.ph_hi = li + 1; }
        a.li = (N_LAUNCHES == 1) ? 0 : 0;
        hipLaunchKernelGGL(mk_fwd, dim3(grid), dim3(NWAVES * 64), LDS_BYTES, stream, a);
    }
}
```

```cpp
#include <hip/hip_runtime.h>
#include <cstdio>
#include <cstdint>
#include <type_traits>
namespace pg8 {
#define PG8_LAS __attribute__((address_space(3)))
typedef unsigned short bf16_t;
typedef short bf16x8 __attribute__((ext_vector_type(8)));
typedef float f32x4 __attribute__((ext_vector_type(4)));
typedef unsigned u32x4 __attribute__((ext_vector_type(4)));
constexpr int BM = 256, BK = 64, HALF = 128, HTB = HALF * BK * 2  , STAGE_BYTES = 8 * HTB, NXCD = 8, WGM = 8;

__host__ __device__ __forceinline__ int lds_byte(int r, int c) { const int st = (r >> 4) * 2 + (c >> 5), rr = r & 15, cc = c & 31, ob = rr * 64 + cc * 2; return st * 1024 + (ob ^ (((ob >> 9) & 1) << 5)); }
__host__ __device__ __forceinline__ void stage_rc(int b, int& R, int& C) { const int st = b / 1024, sb = b % 1024, swz = sb ^ (((sb >> 9) & 1) << 5); R = (st >> 1) * 16 + swz / 64; C = (st & 1) * 32 + (swz % 64) / 2; }
__host__ __device__ __forceinline__ int perm32(int rho) { const int n = rho >> 4, i = rho & 15; return 8 * (i >> 2) + 4 * n + (i & 3); }

struct Unit { int pm, pn; };
struct Gemm { const bf16_t* A; const bf16_t* Bt; int M, N, K; };
struct StaticOrder {
    int nM, nN, nwg, G, c;
    __host__ __device__ void init(int M, int N, int G_, int c_) { nM = M / BM; nN = N / BM; nwg = nM * nN; G = G_; c = c_; }
    __host__ __device__ bool next(int i, Unit& u) const {
        const long L = (long)i * G + c; if (L >= nwg) return false;
        int wgid = (int)L; { const int q = nwg / NXCD, r = nwg % NXCD, xcd = wgid % NXCD, off = wgid / NXCD; wgid = (xcd < r ? xcd * (q + 1) : r * (q + 1) + (xcd - r) * q) + off; }
        const int nig = WGM * nN, gid = wgid / nig, fm = gid * WGM, gsz = (nM - fm) < WGM ? (nM - fm) : WGM;
        u.pm = fm + ((wgid % nig) % gsz); u.pn = (wgid % nig) / gsz; return true;
    }
    __device__ __forceinline__ void a_ready(const Unit&) const {}
    __device__ __forceinline__ void done(const Unit&) const {}
    __device__ __forceinline__ const char* pa(const Gemm& g, const Unit& u) const { return (const char*)g.A + (size_t)u.pm * ((size_t)BM * g.K * 2); }
    __device__ __forceinline__ const char* pb(const Gemm& g, const Unit& u) const { return (const char*)g.Bt + (size_t)u.pn * ((size_t)BM * g.K * 2); }
};
struct InProjOrder {
    StaticOrder so;
    __host__ __device__ void init(int G_, int c_) { so.init(136 * BM, 8 * BM, G_, c_); }
    __host__ __device__ bool next(int i, Unit& u) const { int cnt = -1; for (int j = 0; ; ++j) { if (!so.next(j, u)) return false; if (!(u.pm >= 128 && u.pn < 4)) { if (++cnt == i) return true; } } }
    __device__ __forceinline__ void a_ready(const Unit&) const {}
    __device__ __forceinline__ void done(const Unit&) const {}
    __device__ __forceinline__ const char* pa(const Gemm& g, const Unit& u) const { return u.pn < 6 ? (const char*)g.A + (size_t)u.pm * ((size_t)BM * g.K * 2) : (const char*)g.Bt + (size_t)u.pn * ((size_t)BM * g.K * 2); }
    __device__ __forceinline__ const char* pb(const Gemm& g, const Unit& u) const { return u.pn < 6 ? (const char*)g.Bt + (size_t)u.pn * ((size_t)BM * g.K * 2) : (const char*)g.A + (size_t)u.pm * ((size_t)BM * g.K * 2); }
};

__device__ __forceinline__ unsigned cvt_pk_bf16(float lo, float hi) { unsigned r; asm volatile("v_cvt_pk_bf16_f32 %0, %1, %2" : "=v"(r) : "v"(lo), "v"(hi)); return r; }
struct EpiBf16 {
    static constexpr bool PERM = true, AFTER_DRAIN = false;
    bf16_t* O; int ldc;
    __device__ __forceinline__ void operator()(const f32x4 (&acc)[2][2][4][2], const Unit& u, int wr, int wc, int fr, int fq) const {
        const int row0 = u.pm * BM + wr * 64 + fr, col0 = u.pn * BM + wc * 32 + 8 * fq;
#pragma unroll
        for (int ai = 0; ai < 2; ++ai)
#pragma unroll
            for (int m = 0; m < 4; ++m) { bf16_t* rowp = O + (size_t)(row0 + ai * HALF + m * 16) * ldc + col0;
#pragma unroll
                for (int bj = 0; bj < 2; ++bj) { const f32x4 v0 = acc[ai][bj][m][0], v1 = acc[ai][bj][m][1];
                    u32x4 w; w.x = cvt_pk_bf16(v0[0], v0[1]); w.y = cvt_pk_bf16(v0[2], v0[3]); w.z = cvt_pk_bf16(v1[0], v1[1]); w.w = cvt_pk_bf16(v1[2], v1[3]);
                    *(u32x4*)(rowp + bj * HALF) = w; } }
    }
};
struct EpiX1 {
    static constexpr bool PERM = true, AFTER_DRAIN = false;
    const float* x; const float* mod; bf16_t* out;
    __device__ __forceinline__ void operator()(const f32x4 (&acc)[2][2][4][2], const Unit& u, int wr, int wc, int fr, int fq) const {
        const int row0 = u.pm * BM + wr * 64 + fr, col0 = u.pn * BM + wc * 32 + 8 * fq;
        const float* g1 = mod + (size_t)((u.pm * BM) >> 12) * 6144 + 2048 + col0;
        f32x4 gv[2][2];
#pragma unroll
        for (int bj = 0; bj < 2; ++bj)
#pragma unroll
            for (int n = 0; n < 2; ++n) gv[bj][n] = *(const f32x4*)(g1 + bj * HALF + 4 * n);
#pragma unroll
        for (int ai = 0; ai < 2; ++ai)
#pragma unroll
            for (int m = 0; m < 4; ++m) { const size_t off = (size_t)(row0 + ai * HALF + m * 16) * 1024 + col0;
#pragma unroll
                for (int bj = 0; bj < 2; ++bj) { const f32x4 x0 = *(const f32x4*)(x + off + bj * HALF), x1 = *(const f32x4*)(x + off + bj * HALF + 4);
                    const f32x4 v0 = x0 + gv[bj][0] * acc[ai][bj][m][0], v1 = x1 + gv[bj][1] * acc[ai][bj][m][1];
                    u32x4 w; w.x = cvt_pk_bf16(v0[0], v0[1]); w.y = cvt_pk_bf16(v0[2], v0[3]); w.z = cvt_pk_bf16(v1[0], v1[1]); w.w = cvt_pk_bf16(v1[2], v1[3]);
                    *(u32x4*)(out + off + bj * HALF) = w; } }
    }
};


struct EpiInProj {
    static constexpr bool PERM = true, AFTER_DRAIN = false;
    bf16_t *PB, *QF, *KF, *VF;
    __device__ __forceinline__ void operator()(const f32x4 (&acc)[2][2][4][2], const Unit& u, int wr, int wc, int fr, int fq) const {
        if (u.pn < 6) {
            const int sec = u.pn >> 1, cbase = (u.pn & 1) * 256 + wc * 32 + 8 * fq;
#pragma unroll
            for (int ai = 0; ai < 2; ++ai)
#pragma unroll
                for (int m = 0; m < 4; ++m) { const int T = u.pm * BM + ai * HALF + wr * 64 + m * 16 + fr;
                    int bb, blk; if (T < 32768) { bb = T >> 12; blk = (T & 4095) >> 5; } else { const int cc = T - 32768; bb = cc >> 8; blk = 128 + ((cc & 255) >> 5); }
                    const int tl = T & 31;
#pragma unroll
                    for (int bj = 0; bj < 2; ++bj) { const int c = cbase + HALF * bj; const f32x4 v0 = acc[ai][bj][m][0], v1 = acc[ai][bj][m][1];
                        u32x4 w; w.x = cvt_pk_bf16(v0[0], v0[1]); w.y = cvt_pk_bf16(v0[2], v0[3]); w.z = cvt_pk_bf16(v1[0], v1[1]); w.w = cvt_pk_bf16(v1[2], v1[3]);
                        if (sec == 0) *(u32x4*)(PB + (size_t)T * 512 + c) = w;
                        else { const int h = c >> 6, d0 = c & 63, fo = ((d0 >> 4) * 64 + ((d0 >> 3) & 1) * 32 + tl) * 8;
                            bf16_t* dst = (sec == 1) ? QF + (size_t)((bb * 8 + h) * 128 + blk) * 2048 + fo : KF + (size_t)((bb * 8 + h) * 136 + blk) * 2048 + fo;
                            *(u32x4*)dst = w; } } }
        } else {
            typedef unsigned u32x2 __attribute__((ext_vector_type(2)));
#pragma unroll
            for (int ai = 0; ai < 2; ++ai)
#pragma unroll
                for (int m = 0; m < 4; ++m) { const int vc = (u.pn - 6) * BM + ai * HALF + wr * 64 + m * 16 + fr, h = vc >> 6, dt = (vc >> 5) & 1, dl = vc & 31;
#pragma unroll
                    for (int bj = 0; bj < 2; ++bj) { const int T0 = u.pm * BM + bj * HALF + wc * 32 + 8 * fq;
                        int bb, blk; if (T0 < 32768) { bb = T0 >> 12; blk = (T0 & 4095) >> 5; } else { const int cc = T0 - 32768; bb = cc >> 8; blk = 128 + ((cc & 255) >> 5); }
                        bf16_t* base = VF + ((size_t)(((bb * 8 + h) * 136 + blk) * 2 + dt) * 2 + (fq >> 1)) * 512 + 4 * (fq & 1);
                        const f32x4 v0 = acc[ai][bj][m][0], v1 = acc[ai][bj][m][1];
                        u32x2 w0, w1; w0.x = cvt_pk_bf16(v0[0], v0[1]); w0.y = cvt_pk_bf16(v0[2], v0[3]); w1.x = cvt_pk_bf16(v1[0], v1[1]); w1.y = cvt_pk_bf16(v1[2], v1[3]);
                        *(u32x2*)(base + dl * 8) = w0; *(u32x2*)(base + (32 + dl) * 8) = w1; } }
        }
    }
};

struct EpiQP {
    static constexpr bool PERM = true, AFTER_DRAIN = false;
    bf16_t* QP;
    __device__ __forceinline__ void operator()(const f32x4 (&acc)[2][2][4][2], const Unit& u, int wr, int wc, int fr, int fq) const {
#pragma unroll
        for (int ai = 0; ai < 2; ++ai)
#pragma unroll
            for (int m = 0; m < 4; ++m) { const int T = u.pm * BM + ai * HALF + wr * 64 + m * 16 + fr;
#pragma unroll
                for (int bj = 0; bj < 2; ++bj) { const int hp = 2 * u.pn + bj, ks = 2 * wc + (fq >> 1), hh = fq & 1;
                    const f32x4 v0 = acc[ai][bj][m][0], v1 = acc[ai][bj][m][1];
                    u32x4 w; w.x = cvt_pk_bf16(v0[0], v0[1]); w.y = cvt_pk_bf16(v0[2], v0[3]); w.z = cvt_pk_bf16(v1[0], v1[1]); w.w = cvt_pk_bf16(v1[2], v1[3]);
                    *(u32x4*)(QP + ((size_t)(T >> 5) * 16 + hp) * 4096 + (ks * 64 + hh * 32 + (T & 31)) * 8) = w; } }
    }
};
template <class Epi, class Sched, bool ALIGN_EPI = false, bool SP2 = false>
__device__ __forceinline__ void gemm_phase(PG8_LAS unsigned char* lds, const Gemm g, const Sched& S, const Epi& E) {
    const int tid = threadIdx.x, wid = __builtin_amdgcn_readfirstlane(tid >> 6), lane = tid & 63, wr = wid >> 2, wc = wid & 3, fr = lane & 15, fq = lane >> 4;
    const int K = g.K, nt = K / BK;
    unsigned voffA[2], voffB[2];
#pragma unroll
    for (int i = 0; i < 2; ++i) { int R, C; stage_rc(tid * 16 + i * 8192, R, C); const int Rb = Epi::PERM ? ((R & ~31) + perm32(R & 31)) : R;
        voffA[i] = (unsigned)(R * K + C) * 2u; voffB[i] = (unsigned)(Rb * K + C) * 2u; }
    const size_t kstep = (size_t)(BK * 2);
    const size_t hstep = (size_t)HALF * K * 2;
    const size_t tstep = 2 * hstep;
    const unsigned ldsw = (unsigned)wid * 1024u;
    const int aoff = lds_byte(wr * 64 + fr, fq * 8), boff = lds_byte(wc * 32 + fr, fq * 8);
#define PG8_SA(b, h) (((b) * 2 + (h)) * HTB)
#define PG8_SB(b, h) ((4 + (b) * 2 + (h)) * HTB)
#define PG8_STAGE(bufoff, gbase, voff) do { _Pragma("unroll") for (int _i = 0; _i < 2; ++_i) \
        __builtin_amdgcn_global_load_lds((const unsigned*)((const char*)(gbase) + (voff)[_i]), (PG8_LAS unsigned*)(lds + (bufoff) + ldsw + _i * 8192), 16, 0, 0); } while (0)
#define PG8_LDA(dst, b, h) do { _Pragma("unroll") for (int m = 0; m < 4; ++m) _Pragma("unroll") for (int k = 0; k < 2; ++k) dst[m][k] = *(const PG8_LAS bf16x8*)(lds + PG8_SA(b, h) + aoff + m * 2048 + k * 1024); } while (0)
#define PG8_LDB(dst, b, h) do { _Pragma("unroll") for (int n = 0; n < 2; ++n) _Pragma("unroll") for (int k = 0; k < 2; ++k) dst[n][k] = *(const PG8_LAS bf16x8*)(lds + PG8_SB(b, h) + boff + n * 2048 + k * 1024); } while (0)
#define PG8_MMA(ai, bj, At, Bt) do { __builtin_amdgcn_s_setprio(1); _Pragma("unroll") for (int m = 0; m < 4; ++m) _Pragma("unroll") for (int n = 0; n < 2; ++n) _Pragma("unroll") for (int k = 0; k < 2; ++k) \
        acc[ai][bj][m][n] = __builtin_amdgcn_mfma_f32_16x16x32_bf16(Bt[n][k], At[m][k], acc[ai][bj][m][n], 0, 0, 0); __builtin_amdgcn_s_setprio(0); } while (0)
#define PG8_WAIT_V(n) asm volatile("s_waitcnt vmcnt(" #n ")" ::: "memory")
#define PG8_WAIT_L(n) asm volatile("s_waitcnt lgkmcnt(" #n ")" ::: "memory")
#define PG8_BAR __builtin_amdgcn_s_barrier()
#define PG8_SCHED __builtin_amdgcn_sched_barrier(0)
    Unit cur, nxt; int ui = 0;
    if (!S.next(0, cur)) return;
    f32x4 acc[2][2][4][2];
#pragma unroll
    for (int a = 0; a < 2; ++a)
#pragma unroll
        for (int b = 0; b < 2; ++b)
#pragma unroll
            for (int m = 0; m < 4; ++m)
#pragma unroll
                for (int n = 0; n < 2; ++n) acc[a][b][m][n] = (f32x4){0.f, 0.f, 0.f, 0.f};
    bf16x8 At[4][2], B0[2][2], B1[2][2];
    const char* cA = S.pa(g, cur); const char* cB = S.pb(g, cur);
    S.a_ready(cur);
    if constexpr (SP2) {
        PG8_STAGE(PG8_SB(0, 0), cB, voffB); PG8_STAGE(PG8_SB(0, 1), cB + hstep, voffB); PG8_STAGE(PG8_SA(0, 0), cA, voffA); PG8_STAGE(PG8_SA(0, 1), cA + hstep, voffA);
        if (wr == 1) PG8_BAR;
        PG8_WAIT_V(2); PG8_BAR;
        PG8_STAGE(PG8_SB(1, 0), cB + kstep, voffB); PG8_STAGE(PG8_SA(1, 0), cA + kstep, voffA); PG8_STAGE(PG8_SB(1, 1), cB + hstep + kstep, voffB);
        PG8_WAIT_V(6); PG8_BAR;
    } else {
        PG8_STAGE(PG8_SB(0, 0), cB, voffB); PG8_STAGE(PG8_SA(0, 0), cA, voffA); PG8_STAGE(PG8_SB(0, 1), cB + hstep, voffB); PG8_STAGE(PG8_SA(0, 1), cA + hstep, voffA);
        if (wr == 1) PG8_BAR;
        PG8_WAIT_V(4); PG8_BAR;
        PG8_STAGE(PG8_SB(1, 0), cB + kstep, voffB); PG8_STAGE(PG8_SA(1, 0), cA + kstep, voffA); PG8_STAGE(PG8_SB(1, 1), cB + hstep + kstep, voffB);
        PG8_WAIT_V(6); PG8_BAR;
    }
    for (;;) {
        const bool has_next = S.next(ui + 1, nxt);
        const char* nA = has_next ? S.pa(g, nxt) : cA; const char* nB = has_next ? S.pb(g, nxt) : cB;
        for (int t = 0; t < nt; t += 2) {
            const bool last = (t == nt - 2);
            const char* a1 = cA + (size_t)(t + 1) * kstep;
            const char* a2 = last ? nA : cA + (size_t)(t + 2) * kstep; const char* b2 = last ? nB : cB + (size_t)(t + 2) * kstep;
            const char* a3 = a2 + kstep; const char* b3 = b2 + kstep;
            if (last && has_next) S.a_ready(nxt);
            if constexpr (SP2) {
            PG8_LDB(B0, 0, 0); PG8_LDB(B1, 0, 1); PG8_SCHED; PG8_LDA(At, 0, 0); PG8_STAGE(PG8_SA(1, 1), a1 + hstep, voffA);
            PG8_WAIT_V(8); PG8_WAIT_L(0); PG8_BAR; PG8_MMA(0, 0, At, B0); PG8_MMA(0, 1, At, B1); PG8_BAR; PG8_SCHED;
            PG8_LDA(At, 0, 1); PG8_STAGE(PG8_SB(0, 0), b2, voffB); PG8_STAGE(PG8_SB(0, 1), b2 + hstep, voffB); PG8_STAGE(PG8_SA(0, 0), a2, voffA);
            PG8_WAIT_V(8); PG8_WAIT_L(0); PG8_BAR; PG8_MMA(1, 0, At, B0); PG8_MMA(1, 1, At, B1); PG8_BAR; PG8_SCHED;
            PG8_LDB(B0, 1, 0); PG8_LDB(B1, 1, 1); PG8_SCHED; PG8_LDA(At, 1, 0); PG8_STAGE(PG8_SA(0, 1), a2 + hstep, voffA);
            PG8_WAIT_V(8); PG8_WAIT_L(0); PG8_BAR; PG8_MMA(0, 0, At, B0); PG8_MMA(0, 1, At, B1); PG8_BAR; PG8_SCHED;
            PG8_LDA(At, 1, 1); PG8_STAGE(PG8_SB(1, 0), b3, voffB); PG8_STAGE(PG8_SB(1, 1), b3 + hstep, voffB); PG8_STAGE(PG8_SA(1, 0), a3, voffA);
            PG8_WAIT_V(8); PG8_WAIT_L(0); PG8_BAR; PG8_MMA(1, 0, At, B0); PG8_MMA(1, 1, At, B1); PG8_BAR; PG8_SCHED;
            } else {
            PG8_LDB(B0, 0, 0); PG8_SCHED; PG8_LDA(At, 0, 0); PG8_STAGE(PG8_SA(1, 1), a1 + hstep, voffA);
            PG8_WAIT_L(8); PG8_BAR; PG8_WAIT_L(0); PG8_MMA(0, 0, At, B0); PG8_BAR; PG8_SCHED;
            PG8_LDB(B1, 0, 1); PG8_STAGE(PG8_SB(0, 0), b2, voffB);
            PG8_BAR; PG8_WAIT_L(0); PG8_MMA(0, 1, At, B1); PG8_BAR;
            PG8_LDA(At, 0, 1); PG8_STAGE(PG8_SA(0, 0), a2, voffA);
            PG8_BAR; PG8_WAIT_L(0); PG8_MMA(1, 0, At, B0); PG8_BAR; PG8_SCHED;
            PG8_STAGE(PG8_SB(0, 1), b2 + hstep, voffB);
            PG8_WAIT_V(6); PG8_BAR; PG8_MMA(1, 1, At, B1); PG8_BAR;
            PG8_LDB(B0, 1, 0); PG8_SCHED; PG8_LDA(At, 1, 0); PG8_STAGE(PG8_SA(0, 1), a2 + hstep, voffA);
            PG8_WAIT_L(8); PG8_BAR; PG8_WAIT_L(0); PG8_MMA(0, 0, At, B0); PG8_BAR; PG8_SCHED;
            PG8_LDB(B1, 1, 1); PG8_STAGE(PG8_SB(1, 0), b3, voffB);
            PG8_BAR; PG8_WAIT_L(0); PG8_MMA(0, 1, At, B1); PG8_BAR;
            PG8_LDA(At, 1, 1); PG8_STAGE(PG8_SA(1, 0), a3, voffA);
            PG8_BAR; PG8_WAIT_L(0); PG8_MMA(1, 0, At, B0); PG8_BAR; PG8_SCHED;
            PG8_STAGE(PG8_SB(1, 1), b3 + hstep, voffB);
            PG8_WAIT_V(6); PG8_BAR; PG8_MMA(1, 1, At, B1); PG8_BAR;
            }
        }
        if constexpr (ALIGN_EPI) { if (wr == 0) PG8_BAR; }
        if constexpr (!Epi::AFTER_DRAIN) { E(acc, cur, wr, wc, fr, fq); S.done(cur); }
        if (!has_next) break;
#pragma unroll
        for (int a = 0; a < 2; ++a)
#pragma unroll
            for (int b = 0; b < 2; ++b)
#pragma unroll
                for (int m = 0; m < 4; ++m)
#pragma unroll
                    for (int n = 0; n < 2; ++n) acc[a][b][m][n] = (f32x4){0.f, 0.f, 0.f, 0.f};
        cur = nxt; cA = nA; cB = nB; ++ui;
        if constexpr (ALIGN_EPI) { if (wr == 1) PG8_BAR; }
    }
    PG8_WAIT_V(0);
    if constexpr (!ALIGN_EPI) { if (wr == 0) PG8_BAR; }
    PG8_BAR;
    if constexpr (Epi::AFTER_DRAIN) { E.fused(acc, cur, wr, wc, fr, fq, lds, wid, lane); S.done(cur); }
#undef PG8_SA
#undef PG8_SB
#undef PG8_STAGE
#undef PG8_LDA
#undef PG8_LDB
#undef PG8_MMA
#undef PG8_WAIT_V
#undef PG8_WAIT_L
#undef PG8_BAR
#undef PG8_SCHED
}
}

constexpr int DM = 1024, NBATCH = 8, SEQ = 4096, NTOK = NBATCH * SEQ, CTXL = 256, NCTX = NBATCH * CTXL, MROWS = NTOK + NCTX;
constexpr int DIN = 2048, NHEAD = 8, HD = 64, GRIDW = 64, NMOD = 6 * DM;
constexpr int NEXP = 16384;
constexpr float EPS = 1e-6f;
constexpr int NWAVES = 8;
constexpr int NPHASE = 8;
constexpr float U_SCALE = 64.f, V_SCALE = 4.f;
#ifndef GATHER_NT
#define GATHER_NT 4
#endif
#ifndef MK_N_LAUNCHES
#define MK_N_LAUNCHES 1
#endif
constexpr int N_LAUNCHES = MK_N_LAUNCHES;

constexpr size_t MiB = 1u << 20;
constexpr size_t WS_CTL = 0, CTL_ZERO_BYTES = 64 * 1024;
constexpr size_t WS_WIN = 2 * MiB, WS_WOUT = 6 * MiB, WS_WQ = 8 * MiB, WS_KEYS = 12 * MiB, WS_POOLW = 12 * MiB + 512 * 1024, WS_MOD = 13 * MiB;
constexpr size_t WS_SU = 13 * MiB + 512 * 1024;
constexpr size_t WS_U = 14 * MiB, WS_V = 46 * MiB;
constexpr size_t WS_HX = 78 * MiB;
constexpr size_t WS_ZX = 146 * MiB;
constexpr size_t WS_PB = 146 * MiB, WS_QF = 178 * MiB, WS_KF = 210 * MiB, WS_VF = 244 * MiB;
constexpr size_t WS_MIX = 282 * MiB;
constexpr size_t WS_EXP = 346 * MiB, WS_GATE = 362 * MiB;
constexpr size_t WS_POOLED = 378 * MiB;
constexpr size_t WS_X1 = 378 * MiB;
constexpr size_t WS_LISTS = 410 * MiB;
constexpr size_t WS_END = 442 * MiB;
constexpr int CW_BAR = 4096;

constexpr int RING_OFF = 0, RING_BYTES = 131072;
constexpr int LDSCTL_OFF = RING_BYTES, MISC_OFF = LDSCTL_OFF + 320;
constexpr int LDS_BYTES = 147456;

#define GAS __attribute__((address_space(1)))
#define LAS __attribute__((address_space(3)))
#define DI __device__ __forceinline__
typedef unsigned short bf16;
typedef unsigned v4u __attribute__((ext_vector_type(4)));
typedef unsigned v2u __attribute__((ext_vector_type(2)));
typedef float f32x4 __attribute__((ext_vector_type(4)));
typedef float f32x2 __attribute__((ext_vector_type(2)));
typedef GAS unsigned gu32;
#define RLX_AGENT __ATOMIC_RELAXED, __HIP_MEMORY_SCOPE_AGENT
#define LDS_WAIT() asm volatile("s_waitcnt lgkmcnt(0)" ::: "memory")
#define VM_WAIT() asm volatile("s_waitcnt vmcnt(0)" ::: "memory")
DI unsigned f2bf(float f) { unsigned u = __builtin_bit_cast(unsigned, f); return (u + 0x7fffu + ((u >> 16) & 1u)) >> 16; }
DI unsigned pk2(float lo, float hi) { return f2bf(lo) | (f2bf(hi) << 16); }
DI float bflo(unsigned u) { return __uint_as_float(u << 16); }
DI float bfhi(unsigned u) { return __uint_as_float(u & 0xffff0000u); }
DI float wave_sum(float v) {
#pragma unroll
    for (int o = 1; o < 64; o <<= 1) v += __shfl_xor(v, o);
    return v;
}

#define XB_TMO      128
#define XB_XCNT(j)  (256  + 64 * (j))
#define XB_XSUB(j)  (1280 + 64 * (j))
#define XB_XGEN(j)  (2304 + 64 * (j))
#define XB_TOP      3328
#define XB_TOPGEN   3392
#define XCD_BAR_WORDS 3456
#define XB_SPIN_CAP (1u << 18)

__device__ __forceinline__ unsigned xb_ld(unsigned* p)              { return __hip_atomic_load(p, __ATOMIC_RELAXED, __HIP_MEMORY_SCOPE_AGENT); }
__device__ __forceinline__ unsigned xb_add(unsigned* p, unsigned v) { return __hip_atomic_fetch_add(p, v, __ATOMIC_RELAXED, __HIP_MEMORY_SCOPE_AGENT); }
__device__ __forceinline__ unsigned xb_xcc_id() { return (unsigned)__builtin_amdgcn_s_getreg((3 << 11) | 20) & 0xFu; }
#define XB_SPIN(cond, bar) do { unsigned _sp = 0; while (cond) { __builtin_amdgcn_s_sleep(1); \
    if ((++_sp & 255u) == 0u) { if (xb_ld(&(bar)[XB_TMO])) break; if (_sp > XB_SPIN_CAP) { atomicAdd(&(bar)[XB_TMO], 1u); break; } } } } while (0)

struct XcdBarrier {
    unsigned* bar; unsigned x;
    volatile LAS unsigned* st;
};

__device__ __forceinline__ XcdBarrier xcd_barrier_post(unsigned* bar, volatile LAS unsigned* st) {
    XcdBarrier b; b.bar = bar; b.x = xb_xcc_id(); b.st = st;
    if (threadIdx.x == 0) (void)xb_add(&bar[XB_XCNT(b.x)], 1u);
    return b;
}
__device__ __forceinline__ void xcd_barrier_complete(unsigned* bar, unsigned x, unsigned& nloc, unsigned& nx) {
    const unsigned G = gridDim.x * gridDim.y * gridDim.z;
    unsigned sum, cnt, mine, sp = 0u;
    for (;;) {
        sum = 0u; cnt = 0u; mine = 0u;
#pragma unroll
        for (unsigned j = 0; j < 16; ++j) { const unsigned c = xb_ld(&bar[XB_XCNT(j)]); sum += c; cnt += (c > 0u) ? 1u : 0u; mine = (j == x) ? c : mine; }
        if (sum == G) break;
        __builtin_amdgcn_s_sleep(1);
        if ((++sp & 255u) == 0u) { if (xb_ld(&bar[XB_TMO])) break; if (sp > XB_SPIN_CAP) { atomicAdd(&bar[XB_TMO], 1u); break; } }
    }
    nloc = mine > 0u ? mine : 1u; nx = cnt > 0u ? cnt : 1u;
}

__device__ __forceinline__ void xcd_barrier(const XcdBarrier& b) {
    asm volatile("s_waitcnt vmcnt(0)" ::: "memory");
    __syncthreads();
    if (threadIdx.x == 0) {
        unsigned* bar = b.bar;
        __builtin_amdgcn_s_waitcnt(0);
        unsigned nloc = b.st[0], nx = b.st[1];
        if (nloc == 0u) { xcd_barrier_complete(bar, b.x, nloc, nx); b.st[0] = nloc; b.st[1] = nx; }
        const unsigned old = xb_add(&bar[XB_XSUB(b.x)], 1u);
        const unsigned gen = old / nloc;
        if (old + 1u == (gen + 1u) * nloc) {
            __builtin_amdgcn_fence(__ATOMIC_RELEASE, "agent");
            asm volatile("s_waitcnt vmcnt(0)" ::: "memory");
            const unsigned og = xb_add(&bar[XB_TOP], 1u);
            const unsigned tg = og / nx;
            if (og + 1u == (tg + 1u) * nx) xb_add(&bar[XB_TOPGEN], 1u);
            else XB_SPIN(xb_ld(&bar[XB_TOPGEN]) == tg, bar);
            __builtin_amdgcn_fence(__ATOMIC_ACQUIRE, "agent");
            xb_add(&bar[XB_XGEN(b.x)], 1u);
            asm volatile("s_waitcnt vmcnt(0)" ::: "memory");
        } else {
            XB_SPIN(xb_ld(&bar[XB_XGEN(b.x)]) == gen, bar);
            __builtin_amdgcn_fence(__ATOMIC_ACQUIRE, "agent");
            asm volatile("s_waitcnt vmcnt(0)" ::: "memory");
        }
    }
    __syncthreads();
}


__device__ __forceinline__ void p0_transpose_item(const float* W, int K, int N, bf16* WT, int row_off, LAS float* scr, int item, int lane) {
    const int nblk = N / 32, kb = item / nblk, nb = item % nblk, k0 = 64 * kb, n0 = 32 * nb;
#pragma unroll 8
    for (int i = 0; i < 32; ++i) { const int kk = 2 * i + (lane >> 5); scr[kk * 33 + (lane & 31)] = W[(size_t)(k0 + kk) * N + n0 + (lane & 31)]; }
    LDS_WAIT(); asm volatile("" ::: "memory");
    const int c = lane & 7;
#pragma unroll
    for (int j = 0; j < 4; ++j) { const int n = (lane >> 3) + 8 * j; const LAS float* s = scr + (8 * c) * 33 + n;
        v4u o; o.x = pk2(s[0 * 33], s[1 * 33]); o.y = pk2(s[2 * 33], s[3 * 33]); o.z = pk2(s[4 * 33], s[5 * 33]); o.w = pk2(s[6 * 33], s[7 * 33]);
        *(GAS v4u*)(WT + (size_t)(row_off + n0 + n) * K + k0 + 8 * c) = o; }
    LDS_WAIT(); asm volatile("" ::: "memory");
}


struct Frame {
    LAS unsigned char* lds;
    int tid, lane, wave, vcu, G, gw, NGW;
    const float* in[18]; float* out; unsigned char* ws;
};

DI void p0_prologue(Frame& F) {
    const float* c = F.in[1]; const float* c_ctx = F.in[3]; const float* ada_w = F.in[4]; const float* ada_b = F.in[5];
    float* MOD = (float*)(F.ws + WS_MOD);
    LAS float* sl = (LAS float*)(F.lds + 73728);
    for (int i = F.tid; i < 9 * 1024; i += 512) { const int b = i >> 10, k = i & 1023; const float cv = (b < 8) ? c[b * 1024 + k] : c_ctx[k]; sl[i] = cv / (1.f + __expf(-cv)); }
    __syncthreads();
    for (int a = F.gw; a < NMOD / 16; a += F.NGW) {
        const int n = a * 16 + (F.lane & 15), kg = F.lane >> 4;
        float acc[9];
#pragma unroll
        for (int b = 0; b < 9; ++b) acc[b] = 0.f;
        const float* wp = ada_w + (size_t)(kg * 256) * NMOD + n; const LAS float* sp = sl + kg * 256;
#pragma unroll 8
        for (int i = 0; i < 256; ++i) { const float w = wp[(size_t)i * NMOD];
#pragma unroll
            for (int b = 0; b < 9; ++b) acc[b] += sp[b * 1024 + i] * w; }
#pragma unroll
        for (int b = 0; b < 9; ++b) { acc[b] += __shfl_xor(acc[b], 16); acc[b] += __shfl_xor(acc[b], 32); }
        if (kg == 0) { const float bb = ada_b[n];
#pragma unroll
            for (int b = 0; b < 9; ++b) MOD[b * NMOD + n] = acc[b] + bb; }
    }
    LAS float* scr = (LAS float*)(F.lds + F.wave * 9216);
    constexpr int I_IN = (DM / 64) * (DIN / 32), I_OUT = (DM / 64) * (DM / 32), I_Q = (DM / 64) * (2048 / 32), I_P = 4 * 8;
    for (int it = F.gw; it < I_IN + I_OUT + I_Q + I_P; it += F.NGW) {
        int r = it;
        if (r < I_IN) { p0_transpose_item(F.in[7], DM, DIN, (bf16*)(F.ws + WS_WIN), 0, scr, r, F.lane); continue; } r -= I_IN;
        if (r < I_OUT) { p0_transpose_item(F.in[11], DM, DM, (bf16*)(F.ws + WS_WOUT), 0, scr, r, F.lane); continue; } r -= I_OUT;
        if (r < I_Q) { p0_transpose_item(F.in[13], DM, 2048, (bf16*)(F.ws + WS_WQ), 0, scr, r, F.lane); continue; } r -= I_Q;
        { const int g = r >> 3; p0_transpose_item(F.in[8] + g * 16384, 128, 128, (bf16*)(F.ws + WS_POOLW) + g * 16384, 0, scr, r & 7, F.lane); }
    }
    { const float* kf = F.in[14]; bf16* kb = (bf16*)(F.ws + WS_KEYS);
      for (int it = F.gw; it < 16 * 32; it += F.NGW) { const int hp = it >> 5, nt = (it >> 3) & 3, ks = it & 7;
          const float* src = kf + ((size_t)hp * 128 + 32 * nt + (F.lane & 31)) * 128 + 16 * ks + 8 * (F.lane >> 5);
          const f32x4 a = *(const f32x4*)(src), b = *(const f32x4*)(src + 4);
          v4u w; w.x = pk2(a.x, a.y); w.y = pk2(a.z, a.w); w.z = pk2(b.x, b.y); w.w = pk2(b.z, b.w); *(v4u*)(kb + ((size_t)it * 64 + F.lane) * 8) = w; } }
    for (int it = F.gw; it < 2 * NEXP; it += F.NGW) {
        const bool isu = it < NEXP;
        const float* src = isu ? F.in[15] + (size_t)it * 1024 : F.in[16] + (size_t)(it - NEXP) * 1024;
        unsigned char* dst = isu ? F.ws + WS_U + (size_t)it * 1024 : F.ws + WS_V + (size_t)(it - NEXP) * 1024;
        const f32x4* sp = (const f32x4*)(src + F.lane * 16);
        f32x4 a[4];
#pragma unroll
        for (int j = 0; j < 4; ++j) a[j] = sp[j];
        v4u w;
        if (isu) {
            float am = 0.f;
#pragma unroll
            for (int j = 0; j < 4; ++j) am = fmaxf(fmaxf(am, fmaxf(fabsf(a[j].x), fabsf(a[j].y))), fmaxf(fabsf(a[j].z), fabsf(a[j].w)));
#pragma unroll
            for (int o = 1; o < 64; o <<= 1) am = fmaxf(am, __shfl_xor(am, o));
            am = fmaxf(am, 1e-30f);
            const float inv = 127.0f / am;
#pragma unroll
            for (int j = 0; j < 4; ++j) { const int q0 = (int)rintf(a[j].x * inv), q1 = (int)rintf(a[j].y * inv), q2 = (int)rintf(a[j].z * inv), q3 = (int)rintf(a[j].w * inv);
                w[j] = (unsigned)(q0 & 255) | ((unsigned)(q1 & 255) << 8) | ((unsigned)(q2 & 255) << 16) | ((unsigned)(q3 & 255) << 24); }
            if (F.lane == 0) ((float*)(F.ws + WS_SU))[it] = am * (1.0f / 127.0f);
        } else {
#pragma unroll
            for (int j = 0; j < 4; ++j) { const f32x4 sv = a[j] * V_SCALE; int pk = 0; pk = __builtin_amdgcn_cvt_pk_fp8_f32(sv.x, sv.y, pk, false); pk = __builtin_amdgcn_cvt_pk_fp8_f32(sv.z, sv.w, pk, true); w[j] = (unsigned)pk; }
        }
        *(v4u*)(dst + F.lane * 16) = w;
    }
}

template <bool SRC_BF16> DI void norm_rows(Frame& F, const float* src_x, const float* src_ctx, int nrows, const float* gain, int shift_off, int scale_off, bf16* dst) {
    const float* MOD = (const float*)(F.ws + WS_MOD);
    for (int m = F.gw; m < nrows; m += F.NGW) {
        const float* xrow; int b;
        if (m < NTOK) { xrow = src_x + (size_t)m * DM; b = m >> 12; } else { xrow = src_ctx + (size_t)(m - NTOK) * DM; b = 8; }
        f32x4 v[4]; float s = 0.f;
        if (SRC_BF16) { const v2u* xr = (const v2u*)((const bf16*)src_x + (size_t)m * DM) + F.lane;
#pragma unroll
            for (int j = 0; j < 4; ++j) { const v2u w = xr[64 * j]; v[j] = (f32x4){bflo(w.x), bfhi(w.x), bflo(w.y), bfhi(w.y)}; }
        } else { const f32x4* xr = (const f32x4*)xrow + F.lane;
#pragma unroll
            for (int j = 0; j < 4; ++j) v[j] = xr[64 * j]; }
#pragma unroll
        for (int j = 0; j < 4; ++j) s += (v[j].x * v[j].x + v[j].y * v[j].y) + (v[j].z * v[j].z + v[j].w * v[j].w);
        const float rinv = 1.0f / sqrtf(wave_sum(s) * (1.f / DM) + EPS);
        const f32x4* gp = (const f32x4*)gain + F.lane; const f32x4* shp = (const f32x4*)(MOD + b * NMOD + shift_off) + F.lane; const f32x4* scp = (const f32x4*)(MOD + b * NMOD + scale_off) + F.lane;
        unsigned long long* o8 = (unsigned long long*)(dst + (size_t)m * DM) + F.lane;
#pragma unroll
        for (int j = 0; j < 4; ++j) { const f32x4 g = gp[64 * j], sh = shp[64 * j], sc = scp[64 * j];
            const f32x4 y = (v[j] * rinv) * g * (sc + 1.0f) + sh;
            o8[64 * j] = (unsigned long long)pk2(y.x, y.y) | ((unsigned long long)pk2(y.z, y.w) << 32); }
    }
}

DI void attn_key(const bf16* KF, const bf16* VF, int blkbase, int kk, int dt, float bias, const float (&q)[64], float (&o)[32], float& m, float& l) {
    const bf16* kp = KF + (size_t)blkbase * 2048 + kk * 8;
    float acc = 0.f;
#pragma unroll
    for (int cc = 0; cc < 8; ++cc) { const v4u kv = *(const v4u*)(kp + ((cc >> 1) * 64 + (cc & 1) * 32) * 8);
        acc += q[8 * cc + 0] * bflo(kv.x) + q[8 * cc + 1] * bfhi(kv.x) + q[8 * cc + 2] * bflo(kv.y) + q[8 * cc + 3] * bfhi(kv.y)
             + q[8 * cc + 4] * bflo(kv.z) + q[8 * cc + 5] * bfhi(kv.z) + q[8 * cc + 6] * bflo(kv.w) + q[8 * cc + 7] * bfhi(kv.w); }
    const float s = acc + bias;
    const float mn = fmaxf(m, s), alpha = __expf(m - mn), p = __expf(s - mn);
    l = l * alpha + p; m = mn;
    const bf16* vp = VF + (size_t)blkbase * 2048 + dt * 1024 + (kk >> 4) * 512 + (((kk >> 2) & 1) * 32) * 8 + 4 * ((kk >> 3) & 1) + (kk & 3);
#pragma unroll
    for (int d = 0; d < 32; ++d) o[d] = o[d] * alpha + p * __uint_as_float((unsigned)vp[d * 8] << 16);
}
DI void attn_naive(Frame& F) {
    const bf16* QF = (const bf16*)(F.ws + WS_QF); const bf16* KF = (const bf16*)(F.ws + WS_KF); const bf16* VF = (const bf16*)(F.ws + WS_VF);
    bf16* MIX = (bf16*)(F.ws + WS_MIX); const float* rpb = F.in[10];
    for (int unit2 = F.gw; unit2 < 2 * NBATCH * NHEAD * 64; unit2 += F.NGW) {
        const int unit = unit2 >> 1, dt = unit2 & 1;
        const int r = unit & 63, h = (unit >> 6) & 7, b = unit >> 9, col = F.lane;
        const int tq = b * SEQ + r * GRIDW + col;
        float q[64], o[32];
        { const bf16* qp = QF + (size_t)((b * 8 + h) * 128 + 2 * r + (col >> 5)) * 2048 + (col & 31) * 8;
#pragma unroll
          for (int cc = 0; cc < 8; ++cc) { const v4u qv = *(const v4u*)(qp + ((cc >> 1) * 64 + (cc & 1) * 32) * 8);
              q[8 * cc + 0] = 0.125f * bflo(qv.x); q[8 * cc + 1] = 0.125f * bfhi(qv.x); q[8 * cc + 2] = 0.125f * bflo(qv.y); q[8 * cc + 3] = 0.125f * bfhi(qv.y);
              q[8 * cc + 4] = 0.125f * bflo(qv.z); q[8 * cc + 5] = 0.125f * bfhi(qv.z); q[8 * cc + 6] = 0.125f * bflo(qv.w); q[8 * cc + 7] = 0.125f * bfhi(qv.w); } }
#pragma unroll
        for (int d = 0; d < 32; ++d) o[d] = 0.f;
        float m = -1e30f, l = 0.f;
#pragma unroll 1
        for (int g = 0; g < CTXL; ++g) attn_key(KF, VF, (b * 8 + h) * 136 + 128 + (g >> 5), g & 31, dt, 0.f, q, o, m, l);
        const int r0 = min(max(r - 4, 0), 56), c0 = min(max(col - 8, 0), 48);
#pragma unroll 1
        for (int ij = 0; ij < 128; ++ij) { const int i = ij >> 4, j = ij & 15, kc = c0 + j;
            attn_key(KF, VF, (b * 8 + h) * 136 + 2 * (r0 + i) + (kc >> 5), kc & 31, dt, rpb[(h * 15 + (r0 + i - r + 7)) * 31 + (kc - col + 15)], q, o, m, l); }
        const float il = 1.0f / l;
        v4u* op = (v4u*)(MIX + (size_t)tq * DM + 512 + h * 64 + dt * 32);
#pragma unroll
        for (int cc = 0; cc < 4; ++cc) { v4u w; w.x = pk2(o[8 * cc] * il, o[8 * cc + 1] * il); w.y = pk2(o[8 * cc + 2] * il, o[8 * cc + 3] * il);
            w.z = pk2(o[8 * cc + 4] * il, o[8 * cc + 5] * il); w.w = pk2(o[8 * cc + 6] * il, o[8 * cc + 7] * il); op[cc] = w; }
    }
}
typedef float f32x16 __attribute__((ext_vector_type(16)));
typedef short s16x8 __attribute__((ext_vector_type(8)));
typedef __bf16 bf16x2_t __attribute__((ext_vector_type(2)));
#define MFMA32(a, b, c) __builtin_amdgcn_mfma_f32_32x32x16_bf16((a), (b), (c), 0, 0, 0)
DI unsigned cvtpk(float lo, float hi) { f32x2 v = {lo, hi}; bf16x2_t bb = __builtin_convertvector(v, bf16x2_t); return __builtin_bit_cast(unsigned, bb); }
DI float pairmax(float v) { auto rr = __builtin_amdgcn_permlane32_swap(__float_as_uint(v), __float_as_uint(v), false, false); return fmaxf(__uint_as_float(rr[0]), __uint_as_float(rr[1])); }
constexpr float LOG2E = 1.4426950408889634f, ATT_C2 = 0.125f * LOG2E, ATT_THR = 6.0f;
template <int QMASK, bool LOCAL>
DI void attn_tile(const s16x8 (&kf)[4], const s16x8 (&vf)[4], const LAS s16x8* qfp, f32x16 (&o)[2], float& m, float& l, const LAS float* brow, int djb, int lo) {
    f32x16 s; s16x8 qf[4];
#pragma unroll
    for (int ks = 0; ks < 4; ++ks) qf[ks] = qfp[ks * 64];
#pragma unroll
    for (int i = 0; i < 16; ++i) s[i] = 0.f;
#pragma unroll
    for (int ks = 0; ks < 4; ++ks) s = MFMA32(kf[ks], qf[ks], s);
    float sv[16]; float tmax = -INFINITY;
#pragma unroll
    for (int i = 0; i < 16; ++i) {
        if (!((QMASK >> (i >> 2)) & 1)) { sv[i] = -INFINITY; continue; }
        if (LOCAL) { const int dj = djb + (i & 3) + 8 * (i >> 2); const bool valid = (unsigned)(dj - lo) < 16u;
            const float x = s[i] * ATT_C2 + brow[valid ? dj : 0]; sv[i] = valid ? x : -INFINITY; }
        else sv[i] = s[i] * ATT_C2;
        tmax = fmaxf(tmax, sv[i]);
    }
    tmax = pairmax(tmax);
    if (__any(tmax > m + ATT_THR)) { const float mn = fmaxf(m, tmax), alpha = __builtin_amdgcn_exp2f(m - mn); o[0] *= alpha; o[1] *= alpha; l *= alpha; m = mn; }
    float p[16];
#pragma unroll
    for (int i = 0; i < 16; ++i) { if ((QMASK >> (i >> 2)) & 1) { p[i] = __builtin_amdgcn_exp2f(sv[i] - m); l += p[i]; } else p[i] = 0.f; }
#pragma unroll
    for (int s2 = 0; s2 < 2; ++s2) if (QMASK & (3 << (2 * s2))) {
        v4u pk; pk.x = cvtpk(p[8 * s2], p[8 * s2 + 1]); pk.y = cvtpk(p[8 * s2 + 2], p[8 * s2 + 3]); pk.z = cvtpk(p[8 * s2 + 4], p[8 * s2 + 5]); pk.w = cvtpk(p[8 * s2 + 6], p[8 * s2 + 7]);
        const s16x8 pf = __builtin_bit_cast(s16x8, pk);
        o[0] = MFMA32(vf[s2], pf, o[0]); o[1] = MFMA32(vf[2 + s2], pf, o[1]);
    }
}
DI void attn_mfma(Frame& F) {
    const bf16* QF = (const bf16*)(F.ws + WS_QF); const bf16* KF = (const bf16*)(F.ws + WS_KF); const bf16* VF = (const bf16*)(F.ws + WS_VF);
    bf16* MIX = (bf16*)(F.ws + WS_MIX); const float* rpb = F.in[10];
    LAS float* rp = (LAS float*)(F.lds);
    for (int i = F.tid; i < NHEAD * 15 * 31; i += 512) rp[i] = rpb[i] * LOG2E;
    __syncthreads();
    const int lane = F.lane, hh = lane >> 5, ql = lane & 31;
    int lo[2], djb[2][2];
#pragma unroll
    for (int qb = 0; qb < 2; ++qb) { const int qc = 32 * qb + ql, c0 = min(max(qc - 8, 0), 48); lo[qb] = c0 - qc + 15;
#pragma unroll
        for (int jb = 0; jb < 2; ++jb) djb[qb][jb] = 32 * (jb - qb) + 4 * hh - ql + 15; }
    for (int unit = F.gw; unit < NBATCH * NHEAD * 64; unit += F.NGW) {
        const int r = unit & 63, h = (unit >> 6) & 7, b = unit >> 9, bh = b * 8 + h;
        LAS s16x8* qfl = (LAS s16x8*)(F.lds + 16384 + F.wave * 8192) + lane;
#pragma unroll
        for (int qb = 0; qb < 2; ++qb)
#pragma unroll
            for (int ks = 0; ks < 4; ++ks) qfl[(qb * 4 + ks) * 64] = ((const s16x8*)(QF + (size_t)(bh * 128 + 2 * r + qb) * 2048))[ks * 64 + lane];
        f32x16 o[2][2]; float m[2], l[2];
#pragma unroll
        for (int qb = 0; qb < 2; ++qb) { m[qb] = -1e30f; l[qb] = 0.f;
#pragma unroll
            for (int dt = 0; dt < 2; ++dt)
#pragma unroll
                for (int i = 0; i < 16; ++i) o[qb][dt][i] = 0.f; }
        s16x8 kf[4], vf[4];
#pragma unroll 1
        for (int kb = 0; kb < 8; ++kb) {
            const s16x8* kp = (const s16x8*)(KF + (size_t)(bh * 136 + 128 + kb) * 2048) + lane; const s16x8* vp = (const s16x8*)(VF + (size_t)(bh * 136 + 128 + kb) * 2048) + lane;
#pragma unroll
            for (int j = 0; j < 4; ++j) { kf[j] = kp[j * 64]; vf[j] = vp[j * 64]; }
            attn_tile<15, false>(kf, vf, qfl, o[0], m[0], l[0], rp, 0, 0); __builtin_amdgcn_sched_barrier(0);
            attn_tile<15, false>(kf, vf, qfl + 256, o[1], m[1], l[1], rp, 0, 0); __builtin_amdgcn_sched_barrier(0);
        }
        const int r0 = min(max(r - 4, 0), 56);
#pragma unroll 1
        for (int i = 0; i < 8; ++i) {
            const LAS float* brow = rp + (h * 15 + (r0 + i - r + 7)) * 31;
            { const s16x8* kp = (const s16x8*)(KF + (size_t)(bh * 136 + 2 * (r0 + i)) * 2048) + lane; const s16x8* vp = (const s16x8*)(VF + (size_t)(bh * 136 + 2 * (r0 + i)) * 2048) + lane;
#pragma unroll
              for (int j = 0; j < 4; ++j) { kf[j] = kp[j * 64]; vf[j] = vp[j * 64]; } }
            attn_tile<15, true>(kf, vf, qfl, o[0], m[0], l[0], brow, djb[0][0], lo[0]); __builtin_amdgcn_sched_barrier(0);
            attn_tile<8, true>(kf, vf, qfl + 256, o[1], m[1], l[1], brow, djb[1][0], lo[1]); __builtin_amdgcn_sched_barrier(0);
            { const s16x8* kp = (const s16x8*)(KF + (size_t)(bh * 136 + 2 * (r0 + i) + 1) * 2048) + lane; const s16x8* vp = (const s16x8*)(VF + (size_t)(bh * 136 + 2 * (r0 + i) + 1) * 2048) + lane;
#pragma unroll
              for (int j = 0; j < 4; ++j) { kf[j] = kp[j * 64]; vf[j] = vp[j * 64]; } }
            attn_tile<1, true>(kf, vf, qfl, o[0], m[0], l[0], brow, djb[0][1], lo[0]); __builtin_amdgcn_sched_barrier(0);
            attn_tile<15, true>(kf, vf, qfl + 256, o[1], m[1], l[1], brow, djb[1][1], lo[1]); __builtin_amdgcn_sched_barrier(0);
        }
#pragma unroll
        for (int qb = 0; qb < 2; ++qb) {
            const float lt = l[qb] + __shfl_xor(l[qb], 32), inv = 1.0f / lt;
            bf16* orow = MIX + (size_t)(b * SEQ + r * GRIDW + 32 * qb + ql) * DM + 512 + h * 64 + 4 * hh;
#pragma unroll
            for (int dt = 0; dt < 2; ++dt)
#pragma unroll
                for (int g = 0; g < 4; ++g) { v2u w; w.x = pk2(o[qb][dt][4 * g] * inv, o[qb][dt][4 * g + 1] * inv); w.y = pk2(o[qb][dt][4 * g + 2] * inv, o[qb][dt][4 * g + 3] * inv);
                    *(v2u*)(orow + 32 * dt + 8 * g) = w; }
        }
    }
    __syncthreads();
}
DI void pool_mfma(Frame& F) {
    const bf16* PBF = (const bf16*)(F.ws + WS_PB); bf16* MIX = (bf16*)(F.ws + WS_MIX); const bf16* PW = (const bf16*)(F.ws + WS_POOLW); const float* pool_scale = F.in[9];
    constexpr int RS = 272;
    LAS unsigned char* ptile = F.lds + 32768;
    LAS unsigned char* atile = F.lds + 32768 + 144 * RS;
    const int lane = F.lane, hh = lane >> 5, ql = lane & 31;
    for (int tile = F.vcu; tile < NTOK / 128; tile += F.G) {
        const int tok0 = tile * 128, bstart = tok0 & ~(SEQ - 1);
#pragma unroll 1
        for (int g = 0; g < 4; ++g) {
            for (int it = F.tid; it < 144 * 16; it += 512) { const int rr = it >> 4, ch = it & 15, t = tok0 - 8 + rr;
                v4u v = (v4u){0u, 0u, 0u, 0u};
                if (t >= bstart && t < bstart + SEQ) v = *(const v4u*)(PBF + (size_t)t * 512 + g * 128 + ch * 8);
                *(LAS v4u*)(ptile + rr * RS + ch * 16) = v; }
            __syncthreads();
            { const int cp = F.tid & 63, sg = F.tid >> 6, w = 2 << g, hw = w >> 1;
              const LAS unsigned char* col = ptile + cp * 4;
              float s0 = 0.f, s1 = 0.f;
              const int tl0 = sg * 16;
              for (int rr = tl0 + 8 - hw; rr < tl0 + 8 + hw; ++rr) { const unsigned u = *(const LAS unsigned*)(col + rr * RS); s0 += bflo(u); s1 += bfhi(u); }
#pragma unroll 4
              for (int i = 0; i < 16; ++i) { const int tl = tl0 + i, sp = (tok0 + tl) & (SEQ - 1);
                  const int cnt = min(sp + hw, SEQ) - max(sp - hw, 0); const float inv = 1.0f / (float)cnt;
                  const unsigned self = *(const LAS unsigned*)(col + (tl + 8) * RS);
                  *(LAS unsigned*)(atile + tl * RS + cp * 4) = pk2(s0 * inv - bflo(self), s1 * inv - bfhi(self));
                  const unsigned un = *(const LAS unsigned*)(col + (tl + 8 + hw) * RS), uo = *(const LAS unsigned*)(col + (tl + 8 - hw) * RS);
                  s0 += bflo(un) - bflo(uo); s1 += bfhi(un) - bfhi(uo); } }
            __syncthreads();
            { const int tb = F.wave >> 1, dt0 = (F.wave & 1) * 2;
              f32x16 acc[2];
#pragma unroll
              for (int j = 0; j < 2; ++j)
#pragma unroll
                  for (int i = 0; i < 16; ++i) acc[j][i] = 0.f;
#pragma unroll
              for (int ks = 0; ks < 8; ++ks) {
                  const s16x8 bfr = *(const LAS s16x8*)(atile + (32 * tb + ql) * RS + (16 * ks + 8 * hh) * 2);
#pragma unroll
                  for (int j = 0; j < 2; ++j) { const s16x8 afr = *(const s16x8*)(PW + (size_t)g * 16384 + (32 * (dt0 + j) + ql) * 128 + 16 * ks + 8 * hh);
                      acc[j] = MFMA32(afr, bfr, acc[j]); } }
              bf16* orow = MIX + (size_t)(tok0 + 32 * tb + ql) * DM + g * 128 + 4 * hh;
#pragma unroll
              for (int j = 0; j < 2; ++j)
#pragma unroll
                  for (int q = 0; q < 4; ++q) { const int d = 32 * (dt0 + j) + 8 * q; const f32x4 sc = *(const f32x4*)(pool_scale + g * 128 + d + 4 * hh);
                      v2u wv; wv.x = pk2(acc[j][4 * q] * sc.x, acc[j][4 * q + 1] * sc.y); wv.y = pk2(acc[j][4 * q + 2] * sc.z, acc[j][4 * q + 3] * sc.w);
                      *(v2u*)(orow + d) = wv; } }
            __syncthreads();
        }
    }
}
DI void pool_naive(Frame& F) {
    const bf16* PBF = (const bf16*)(F.ws + WS_PB); bf16* MIX = (bf16*)(F.ws + WS_MIX); bf16* PO = (bf16*)(F.ws + WS_POOLED);
    const float* pool_w = F.in[8]; const float* pool_scale = F.in[9];
    for (int tile = F.vcu; tile < NTOK / 128; tile += F.G) {
        const int tok0 = tile * 128;
        for (int it = F.tid; it < 128 * 64; it += 512) {
            const int t = tok0 + (it >> 6), ch = (it & 63) * 8, g = ch >> 7, w = 2 << g, s = t & (SEQ - 1), tb = t - s;
            const int lo = max(s - w / 2, 0), hi = min(s + w / 2, SEQ);
            float acc[8];
#pragma unroll
            for (int i = 0; i < 8; ++i) acc[i] = 0.f;
            for (int p = lo; p < hi; ++p) { const v4u v = *(const v4u*)(PBF + (size_t)(tb + p) * 512 + ch);
                acc[0] += bflo(v.x); acc[1] += bfhi(v.x); acc[2] += bflo(v.y); acc[3] += bfhi(v.y); acc[4] += bflo(v.z); acc[5] += bfhi(v.z); acc[6] += bflo(v.w); acc[7] += bfhi(v.w); }
            const float inv = 1.0f / (float)(hi - lo);
            const v4u sv = *(const v4u*)(PBF + (size_t)t * 512 + ch);
            v4u wv; wv.x = pk2(acc[0] * inv - bflo(sv.x), acc[1] * inv - bfhi(sv.x)); wv.y = pk2(acc[2] * inv - bflo(sv.y), acc[3] * inv - bfhi(sv.y));
            wv.z = pk2(acc[4] * inv - bflo(sv.z), acc[5] * inv - bfhi(sv.z)); wv.w = pk2(acc[6] * inv - bflo(sv.w), acc[7] * inv - bfhi(sv.w));
            *(v4u*)(PO + (size_t)t * 512 + ch) = wv;
        }
        VM_WAIT(); __syncthreads();
        for (int it = F.wave; it < 1024; it += 8) {
            const int t = tok0 + (it >> 3), g = (it >> 1) & 3, d = (it & 1) * 64 + F.lane;
            const bf16* pr = PO + (size_t)t * 512 + g * 128; const float* wp = pool_w + g * 16384 + d;
            float acc = 0.f;
            for (int c8 = 0; c8 < 16; ++c8) { const v4u pv = *(const v4u*)(pr + c8 * 8); const float* w8 = wp + c8 * 8 * 128;
                acc += bflo(pv.x) * w8[0] + bfhi(pv.x) * w8[128] + bflo(pv.y) * w8[256] + bfhi(pv.y) * w8[384] + bflo(pv.z) * w8[512] + bfhi(pv.z) * w8[640] + bflo(pv.w) * w8[768] + bfhi(pv.w) * w8[896]; }
            MIX[(size_t)t * DM + g * 128 + d] = (bf16)f2bf(acc * pool_scale[g * 128 + d]);
        }
        __syncthreads();
    }
}

DI void peer_topk_naive(Frame& F, int tok0) {
    const bf16* Q = (const bf16*)(F.ws + WS_ZX); const float* keys = F.in[14]; float* LISTS = (float*)(F.ws + WS_LISTS);
    int* EXPERTS = (int*)(F.ws + WS_EXP); float* GATES = (float*)(F.ws + WS_GATE);
    for (int it = F.wave; it < 32; it += 8) {
        const int hp = it & 15, t = tok0 + (it >> 4) * 64 + F.lane;
        float q[128];
        { const v4u* qp = (const v4u*)(Q + (size_t)t * 2048 + hp * 128);
#pragma unroll
          for (int cc = 0; cc < 16; ++cc) { const v4u qv = qp[cc];
              q[8 * cc + 0] = bflo(qv.x); q[8 * cc + 1] = bfhi(qv.x); q[8 * cc + 2] = bflo(qv.y); q[8 * cc + 3] = bfhi(qv.y);
              q[8 * cc + 4] = bflo(qv.z); q[8 * cc + 5] = bfhi(qv.z); q[8 * cc + 6] = bflo(qv.w); q[8 * cc + 7] = bfhi(qv.w); } }
        float top[16];
#pragma unroll
        for (int i = 0; i < 16; ++i) top[i] = -INFINITY;
        const float* kb = keys + (size_t)hp * 16384;
        for (int n = 0; n < 128; ++n) {
            const f32x4* kr = (const f32x4*)(kb + n * 128);
            float acc = 0.f;
#pragma unroll
            for (int cc = 0; cc < 32; ++cc) { const f32x4 kv = kr[cc]; acc += q[4 * cc] * kv.x + q[4 * cc + 1] * kv.y + q[4 * cc + 2] * kv.z + q[4 * cc + 3] * kv.w; }
            float v = __uint_as_float((__float_as_uint(acc) & ~127u) | (unsigned)n);
#pragma unroll
            for (int i = 0; i < 16; ++i) { const float hi = fmaxf(top[i], v); v = fminf(top[i], v); top[i] = hi; }
        }
        f32x4* lp = (f32x4*)(LISTS + ((size_t)t * 16 + hp) * 16);
#pragma unroll
        for (int i = 0; i < 4; ++i) lp[i] = (f32x4){top[4 * i], top[4 * i + 1], top[4 * i + 2], top[4 * i + 3]};
    }
    VM_WAIT(); __syncthreads();
    for (int it = F.tid; it < 128 * 8; it += 512) {
        const int t = tok0 + (it >> 3), h = it & 7;
        float v0[16], v1[16]; int i0[16], i1[16];
        const f32x4* l0 = (const f32x4*)(LISTS + ((size_t)t * 16 + h * 2) * 16);
#pragma unroll
        for (int i = 0; i < 4; ++i) { const f32x4 a = l0[i], b = l0[4 + i];
#pragma unroll
            for (int e = 0; e < 4; ++e) { const unsigned ua = __float_as_uint(a[e]), ub = __float_as_uint(b[e]);
                v0[4 * i + e] = __uint_as_float(ua & ~127u); i0[4 * i + e] = (int)(ua & 127u); v1[4 * i + e] = __uint_as_float(ub & ~127u); i1[4 * i + e] = (int)(ub & 127u); } }
        float tv[16]; int ti[16];
#pragma unroll
        for (int i = 0; i < 16; ++i) { tv[i] = -INFINITY; ti[i] = 0; }
#pragma unroll
        for (int i = 0; i < 16; ++i)
#pragma unroll
            for (int j = 0; j < 16; ++j) if ((i + 1) * (j + 1) <= 16) {
                float cv = v0[i] + v1[j]; int ci = i0[i] * 128 + i1[j];
#pragma unroll
                for (int k = 0; k < 16; ++k) { const bool gt = cv > tv[k]; const float nv = gt ? cv : tv[k]; const int ni = gt ? ci : ti[k]; cv = gt ? tv[k] : cv; ci = gt ? ti[k] : ci; tv[k] = nv; ti[k] = ni; }
            }
        float e[16], sum = 0.f;
#pragma unroll
        for (int k = 0; k < 16; ++k) { e[k] = __expf(tv[k] - tv[0]); sum += e[k]; }
        const float is = 1.0f / sum;
        int* ep = EXPERTS + (size_t)t * 128 + h * 16; float* gp = GATES + (size_t)t * 128 + h * 16;
#pragma unroll
        for (int k = 0; k < 16; ++k) { ep[k] = ti[k]; gp[k] = e[k] * is; }
    }
    VM_WAIT(); __syncthreads();
}

DI int f2key(float f) { const int b = __float_as_int(f); return b ^ ((b >> 31) & 0x7fffffff); }
DI float key2f(int k) { return __int_as_float(k ^ ((k >> 31) & 0x7fffffff)); }
DI void ce_desc(int& x, int& y) { const int hi = max(x, y), lo = min(x, y); x = hi; y = lo; }
DI void sort16_desc(int (&a)[16]) {
#pragma unroll
    for (int k = 2; k <= 16; k <<= 1)
#pragma unroll
        for (int j = k >> 1; j > 0; j >>= 1)
#pragma unroll
            for (int i = 0; i < 16; ++i) { const int l = i ^ j; if (l > i) { if ((i & k) == 0) ce_desc(a[i], a[l]); else ce_desc(a[l], a[i]); } }
}
DI void merge16_desc(int (&a)[16], const int (&b)[16]) {
#pragma unroll
    for (int i = 0; i < 16; ++i) a[i] = max(a[i], b[15 - i]);
#pragma unroll
    for (int j = 8; j > 0; j >>= 1)
#pragma unroll
        for (int i = 0; i < 16; ++i) if ((i & j) == 0) ce_desc(a[i], a[i + j]);
}
DI void peer_topk_mfma(Frame& F, int tile) {
    const bf16* QP = (const bf16*)(F.ws + WS_ZX); const bf16* KEYF = (const bf16*)(F.ws + WS_KEYS);
    int* EXPERTS = (int*)(F.ws + WS_EXP); float* GATES = (float*)(F.ws + WS_GATE);
    const int lane = F.lane, hh = lane >> 5, ql = lane & 31, tb = F.wave >> 1, p = F.wave & 1;
    const int tokblk = tile * 4 + tb, tok = tokblk * 32 + ql;
#pragma unroll 1
    for (int h = 0; h < 8; ++h) {
        const int hp = 2 * h + p;
        s16x8 qf[8];
#pragma unroll
        for (int ks = 0; ks < 8; ++ks) qf[ks] = ((const s16x8*)(QP + ((size_t)tokblk * 16 + hp) * 4096))[ks * 64 + lane];
        const s16x8* kfp = (const s16x8*)(KEYF + (size_t)hp * 16384) + lane;
        int top[16];
#pragma unroll
        for (int i = 0; i < 16; ++i) top[i] = (int)0x80000000;
#pragma unroll 1
        for (int nt = 0; nt < 4; ++nt) {
            f32x16 acc;
#pragma unroll
            for (int i = 0; i < 16; ++i) acc[i] = 0.f;
#pragma unroll
            for (int ks = 0; ks < 8; ++ks) acc = MFMA32(kfp[(nt * 8 + ks) * 64], qf[ks], acc);
            int a[16];
#pragma unroll
            for (int i = 0; i < 16; ++i) { const int n = 32 * nt + (i & 3) + 8 * (i >> 2) + 4 * hh; a[i] = f2key(__int_as_float((__float_as_int(acc[i]) & ~127) | n)); }
            sort16_desc(a);
            merge16_desc(top, a);
        }
        { int oth[16];
#pragma unroll
          for (int i = 0; i < 16; ++i) oth[i] = __shfl_xor(top[i], 32);
          merge16_desc(top, oth); }
        LAS float* L = (LAS float*)(F.lds) + (h & 1) * 4096 + (tb * 2) * 512;
        if (hh == 0) {
#pragma unroll
            for (int i = 0; i < 16; ++i) L[p * 512 + i * 32 + ql] = key2f(top[i]);
        }
        __syncthreads();
        if (p == 0 && hh == 0) {
            float v0[16], v1[16];
#pragma unroll
            for (int i = 0; i < 16; ++i) { v0[i] = __int_as_float(__float_as_int(L[i * 32 + ql]) & ~127); v1[i] = __int_as_float(__float_as_int(L[512 + i * 32 + ql]) & ~127); }
            int grp[4][16]; int cnt = 0;
#pragma unroll
            for (int g = 0; g < 4; ++g)
#pragma unroll
                for (int i = 0; i < 16; ++i) grp[g][i] = (int)0x80000000;
#pragma unroll
            for (int i = 0; i < 16; ++i)
#pragma unroll
                for (int j = 0; j < 16; ++j) if ((i + 1) * (j + 1) <= 16) {
                    grp[cnt >> 4][cnt & 15] = f2key(__int_as_float((__float_as_int(v0[i] + v1[j]) & ~255) | (i * 16 + j))); ++cnt; }
#pragma unroll
            for (int g = 0; g < 4; ++g) sort16_desc(grp[g]);
            merge16_desc(grp[0], grp[1]); merge16_desc(grp[2], grp[3]); merge16_desc(grp[0], grp[2]);
            float tv[16]; float e[16]; float sum = 0.f; int eid[16];
#pragma unroll
            for (int k = 0; k < 16; ++k) { const int bits = __float_as_int(key2f(grp[0][k])); const int code = bits & 255; tv[k] = __int_as_float(bits & ~255);
                const int n0 = __float_as_int(L[(code >> 4) * 32 + ql]) & 127, n1 = __float_as_int(L[512 + (code & 15) * 32 + ql]) & 127; eid[k] = n0 * 128 + n1; }
#pragma unroll
            for (int k = 0; k < 16; ++k) { e[k] = __expf(tv[k] - tv[0]); sum += e[k]; }
            const float is = 1.0f / sum;
            int* ep = EXPERTS + (size_t)tok * 128 + h * 16; float* gp = GATES + (size_t)tok * 128 + h * 16;
#pragma unroll
            for (int k4 = 0; k4 < 4; ++k4) { *(v4u*)(ep + 4 * k4) = (v4u){(unsigned)eid[4 * k4], (unsigned)eid[4 * k4 + 1], (unsigned)eid[4 * k4 + 2], (unsigned)eid[4 * k4 + 3]};
                *(f32x4*)(gp + 4 * k4) = (f32x4){e[4 * k4] * is, e[4 * k4 + 1] * is, e[4 * k4 + 2] * is, e[4 * k4 + 3] * is}; }
        }
    }
    VM_WAIT(); __syncthreads();
}

DI float gelu_fast(float v) {
    const float av = fabsf(v), t = __builtin_amdgcn_rcpf(av * 0.2316418882f + 1.0f);
    float q = t * 0.5307027145f + (-0.7265760135f); q = q * t + 0.7107068705f; q = q * t + (-0.142248368f); q = q * t + 0.127414796f; q = q * t;
    const float e = __builtin_amdgcn_exp2f((v * v) * (-0.72134752044f));
    const float m = v * (q * e);
    return v < 0.f ? m : v - m;
}
DI float gelu_exact(float a) { return 0.5f * a * (1.0f + erff(a * 0.70710678118654752f)); }

DI void fp8x16_to_f32(const v4u r, float (&f)[16]) {
#pragma unroll
    for (int j = 0; j < 4; ++j) { const f32x2 lo = __builtin_amdgcn_cvt_pk_f32_fp8((int)r[j], false), hi = __builtin_amdgcn_cvt_pk_f32_fp8((int)r[j], true);
        f[4 * j] = lo.x; f[4 * j + 1] = lo.y; f[4 * j + 2] = hi.x; f[4 * j + 3] = hi.y; }
}
typedef __bf16 bf16x2v __attribute__((ext_vector_type(2)));
#ifndef G2_NOSORT
#define G2_NOSORT 0
#endif
#define TOK_CASE(JV, BODY) { constexpr int j = JV; BODY }
#define TOK_DISPATCHN(tk, BODY) do { if constexpr (NT == 1) TOK_CASE(0, BODY) else if constexpr (NT == 2) { if ((tk) < 1) TOK_CASE(0, BODY) else TOK_CASE(1, BODY) } \
    else { if ((tk) < 2) { if ((tk) < 1) TOK_CASE(0, BODY) else TOK_CASE(1, BODY) } else { if ((tk) < 3) TOK_CASE(2, BODY) else TOK_CASE(NT > 3 ? 3 : 0, BODY) } } } while (0)
template <int NT, bool FAKE = false> DI void gather_round(Frame& F, int tbase, volatile LAS int* prog, int pbase) {
    constexpr int NK = 2 * NT, N = 128 * NT, NB = N / 8, LPB = 8 / NK;
    const bf16* H2 = (const bf16*)(F.ws + WS_HX); const unsigned char* U = F.ws + WS_U; const unsigned char* V = F.ws + WS_V;
    const int* EXPERTS = (const int*)(F.ws + WS_EXP); const float* GATES = (const float*)(F.ws + WS_GATE); const float* MOD = (const float*)(F.ws + WS_MOD);
    const int lane = F.lane;
    int key[NK];
#pragma unroll
    for (int j = 0; j < NT; ++j)
#pragma unroll
        for (int hf = 0; hf < 2; ++hf) { const int k = hf * 64 + lane; key[j * 2 + hf] = (EXPERTS[(size_t)(tbase + j) * 128 + k] << 9) | (j << 7) | k; }
#pragma unroll
    for (int k = 2; k <= (G2_NOSORT ? 1 : N); k <<= 1)
#pragma unroll
        for (int j = k >> 1; j > 0; j >>= 1) {
            if (j < NK) {
#pragma unroll
                for (int r = 0; r < NK; ++r) if ((r & j) == 0) { const bool asc = (((lane * NK + r) & k) == 0); const int x = key[r], y = key[r | j], lo = min(x, y), hi = max(x, y);
                    key[r] = asc ? lo : hi; key[r | j] = asc ? hi : lo; }
            } else {
                const bool asc = (((lane * NK) & k) == 0), lower = ((lane & (j / NK)) == 0), takemin = (asc == lower);
#pragma unroll
                for (int r = 0; r < NK; ++r) { const int o = __shfl_xor(key[r], j / NK); key[r] = takemin ? min(key[r], o) : max(key[r], o); }
            }
        }
    unsigned hsq[NT][4]; float hsc[NT]; float out[NT][16];
#pragma unroll
    for (int j = 0; j < NT; ++j) { const v4u a = *((const v4u*)(H2 + (size_t)(tbase + j) * DM + lane * 16)), b = *((const v4u*)(H2 + (size_t)(tbase + j) * DM + lane * 16 + 8));
        float hv[16]; hv[0] = bflo(a.x); hv[1] = bfhi(a.x); hv[2] = bflo(a.y); hv[3] = bfhi(a.y); hv[4] = bflo(a.z); hv[5] = bfhi(a.z); hv[6] = bflo(a.w); hv[7] = bfhi(a.w);
        hv[8] = bflo(b.x); hv[9] = bfhi(b.x); hv[10] = bflo(b.y); hv[11] = bfhi(b.y); hv[12] = bflo(b.z); hv[13] = bfhi(b.z); hv[14] = bflo(b.w); hv[15] = bfhi(b.w);
        float am = 0.f;
#pragma unroll
        for (int i = 0; i < 16; ++i) am = fmaxf(am, fabsf(hv[i]));
#pragma unroll
        for (int o = 1; o < 64; o <<= 1) am = fmaxf(am, __shfl_xor(am, o));
        am = fmaxf(am, 1e-30f); hsc[j] = am * (1.0f / 127.0f);
        const float inv = 127.0f / am;
#pragma unroll
        for (int d = 0; d < 4; ++d) { const int q0 = (int)rintf(hv[4 * d] * inv), q1 = (int)rintf(hv[4 * d + 1] * inv), q2 = (int)rintf(hv[4 * d + 2] * inv), q3 = (int)rintf(hv[4 * d + 3] * inv);
            hsq[j][d] = (unsigned)(q0 & 255) | ((unsigned)(q1 & 255) << 8) | ((unsigned)(q2 & 255) << 16) | ((unsigned)(q3 & 255) << 24); }
#pragma unroll
        for (int i = 0; i < 16; ++i) out[j][i] = 0.f; }
    LAS float* sgL = (LAS float*)(F.lds + 65536) + F.wave * (2 * N); LAS float* suL = sgL + N;
    const float* SU = (const float*)(F.ws + WS_SU);
#pragma unroll
    for (int r = 0; r < NK; ++r) { const int tj = (key[r] >> 7) & 3; float sc = hsc[0];
#pragma unroll
        for (int j = 1; j < NT; ++j) sc = (tj == j) ? hsc[j] : sc;
        sgL[lane * NK + r] = GATES[(size_t)(tbase + tj) * 128 + (key[r] & 127)]; suL[lane * NK + r] = SU[(key[r] >> 9) & (FAKE ? 7 : 16383)] * sc; }
    v4u ucur[8];
#pragma unroll
    for (int r = 0; r < 8; ++r) { const int kk = __builtin_amdgcn_readlane(key[r % NK], r / NK); ucur[r] = *((const v4u*)(U + (size_t)((kk >> 9) & (FAKE ? 7 : 16383)) * 1024) + lane); }
#pragma unroll 1
    for (int b = 0; b < NB; ++b) {
        int kk[8]; v4u vcur[8];
#pragma unroll
        for (int r = 0; r < 8; ++r) { kk[r] = __builtin_amdgcn_readlane(key[r % NK], b * LPB + r / NK); vcur[r] = *((const v4u*)(V + (size_t)((kk[r] >> 9) & (FAKE ? 7 : 16383)) * 1024) + lane); }
        if (lane == 0) *prog = pbase + (kk[0] >> 9);
        int p[8];
#pragma unroll
        for (int r = 0; r < 8; ++r) { const int tk = (kk[r] >> 7) & 3; int acc = 0;
#pragma unroll
            for (int j = 0; j < NT; ++j) if (tk == j) {
#pragma unroll
                for (int q = 0; q < 4; ++q) asm("v_dot4_i32_i8 %0, %1, %2, %0" : "+v"(acc) : "v"(ucur[r][q]), "v"(hsq[j][q])); }
            p[r] = acc; }
        { const int bn = (b + 1 < NB) ? b + 1 : 0;
#pragma unroll
          for (int r = 0; r < 8; ++r) { const int kn = __builtin_amdgcn_readlane(key[r % NK], bn * LPB + r / NK); ucur[r] = *((const v4u*)(U + (size_t)((kn >> 9) & (FAKE ? 7 : 16383)) * 1024) + lane); } }
        int psum;
        { int q4[4];
#pragma unroll
          for (int i = 0; i < 4; ++i) { auto rr = __builtin_amdgcn_permlane32_swap((unsigned)p[i], (unsigned)p[i + 4], false, false); q4[i] = (int)(rr[0] + rr[1]); }
          int q2[2];
#pragma unroll
          for (int i = 0; i < 2; ++i) { auto rr = __builtin_amdgcn_permlane16_swap((unsigned)q4[i], (unsigned)q4[i + 2], false, false); q2[i] = (int)(rr[0] + rr[1]); }
          const int t0 = q2[0] + __builtin_amdgcn_update_dpp(0, q2[0], 0x128, 0xf, 0xf, false);
          const int t1 = q2[1] + __builtin_amdgcn_update_dpp(0, q2[1], 0x128, 0xf, 0xf, false);
          int v = (lane & 8) ? t1 : t0;
          v += __builtin_amdgcn_update_dpp(0, v, 0x141, 0xf, 0xf, false);
          v += __builtin_amdgcn_update_dpp(0, v, 0x4e, 0xf, 0xf, false);
          v += __builtin_amdgcn_update_dpp(0, v, 0xb1, 0xf, 0xf, false);
          psum = v; }
        const float w = sgL[b * 8 + ((lane >> 3) & 7)] * gelu_fast((float)psum * suL[b * 8 + ((lane >> 3) & 7)]);
#pragma unroll
        for (int r = 0; r < 8; ++r) { const float wr = __builtin_bit_cast(float, __builtin_amdgcn_readlane(__builtin_bit_cast(int, w), r * 8)); float f[16]; fp8x16_to_f32(vcur[r], f);
            const int tk = (kk[r] >> 7) & 3;
#pragma unroll
            for (int j = 0; j < NT; ++j) if (tk == j) {
#pragma unroll
                for (int i = 0; i < 16; ++i) out[j][i] += wr * f[i]; } }
    }
    const float* fg = F.in[17];
#pragma unroll
    for (int j = 0; j < NT; ++j) {
        const int t = tbase + j, bb = t >> 12; const float* g2 = MOD + bb * NMOD + 5 * DM; float* xo = F.out + (size_t)t * DM;
        const bf16* x1r = (const bf16*)(F.ws + WS_X1) + (size_t)t * DM + lane * 16;
        float x2[16]; float ss = 0.f;
#pragma unroll
        for (int hq = 0; hq < 4; ++hq) { const int c = lane * 16 + hq * 4; const v2u xw = *(const v2u*)(x1r + hq * 4); const f32x4 xv = (f32x4){bflo(xw.x), bfhi(xw.x), bflo(xw.y), bfhi(xw.y)}, gv = *(const f32x4*)(g2 + c);
#pragma unroll
            for (int e = 0; e < 4; ++e) { const float y = xv[e] + gv[e] * (out[j][hq * 4 + e] * (1.0f / V_SCALE)); x2[hq * 4 + e] = y; ss += y * y; } }
        const float rinv = 1.0f / sqrtf(wave_sum(ss) * (1.f / DM) + EPS);
#pragma unroll
        for (int hq = 0; hq < 4; ++hq) { const int c = lane * 16 + hq * 4; const f32x4 fv = *(const f32x4*)(fg + c);
            f32x4 y;
#pragma unroll
            for (int e = 0; e < 4; ++e) y[e] = x2[hq * 4 + e] * rinv * fv[e];
            if (!FAKE || rinv == 12345.678f) *(f32x4*)(xo + c) = y; }
    }
}

#ifdef MB_OP
DI void mb_probe(Frame& F) {
    unsigned x[32];
#pragma unroll
    for (int i = 0; i < 32; ++i) x[i] = F.lane * 2654435761u + i * 40503u + 0x3f800000u;
    const unsigned kc = 0x3c003c00u + F.wave;
#pragma unroll 1
    for (int it = 0; it < MB_ITERS; ++it) {
#pragma unroll
        for (int i = 0; i < 32; ++i) {
#if MB_OP == 0
            asm volatile("v_fmac_f32 %0, %1, %2" : "+v"(x[i]) : "v"(kc), "v"(x[(i + 1) & 31]));
#elif MB_OP == 1
            asm volatile("v_pk_fma_f32 %0, %1, %2, %0" : "+v"(*(unsigned long long*)&x[i & 30]) : "v"(*(unsigned long long*)&x[(i + 2) & 30]), "v"(*(unsigned long long*)&x[(i + 4) & 30]));
#elif MB_OP == 2
            asm volatile("v_cvt_pk_f32_fp8 %0, %1" : "=v"(*(unsigned long long*)&x[i & 30]) : "v"(x[(i + 3) & 31]));
#elif MB_OP == 3
            asm volatile("v_cvt_scalef32_pk_bf16_fp8 %0, %1, 1.0" : "=v"(x[i]) : "v"(x[(i + 3) & 31]));
#elif MB_OP == 4
            asm volatile("v_dot2c_f32_bf16 %0, %1, %2" : "+v"(x[i]) : "v"(kc), "v"(x[(i + 1) & 31]));
#elif MB_OP == 5
            asm volatile("v_dot4_i32_i8 %0, %1, %2, %0" : "+v"(x[i]) : "v"(kc), "v"(x[(i + 1) & 31]));
#elif MB_OP == 6
            asm volatile("v_perm_b32 %0, %1, %2, %3" : "=v"(x[i]) : "v"(x[(i + 1) & 31]), "v"(x[(i + 2) & 31]), "v"(kc));
#elif MB_OP == 7
            asm volatile("v_cvt_f32_ubyte1 %0, %1" : "=v"(x[i]) : "v"(x[(i + 3) & 31]));
#endif
        }
    }
    unsigned acc = 0;
#pragma unroll
    for (int i = 0; i < 32; ++i) acc ^= x[i];
    if (acc == 0x12345u) *(volatile unsigned*)(F.ws + WS_CTL + 32768) = acc;
}
#endif
struct Args { const float* in[18]; float* out; unsigned char* ws; int ph_lo, ph_hi, li, pad; };
__global__ void __launch_bounds__(NWAVES * 64, 2) mk_fwd(Args args) {
    extern __shared__ __attribute__((aligned(16))) unsigned char lds[];
    Frame F;
    F.lds = (LAS unsigned char*)lds;
    F.tid = threadIdx.x; F.lane = F.tid & 63; F.wave = __builtin_amdgcn_readfirstlane(F.tid >> 6);
    F.G = gridDim.x; { const int bx = blockIdx.x; F.vcu = (F.G % 8 == 0) ? (bx % 8) * (F.G / 8) + bx / 8 : bx; }
    F.gw = F.vcu * NWAVES + F.wave; F.NGW = F.G * NWAVES;
#pragma unroll
    for (int i = 0; i < 18; ++i) F.in[i] = args.in[i];
    F.out = args.out; F.ws = args.ws;
    volatile LAS unsigned* MISC = (volatile LAS unsigned*)(F.lds + MISC_OFF);
    for (int u = F.tid; u < (LDS_BYTES - LDSCTL_OFF) / 4; u += NWAVES * 64) ((LAS unsigned*)(F.lds + LDSCTL_OFF))[u] = 0u;
    __syncthreads();
    gu32* ctl = (gu32*)(F.ws + WS_CTL);
    XcdBarrier bar; bar.bar = (unsigned*)(ctl + CW_BAR) + args.li * XCD_BAR_WORDS; bar.x = 0; bar.st = nullptr;
    const int lo = args.ph_lo, hi = args.ph_hi;
    if (hi - lo > 1) bar = xcd_barrier_post((unsigned*)(ctl + CW_BAR) + args.li * XCD_BAR_WORDS, MISC + 8);
#ifndef PROBE_MASK
#define PROBE_MASK 0
#endif
#define REP(k) for (int rep_ = 0; rep_ < 1 + ((PROBE_MASK >> (k)) & 1); ++rep_)
#define IN(k) (lo <= (k) && (k) < hi)
#ifndef PROBE_SEAMS
#define PROBE_SEAMS 1
#endif
#define SEAM(k) do { if (IN(k) && IN((k) + 1)) for (int s_ = 0; s_ < PROBE_SEAMS; ++s_) xcd_barrier(bar); } while (0)

#ifndef SKIP0
    if (IN(0)) { REP(0) { p0_prologue(F); __syncthreads(); } SEAM(0); }
#endif
#ifdef MB_OP
    if (IN(1)) mb_probe(F);
#endif
    if (IN(1)) { REP(1) norm_rows<false>(F, F.in[0], F.in[2], MROWS, F.in[6], 0, DM, (bf16*)(F.ws + WS_HX)); SEAM(1); }
    if (IN(2)) {
        pg8::Gemm g{(const bf16*)(F.ws + WS_HX), (const bf16*)(F.ws + WS_WIN), MROWS, DIN, DM}; pg8::InProjOrder S; S.init(F.G, (int)blockIdx.x);
        pg8::EpiInProj E{(bf16*)(F.ws + WS_PB), (bf16*)(F.ws + WS_QF), (bf16*)(F.ws + WS_KF), (bf16*)(F.ws + WS_VF)};
        REP(2) pg8::gemm_phase<pg8::EpiInProj, pg8::InProjOrder, true, true>(F.lds + RING_OFF, g, S, E);
        SEAM(2);
    }
    if (IN(3)) {
#ifndef SKIP3A
#ifdef ATT_NAIVE
 attn_naive(F);
#else
 REP(3) attn_mfma(F);
#endif
#endif
#ifndef SKIP3B
#ifdef POOL_NAIVE
 pool_naive(F);
#else
 REP(9) pool_mfma(F);
#endif
#endif
 SEAM(3); }
    if (IN(4)) {
        pg8::Gemm g{(const bf16*)(F.ws + WS_MIX), (const bf16*)(F.ws + WS_WOUT), NTOK, DM, DM}; pg8::StaticOrder S; S.init(NTOK, DM, F.G, (int)blockIdx.x);
        pg8::EpiX1 E{F.in[0], (const float*)(F.ws + WS_MOD), (bf16*)(F.ws + WS_X1)};
        REP(4) pg8::gemm_phase<pg8::EpiX1, pg8::StaticOrder, true, true>(F.lds + RING_OFF, g, S, E);
        SEAM(4);
    }
    if (IN(5)) { REP(5) norm_rows<true>(F, (const float*)(F.ws + WS_X1), nullptr, NTOK, F.in[12], 3 * DM, 4 * DM, (bf16*)(F.ws + WS_HX)); SEAM(5); }
    if (IN(6)) {
        pg8::Gemm g{(const bf16*)(F.ws + WS_HX), (const bf16*)(F.ws + WS_WQ), NTOK, 2048, DM}; pg8::StaticOrder S; S.init(NTOK, 2048, F.G, (int)blockIdx.x);
#ifdef TOPK_NAIVE
        pg8::EpiBf16 E{(bf16*)(F.ws + WS_ZX), 2048};
        pg8::gemm_phase<pg8::EpiBf16, pg8::StaticOrder, true, true>(F.lds + RING_OFF, g, S, E);
#else
        pg8::EpiQP E{(bf16*)(F.ws + WS_ZX)};
        REP(6) pg8::gemm_phase<pg8::EpiQP, pg8::StaticOrder, true, true>(F.lds + RING_OFF, g, S, E);
#endif
        SEAM(6);
    }
    if (IN(7)) {
        for (int tile = F.vcu; tile < NTOK / 128; tile += F.G) {
            const int tok0 = tile * 128;
#ifndef SKIP7A
#ifdef TOPK_NAIVE
            peer_topk_naive(F, tok0);
#else
            REP(7) peer_topk_mfma(F, tile);
#endif
#endif
#ifndef SKIP7B
            { volatile LAS int* prog = (volatile LAS int*)(F.lds + 98304);
              if ((PROBE_MASK >> 8) & 1) for (int rd = 0; rd < 4; ++rd) gather_round<4, true>(F, tok0 + rd * 32 + F.wave * 4, prog + F.wave, rd * 16384);
              for (int rd = 0; rd < 4; ++rd) gather_round<4>(F, tok0 + rd * 32 + F.wave * 4, prog + F.wave, rd * 16384); }
#endif
        }
    }
#undef IN
#undef SEAM
}

extern "C" void kernel_launch(void* const* d_in, const int* in_sizes, int n_in, void* d_out, int out_size, void* d_ws, size_t ws_size, hipStream_t stream) {
    static int grid = 0;
    if (grid == 0) {
        if (n_in != 18 || in_sizes[0] != NTOK * DM || out_size != NTOK * DM || ws_size < WS_END) { fprintf(stderr, "kernel_launch: unexpected shapes / workspace (n_in %d, ws %zu); nothing launched\n", n_in, ws_size); grid = -1; return; }
        int dev = 0, cus = 0;
        if (hipGetDevice(&dev) != hipSuccess || hipDeviceGetAttribute(&cus, hipDeviceAttributeMultiprocessorCount, dev) != hipSuccess) { grid = -1; return; }
        if (hipFuncSetAttribute((const void*)mk_fwd, hipFuncAttributeMaxDynamicSharedMemorySize, LDS_BYTES) != hipSuccess) { fprintf(stderr, "kernel_launch: hipFuncSetAttribute failed\n"); grid = -1; return; }
        int per_cu = 0;
        if (hipOccupancyMaxActiveBlocksPerMultiprocessor(&per_cu, (const void*)mk_fwd, NWAVES * 64, LDS_BYTES) != hipSuccess || per_cu < 1) fprintf(stderr, "kernel_launch: note: occupancy query reports %d blocks per CU\n", per_cu);
        (void)hipGetLastError();
        grid = cus;
    }
    if (grid < 0) return;
    (void)hipMemsetAsync((char*)d_ws + WS_CTL, 0, CTL_ZERO_BYTES, stream);
    Args a{};
    for (int i = 0; i < 18; ++i) a.in[i] = (const float*)d_in[i];
    a.out = (float*)d_out; a.ws = (unsigned char*)d_ws;
    for (int li = 0; li < N_LAUNCHES; ++li) {
        if (N_LAUNCHES == 1) { a.ph_lo = 0; a.ph_hi = NPHASE; } else { a.ph_lo = li; a.ph_hi = li + 1; }
        a.li = (N_LAUNCHES == 1) ? 0 : 0;
        hipLaunchKernelGGL(mk_fwd, dim3(grid), dim3(NWAVES * 64), LDS_BYTES, stream, a);
    }
}
```

```cpp
#include <hip/hip_runtime.h>
#include <cstdio>
#include <cstdint>
#include <type_traits>
namespace pg8 {
#define PG8_LAS __attribute__((address_space(3)))
typedef unsigned short bf16_t;
typedef short bf16x8 __attribute__((ext_vector_type(8)));
typedef float f32x4 __attribute__((ext_vector_type(4)));
typedef unsigned u32x4 __attribute__((ext_vector_type(4)));
constexpr int BM = 256, BK = 64, HALF = 128, HTB = HALF * BK * 2  , STAGE_BYTES = 8 * HTB, NXCD = 8, WGM = 8;

__host__ __device__ __forceinline__ int lds_byte(int r, int c) { const int st = (r >> 4) * 2 + (c >> 5), rr = r & 15, cc = c & 31, ob = rr * 64 + cc * 2; return st * 1024 + (ob ^ (((ob >> 9) & 1) << 5)); }
__host__ __device__ __forceinline__ void stage_rc(int b, int& R, int& C) { const int st = b / 1024, sb = b % 1024, swz = sb ^ (((sb >> 9) & 1) << 5); R = (st >> 1) * 16 + swz / 64; C = (st & 1) * 32 + (swz % 64) / 2; }
__host__ __device__ __forceinline__ int perm32(int rho) { const int n = rho >> 4, i = rho & 15; return 8 * (i >> 2) + 4 * n + (i & 3); }

struct Unit { int pm, pn; };
struct Gemm { const bf16_t* A; const bf16_t* Bt; int M, N, K; };
struct StaticOrder {
    int nM, nN, nwg, G, c;
    __host__ __device__ void init(int M, int N, int G_, int c_) { nM = M / BM; nN = N / BM; nwg = nM * nN; G = G_; c = c_; }
    __host__ __device__ bool next(int i, Unit& u) const {
        const long L = (long)i * G + c; if (L >= nwg) return false;
        int wgid = (int)L; { const int q = nwg / NXCD, r = nwg % NXCD, xcd = wgid % NXCD, off = wgid / NXCD; wgid = (xcd < r ? xcd * (q + 1) : r * (q + 1) + (xcd - r) * q) + off; }
        const int nig = WGM * nN, gid = wgid / nig, fm = gid * WGM, gsz = (nM - fm) < WGM ? (nM - fm) : WGM;
        u.pm = fm + ((wgid % nig) % gsz); u.pn = (wgid % nig) / gsz; return true;
    }
    __device__ __forceinline__ void a_ready(const Unit&) const {}
    __device__ __forceinline__ void done(const Unit&) const {}
    __device__ __forceinline__ const char* pa(const Gemm& g, const Unit& u) const { return (const char*)g.A + (size_t)u.pm * ((size_t)BM * g.K * 2); }
    __device__ __forceinline__ const char* pb(const Gemm& g, const Unit& u) const { return (const char*)g.Bt + (size_t)u.pn * ((size_t)BM * g.K * 2); }
};
struct InProjOrder {
    StaticOrder so;
    __host__ __device__ void init(int G_, int c_) { so.init(136 * BM, 8 * BM, G_, c_); }
    __host__ __device__ bool next(int i, Unit& u) const { int cnt = -1; for (int j = 0; ; ++j) { if (!so.next(j, u)) return false; if (!(u.pm >= 128 && u.pn < 4)) { if (++cnt == i) return true; } } }
    __device__ __forceinline__ void a_ready(const Unit&) const {}
    __device__ __forceinline__ void done(const Unit&) const {}
    __device__ __forceinline__ const char* pa(const Gemm& g, const Unit& u) const { return u.pn < 6 ? (const char*)g.A + (size_t)u.pm * ((size_t)BM * g.K * 2) : (const char*)g.Bt + (size_t)u.pn * ((size_t)BM * g.K * 2); }
    __device__ __forceinline__ const char* pb(const Gemm& g, const Unit& u) const { return u.pn < 6 ? (const char*)g.Bt + (size_t)u.pn * ((size_t)BM * g.K * 2) : (const char*)g.A + (size_t)u.pm * ((size_t)BM * g.K * 2); }
};

__device__ __forceinline__ unsigned cvt_pk_bf16(float lo, float hi) { unsigned r; asm volatile("v_cvt_pk_bf16_f32 %0, %1, %2" : "=v"(r) : "v"(lo), "v"(hi)); return r; }
struct EpiBf16 {
    static constexpr bool PERM = true, AFTER_DRAIN = false;
    bf16_t* O; int ldc;
    __device__ __forceinline__ void operator()(const f32x4 (&acc)[2][2][4][2], const Unit& u, int wr, int wc, int fr, int fq) const {
        const int row0 = u.pm * BM + wr * 64 + fr, col0 = u.pn * BM + wc * 32 + 8 * fq;
#pragma unroll
        for (int ai = 0; ai < 2; ++ai)
#pragma unroll
            for (int m = 0; m < 4; ++m) { bf16_t* rowp = O + (size_t)(row0 + ai * HALF + m * 16) * ldc + col0;
#pragma unroll
                for (int bj = 0; bj < 2; ++bj) { const f32x4 v0 = acc[ai][bj][m][0], v1 = acc[ai][bj][m][1];
                    u32x4 w; w.x = cvt_pk_bf16(v0[0], v0[1]); w.y = cvt_pk_bf16(v0[2], v0[3]); w.z = cvt_pk_bf16(v1[0], v1[1]); w.w = cvt_pk_bf16(v1[2], v1[3]);
                    *(u32x4*)(rowp + bj * HALF) = w; } }
    }
};
struct EpiX1 {
    static constexpr bool PERM = true, AFTER_DRAIN = false;
    const float* x; const float* mod; bf16_t* out;
    __device__ __forceinline__ void operator()(const f32x4 (&acc)[2][2][4][2], const Unit& u, int wr, int wc, int fr, int fq) const {
        const int row0 = u.pm * BM + wr * 64 + fr, col0 = u.pn * BM + wc * 32 + 8 * fq;
        const float* g1 = mod + (size_t)((u.pm * BM) >> 12) * 6144 + 2048 + col0;
        f32x4 gv[2][2];
#pragma unroll
        for (int bj = 0; bj < 2; ++bj)
#pragma unroll
            for (int n = 0; n < 2; ++n) gv[bj][n] = *(const f32x4*)(g1 + bj * HALF + 4 * n);
#pragma unroll
        for (int ai = 0; ai < 2; ++ai)
#pragma unroll
            for (int m = 0; m < 4; ++m) { const size_t off = (size_t)(row0 + ai * HALF + m * 16) * 1024 + col0;
#pragma unroll
                for (int bj = 0; bj < 2; ++bj) { const f32x4 x0 = *(const f32x4*)(x + off + bj * HALF), x1 = *(const f32x4*)(x + off + bj * HALF + 4);
                    const f32x4 v0 = x0 + gv[bj][0] * acc[ai][bj][m][0], v1 = x1 + gv[bj][1] * acc[ai][bj][m][1];
                    u32x4 w; w.x = cvt_pk_bf16(v0[0], v0[1]); w.y = cvt_pk_bf16(v0[2], v0[3]); w.z = cvt_pk_bf16(v1[0], v1[1]); w.w = cvt_pk_bf16(v1[2], v1[3]);
                    *(u32x4*)(out + off + bj * HALF) = w; } }
    }
};


struct EpiInProj {
    static constexpr bool PERM = true, AFTER_DRAIN = false;
    bf16_t *PB, *QF, *KF, *VF;
    __device__ __forceinline__ void operator()(const f32x4 (&acc)[2][2][4][2], const Unit& u, int wr, int wc, int fr, int fq) const {
        if (u.pn < 6) {
            const int sec = u.pn >> 1, cbase = (u.pn & 1) * 256 + wc * 32 + 8 * fq;
#pragma unroll
            for (int ai = 0; ai < 2; ++ai)
#pragma unroll
                for (int m = 0; m < 4; ++m) { const int T = u.pm * BM + ai * HALF + wr * 64 + m * 16 + fr;
                    int bb, blk; if (T < 32768) { bb = T >> 12; blk = (T & 4095) >> 5; } else { const int cc = T - 32768; bb = cc >> 8; blk = 128 + ((cc & 255) >> 5); }
                    const int tl = T & 31;
#pragma unroll
                    for (int bj = 0; bj < 2; ++bj) { const int c = cbase + HALF * bj; const f32x4 v0 = acc[ai][bj][m][0], v1 = acc[ai][bj][m][1];
                        u32x4 w; w.x = cvt_pk_bf16(v0[0], v0[1]); w.y = cvt_pk_bf16(v0[2], v0[3]); w.z = cvt_pk_bf16(v1[0], v1[1]); w.w = cvt_pk_bf16(v1[2], v1[3]);
                        if (sec == 0) *(u32x4*)(PB + (size_t)T * 512 + c) = w;
                        else { const int h = c >> 6, d0 = c & 63, fo = ((d0 >> 4) * 64 + ((d0 >> 3) & 1) * 32 + tl) * 8;
                            bf16_t* dst = (sec == 1) ? QF + (size_t)((bb * 8 + h) * 128 + blk) * 2048 + fo : KF + (size_t)((bb * 8 + h) * 136 + blk) * 2048 + fo;
                            *(u32x4*)dst = w; } } }
        } else {
            typedef unsigned u32x2 __attribute__((ext_vector_type(2)));
#pragma unroll
            for (int ai = 0; ai < 2; ++ai)
#pragma unroll
                for (int m = 0; m < 4; ++m) { const int vc = (u.pn - 6) * BM + ai * HALF + wr * 64 + m * 16 + fr, h = vc >> 6, dt = (vc >> 5) & 1, dl = vc & 31;
#pragma unroll
                    for (int bj = 0; bj < 2; ++bj) { const int T0 = u.pm * BM + bj * HALF + wc * 32 + 8 * fq;
                        int bb, blk; if (T0 < 32768) { bb = T0 >> 12; blk = (T0 & 4095) >> 5; } else { const int cc = T0 - 32768; bb = cc >> 8; blk = 128 + ((cc & 255) >> 5); }
                        bf16_t* base = VF + ((size_t)(((bb * 8 + h) * 136 + blk) * 2 + dt) * 2 + (fq >> 1)) * 512 + 4 * (fq & 1);
                        const f32x4 v0 = acc[ai][bj][m][0], v1 = acc[ai][bj][m][1];
                        u32x2 w0, w1; w0.x = cvt_pk_bf16(v0[0], v0[1]); w0.y = cvt_pk_bf16(v0[2], v0[3]); w1.x = cvt_pk_bf16(v1[0], v1[1]); w1.y = cvt_pk_bf16(v1[2], v1[3]);
                        *(u32x2*)(base + dl * 8) = w0; *(u32x2*)(base + (32 + dl) * 8) = w1; } }
        }
    }
};

struct EpiQP {
    static constexpr bool PERM = true, AFTER_DRAIN = false;
    bf16_t* QP;
    __device__ __forceinline__ void operator()(const f32x4 (&acc)[2][2][4][2], const Unit& u, int wr, int wc, int fr, int fq) const {
#pragma unroll
        for (int ai = 0; ai < 2; ++ai)
#pragma unroll
            for (int m = 0; m < 4; ++m) { const int T = u.pm * BM + ai * HALF + wr * 64 + m * 16 + fr;
#pragma unroll
                for (int bj = 0; bj < 2; ++bj) { const int hp = 2 * u.pn + bj, ks = 2 * wc + (fq >> 1), hh = fq & 1;
                    const f32x4 v0 = acc[ai][bj][m][0], v1 = acc[ai][bj][m][1];
                    u32x4 w; w.x = cvt_pk_bf16(v0[0], v0[1]); w.y = cvt_pk_bf16(v0[2], v0[3]); w.z = cvt_pk_bf16(v1[0], v1[1]); w.w = cvt_pk_bf16(v1[2], v1[3]);
                    *(u32x4*)(QP + ((size_t)(T >> 5) * 16 + hp) * 4096 + (ks * 64 + hh * 32 + (T & 31)) * 8) = w; } }
    }
};
template <class Epi, class Sched, bool ALIGN_EPI = false, bool SP2 = false>
__device__ __forceinline__ void gemm_phase(PG8_LAS unsigned char* lds, const Gemm g, const Sched& S, const Epi& E) {
    const int tid = threadIdx.x, wid = __builtin_amdgcn_readfirstlane(tid >> 6), lane = tid & 63, wr = wid >> 2, wc = wid & 3, fr = lane & 15, fq = lane >> 4;
    const int K = g.K, nt = K / BK;
    unsigned voffA[2], voffB[2];
#pragma unroll
    for (int i = 0; i < 2; ++i) { int R, C; stage_rc(tid * 16 + i * 8192, R, C); const int Rb = Epi::PERM ? ((R & ~31) + perm32(R & 31)) : R;
        voffA[i] = (unsigned)(R * K + C) * 2u; voffB[i] = (unsigned)(Rb * K + C) * 2u; }
    const size_t kstep = (size_t)(BK * 2);
    const size_t hstep = (size_t)HALF * K * 2;
    const size_t tstep = 2 * hstep;
    const unsigned ldsw = (unsigned)wid * 1024u;
    const int aoff = lds_byte(wr * 64 + fr, fq * 8), boff = lds_byte(wc * 32 + fr, fq * 8);
#define PG8_SA(b, h) (((b) * 2 + (h)) * HTB)
#define PG8_SB(b, h) ((4 + (b) * 2 + (h)) * HTB)
#define PG8_STAGE(bufoff, gbase, voff) do { _Pragma("unroll") for (int _i = 0; _i < 2; ++_i) \
        __builtin_amdgcn_global_load_lds((const unsigned*)((const char*)(gbase) + (voff)[_i]), (PG8_LAS unsigned*)(lds + (bufoff) + ldsw + _i * 8192), 16, 0, 0); } while (0)
#define PG8_LDA(dst, b, h) do { _Pragma("unroll") for (int m = 0; m < 4; ++m) _Pragma("unroll") for (int k = 0; k < 2; ++k) dst[m][k] = *(const PG8_LAS bf16x8*)(lds + PG8_SA(b, h) + aoff + m * 2048 + k * 1024); } while (0)
#define PG8_LDB(dst, b, h) do { _Pragma("unroll") for (int n = 0; n < 2; ++n) _Pragma("unroll") for (int k = 0; k < 2; ++k) dst[n][k] = *(const PG8_LAS bf16x8*)(lds + PG8_SB(b, h) + boff + n * 2048 + k * 1024); } while (0)
#define PG8_MMA(ai, bj, At, Bt) do { __builtin_amdgcn_s_setprio(1); _Pragma("unroll") for (int m = 0; m < 4; ++m) _Pragma("unroll") for (int n = 0; n < 2; ++n) _Pragma("unroll") for (int k = 0; k < 2; ++k) \
        acc[ai][bj][m][n] = __builtin_amdgcn_mfma_f32_16x16x32_bf16(Bt[n][k], At[m][k], acc[ai][bj][m][n], 0, 0, 0); __builtin_amdgcn_s_setprio(0); } while (0)
#define PG8_WAIT_V(n) asm volatile("s_waitcnt vmcnt(" #n ")" ::: "memory")
#define PG8_WAIT_L(n) asm volatile("s_waitcnt lgkmcnt(" #n ")" ::: "memory")
#define PG8_BAR __builtin_amdgcn_s_barrier()
#define PG8_SCHED __builtin_amdgcn_sched_barrier(0)
    Unit cur, nxt; int ui = 0;
    if (!S.next(0, cur)) return;
    f32x4 acc[2][2][4][2];
#pragma unroll
    for (int a = 0; a < 2; ++a)
#pragma unroll
        for (int b = 0; b < 2; ++b)
#pragma unroll
            for (int m = 0; m < 4; ++m)
#pragma unroll
                for (int n = 0; n < 2; ++n) acc[a][b][m][n] = (f32x4){0.f, 0.f, 0.f, 0.f};
    bf16x8 At[4][2], B0[2][2], B1[2][2];
    const char* cA = S.pa(g, cur); const char* cB = S.pb(g, cur);
    S.a_ready(cur);
    if constexpr (SP2) {
        PG8_STAGE(PG8_SB(0, 0), cB, voffB); PG8_STAGE(PG8_SB(0, 1), cB + hstep, voffB); PG8_STAGE(PG8_SA(0, 0), cA, voffA); PG8_STAGE(PG8_SA(0, 1), cA + hstep, voffA);
        if (wr == 1) PG8_BAR;
        PG8_WAIT_V(2); PG8_BAR;
        PG8_STAGE(PG8_SB(1, 0), cB + kstep, voffB); PG8_STAGE(PG8_SA(1, 0), cA + kstep, voffA); PG8_STAGE(PG8_SB(1, 1), cB + hstep + kstep, voffB);
        PG8_WAIT_V(6); PG8_BAR;
    } else {
        PG8_STAGE(PG8_SB(0, 0), cB, voffB); PG8_STAGE(PG8_SA(0, 0), cA, voffA); PG8_STAGE(PG8_SB(0, 1), cB + hstep, voffB); PG8_STAGE(PG8_SA(0, 1), cA + hstep, voffA);
        if (wr == 1) PG8_BAR;
        PG8_WAIT_V(4); PG8_BAR;
        PG8_STAGE(PG8_SB(1, 0), cB + kstep, voffB); PG8_STAGE(PG8_SA(1, 0), cA + kstep, voffA); PG8_STAGE(PG8_SB(1, 1), cB + hstep + kstep, voffB);
        PG8_WAIT_V(6); PG8_BAR;
    }
    for (;;) {
        const bool has_next = S.next(ui + 1, nxt);
        const char* nA = has_next ? S.pa(g, nxt) : cA; const char* nB = has_next ? S.pb(g, nxt) : cB;
        for (int t = 0; t < nt; t += 2) {
            const bool last = (t == nt - 2);
            const char* a1 = cA + (size_t)(t + 1) * kstep;
            const char* a2 = last ? nA : cA + (size_t)(t + 2) * kstep; const char* b2 = last ? nB : cB + (size_t)(t + 2) * kstep;
            const char* a3 = a2 + kstep; const char* b3 = b2 + kstep;
            if (last && has_next) S.a_ready(nxt);
            if constexpr (SP2) {
            PG8_LDB(B0, 0, 0); PG8_LDB(B1, 0, 1); PG8_SCHED; PG8_LDA(At, 0, 0); PG8_STAGE(PG8_SA(1, 1), a1 + hstep, voffA);
            PG8_WAIT_V(8); PG8_WAIT_L(0); PG8_BAR; PG8_MMA(0, 0, At, B0); PG8_MMA(0, 1, At, B1); PG8_BAR; PG8_SCHED;
            PG8_LDA(At, 0, 1); PG8_STAGE(PG8_SB(0, 0), b2, voffB); PG8_STAGE(PG8_SB(0, 1), b2 + hstep, voffB); PG8_STAGE(PG8_SA(0, 0), a2, voffA);
            PG8_WAIT_V(8); PG8_WAIT_L(0); PG8_BAR; PG8_MMA(1, 0, At, B0); PG8_MMA(1, 1, At, B1); PG8_BAR; PG8_SCHED;
            PG8_LDB(B0, 1, 0); PG8_LDB(B1, 1, 1); PG8_SCHED; PG8_LDA(At, 1, 0); PG8_STAGE(PG8_SA(0, 1), a2 + hstep, voffA);
            PG8_WAIT_V(8); PG8_WAIT_L(0); PG8_BAR; PG8_MMA(0, 0, At, B0); PG8_MMA(0, 1, At, B1); PG8_BAR; PG8_SCHED;
            PG8_LDA(At, 1, 1); PG8_STAGE(PG8_SB(1, 0), b3, voffB); PG8_STAGE(PG8_SB(1, 1), b3 + hstep, voffB); PG8_STAGE(PG8_SA(1, 0), a3, voffA);
            PG8_WAIT_V(8); PG8_WAIT_L(0); PG8_BAR; PG8_MMA(1, 0, At, B0); PG8_MMA(1, 1, At, B1); PG8_BAR; PG8_SCHED;
            } else {
            PG8_LDB(B0, 0, 0); PG8_SCHED; PG8_LDA(At, 0, 0); PG8_STAGE(PG8_SA(1, 1), a1 + hstep, voffA);
            PG8_WAIT_L(8); PG8_BAR; PG8_WAIT_L(0); PG8_MMA(0, 0, At, B0); PG8_BAR; PG8_SCHED;
            PG8_LDB(B1, 0, 1); PG8_STAGE(PG8_SB(0, 0), b2, voffB);
            PG8_BAR; PG8_WAIT_L(0); PG8_MMA(0, 1, At, B1); PG8_BAR;
            PG8_LDA(At, 0, 1); PG8_STAGE(PG8_SA(0, 0), a2, voffA);
            PG8_BAR; PG8_WAIT_L(0); PG8_MMA(1, 0, At, B0); PG8_BAR; PG8_SCHED;
            PG8_STAGE(PG8_SB(0, 1), b2 + hstep, voffB);
            PG8_WAIT_V(6); PG8_BAR; PG8_MMA(1, 1, At, B1); PG8_BAR;
            PG8_LDB(B0, 1, 0); PG8_SCHED; PG8_LDA(At, 1, 0); PG8_STAGE(PG8_SA(0, 1), a2 + hstep, voffA);
            PG8_WAIT_L(8); PG8_BAR; PG8_WAIT_L(0); PG8_MMA(0, 0, At, B0); PG8_BAR; PG8_SCHED;
            PG8_LDB(B1, 1, 1); PG8_STAGE(PG8_SB(1, 0), b3, voffB);
            PG8_BAR; PG8_WAIT_L(0); PG8_MMA(0, 1, At, B1); PG8_BAR;
            PG8_LDA(At, 1, 1); PG8_STAGE(PG8_SA(1, 0), a3, voffA);
            PG8_BAR; PG8_WAIT_L(0); PG8_MMA(1, 0, At, B0); PG8_BAR; PG8_SCHED;
            PG8_STAGE(PG8_SB(1, 1), b3 + hstep, voffB);
            PG8_WAIT_V(6); PG8_BAR; PG8_MMA(1, 1, At, B1); PG8_BAR;
            }
        }
        if constexpr (ALIGN_EPI) { if (wr == 0) PG8_BAR; }
        if constexpr (!Epi::AFTER_DRAIN) { E(acc, cur, wr, wc, fr, fq); S.done(cur); }
        if (!has_next) break;
#pragma unroll
        for (int a = 0; a < 2; ++a)
#pragma unroll
            for (int b = 0; b < 2; ++b)
#pragma unroll
                for (int m = 0; m < 4; ++m)
#pragma unroll
                    for (int n = 0; n < 2; ++n) acc[a][b][m][n] = (f32x4){0.f, 0.f, 0.f, 0.f};
        cur = nxt; cA = nA; cB = nB; ++ui;
        if constexpr (ALIGN_EPI) { if (wr == 1) PG8_BAR; }
    }
    PG8_WAIT_V(0);
    if constexpr (!ALIGN_EPI) { if (wr == 0) PG8_BAR; }
    PG8_BAR;
    if constexpr (Epi::AFTER_DRAIN) { E.fused(acc, cur, wr, wc, fr, fq, lds, wid, lane); S.done(cur); }
#undef PG8_SA
#undef PG8_SB
#undef PG8_STAGE
#undef PG8_LDA
#undef PG8_LDB
#undef PG8_MMA
#undef PG8_WAIT_V
#undef PG8_WAIT_L
#undef PG8_BAR
#undef PG8_SCHED
}
}

constexpr int DM = 1024, NBATCH = 8, SEQ = 4096, NTOK = NBATCH * SEQ, CTXL = 256, NCTX = NBATCH * CTXL, MROWS = NTOK + NCTX;
constexpr int DIN = 2048, NHEAD = 8, HD = 64, GRIDW = 64, NMOD = 6 * DM;
constexpr int NEXP = 16384;
constexpr float EPS = 1e-6f;
constexpr int NWAVES = 8;
constexpr int NPHASE = 8;
constexpr float U_SCALE = 64.f, V_SCALE = 4.f;

#define GATHER_V2 1
#ifndef GATHER_NT
#define GATHER_NT 4
#endif
#ifndef MK_N_LAUNCHES
#define MK_N_LAUNCHES 1
#endif
constexpr int N_LAUNCHES = MK_N_LAUNCHES;

constexpr size_t MiB = 1u << 20;
constexpr size_t WS_CTL = 0, CTL_ZERO_BYTES = 64 * 1024;
constexpr size_t WS_WIN = 2 * MiB, WS_WOUT = 6 * MiB, WS_WQ = 8 * MiB, WS_KEYS = 12 * MiB, WS_POOLW = 12 * MiB + 512 * 1024, WS_MOD = 13 * MiB;
constexpr size_t WS_SU = 13 * MiB + 512 * 1024;
constexpr size_t WS_U = 14 * MiB, WS_V = 46 * MiB;
constexpr size_t WS_HX = 78 * MiB;
constexpr size_t WS_ZX = 146 * MiB;
constexpr size_t WS_PB = 146 * MiB, WS_QF = 178 * MiB, WS_KF = 210 * MiB, WS_VF = 244 * MiB;
constexpr size_t WS_MIX = 282 * MiB;
constexpr size_t WS_EXP = 346 * MiB, WS_GATE = 362 * MiB;
constexpr size_t WS_POOLED = 378 * MiB;
constexpr size_t WS_X1 = 378 * MiB;
constexpr size_t WS_LISTS = 410 * MiB;
constexpr size_t WS_END = 442 * MiB;
constexpr int CW_BAR = 4096;

constexpr int RING_OFF = 0, RING_BYTES = 131072;
constexpr int LDSCTL_OFF = RING_BYTES, MISC_OFF = LDSCTL_OFF + 320;
constexpr int LDS_BYTES = 147456;

#define GAS __attribute__((address_space(1)))
#define LAS __attribute__((address_space(3)))
#define DI __device__ __forceinline__
typedef unsigned short bf16;
typedef unsigned v4u __attribute__((ext_vector_type(4)));
typedef unsigned v2u __attribute__((ext_vector_type(2)));
typedef float f32x4 __attribute__((ext_vector_type(4)));
typedef float f32x2 __attribute__((ext_vector_type(2)));
typedef GAS unsigned gu32;
#define RLX_AGENT __ATOMIC_RELAXED, __HIP_MEMORY_SCOPE_AGENT
#define LDS_WAIT() asm volatile("s_waitcnt lgkmcnt(0)" ::: "memory")
#define VM_WAIT() asm volatile("s_waitcnt vmcnt(0)" ::: "memory")
DI unsigned f2bf(float f) { unsigned u = __builtin_bit_cast(unsigned, f); return (u + 0x7fffu + ((u >> 16) & 1u)) >> 16; }
DI unsigned pk2(float lo, float hi) { return f2bf(lo) | (f2bf(hi) << 16); }
DI float bflo(unsigned u) { return __uint_as_float(u << 16); }
DI float bfhi(unsigned u) { return __uint_as_float(u & 0xffff0000u); }
DI float wave_sum(float v) {
#pragma unroll
    for (int o = 1; o < 64; o <<= 1) v += __shfl_xor(v, o);
    return v;
}

#define XB_TMO      128
#define XB_XCNT(j)  (256  + 64 * (j))
#define XB_XSUB(j)  (1280 + 64 * (j))
#define XB_XGEN(j)  (2304 + 64 * (j))
#define XB_TOP      3328
#define XB_TOPGEN   3392
#define XCD_BAR_WORDS 3456
#define XB_SPIN_CAP (1u << 18)

__device__ __forceinline__ unsigned xb_ld(unsigned* p)              { return __hip_atomic_load(p, __ATOMIC_RELAXED, __HIP_MEMORY_SCOPE_AGENT); }
__device__ __forceinline__ unsigned xb_add(unsigned* p, unsigned v) { return __hip_atomic_fetch_add(p, v, __ATOMIC_RELAXED, __HIP_MEMORY_SCOPE_AGENT); }
__device__ __forceinline__ unsigned xb_xcc_id() { return (unsigned)__builtin_amdgcn_s_getreg((3 << 11) | 20) & 0xFu; }
#define XB_SPIN(cond, bar) do { unsigned _sp = 0; while (cond) { __builtin_amdgcn_s_sleep(1); \
    if ((++_sp & 255u) == 0u) { if (xb_ld(&(bar)[XB_TMO])) break; if (_sp > XB_SPIN_CAP) { atomicAdd(&(bar)[XB_TMO], 1u); break; } } } } while (0)

struct XcdBarrier {
    unsigned* bar; unsigned x;
    volatile LAS unsigned* st;
};

__device__ __forceinline__ XcdBarrier xcd_barrier_post(unsigned* bar, volatile LAS unsigned* st) {
    XcdBarrier b; b.bar = bar; b.x = xb_xcc_id(); b.st = st;
    if (threadIdx.x == 0) (void)xb_add(&bar[XB_XCNT(b.x)], 1u);
    return b;
}
__device__ __forceinline__ void xcd_barrier_complete(unsigned* bar, unsigned x, unsigned& nloc, unsigned& nx) {
    const unsigned G = gridDim.x * gridDim.y * gridDim.z;
    unsigned sum, cnt, mine, sp = 0u;
    for (;;) {
        sum = 0u; cnt = 0u; mine = 0u;
#pragma unroll
        for (unsigned j = 0; j < 16; ++j) { const unsigned c = xb_ld(&bar[XB_XCNT(j)]); sum += c; cnt += (c > 0u) ? 1u : 0u; mine = (j == x) ? c : mine; }
        if (sum == G) break;
        __builtin_amdgcn_s_sleep(1);
        if ((++sp & 255u) == 0u) { if (xb_ld(&bar[XB_TMO])) break; if (sp > XB_SPIN_CAP) { atomicAdd(&bar[XB_TMO], 1u); break; } }
    }
    nloc = mine > 0u ? mine : 1u; nx = cnt > 0u ? cnt : 1u;
}

__device__ __forceinline__ void xcd_barrier(const XcdBarrier& b) {
    asm volatile("s_waitcnt vmcnt(0)" ::: "memory");
    __syncthreads();
    if (threadIdx.x == 0) {
        unsigned* bar = b.bar;
        __builtin_amdgcn_s_waitcnt(0);
        unsigned nloc = b.st[0], nx = b.st[1];
        if (nloc == 0u) { xcd_barrier_complete(bar, b.x, nloc, nx); b.st[0] = nloc; b.st[1] = nx; }
        const unsigned old = xb_add(&bar[XB_XSUB(b.x)], 1u);
        const unsigned gen = old / nloc;
        if (old + 1u == (gen + 1u) * nloc) {
            __builtin_amdgcn_fence(__ATOMIC_RELEASE, "agent");
            asm volatile("s_waitcnt vmcnt(0)" ::: "memory");
            const unsigned og = xb_add(&bar[XB_TOP], 1u);
            const unsigned tg = og / nx;
            if (og + 1u == (tg + 1u) * nx) xb_add(&bar[XB_TOPGEN], 1u);
            else XB_SPIN(xb_ld(&bar[XB_TOPGEN]) == tg, bar);
            __builtin_amdgcn_fence(__ATOMIC_ACQUIRE, "agent");
            xb_add(&bar[XB_XGEN(b.x)], 1u);
            asm volatile("s_waitcnt vmcnt(0)" ::: "memory");
        } else {
            XB_SPIN(xb_ld(&bar[XB_XGEN(b.x)]) == gen, bar);
            __builtin_amdgcn_fence(__ATOMIC_ACQUIRE, "agent");
            asm volatile("s_waitcnt vmcnt(0)" ::: "memory");
        }
    }
    __syncthreads();
}


__device__ __forceinline__ void p0_transpose_item(const float* W, int K, int N, bf16* WT, int row_off, LAS float* scr, int item, int lane) {
    const int nblk = N / 32, kb = item / nblk, nb = item % nblk, k0 = 64 * kb, n0 = 32 * nb;
#pragma unroll 8
    for (int i = 0; i < 32; ++i) { const int kk = 2 * i + (lane >> 5); scr[kk * 33 + (lane & 31)] = W[(size_t)(k0 + kk) * N + n0 + (lane & 31)]; }
    LDS_WAIT(); asm volatile("" ::: "memory");
    const int c = lane & 7;
#pragma unroll
    for (int j = 0; j < 4; ++j) { const int n = (lane >> 3) + 8 * j; const LAS float* s = scr + (8 * c) * 33 + n;
        v4u o; o.x = pk2(s[0 * 33], s[1 * 33]); o.y = pk2(s[2 * 33], s[3 * 33]); o.z = pk2(s[4 * 33], s[5 * 33]); o.w = pk2(s[6 * 33], s[7 * 33]);
        *(GAS v4u*)(WT + (size_t)(row_off + n0 + n) * K + k0 + 8 * c) = o; }
    LDS_WAIT(); asm volatile("" ::: "memory");
}


struct Frame {
    LAS unsigned char* lds;
    int tid, lane, wave, vcu, G, gw, NGW;
    const float* in[18]; float* out; unsigned char* ws;
};

DI void p0_prologue(Frame& F) {
    const float* c = F.in[1]; const float* c_ctx = F.in[3]; const float* ada_w = F.in[4]; const float* ada_b = F.in[5];
    float* MOD = (float*)(F.ws + WS_MOD);
    LAS float* sl = (LAS float*)(F.lds + 73728);
    for (int i = F.tid; i < 9 * 1024; i += 512) { const int b = i >> 10, k = i & 1023; const float cv = (b < 8) ? c[b * 1024 + k] : c_ctx[k]; sl[i] = cv / (1.f + __expf(-cv)); }
    __syncthreads();
    { LAS float* part = (LAS float*)(F.lds + 110592);
      for (int cg = F.vcu; cg < NMOD / 24; cg += F.G) {
          const int c = F.lane % 24, sub = F.lane / 24, n = cg * 24 + c, k0 = F.wave * 128 + sub * 64;
          float acc[9];
#pragma unroll
          for (int b = 0; b < 9; ++b) acc[b] = 0.f;
          if (sub < 2) { const float* wp = ada_w + (size_t)k0 * NMOD + n; const LAS float* sp = sl + k0;
#pragma unroll 16
              for (int i = 0; i < 64; ++i) { const float w = wp[(size_t)i * NMOD];
#pragma unroll
                  for (int b = 0; b < 9; ++b) acc[b] += sp[b * 1024 + i] * w; } }
#pragma unroll
          for (int b = 0; b < 9; ++b) { const float o = __shfl(acc[b], (F.lane + 24) & 63); if (F.lane < 24) part[(F.wave * 9 + b) * 24 + c] = acc[b] + o; }
          __syncthreads();
          if (F.tid < 216) { const int b = F.tid / 24, cc = F.tid % 24; float t = ada_b[cg * 24 + cc];
#pragma unroll
              for (int w = 0; w < 8; ++w) t += part[(w * 9 + b) * 24 + cc];
              MOD[b * NMOD + cg * 24 + cc] = t; }
          __syncthreads();
      } }
    LAS float* scr = (LAS float*)(F.lds + F.wave * 9216);
    constexpr int I_IN = (DM / 64) * (DIN / 32), I_OUT = (DM / 64) * (DM / 32), I_Q = (DM / 64) * (2048 / 32), I_P = 4 * 8;
    for (int it = F.gw; it < I_IN + I_OUT + I_Q + I_P; it += F.NGW) {
        int r = it;
        if (r < I_IN) { p0_transpose_item(F.in[7], DM, DIN, (bf16*)(F.ws + WS_WIN), 0, scr, r, F.lane); continue; } r -= I_IN;
        if (r < I_OUT) { p0_transpose_item(F.in[11], DM, DM, (bf16*)(F.ws + WS_WOUT), 0, scr, r, F.lane); continue; } r -= I_OUT;
        if (r < I_Q) { p0_transpose_item(F.in[13], DM, 2048, (bf16*)(F.ws + WS_WQ), 0, scr, r, F.lane); continue; } r -= I_Q;
        { const int g = r >> 3; p0_transpose_item(F.in[8] + g * 16384, 128, 128, (bf16*)(F.ws + WS_POOLW) + g * 16384, 0, scr, r & 7, F.lane); }
    }
    { const float* kf = F.in[14]; bf16* kb = (bf16*)(F.ws + WS_KEYS);
      for (int it = F.gw; it < 16 * 32; it += F.NGW) { const int hp = it >> 5, nt = (it >> 3) & 3, ks = it & 7;
          const float* src = kf + ((size_t)hp * 128 + 32 * nt + (F.lane & 31)) * 128 + 16 * ks + 8 * (F.lane >> 5);
          const f32x4 a = *(const f32x4*)(src), b = *(const f32x4*)(src + 4);
          v4u w; w.x = pk2(a.x, a.y); w.y = pk2(a.z, a.w); w.z = pk2(b.x, b.y); w.w = pk2(b.z, b.w); *(v4u*)(kb + ((size_t)it * 64 + F.lane) * 8) = w; } }
    for (int it = F.gw; it < 2 * NEXP; it += F.NGW) {
        const bool isu = it < NEXP;
        const float* src = isu ? F.in[15] + (size_t)it * 1024 : F.in[16] + (size_t)(it - NEXP) * 1024;
        unsigned* dst = (unsigned*)(isu ? F.ws + WS_U + (size_t)it * 1024 : F.ws + WS_V + (size_t)(it - NEXP) * 1024) + F.lane;
        const f32x4* sp = (const f32x4*)src + F.lane;
        f32x4 a[4];
#pragma unroll
        for (int j = 0; j < 4; ++j) a[j] = sp[64 * j];
        if (isu) {
            float am = 0.f;
#pragma unroll
            for (int j = 0; j < 4; ++j) am = fmaxf(fmaxf(am, fmaxf(fabsf(a[j].x), fabsf(a[j].y))), fmaxf(fabsf(a[j].z), fabsf(a[j].w)));
#pragma unroll
            for (int o = 1; o < 64; o <<= 1) am = fmaxf(am, __shfl_xor(am, o));
            am = fmaxf(am, 1e-30f);
            const float inv = 127.0f / am;
#pragma unroll
            for (int j = 0; j < 4; ++j) { const int q0 = (int)rintf(a[j].x * inv), q1 = (int)rintf(a[j].y * inv), q2 = (int)rintf(a[j].z * inv), q3 = (int)rintf(a[j].w * inv);
                dst[64 * j] = (unsigned)(q0 & 255) | ((unsigned)(q1 & 255) << 8) | ((unsigned)(q2 & 255) << 16) | ((unsigned)(q3 & 255) << 24); }
            if (F.lane == 0) ((float*)(F.ws + WS_SU))[it] = am * (1.0f / 127.0f);
        } else {
#pragma unroll
            for (int j = 0; j < 4; ++j) { const f32x4 sv = a[j] * V_SCALE; int pk = 0; pk = __builtin_amdgcn_cvt_pk_fp8_f32(sv.x, sv.y, pk, false); pk = __builtin_amdgcn_cvt_pk_fp8_f32(sv.z, sv.w, pk, true); dst[64 * j] = (unsigned)pk; }
        }
    }
}

template <bool SRC_BF16> DI void norm_rows(Frame& F, const float* src_x, const float* src_ctx, int nrows, const float* gain, int shift_off, int scale_off, bf16* dst) {
    const float* MOD = (const float*)(F.ws + WS_MOD);
    const int per = (nrows + F.NGW - 1) / F.NGW, m_lo = F.gw * per, m_hi = min(m_lo + per, nrows);
    f32x4 gs[4], shv[4]; int cb = -1;
    for (int m = m_lo; m < m_hi; ++m) {
        const float* xrow; int b;
        if (m < NTOK) { xrow = src_x + (size_t)m * DM; b = m >> 12; } else { xrow = src_ctx + (size_t)(m - NTOK) * DM; b = 8; }
        f32x4 v[4]; float s = 0.f;
        if (SRC_BF16) { const v2u* xr = (const v2u*)((const bf16*)src_x + (size_t)m * DM) + F.lane;
#pragma unroll
            for (int j = 0; j < 4; ++j) { const v2u w = xr[64 * j]; v[j] = (f32x4){bflo(w.x), bfhi(w.x), bflo(w.y), bfhi(w.y)}; }
        } else { const f32x4* xr = (const f32x4*)xrow + F.lane;
#pragma unroll
            for (int j = 0; j < 4; ++j) v[j] = xr[64 * j]; }
        if (b != cb) { cb = b;
            const f32x4* gp = (const f32x4*)gain + F.lane; const f32x4* shp = (const f32x4*)(MOD + b * NMOD + shift_off) + F.lane; const f32x4* scp = (const f32x4*)(MOD + b * NMOD + scale_off) + F.lane;
#pragma unroll
            for (int j = 0; j < 4; ++j) { gs[j] = gp[64 * j] * (scp[64 * j] + 1.0f); shv[j] = shp[64 * j]; } }
#pragma unroll
        for (int j = 0; j < 4; ++j) s += (v[j].x * v[j].x + v[j].y * v[j].y) + (v[j].z * v[j].z + v[j].w * v[j].w);
        const float rinv = 1.0f / sqrtf(wave_sum(s) * (1.f / DM) + EPS);
        unsigned long long* o8 = (unsigned long long*)(dst + (size_t)m * DM) + F.lane;
#pragma unroll
        for (int j = 0; j < 4; ++j) { const f32x4 y = (v[j] * rinv) * gs[j] + shv[j];
            o8[64 * j] = (unsigned long long)pk2(y.x, y.y) | ((unsigned long long)pk2(y.z, y.w) << 32); }
    }
}

DI void attn_key(const bf16* KF, const bf16* VF, int blkbase, int kk, int dt, float bias, const float (&q)[64], float (&o)[32], float& m, float& l) {
    const bf16* kp = KF + (size_t)blkbase * 2048 + kk * 8;
    float acc = 0.f;
#pragma unroll
    for (int cc = 0; cc < 8; ++cc) { const v4u kv = *(const v4u*)(kp + ((cc >> 1) * 64 + (cc & 1) * 32) * 8);
        acc += q[8 * cc + 0] * bflo(kv.x) + q[8 * cc + 1] * bfhi(kv.x) + q[8 * cc + 2] * bflo(kv.y) + q[8 * cc + 3] * bfhi(kv.y)
             + q[8 * cc + 4] * bflo(kv.z) + q[8 * cc + 5] * bfhi(kv.z) + q[8 * cc + 6] * bflo(kv.w) + q[8 * cc + 7] * bfhi(kv.w); }
    const float s = acc + bias;
    const float mn = fmaxf(m, s), alpha = __expf(m - mn), p = __expf(s - mn);
    l = l * alpha + p; m = mn;
    const bf16* vp = VF + (size_t)blkbase * 2048 + dt * 1024 + (kk >> 4) * 512 + (((kk >> 2) & 1) * 32) * 8 + 4 * ((kk >> 3) & 1) + (kk & 3);
#pragma unroll
    for (int d = 0; d < 32; ++d) o[d] = o[d] * alpha + p * __uint_as_float((unsigned)vp[d * 8] << 16);
}
DI void attn_naive(Frame& F) {
    const bf16* QF = (const bf16*)(F.ws + WS_QF); const bf16* KF = (const bf16*)(F.ws + WS_KF); const bf16* VF = (const bf16*)(F.ws + WS_VF);
    bf16* MIX = (bf16*)(F.ws + WS_MIX); const float* rpb = F.in[10];
    for (int unit2 = F.gw; unit2 < 2 * NBATCH * NHEAD * 64; unit2 += F.NGW) {
        const int unit = unit2 >> 1, dt = unit2 & 1;
        const int r = unit & 63, h = (unit >> 6) & 7, b = unit >> 9, col = F.lane;
        const int tq = b * SEQ + r * GRIDW + col;
        float q[64], o[32];
        { const bf16* qp = QF + (size_t)((b * 8 + h) * 128 + 2 * r + (col >> 5)) * 2048 + (col & 31) * 8;
#pragma unroll
          for (int cc = 0; cc < 8; ++cc) { const v4u qv = *(const v4u*)(qp + ((cc >> 1) * 64 + (cc & 1) * 32) * 8);
              q[8 * cc + 0] = 0.125f * bflo(qv.x); q[8 * cc + 1] = 0.125f * bfhi(qv.x); q[8 * cc + 2] = 0.125f * bflo(qv.y); q[8 * cc + 3] = 0.125f * bfhi(qv.y);
              q[8 * cc + 4] = 0.125f * bflo(qv.z); q[8 * cc + 5] = 0.125f * bfhi(qv.z); q[8 * cc + 6] = 0.125f * bflo(qv.w); q[8 * cc + 7] = 0.125f * bfhi(qv.w); } }
#pragma unroll
        for (int d = 0; d < 32; ++d) o[d] = 0.f;
        float m = -1e30f, l = 0.f;
#pragma unroll 1
        for (int g = 0; g < CTXL; ++g) attn_key(KF, VF, (b * 8 + h) * 136 + 128 + (g >> 5), g & 31, dt, 0.f, q, o, m, l);
        const int r0 = min(max(r - 4, 0), 56), c0 = min(max(col - 8, 0), 48);
#pragma unroll 1
        for (int ij = 0; ij < 128; ++ij) { const int i = ij >> 4, j = ij & 15, kc = c0 + j;
            attn_key(KF, VF, (b * 8 + h) * 136 + 2 * (r0 + i) + (kc >> 5), kc & 31, dt, rpb[(h * 15 + (r0 + i - r + 7)) * 31 + (kc - col + 15)], q, o, m, l); }
        const float il = 1.0f / l;
        v4u* op = (v4u*)(MIX + (size_t)tq * DM + 512 + h * 64 + dt * 32);
#pragma unroll
        for (int cc = 0; cc < 4; ++cc) { v4u w; w.x = pk2(o[8 * cc] * il, o[8 * cc + 1] * il); w.y = pk2(o[8 * cc + 2] * il, o[8 * cc + 3] * il);
            w.z = pk2(o[8 * cc + 4] * il, o[8 * cc + 5] * il); w.w = pk2(o[8 * cc + 6] * il, o[8 * cc + 7] * il); op[cc] = w; }
    }
}
typedef float f32x16 __attribute__((ext_vector_type(16)));
typedef short s16x8 __attribute__((ext_vector_type(8)));
typedef __bf16 bf16x2_t __attribute__((ext_vector_type(2)));
#define MFMA32(a, b, c) __builtin_amdgcn_mfma_f32_32x32x16_bf16((a), (b), (c), 0, 0, 0)
DI unsigned cvtpk(float lo, float hi) { f32x2 v = {lo, hi}; bf16x2_t bb = __builtin_convertvector(v, bf16x2_t); return __builtin_bit_cast(unsigned, bb); }
DI float pairmax(float v) { auto rr = __builtin_amdgcn_permlane32_swap(__float_as_uint(v), __float_as_uint(v), false, false); return fmaxf(__uint_as_float(rr[0]), __uint_as_float(rr[1])); }
constexpr float LOG2E = 1.4426950408889634f, ATT_C2 = 0.125f * LOG2E, ATT_THR = 6.0f;
template <int QMASK, bool LOCAL>
DI void attn_tile(const s16x8 (&kf)[4], const s16x8 (&vf)[4], const LAS s16x8* qfp, f32x16 (&o)[2], float& m, float& l, const LAS float* brow, int djb, int lo) {
    f32x16 s; s16x8 qf[4];
#pragma unroll
    for (int ks = 0; ks < 4; ++ks) qf[ks] = qfp[ks * 64];
#pragma unroll
    for (int i = 0; i < 16; ++i) s[i] = 0.f;
#pragma unroll
    for (int ks = 0; ks < 4; ++ks) s = MFMA32(kf[ks], qf[ks], s);
    float sv[16]; float tmax = -INFINITY;
#pragma unroll
    for (int i = 0; i < 16; ++i) {
        if (!((QMASK >> (i >> 2)) & 1)) { sv[i] = -INFINITY; continue; }
        if (LOCAL) { const int dj = djb + (i & 3) + 8 * (i >> 2); const bool valid = (unsigned)(dj - lo) < 16u;
            const float x = s[i] * ATT_C2 + brow[valid ? dj : 0]; sv[i] = valid ? x : -INFINITY; }
        else sv[i] = s[i] * ATT_C2;
        tmax = fmaxf(tmax, sv[i]);
    }
    tmax = pairmax(tmax);
    if (__any(tmax > m + ATT_THR)) { const float mn = fmaxf(m, tmax), alpha = __builtin_amdgcn_exp2f(m - mn); o[0] *= alpha; o[1] *= alpha; l *= alpha; m = mn; }
    float p[16];
#pragma unroll
    for (int i = 0; i < 16; ++i) { if ((QMASK >> (i >> 2)) & 1) { p[i] = __builtin_amdgcn_exp2f(sv[i] - m); l += p[i]; } else p[i] = 0.f; }
#pragma unroll
    for (int s2 = 0; s2 < 2; ++s2) if (QMASK & (3 << (2 * s2))) {
        v4u pk; pk.x = cvtpk(p[8 * s2], p[8 * s2 + 1]); pk.y = cvtpk(p[8 * s2 + 2], p[8 * s2 + 3]); pk.z = cvtpk(p[8 * s2 + 4], p[8 * s2 + 5]); pk.w = cvtpk(p[8 * s2 + 6], p[8 * s2 + 7]);
        const s16x8 pf = __builtin_bit_cast(s16x8, pk);
        o[0] = MFMA32(vf[s2], pf, o[0]); o[1] = MFMA32(vf[2 + s2], pf, o[1]);
    }
}
DI void attn_mfma(Frame& F) {
    const bf16* QF = (const bf16*)(F.ws + WS_QF); const bf16* KF = (const bf16*)(F.ws + WS_KF); const bf16* VF = (const bf16*)(F.ws + WS_VF);
    bf16* MIX = (bf16*)(F.ws + WS_MIX); const float* rpb = F.in[10];
    LAS float* rp = (LAS float*)(F.lds);
    for (int i = F.tid; i < NHEAD * 15 * 31; i += 512) rp[i] = rpb[i] * LOG2E;
    __syncthreads();
    const int lane = F.lane, hh = lane >> 5, ql = lane & 31;
    int lo[2], djb[2][2];
#pragma unroll
    for (int qb = 0; qb < 2; ++qb) { const int qc = 32 * qb + ql, c0 = min(max(qc - 8, 0), 48); lo[qb] = c0 - qc + 15;
#pragma unroll
        for (int jb = 0; jb < 2; ++jb) djb[qb][jb] = 32 * (jb - qb) + 4 * hh - ql + 15; }
    for (int unit = F.gw; unit < NBATCH * NHEAD * 64; unit += F.NGW) {
        const int r = unit & 63, h = (unit >> 6) & 7, b = unit >> 9, bh = b * 8 + h;
        LAS s16x8* qfl = (LAS s16x8*)(F.lds + 16384 + F.wave * 8192) + lane;
#pragma unroll
        for (int qb = 0; qb < 2; ++qb)
#pragma unroll
            for (int ks = 0; ks < 4; ++ks) qfl[(qb * 4 + ks) * 64] = ((const s16x8*)(QF + (size_t)(bh * 128 + 2 * r + qb) * 2048))[ks * 64 + lane];
        f32x16 o[2][2]; float m[2], l[2];
#pragma unroll
        for (int qb = 0; qb < 2; ++qb) { m[qb] = -1e30f; l[qb] = 0.f;
#pragma unroll
            for (int dt = 0; dt < 2; ++dt)
#pragma unroll
                for (int i = 0; i < 16; ++i) o[qb][dt][i] = 0.f; }
        s16x8 kf[4], vf[4];
#pragma unroll 1
        for (int kb = 0; kb < 8; ++kb) {
            const s16x8* kp = (const s16x8*)(KF + (size_t)(bh * 136 + 128 + kb) * 2048) + lane; const s16x8* vp = (const s16x8*)(VF + (size_t)(bh * 136 + 128 + kb) * 2048) + lane;
#pragma unroll
            for (int j = 0; j < 4; ++j) { kf[j] = kp[j * 64]; vf[j] = vp[j * 64]; }
            attn_tile<15, false>(kf, vf, qfl, o[0], m[0], l[0], rp, 0, 0); __builtin_amdgcn_sched_barrier(0);
            attn_tile<15, false>(kf, vf, qfl + 256, o[1], m[1], l[1], rp, 0, 0); __builtin_amdgcn_sched_barrier(0);
        }
        const int r0 = min(max(r - 4, 0), 56);
#pragma unroll 1
        for (int i = 0; i < 8; ++i) {
            const LAS float* brow = rp + (h * 15 + (r0 + i - r + 7)) * 31;
            { const s16x8* kp = (const s16x8*)(KF + (size_t)(bh * 136 + 2 * (r0 + i)) * 2048) + lane; const s16x8* vp = (const s16x8*)(VF + (size_t)(bh * 136 + 2 * (r0 + i)) * 2048) + lane;
#pragma unroll
              for (int j = 0; j < 4; ++j) { kf[j] = kp[j * 64]; vf[j] = vp[j * 64]; } }
            attn_tile<15, true>(kf, vf, qfl, o[0], m[0], l[0], brow, djb[0][0], lo[0]); __builtin_amdgcn_sched_barrier(0);
            attn_tile<8, true>(kf, vf, qfl + 256, o[1], m[1], l[1], brow, djb[1][0], lo[1]); __builtin_amdgcn_sched_barrier(0);
            { const s16x8* kp = (const s16x8*)(KF + (size_t)(bh * 136 + 2 * (r0 + i) + 1) * 2048) + lane; const s16x8* vp = (const s16x8*)(VF + (size_t)(bh * 136 + 2 * (r0 + i) + 1) * 2048) + lane;
#pragma unroll
              for (int j = 0; j < 4; ++j) { kf[j] = kp[j * 64]; vf[j] = vp[j * 64]; } }
            attn_tile<1, true>(kf, vf, qfl, o[0], m[0], l[0], brow, djb[0][1], lo[0]); __builtin_amdgcn_sched_barrier(0);
            attn_tile<15, true>(kf, vf, qfl + 256, o[1], m[1], l[1], brow, djb[1][1], lo[1]); __builtin_amdgcn_sched_barrier(0);
        }
#pragma unroll
        for (int qb = 0; qb < 2; ++qb) {
            const float lt = l[qb] + __shfl_xor(l[qb], 32), inv = 1.0f / lt;
            bf16* orow = MIX + (size_t)(b * SEQ + r * GRIDW + 32 * qb + ql) * DM + 512 + h * 64 + 4 * hh;
#pragma unroll
            for (int dt = 0; dt < 2; ++dt)
#pragma unroll
                for (int g = 0; g < 4; ++g) { v2u w; w.x = pk2(o[qb][dt][4 * g] * inv, o[qb][dt][4 * g + 1] * inv); w.y = pk2(o[qb][dt][4 * g + 2] * inv, o[qb][dt][4 * g + 3] * inv);
                    *(v2u*)(orow + 32 * dt + 8 * g) = w; }
        }
    }
    __syncthreads();
}
DI void pool_mfma(Frame& F) {
    const bf16* PBF = (const bf16*)(F.ws + WS_PB); bf16* MIX = (bf16*)(F.ws + WS_MIX); const bf16* PW = (const bf16*)(F.ws + WS_POOLW); const float* pool_scale = F.in[9];
    constexpr int RS = 272;
    LAS unsigned char* ptile = F.lds + 32768;
    LAS unsigned char* atile = F.lds + 32768 + 144 * RS;
    const int lane = F.lane, hh = lane >> 5, ql = lane & 31;
    for (int tile = F.vcu; tile < NTOK / 128; tile += F.G) {
        const int tok0 = tile * 128, bstart = tok0 & ~(SEQ - 1);
#pragma unroll 1
        for (int g = 0; g < 4; ++g) {
            for (int it = F.tid; it < 144 * 16; it += 512) { const int rr = it >> 4, ch = it & 15, t = tok0 - 8 + rr;
                v4u v = (v4u){0u, 0u, 0u, 0u};
                if (t >= bstart && t < bstart + SEQ) v = *(const v4u*)(PBF + (size_t)t * 512 + g * 128 + ch * 8);
                *(LAS v4u*)(ptile + rr * RS + ch * 16) = v; }
            __syncthreads();
            { const int cp = F.tid & 63, sg = F.tid >> 6, w = 2 << g, hw = w >> 1;
              const LAS unsigned char* col = ptile + cp * 4;
              float s0 = 0.f, s1 = 0.f;
              const int tl0 = sg * 16;
              for (int rr = tl0 + 8 - hw; rr < tl0 + 8 + hw; ++rr) { const unsigned u = *(const LAS unsigned*)(col + rr * RS); s0 += bflo(u); s1 += bfhi(u); }
#pragma unroll 4
              for (int i = 0; i < 16; ++i) { const int tl = tl0 + i, sp = (tok0 + tl) & (SEQ - 1);
                  const int cnt = min(sp + hw, SEQ) - max(sp - hw, 0); const float inv = 1.0f / (float)cnt;
                  const unsigned self = *(const LAS unsigned*)(col + (tl + 8) * RS);
                  *(LAS unsigned*)(atile + tl * RS + cp * 4) = pk2(s0 * inv - bflo(self), s1 * inv - bfhi(self));
                  const unsigned un = *(const LAS unsigned*)(col + (tl + 8 + hw) * RS), uo = *(const LAS unsigned*)(col + (tl + 8 - hw) * RS);
                  s0 += bflo(un) - bflo(uo); s1 += bfhi(un) - bfhi(uo); } }
            __syncthreads();
            { const int tb = F.wave >> 1, dt0 = (F.wave & 1) * 2;
              f32x16 acc[2];
#pragma unroll
              for (int j = 0; j < 2; ++j)
#pragma unroll
                  for (int i = 0; i < 16; ++i) acc[j][i] = 0.f;
#pragma unroll
              for (int ks = 0; ks < 8; ++ks) {
                  const s16x8 bfr = *(const LAS s16x8*)(atile + (32 * tb + ql) * RS + (16 * ks + 8 * hh) * 2);
#pragma unroll
                  for (int j = 0; j < 2; ++j) { const s16x8 afr = *(const s16x8*)(PW + (size_t)g * 16384 + (32 * (dt0 + j) + ql) * 128 + 16 * ks + 8 * hh);
                      acc[j] = MFMA32(afr, bfr, acc[j]); } }
              bf16* orow = MIX + (size_t)(tok0 + 32 * tb + ql) * DM + g * 128 + 4 * hh;
#pragma unroll
              for (int j = 0; j < 2; ++j)
#pragma unroll
                  for (int q = 0; q < 4; ++q) { const int d = 32 * (dt0 + j) + 8 * q; const f32x4 sc = *(const f32x4*)(pool_scale + g * 128 + d + 4 * hh);
                      v2u wv; wv.x = pk2(acc[j][4 * q] * sc.x, acc[j][4 * q + 1] * sc.y); wv.y = pk2(acc[j][4 * q + 2] * sc.z, acc[j][4 * q + 3] * sc.w);
                      *(v2u*)(orow + d) = wv; } }
            __syncthreads();
        }
    }
}
DI void pool_naive(Frame& F) {
    const bf16* PBF = (const bf16*)(F.ws + WS_PB); bf16* MIX = (bf16*)(F.ws + WS_MIX); bf16* PO = (bf16*)(F.ws + WS_POOLED);
    const float* pool_w = F.in[8]; const float* pool_scale = F.in[9];
    for (int tile = F.vcu; tile < NTOK / 128; tile += F.G) {
        const int tok0 = tile * 128;
        for (int it = F.tid; it < 128 * 64; it += 512) {
            const int t = tok0 + (it >> 6), ch = (it & 63) * 8, g = ch >> 7, w = 2 << g, s = t & (SEQ - 1), tb = t - s;
            const int lo = max(s - w / 2, 0), hi = min(s + w / 2, SEQ);
            float acc[8];
#pragma unroll
            for (int i = 0; i < 8; ++i) acc[i] = 0.f;
            for (int p = lo; p < hi; ++p) { const v4u v = *(const v4u*)(PBF + (size_t)(tb + p) * 512 + ch);
                acc[0] += bflo(v.x); acc[1] += bfhi(v.x); acc[2] += bflo(v.y); acc[3] += bfhi(v.y); acc[4] += bflo(v.z); acc[5] += bfhi(v.z); acc[6] += bflo(v.w); acc[7] += bfhi(v.w); }
            const float inv = 1.0f / (float)(hi - lo);
            const v4u sv = *(const v4u*)(PBF + (size_t)t * 512 + ch);
            v4u wv; wv.x = pk2(acc[0] * inv - bflo(sv.x), acc[1] * inv - bfhi(sv.x)); wv.y = pk2(acc[2] * inv - bflo(sv.y), acc[3] * inv - bfhi(sv.y));
            wv.z = pk2(acc[4] * inv - bflo(sv.z), acc[5] * inv - bfhi(sv.z)); wv.w = pk2(acc[6] * inv - bflo(sv.w), acc[7] * inv - bfhi(sv.w));
            *(v4u*)(PO + (size_t)t * 512 + ch) = wv;
        }
        VM_WAIT(); __syncthreads();
        for (int it = F.wave; it < 1024; it += 8) {
            const int t = tok0 + (it >> 3), g = (it >> 1) & 3, d = (it & 1) * 64 + F.lane;
            const bf16* pr = PO + (size_t)t * 512 + g * 128; const float* wp = pool_w + g * 16384 + d;
            float acc = 0.f;
            for (int c8 = 0; c8 < 16; ++c8) { const v4u pv = *(const v4u*)(pr + c8 * 8); const float* w8 = wp + c8 * 8 * 128;
                acc += bflo(pv.x) * w8[0] + bfhi(pv.x) * w8[128] + bflo(pv.y) * w8[256] + bfhi(pv.y) * w8[384] + bflo(pv.z) * w8[512] + bfhi(pv.z) * w8[640] + bflo(pv.w) * w8[768] + bfhi(pv.w) * w8[896]; }
            MIX[(size_t)t * DM + g * 128 + d] = (bf16)f2bf(acc * pool_scale[g * 128 + d]);
        }
        __syncthreads();
    }
}

DI void peer_topk_naive(Frame& F, int tok0) {
    const bf16* Q = (const bf16*)(F.ws + WS_ZX); const float* keys = F.in[14]; float* LISTS = (float*)(F.ws + WS_LISTS);
    int* EXPERTS = (int*)(F.ws + WS_EXP); float* GATES = (float*)(F.ws + WS_GATE);
    for (int it = F.wave; it < 32; it += 8) {
        const int hp = it & 15, t = tok0 + (it >> 4) * 64 + F.lane;
        float q[128];
        { const v4u* qp = (const v4u*)(Q + (size_t)t * 2048 + hp * 128);
#pragma unroll
          for (int cc = 0; cc < 16; ++cc) { const v4u qv = qp[cc];
              q[8 * cc + 0] = bflo(qv.x); q[8 * cc + 1] = bfhi(qv.x); q[8 * cc + 2] = bflo(qv.y); q[8 * cc + 3] = bfhi(qv.y);
              q[8 * cc + 4] = bflo(qv.z); q[8 * cc + 5] = bfhi(qv.z); q[8 * cc + 6] = bflo(qv.w); q[8 * cc + 7] = bfhi(qv.w); } }
        float top[16];
#pragma unroll
        for (int i = 0; i < 16; ++i) top[i] = -INFINITY;
        const float* kb = keys + (size_t)hp * 16384;
        for (int n = 0; n < 128; ++n) {
            const f32x4* kr = (const f32x4*)(kb + n * 128);
            float acc = 0.f;
#pragma unroll
            for (int cc = 0; cc < 32; ++cc) { const f32x4 kv = kr[cc]; acc += q[4 * cc] * kv.x + q[4 * cc + 1] * kv.y + q[4 * cc + 2] * kv.z + q[4 * cc + 3] * kv.w; }
            float v = __uint_as_float((__float_as_uint(acc) & ~127u) | (unsigned)n);
#pragma unroll
            for (int i = 0; i < 16; ++i) { const float hi = fmaxf(top[i], v); v = fminf(top[i], v); top[i] = hi; }
        }
        f32x4* lp = (f32x4*)(LISTS + ((size_t)t * 16 + hp) * 16);
#pragma unroll
        for (int i = 0; i < 4; ++i) lp[i] = (f32x4){top[4 * i], top[4 * i + 1], top[4 * i + 2], top[4 * i + 3]};
    }
    VM_WAIT(); __syncthreads();
    for (int it = F.tid; it < 128 * 8; it += 512) {
        const int t = tok0 + (it >> 3), h = it & 7;
        float v0[16], v1[16]; int i0[16], i1[16];
        const f32x4* l0 = (const f32x4*)(LISTS + ((size_t)t * 16 + h * 2) * 16);
#pragma unroll
        for (int i = 0; i < 4; ++i) { const f32x4 a = l0[i], b = l0[4 + i];
#pragma unroll
            for (int e = 0; e < 4; ++e) { const unsigned ua = __float_as_uint(a[e]), ub = __float_as_uint(b[e]);
                v0[4 * i + e] = __uint_as_float(ua & ~127u); i0[4 * i + e] = (int)(ua & 127u); v1[4 * i + e] = __uint_as_float(ub & ~127u); i1[4 * i + e] = (int)(ub & 127u); } }
        float tv[16]; int ti[16];
#pragma unroll
        for (int i = 0; i < 16; ++i) { tv[i] = -INFINITY; ti[i] = 0; }
#pragma unroll
        for (int i = 0; i < 16; ++i)
#pragma unroll
            for (int j = 0; j < 16; ++j) if ((i + 1) * (j + 1) <= 16) {
                float cv = v0[i] + v1[j]; int ci = i0[i] * 128 + i1[j];
#pragma unroll
                for (int k = 0; k < 16; ++k) { const bool gt = cv > tv[k]; const float nv = gt ? cv : tv[k]; const int ni = gt ? ci : ti[k]; cv = gt ? tv[k] : cv; ci = gt ? ti[k] : ci; tv[k] = nv; ti[k] = ni; }
            }
        float e[16], sum = 0.f;
#pragma unroll
        for (int k = 0; k < 16; ++k) { e[k] = __expf(tv[k] - tv[0]); sum += e[k]; }
        const float is = 1.0f / sum;
        int* ep = EXPERTS + (size_t)t * 128 + h * 16; float* gp = GATES + (size_t)t * 128 + h * 16;
#pragma unroll
        for (int k = 0; k < 16; ++k) { ep[k] = ti[k]; gp[k] = e[k] * is; }
    }
    VM_WAIT(); __syncthreads();
}

DI int f2key(float f) { const int b = __float_as_int(f); return b ^ ((b >> 31) & 0x7fffffff); }
DI float key2f(int k) { return __int_as_float(k ^ ((k >> 31) & 0x7fffffff)); }
DI void ce_desc(int& x, int& y) { const int hi = max(x, y), lo = min(x, y); x = hi; y = lo; }
DI void sort16_desc(int (&a)[16]) {
#pragma unroll
    for (int k = 2; k <= 16; k <<= 1)
#pragma unroll
        for (int j = k >> 1; j > 0; j >>= 1)
#pragma unroll
            for (int i = 0; i < 16; ++i) { const int l = i ^ j; if (l > i) { if ((i & k) == 0) ce_desc(a[i], a[l]); else ce_desc(a[l], a[i]); } }
}
DI void merge16_desc(int (&a)[16], const int (&b)[16]) {
#pragma unroll
    for (int i = 0; i < 16; ++i) a[i] = max(a[i], b[15 - i]);
#pragma unroll
    for (int j = 8; j > 0; j >>= 1)
#pragma unroll
        for (int i = 0; i < 16; ++i) if ((i & j) == 0) ce_desc(a[i], a[i + j]);
}
DI void peer_topk_mfma(Frame& F, int tile) {
    const bf16* QP = (const bf16*)(F.ws + WS_ZX); const bf16* KEYF = (const bf16*)(F.ws + WS_KEYS);
    int* EXPERTS = (int*)(F.ws + WS_EXP); float* GATES = (float*)(F.ws + WS_GATE);
    const int lane = F.lane, hh = lane >> 5, ql = lane & 31, tb = F.wave >> 1, p = F.wave & 1;
    const int tokblk = tile * 4 + tb, tok = tokblk * 32 + ql;
#pragma unroll 1
    for (int h = 0; h < 8; ++h) {
        const int hp = 2 * h + p;
        s16x8 qf[8];
#pragma unroll
        for (int ks = 0; ks < 8; ++ks) qf[ks] = ((const s16x8*)(QP + ((size_t)tokblk * 16 + hp) * 4096))[ks * 64 + lane];
        const s16x8* kfp = (const s16x8*)(KEYF + (size_t)hp * 16384) + lane;
        int top[16];
#pragma unroll
        for (int i = 0; i < 16; ++i) top[i] = (int)0x80000000;
#pragma unroll 1
        for (int nt = 0; nt < 4; ++nt) {
            f32x16 acc;
#pragma unroll
            for (int i = 0; i < 16; ++i) acc[i] = 0.f;
#pragma unroll
            for (int ks = 0; ks < 8; ++ks) acc = MFMA32(kfp[(nt * 8 + ks) * 64], qf[ks], acc);
            int a[16];
#pragma unroll
            for (int i = 0; i < 16; ++i) { const int n = 32 * nt + (i & 3) + 8 * (i >> 2) + 4 * hh; a[i] = f2key(__int_as_float((__float_as_int(acc[i]) & ~127) | n)); }
            sort16_desc(a);
            merge16_desc(top, a);
        }
        { int oth[16];
#pragma unroll
          for (int i = 0; i < 16; ++i) oth[i] = __shfl_xor(top[i], 32);
          merge16_desc(top, oth); }
        LAS float* L = (LAS float*)(F.lds) + (h & 1) * 4096 + (tb * 2) * 512;
        if (hh == 0) {
#pragma unroll
            for (int i = 0; i < 16; ++i) L[p * 512 + i * 32 + ql] = key2f(top[i]);
        }
        __syncthreads();
        if (p == 0 && hh == 0) {
            float v0[16], v1[16];
#pragma unroll
            for (int i = 0; i < 16; ++i) { v0[i] = __int_as_float(__float_as_int(L[i * 32 + ql]) & ~127); v1[i] = __int_as_float(__float_as_int(L[512 + i * 32 + ql]) & ~127); }
            int grp[4][16]; int cnt = 0;
#pragma unroll
            for (int g = 0; g < 4; ++g)
#pragma unroll
                for (int i = 0; i < 16; ++i) grp[g][i] = (int)0x80000000;
#pragma unroll
            for (int i = 0; i < 16; ++i)
#pragma unroll
                for (int j = 0; j < 16; ++j) if ((i + 1) * (j + 1) <= 16) {
                    grp[cnt >> 4][cnt & 15] = f2key(__int_as_float((__float_as_int(v0[i] + v1[j]) & ~255) | (i * 16 + j))); ++cnt; }
#pragma unroll
            for (int g = 0; g < 4; ++g) sort16_desc(grp[g]);
            merge16_desc(grp[0], grp[1]); merge16_desc(grp[2], grp[3]); merge16_desc(grp[0], grp[2]);
            float tv[16]; float e[16]; float sum = 0.f; int eid[16];
#pragma unroll
            for (int k = 0; k < 16; ++k) { const int bits = __float_as_int(key2f(grp[0][k])); const int code = bits & 255; tv[k] = __int_as_float(bits & ~255);
                const int n0 = __float_as_int(L[(code >> 4) * 32 + ql]) & 127, n1 = __float_as_int(L[512 + (code & 15) * 32 + ql]) & 127; eid[k] = n0 * 128 + n1; }
#pragma unroll
            for (int k = 0; k < 16; ++k) { e[k] = __expf(tv[k] - tv[0]); sum += e[k]; }
            const float is = 1.0f / sum;
            int* ep = EXPERTS + (size_t)tok * 128 + h * 16; float* gp = GATES + (size_t)tok * 128 + h * 16;
#pragma unroll
            for (int k4 = 0; k4 < 4; ++k4) { *(v4u*)(ep + 4 * k4) = (v4u){(unsigned)eid[4 * k4], (unsigned)eid[4 * k4 + 1], (unsigned)eid[4 * k4 + 2], (unsigned)eid[4 * k4 + 3]};
                *(f32x4*)(gp + 4 * k4) = (f32x4){e[4 * k4] * is, e[4 * k4 + 1] * is, e[4 * k4 + 2] * is, e[4 * k4 + 3] * is}; }
        }
    }
    VM_WAIT(); __syncthreads();
}

DI float gelu_fast(float v) {
    const float av = fabsf(v), t = __builtin_amdgcn_rcpf(av * 0.2316418882f + 1.0f);
    float q = t * 0.5307027145f + (-0.7265760135f); q = q * t + 0.7107068705f; q = q * t + (-0.142248368f); q = q * t + 0.127414796f; q = q * t;
    const float e = __builtin_amdgcn_exp2f((v * v) * (-0.72134752044f));
    const float m = v * (q * e);
    return v < 0.f ? m : v - m;
}
DI float gelu_exact(float a) { return 0.5f * a * (1.0f + erff(a * 0.70710678118654752f)); }

DI void fp8x16_to_f32(const v4u r, float (&f)[16]) {
#pragma unroll
    for (int j = 0; j < 4; ++j) { const f32x2 lo = __builtin_amdgcn_cvt_pk_f32_fp8((int)r[j], false), hi = __builtin_amdgcn_cvt_pk_f32_fp8((int)r[j], true);
        f[4 * j] = lo.x; f[4 * j + 1] = lo.y; f[4 * j + 2] = hi.x; f[4 * j + 3] = hi.y; }
}
typedef __bf16 bf16x2v __attribute__((ext_vector_type(2)));
#ifndef G2_NOSORT
#define G2_NOSORT 0
#endif
#define TOK_CASE(JV, BODY) { constexpr int j = JV; BODY }
#define TOK_DISPATCHN(tk, BODY) do { if constexpr (NT == 1) TOK_CASE(0, BODY) else if constexpr (NT == 2) { if ((tk) < 1) TOK_CASE(0, BODY) else TOK_CASE(1, BODY) } \
    else { if ((tk) < 2) { if ((tk) < 1) TOK_CASE(0, BODY) else TOK_CASE(1, BODY) } else { if ((tk) < 3) TOK_CASE(2, BODY) else TOK_CASE(NT > 3 ? 3 : 0, BODY) } } } while (0)
template <int NT, bool FAKE = false> DI void gather_round(Frame& F, int tbase, volatile LAS int* prog, int pbase) {
    constexpr int NK = 2 * NT, N = 128 * NT, NB = N / 8, LPB = 8 / NK;
    const bf16* H2 = (const bf16*)(F.ws + WS_HX); const unsigned char* U = F.ws + WS_U; const unsigned char* V = F.ws + WS_V;
    const int* EXPERTS = (const int*)(F.ws + WS_EXP); const float* GATES = (const float*)(F.ws + WS_GATE); const float* MOD = (const float*)(F.ws + WS_MOD);
    const int lane = F.lane;
    int key[NK];
#pragma unroll
    for (int j = 0; j < NT; ++j)
#pragma unroll
        for (int hf = 0; hf < 2; ++hf) { const int k = hf * 64 + lane; key[j * 2 + hf] = (EXPERTS[(size_t)(tbase + j) * 128 + k] << 9) | (j << 7) | k; }
#pragma unroll
    for (int k = 2; k <= (G2_NOSORT ? 1 : N); k <<= 1)
#pragma unroll
        for (int j = k >> 1; j > 0; j >>= 1) {
            if (j < NK) {
#pragma unroll
                for (int r = 0; r < NK; ++r) if ((r & j) == 0) { const bool asc = (((lane * NK + r) & k) == 0); const int x = key[r], y = key[r | j], lo = min(x, y), hi = max(x, y);
                    key[r] = asc ? lo : hi; key[r | j] = asc ? hi : lo; }
            } else {
                const bool asc = (((lane * NK) & k) == 0), lower = ((lane & (j / NK)) == 0), takemin = (asc == lower);
#pragma unroll
                for (int r = 0; r < NK; ++r) { const int o = __shfl_xor(key[r], j / NK); key[r] = takemin ? min(key[r], o) : max(key[r], o); }
            }
        }
    unsigned hsq[NT][4]; float hsc[NT]; float out[NT][16];
#pragma unroll
    for (int j = 0; j < NT; ++j) { const v4u a = *((const v4u*)(H2 + (size_t)(tbase + j) * DM + lane * 16)), b = *((const v4u*)(H2 + (size_t)(tbase + j) * DM + lane * 16 + 8));
        float hv[16]; hv[0] = bflo(a.x); hv[1] = bfhi(a.x); hv[2] = bflo(a.y); hv[3] = bfhi(a.y); hv[4] = bflo(a.z); hv[5] = bfhi(a.z); hv[6] = bflo(a.w); hv[7] = bfhi(a.w);
        hv[8] = bflo(b.x); hv[9] = bfhi(b.x); hv[10] = bflo(b.y); hv[11] = bfhi(b.y); hv[12] = bflo(b.z); hv[13] = bfhi(b.z); hv[14] = bflo(b.w); hv[15] = bfhi(b.w);
        float am = 0.f;
#pragma unroll
        for (int i = 0; i < 16; ++i) am = fmaxf(am, fabsf(hv[i]));
#pragma unroll
        for (int o = 1; o < 64; o <<= 1) am = fmaxf(am, __shfl_xor(am, o));
        am = fmaxf(am, 1e-30f); hsc[j] = am * (1.0f / 127.0f);
        const float inv = 127.0f / am;
#pragma unroll
        for (int d = 0; d < 4; ++d) { const int q0 = (int)rintf(hv[4 * d] * inv), q1 = (int)rintf(hv[4 * d + 1] * inv), q2 = (int)rintf(hv[4 * d + 2] * inv), q3 = (int)rintf(hv[4 * d + 3] * inv);
            hsq[j][d] = (unsigned)(q0 & 255) | ((unsigned)(q1 & 255) << 8) | ((unsigned)(q2 & 255) << 16) | ((unsigned)(q3 & 255) << 24); }
#pragma unroll
        for (int i = 0; i < 16; ++i) out[j][i] = 0.f; }
    LAS float* sgL = (LAS float*)(F.lds + 65536) + F.wave * (2 * N); LAS float* suL = sgL + N;
    const float* SU = (const float*)(F.ws + WS_SU);
#pragma unroll
    for (int r = 0; r < NK; ++r) { const int tj = (key[r] >> 7) & 3; float sc = hsc[0];
#pragma unroll
        for (int j = 1; j < NT; ++j) sc = (tj == j) ? hsc[j] : sc;
        sgL[lane * NK + r] = GATES[(size_t)(tbase + tj) * 128 + (key[r] & 127)]; suL[lane * NK + r] = SU[(key[r] >> 9) & (FAKE ? 7 : 16383)] * sc; }
    v4u ucur[8];
#pragma unroll
    for (int r = 0; r < 8; ++r) { const int kk = __builtin_amdgcn_readlane(key[r % NK], r / NK); ucur[r] = *((const v4u*)(U + (size_t)((kk >> 9) & (FAKE ? 7 : 16383)) * 1024) + lane); }
#pragma unroll 1
    for (int b = 0; b < NB; ++b) {
        int kk[8]; v4u vcur[8];
#pragma unroll
        for (int r = 0; r < 8; ++r) { kk[r] = __builtin_amdgcn_readlane(key[r % NK], b * LPB + r / NK); vcur[r] = *((const v4u*)(V + (size_t)((kk[r] >> 9) & (FAKE ? 7 : 16383)) * 1024) + lane); }
        if (lane == 0) *prog = pbase + (kk[0] >> 9);
        int p[8];
#pragma unroll
        for (int r = 0; r < 8; ++r) { const int tk = (kk[r] >> 7) & 3; int acc = 0;
#pragma unroll
            for (int j = 0; j < NT; ++j) if (tk == j) {
#pragma unroll
                for (int q = 0; q < 4; ++q) acc = __builtin_amdgcn_sdot4((int)ucur[r][q], (int)hsq[j][q], acc, false); }
            p[r] = acc; }
        { const int bn = (b + 1 < NB) ? b + 1 : 0;
#pragma unroll
          for (int r = 0; r < 8; ++r) { const int kn = __builtin_amdgcn_readlane(key[r % NK], bn * LPB + r / NK); ucur[r] = *((const v4u*)(U + (size_t)((kn >> 9) & (FAKE ? 7 : 16383)) * 1024) + lane); } }
        int psum;
        { int q4[4];
#pragma unroll
          for (int i = 0; i < 4; ++i) { auto rr = __builtin_amdgcn_permlane32_swap((unsigned)p[i], (unsigned)p[i + 4], false, false); q4[i] = (int)(rr[0] + rr[1]); }
          int q2[2];
#pragma unroll
          for (int i = 0; i < 2; ++i) { auto rr = __builtin_amdgcn_permlane16_swap((unsigned)q4[i], (unsigned)q4[i + 2], false, false); q2[i] = (int)(rr[0] + rr[1]); }
          const int t0 = q2[0] + __builtin_amdgcn_update_dpp(0, q2[0], 0x128, 0xf, 0xf, false);
          const int t1 = q2[1] + __builtin_amdgcn_update_dpp(0, q2[1], 0x128, 0xf, 0xf, false);
          int v = (lane & 8) ? t1 : t0;
          v += __builtin_amdgcn_update_dpp(0, v, 0x141, 0xf, 0xf, false);
          v += __builtin_amdgcn_update_dpp(0, v, 0x4e, 0xf, 0xf, false);
          v += __builtin_amdgcn_update_dpp(0, v, 0xb1, 0xf, 0xf, false);
          psum = v; }
        const float w = sgL[b * 8 + ((lane >> 3) & 7)] * gelu_fast((float)psum * suL[b * 8 + ((lane >> 3) & 7)]);
#pragma unroll
        for (int r = 0; r < 8; ++r) { const float wr = __builtin_bit_cast(float, __builtin_amdgcn_readlane(__builtin_bit_cast(int, w), r * 8)); float f[16]; fp8x16_to_f32(vcur[r], f);
            const int tk = (kk[r] >> 7) & 3;
#pragma unroll
            for (int j = 0; j < NT; ++j) if (tk == j) {
#pragma unroll
                for (int i = 0; i < 16; ++i) out[j][i] += wr * f[i]; } }
    }
    const float* fg = F.in[17];
#pragma unroll
    for (int j = 0; j < NT; ++j) {
        const int t = tbase + j, bb = t >> 12; const float* g2 = MOD + bb * NMOD + 5 * DM; float* xo = F.out + (size_t)t * DM;
        const bf16* x1r = (const bf16*)(F.ws + WS_X1) + (size_t)t * DM + lane * 16;
        float x2[16]; float ss = 0.f;
#pragma unroll
        for (int hq = 0; hq < 4; ++hq) { const int c = lane * 16 + hq * 4; const v2u xw = *(const v2u*)(x1r + hq * 4); const f32x4 xv = (f32x4){bflo(xw.x), bfhi(xw.x), bflo(xw.y), bfhi(xw.y)}, gv = *(const f32x4*)(g2 + c);
#pragma unroll
            for (int e = 0; e < 4; ++e) { const float y = xv[e] + gv[e] * (out[j][hq * 4 + e] * (1.0f / V_SCALE)); x2[hq * 4 + e] = y; ss += y * y; } }
        const float rinv = 1.0f / sqrtf(wave_sum(ss) * (1.f / DM) + EPS);
#pragma unroll
        for (int hq = 0; hq < 4; ++hq) { const int c = lane * 16 + hq * 4; const f32x4 fv = *(const f32x4*)(fg + c);
            f32x4 y;
#pragma unroll
            for (int e = 0; e < 4; ++e) y[e] = x2[hq * 4 + e] * rinv * fv[e];
            if (!FAKE || rinv == 12345.678f) *(f32x4*)(xo + c) = y; }
    }
}

template <bool FAKE = false> DI void gather_ts(Frame& F, int tbase) {
    constexpr int NT = 4;
    const bf16* H2 = (const bf16*)(F.ws + WS_HX); const unsigned char* U = F.ws + WS_U; const unsigned char* V = F.ws + WS_V;
    const int* EXPERTS = (const int*)(F.ws + WS_EXP); const float* GATES = (const float*)(F.ws + WS_GATE); const float* MOD = (const float*)(F.ws + WS_MOD);
    const float* SU = (const float*)(F.ws + WS_SU);
    const int lane = F.lane; const unsigned ul = (unsigned)F.lane;
    constexpr int EMASK = FAKE ? 7 : 16383;
    int key[NT][2];
#pragma unroll
    for (int j = 0; j < NT; ++j) {
#pragma unroll
        for (int r = 0; r < 2; ++r) { const int k = r * 64 + lane; key[j][r] = (EXPERTS[(size_t)(tbase + j) * 128 + k] << 7) | k; }
#pragma unroll
        for (int k = 2; k <= 128; k <<= 1)
#pragma unroll
            for (int jj = k >> 1; jj > 0; jj >>= 1) {
                if (jj < 2) { const bool asc = (((lane * 2) & k) == 0); const int x = key[j][0], y = key[j][1], lo = min(x, y), hi = max(x, y); key[j][0] = asc ? lo : hi; key[j][1] = asc ? hi : lo; }
                else { const bool asc = (((lane * 2) & k) == 0), lower = ((lane & (jj / 2)) == 0), takemin = (asc == lower);
#pragma unroll
                    for (int r = 0; r < 2; ++r) { const int o = __shfl_xor(key[j][r], jj / 2); key[j][r] = takemin ? min(key[j][r], o) : max(key[j][r], o); } }
            }
    }
    unsigned hsq[NT][4]; float hsc[NT]; float out[NT][16];
#pragma unroll
    for (int j = 0; j < NT; ++j) { const v4u a = *((const v4u*)(H2 + (size_t)(tbase + j) * DM + lane * 16)), b = *((const v4u*)(H2 + (size_t)(tbase + j) * DM + lane * 16 + 8));
        float hv[16]; hv[0] = bflo(a.x); hv[1] = bfhi(a.x); hv[2] = bflo(a.y); hv[3] = bfhi(a.y); hv[4] = bflo(a.z); hv[5] = bfhi(a.z); hv[6] = bflo(a.w); hv[7] = bfhi(a.w);
        hv[8] = bflo(b.x); hv[9] = bfhi(b.x); hv[10] = bflo(b.y); hv[11] = bfhi(b.y); hv[12] = bflo(b.z); hv[13] = bfhi(b.z); hv[14] = bflo(b.w); hv[15] = bfhi(b.w);
        float am = 0.f;
#pragma unroll
        for (int i = 0; i < 16; ++i) am = fmaxf(am, fabsf(hv[i]));
#pragma unroll
        for (int o = 1; o < 64; o <<= 1) am = fmaxf(am, __shfl_xor(am, o));
        am = fmaxf(am, 1e-30f); hsc[j] = am * (1.0f / 127.0f);
        const float inv = 127.0f / am;
#pragma unroll
        for (int d = 0; d < 4; ++d) { const int q0 = (int)rintf(hv[4 * d] * inv), q1 = (int)rintf(hv[4 * d + 1] * inv), q2 = (int)rintf(hv[4 * d + 2] * inv), q3 = (int)rintf(hv[4 * d + 3] * inv);
            hsq[j][d] = (unsigned)(q0 & 255) | ((unsigned)(q1 & 255) << 8) | ((unsigned)(q2 & 255) << 16) | ((unsigned)(q3 & 255) << 24); }
#pragma unroll
        for (int i = 0; i < 16; ++i) out[j][i] = 0.f; }
    LAS float* sgL = (LAS float*)(F.lds + 65536) + F.wave * 1024; LAS float* suL = sgL + 512;
#pragma unroll
    for (int j = 0; j < NT; ++j)
#pragma unroll
        for (int r = 0; r < 2; ++r) { sgL[j * 128 + lane * 2 + r] = GATES[(size_t)(tbase + j) * 128 + (key[j][r] & 127)]; suL[j * 128 + lane * 2 + r] = SU[(key[j][r] >> 7) & EMASK] * hsc[j]; }
    v4u ucur[8];
#pragma unroll
    for (int r = 0; r < 8; ++r) ucur[r] = *((const v4u*)(U + (size_t)((__builtin_amdgcn_readlane(key[0][r & 1], r >> 1) >> 7) & EMASK) * 1024) + ul);
#pragma unroll 1
    for (int b = 0; b < 16; ++b) {
#pragma unroll
        for (int j = 0; j < NT; ++j) {
            v4u vcur[8];
#pragma unroll
            for (int r = 0; r < 8; ++r) vcur[r] = *((const v4u*)(V + (size_t)((__builtin_amdgcn_readlane(key[j][r & 1], b * 4 + (r >> 1)) >> 7) & EMASK) * 1024) + ul);
            int p[8];
#pragma unroll
            for (int r = 0; r < 8; ++r) { int acc = 0;
#pragma unroll
                for (int q = 0; q < 4; ++q) acc = __builtin_amdgcn_sdot4((int)ucur[r][q], (int)hsq[j][q], acc, false);
                p[r] = acc; }
            { const int jn = (j + 1) & 3; const int bn = (j == 3) ? ((b + 1) & 15) : b;
#pragma unroll
              for (int r = 0; r < 8; ++r) ucur[r] = *((const v4u*)(U + (size_t)((__builtin_amdgcn_readlane(key[jn][r & 1], bn * 4 + (r >> 1)) >> 7) & EMASK) * 1024) + ul); }
            int psum;
            { int q4[4];
#pragma unroll
              for (int i = 0; i < 4; ++i) { auto rr = __builtin_amdgcn_permlane32_swap((unsigned)p[i], (unsigned)p[i + 4], false, false); q4[i] = (int)(rr[0] + rr[1]); }
              int q2[2];
#pragma unroll
              for (int i = 0; i < 2; ++i) { auto rr = __builtin_amdgcn_permlane16_swap((unsigned)q4[i], (unsigned)q4[i + 2], false, false); q2[i] = (int)(rr[0] + rr[1]); }
              const int t0 = q2[0] + __builtin_amdgcn_update_dpp(0, q2[0], 0x128, 0xf, 0xf, false);
              const int t1 = q2[1] + __builtin_amdgcn_update_dpp(0, q2[1], 0x128, 0xf, 0xf, false);
              int v = (lane & 8) ? t1 : t0;
              v += __builtin_amdgcn_update_dpp(0, v, 0x141, 0xf, 0xf, false);
              v += __builtin_amdgcn_update_dpp(0, v, 0x4e, 0xf, 0xf, false);
              v += __builtin_amdgcn_update_dpp(0, v, 0xb1, 0xf, 0xf, false);
              psum = v; }
            const int pos = j * 128 + b * 8 + ((lane >> 3) & 7);
            const float w = sgL[pos] * gelu_fast((float)psum * suL[pos]);
#pragma unroll
            for (int r = 0; r < 8; ++r) { const float wr = __builtin_bit_cast(float, __builtin_amdgcn_readlane(__builtin_bit_cast(int, w), r * 8));
#pragma unroll
                for (int q = 0; q < 4; ++q) { const f32x2 lo = __builtin_amdgcn_cvt_pk_f32_fp8((int)vcur[r][q], false), hi = __builtin_amdgcn_cvt_pk_f32_fp8((int)vcur[r][q], true);
                    out[j][4 * q] += wr * lo.x; out[j][4 * q + 1] += wr * lo.y; out[j][4 * q + 2] += wr * hi.x; out[j][4 * q + 3] += wr * hi.y; } }
            __builtin_amdgcn_sched_barrier(0);
        }
    }
    const float* fg = F.in[17];
#pragma unroll
    for (int j = 0; j < NT; ++j) {
        const int t = tbase + j, bb = t >> 12; const float* g2 = MOD + bb * NMOD + 5 * DM; float* xo = F.out + (size_t)t * DM;
        const bf16* x1r = (const bf16*)(F.ws + WS_X1) + (size_t)t * DM + lane * 16;
        float x2[16]; float ss = 0.f;
#pragma unroll
        for (int hq = 0; hq < 4; ++hq) { const int c = lane * 16 + hq * 4; const v2u xw = *(const v2u*)(x1r + hq * 4); const f32x4 xv = (f32x4){bflo(xw.x), bfhi(xw.x), bflo(xw.y), bfhi(xw.y)}, gv = *(const f32x4*)(g2 + c);
#pragma unroll
            for (int e = 0; e < 4; ++e) { const float y = xv[e] + gv[e] * (out[j][hq * 4 + e] * (1.0f / V_SCALE)); x2[hq * 4 + e] = y; ss += y * y; } }
        const float rinv = 1.0f / sqrtf(wave_sum(ss) * (1.f / DM) + EPS);
#pragma unroll
        for (int hq = 0; hq < 4; ++hq) { const int c = lane * 16 + hq * 4; const f32x4 fv = *(const f32x4*)(fg + c);
            f32x4 y;
#pragma unroll
            for (int e = 0; e < 4; ++e) y[e] = x2[hq * 4 + e] * rinv * fv[e];
            if (!FAKE || rinv == 12345.678f) *(f32x4*)(xo + c) = y; }
    }
}

template <bool FAKE = false> DI void gather_ts2(Frame& F, int tbase) {
    constexpr int NT = 2;
    const bf16* H2 = (const bf16*)(F.ws + WS_HX); const unsigned char* U = F.ws + WS_U; const unsigned char* V = F.ws + WS_V;
    const int* EXPERTS = (const int*)(F.ws + WS_EXP); const float* GATES = (const float*)(F.ws + WS_GATE); const float* MOD = (const float*)(F.ws + WS_MOD);
    const float* SU = (const float*)(F.ws + WS_SU);
    int lane = F.lane; asm volatile("" : "+v"(lane));
    const unsigned ul = (unsigned)lane;
    constexpr int EMASK = FAKE ? 7 : 16383;
    int key[NT][2];
#pragma unroll
    for (int j = 0; j < NT; ++j) {
#pragma unroll
        for (int r = 0; r < 2; ++r) { const int k = r * 64 + lane; key[j][r] = (EXPERTS[(size_t)(tbase + j) * 128 + k] << 7) | k; }
#pragma unroll
        for (int k = 2; k <= 128; k <<= 1)
#pragma unroll
            for (int jj = k >> 1; jj > 0; jj >>= 1) {
                if (jj < 2) { const bool asc = (((lane * 2) & k) == 0); const int x = key[j][0], y = key[j][1], lo = min(x, y), hi = max(x, y); key[j][0] = asc ? lo : hi; key[j][1] = asc ? hi : lo; }
                else { const bool asc = (((lane * 2) & k) == 0), lower = ((lane & (jj / 2)) == 0), takemin = (asc == lower);
#pragma unroll
                    for (int r = 0; r < 2; ++r) { const int o = __shfl_xor(key[j][r], jj / 2); key[j][r] = takemin ? min(key[j][r], o) : max(key[j][r], o); } }
            }
    }
    unsigned hsq[NT][4]; float hsc[NT]; float out[NT][16];
#pragma unroll
    for (int j = 0; j < NT; ++j) { const v4u a = *((const v4u*)(H2 + (size_t)(tbase + j) * DM + lane * 16)), b = *((const v4u*)(H2 + (size_t)(tbase + j) * DM + lane * 16 + 8));
        float hv[16]; hv[0] = bflo(a.x); hv[1] = bfhi(a.x); hv[2] = bflo(a.y); hv[3] = bfhi(a.y); hv[4] = bflo(a.z); hv[5] = bfhi(a.z); hv[6] = bflo(a.w); hv[7] = bfhi(a.w);
        hv[8] = bflo(b.x); hv[9] = bfhi(b.x); hv[10] = bflo(b.y); hv[11] = bfhi(b.y); hv[12] = bflo(b.z); hv[13] = bfhi(b.z); hv[14] = bflo(b.w); hv[15] = bfhi(b.w);
        float am = 0.f;
#pragma unroll
        for (int i = 0; i < 16; ++i) am = fmaxf(am, fabsf(hv[i]));
#pragma unroll
        for (int o = 1; o < 64; o <<= 1) am = fmaxf(am, __shfl_xor(am, o));
        am = fmaxf(am, 1e-30f); hsc[j] = am * (1.0f / 127.0f);
        const float inv = 127.0f / am;
#pragma unroll
        for (int d = 0; d < 4; ++d) { const int q0 = (int)rintf(hv[4 * d] * inv), q1 = (int)rintf(hv[4 * d + 1] * inv), q2 = (int)rintf(hv[4 * d + 2] * inv), q3 = (int)rintf(hv[4 * d + 3] * inv);
            hsq[j][d] = (unsigned)(q0 & 255) | ((unsigned)(q1 & 255) << 8) | ((unsigned)(q2 & 255) << 16) | ((unsigned)(q3 & 255) << 24); }
#pragma unroll
        for (int i = 0; i < 16; ++i) out[j][i] = 0.f; }
    LAS float* sgL = (LAS float*)(F.lds + 65536) + F.wave * 512; LAS float* suL = sgL + 256;
#pragma unroll
    for (int j = 0; j < NT; ++j)
#pragma unroll
        for (int r = 0; r < 2; ++r) { sgL[j * 128 + lane * 2 + r] = GATES[(size_t)(tbase + j) * 128 + (key[j][r] & 127)]; suL[j * 128 + lane * 2 + r] = SU[(key[j][r] >> 7) & EMASK] * hsc[j]; }
#define TS2_ROW(TBL, jj, bb, r) (*(const v4u*)((TBL) + (size_t)((__builtin_amdgcn_readlane(key[jj][(r) & 1], (bb) * 4 + ((r) >> 1)) >> 7) & EMASK) * 1024 + voff))
    unsigned voff = ul * 16u;
    v4u ub[NT][8], vb[8];
#pragma unroll
    for (int r = 0; r < 8; ++r) { ub[0][r] = TS2_ROW(U, 0, 0, r); ub[1][r] = TS2_ROW(U, 1, 0, r); vb[r] = TS2_ROW(V, 0, 0, r); }
#pragma unroll 1
    for (int b = 0; b < 16; ++b) {
        const int bn = (b + 1) & 15;
#pragma unroll
        for (int j = 0; j < NT; ++j) {
            asm volatile("" : "+v"(voff));
            int p[8];
#pragma unroll
            for (int r = 0; r < 8; ++r) { int acc = 0;
#pragma unroll
                for (int q = 0; q < 4; ++q) acc = __builtin_amdgcn_sdot4((int)ub[j][r][q], (int)hsq[j][q], acc, false);
                p[r] = acc; }
#pragma unroll
            for (int r = 0; r < 8; ++r) ub[j][r] = TS2_ROW(U, j, bn, r);
            int psum;
            { int q4[4];
#pragma unroll
              for (int i = 0; i < 4; ++i) { auto rr = __builtin_amdgcn_permlane32_swap((unsigned)p[i], (unsigned)p[i + 4], false, false); q4[i] = (int)(rr[0] + rr[1]); }
              int q2[2];
#pragma unroll
              for (int i = 0; i < 2; ++i) { auto rr = __builtin_amdgcn_permlane16_swap((unsigned)q4[i], (unsigned)q4[i + 2], false, false); q2[i] = (int)(rr[0] + rr[1]); }
              const int t0 = q2[0] + __builtin_amdgcn_update_dpp(0, q2[0], 0x128, 0xf, 0xf, false);
              const int t1 = q2[1] + __builtin_amdgcn_update_dpp(0, q2[1], 0x128, 0xf, 0xf, false);
              int v = (lane & 8) ? t1 : t0;
              v += __builtin_amdgcn_update_dpp(0, v, 0x141, 0xf, 0xf, false);
              v += __builtin_amdgcn_update_dpp(0, v, 0x4e, 0xf, 0xf, false);
              v += __builtin_amdgcn_update_dpp(0, v, 0xb1, 0xf, 0xf, false);
              psum = v; }
            const int pos = j * 128 + b * 8 + ((lane >> 3) & 7);
            const float w = sgL[pos] * gelu_fast((float)psum * suL[pos]);
#pragma unroll
            for (int r = 0; r < 8; ++r) { const float wr = __builtin_bit_cast(float, __builtin_amdgcn_readlane(__builtin_bit_cast(int, w), r * 8));
#pragma unroll
                for (int q = 0; q < 4; ++q) { const f32x2 lo = __builtin_amdgcn_cvt_pk_f32_fp8((int)vb[r][q], false), hi = __builtin_amdgcn_cvt_pk_f32_fp8((int)vb[r][q], true);
                    out[j][4 * q] += wr * lo.x; out[j][4 * q + 1] += wr * lo.y; out[j][4 * q + 2] += wr * hi.x; out[j][4 * q + 3] += wr * hi.y; }
                vb[r] = TS2_ROW(V, j ^ 1, (j == 0) ? b : bn, r); }
            __builtin_amdgcn_sched_barrier(0);
        }
    }
#undef TS2_ROW
    const float* fg = F.in[17];
#pragma unroll
    for (int j = 0; j < NT; ++j) {
        const int t = tbase + j, bb = t >> 12; const float* g2 = MOD + bb * NMOD + 5 * DM; float* xo = F.out + (size_t)t * DM;
        const bf16* x1r = (const bf16*)(F.ws + WS_X1) + (size_t)t * DM + lane * 16;
        float x2[16]; float ss = 0.f;
#pragma unroll
        for (int hq = 0; hq < 4; ++hq) { const int c = lane * 16 + hq * 4; const v2u xw = *(const v2u*)(x1r + hq * 4); const f32x4 xv = (f32x4){bflo(xw.x), bfhi(xw.x), bflo(xw.y), bfhi(xw.y)}, gv = *(const f32x4*)(g2 + c);
#pragma unroll
            for (int e = 0; e < 4; ++e) { const float y = xv[e] + gv[e] * (out[j][hq * 4 + e] * (1.0f / V_SCALE)); x2[hq * 4 + e] = y; ss += y * y; } }
        const float rinv = 1.0f / sqrtf(wave_sum(ss) * (1.f / DM) + EPS);
#pragma unroll
        for (int hq = 0; hq < 4; ++hq) { const int c = lane * 16 + hq * 4; const f32x4 fv = *(const f32x4*)(fg + c);
            f32x4 y;
#pragma unroll
            for (int e = 0; e < 4; ++e) y[e] = x2[hq * 4 + e] * rinv * fv[e];
            if (!FAKE || rinv == 12345.678f) *(f32x4*)(xo + c) = y; }
    }
}

#ifdef MB_OP
DI void mb_probe(Frame& F) {
    unsigned x[32];
#pragma unroll
    for (int i = 0; i < 32; ++i) x[i] = F.lane * 2654435761u + i * 40503u + 0x3f800000u;
    const unsigned kc = 0x3c003c00u + F.wave;
#pragma unroll 1
    for (int it = 0; it < MB_ITERS; ++it) {
#pragma unroll
        for (int i = 0; i < 32; ++i) {
#if MB_OP == 0
            asm volatile("v_fmac_f32 %0, %1, %2" : "+v"(x[i]) : "v"(kc), "v"(x[(i + 1) & 31]));
#elif MB_OP == 1
            asm volatile("v_pk_fma_f32 %0, %1, %2, %0" : "+v"(*(unsigned long long*)&x[i & 30]) : "v"(*(unsigned long long*)&x[(i + 2) & 30]), "v"(*(unsigned long long*)&x[(i + 4) & 30]));
#elif MB_OP == 2
            asm volatile("v_cvt_pk_f32_fp8 %0, %1" : "=v"(*(unsigned long long*)&x[i & 30]) : "v"(x[(i + 3) & 31]));
#elif MB_OP == 3
            asm volatile("v_cvt_scalef32_pk_bf16_fp8 %0, %1, 1.0" : "=v"(x[i]) : "v"(x[(i + 3) & 31]));
#elif MB_OP == 4
            asm volatile("v_dot2c_f32_bf16 %0, %1, %2" : "+v"(x[i]) : "v"(kc), "v"(x[(i + 1) & 31]));
#elif MB_OP == 5
            asm volatile("v_dot4_i32_i8 %0, %1, %2, %0" : "+v"(x[i]) : "v"(kc), "v"(x[(i + 1) & 31]));
#elif MB_OP == 6
            asm volatile("v_perm_b32 %0, %1, %2, %3" : "=v"(x[i]) : "v"(x[(i + 1) & 31]), "v"(x[(i + 2) & 31]), "v"(kc));
#elif MB_OP == 7
            asm volatile("v_cvt_f32_ubyte1 %0, %1" : "=v"(x[i]) : "v"(x[(i + 3) & 31]));
#endif
        }
    }
    unsigned acc = 0;
#pragma unroll
    for (int i = 0; i < 32; ++i) acc ^= x[i];
    if (acc == 0x12345u) *(volatile unsigned*)(F.ws + WS_CTL + 32768) = acc;
}
#endif
struct Args { const float* in[18]; float* out; unsigned char* ws; int ph_lo, ph_hi, li, pad; };
__global__ void __launch_bounds__(NWAVES * 64, 2) mk_fwd(Args args) {
    extern __shared__ __attribute__((aligned(16))) unsigned char lds[];
    Frame F;
    F.lds = (LAS unsigned char*)lds;
    F.tid = threadIdx.x; F.lane = F.tid & 63; F.wave = __builtin_amdgcn_readfirstlane(F.tid >> 6);
    F.G = gridDim.x; { const int bx = blockIdx.x; F.vcu = (F.G % 8 == 0) ? (bx % 8) * (F.G / 8) + bx / 8 : bx; }
    F.gw = F.vcu * NWAVES + F.wave; F.NGW = F.G * NWAVES;
#pragma unroll
    for (int i = 0; i < 18; ++i) F.in[i] = args.in[i];
    F.out = args.out; F.ws = args.ws;
    volatile LAS unsigned* MISC = (volatile LAS unsigned*)(F.lds + MISC_OFF);
    for (int u = F.tid; u < (LDS_BYTES - LDSCTL_OFF) / 4; u += NWAVES * 64) ((LAS unsigned*)(F.lds + LDSCTL_OFF))[u] = 0u;
    __syncthreads();
    gu32* ctl = (gu32*)(F.ws + WS_CTL);
    XcdBarrier bar; bar.bar = (unsigned*)(ctl + CW_BAR) + args.li * XCD_BAR_WORDS; bar.x = 0; bar.st = nullptr;
    const int lo = args.ph_lo, hi = args.ph_hi;
    if (hi - lo > 1) bar = xcd_barrier_post((unsigned*)(ctl + CW_BAR) + args.li * XCD_BAR_WORDS, MISC + 8);
#ifndef PROBE_MASK
#define PROBE_MASK 0
#endif
#define REP(k) for (int rep_ = 0; rep_ < 1 + ((PROBE_MASK >> (k)) & 1); ++rep_)
#define IN(k) (lo <= (k) && (k) < hi)
#ifndef PROBE_SEAMS
#define PROBE_SEAMS 1
#endif
#define SEAM(k) do { if (IN(k) && IN((k) + 1)) for (int s_ = 0; s_ < PROBE_SEAMS; ++s_) xcd_barrier(bar); } while (0)

#ifndef SKIP0
    if (IN(0)) { REP(0) { p0_prologue(F); __syncthreads(); } SEAM(0); }
#endif
#ifdef MB_OP
    if (IN(1)) mb_probe(F);
#endif
    if (IN(1)) { REP(1) norm_rows<false>(F, F.in[0], F.in[2], MROWS, F.in[6], 0, DM, (bf16*)(F.ws + WS_HX)); SEAM(1); }
    if (IN(2)) {
        pg8::Gemm g{(const bf16*)(F.ws + WS_HX), (const bf16*)(F.ws + WS_WIN), MROWS, DIN, DM}; pg8::InProjOrder S; S.init(F.G, (int)blockIdx.x);
        pg8::EpiInProj E{(bf16*)(F.ws + WS_PB), (bf16*)(F.ws + WS_QF), (bf16*)(F.ws + WS_KF), (bf16*)(F.ws + WS_VF)};
        REP(2) pg8::gemm_phase<pg8::EpiInProj, pg8::InProjOrder, true, true>(F.lds + RING_OFF, g, S, E);
        SEAM(2);
    }
    if (IN(3)) {
#ifndef SKIP3A
#ifdef ATT_NAIVE
 attn_naive(F);
#else
 REP(3) attn_mfma(F);
#endif
#endif
#ifndef SKIP3B
#ifdef POOL_NAIVE
 pool_naive(F);
#else
 REP(9) pool_mfma(F);
#endif
#endif
 SEAM(3); }
    if (IN(4)) {
        pg8::Gemm g{(const bf16*)(F.ws + WS_MIX), (const bf16*)(F.ws + WS_WOUT), NTOK, DM, DM}; pg8::StaticOrder S; S.init(NTOK, DM, F.G, (int)blockIdx.x);
        pg8::EpiX1 E{F.in[0], (const float*)(F.ws + WS_MOD), (bf16*)(F.ws + WS_X1)};
        REP(4) pg8::gemm_phase<pg8::EpiX1, pg8::StaticOrder, true, true>(F.lds + RING_OFF, g, S, E);
        SEAM(4);
    }
    if (IN(5)) { REP(5) norm_rows<true>(F, (const float*)(F.ws + WS_X1), nullptr, NTOK, F.in[12], 3 * DM, 4 * DM, (bf16*)(F.ws + WS_HX)); SEAM(5); }
    if (IN(6)) {
        pg8::Gemm g{(const bf16*)(F.ws + WS_HX), (const bf16*)(F.ws + WS_WQ), NTOK, 2048, DM}; pg8::StaticOrder S; S.init(NTOK, 2048, F.G, (int)blockIdx.x);
#ifdef TOPK_NAIVE
        pg8::EpiBf16 E{(bf16*)(F.ws + WS_ZX), 2048};
        pg8::gemm_phase<pg8::EpiBf16, pg8::StaticOrder, true, true>(F.lds + RING_OFF, g, S, E);
#else
        pg8::EpiQP E{(bf16*)(F.ws + WS_ZX)};
        REP(6) pg8::gemm_phase<pg8::EpiQP, pg8::StaticOrder, true, true>(F.lds + RING_OFF, g, S, E);
#endif
        SEAM(6);
    }
    if (IN(7)) {
        for (int tile = F.vcu; tile < NTOK / 128; tile += F.G) {
            const int tok0 = tile * 128;
#ifndef SKIP7A
#ifdef TOPK_NAIVE
            peer_topk_naive(F, tok0);
#else
            REP(7) peer_topk_mfma(F, tile);
#endif
#endif
#ifndef SKIP7B
#ifdef GATHER_V2
            { volatile LAS int* prog = (volatile LAS int*)(F.lds + 98304);
              if ((PROBE_MASK >> 8) & 1) for (int rd = 0; rd < 4; ++rd) gather_round<4, true>(F, tok0 + rd * 32 + F.wave * 4, prog + F.wave, rd * 16384);
              if ((PROBE_MASK >> 10) & 1) for (int rd = 0; rd < 4; ++rd) gather_round<4>(F, tok0 + rd * 32 + F.wave * 4, prog + F.wave, rd * 16384);
              for (int rd = 0; rd < 4; ++rd) gather_round<4>(F, tok0 + rd * 32 + F.wave * 4, prog + F.wave, rd * 16384); }
#else
#ifdef GATHER_TS4
            if ((PROBE_MASK >> 8) & 1) for (int rd = 0; rd < 4; ++rd) gather_ts<true>(F, tok0 + rd * 32 + F.wave * 4);
            for (int rd = 0; rd < 4; ++rd) gather_ts<false>(F, tok0 + rd * 32 + F.wave * 4);
#else
            if ((PROBE_MASK >> 8) & 1) for (int rd = 0; rd < 8; ++rd) gather_ts2<true>(F, tok0 + rd * 16 + F.wave * 2);
            for (int rd = 0; rd < 8; ++rd) gather_ts2<false>(F, tok0 + rd * 16 + F.wave * 2);
#endif
#endif
#endif
        }
    }
#undef IN
#undef SEAM
}

extern "C" void kernel_launch(void* const* d_in, const int* in_sizes, int n_in, void* d_out, int out_size, void* d_ws, size_t ws_size, hipStream_t stream) {
    static int grid = 0;
    if (grid == 0) {
        if (n_in != 18 || in_sizes[0] != NTOK * DM || out_size != NTOK * DM || ws_size < WS_END) { fprintf(stderr, "kernel_launch: unexpected shapes / workspace (n_in %d, ws %zu); nothing launched\n", n_in, ws_size); grid = -1; return; }
        int dev = 0, cus = 0;
        if (hipGetDevice(&dev) != hipSuccess || hipDeviceGetAttribute(&cus, hipDeviceAttributeMultiprocessorCount, dev) != hipSuccess) { grid = -1; return; }
        if (hipFuncSetAttribute((const void*)mk_fwd, hipFuncAttributeMaxDynamicSharedMemorySize, LDS_BYTES) != hipSuccess) { fprintf(stderr, "kernel_launch: hipFuncSetAttribute failed\n"); grid = -1; return; }
        int per_cu = 0;
        if (hipOccupancyMaxActiveBlocksPerMultiprocessor(&per_cu, (const void*)mk_fwd, NWAVES * 64, LDS_BYTES) != hipSuccess || per_cu < 1) fprintf(stderr, "kernel_launch: note: occupancy query reports %d blocks per CU\n", per_cu);
        (void)hipGetLastError();
        grid = cus;
    }
    if (grid < 0) return;
    (void)hipMemsetAsync((char*)d_ws + WS_CTL, 0, CTL_ZERO_BYTES, stream);
    Args a{};
    for (int i = 0; i < 18; ++i) a.in[i] = (const float*)d_in[i];
    a.out = (float*)d_out; a.ws = (unsigned char*)d_ws;
    for (int li = 0; li < N_LAUNCHES; ++li) {
        if (N_LAUNCHES == 1) { a.ph_lo = 0; a.ph_hi = NPHASE; } else { a.ph_lo = li; a.ph_hi = li + 1; }
        a.li = (N_LAUNCHES == 1) ? 0 : 0;
        hipLaunchKernelGGL(mk_fwd, dim3(grid), dim3(NWAVES * 64), LDS_BYTES, stream, a);
    }
}
```

```cpp
#include <hip/hip_runtime.h>
#include <cstdio>
#include <cstdint>
#include <type_traits>
namespace pg8 {
#define PG8_LAS __attribute__((address_space(3)))
typedef unsigned short bf16_t;
typedef short bf16x8 __attribute__((ext_vector_type(8)));
typedef float f32x4 __attribute__((ext_vector_type(4)));
typedef unsigned u32x4 __attribute__((ext_vector_type(4)));
constexpr int BM = 256, BK = 64, HALF = 128, HTB = HALF * BK * 2  , STAGE_BYTES = 8 * HTB, NXCD = 8, WGM = 8;

__host__ __device__ __forceinline__ int lds_byte(int r, int c) { const int st = (r >> 4) * 2 + (c >> 5), rr = r & 15, cc = c & 31, ob = rr * 64 + cc * 2; return st * 1024 + (ob ^ (((ob >> 9) & 1) << 5)); }
__host__ __device__ __forceinline__ void stage_rc(int b, int& R, int& C) { const int st = b / 1024, sb = b % 1024, swz = sb ^ (((sb >> 9) & 1) << 5); R = (st >> 1) * 16 + swz / 64; C = (st & 1) * 32 + (swz % 64) / 2; }
__host__ __device__ __forceinline__ int perm32(int rho) { const int n = rho >> 4, i = rho & 15; return 8 * (i >> 2) + 4 * n + (i & 3); }

struct Unit { int pm, pn; };
struct Gemm { const bf16_t* A; const bf16_t* Bt; int M, N, K; };
struct StaticOrder {
    int nM, nN, nwg, G, c;
    __host__ __device__ void init(int M, int N, int G_, int c_) { nM = M / BM; nN = N / BM; nwg = nM * nN; G = G_; c = c_; }
    __host__ __device__ bool next(int i, Unit& u) const {
        const long L = (long)i * G + c; if (L >= nwg) return false;
        int wgid = (int)L; { const int q = nwg / NXCD, r = nwg % NXCD, xcd = wgid % NXCD, off = wgid / NXCD; wgid = (xcd < r ? xcd * (q + 1) : r * (q + 1) + (xcd - r) * q) + off; }
        const int nig = WGM * nN, gid = wgid / nig, fm = gid * WGM, gsz = (nM - fm) < WGM ? (nM - fm) : WGM;
        u.pm = fm + ((wgid % nig) % gsz); u.pn = (wgid % nig) / gsz; return true;
    }
    __device__ __forceinline__ void a_ready(const Unit&) const {}
    __device__ __forceinline__ void done(const Unit&) const {}
    __device__ __forceinline__ const char* pa(const Gemm& g, const Unit& u) const { return (const char*)g.A + (size_t)u.pm * ((size_t)BM * g.K * 2); }
    __device__ __forceinline__ const char* pb(const Gemm& g, const Unit& u) const { return (const char*)g.Bt + (size_t)u.pn * ((size_t)BM * g.K * 2); }
};
struct InProjOrder {
    StaticOrder so;
    __host__ __device__ void init(int G_, int c_) { so.init(136 * BM, 8 * BM, G_, c_); }
    __host__ __device__ bool next(int i, Unit& u) const { int cnt = -1; for (int j = 0; ; ++j) { if (!so.next(j, u)) return false; if (!(u.pm >= 128 && u.pn < 4)) { if (++cnt == i) return true; } } }
    __device__ __forceinline__ void a_ready(const Unit&) const {}
    __device__ __forceinline__ void done(const Unit&) const {}
    __device__ __forceinline__ const char* pa(const Gemm& g, const Unit& u) const { return u.pn < 6 ? (const char*)g.A + (size_t)u.pm * ((size_t)BM * g.K * 2) : (const char*)g.Bt + (size_t)u.pn * ((size_t)BM * g.K * 2); }
    __device__ __forceinline__ const char* pb(const Gemm& g, const Unit& u) const { return u.pn < 6 ? (const char*)g.Bt + (size_t)u.pn * ((size_t)BM * g.K * 2) : (const char*)g.A + (size_t)u.pm * ((size_t)BM * g.K * 2); }
};

__device__ __forceinline__ unsigned cvt_pk_bf16(float lo, float hi) { unsigned r; asm volatile("v_cvt_pk_bf16_f32 %0, %1, %2" : "=v"(r) : "v"(lo), "v"(hi)); return r; }
struct EpiBf16 {
    static constexpr bool PERM = true, AFTER_DRAIN = false;
    bf16_t* O; int ldc;
    __device__ __forceinline__ void operator()(const f32x4 (&acc)[2][2][4][2], const Unit& u, int wr, int wc, int fr, int fq) const {
        const int row0 = u.pm * BM + wr * 64 + fr, col0 = u.pn * BM + wc * 32 + 8 * fq;
#pragma unroll
        for (int ai = 0; ai < 2; ++ai)
#pragma unroll
            for (int m = 0; m < 4; ++m) { bf16_t* rowp = O + (size_t)(row0 + ai * HALF + m * 16) * ldc + col0;
#pragma unroll
                for (int bj = 0; bj < 2; ++bj) { const f32x4 v0 = acc[ai][bj][m][0], v1 = acc[ai][bj][m][1];
                    u32x4 w; w.x = cvt_pk_bf16(v0[0], v0[1]); w.y = cvt_pk_bf16(v0[2], v0[3]); w.z = cvt_pk_bf16(v1[0], v1[1]); w.w = cvt_pk_bf16(v1[2], v1[3]);
                    *(u32x4*)(rowp + bj * HALF) = w; } }
    }
};
struct EpiX1 {
    static constexpr bool PERM = true, AFTER_DRAIN = false;
    const float* x; const float* mod; bf16_t* out;
    __device__ __forceinline__ void operator()(const f32x4 (&acc)[2][2][4][2], const Unit& u, int wr, int wc, int fr, int fq) const {
        const int row0 = u.pm * BM + wr * 64 + fr, col0 = u.pn * BM + wc * 32 + 8 * fq;
        const float* g1 = mod + (size_t)((u.pm * BM) >> 12) * 6144 + 2048 + col0;
        f32x4 gv[2][2];
#pragma unroll
        for (int bj = 0; bj < 2; ++bj)
#pragma unroll
            for (int n = 0; n < 2; ++n) gv[bj][n] = *(const f32x4*)(g1 + bj * HALF + 4 * n);
#pragma unroll
        for (int ai = 0; ai < 2; ++ai)
#pragma unroll
            for (int m = 0; m < 4; ++m) { const size_t off = (size_t)(row0 + ai * HALF + m * 16) * 1024 + col0;
#pragma unroll
                for (int bj = 0; bj < 2; ++bj) { const f32x4 x0 = *(const f32x4*)(x + off + bj * HALF), x1 = *(const f32x4*)(x + off + bj * HALF + 4);
                    const f32x4 v0 = x0 + gv[bj][0] * acc[ai][bj][m][0], v1 = x1 + gv[bj][1] * acc[ai][bj][m][1];
                    u32x4 w; w.x = cvt_pk_bf16(v0[0], v0[1]); w.y = cvt_pk_bf16(v0[2], v0[3]); w.z = cvt_pk_bf16(v1[0], v1[1]); w.w = cvt_pk_bf16(v1[2], v1[3]);
                    *(u32x4*)(out + off + bj * HALF) = w; } }
    }
};


struct EpiInProj {
    static constexpr bool PERM = true, AFTER_DRAIN = false;
    bf16_t *PB, *QF, *KF, *VF;
    __device__ __forceinline__ void operator()(const f32x4 (&acc)[2][2][4][2], const Unit& u, int wr, int wc, int fr, int fq) const {
        if (u.pn < 6) {
            const int sec = u.pn >> 1, cbase = (u.pn & 1) * 256 + wc * 32 + 8 * fq;
#pragma unroll
            for (int ai = 0; ai < 2; ++ai)
#pragma unroll
                for (int m = 0; m < 4; ++m) { const int T = u.pm * BM + ai * HALF + wr * 64 + m * 16 + fr;
                    int bb, blk; if (T < 32768) { bb = T >> 12; blk = (T & 4095) >> 5; } else { const int cc = T - 32768; bb = cc >> 8; blk = 128 + ((cc & 255) >> 5); }
                    const int tl = T & 31;
#pragma unroll
                    for (int bj = 0; bj < 2; ++bj) { const int c = cbase + HALF * bj; const f32x4 v0 = acc[ai][bj][m][0], v1 = acc[ai][bj][m][1];
                        u32x4 w; w.x = cvt_pk_bf16(v0[0], v0[1]); w.y = cvt_pk_bf16(v0[2], v0[3]); w.z = cvt_pk_bf16(v1[0], v1[1]); w.w = cvt_pk_bf16(v1[2], v1[3]);
                        if (sec == 0) *(u32x4*)(PB + (size_t)T * 512 + c) = w;
                        else { const int h = c >> 6, d0 = c & 63, fo = ((d0 >> 4) * 64 + ((d0 >> 3) & 1) * 32 + tl) * 8;
                            bf16_t* dst = (sec == 1) ? QF + (size_t)((bb * 8 + h) * 128 + blk) * 2048 + fo : KF + (size_t)((bb * 8 + h) * 136 + blk) * 2048 + fo;
                            *(u32x4*)dst = w; } } }
        } else {
            typedef unsigned u32x2 __attribute__((ext_vector_type(2)));
#pragma unroll
            for (int ai = 0; ai < 2; ++ai)
#pragma unroll
                for (int m = 0; m < 4; ++m) { const int vc = (u.pn - 6) * BM + ai * HALF + wr * 64 + m * 16 + fr, h = vc >> 6, dt = (vc >> 5) & 1, dl = vc & 31;
#pragma unroll
                    for (int bj = 0; bj < 2; ++bj) { const int T0 = u.pm * BM + bj * HALF + wc * 32 + 8 * fq;
                        int bb, blk; if (T0 < 32768) { bb = T0 >> 12; blk = (T0 & 4095) >> 5; } else { const int cc = T0 - 32768; bb = cc >> 8; blk = 128 + ((cc & 255) >> 5); }
                        bf16_t* base = VF + ((size_t)(((bb * 8 + h) * 136 + blk) * 2 + dt) * 2 + (fq >> 1)) * 512 + 4 * (fq & 1);
                        const f32x4 v0 = acc[ai][bj][m][0], v1 = acc[ai][bj][m][1];
                        u32x2 w0, w1; w0.x = cvt_pk_bf16(v0[0], v0[1]); w0.y = cvt_pk_bf16(v0[2], v0[3]); w1.x = cvt_pk_bf16(v1[0], v1[1]); w1.y = cvt_pk_bf16(v1[2], v1[3]);
                        *(u32x2*)(base + dl * 8) = w0; *(u32x2*)(base + (32 + dl) * 8) = w1; } }
        }
    }
};

struct EpiQP {
    static constexpr bool PERM = true, AFTER_DRAIN = false;
    bf16_t* QP;
    __device__ __forceinline__ void operator()(const f32x4 (&acc)[2][2][4][2], const Unit& u, int wr, int wc, int fr, int fq) const {
#pragma unroll
        for (int ai = 0; ai < 2; ++ai)
#pragma unroll
            for (int m = 0; m < 4; ++m) { const int T = u.pm * BM + ai * HALF + wr * 64 + m * 16 + fr;
#pragma unroll
                for (int bj = 0; bj < 2; ++bj) { const int hp = 2 * u.pn + bj, ks = 2 * wc + (fq >> 1), hh = fq & 1;
                    const f32x4 v0 = acc[ai][bj][m][0], v1 = acc[ai][bj][m][1];
                    u32x4 w; w.x = cvt_pk_bf16(v0[0], v0[1]); w.y = cvt_pk_bf16(v0[2], v0[3]); w.z = cvt_pk_bf16(v1[0], v1[1]); w.w = cvt_pk_bf16(v1[2], v1[3]);
                    *(u32x4*)(QP + ((size_t)(T >> 5) * 16 + hp) * 4096 + (ks * 64 + hh * 32 + (T & 31)) * 8) = w; } }
    }
};
template <class Epi, class Sched, bool ALIGN_EPI = false, bool SP2 = false>
__device__ __forceinline__ void gemm_phase(PG8_LAS unsigned char* lds, const Gemm g, const Sched& S, const Epi& E) {
    const int tid = threadIdx.x, wid = __builtin_amdgcn_readfirstlane(tid >> 6), lane = tid & 63, wr = wid >> 2, wc = wid & 3, fr = lane & 15, fq = lane >> 4;
    const int K = g.K, nt = K / BK;
    unsigned voffA[2], voffB[2];
#pragma unroll
    for (int i = 0; i < 2; ++i) { int R, C; stage_rc(tid * 16 + i * 8192, R, C); const int Rb = Epi::PERM ? ((R & ~31) + perm32(R & 31)) : R;
        voffA[i] = (unsigned)(R * K + C) * 2u; voffB[i] = (unsigned)(Rb * K + C) * 2u; }
    const size_t kstep = (size_t)(BK * 2);
    const size_t hstep = (size_t)HALF * K * 2;
    const size_t tstep = 2 * hstep;
    const unsigned ldsw = (unsigned)wid * 1024u;
    const int aoff = lds_byte(wr * 64 + fr, fq * 8), boff = lds_byte(wc * 32 + fr, fq * 8);
#define PG8_SA(b, h) (((b) * 2 + (h)) * HTB)
#define PG8_SB(b, h) ((4 + (b) * 2 + (h)) * HTB)
#define PG8_STAGE(bufoff, gbase, voff) do { _Pragma("unroll") for (int _i = 0; _i < 2; ++_i) \
        __builtin_amdgcn_global_load_lds((const unsigned*)((const char*)(gbase) + (voff)[_i]), (PG8_LAS unsigned*)(lds + (bufoff) + ldsw + _i * 8192), 16, 0, 0); } while (0)
#define PG8_LDA(dst, b, h) do { _Pragma("unroll") for (int m = 0; m < 4; ++m) _Pragma("unroll") for (int k = 0; k < 2; ++k) dst[m][k] = *(const PG8_LAS bf16x8*)(lds + PG8_SA(b, h) + aoff + m * 2048 + k * 1024); } while (0)
#define PG8_LDB(dst, b, h) do { _Pragma("unroll") for (int n = 0; n < 2; ++n) _Pragma("unroll") for (int k = 0; k < 2; ++k) dst[n][k] = *(const PG8_LAS bf16x8*)(lds + PG8_SB(b, h) + boff + n * 2048 + k * 1024); } while (0)
#define PG8_MMA(ai, bj, At, Bt) do { __builtin_amdgcn_s_setprio(1); _Pragma("unroll") for (int m = 0; m < 4; ++m) _Pragma("unroll") for (int n = 0; n < 2; ++n) _Pragma("unroll") for (int k = 0; k < 2; ++k) \
        acc[ai][bj][m][n] = __builtin_amdgcn_mfma_f32_16x16x32_bf16(Bt[n][k], At[m][k], acc[ai][bj][m][n], 0, 0, 0); __builtin_amdgcn_s_setprio(0); } while (0)
#define PG8_WAIT_V(n) asm volatile("s_waitcnt vmcnt(" #n ")" ::: "memory")
#define PG8_WAIT_L(n) asm volatile("s_waitcnt lgkmcnt(" #n ")" ::: "memory")
#define PG8_BAR __builtin_amdgcn_s_barrier()
#define PG8_SCHED __builtin_amdgcn_sched_barrier(0)
    Unit cur, nxt; int ui = 0;
    if (!S.next(0, cur)) return;
    f32x4 acc[2][2][4][2];
#pragma unroll
    for (int a = 0; a < 2; ++a)
#pragma unroll
        for (int b = 0; b < 2; ++b)
#pragma unroll
            for (int m = 0; m < 4; ++m)
#pragma unroll
                for (int n = 0; n < 2; ++n) acc[a][b][m][n] = (f32x4){0.f, 0.f, 0.f, 0.f};
    bf16x8 At[4][2], B0[2][2], B1[2][2];
    const char* cA = S.pa(g, cur); const char* cB = S.pb(g, cur);
    S.a_ready(cur);
    if constexpr (SP2) {
        PG8_STAGE(PG8_SB(0, 0), cB, voffB); PG8_STAGE(PG8_SB(0, 1), cB + hstep, voffB); PG8_STAGE(PG8_SA(0, 0), cA, voffA); PG8_STAGE(PG8_SA(0, 1), cA + hstep, voffA);
        if (wr == 1) PG8_BAR;
        PG8_WAIT_V(2); PG8_BAR;
        PG8_STAGE(PG8_SB(1, 0), cB + kstep, voffB); PG8_STAGE(PG8_SA(1, 0), cA + kstep, voffA); PG8_STAGE(PG8_SB(1, 1), cB + hstep + kstep, voffB);
        PG8_WAIT_V(6); PG8_BAR;
    } else {
        PG8_STAGE(PG8_SB(0, 0), cB, voffB); PG8_STAGE(PG8_SA(0, 0), cA, voffA); PG8_STAGE(PG8_SB(0, 1), cB + hstep, voffB); PG8_STAGE(PG8_SA(0, 1), cA + hstep, voffA);
        if (wr == 1) PG8_BAR;
        PG8_WAIT_V(4); PG8_BAR;
        PG8_STAGE(PG8_SB(1, 0), cB + kstep, voffB); PG8_STAGE(PG8_SA(1, 0), cA + kstep, voffA); PG8_STAGE(PG8_SB(1, 1), cB + hstep + kstep, voffB);
        PG8_WAIT_V(6); PG8_BAR;
    }
    for (;;) {
        const bool has_next = S.next(ui + 1, nxt);
        const char* nA = has_next ? S.pa(g, nxt) : cA; const char* nB = has_next ? S.pb(g, nxt) : cB;
        for (int t = 0; t < nt; t += 2) {
            const bool last = (t == nt - 2);
            const char* a1 = cA + (size_t)(t + 1) * kstep;
            const char* a2 = last ? nA : cA + (size_t)(t + 2) * kstep; const char* b2 = last ? nB : cB + (size_t)(t + 2) * kstep;
            const char* a3 = a2 + kstep; const char* b3 = b2 + kstep;
            if (last && has_next) S.a_ready(nxt);
            if constexpr (SP2) {
            PG8_LDB(B0, 0, 0); PG8_LDB(B1, 0, 1); PG8_SCHED; PG8_LDA(At, 0, 0); PG8_STAGE(PG8_SA(1, 1), a1 + hstep, voffA);
            PG8_WAIT_V(8); PG8_WAIT_L(0); PG8_BAR; PG8_MMA(0, 0, At, B0); PG8_MMA(0, 1, At, B1); PG8_BAR; PG8_SCHED;
            PG8_LDA(At, 0, 1); PG8_STAGE(PG8_SB(0, 0), b2, voffB); PG8_STAGE(PG8_SB(0, 1), b2 + hstep, voffB); PG8_STAGE(PG8_SA(0, 0), a2, voffA);
            PG8_WAIT_V(8); PG8_WAIT_L(0); PG8_BAR; PG8_MMA(1, 0, At, B0); PG8_MMA(1, 1, At, B1); PG8_BAR; PG8_SCHED;
            PG8_LDB(B0, 1, 0); PG8_LDB(B1, 1, 1); PG8_SCHED; PG8_LDA(At, 1, 0); PG8_STAGE(PG8_SA(0, 1), a2 + hstep, voffA);
            PG8_WAIT_V(8); PG8_WAIT_L(0); PG8_BAR; PG8_MMA(0, 0, At, B0); PG8_MMA(0, 1, At, B1); PG8_BAR; PG8_SCHED;
            PG8_LDA(At, 1, 1); PG8_STAGE(PG8_SB(1, 0), b3, voffB); PG8_STAGE(PG8_SB(1, 1), b3 + hstep, voffB); PG8_STAGE(PG8_SA(1, 0), a3, voffA);
            PG8_WAIT_V(8); PG8_WAIT_L(0); PG8_BAR; PG8_MMA(1, 0, At, B0); PG8_MMA(1, 1, At, B1); PG8_BAR; PG8_SCHED;
            } else {
            PG8_LDB(B0, 0, 0); PG8_SCHED; PG8_LDA(At, 0, 0); PG8_STAGE(PG8_SA(1, 1), a1 + hstep, voffA);
            PG8_WAIT_L(8); PG8_BAR; PG8_WAIT_L(0); PG8_MMA(0, 0, At, B0); PG8_BAR; PG8_SCHED;
            PG8_LDB(B1, 0, 1); PG8_STAGE(PG8_SB(0, 0), b2, voffB);
            PG8_BAR; PG8_WAIT_L(0); PG8_MMA(0, 1, At, B1); PG8_BAR;
            PG8_LDA(At, 0, 1); PG8_STAGE(PG8_SA(0, 0), a2, voffA);
            PG8_BAR; PG8_WAIT_L(0); PG8_MMA(1, 0, At, B0); PG8_BAR; PG8_SCHED;
            PG8_STAGE(PG8_SB(0, 1), b2 + hstep, voffB);
            PG8_WAIT_V(6); PG8_BAR; PG8_MMA(1, 1, At, B1); PG8_BAR;
            PG8_LDB(B0, 1, 0); PG8_SCHED; PG8_LDA(At, 1, 0); PG8_STAGE(PG8_SA(0, 1), a2 + hstep, voffA);
            PG8_WAIT_L(8); PG8_BAR; PG8_WAIT_L(0); PG8_MMA(0, 0, At, B0); PG8_BAR; PG8_SCHED;
            PG8_LDB(B1, 1, 1); PG8_STAGE(PG8_SB(1, 0), b3, voffB);
            PG8_BAR; PG8_WAIT_L(0); PG8_MMA(0, 1, At, B1); PG8_BAR;
            PG8_LDA(At, 1, 1); PG8_STAGE(PG8_SA(1, 0), a3, voffA);
            PG8_BAR; PG8_WAIT_L(0); PG8_MMA(1, 0, At, B0); PG8_BAR; PG8_SCHED;
            PG8_STAGE(PG8_SB(1, 1), b3 + hstep, voffB);
            PG8_WAIT_V(6); PG8_BAR; PG8_MMA(1, 1, At, B1); PG8_BAR;
            }
        }
        if constexpr (ALIGN_EPI) { if (wr == 0) PG8_BAR; }
        if constexpr (!Epi::AFTER_DRAIN) { E(acc, cur, wr, wc, fr, fq); S.done(cur); }
        if (!has_next) break;
#pragma unroll
        for (int a = 0; a < 2; ++a)
#pragma unroll
            for (int b = 0; b < 2; ++b)
#pragma unroll
                for (int m = 0; m < 4; ++m)
#pragma unroll
                    for (int n = 0; n < 2; ++n) acc[a][b][m][n] = (f32x4){0.f, 0.f, 0.f, 0.f};
        cur = nxt; cA = nA; cB = nB; ++ui;
        if constexpr (ALIGN_EPI) { if (wr == 1) PG8_BAR; }
    }
    PG8_WAIT_V(0);
    if constexpr (!ALIGN_EPI) { if (wr == 0) PG8_BAR; }
    PG8_BAR;
    if constexpr (Epi::AFTER_DRAIN) { E.fused(acc, cur, wr, wc, fr, fq, lds, wid, lane); S.done(cur); }
#undef PG8_SA
#undef PG8_SB
#undef PG8_STAGE
#undef PG8_LDA
#undef PG8_LDB
#undef PG8_MMA
#undef PG8_WAIT_V
#undef PG8_WAIT_L
#undef PG8_BAR
#undef PG8_SCHED
}
}

constexpr int DM = 1024, NBATCH = 8, SEQ = 4096, NTOK = NBATCH * SEQ, CTXL = 256, NCTX = NBATCH * CTXL, MROWS = NTOK + NCTX;
constexpr int DIN = 2048, NHEAD = 8, HD = 64, GRIDW = 64, NMOD = 6 * DM;
constexpr int NEXP = 16384;
constexpr float EPS = 1e-6f;
constexpr int NWAVES = 8;
constexpr int NPHASE = 8;
constexpr float U_SCALE = 64.f, V_SCALE = 4.f;

#define GATHER_V2 1
#ifndef GATHER_NT
#define GATHER_NT 4
#endif
#ifndef MK_N_LAUNCHES
#define MK_N_LAUNCHES 1
#endif
constexpr int N_LAUNCHES = MK_N_LAUNCHES;

constexpr size_t MiB = 1u << 20;
constexpr size_t WS_CTL = 0, CTL_ZERO_BYTES = 64 * 1024;
constexpr size_t WS_WIN = 2 * MiB, WS_WOUT = 6 * MiB, WS_WQ = 8 * MiB, WS_KEYS = 12 * MiB, WS_POOLW = 12 * MiB + 512 * 1024, WS_MOD = 13 * MiB;
constexpr size_t WS_SU = 13 * MiB + 512 * 1024;
constexpr size_t WS_U = 14 * MiB, WS_V = 46 * MiB;
constexpr size_t WS_HX = 78 * MiB;
constexpr size_t WS_ZX = 146 * MiB;
constexpr size_t WS_PB = 146 * MiB, WS_QF = 178 * MiB, WS_KF = 210 * MiB, WS_VF = 244 * MiB;
constexpr size_t WS_MIX = 282 * MiB;
constexpr size_t WS_EXP = 346 * MiB, WS_GATE = 362 * MiB;
constexpr size_t WS_POOLED = 378 * MiB;
constexpr size_t WS_X1 = 378 * MiB;
constexpr size_t WS_LISTS = 410 * MiB;
constexpr size_t WS_END = 442 * MiB;
constexpr int CW_BAR = 4096;

constexpr int RING_OFF = 0, RING_BYTES = 131072;
constexpr int LDSCTL_OFF = RING_BYTES, MISC_OFF = LDSCTL_OFF + 320;
constexpr int LDS_BYTES = 147456;

#define GAS __attribute__((address_space(1)))
#define LAS __attribute__((address_space(3)))
#define DI __device__ __forceinline__
typedef unsigned short bf16;
typedef unsigned v4u __attribute__((ext_vector_type(4)));
typedef unsigned v2u __attribute__((ext_vector_type(2)));
typedef float f32x4 __attribute__((ext_vector_type(4)));
typedef float f32x2 __attribute__((ext_vector_type(2)));
typedef GAS unsigned gu32;
#define RLX_AGENT __ATOMIC_RELAXED, __HIP_MEMORY_SCOPE_AGENT
#define LDS_WAIT() asm volatile("s_waitcnt lgkmcnt(0)" ::: "memory")
#define VM_WAIT() asm volatile("s_waitcnt vmcnt(0)" ::: "memory")
DI unsigned f2bf(float f) { unsigned u = __builtin_bit_cast(unsigned, f); return (u + 0x7fffu + ((u >> 16) & 1u)) >> 16; }
DI unsigned pk2(float lo, float hi) { return f2bf(lo) | (f2bf(hi) << 16); }
DI float bflo(unsigned u) { return __uint_as_float(u << 16); }
DI float bfhi(unsigned u) { return __uint_as_float(u & 0xffff0000u); }
DI float wave_sum(float v) {
#pragma unroll
    for (int o = 1; o < 64; o <<= 1) v += __shfl_xor(v, o);
    return v;
}

#define XB_TMO      128
#define XB_XCNT(j)  (256  + 64 * (j))
#define XB_XSUB(j)  (1280 + 64 * (j))
#define XB_XGEN(j)  (2304 + 64 * (j))
#define XB_TOP      3328
#define XB_TOPGEN   3392
#define XCD_BAR_WORDS 3456
#define XB_SPIN_CAP (1u << 18)

__device__ __forceinline__ unsigned xb_ld(unsigned* p)              { return __hip_atomic_load(p, __ATOMIC_RELAXED, __HIP_MEMORY_SCOPE_AGENT); }
__device__ __forceinline__ unsigned xb_add(unsigned* p, unsigned v) { return __hip_atomic_fetch_add(p, v, __ATOMIC_RELAXED, __HIP_MEMORY_SCOPE_AGENT); }
__device__ __forceinline__ unsigned xb_xcc_id() { return (unsigned)__builtin_amdgcn_s_getreg((3 << 11) | 20) & 0xFu; }
#define XB_SPIN(cond, bar) do { unsigned _sp = 0; while (cond) { __builtin_amdgcn_s_sleep(1); \
    if ((++_sp & 255u) == 0u) { if (xb_ld(&(bar)[XB_TMO])) break; if (_sp > XB_SPIN_CAP) { atomicAdd(&(bar)[XB_TMO], 1u); break; } } } } while (0)

struct XcdBarrier {
    unsigned* bar; unsigned x;
    volatile LAS unsigned* st;
};

__device__ __forceinline__ XcdBarrier xcd_barrier_post(unsigned* bar, volatile LAS unsigned* st) {
    XcdBarrier b; b.bar = bar; b.x = xb_xcc_id(); b.st = st;
    if (threadIdx.x == 0) (void)xb_add(&bar[XB_XCNT(b.x)], 1u);
    return b;
}
__device__ __forceinline__ void xcd_barrier_complete(unsigned* bar, unsigned x, unsigned& nloc, unsigned& nx) {
    const unsigned G = gridDim.x * gridDim.y * gridDim.z;
    unsigned sum, cnt, mine, sp = 0u;
    for (;;) {
        sum = 0u; cnt = 0u; mine = 0u;
#pragma unroll
        for (unsigned j = 0; j < 16; ++j) { const unsigned c = xb_ld(&bar[XB_XCNT(j)]); sum += c; cnt += (c > 0u) ? 1u : 0u; mine = (j == x) ? c : mine; }
        if (sum == G) break;
        __builtin_amdgcn_s_sleep(1);
        if ((++sp & 255u) == 0u) { if (xb_ld(&bar[XB_TMO])) break; if (sp > XB_SPIN_CAP) { atomicAdd(&bar[XB_TMO], 1u); break; } }
    }
    nloc = mine > 0u ? mine : 1u; nx = cnt > 0u ? cnt : 1u;
}

__device__ __forceinline__ void xcd_barrier(const XcdBarrier& b) {
    asm volatile("s_waitcnt vmcnt(0)" ::: "memory");
    __syncthreads();
    if (threadIdx.x == 0) {
        unsigned* bar = b.bar;
        __builtin_amdgcn_s_waitcnt(0);
        unsigned nloc = b.st[0], nx = b.st[1];
        if (nloc == 0u) { xcd_barrier_complete(bar, b.x, nloc, nx); b.st[0] = nloc; b.st[1] = nx; }
        const unsigned old = xb_add(&bar[XB_XSUB(b.x)], 1u);
        const unsigned gen = old / nloc;
        if (old + 1u == (gen + 1u) * nloc) {
            __builtin_amdgcn_fence(__ATOMIC_RELEASE, "agent");
            asm volatile("s_waitcnt vmcnt(0)" ::: "memory");
            const unsigned og = xb_add(&bar[XB_TOP], 1u);
            const unsigned tg = og / nx;
            if (og + 1u == (tg + 1u) * nx) xb_add(&bar[XB_TOPGEN], 1u);
            else XB_SPIN(xb_ld(&bar[XB_TOPGEN]) == tg, bar);
            __builtin_amdgcn_fence(__ATOMIC_ACQUIRE, "agent");
            xb_add(&bar[XB_XGEN(b.x)], 1u);
            asm volatile("s_waitcnt vmcnt(0)" ::: "memory");
        } else {
            XB_SPIN(xb_ld(&bar[XB_XGEN(b.x)]) == gen, bar);
            __builtin_amdgcn_fence(__ATOMIC_ACQUIRE, "agent");
            asm volatile("s_waitcnt vmcnt(0)" ::: "memory");
        }
    }
    __syncthreads();
}


__device__ __forceinline__ void p0_transpose_item(const float* W, int K, int N, bf16* WT, int row_off, LAS float* scr, int item, int lane) {
    const int nblk = N / 32, kb = item / nblk, nb = item % nblk, k0 = 64 * kb, n0 = 32 * nb;
#pragma unroll 8
    for (int i = 0; i < 32; ++i) { const int kk = 2 * i + (lane >> 5); scr[kk * 33 + (lane & 31)] = W[(size_t)(k0 + kk) * N + n0 + (lane & 31)]; }
    LDS_WAIT(); asm volatile("" ::: "memory");
    const int c = lane & 7;
#pragma unroll
    for (int j = 0; j < 4; ++j) { const int n = (lane >> 3) + 8 * j; const LAS float* s = scr + (8 * c) * 33 + n;
        v4u o; o.x = pk2(s[0 * 33], s[1 * 33]); o.y = pk2(s[2 * 33], s[3 * 33]); o.z = pk2(s[4 * 33], s[5 * 33]); o.w = pk2(s[6 * 33], s[7 * 33]);
        *(GAS v4u*)(WT + (size_t)(row_off + n0 + n) * K + k0 + 8 * c) = o; }
    LDS_WAIT(); asm volatile("" ::: "memory");
}


struct Frame {
    LAS unsigned char* lds;
    int tid, lane, wave, vcu, G, gw, NGW;
    const float* in[18]; float* out; unsigned char* ws;
};

DI void p0_prologue(Frame& F) {
    const float* c = F.in[1]; const float* c_ctx = F.in[3]; const float* ada_w = F.in[4]; const float* ada_b = F.in[5];
    float* MOD = (float*)(F.ws + WS_MOD);
    LAS float* sl = (LAS float*)(F.lds + 73728);
    for (int i = F.tid; i < 9 * 1024; i += 512) { const int b = i >> 10, k = i & 1023; const float cv = (b < 8) ? c[b * 1024 + k] : c_ctx[k]; sl[i] = cv / (1.f + __expf(-cv)); }
    __syncthreads();
    { LAS float* part = (LAS float*)(F.lds + 110592);
      for (int cg = F.vcu; cg < NMOD / 24; cg += F.G) {
          const int c = F.lane % 24, sub = F.lane / 24, n = cg * 24 + c, k0 = F.wave * 128 + sub * 64;
          float acc[9];
#pragma unroll
          for (int b = 0; b < 9; ++b) acc[b] = 0.f;
          if (sub < 2) { const float* wp = ada_w + (size_t)k0 * NMOD + n; const LAS float* sp = sl + k0;
#pragma unroll 16
              for (int i = 0; i < 64; ++i) { const float w = wp[(size_t)i * NMOD];
#pragma unroll
                  for (int b = 0; b < 9; ++b) acc[b] += sp[b * 1024 + i] * w; } }
#pragma unroll
          for (int b = 0; b < 9; ++b) { const float o = __shfl(acc[b], (F.lane + 24) & 63); if (F.lane < 24) part[(F.wave * 9 + b) * 24 + c] = acc[b] + o; }
          __syncthreads();
          if (F.tid < 216) { const int b = F.tid / 24, cc = F.tid % 24; float t = ada_b[cg * 24 + cc];
#pragma unroll
              for (int w = 0; w < 8; ++w) t += part[(w * 9 + b) * 24 + cc];
              MOD[b * NMOD + cg * 24 + cc] = t; }
          __syncthreads();
      } }
    LAS float* scr = (LAS float*)(F.lds + F.wave * 9216);
    constexpr int I_IN = (DM / 64) * (DIN / 32), I_OUT = (DM / 64) * (DM / 32), I_Q = (DM / 64) * (2048 / 32), I_P = 4 * 8;
    for (int it = F.gw; it < I_IN + I_OUT + I_Q + I_P; it += F.NGW) {
        int r = it;
        if (r < I_IN) { p0_transpose_item(F.in[7], DM, DIN, (bf16*)(F.ws + WS_WIN), 0, scr, r, F.lane); continue; } r -= I_IN;
        if (r < I_OUT) { p0_transpose_item(F.in[11], DM, DM, (bf16*)(F.ws + WS_WOUT), 0, scr, r, F.lane); continue; } r -= I_OUT;
        if (r < I_Q) { p0_transpose_item(F.in[13], DM, 2048, (bf16*)(F.ws + WS_WQ), 0, scr, r, F.lane); continue; } r -= I_Q;
        { const int g = r >> 3; p0_transpose_item(F.in[8] + g * 16384, 128, 128, (bf16*)(F.ws + WS_POOLW) + g * 16384, 0, scr, r & 7, F.lane); }
    }
    { const float* kf = F.in[14]; bf16* kb = (bf16*)(F.ws + WS_KEYS);
      for (int it = F.gw; it < 16 * 32; it += F.NGW) { const int hp = it >> 5, nt = (it >> 3) & 3, ks = it & 7;
          const float* src = kf + ((size_t)hp * 128 + 32 * nt + (F.lane & 31)) * 128 + 16 * ks + 8 * (F.lane >> 5);
          const f32x4 a = *(const f32x4*)(src), b = *(const f32x4*)(src + 4);
          v4u w; w.x = pk2(a.x, a.y); w.y = pk2(a.z, a.w); w.z = pk2(b.x, b.y); w.w = pk2(b.z, b.w); *(v4u*)(kb + ((size_t)it * 64 + F.lane) * 8) = w; } }
    for (int it = F.gw; it < 2 * NEXP; it += F.NGW) {
        const bool isu = it < NEXP;
        const float* src = isu ? F.in[15] + (size_t)it * 1024 : F.in[16] + (size_t)(it - NEXP) * 1024;
        unsigned* dst = (unsigned*)(isu ? F.ws + WS_U + (size_t)it * 1024 : F.ws + WS_V + (size_t)(it - NEXP) * 1024) + F.lane;
        const f32x4* sp = (const f32x4*)src + F.lane;
        f32x4 a[4];
#pragma unroll
        for (int j = 0; j < 4; ++j) a[j] = sp[64 * j];
        if (isu) {
            float am = 0.f;
#pragma unroll
            for (int j = 0; j < 4; ++j) am = fmaxf(fmaxf(am, fmaxf(fabsf(a[j].x), fabsf(a[j].y))), fmaxf(fabsf(a[j].z), fabsf(a[j].w)));
#pragma unroll
            for (int o = 1; o < 64; o <<= 1) am = fmaxf(am, __shfl_xor(am, o));
            am = fmaxf(am, 1e-30f);
            const float inv = 127.0f / am;
#pragma unroll
            for (int j = 0; j < 4; ++j) { const int q0 = (int)rintf(a[j].x * inv), q1 = (int)rintf(a[j].y * inv), q2 = (int)rintf(a[j].z * inv), q3 = (int)rintf(a[j].w * inv);
                dst[64 * j] = (unsigned)(q0 & 255) | ((unsigned)(q1 & 255) << 8) | ((unsigned)(q2 & 255) << 16) | ((unsigned)(q3 & 255) << 24); }
            if (F.lane == 0) ((float*)(F.ws + WS_SU))[it] = am * (1.0f / 127.0f);
        } else {
#pragma unroll
            for (int j = 0; j < 4; ++j) { const f32x4 sv = a[j] * V_SCALE; int pk = 0; pk = __builtin_amdgcn_cvt_pk_fp8_f32(sv.x, sv.y, pk, false); pk = __builtin_amdgcn_cvt_pk_fp8_f32(sv.z, sv.w, pk, true); dst[64 * j] = (unsigned)pk; }
        }
    }
}

template <bool SRC_BF16> DI void norm_rows(Frame& F, const float* src_x, const float* src_ctx, int nrows, const float* gain, int shift_off, int scale_off, bf16* dst) {
    const float* MOD = (const float*)(F.ws + WS_MOD);
    const int per = (nrows + F.NGW - 1) / F.NGW, m_lo = F.gw * per, m_hi = min(m_lo + per, nrows);
    f32x4 gs[4], shv[4]; int cb = -1;
    for (int m = m_lo; m < m_hi; ++m) {
        const float* xrow; int b;
        if (m < NTOK) { xrow = src_x + (size_t)m * DM; b = m >> 12; } else { xrow = src_ctx + (size_t)(m - NTOK) * DM; b = 8; }
        f32x4 v[4]; float s = 0.f;
        if (SRC_BF16) { const v2u* xr = (const v2u*)((const bf16*)src_x + (size_t)m * DM) + F.lane;
#pragma unroll
            for (int j = 0; j < 4; ++j) { const v2u w = xr[64 * j]; v[j] = (f32x4){bflo(w.x), bfhi(w.x), bflo(w.y), bfhi(w.y)}; }
        } else { const f32x4* xr = (const f32x4*)xrow + F.lane;
#pragma unroll
            for (int j = 0; j < 4; ++j) v[j] = xr[64 * j]; }
        if (b != cb) { cb = b;
            const f32x4* gp = (const f32x4*)gain + F.lane; const f32x4* shp = (const f32x4*)(MOD + b * NMOD + shift_off) + F.lane; const f32x4* scp = (const f32x4*)(MOD + b * NMOD + scale_off) + F.lane;
#pragma unroll
            for (int j = 0; j < 4; ++j) { gs[j] = gp[64 * j] * (scp[64 * j] + 1.0f); shv[j] = shp[64 * j]; } }
#pragma unroll
        for (int j = 0; j < 4; ++j) s += (v[j].x * v[j].x + v[j].y * v[j].y) + (v[j].z * v[j].z + v[j].w * v[j].w);
        const float rinv = 1.0f / sqrtf(wave_sum(s) * (1.f / DM) + EPS);
        unsigned long long* o8 = (unsigned long long*)(dst + (size_t)m * DM) + F.lane;
#pragma unroll
        for (int j = 0; j < 4; ++j) { const f32x4 y = (v[j] * rinv) * gs[j] + shv[j];
            o8[64 * j] = (unsigned long long)pk2(y.x, y.y) | ((unsigned long long)pk2(y.z, y.w) << 32); }
    }
}

DI void attn_key(const bf16* KF, const bf16* VF, int blkbase, int kk, int dt, float bias, const float (&q)[64], float (&o)[32], float& m, float& l) {
    const bf16* kp = KF + (size_t)blkbase * 2048 + kk * 8;
    float acc = 0.f;
#pragma unroll
    for (int cc = 0; cc < 8; ++cc) { const v4u kv = *(const v4u*)(kp + ((cc >> 1) * 64 + (cc & 1) * 32) * 8);
        acc += q[8 * cc + 0] * bflo(kv.x) + q[8 * cc + 1] * bfhi(kv.x) + q[8 * cc + 2] * bflo(kv.y) + q[8 * cc + 3] * bfhi(kv.y)
             + q[8 * cc + 4] * bflo(kv.z) + q[8 * cc + 5] * bfhi(kv.z) + q[8 * cc + 6] * bflo(kv.w) + q[8 * cc + 7] * bfhi(kv.w); }
    const float s = acc + bias;
    const float mn = fmaxf(m, s), alpha = __expf(m - mn), p = __expf(s - mn);
    l = l * alpha + p; m = mn;
    const bf16* vp = VF + (size_t)blkbase * 2048 + dt * 1024 + (kk >> 4) * 512 + (((kk >> 2) & 1) * 32) * 8 + 4 * ((kk >> 3) & 1) + (kk & 3);
#pragma unroll
    for (int d = 0; d < 32; ++d) o[d] = o[d] * alpha + p * __uint_as_float((unsigned)vp[d * 8] << 16);
}
DI void attn_naive(Frame& F) {
    const bf16* QF = (const bf16*)(F.ws + WS_QF); const bf16* KF = (const bf16*)(F.ws + WS_KF); const bf16* VF = (const bf16*)(F.ws + WS_VF);
    bf16* MIX = (bf16*)(F.ws + WS_MIX); const float* rpb = F.in[10];
    for (int unit2 = F.gw; unit2 < 2 * NBATCH * NHEAD * 64; unit2 += F.NGW) {
        const int unit = unit2 >> 1, dt = unit2 & 1;
        const int r = unit & 63, h = (unit >> 6) & 7, b = unit >> 9, col = F.lane;
        const int tq = b * SEQ + r * GRIDW + col;
        float q[64], o[32];
        { const bf16* qp = QF + (size_t)((b * 8 + h) * 128 + 2 * r + (col >> 5)) * 2048 + (col & 31) * 8;
#pragma unroll
          for (int cc = 0; cc < 8; ++cc) { const v4u qv = *(const v4u*)(qp + ((cc >> 1) * 64 + (cc & 1) * 32) * 8);
              q[8 * cc + 0] = 0.125f * bflo(qv.x); q[8 * cc + 1] = 0.125f * bfhi(qv.x); q[8 * cc + 2] = 0.125f * bflo(qv.y); q[8 * cc + 3] = 0.125f * bfhi(qv.y);
              q[8 * cc + 4] = 0.125f * bflo(qv.z); q[8 * cc + 5] = 0.125f * bfhi(qv.z); q[8 * cc + 6] = 0.125f * bflo(qv.w); q[8 * cc + 7] = 0.125f * bfhi(qv.w); } }
#pragma unroll
        for (int d = 0; d < 32; ++d) o[d] = 0.f;
        float m = -1e30f, l = 0.f;
#pragma unroll 1
        for (int g = 0; g < CTXL; ++g) attn_key(KF, VF, (b * 8 + h) * 136 + 128 + (g >> 5), g & 31, dt, 0.f, q, o, m, l);
        const int r0 = min(max(r - 4, 0), 56), c0 = min(max(col - 8, 0), 48);
#pragma unroll 1
        for (int ij = 0; ij < 128; ++ij) { const int i = ij >> 4, j = ij & 15, kc = c0 + j;
            attn_key(KF, VF, (b * 8 + h) * 136 + 2 * (r0 + i) + (kc >> 5), kc & 31, dt, rpb[(h * 15 + (r0 + i - r + 7)) * 31 + (kc - col + 15)], q, o, m, l); }
        const float il = 1.0f / l;
        v4u* op = (v4u*)(MIX + (size_t)tq * DM + 512 + h * 64 + dt * 32);
#pragma unroll
        for (int cc = 0; cc < 4; ++cc) { v4u w; w.x = pk2(o[8 * cc] * il, o[8 * cc + 1] * il); w.y = pk2(o[8 * cc + 2] * il, o[8 * cc + 3] * il);
            w.z = pk2(o[8 * cc + 4] * il, o[8 * cc + 5] * il); w.w = pk2(o[8 * cc + 6] * il, o[8 * cc + 7] * il); op[cc] = w; }
    }
}
typedef float f32x16 __attribute__((ext_vector_type(16)));
typedef short s16x8 __attribute__((ext_vector_type(8)));
typedef __bf16 bf16x2_t __attribute__((ext_vector_type(2)));
#define MFMA32(a, b, c) __builtin_amdgcn_mfma_f32_32x32x16_bf16((a), (b), (c), 0, 0, 0)
DI unsigned cvtpk(float lo, float hi) { f32x2 v = {lo, hi}; bf16x2_t bb = __builtin_convertvector(v, bf16x2_t); return __builtin_bit_cast(unsigned, bb); }
DI float pairmax(float v) { auto rr = __builtin_amdgcn_permlane32_swap(__float_as_uint(v), __float_as_uint(v), false, false); return fmaxf(__uint_as_float(rr[0]), __uint_as_float(rr[1])); }
constexpr float LOG2E = 1.4426950408889634f, ATT_C2 = 0.125f * LOG2E, ATT_THR = 6.0f;
template <int QMASK, bool LOCAL>
DI void attn_tile(const s16x8 (&kf)[4], const s16x8 (&vf)[4], const LAS s16x8* qfp, f32x16 (&o)[2], float& m, float& l, const LAS float* brow, int djb, int lo) {
    f32x16 s; s16x8 qf[4];
#pragma unroll
    for (int ks = 0; ks < 4; ++ks) qf[ks] = qfp[ks * 64];
#pragma unroll
    for (int i = 0; i < 16; ++i) s[i] = 0.f;
#pragma unroll
    for (int ks = 0; ks < 4; ++ks) s = MFMA32(kf[ks], qf[ks], s);
    float sv[16]; float tmax = -INFINITY;
#pragma unroll
    for (int i = 0; i < 16; ++i) {
        if (!((QMASK >> (i >> 2)) & 1)) { sv[i] = -INFINITY; continue; }
        if (LOCAL) { const int dj = djb + (i & 3) + 8 * (i >> 2); const bool valid = (unsigned)(dj - lo) < 16u;
            const float x = s[i] * ATT_C2 + brow[valid ? dj : 0]; sv[i] = valid ? x : -INFINITY; }
        else sv[i] = s[i] * ATT_C2;
        tmax = fmaxf(tmax, sv[i]);
    }
    tmax = pairmax(tmax);
    if (__any(tmax > m + ATT_THR)) { const float mn = fmaxf(m, tmax), alpha = __builtin_amdgcn_exp2f(m - mn); o[0] *= alpha; o[1] *= alpha; l *= alpha; m = mn; }
    float p[16];
#pragma unroll
    for (int i = 0; i < 16; ++i) { if ((QMASK >> (i >> 2)) & 1) { p[i] = __builtin_amdgcn_exp2f(sv[i] - m); l += p[i]; } else p[i] = 0.f; }
#pragma unroll
    for (int s2 = 0; s2 < 2; ++s2) if (QMASK & (3 << (2 * s2))) {
        v4u pk; pk.x = cvtpk(p[8 * s2], p[8 * s2 + 1]); pk.y = cvtpk(p[8 * s2 + 2], p[8 * s2 + 3]); pk.z = cvtpk(p[8 * s2 + 4], p[8 * s2 + 5]); pk.w = cvtpk(p[8 * s2 + 6], p[8 * s2 + 7]);
        const s16x8 pf = __builtin_bit_cast(s16x8, pk);
        o[0] = MFMA32(vf[s2], pf, o[0]); o[1] = MFMA32(vf[2 + s2], pf, o[1]);
    }
}
DI void attn_mfma(Frame& F) {
    const bf16* QF = (const bf16*)(F.ws + WS_QF); const bf16* KF = (const bf16*)(F.ws + WS_KF); const bf16* VF = (const bf16*)(F.ws + WS_VF);
    bf16* MIX = (bf16*)(F.ws + WS_MIX); const float* rpb = F.in[10];
    LAS float* rp = (LAS float*)(F.lds);
    for (int i = F.tid; i < NHEAD * 15 * 31; i += 512) rp[i] = rpb[i] * LOG2E;
    __syncthreads();
    const int lane = F.lane, hh = lane >> 5, ql = lane & 31;
    int lo[2], djb[2][2];
#pragma unroll
    for (int qb = 0; qb < 2; ++qb) { const int qc = 32 * qb + ql, c0 = min(max(qc - 8, 0), 48); lo[qb] = c0 - qc + 15;
#pragma unroll
        for (int jb = 0; jb < 2; ++jb) djb[qb][jb] = 32 * (jb - qb) + 4 * hh - ql + 15; }
    for (int unit = F.gw; unit < NBATCH * NHEAD * 64; unit += F.NGW) {
        const int r = unit & 63, h = (unit >> 6) & 7, b = unit >> 9, bh = b * 8 + h;
        LAS s16x8* qfl = (LAS s16x8*)(F.lds + 16384 + F.wave * 8192) + lane;
#pragma unroll
        for (int qb = 0; qb < 2; ++qb)
#pragma unroll
            for (int ks = 0; ks < 4; ++ks) qfl[(qb * 4 + ks) * 64] = ((const s16x8*)(QF + (size_t)(bh * 128 + 2 * r + qb) * 2048))[ks * 64 + lane];
        f32x16 o[2][2]; float m[2], l[2];
#pragma unroll
        for (int qb = 0; qb < 2; ++qb) { m[qb] = -1e30f; l[qb] = 0.f;
#pragma unroll
            for (int dt = 0; dt < 2; ++dt)
#pragma unroll
                for (int i = 0; i < 16; ++i) o[qb][dt][i] = 0.f; }
        const int r0 = min(max(r - 4, 0), 56);
        s16x8 kf[4], vf[4], kn[4];
        { const s16x8* kp = (const s16x8*)(KF + (size_t)(bh * 136 + 128) * 2048) + lane;
#pragma unroll
          for (int j = 0; j < 4; ++j) kn[j] = kp[j * 64]; }
#pragma unroll 1
        for (int kb = 0; kb < 8; ++kb) {
            { const s16x8* vp = (const s16x8*)(VF + (size_t)(bh * 136 + 128 + kb) * 2048) + lane;
#pragma unroll
              for (int j = 0; j < 4; ++j) { kf[j] = kn[j]; vf[j] = vp[j * 64]; } }
            { const int nb = (kb < 7) ? bh * 136 + 128 + kb + 1 : bh * 136 + 2 * r0;
              const s16x8* kp = (const s16x8*)(KF + (size_t)nb * 2048) + lane;
#pragma unroll
              for (int j = 0; j < 4; ++j) kn[j] = kp[j * 64]; }
            attn_tile<15, false>(kf, vf, qfl, o[0], m[0], l[0], rp, 0, 0); __builtin_amdgcn_sched_barrier(0);
            attn_tile<15, false>(kf, vf, qfl + 256, o[1], m[1], l[1], rp, 0, 0); __builtin_amdgcn_sched_barrier(0);
        }
#pragma unroll 1
        for (int i = 0; i < 8; ++i) {
            const LAS float* brow = rp + (h * 15 + (r0 + i - r + 7)) * 31;
            { const s16x8* vp = (const s16x8*)(VF + (size_t)(bh * 136 + 2 * (r0 + i)) * 2048) + lane;
#pragma unroll
              for (int j = 0; j < 4; ++j) { kf[j] = kn[j]; vf[j] = vp[j * 64]; } }
            { const int nb = bh * 136 + 2 * (r0 + i) + 1;
              const s16x8* kp = (const s16x8*)(KF + (size_t)nb * 2048) + lane;
#pragma unroll
              for (int j = 0; j < 4; ++j) kn[j] = kp[j * 64]; }
            attn_tile<15, true>(kf, vf, qfl, o[0], m[0], l[0], brow, djb[0][0], lo[0]); __builtin_amdgcn_sched_barrier(0);
            attn_tile<8, true>(kf, vf, qfl + 256, o[1], m[1], l[1], brow, djb[1][0], lo[1]); __builtin_amdgcn_sched_barrier(0);
            { const s16x8* vp = (const s16x8*)(VF + (size_t)(bh * 136 + 2 * (r0 + i) + 1) * 2048) + lane;
#pragma unroll
              for (int j = 0; j < 4; ++j) { kf[j] = kn[j]; vf[j] = vp[j * 64]; } }
            { const int nb = bh * 136 + 2 * (r0 + ((i < 7) ? i + 1 : 0));
              const s16x8* kp = (const s16x8*)(KF + (size_t)nb * 2048) + lane;
#pragma unroll
              for (int j = 0; j < 4; ++j) kn[j] = kp[j * 64]; }
            attn_tile<1, true>(kf, vf, qfl, o[0], m[0], l[0], brow, djb[0][1], lo[0]); __builtin_amdgcn_sched_barrier(0);
            attn_tile<15, true>(kf, vf, qfl + 256, o[1], m[1], l[1], brow, djb[1][1], lo[1]); __builtin_amdgcn_sched_barrier(0);
        }
#pragma unroll
        for (int qb = 0; qb < 2; ++qb) {
            const float lt = l[qb] + __shfl_xor(l[qb], 32), inv = 1.0f / lt;
            bf16* orow = MIX + (size_t)(b * SEQ + r * GRIDW + 32 * qb + ql) * DM + 512 + h * 64 + 4 * hh;
#pragma unroll
            for (int dt = 0; dt < 2; ++dt)
#pragma unroll
                for (int g = 0; g < 4; ++g) { v2u w; w.x = pk2(o[qb][dt][4 * g] * inv, o[qb][dt][4 * g + 1] * inv); w.y = pk2(o[qb][dt][4 * g + 2] * inv, o[qb][dt][4 * g + 3] * inv);
                    *(v2u*)(orow + 32 * dt + 8 * g) = w; }
        }
    }
    __syncthreads();
}
DI void pool_mfma(Frame& F) {
    const bf16* PBF = (const bf16*)(F.ws + WS_PB); bf16* MIX = (bf16*)(F.ws + WS_MIX); const bf16* PW = (const bf16*)(F.ws + WS_POOLW); const float* pool_scale = F.in[9];
    constexpr int RS = 272;
    LAS unsigned char* ptile = F.lds + 32768;
    LAS unsigned char* atile = F.lds + 32768 + 144 * RS;
    const int lane = F.lane, hh = lane >> 5, ql = lane & 31;
    for (int tile = F.vcu; tile < NTOK / 128; tile += F.G) {
        const int tok0 = tile * 128, bstart = tok0 & ~(SEQ - 1);
#pragma unroll 1
        for (int g = 0; g < 4; ++g) {
            for (int it = F.tid; it < 144 * 16; it += 512) { const int rr = it >> 4, ch = it & 15, t = tok0 - 8 + rr;
                v4u v = (v4u){0u, 0u, 0u, 0u};
                if (t >= bstart && t < bstart + SEQ) v = *(const v4u*)(PBF + (size_t)t * 512 + g * 128 + ch * 8);
                *(LAS v4u*)(ptile + rr * RS + ch * 16) = v; }
            __syncthreads();
            { const int cp = F.tid & 63, sg = F.tid >> 6, w = 2 << g, hw = w >> 1;
              const LAS unsigned char* col = ptile + cp * 4;
              float s0 = 0.f, s1 = 0.f;
              const int tl0 = sg * 16;
              for (int rr = tl0 + 8 - hw; rr < tl0 + 8 + hw; ++rr) { const unsigned u = *(const LAS unsigned*)(col + rr * RS); s0 += bflo(u); s1 += bfhi(u); }
#pragma unroll 4
              for (int i = 0; i < 16; ++i) { const int tl = tl0 + i, sp = (tok0 + tl) & (SEQ - 1);
                  const int cnt = min(sp + hw, SEQ) - max(sp - hw, 0); const float inv = 1.0f / (float)cnt;
                  const unsigned self = *(const LAS unsigned*)(col + (tl + 8) * RS);
                  *(LAS unsigned*)(atile + tl * RS + cp * 4) = pk2(s0 * inv - bflo(self), s1 * inv - bfhi(self));
                  const unsigned un = *(const LAS unsigned*)(col + (tl + 8 + hw) * RS), uo = *(const LAS unsigned*)(col + (tl + 8 - hw) * RS);
                  s0 += bflo(un) - bflo(uo); s1 += bfhi(un) - bfhi(uo); } }
            __syncthreads();
            { const int tb = F.wave >> 1, dt0 = (F.wave & 1) * 2;
              f32x16 acc[2];
#pragma unroll
              for (int j = 0; j < 2; ++j)
#pragma unroll
                  for (int i = 0; i < 16; ++i) acc[j][i] = 0.f;
#pragma unroll
              for (int ks = 0; ks < 8; ++ks) {
                  const s16x8 bfr = *(const LAS s16x8*)(atile + (32 * tb + ql) * RS + (16 * ks + 8 * hh) * 2);
#pragma unroll
                  for (int j = 0; j < 2; ++j) { const s16x8 afr = *(const s16x8*)(PW + (size_t)g * 16384 + (32 * (dt0 + j) + ql) * 128 + 16 * ks + 8 * hh);
                      acc[j] = MFMA32(afr, bfr, acc[j]); } }
              bf16* orow = MIX + (size_t)(tok0 + 32 * tb + ql) * DM + g * 128 + 4 * hh;
#pragma unroll
              for (int j = 0; j < 2; ++j)
#pragma unroll
                  for (int q = 0; q < 4; ++q) { const int d = 32 * (dt0 + j) + 8 * q; const f32x4 sc = *(const f32x4*)(pool_scale + g * 128 + d + 4 * hh);
                      v2u wv; wv.x = pk2(acc[j][4 * q] * sc.x, acc[j][4 * q + 1] * sc.y); wv.y = pk2(acc[j][4 * q + 2] * sc.z, acc[j][4 * q + 3] * sc.w);
                      *(v2u*)(orow + d) = wv; } }
            __syncthreads();
        }
    }
}
DI void pool_naive(Frame& F) {
    const bf16* PBF = (const bf16*)(F.ws + WS_PB); bf16* MIX = (bf16*)(F.ws + WS_MIX); bf16* PO = (bf16*)(F.ws + WS_POOLED);
    const float* pool_w = F.in[8]; const float* pool_scale = F.in[9];
    for (int tile = F.vcu; tile < NTOK / 128; tile += F.G) {
        const int tok0 = tile * 128;
        for (int it = F.tid; it < 128 * 64; it += 512) {
            const int t = tok0 + (it >> 6), ch = (it & 63) * 8, g = ch >> 7, w = 2 << g, s = t & (SEQ - 1), tb = t - s;
            const int lo = max(s - w / 2, 0), hi = min(s + w / 2, SEQ);
            float acc[8];
#pragma unroll
            for (int i = 0; i < 8; ++i) acc[i] = 0.f;
            for (int p = lo; p < hi; ++p) { const v4u v = *(const v4u*)(PBF + (size_t)(tb + p) * 512 + ch);
                acc[0] += bflo(v.x); acc[1] += bfhi(v.x); acc[2] += bflo(v.y); acc[3] += bfhi(v.y); acc[4] += bflo(v.z); acc[5] += bfhi(v.z); acc[6] += bflo(v.w); acc[7] += bfhi(v.w); }
            const float inv = 1.0f / (float)(hi - lo);
            const v4u sv = *(const v4u*)(PBF + (size_t)t * 512 + ch);
            v4u wv; wv.x = pk2(acc[0] * inv - bflo(sv.x), acc[1] * inv - bfhi(sv.x)); wv.y = pk2(acc[2] * inv - bflo(sv.y), acc[3] * inv - bfhi(sv.y));
            wv.z = pk2(acc[4] * inv - bflo(sv.z), acc[5] * inv - bfhi(sv.z)); wv.w = pk2(acc[6] * inv - bflo(sv.w), acc[7] * inv - bfhi(sv.w));
            *(v4u*)(PO + (size_t)t * 512 + ch) = wv;
        }
        VM_WAIT(); __syncthreads();
        for (int it = F.wave; it < 1024; it += 8) {
            const int t = tok0 + (it >> 3), g = (it >> 1) & 3, d = (it & 1) * 64 + F.lane;
            const bf16* pr = PO + (size_t)t * 512 + g * 128; const float* wp = pool_w + g * 16384 + d;
            float acc = 0.f;
            for (int c8 = 0; c8 < 16; ++c8) { const v4u pv = *(const v4u*)(pr + c8 * 8); const float* w8 = wp + c8 * 8 * 128;
                acc += bflo(pv.x) * w8[0] + bfhi(pv.x) * w8[128] + bflo(pv.y) * w8[256] + bfhi(pv.y) * w8[384] + bflo(pv.z) * w8[512] + bfhi(pv.z) * w8[640] + bflo(pv.w) * w8[768] + bfhi(pv.w) * w8[896]; }
            MIX[(size_t)t * DM + g * 128 + d] = (bf16)f2bf(acc * pool_scale[g * 128 + d]);
        }
        __syncthreads();
    }
}

DI void peer_topk_naive(Frame& F, int tok0) {
    const bf16* Q = (const bf16*)(F.ws + WS_ZX); const float* keys = F.in[14]; float* LISTS = (float*)(F.ws + WS_LISTS);
    int* EXPERTS = (int*)(F.ws + WS_EXP); float* GATES = (float*)(F.ws + WS_GATE);
    for (int it = F.wave; it < 32; it += 8) {
        const int hp = it & 15, t = tok0 + (it >> 4) * 64 + F.lane;
        float q[128];
        { const v4u* qp = (const v4u*)(Q + (size_t)t * 2048 + hp * 128);
#pragma unroll
          for (int cc = 0; cc < 16; ++cc) { const v4u qv = qp[cc];
              q[8 * cc + 0] = bflo(qv.x); q[8 * cc + 1] = bfhi(qv.x); q[8 * cc + 2] = bflo(qv.y); q[8 * cc + 3] = bfhi(qv.y);
              q[8 * cc + 4] = bflo(qv.z); q[8 * cc + 5] = bfhi(qv.z); q[8 * cc + 6] = bflo(qv.w); q[8 * cc + 7] = bfhi(qv.w); } }
        float top[16];
#pragma unroll
        for (int i = 0; i < 16; ++i) top[i] = -INFINITY;
        const float* kb = keys + (size_t)hp * 16384;
        for (int n = 0; n < 128; ++n) {
            const f32x4* kr = (const f32x4*)(kb + n * 128);
            float acc = 0.f;
#pragma unroll
            for (int cc = 0; cc < 32; ++cc) { const f32x4 kv = kr[cc]; acc += q[4 * cc] * kv.x + q[4 * cc + 1] * kv.y + q[4 * cc + 2] * kv.z + q[4 * cc + 3] * kv.w; }
            float v = __uint_as_float((__float_as_uint(acc) & ~127u) | (unsigned)n);
#pragma unroll
            for (int i = 0; i < 16; ++i) { const float hi = fmaxf(top[i], v); v = fminf(top[i], v); top[i] = hi; }
        }
        f32x4* lp = (f32x4*)(LISTS + ((size_t)t * 16 + hp) * 16);
#pragma unroll
        for (int i = 0; i < 4; ++i) lp[i] = (f32x4){top[4 * i], top[4 * i + 1], top[4 * i + 2], top[4 * i + 3]};
    }
    VM_WAIT(); __syncthreads();
    for (int it = F.tid; it < 128 * 8; it += 512) {
        const int t = tok0 + (it >> 3), h = it & 7;
        float v0[16], v1[16]; int i0[16], i1[16];
        const f32x4* l0 = (const f32x4*)(LISTS + ((size_t)t * 16 + h * 2) * 16);
#pragma unroll
        for (int i = 0; i < 4; ++i) { const f32x4 a = l0[i], b = l0[4 + i];
#pragma unroll
            for (int e = 0; e < 4; ++e) { const unsigned ua = __float_as_uint(a[e]), ub = __float_as_uint(b[e]);
                v0[4 * i + e] = __uint_as_float(ua & ~127u); i0[4 * i + e] = (int)(ua & 127u); v1[4 * i + e] = __uint_as_float(ub & ~127u); i1[4 * i + e] = (int)(ub & 127u); } }
        float tv[16]; int ti[16];
#pragma unroll
        for (int i = 0; i < 16; ++i) { tv[i] = -INFINITY; ti[i] = 0; }
#pragma unroll
        for (int i = 0; i < 16; ++i)
#pragma unroll
            for (int j = 0; j < 16; ++j) if ((i + 1) * (j + 1) <= 16) {
                float cv = v0[i] + v1[j]; int ci = i0[i] * 128 + i1[j];
#pragma unroll
                for (int k = 0; k < 16; ++k) { const bool gt = cv > tv[k]; const float nv = gt ? cv : tv[k]; const int ni = gt ? ci : ti[k]; cv = gt ? tv[k] : cv; ci = gt ? ti[k] : ci; tv[k] = nv; ti[k] = ni; }
            }
        float e[16], sum = 0.f;
#pragma unroll
        for (int k = 0; k < 16; ++k) { e[k] = __expf(tv[k] - tv[0]); sum += e[k]; }
        const float is = 1.0f / sum;
        int* ep = EXPERTS + (size_t)t * 128 + h * 16; float* gp = GATES + (size_t)t * 128 + h * 16;
#pragma unroll
        for (int k = 0; k < 16; ++k) { ep[k] = ti[k]; gp[k] = e[k] * is; }
    }
    VM_WAIT(); __syncthreads();
}

DI int f2key(float f) { const int b = __float_as_int(f); return b ^ ((b >> 31) & 0x7fffffff); }
DI float key2f(int k) { return __int_as_float(k ^ ((k >> 31) & 0x7fffffff)); }
DI void ce_desc(int& x, int& y) { const int hi = max(x, y), lo = min(x, y); x = hi; y = lo; }
DI void sort16_desc(int (&a)[16]) {
#pragma unroll
    for (int k = 2; k <= 16; k <<= 1)
#pragma unroll
        for (int j = k >> 1; j > 0; j >>= 1)
#pragma unroll
            for (int i = 0; i < 16; ++i) { const int l = i ^ j; if (l > i) { if ((i & k) == 0) ce_desc(a[i], a[l]); else ce_desc(a[l], a[i]); } }
}
DI void merge16_desc(int (&a)[16], const int (&b)[16]) {
#pragma unroll
    for (int i = 0; i < 16; ++i) a[i] = max(a[i], b[15 - i]);
#pragma unroll
    for (int j = 8; j > 0; j >>= 1)
#pragma unroll
        for (int i = 0; i < 16; ++i) if ((i & j) == 0) ce_desc(a[i], a[i + j]);
}
DI void peer_topk_mfma(Frame& F, int tile) {
    const bf16* QP = (const bf16*)(F.ws + WS_ZX); const bf16* KEYF = (const bf16*)(F.ws + WS_KEYS);
    int* EXPERTS = (int*)(F.ws + WS_EXP); float* GATES = (float*)(F.ws + WS_GATE);
    const int lane = F.lane, hh = lane >> 5, ql = lane & 31, tb = F.wave >> 1, p = F.wave & 1;
    const int tokblk = tile * 4 + tb, tok = tokblk * 32 + ql;
#pragma unroll 1
    for (int h = 0; h < 8; ++h) {
        const int hp = 2 * h + p;
        s16x8 qf[8];
#pragma unroll
        for (int ks = 0; ks < 8; ++ks) qf[ks] = ((const s16x8*)(QP + ((size_t)tokblk * 16 + hp) * 4096))[ks * 64 + lane];
        const s16x8* kfp = (const s16x8*)(KEYF + (size_t)hp * 16384) + lane;
        int top[16];
#pragma unroll
        for (int i = 0; i < 16; ++i) top[i] = (int)0x80000000;
#pragma unroll 1
        for (int nt = 0; nt < 4; ++nt) {
            f32x16 acc;
#pragma unroll
            for (int i = 0; i < 16; ++i) acc[i] = 0.f;
#pragma unroll
            for (int ks = 0; ks < 8; ++ks) acc = MFMA32(kfp[(nt * 8 + ks) * 64], qf[ks], acc);
            int a[16];
#pragma unroll
            for (int i = 0; i < 16; ++i) { const int n = 32 * nt + (i & 3) + 8 * (i >> 2) + 4 * hh; a[i] = f2key(__int_as_float((__float_as_int(acc[i]) & ~127) | n)); }
            sort16_desc(a);
            merge16_desc(top, a);
        }
        { int oth[16];
#pragma unroll
          for (int i = 0; i < 16; ++i) oth[i] = __shfl_xor(top[i], 32);
          merge16_desc(top, oth); }
        LAS float* L = (LAS float*)(F.lds) + (h & 1) * 4096 + (tb * 2) * 512;
        if (hh == 0) {
#pragma unroll
            for (int i = 0; i < 16; ++i) L[p * 512 + i * 32 + ql] = key2f(top[i]);
        }
        __syncthreads();
        if (p == 0 && hh == 0) {
            float v0[16], v1[16];
#pragma unroll
            for (int i = 0; i < 16; ++i) { v0[i] = __int_as_float(__float_as_int(L[i * 32 + ql]) & ~127); v1[i] = __int_as_float(__float_as_int(L[512 + i * 32 + ql]) & ~127); }
            int grp[4][16]; int cnt = 0;
#pragma unroll
            for (int g = 0; g < 4; ++g)
#pragma unroll
                for (int i = 0; i < 16; ++i) grp[g][i] = (int)0x80000000;
#pragma unroll
            for (int i = 0; i < 16; ++i)
#pragma unroll
                for (int j = 0; j < 16; ++j) if ((i + 1) * (j + 1) <= 16) {
                    grp[cnt >> 4][cnt & 15] = f2key(__int_as_float((__float_as_int(v0[i] + v1[j]) & ~255) | (i * 16 + j))); ++cnt; }
#pragma unroll
            for (int g = 0; g < 4; ++g) sort16_desc(grp[g]);
            merge16_desc(grp[0], grp[1]); merge16_desc(grp[2], grp[3]); merge16_desc(grp[0], grp[2]);
            float tv[16]; float e[16]; float sum = 0.f; int eid[16];
#pragma unroll
            for (int k = 0; k < 16; ++k) { const int bits = __float_as_int(key2f(grp[0][k])); const int code = bits & 255; tv[k] = __int_as_float(bits & ~255);
                const int n0 = __float_as_int(L[(code >> 4) * 32 + ql]) & 127, n1 = __float_as_int(L[512 + (code & 15) * 32 + ql]) & 127; eid[k] = n0 * 128 + n1; }
#pragma unroll
            for (int k = 0; k < 16; ++k) { e[k] = __expf(tv[k] - tv[0]); sum += e[k]; }
            const float is = 1.0f / sum;
            int* ep = EXPERTS + (size_t)tok * 128 + h * 16; float* gp = GATES + (size_t)tok * 128 + h * 16;
#pragma unroll
            for (int k4 = 0; k4 < 4; ++k4) { *(v4u*)(ep + 4 * k4) = (v4u){(unsigned)eid[4 * k4], (unsigned)eid[4 * k4 + 1], (unsigned)eid[4 * k4 + 2], (unsigned)eid[4 * k4 + 3]};
                *(f32x4*)(gp + 4 * k4) = (f32x4){e[4 * k4] * is, e[4 * k4 + 1] * is, e[4 * k4 + 2] * is, e[4 * k4 + 3] * is}; }
        }
    }
    VM_WAIT(); __syncthreads();
}

DI float gelu_fast(float v) {
    const float av = fabsf(v), t = __builtin_amdgcn_rcpf(av * 0.2316418882f + 1.0f);
    float q = t * 0.5307027145f + (-0.7265760135f); q = q * t + 0.7107068705f; q = q * t + (-0.142248368f); q = q * t + 0.127414796f; q = q * t;
    const float e = __builtin_amdgcn_exp2f((v * v) * (-0.72134752044f));
    const float m = v * (q * e);
    return v < 0.f ? m : v - m;
}
DI float gelu_exact(float a) { return 0.5f * a * (1.0f + erff(a * 0.70710678118654752f)); }

DI void fp8x16_to_f32(const v4u r, float (&f)[16]) {
#pragma unroll
    for (int j = 0; j < 4; ++j) { const f32x2 lo = __builtin_amdgcn_cvt_pk_f32_fp8((int)r[j], false), hi = __builtin_amdgcn_cvt_pk_f32_fp8((int)r[j], true);
        f[4 * j] = lo.x; f[4 * j + 1] = lo.y; f[4 * j + 2] = hi.x; f[4 * j + 3] = hi.y; }
}
typedef __bf16 bf16x2v __attribute__((ext_vector_type(2)));
#ifndef G2_NOSORT
#define G2_NOSORT 0
#endif
#define TOK_CASE(JV, BODY) { constexpr int j = JV; BODY }
#define TOK_DISPATCHN(tk, BODY) do { if constexpr (NT == 1) TOK_CASE(0, BODY) else if constexpr (NT == 2) { if ((tk) < 1) TOK_CASE(0, BODY) else TOK_CASE(1, BODY) } \
    else { if ((tk) < 2) { if ((tk) < 1) TOK_CASE(0, BODY) else TOK_CASE(1, BODY) } else { if ((tk) < 3) TOK_CASE(2, BODY) else TOK_CASE(NT > 3 ? 3 : 0, BODY) } } } while (0)
template <int NT, bool FAKE = false> DI void gather_round(Frame& F, int tbase, volatile LAS int* prog, int pbase) {
    constexpr int NK = 2 * NT, N = 128 * NT, NB = N / 8, LPB = 8 / NK;
    const bf16* H2 = (const bf16*)(F.ws + WS_HX); const unsigned char* U = F.ws + WS_U; const unsigned char* V = F.ws + WS_V;
    const int* EXPERTS = (const int*)(F.ws + WS_EXP); const float* GATES = (const float*)(F.ws + WS_GATE); const float* MOD = (const float*)(F.ws + WS_MOD);
    const int lane = F.lane;
    int key[NK];
#pragma unroll
    for (int j = 0; j < NT; ++j)
#pragma unroll
        for (int hf = 0; hf < 2; ++hf) { const int k = hf * 64 + lane; key[j * 2 + hf] = (EXPERTS[(size_t)(tbase + j) * 128 + k] << 9) | (j << 7) | k; }
#pragma unroll
    for (int k = 2; k <= (G2_NOSORT ? 1 : N); k <<= 1)
#pragma unroll
        for (int j = k >> 1; j > 0; j >>= 1) {
            if (j < NK) {
#pragma unroll
                for (int r = 0; r < NK; ++r) if ((r & j) == 0) { const bool asc = (((lane * NK + r) & k) == 0); const int x = key[r], y = key[r | j], lo = min(x, y), hi = max(x, y);
                    key[r] = asc ? lo : hi; key[r | j] = asc ? hi : lo; }
            } else {
                const bool asc = (((lane * NK) & k) == 0), lower = ((lane & (j / NK)) == 0), takemin = (asc == lower);
#pragma unroll
                for (int r = 0; r < NK; ++r) { const int o = __shfl_xor(key[r], j / NK); key[r] = takemin ? min(key[r], o) : max(key[r], o); }
            }
        }
    LAS v4u* hL = (LAS v4u*)(F.lds + 98304) + F.wave * (NT * 64) + lane;
    float hsc[NT]; float out[NT][16];
#pragma unroll
    for (int j = 0; j < NT; ++j) { const v4u a = *((const v4u*)(H2 + (size_t)(tbase + j) * DM + lane * 16)), b = *((const v4u*)(H2 + (size_t)(tbase + j) * DM + lane * 16 + 8));
        float hv[16]; hv[0] = bflo(a.x); hv[1] = bfhi(a.x); hv[2] = bflo(a.y); hv[3] = bfhi(a.y); hv[4] = bflo(a.z); hv[5] = bfhi(a.z); hv[6] = bflo(a.w); hv[7] = bfhi(a.w);
        hv[8] = bflo(b.x); hv[9] = bfhi(b.x); hv[10] = bflo(b.y); hv[11] = bfhi(b.y); hv[12] = bflo(b.z); hv[13] = bfhi(b.z); hv[14] = bflo(b.w); hv[15] = bfhi(b.w);
        float am = 0.f;
#pragma unroll
        for (int i = 0; i < 16; ++i) am = fmaxf(am, fabsf(hv[i]));
#pragma unroll
        for (int o = 1; o < 64; o <<= 1) am = fmaxf(am, __shfl_xor(am, o));
        am = fmaxf(am, 1e-30f); hsc[j] = am * (1.0f / 127.0f);
        const float inv = 127.0f / am;
        v4u hq;
#pragma unroll
        for (int d = 0; d < 4; ++d) { const int q0 = (int)rintf(hv[4 * d] * inv), q1 = (int)rintf(hv[4 * d + 1] * inv), q2 = (int)rintf(hv[4 * d + 2] * inv), q3 = (int)rintf(hv[4 * d + 3] * inv);
            hq[d] = (unsigned)(q0 & 255) | ((unsigned)(q1 & 255) << 8) | ((unsigned)(q2 & 255) << 16) | ((unsigned)(q3 & 255) << 24); }
        hL[j * 64] = hq;
#pragma unroll
        for (int i = 0; i < 16; ++i) out[j][i] = 0.f; }
    LAS float* sgL = (LAS float*)(F.lds + 65536) + F.wave * (2 * N); LAS float* suL = sgL + N;
    const float* SU = (const float*)(F.ws + WS_SU);
#pragma unroll
    for (int r = 0; r < NK; ++r) { const int tj = (key[r] >> 7) & 3; float sc = hsc[0];
#pragma unroll
        for (int j = 1; j < NT; ++j) sc = (tj == j) ? hsc[j] : sc;
        sgL[lane * NK + r] = GATES[(size_t)(tbase + tj) * 128 + (key[r] & 127)]; suL[lane * NK + r] = SU[(key[r] >> 9) & (FAKE ? 7 : 16383)] * sc; }
    v4u ucur[8];
#pragma unroll
    for (int r = 0; r < 8; ++r) { const int kk = __builtin_amdgcn_readlane(key[r % NK], r / NK); ucur[r] = *((const v4u*)(U + (size_t)((kk >> 9) & (FAKE ? 7 : 16383)) * 1024) + lane); }
#pragma unroll 1
    for (int b = 0; b < NB; ++b) {
        int kk[8]; v4u vcur[8];
#pragma unroll
        for (int r = 0; r < 8; ++r) { kk[r] = __builtin_amdgcn_readlane(key[r % NK], b * LPB + r / NK); vcur[r] = *((const v4u*)(V + (size_t)((kk[r] >> 9) & (FAKE ? 7 : 16383)) * 1024) + lane); }
        int p[8]; v4u hsel[8];
#pragma unroll
        for (int r = 0; r < 8; ++r) { hsel[r] = hL[((kk[r] >> 7) & 3) * 64]; p[r] = 0; }
#pragma unroll
        for (int q = 0; q < 4; ++q)
#pragma unroll
            for (int r = 0; r < 8; ++r) p[r] = __builtin_amdgcn_sdot4((int)ucur[r][q], (int)hsel[r][q], p[r], false);
        { const int bn = (b + 1 < NB) ? b + 1 : 0;
#pragma unroll
          for (int r = 0; r < 8; ++r) { const int kn = __builtin_amdgcn_readlane(key[r % NK], bn * LPB + r / NK); ucur[r] = *((const v4u*)(U + (size_t)((kn >> 9) & (FAKE ? 7 : 16383)) * 1024) + lane); } }
        int psum;
        { int q4[4];
#pragma unroll
          for (int i = 0; i < 4; ++i) { auto rr = __builtin_amdgcn_permlane32_swap((unsigned)p[i], (unsigned)p[i + 4], false, false); q4[i] = (int)(rr[0] + rr[1]); }
          int q2[2];
#pragma unroll
          for (int i = 0; i < 2; ++i) { auto rr = __builtin_amdgcn_permlane16_swap((unsigned)q4[i], (unsigned)q4[i + 2], false, false); q2[i] = (int)(rr[0] + rr[1]); }
          const int t0 = q2[0] + __builtin_amdgcn_update_dpp(0, q2[0], 0x128, 0xf, 0xf, false);
          const int t1 = q2[1] + __builtin_amdgcn_update_dpp(0, q2[1], 0x128, 0xf, 0xf, false);
          int v = (lane & 8) ? t1 : t0;
          v += __builtin_amdgcn_update_dpp(0, v, 0x141, 0xf, 0xf, false);
          v += __builtin_amdgcn_update_dpp(0, v, 0x4e, 0xf, 0xf, false);
          v += __builtin_amdgcn_update_dpp(0, v, 0xb1, 0xf, 0xf, false);
          psum = v; }
        const float w = sgL[b * 8 + ((lane >> 3) & 7)] * gelu_fast((float)psum * suL[b * 8 + ((lane >> 3) & 7)]);
#pragma unroll
        for (int r = 0; r < 8; ++r) { const float wr = __builtin_bit_cast(float, __builtin_amdgcn_readlane(__builtin_bit_cast(int, w), r * 8)); float f[16]; fp8x16_to_f32(vcur[r], f);
            const int tk = (kk[r] >> 7) & 3;
#pragma unroll
            for (int j = 0; j < NT; ++j) if (tk == j) {
#pragma unroll
                for (int i = 0; i < 16; ++i) out[j][i] += wr * f[i]; } }
    }
    const float* fg = F.in[17];
#pragma unroll
    for (int j = 0; j < NT; ++j) {
        const int t = tbase + j, bb = t >> 12; const float* g2 = MOD + bb * NMOD + 5 * DM; float* xo = F.out + (size_t)t * DM;
        const bf16* x1r = (const bf16*)(F.ws + WS_X1) + (size_t)t * DM + lane * 16;
        float x2[16]; float ss = 0.f;
#pragma unroll
        for (int hq = 0; hq < 4; ++hq) { const int c = lane * 16 + hq * 4; const v2u xw = *(const v2u*)(x1r + hq * 4); const f32x4 xv = (f32x4){bflo(xw.x), bfhi(xw.x), bflo(xw.y), bfhi(xw.y)}, gv = *(const f32x4*)(g2 + c);
#pragma unroll
            for (int e = 0; e < 4; ++e) { const float y = xv[e] + gv[e] * (out[j][hq * 4 + e] * (1.0f / V_SCALE)); x2[hq * 4 + e] = y; ss += y * y; } }
        const float rinv = 1.0f / sqrtf(wave_sum(ss) * (1.f / DM) + EPS);
#pragma unroll
        for (int hq = 0; hq < 4; ++hq) { const int c = lane * 16 + hq * 4; const f32x4 fv = *(const f32x4*)(fg + c);
            f32x4 y;
#pragma unroll
            for (int e = 0; e < 4; ++e) y[e] = x2[hq * 4 + e] * rinv * fv[e];
            if (!FAKE || rinv == 12345.678f) *(f32x4*)(xo + c) = y; }
    }
}

template <bool FAKE = false> DI void gather_ts(Frame& F, int tbase) {
    constexpr int NT = 4;
    const bf16* H2 = (const bf16*)(F.ws + WS_HX); const unsigned char* U = F.ws + WS_U; const unsigned char* V = F.ws + WS_V;
    const int* EXPERTS = (const int*)(F.ws + WS_EXP); const float* GATES = (const float*)(F.ws + WS_GATE); const float* MOD = (const float*)(F.ws + WS_MOD);
    const float* SU = (const float*)(F.ws + WS_SU);
    const int lane = F.lane; const unsigned ul = (unsigned)F.lane;
    constexpr int EMASK = FAKE ? 7 : 16383;
    int key[NT][2];
#pragma unroll
    for (int j = 0; j < NT; ++j) {
#pragma unroll
        for (int r = 0; r < 2; ++r) { const int k = r * 64 + lane; key[j][r] = (EXPERTS[(size_t)(tbase + j) * 128 + k] << 7) | k; }
#pragma unroll
        for (int k = 2; k <= 128; k <<= 1)
#pragma unroll
            for (int jj = k >> 1; jj > 0; jj >>= 1) {
                if (jj < 2) { const bool asc = (((lane * 2) & k) == 0); const int x = key[j][0], y = key[j][1], lo = min(x, y), hi = max(x, y); key[j][0] = asc ? lo : hi; key[j][1] = asc ? hi : lo; }
                else { const bool asc = (((lane * 2) & k) == 0), lower = ((lane & (jj / 2)) == 0), takemin = (asc == lower);
#pragma unroll
                    for (int r = 0; r < 2; ++r) { const int o = __shfl_xor(key[j][r], jj / 2); key[j][r] = takemin ? min(key[j][r], o) : max(key[j][r], o); } }
            }
    }
    unsigned hsq[NT][4]; float hsc[NT]; float out[NT][16];
#pragma unroll
    for (int j = 0; j < NT; ++j) { const v4u a = *((const v4u*)(H2 + (size_t)(tbase + j) * DM + lane * 16)), b = *((const v4u*)(H2 + (size_t)(tbase + j) * DM + lane * 16 + 8));
        float hv[16]; hv[0] = bflo(a.x); hv[1] = bfhi(a.x); hv[2] = bflo(a.y); hv[3] = bfhi(a.y); hv[4] = bflo(a.z); hv[5] = bfhi(a.z); hv[6] = bflo(a.w); hv[7] = bfhi(a.w);
        hv[8] = bflo(b.x); hv[9] = bfhi(b.x); hv[10] = bflo(b.y); hv[11] = bfhi(b.y); hv[12] = bflo(b.z); hv[13] = bfhi(b.z); hv[14] = bflo(b.w); hv[15] = bfhi(b.w);
        float am = 0.f;
#pragma unroll
        for (int i = 0; i < 16; ++i) am = fmaxf(am, fabsf(hv[i]));
#pragma unroll
        for (int o = 1; o < 64; o <<= 1) am = fmaxf(am, __shfl_xor(am, o));
        am = fmaxf(am, 1e-30f); hsc[j] = am * (1.0f / 127.0f);
        const float inv = 127.0f / am;
#pragma unroll
        for (int d = 0; d < 4; ++d) { const int q0 = (int)rintf(hv[4 * d] * inv), q1 = (int)rintf(hv[4 * d + 1] * inv), q2 = (int)rintf(hv[4 * d + 2] * inv), q3 = (int)rintf(hv[4 * d + 3] * inv);
            hsq[j][d] = (unsigned)(q0 & 255) | ((unsigned)(q1 & 255) << 8) | ((unsigned)(q2 & 255) << 16) | ((unsigned)(q3 & 255) << 24); }
#pragma unroll
        for (int i = 0; i < 16; ++i) out[j][i] = 0.f; }
    LAS float* sgL = (LAS float*)(F.lds + 65536) + F.wave * 1024; LAS float* suL = sgL + 512;
#pragma unroll
    for (int j = 0; j < NT; ++j)
#pragma unroll
        for (int r = 0; r < 2; ++r) { sgL[j * 128 + lane * 2 + r] = GATES[(size_t)(tbase + j) * 128 + (key[j][r] & 127)]; suL[j * 128 + lane * 2 + r] = SU[(key[j][r] >> 7) & EMASK] * hsc[j]; }
    v4u ucur[8];
#pragma unroll
    for (int r = 0; r < 8; ++r) ucur[r] = *((const v4u*)(U + (size_t)((__builtin_amdgcn_readlane(key[0][r & 1], r >> 1) >> 7) & EMASK) * 1024) + ul);
#pragma unroll 1
    for (int b = 0; b < 16; ++b) {
#pragma unroll
        for (int j = 0; j < NT; ++j) {
            v4u vcur[8];
#pragma unroll
            for (int r = 0; r < 8; ++r) vcur[r] = *((const v4u*)(V + (size_t)((__builtin_amdgcn_readlane(key[j][r & 1], b * 4 + (r >> 1)) >> 7) & EMASK) * 1024) + ul);
            int p[8];
#pragma unroll
            for (int r = 0; r < 8; ++r) { int acc = 0;
#pragma unroll
                for (int q = 0; q < 4; ++q) acc = __builtin_amdgcn_sdot4((int)ucur[r][q], (int)hsq[j][q], acc, false);
                p[r] = acc; }
            { const int jn = (j + 1) & 3; const int bn = (j == 3) ? ((b + 1) & 15) : b;
#pragma unroll
              for (int r = 0; r < 8; ++r) ucur[r] = *((const v4u*)(U + (size_t)((__builtin_amdgcn_readlane(key[jn][r & 1], bn * 4 + (r >> 1)) >> 7) & EMASK) * 1024) + ul); }
            int psum;
            { int q4[4];
#pragma unroll
              for (int i = 0; i < 4; ++i) { auto rr = __builtin_amdgcn_permlane32_swap((unsigned)p[i], (unsigned)p[i + 4], false, false); q4[i] = (int)(rr[0] + rr[1]); }
              int q2[2];
#pragma unroll
              for (int i = 0; i < 2; ++i) { auto rr = __builtin_amdgcn_permlane16_swap((unsigned)q4[i], (unsigned)q4[i + 2], false, false); q2[i] = (int)(rr[0] + rr[1]); }
              const int t0 = q2[0] + __builtin_amdgcn_update_dpp(0, q2[0], 0x128, 0xf, 0xf, false);
              const int t1 = q2[1] + __builtin_amdgcn_update_dpp(0, q2[1], 0x128, 0xf, 0xf, false);
              int v = (lane & 8) ? t1 : t0;
              v += __builtin_amdgcn_update_dpp(0, v, 0x141, 0xf, 0xf, false);
              v += __builtin_amdgcn_update_dpp(0, v, 0x4e, 0xf, 0xf, false);
              v += __builtin_amdgcn_update_dpp(0, v, 0xb1, 0xf, 0xf, false);
              psum = v; }
            const int pos = j * 128 + b * 8 + ((lane >> 3) & 7);
            const float w = sgL[pos] * gelu_fast((float)psum * suL[pos]);
#pragma unroll
            for (int r = 0; r < 8; ++r) { const float wr = __builtin_bit_cast(float, __builtin_amdgcn_readlane(__builtin_bit_cast(int, w), r * 8));
#pragma unroll
                for (int q = 0; q < 4; ++q) { const f32x2 lo = __builtin_amdgcn_cvt_pk_f32_fp8((int)vcur[r][q], false), hi = __builtin_amdgcn_cvt_pk_f32_fp8((int)vcur[r][q], true);
                    out[j][4 * q] += wr * lo.x; out[j][4 * q + 1] += wr * lo.y; out[j][4 * q + 2] += wr * hi.x; out[j][4 * q + 3] += wr * hi.y; } }
            __builtin_amdgcn_sched_barrier(0);
        }
    }
    const float* fg = F.in[17];
#pragma unroll
    for (int j = 0; j < NT; ++j) {
        const int t = tbase + j, bb = t >> 12; const float* g2 = MOD + bb * NMOD + 5 * DM; float* xo = F.out + (size_t)t * DM;
        const bf16* x1r = (const bf16*)(F.ws + WS_X1) + (size_t)t * DM + lane * 16;
        float x2[16]; float ss = 0.f;
#pragma unroll
        for (int hq = 0; hq < 4; ++hq) { const int c = lane * 16 + hq * 4; const v2u xw = *(const v2u*)(x1r + hq * 4); const f32x4 xv = (f32x4){bflo(xw.x), bfhi(xw.x), bflo(xw.y), bfhi(xw.y)}, gv = *(const f32x4*)(g2 + c);
#pragma unroll
            for (int e = 0; e < 4; ++e) { const float y = xv[e] + gv[e] * (out[j][hq * 4 + e] * (1.0f / V_SCALE)); x2[hq * 4 + e] = y; ss += y * y; } }
        const float rinv = 1.0f / sqrtf(wave_sum(ss) * (1.f / DM) + EPS);
#pragma unroll
        for (int hq = 0; hq < 4; ++hq) { const int c = lane * 16 + hq * 4; const f32x4 fv = *(const f32x4*)(fg + c);
            f32x4 y;
#pragma unroll
            for (int e = 0; e < 4; ++e) y[e] = x2[hq * 4 + e] * rinv * fv[e];
            if (!FAKE || rinv == 12345.678f) *(f32x4*)(xo + c) = y; }
    }
}

template <bool FAKE = false> DI void gather_ts2(Frame& F, int tbase) {
    constexpr int NT = 2;
    const bf16* H2 = (const bf16*)(F.ws + WS_HX); const unsigned char* U = F.ws + WS_U; const unsigned char* V = F.ws + WS_V;
    const int* EXPERTS = (const int*)(F.ws + WS_EXP); const float* GATES = (const float*)(F.ws + WS_GATE); const float* MOD = (const float*)(F.ws + WS_MOD);
    const float* SU = (const float*)(F.ws + WS_SU);
    int lane = F.lane; asm volatile("" : "+v"(lane));
    const unsigned ul = (unsigned)lane;
    constexpr int EMASK = FAKE ? 7 : 16383;
    int key[NT][2];
#pragma unroll
    for (int j = 0; j < NT; ++j) {
#pragma unroll
        for (int r = 0; r < 2; ++r) { const int k = r * 64 + lane; key[j][r] = (EXPERTS[(size_t)(tbase + j) * 128 + k] << 7) | k; }
#pragma unroll
        for (int k = 2; k <= 128; k <<= 1)
#pragma unroll
            for (int jj = k >> 1; jj > 0; jj >>= 1) {
                if (jj < 2) { const bool asc = (((lane * 2) & k) == 0); const int x = key[j][0], y = key[j][1], lo = min(x, y), hi = max(x, y); key[j][0] = asc ? lo : hi; key[j][1] = asc ? hi : lo; }
                else { const bool asc = (((lane * 2) & k) == 0), lower = ((lane & (jj / 2)) == 0), takemin = (asc == lower);
#pragma unroll
                    for (int r = 0; r < 2; ++r) { const int o = __shfl_xor(key[j][r], jj / 2); key[j][r] = takemin ? min(key[j][r], o) : max(key[j][r], o); } }
            }
    }
    unsigned hsq[NT][4]; float hsc[NT]; float out[NT][16];
#pragma unroll
    for (int j = 0; j < NT; ++j) { const v4u a = *((const v4u*)(H2 + (size_t)(tbase + j) * DM + lane * 16)), b = *((const v4u*)(H2 + (size_t)(tbase + j) * DM + lane * 16 + 8));
        float hv[16]; hv[0] = bflo(a.x); hv[1] = bfhi(a.x); hv[2] = bflo(a.y); hv[3] = bfhi(a.y); hv[4] = bflo(a.z); hv[5] = bfhi(a.z); hv[6] = bflo(a.w); hv[7] = bfhi(a.w);
        hv[8] = bflo(b.x); hv[9] = bfhi(b.x); hv[10] = bflo(b.y); hv[11] = bfhi(b.y); hv[12] = bflo(b.z); hv[13] = bfhi(b.z); hv[14] = bflo(b.w); hv[15] = bfhi(b.w);
        float am = 0.f;
#pragma unroll
        for (int i = 0; i < 16; ++i) am = fmaxf(am, fabsf(hv[i]));
#pragma unroll
        for (int o = 1; o < 64; o <<= 1) am = fmaxf(am, __shfl_xor(am, o));
        am = fmaxf(am, 1e-30f); hsc[j] = am * (1.0f / 127.0f);
        const float inv = 127.0f / am;
#pragma unroll
        for (int d = 0; d < 4; ++d) { const int q0 = (int)rintf(hv[4 * d] * inv), q1 = (int)rintf(hv[4 * d + 1] * inv), q2 = (int)rintf(hv[4 * d + 2] * inv), q3 = (int)rintf(hv[4 * d + 3] * inv);
            hsq[j][d] = (unsigned)(q0 & 255) | ((unsigned)(q1 & 255) << 8) | ((unsigned)(q2 & 255) << 16) | ((unsigned)(q3 & 255) << 24); }
#pragma unroll
        for (int i = 0; i < 16; ++i) out[j][i] = 0.f; }
    LAS float* sgL = (LAS float*)(F.lds + 65536) + F.wave * 512; LAS float* suL = sgL + 256;
#pragma unroll
    for (int j = 0; j < NT; ++j)
#pragma unroll
        for (int r = 0; r < 2; ++r) { sgL[j * 128 + lane * 2 + r] = GATES[(size_t)(tbase + j) * 128 + (key[j][r] & 127)]; suL[j * 128 + lane * 2 + r] = SU[(key[j][r] >> 7) & EMASK] * hsc[j]; }
#define TS2_ROW(TBL, jj, bb, r) (*(const v4u*)((TBL) + (size_t)((__builtin_amdgcn_readlane(key[jj][(r) & 1], (bb) * 4 + ((r) >> 1)) >> 7) & EMASK) * 1024 + voff))
    unsigned voff = ul * 16u;
    v4u ub[NT][8], vb[8];
#pragma unroll
    for (int r = 0; r < 8; ++r) { ub[0][r] = TS2_ROW(U, 0, 0, r); ub[1][r] = TS2_ROW(U, 1, 0, r); vb[r] = TS2_ROW(V, 0, 0, r); }
#pragma unroll 1
    for (int b = 0; b < 16; ++b) {
        const int bn = (b + 1) & 15;
#pragma unroll
        for (int j = 0; j < NT; ++j) {
            asm volatile("" : "+v"(voff));
            int p[8];
#pragma unroll
            for (int r = 0; r < 8; ++r) { int acc = 0;
#pragma unroll
                for (int q = 0; q < 4; ++q) acc = __builtin_amdgcn_sdot4((int)ub[j][r][q], (int)hsq[j][q], acc, false);
                p[r] = acc; }
#pragma unroll
            for (int r = 0; r < 8; ++r) ub[j][r] = TS2_ROW(U, j, bn, r);
            int psum;
            { int q4[4];
#pragma unroll
              for (int i = 0; i < 4; ++i) { auto rr = __builtin_amdgcn_permlane32_swap((unsigned)p[i], (unsigned)p[i + 4], false, false); q4[i] = (int)(rr[0] + rr[1]); }
              int q2[2];
#pragma unroll
              for (int i = 0; i < 2; ++i) { auto rr = __builtin_amdgcn_permlane16_swap((unsigned)q4[i], (unsigned)q4[i + 2], false, false); q2[i] = (int)(rr[0] + rr[1]); }
              const int t0 = q2[0] + __builtin_amdgcn_update_dpp(0, q2[0], 0x128, 0xf, 0xf, false);
              const int t1 = q2[1] + __builtin_amdgcn_update_dpp(0, q2[1], 0x128, 0xf, 0xf, false);
              int v = (lane & 8) ? t1 : t0;
              v += __builtin_amdgcn_update_dpp(0, v, 0x141, 0xf, 0xf, false);
              v += __builtin_amdgcn_update_dpp(0, v, 0x4e, 0xf, 0xf, false);
              v += __builtin_amdgcn_update_dpp(0, v, 0xb1, 0xf, 0xf, false);
              psum = v; }
            const int pos = j * 128 + b * 8 + ((lane >> 3) & 7);
            const float w = sgL[pos] * gelu_fast((float)psum * suL[pos]);
#pragma unroll
            for (int r = 0; r < 8; ++r) { const float wr = __builtin_bit_cast(float, __builtin_amdgcn_readlane(__builtin_bit_cast(int, w), r * 8));
#pragma unroll
                for (int q = 0; q < 4; ++q) { const f32x2 lo = __builtin_amdgcn_cvt_pk_f32_fp8((int)vb[r][q], false), hi = __builtin_amdgcn_cvt_pk_f32_fp8((int)vb[r][q], true);
                    out[j][4 * q] += wr * lo.x; out[j][4 * q + 1] += wr * lo.y; out[j][4 * q + 2] += wr * hi.x; out[j][4 * q + 3] += wr * hi.y; }
                vb[r] = TS2_ROW(V, j ^ 1, (j == 0) ? b : bn, r); }
            __builtin_amdgcn_sched_barrier(0);
        }
    }
#undef TS2_ROW
    const float* fg = F.in[17];
#pragma unroll
    for (int j = 0; j < NT; ++j) {
        const int t = tbase + j, bb = t >> 12; const float* g2 = MOD + bb * NMOD + 5 * DM; float* xo = F.out + (size_t)t * DM;
        const bf16* x1r = (const bf16*)(F.ws + WS_X1) + (size_t)t * DM + lane * 16;
        float x2[16]; float ss = 0.f;
#pragma unroll
        for (int hq = 0; hq < 4; ++hq) { const int c = lane * 16 + hq * 4; const v2u xw = *(const v2u*)(x1r + hq * 4); const f32x4 xv = (f32x4){bflo(xw.x), bfhi(xw.x), bflo(xw.y), bfhi(xw.y)}, gv = *(const f32x4*)(g2 + c);
#pragma unroll
            for (int e = 0; e < 4; ++e) { const float y = xv[e] + gv[e] * (out[j][hq * 4 + e] * (1.0f / V_SCALE)); x2[hq * 4 + e] = y; ss += y * y; } }
        const float rinv = 1.0f / sqrtf(wave_sum(ss) * (1.f / DM) + EPS);
#pragma unroll
        for (int hq = 0; hq < 4; ++hq) { const int c = lane * 16 + hq * 4; const f32x4 fv = *(const f32x4*)(fg + c);
            f32x4 y;
#pragma unroll
            for (int e = 0; e < 4; ++e) y[e] = x2[hq * 4 + e] * rinv * fv[e];
            if (!FAKE || rinv == 12345.678f) *(f32x4*)(xo + c) = y; }
    }
}

#ifdef MB_OP
DI void mb_probe(Frame& F) {
    unsigned x[32];
#pragma unroll
    for (int i = 0; i < 32; ++i) x[i] = F.lane * 2654435761u + i * 40503u + 0x3f800000u;
    const unsigned kc = 0x3c003c00u + F.wave;
#pragma unroll 1
    for (int it = 0; it < MB_ITERS; ++it) {
#pragma unroll
        for (int i = 0; i < 32; ++i) {
#if MB_OP == 0
            asm volatile("v_fmac_f32 %0, %1, %2" : "+v"(x[i]) : "v"(kc), "v"(x[(i + 1) & 31]));
#elif MB_OP == 1
            asm volatile("v_pk_fma_f32 %0, %1, %2, %0" : "+v"(*(unsigned long long*)&x[i & 30]) : "v"(*(unsigned long long*)&x[(i + 2) & 30]), "v"(*(unsigned long long*)&x[(i + 4) & 30]));
#elif MB_OP == 2
            asm volatile("v_cvt_pk_f32_fp8 %0, %1" : "=v"(*(unsigned long long*)&x[i & 30]) : "v"(x[(i + 3) & 31]));
#elif MB_OP == 3
            asm volatile("v_cvt_scalef32_pk_bf16_fp8 %0, %1, 1.0" : "=v"(x[i]) : "v"(x[(i + 3) & 31]));
#elif MB_OP == 4
            asm volatile("v_dot2c_f32_bf16 %0, %1, %2" : "+v"(x[i]) : "v"(kc), "v"(x[(i + 1) & 31]));
#elif MB_OP == 5
            asm volatile("v_dot4_i32_i8 %0, %1, %2, %0" : "+v"(x[i]) : "v"(kc), "v"(x[(i + 1) & 31]));
#elif MB_OP == 6
            asm volatile("v_perm_b32 %0, %1, %2, %3" : "=v"(x[i]) : "v"(x[(i + 1) & 31]), "v"(x[(i + 2) & 31]), "v"(kc));
#elif MB_OP == 7
            asm volatile("v_cvt_f32_ubyte1 %0, %1" : "=v"(x[i]) : "v"(x[(i + 3) & 31]));
#endif
        }
    }
    unsigned acc = 0;
#pragma unroll
    for (int i = 0; i < 32; ++i) acc ^= x[i];
    if (acc == 0x12345u) *(volatile unsigned*)(F.ws + WS_CTL + 32768) = acc;
}
#endif
struct Args { const float* in[18]; float* out; unsigned char* ws; int ph_lo, ph_hi, li, pad; };
__global__ void __launch_bounds__(NWAVES * 64, 2) mk_fwd(Args args) {
    extern __shared__ __attribute__((aligned(16))) unsigned char lds[];
    Frame F;
    F.lds = (LAS unsigned char*)lds;
    F.tid = threadIdx.x; F.lane = F.tid & 63; F.wave = __builtin_amdgcn_readfirstlane(F.tid >> 6);
    F.G = gridDim.x; { const int bx = blockIdx.x; F.vcu = (F.G % 8 == 0) ? (bx % 8) * (F.G / 8) + bx / 8 : bx; }
    F.gw = F.vcu * NWAVES + F.wave; F.NGW = F.G * NWAVES;
#pragma unroll
    for (int i = 0; i < 18; ++i) F.in[i] = args.in[i];
    F.out = args.out; F.ws = args.ws;
    volatile LAS unsigned* MISC = (volatile LAS unsigned*)(F.lds + MISC_OFF);
    for (int u = F.tid; u < (LDS_BYTES - LDSCTL_OFF) / 4; u += NWAVES * 64) ((LAS unsigned*)(F.lds + LDSCTL_OFF))[u] = 0u;
    __syncthreads();
    gu32* ctl = (gu32*)(F.ws + WS_CTL);
    XcdBarrier bar; bar.bar = (unsigned*)(ctl + CW_BAR) + args.li * XCD_BAR_WORDS; bar.x = 0; bar.st = nullptr;
    const int lo = args.ph_lo, hi = args.ph_hi;
    if (hi - lo > 1) bar = xcd_barrier_post((unsigned*)(ctl + CW_BAR) + args.li * XCD_BAR_WORDS, MISC + 8);
#ifndef PROBE_MASK
#define PROBE_MASK 0
#endif
#define REP(k) for (int rep_ = 0; rep_ < 1 + ((PROBE_MASK >> (k)) & 1); ++rep_)
#define IN(k) (lo <= (k) && (k) < hi)
#ifndef PROBE_SEAMS
#define PROBE_SEAMS 1
#endif
#define SEAM(k) do { if (IN(k) && IN((k) + 1)) for (int s_ = 0; s_ < PROBE_SEAMS; ++s_) xcd_barrier(bar); } while (0)

#ifndef SKIP0
    if (IN(0)) { REP(0) { p0_prologue(F); __syncthreads(); } SEAM(0); }
#endif
#ifdef MB_OP
    if (IN(1)) mb_probe(F);
#endif
    if (IN(1)) { REP(1) norm_rows<false>(F, F.in[0], F.in[2], MROWS, F.in[6], 0, DM, (bf16*)(F.ws + WS_HX)); SEAM(1); }
    if (IN(2)) {
        pg8::Gemm g{(const bf16*)(F.ws + WS_HX), (const bf16*)(F.ws + WS_WIN), MROWS, DIN, DM}; pg8::InProjOrder S; S.init(F.G, (int)blockIdx.x);
        pg8::EpiInProj E{(bf16*)(F.ws + WS_PB), (bf16*)(F.ws + WS_QF), (bf16*)(F.ws + WS_KF), (bf16*)(F.ws + WS_VF)};
        REP(2) pg8::gemm_phase<pg8::EpiInProj, pg8::InProjOrder, true, true>(F.lds + RING_OFF, g, S, E);
        SEAM(2);
    }
    if (IN(3)) {
#ifndef SKIP3A
#ifdef ATT_NAIVE
 attn_naive(F);
#else
 REP(3) attn_mfma(F);
#endif
#endif
#ifndef SKIP3B
#ifdef POOL_NAIVE
 pool_naive(F);
#else
 REP(9) pool_mfma(F);
#endif
#endif
 SEAM(3); }
    if (IN(4)) {
        pg8::Gemm g{(const bf16*)(F.ws + WS_MIX), (const bf16*)(F.ws + WS_WOUT), NTOK, DM, DM}; pg8::StaticOrder S; S.init(NTOK, DM, F.G, (int)blockIdx.x);
        pg8::EpiX1 E{F.in[0], (const float*)(F.ws + WS_MOD), (bf16*)(F.ws + WS_X1)};
        REP(4) pg8::gemm_phase<pg8::EpiX1, pg8::StaticOrder, true, true>(F.lds + RING_OFF, g, S, E);
        SEAM(4);
    }
    if (IN(5)) { REP(5) norm_rows<true>(F, (const float*)(F.ws + WS_X1), nullptr, NTOK, F.in[12], 3 * DM, 4 * DM, (bf16*)(F.ws + WS_HX)); SEAM(5); }
    if (IN(6)) {
        pg8::Gemm g{(const bf16*)(F.ws + WS_HX), (const bf16*)(F.ws + WS_WQ), NTOK, 2048, DM}; pg8::StaticOrder S; S.init(NTOK, 2048, F.G, (int)blockIdx.x);
#ifdef TOPK_NAIVE
        pg8::EpiBf16 E{(bf16*)(F.ws + WS_ZX), 2048};
        pg8::gemm_phase<pg8::EpiBf16, pg8::StaticOrder, true, true>(F.lds + RING_OFF, g, S, E);
#else
        pg8::EpiQP E{(bf16*)(F.ws + WS_ZX)};
        REP(6) pg8::gemm_phase<pg8::EpiQP, pg8::StaticOrder, true, true>(F.lds + RING_OFF, g, S, E);
#endif
        SEAM(6);
    }
    if (IN(7)) {
        for (int tile = F.vcu; tile < NTOK / 128; tile += F.G) {
            const int tok0 = tile * 128;
#ifndef SKIP7A
#ifdef TOPK_NAIVE
            peer_topk_naive(F, tok0);
#else
            REP(7) peer_topk_mfma(F, tile);
#endif
#endif
#ifndef SKIP7B
#ifdef GATHER_V2
            { volatile LAS int* prog = (volatile LAS int*)(F.lds + 98304);
              if ((PROBE_MASK >> 8) & 1) for (int rd = 0; rd < 4; ++rd) gather_round<4, true>(F, tok0 + rd * 32 + F.wave * 4, prog + F.wave, rd * 16384);
              if ((PROBE_MASK >> 10) & 1) for (int rd = 0; rd < 4; ++rd) gather_round<4>(F, tok0 + rd * 32 + F.wave * 4, prog + F.wave, rd * 16384);
              for (int rd = 0; rd < 4; ++rd) gather_round<4>(F, tok0 + rd * 32 + F.wave * 4, prog + F.wave, rd * 16384); }
#else
#ifdef GATHER_TS4
            if ((PROBE_MASK >> 8) & 1) for (int rd = 0; rd < 4; ++rd) gather_ts<true>(F, tok0 + rd * 32 + F.wave * 4);
            for (int rd = 0; rd < 4; ++rd) gather_ts<false>(F, tok0 + rd * 32 + F.wave * 4);
#else
            if ((PROBE_MASK >> 8) & 1) for (int rd = 0; rd < 8; ++rd) gather_ts2<true>(F, tok0 + rd * 16 + F.wave * 2);
            for (int rd = 0; rd < 8; ++rd) gather_ts2<false>(F, tok0 + rd * 16 + F.wave * 2);
#endif
#endif
#endif
        }
    }
#undef IN
#undef SEAM
}

extern "C" void kernel_launch(void* const* d_in, const int* in_sizes, int n_in, void* d_out, int out_size, void* d_ws, size_t ws_size, hipStream_t stream) {
    static int grid = 0;
    if (grid == 0) {
        if (n_in != 18 || in_sizes[0] != NTOK * DM || out_size != NTOK * DM || ws_size < WS_END) { fprintf(stderr, "kernel_launch: unexpected shapes / workspace (n_in %d, ws %zu); nothing launched\n", n_in, ws_size); grid = -1; return; }
        int dev = 0, cus = 0;
        if (hipGetDevice(&dev) != hipSuccess || hipDeviceGetAttribute(&cus, hipDeviceAttributeMultiprocessorCount, dev) != hipSuccess) { grid = -1; return; }
        if (hipFuncSetAttribute((const void*)mk_fwd, hipFuncAttributeMaxDynamicSharedMemorySize, LDS_BYTES) != hipSuccess) { fprintf(stderr, "kernel_launch: hipFuncSetAttribute failed\n"); grid = -1; return; }
        int per_cu = 0;
        if (hipOccupancyMaxActiveBlocksPerMultiprocessor(&per_cu, (const void*)mk_fwd, NWAVES * 64, LDS_BYTES) != hipSuccess || per_cu < 1) fprintf(stderr, "kernel_launch: note: occupancy query reports %d blocks per CU\n", per_cu);
        (void)hipGetLastError();
        grid = cus;
    }
    if (grid < 0) return;
    (void)hipMemsetAsync((char*)d_ws + WS_CTL, 0, CTL_ZERO_BYTES, stream);
    Args a{};
    for (int i = 0; i < 18; ++i) a.in[i] = (const float*)d_in[i];
    a.out = (float*)d_out; a.ws = (unsigned char*)d_ws;
    for (int li = 0; li < N_LAUNCHES; ++li) {
        if (N_LAUNCHES == 1) { a.ph_lo = 0; a.ph_hi = NPHASE; } else { a.ph_lo = li; a.ph_hi = li + 1; }
        a.li = (N_LAUNCHES == 1) ? 0 : 0;
        hipLaunchKernelGGL(mk_fwd, dim3(grid), dim3(NWAVES * 64), LDS_BYTES, stream, a);
    }
}
```

```cpp
#define GATHER_V4 1
#include <hip/hip_runtime.h>
#include <cstdio>
#include <cstdint>
#include <type_traits>
namespace pg8 {
#define PG8_LAS __attribute__((address_space(3)))
typedef unsigned short bf16_t;
typedef short bf16x8 __attribute__((ext_vector_type(8)));
typedef float f32x4 __attribute__((ext_vector_type(4)));
typedef unsigned u32x4 __attribute__((ext_vector_type(4)));
constexpr int BM = 256, BK = 64, HALF = 128, HTB = HALF * BK * 2  , STAGE_BYTES = 8 * HTB, NXCD = 8, WGM = 8;

__host__ __device__ __forceinline__ int lds_byte(int r, int c) { const int st = (r >> 4) * 2 + (c >> 5), rr = r & 15, cc = c & 31, ob = rr * 64 + cc * 2; return st * 1024 + (ob ^ (((ob >> 9) & 1) << 5)); }
__host__ __device__ __forceinline__ void stage_rc(int b, int& R, int& C) { const int st = b / 1024, sb = b % 1024, swz = sb ^ (((sb >> 9) & 1) << 5); R = (st >> 1) * 16 + swz / 64; C = (st & 1) * 32 + (swz % 64) / 2; }
__host__ __device__ __forceinline__ int perm32(int rho) { const int n = rho >> 4, i = rho & 15; return 8 * (i >> 2) + 4 * n + (i & 3); }

struct Unit { int pm, pn; };
struct Gemm { const bf16_t* A; const bf16_t* Bt; int M, N, K; };
struct StaticOrder {
    int nM, nN, nwg, G, c;
    __host__ __device__ void init(int M, int N, int G_, int c_) { nM = M / BM; nN = N / BM; nwg = nM * nN; G = G_; c = c_; }
    __host__ __device__ bool next(int i, Unit& u) const {
        const long L = (long)i * G + c; if (L >= nwg) return false;
        int wgid = (int)L; { const int q = nwg / NXCD, r = nwg % NXCD, xcd = wgid % NXCD, off = wgid / NXCD; wgid = (xcd < r ? xcd * (q + 1) : r * (q + 1) + (xcd - r) * q) + off; }
        const int nig = WGM * nN, gid = wgid / nig, fm = gid * WGM, gsz = (nM - fm) < WGM ? (nM - fm) : WGM;
        u.pm = fm + ((wgid % nig) % gsz); u.pn = (wgid % nig) / gsz; return true;
    }
    __device__ __forceinline__ void a_ready(const Unit&) const {}
    __device__ __forceinline__ void done(const Unit&) const {}
    __device__ __forceinline__ const char* pa(const Gemm& g, const Unit& u) const { return (const char*)g.A + (size_t)u.pm * ((size_t)BM * g.K * 2); }
    __device__ __forceinline__ const char* pb(const Gemm& g, const Unit& u) const { return (const char*)g.Bt + (size_t)u.pn * ((size_t)BM * g.K * 2); }
};
struct InProjOrder {
    StaticOrder so;
    __host__ __device__ void init(int G_, int c_) { so.init(136 * BM, 8 * BM, G_, c_); }
    __host__ __device__ bool next(int i, Unit& u) const { int cnt = -1; for (int j = 0; ; ++j) { if (!so.next(j, u)) return false; if (!(u.pm >= 128 && u.pn < 4)) { if (++cnt == i) return true; } } }
    __device__ __forceinline__ void a_ready(const Unit&) const {}
    __device__ __forceinline__ void done(const Unit&) const {}
    __device__ __forceinline__ const char* pa(const Gemm& g, const Unit& u) const { return u.pn < 6 ? (const char*)g.A + (size_t)u.pm * ((size_t)BM * g.K * 2) : (const char*)g.Bt + (size_t)u.pn * ((size_t)BM * g.K * 2); }
    __device__ __forceinline__ const char* pb(const Gemm& g, const Unit& u) const { return u.pn < 6 ? (const char*)g.Bt + (size_t)u.pn * ((size_t)BM * g.K * 2) : (const char*)g.A + (size_t)u.pm * ((size_t)BM * g.K * 2); }
};

__device__ __forceinline__ unsigned cvt_pk_bf16(float lo, float hi) { unsigned r; asm volatile("v_cvt_pk_bf16_f32 %0, %1, %2" : "=v"(r) : "v"(lo), "v"(hi)); return r; }
struct EpiBf16 {
    static constexpr bool PERM = true, AFTER_DRAIN = false;
    bf16_t* O; int ldc;
    __device__ __forceinline__ void operator()(const f32x4 (&acc)[2][2][4][2], const Unit& u, int wr, int wc, int fr, int fq) const {
        const int row0 = u.pm * BM + wr * 64 + fr, col0 = u.pn * BM + wc * 32 + 8 * fq;
#pragma unroll
        for (int ai = 0; ai < 2; ++ai)
#pragma unroll
            for (int m = 0; m < 4; ++m) { bf16_t* rowp = O + (size_t)(row0 + ai * HALF + m * 16) * ldc + col0;
#pragma unroll
                for (int bj = 0; bj < 2; ++bj) { const f32x4 v0 = acc[ai][bj][m][0], v1 = acc[ai][bj][m][1];
                    u32x4 w; w.x = cvt_pk_bf16(v0[0], v0[1]); w.y = cvt_pk_bf16(v0[2], v0[3]); w.z = cvt_pk_bf16(v1[0], v1[1]); w.w = cvt_pk_bf16(v1[2], v1[3]);
                    *(u32x4*)(rowp + bj * HALF) = w; } }
    }
};
struct EpiX1 {
    static constexpr bool PERM = true, AFTER_DRAIN = false;
    const float* x; const float* mod; bf16_t* out;
    __device__ __forceinline__ void operator()(const f32x4 (&acc)[2][2][4][2], const Unit& u, int wr, int wc, int fr, int fq) const {
        const int row0 = u.pm * BM + wr * 64 + fr, col0 = u.pn * BM + wc * 32 + 8 * fq;
        const float* g1 = mod + (size_t)((u.pm * BM) >> 12) * 6144 + 2048 + col0;
        f32x4 gv[2][2];
#pragma unroll
        for (int bj = 0; bj < 2; ++bj)
#pragma unroll
            for (int n = 0; n < 2; ++n) gv[bj][n] = *(const f32x4*)(g1 + bj * HALF + 4 * n);
#pragma unroll
        for (int ai = 0; ai < 2; ++ai)
#pragma unroll
            for (int m = 0; m < 4; ++m) { const size_t off = (size_t)(row0 + ai * HALF + m * 16) * 1024 + col0;
#pragma unroll
                for (int bj = 0; bj < 2; ++bj) { const f32x4 x0 = *(const f32x4*)(x + off + bj * HALF), x1 = *(const f32x4*)(x + off + bj * HALF + 4);
                    const f32x4 v0 = x0 + gv[bj][0] * acc[ai][bj][m][0], v1 = x1 + gv[bj][1] * acc[ai][bj][m][1];
                    u32x4 w; w.x = cvt_pk_bf16(v0[0], v0[1]); w.y = cvt_pk_bf16(v0[2], v0[3]); w.z = cvt_pk_bf16(v1[0], v1[1]); w.w = cvt_pk_bf16(v1[2], v1[3]);
                    *(u32x4*)(out + off + bj * HALF) = w; } }
    }
};


struct EpiInProj {
    static constexpr bool PERM = true, AFTER_DRAIN = false;
    bf16_t *PB, *QF, *KF, *VF;
    __device__ __forceinline__ void operator()(const f32x4 (&acc)[2][2][4][2], const Unit& u, int wr, int wc, int fr, int fq) const {
        if (u.pn < 6) {
            const int sec = u.pn >> 1, cbase = (u.pn & 1) * 256 + wc * 32 + 8 * fq;
#pragma unroll
            for (int ai = 0; ai < 2; ++ai)
#pragma unroll
                for (int m = 0; m < 4; ++m) { const int T = u.pm * BM + ai * HALF + wr * 64 + m * 16 + fr;
                    int bb, blk; if (T < 32768) { bb = T >> 12; blk = (T & 4095) >> 5; } else { const int cc = T - 32768; bb = cc >> 8; blk = 128 + ((cc & 255) >> 5); }
                    const int tl = T & 31;
#pragma unroll
                    for (int bj = 0; bj < 2; ++bj) { const int c = cbase + HALF * bj; const f32x4 v0 = acc[ai][bj][m][0], v1 = acc[ai][bj][m][1];
                        u32x4 w; w.x = cvt_pk_bf16(v0[0], v0[1]); w.y = cvt_pk_bf16(v0[2], v0[3]); w.z = cvt_pk_bf16(v1[0], v1[1]); w.w = cvt_pk_bf16(v1[2], v1[3]);
                        if (sec == 0) *(u32x4*)(PB + (size_t)T * 512 + c) = w;
                        else { const int h = c >> 6, d0 = c & 63, fo = ((d0 >> 4) * 64 + ((d0 >> 3) & 1) * 32 + tl) * 8;
                            bf16_t* dst = (sec == 1) ? QF + (size_t)((bb * 8 + h) * 128 + blk) * 2048 + fo : KF + (size_t)((bb * 8 + h) * 136 + blk) * 2048 + fo;
                            *(u32x4*)dst = w; } } }
        } else {
            typedef unsigned u32x2 __attribute__((ext_vector_type(2)));
#pragma unroll
            for (int ai = 0; ai < 2; ++ai)
#pragma unroll
                for (int m = 0; m < 4; ++m) { const int vc = (u.pn - 6) * BM + ai * HALF + wr * 64 + m * 16 + fr, h = vc >> 6, dt = (vc >> 5) & 1, dl = vc & 31;
#pragma unroll
                    for (int bj = 0; bj < 2; ++bj) { const int T0 = u.pm * BM + bj * HALF + wc * 32 + 8 * fq;
                        int bb, blk; if (T0 < 32768) { bb = T0 >> 12; blk = (T0 & 4095) >> 5; } else { const int cc = T0 - 32768; bb = cc >> 8; blk = 128 + ((cc & 255) >> 5); }
                        bf16_t* base = VF + ((size_t)(((bb * 8 + h) * 136 + blk) * 2 + dt) * 2 + (fq >> 1)) * 512 + 4 * (fq & 1);
                        const f32x4 v0 = acc[ai][bj][m][0], v1 = acc[ai][bj][m][1];
                        u32x2 w0, w1; w0.x = cvt_pk_bf16(v0[0], v0[1]); w0.y = cvt_pk_bf16(v0[2], v0[3]); w1.x = cvt_pk_bf16(v1[0], v1[1]); w1.y = cvt_pk_bf16(v1[2], v1[3]);
                        *(u32x2*)(base + dl * 8) = w0; *(u32x2*)(base + (32 + dl) * 8) = w1; } }
        }
    }
};

struct EpiQP {
    static constexpr bool PERM = true, AFTER_DRAIN = false;
    bf16_t* QP;
    __device__ __forceinline__ void operator()(const f32x4 (&acc)[2][2][4][2], const Unit& u, int wr, int wc, int fr, int fq) const {
#pragma unroll
        for (int ai = 0; ai < 2; ++ai)
#pragma unroll
            for (int m = 0; m < 4; ++m) { const int T = u.pm * BM + ai * HALF + wr * 64 + m * 16 + fr;
#pragma unroll
                for (int bj = 0; bj < 2; ++bj) { const int hp = 2 * u.pn + bj, ks = 2 * wc + (fq >> 1), hh = fq & 1;
                    const f32x4 v0 = acc[ai][bj][m][0], v1 = acc[ai][bj][m][1];
                    u32x4 w; w.x = cvt_pk_bf16(v0[0], v0[1]); w.y = cvt_pk_bf16(v0[2], v0[3]); w.z = cvt_pk_bf16(v1[0], v1[1]); w.w = cvt_pk_bf16(v1[2], v1[3]);
                    *(u32x4*)(QP + ((size_t)(T >> 5) * 16 + hp) * 4096 + (ks * 64 + hh * 32 + (T & 31)) * 8) = w; } }
    }
};
template <class Epi, class Sched, bool ALIGN_EPI = false, bool SP2 = false>
__device__ __forceinline__ void gemm_phase(PG8_LAS unsigned char* lds, const Gemm g, const Sched& S, const Epi& E) {
    const int tid = threadIdx.x, wid = __builtin_amdgcn_readfirstlane(tid >> 6), lane = tid & 63, wr = wid >> 2, wc = wid & 3, fr = lane & 15, fq = lane >> 4;
    const int K = g.K, nt = K / BK;
    unsigned voffA[2], voffB[2];
#pragma unroll
    for (int i = 0; i < 2; ++i) { int R, C; stage_rc(tid * 16 + i * 8192, R, C); const int Rb = Epi::PERM ? ((R & ~31) + perm32(R & 31)) : R;
        voffA[i] = (unsigned)(R * K + C) * 2u; voffB[i] = (unsigned)(Rb * K + C) * 2u; }
    const size_t kstep = (size_t)(BK * 2);
    const size_t hstep = (size_t)HALF * K * 2;
    const size_t tstep = 2 * hstep;
    const unsigned ldsw = (unsigned)wid * 1024u;
    const int aoff = lds_byte(wr * 64 + fr, fq * 8), boff = lds_byte(wc * 32 + fr, fq * 8);
#define PG8_SA(b, h) (((b) * 2 + (h)) * HTB)
#define PG8_SB(b, h) ((4 + (b) * 2 + (h)) * HTB)
#define PG8_STAGE(bufoff, gbase, voff) do { _Pragma("unroll") for (int _i = 0; _i < 2; ++_i) \
        __builtin_amdgcn_global_load_lds((const unsigned*)((const char*)(gbase) + (voff)[_i]), (PG8_LAS unsigned*)(lds + (bufoff) + ldsw + _i * 8192), 16, 0, 0); } while (0)
#define PG8_LDA(dst, b, h) do { _Pragma("unroll") for (int m = 0; m < 4; ++m) _Pragma("unroll") for (int k = 0; k < 2; ++k) dst[m][k] = *(const PG8_LAS bf16x8*)(lds + PG8_SA(b, h) + aoff + m * 2048 + k * 1024); } while (0)
#define PG8_LDB(dst, b, h) do { _Pragma("unroll") for (int n = 0; n < 2; ++n) _Pragma("unroll") for (int k = 0; k < 2; ++k) dst[n][k] = *(const PG8_LAS bf16x8*)(lds + PG8_SB(b, h) + boff + n * 2048 + k * 1024); } while (0)
#define PG8_MMA(ai, bj, At, Bt) do { __builtin_amdgcn_s_setprio(1); _Pragma("unroll") for (int m = 0; m < 4; ++m) _Pragma("unroll") for (int n = 0; n < 2; ++n) _Pragma("unroll") for (int k = 0; k < 2; ++k) \
        acc[ai][bj][m][n] = __builtin_amdgcn_mfma_f32_16x16x32_bf16(Bt[n][k], At[m][k], acc[ai][bj][m][n], 0, 0, 0); __builtin_amdgcn_s_setprio(0); } while (0)
#define PG8_WAIT_V(n) asm volatile("s_waitcnt vmcnt(" #n ")" ::: "memory")
#define PG8_WAIT_L(n) asm volatile("s_waitcnt lgkmcnt(" #n ")" ::: "memory")
#define PG8_BAR __builtin_amdgcn_s_barrier()
#define PG8_SCHED __builtin_amdgcn_sched_barrier(0)
    Unit cur, nxt; int ui = 0;
    if (!S.next(0, cur)) return;
    f32x4 acc[2][2][4][2];
#pragma unroll
    for (int a = 0; a < 2; ++a)
#pragma unroll
        for (int b = 0; b < 2; ++b)
#pragma unroll
            for (int m = 0; m < 4; ++m)
#pragma unroll
                for (int n = 0; n < 2; ++n) acc[a][b][m][n] = (f32x4){0.f, 0.f, 0.f, 0.f};
    bf16x8 At[4][2], B0[2][2], B1[2][2];
    const char* cA = S.pa(g, cur); const char* cB = S.pb(g, cur);
    S.a_ready(cur);
    if constexpr (SP2) {
        PG8_STAGE(PG8_SB(0, 0), cB, voffB); PG8_STAGE(PG8_SB(0, 1), cB + hstep, voffB); PG8_STAGE(PG8_SA(0, 0), cA, voffA); PG8_STAGE(PG8_SA(0, 1), cA + hstep, voffA);
        if (wr == 1) PG8_BAR;
        PG8_WAIT_V(2); PG8_BAR;
        PG8_STAGE(PG8_SB(1, 0), cB + kstep, voffB); PG8_STAGE(PG8_SA(1, 0), cA + kstep, voffA); PG8_STAGE(PG8_SB(1, 1), cB + hstep + kstep, voffB);
        PG8_WAIT_V(6); PG8_BAR;
    } else {
        PG8_STAGE(PG8_SB(0, 0), cB, voffB); PG8_STAGE(PG8_SA(0, 0), cA, voffA); PG8_STAGE(PG8_SB(0, 1), cB + hstep, voffB); PG8_STAGE(PG8_SA(0, 1), cA + hstep, voffA);
        if (wr == 1) PG8_BAR;
        PG8_WAIT_V(4); PG8_BAR;
        PG8_STAGE(PG8_SB(1, 0), cB + kstep, voffB); PG8_STAGE(PG8_SA(1, 0), cA + kstep, voffA); PG8_STAGE(PG8_SB(1, 1), cB + hstep + kstep, voffB);
        PG8_WAIT_V(6); PG8_BAR;
    }
    for (;;) {
        const bool has_next = S.next(ui + 1, nxt);
        const char* nA = has_next ? S.pa(g, nxt) : cA; const char* nB = has_next ? S.pb(g, nxt) : cB;
        for (int t = 0; t < nt; t += 2) {
            const bool last = (t == nt - 2);
            const char* a1 = cA + (size_t)(t + 1) * kstep;
            const char* a2 = last ? nA : cA + (size_t)(t + 2) * kstep; const char* b2 = last ? nB : cB + (size_t)(t + 2) * kstep;
            const char* a3 = a2 + kstep; const char* b3 = b2 + kstep;
            if (last && has_next) S.a_ready(nxt);
            if constexpr (SP2) {
            PG8_LDB(B0, 0, 0); PG8_LDB(B1, 0, 1); PG8_SCHED; PG8_LDA(At, 0, 0); PG8_STAGE(PG8_SA(1, 1), a1 + hstep, voffA);
            PG8_WAIT_V(8); PG8_WAIT_L(0); PG8_BAR; PG8_MMA(0, 0, At, B0); PG8_MMA(0, 1, At, B1); PG8_BAR; PG8_SCHED;
            PG8_LDA(At, 0, 1); PG8_STAGE(PG8_SB(0, 0), b2, voffB); PG8_STAGE(PG8_SB(0, 1), b2 + hstep, voffB); PG8_STAGE(PG8_SA(0, 0), a2, voffA);
            PG8_WAIT_V(8); PG8_WAIT_L(0); PG8_BAR; PG8_MMA(1, 0, At, B0); PG8_MMA(1, 1, At, B1); PG8_BAR; PG8_SCHED;
            PG8_LDB(B0, 1, 0); PG8_LDB(B1, 1, 1); PG8_SCHED; PG8_LDA(At, 1, 0); PG8_STAGE(PG8_SA(0, 1), a2 + hstep, voffA);
            PG8_WAIT_V(8); PG8_WAIT_L(0); PG8_BAR; PG8_MMA(0, 0, At, B0); PG8_MMA(0, 1, At, B1); PG8_BAR; PG8_SCHED;
            PG8_LDA(At, 1, 1); PG8_STAGE(PG8_SB(1, 0), b3, voffB); PG8_STAGE(PG8_SB(1, 1), b3 + hstep, voffB); PG8_STAGE(PG8_SA(1, 0), a3, voffA);
            PG8_WAIT_V(8); PG8_WAIT_L(0); PG8_BAR; PG8_MMA(1, 0, At, B0); PG8_MMA(1, 1, At, B1); PG8_BAR; PG8_SCHED;
            } else {
            PG8_LDB(B0, 0, 0); PG8_SCHED; PG8_LDA(At, 0, 0); PG8_STAGE(PG8_SA(1, 1), a1 + hstep, voffA);
            PG8_WAIT_L(8); PG8_BAR; PG8_WAIT_L(0); PG8_MMA(0, 0, At, B0); PG8_BAR; PG8_SCHED;
            PG8_LDB(B1, 0, 1); PG8_STAGE(PG8_SB(0, 0), b2, voffB);
            PG8_BAR; PG8_WAIT_L(0); PG8_MMA(0, 1, At, B1); PG8_BAR;
            PG8_LDA(At, 0, 1); PG8_STAGE(PG8_SA(0, 0), a2, voffA);
            PG8_BAR; PG8_WAIT_L(0); PG8_MMA(1, 0, At, B0); PG8_BAR; PG8_SCHED;
            PG8_STAGE(PG8_SB(0, 1), b2 + hstep, voffB);
            PG8_WAIT_V(6); PG8_BAR; PG8_MMA(1, 1, At, B1); PG8_BAR;
            PG8_LDB(B0, 1, 0); PG8_SCHED; PG8_LDA(At, 1, 0); PG8_STAGE(PG8_SA(0, 1), a2 + hstep, voffA);
            PG8_WAIT_L(8); PG8_BAR; PG8_WAIT_L(0); PG8_MMA(0, 0, At, B0); PG8_BAR; PG8_SCHED;
            PG8_LDB(B1, 1, 1); PG8_STAGE(PG8_SB(1, 0), b3, voffB);
            PG8_BAR; PG8_WAIT_L(0); PG8_MMA(0, 1, At, B1); PG8_BAR;
            PG8_LDA(At, 1, 1); PG8_STAGE(PG8_SA(1, 0), a3, voffA);
            PG8_BAR; PG8_WAIT_L(0); PG8_MMA(1, 0, At, B0); PG8_BAR; PG8_SCHED;
            PG8_STAGE(PG8_SB(1, 1), b3 + hstep, voffB);
            PG8_WAIT_V(6); PG8_BAR; PG8_MMA(1, 1, At, B1); PG8_BAR;
            }
        }
        if constexpr (ALIGN_EPI) { if (wr == 0) PG8_BAR; }
        if constexpr (!Epi::AFTER_DRAIN) { E(acc, cur, wr, wc, fr, fq); S.done(cur); }
        if (!has_next) break;
#pragma unroll
        for (int a = 0; a < 2; ++a)
#pragma unroll
            for (int b = 0; b < 2; ++b)
#pragma unroll
                for (int m = 0; m < 4; ++m)
#pragma unroll
                    for (int n = 0; n < 2; ++n) acc[a][b][m][n] = (f32x4){0.f, 0.f, 0.f, 0.f};
        cur = nxt; cA = nA; cB = nB; ++ui;
        if constexpr (ALIGN_EPI) { if (wr == 1) PG8_BAR; }
    }
    PG8_WAIT_V(0);
    if constexpr (!ALIGN_EPI) { if (wr == 0) PG8_BAR; }
    PG8_BAR;
    if constexpr (Epi::AFTER_DRAIN) { E.fused(acc, cur, wr, wc, fr, fq, lds, wid, lane); S.done(cur); }
#undef PG8_SA
#undef PG8_SB
#undef PG8_STAGE
#undef PG8_LDA
#undef PG8_LDB
#undef PG8_MMA
#undef PG8_WAIT_V
#undef PG8_WAIT_L
#undef PG8_BAR
#undef PG8_SCHED
}
}

constexpr int DM = 1024, NBATCH = 8, SEQ = 4096, NTOK = NBATCH * SEQ, CTXL = 256, NCTX = NBATCH * CTXL, MROWS = NTOK + NCTX;
constexpr int DIN = 2048, NHEAD = 8, HD = 64, GRIDW = 64, NMOD = 6 * DM;
constexpr int NEXP = 16384;
constexpr float EPS = 1e-6f;
constexpr int NWAVES = 8;
constexpr int NPHASE = 8;
constexpr float U_SCALE = 64.f, V_SCALE = 4.f;

#ifndef FAKE_MASK
#define FAKE_MASK 7
#endif
#ifndef MK_N_LAUNCHES
#define MK_N_LAUNCHES 1
#endif
constexpr int N_LAUNCHES = MK_N_LAUNCHES;

constexpr size_t MiB = 1u << 20;
constexpr size_t WS_CTL = 0, CTL_ZERO_BYTES = 64 * 1024;
constexpr size_t WS_WIN = 2 * MiB, WS_WOUT = 6 * MiB, WS_WQ = 8 * MiB, WS_KEYS = 12 * MiB, WS_POOLW = 12 * MiB + 512 * 1024, WS_MOD = 13 * MiB;
constexpr size_t WS_SU = 13 * MiB + 512 * 1024;
constexpr size_t WS_U = 14 * MiB, WS_V = 46 * MiB;
constexpr size_t WS_HX = 78 * MiB;
constexpr size_t WS_ZX = 146 * MiB;
constexpr size_t WS_PB = 146 * MiB, WS_QF = 178 * MiB, WS_KF = 210 * MiB, WS_VF = 244 * MiB;
constexpr size_t WS_MIX = 282 * MiB;
constexpr size_t WS_EXP = 346 * MiB, WS_GATE = 362 * MiB;
constexpr size_t WS_POOLED = 378 * MiB;
constexpr size_t WS_X1 = 378 * MiB;
constexpr size_t WS_LISTS = 410 * MiB;
constexpr size_t WS_END = 442 * MiB;
constexpr int CW_BAR = 4096;

constexpr int RING_OFF = 0, RING_BYTES = 131072;
constexpr int LDSCTL_OFF = RING_BYTES, MISC_OFF = LDSCTL_OFF + 320;
constexpr int LDS_BYTES = 147456;

#define GAS __attribute__((address_space(1)))
#define LAS __attribute__((address_space(3)))
#define DI __device__ __forceinline__
typedef unsigned short bf16;
typedef unsigned v4u __attribute__((ext_vector_type(4)));
typedef unsigned v2u __attribute__((ext_vector_type(2)));
typedef float f32x4 __attribute__((ext_vector_type(4)));
typedef float f32x2 __attribute__((ext_vector_type(2)));
typedef GAS unsigned gu32;
#define RLX_AGENT __ATOMIC_RELAXED, __HIP_MEMORY_SCOPE_AGENT
#define LDS_WAIT() asm volatile("s_waitcnt lgkmcnt(0)" ::: "memory")
#define VM_WAIT() asm volatile("s_waitcnt vmcnt(0)" ::: "memory")
DI unsigned f2bf(float f) { unsigned u = __builtin_bit_cast(unsigned, f); return (u + 0x7fffu + ((u >> 16) & 1u)) >> 16; }
DI unsigned pk2(float lo, float hi) { return f2bf(lo) | (f2bf(hi) << 16); }
DI float bflo(unsigned u) { return __uint_as_float(u << 16); }
DI float bfhi(unsigned u) { return __uint_as_float(u & 0xffff0000u); }
DI float wave_sum(float v) {
#pragma unroll
    for (int o = 1; o < 64; o <<= 1) v += __shfl_xor(v, o);
    return v;
}

#define XB_TMO      128
#define XB_XCNT(j)  (256  + 64 * (j))
#define XB_XSUB(j)  (1280 + 64 * (j))
#define XB_XGEN(j)  (2304 + 64 * (j))
#define XB_TOP      3328
#define XB_TOPGEN   3392
#define XCD_BAR_WORDS 3456
#define XB_SPIN_CAP (1u << 18)

__device__ __forceinline__ unsigned xb_ld(unsigned* p)              { return __hip_atomic_load(p, __ATOMIC_RELAXED, __HIP_MEMORY_SCOPE_AGENT); }
__device__ __forceinline__ unsigned xb_add(unsigned* p, unsigned v) { return __hip_atomic_fetch_add(p, v, __ATOMIC_RELAXED, __HIP_MEMORY_SCOPE_AGENT); }
__device__ __forceinline__ unsigned xb_xcc_id() { return (unsigned)__builtin_amdgcn_s_getreg((3 << 11) | 20) & 0xFu; }
#define XB_SPIN(cond, bar) do { unsigned _sp = 0; while (cond) { __builtin_amdgcn_s_sleep(1); \
    if ((++_sp & 255u) == 0u) { if (xb_ld(&(bar)[XB_TMO])) break; if (_sp > XB_SPIN_CAP) { atomicAdd(&(bar)[XB_TMO], 1u); break; } } } } while (0)

struct XcdBarrier {
    unsigned* bar; unsigned x;
    volatile LAS unsigned* st;
};

__device__ __forceinline__ XcdBarrier xcd_barrier_post(unsigned* bar, volatile LAS unsigned* st) {
    XcdBarrier b; b.bar = bar; b.x = xb_xcc_id(); b.st = st;
    if (threadIdx.x == 0) (void)xb_add(&bar[XB_XCNT(b.x)], 1u);
    return b;
}
__device__ __forceinline__ void xcd_barrier_complete(unsigned* bar, unsigned x, unsigned& nloc, unsigned& nx) {
    const unsigned G = gridDim.x * gridDim.y * gridDim.z;
    unsigned sum, cnt, mine, sp = 0u;
    for (;;) {
        sum = 0u; cnt = 0u; mine = 0u;
#pragma unroll
        for (unsigned j = 0; j < 16; ++j) { const unsigned c = xb_ld(&bar[XB_XCNT(j)]); sum += c; cnt += (c > 0u) ? 1u : 0u; mine = (j == x) ? c : mine; }
        if (sum == G) break;
        __builtin_amdgcn_s_sleep(1);
        if ((++sp & 255u) == 0u) { if (xb_ld(&bar[XB_TMO])) break; if (sp > XB_SPIN_CAP) { atomicAdd(&bar[XB_TMO], 1u); break; } }
    }
    nloc = mine > 0u ? mine : 1u; nx = cnt > 0u ? cnt : 1u;
}

__device__ __forceinline__ void xcd_barrier(const XcdBarrier& b) {
    asm volatile("s_waitcnt vmcnt(0)" ::: "memory");
    __syncthreads();
    if (threadIdx.x == 0) {
        unsigned* bar = b.bar;
        __builtin_amdgcn_s_waitcnt(0);
        unsigned nloc = b.st[0], nx = b.st[1];
        if (nloc == 0u) { xcd_barrier_complete(bar, b.x, nloc, nx); b.st[0] = nloc; b.st[1] = nx; }
        const unsigned old = xb_add(&bar[XB_XSUB(b.x)], 1u);
        const unsigned gen = old / nloc;
        if (old + 1u == (gen + 1u) * nloc) {
            __builtin_amdgcn_fence(__ATOMIC_RELEASE, "agent");
            asm volatile("s_waitcnt vmcnt(0)" ::: "memory");
            const unsigned og = xb_add(&bar[XB_TOP], 1u);
            const unsigned tg = og / nx;
            if (og + 1u == (tg + 1u) * nx) xb_add(&bar[XB_TOPGEN], 1u);
            else XB_SPIN(xb_ld(&bar[XB_TOPGEN]) == tg, bar);
            __builtin_amdgcn_fence(__ATOMIC_ACQUIRE, "agent");
            xb_add(&bar[XB_XGEN(b.x)], 1u);
            asm volatile("s_waitcnt vmcnt(0)" ::: "memory");
        } else {
            XB_SPIN(xb_ld(&bar[XB_XGEN(b.x)]) == gen, bar);
            __builtin_amdgcn_fence(__ATOMIC_ACQUIRE, "agent");
            asm volatile("s_waitcnt vmcnt(0)" ::: "memory");
        }
    }
    __syncthreads();
}


__device__ __forceinline__ void p0_transpose_item(const float* W, int K, int N, bf16* WT, int row_off, LAS float* scr, int item, int lane) {
    const int nblk = N / 32, kb = item / nblk, nb = item % nblk, k0 = 64 * kb, n0 = 32 * nb;
#pragma unroll 8
    for (int i = 0; i < 32; ++i) { const int kk = 2 * i + (lane >> 5); scr[kk * 33 + (lane & 31)] = W[(size_t)(k0 + kk) * N + n0 + (lane & 31)]; }
    LDS_WAIT(); asm volatile("" ::: "memory");
    const int c = lane & 7;
#pragma unroll
    for (int j = 0; j < 4; ++j) { const int n = (lane >> 3) + 8 * j; const LAS float* s = scr + (8 * c) * 33 + n;
        v4u o; o.x = pk2(s[0 * 33], s[1 * 33]); o.y = pk2(s[2 * 33], s[3 * 33]); o.z = pk2(s[4 * 33], s[5 * 33]); o.w = pk2(s[6 * 33], s[7 * 33]);
        *(GAS v4u*)(WT + (size_t)(row_off + n0 + n) * K + k0 + 8 * c) = o; }
    LDS_WAIT(); asm volatile("" ::: "memory");
}


struct Frame {
    LAS unsigned char* lds;
    int tid, lane, wave, vcu, G, gw, NGW;
    const float* in[18]; float* out; unsigned char* ws;
};

DI void p0_prologue(Frame& F) {
    const float* c = F.in[1]; const float* c_ctx = F.in[3]; const float* ada_w = F.in[4]; const float* ada_b = F.in[5];
    float* MOD = (float*)(F.ws + WS_MOD);
    LAS float* sl = (LAS float*)(F.lds + 73728);
    for (int i = F.tid; i < 9 * 1024; i += 512) { const int b = i >> 10, k = i & 1023; const float cv = (b < 8) ? c[b * 1024 + k] : c_ctx[k]; sl[i] = cv / (1.f + __expf(-cv)); }
    __syncthreads();
    { LAS float* part = (LAS float*)(F.lds + 110592);
      for (int cg = F.vcu; cg < NMOD / 24; cg += F.G) {
          const int c = F.lane % 24, sub = F.lane / 24, n = cg * 24 + c, k0 = F.wave * 128 + sub * 64;
          float acc[9];
#pragma unroll
          for (int b = 0; b < 9; ++b) acc[b] = 0.f;
          if (sub < 2) { const float* wp = ada_w + (size_t)k0 * NMOD + n; const LAS float* sp = sl + k0;
#pragma unroll 16
              for (int i = 0; i < 64; ++i) { const float w = wp[(size_t)i * NMOD];
#pragma unroll
                  for (int b = 0; b < 9; ++b) acc[b] += sp[b * 1024 + i] * w; } }
#pragma unroll
          for (int b = 0; b < 9; ++b) { const float o = __shfl(acc[b], (F.lane + 24) & 63); if (F.lane < 24) part[(F.wave * 9 + b) * 24 + c] = acc[b] + o; }
          __syncthreads();
          if (F.tid < 216) { const int b = F.tid / 24, cc = F.tid % 24; float t = ada_b[cg * 24 + cc];
#pragma unroll
              for (int w = 0; w < 8; ++w) t += part[(w * 9 + b) * 24 + cc];
              MOD[b * NMOD + cg * 24 + cc] = t; }
          __syncthreads();
      } }
    LAS float* scr = (LAS float*)(F.lds + F.wave * 9216);
    constexpr int I_IN = (DM / 64) * (DIN / 32), I_OUT = (DM / 64) * (DM / 32), I_Q = (DM / 64) * (2048 / 32), I_P = 4 * 8;
    for (int it = F.gw; it < I_IN + I_OUT + I_Q + I_P; it += F.NGW) {
        int r = it;
        if (r < I_IN) { p0_transpose_item(F.in[7], DM, DIN, (bf16*)(F.ws + WS_WIN), 0, scr, r, F.lane); continue; } r -= I_IN;
        if (r < I_OUT) { p0_transpose_item(F.in[11], DM, DM, (bf16*)(F.ws + WS_WOUT), 0, scr, r, F.lane); continue; } r -= I_OUT;
        if (r < I_Q) { p0_transpose_item(F.in[13], DM, 2048, (bf16*)(F.ws + WS_WQ), 0, scr, r, F.lane); continue; } r -= I_Q;
        { const int g = r >> 3; p0_transpose_item(F.in[8] + g * 16384, 128, 128, (bf16*)(F.ws + WS_POOLW) + g * 16384, 0, scr, r & 7, F.lane); }
    }
    { const float* kf = F.in[14]; bf16* kb = (bf16*)(F.ws + WS_KEYS);
      for (int it = F.gw; it < 16 * 32; it += F.NGW) { const int hp = it >> 5, nt = (it >> 3) & 3, ks = it & 7;
          const float* src = kf + ((size_t)hp * 128 + 32 * nt + (F.lane & 31)) * 128 + 16 * ks + 8 * (F.lane >> 5);
          const f32x4 a = *(const f32x4*)(src), b = *(const f32x4*)(src + 4);
          v4u w; w.x = pk2(a.x, a.y); w.y = pk2(a.z, a.w); w.z = pk2(b.x, b.y); w.w = pk2(b.z, b.w); *(v4u*)(kb + ((size_t)it * 64 + F.lane) * 8) = w; } }
    for (int it = F.gw; it < 2 * NEXP; it += F.NGW) {
        const bool isu = it < NEXP;
        const float* src = isu ? F.in[15] + (size_t)it * 1024 : F.in[16] + (size_t)(it - NEXP) * 1024;
        unsigned* dst = (unsigned*)(isu ? F.ws + WS_U + (size_t)it * 1024 : F.ws + WS_V + (size_t)(it - NEXP) * 1024) + F.lane;
        const f32x4* sp = (const f32x4*)src + F.lane;
        f32x4 a[4];
#pragma unroll
        for (int j = 0; j < 4; ++j) a[j] = sp[64 * j];
        if (isu) {
            float am = 0.f;
#pragma unroll
            for (int j = 0; j < 4; ++j) am = fmaxf(fmaxf(am, fmaxf(fabsf(a[j].x), fabsf(a[j].y))), fmaxf(fabsf(a[j].z), fabsf(a[j].w)));
#pragma unroll
            for (int o = 1; o < 64; o <<= 1) am = fmaxf(am, __shfl_xor(am, o));
            am = fmaxf(am, 1e-30f);
            const float inv = 127.0f / am;
#pragma unroll
            for (int j = 0; j < 4; ++j) { const int q0 = (int)rintf(a[j].x * inv), q1 = (int)rintf(a[j].y * inv), q2 = (int)rintf(a[j].z * inv), q3 = (int)rintf(a[j].w * inv);
                dst[64 * j] = (unsigned)(q0 & 255) | ((unsigned)(q1 & 255) << 8) | ((unsigned)(q2 & 255) << 16) | ((unsigned)(q3 & 255) << 24); }
            if (F.lane == 0) ((float*)(F.ws + WS_SU))[it] = am * (1.0f / 127.0f);
        } else {
#pragma unroll
            for (int j = 0; j < 4; ++j) { const f32x4 sv = a[j] * V_SCALE; int pk = 0; pk = __builtin_amdgcn_cvt_pk_fp8_f32(sv.x, sv.y, pk, false); pk = __builtin_amdgcn_cvt_pk_fp8_f32(sv.z, sv.w, pk, true); dst[64 * j] = (unsigned)pk; }
        }
    }
}

template <bool SRC_BF16> DI void norm_rows(Frame& F, const float* src_x, const float* src_ctx, int nrows, const float* gain, int shift_off, int scale_off, bf16* dst) {
    const float* MOD = (const float*)(F.ws + WS_MOD);
    const int per = (nrows + F.NGW - 1) / F.NGW, m_lo = F.gw * per, m_hi = min(m_lo + per, nrows);
    f32x4 gs[4], shv[4]; int cb = -1;
    for (int m = m_lo; m < m_hi; ++m) {
        const float* xrow; int b;
        if (m < NTOK) { xrow = src_x + (size_t)m * DM; b = m >> 12; } else { xrow = src_ctx + (size_t)(m - NTOK) * DM; b = 8; }
        f32x4 v[4]; float s = 0.f;
        if (SRC_BF16) { const v2u* xr = (const v2u*)((const bf16*)src_x + (size_t)m * DM) + F.lane;
#pragma unroll
            for (int j = 0; j < 4; ++j) { const v2u w = xr[64 * j]; v[j] = (f32x4){bflo(w.x), bfhi(w.x), bflo(w.y), bfhi(w.y)}; }
        } else { const f32x4* xr = (const f32x4*)xrow + F.lane;
#pragma unroll
            for (int j = 0; j < 4; ++j) v[j] = xr[64 * j]; }
        if (b != cb) { cb = b;
            const f32x4* gp = (const f32x4*)gain + F.lane; const f32x4* shp = (const f32x4*)(MOD + b * NMOD + shift_off) + F.lane; const f32x4* scp = (const f32x4*)(MOD + b * NMOD + scale_off) + F.lane;
#pragma unroll
            for (int j = 0; j < 4; ++j) { gs[j] = gp[64 * j] * (scp[64 * j] + 1.0f); shv[j] = shp[64 * j]; } }
#pragma unroll
        for (int j = 0; j < 4; ++j) s += (v[j].x * v[j].x + v[j].y * v[j].y) + (v[j].z * v[j].z + v[j].w * v[j].w);
        const float rinv = 1.0f / sqrtf(wave_sum(s) * (1.f / DM) + EPS);
        unsigned long long* o8 = (unsigned long long*)(dst + (size_t)m * DM) + F.lane;
#pragma unroll
        for (int j = 0; j < 4; ++j) { const f32x4 y = (v[j] * rinv) * gs[j] + shv[j];
            o8[64 * j] = (unsigned long long)pk2(y.x, y.y) | ((unsigned long long)pk2(y.z, y.w) << 32); }
    }
}

typedef float f32x16 __attribute__((ext_vector_type(16)));
typedef short s16x8 __attribute__((ext_vector_type(8)));
typedef __bf16 bf16x2_t __attribute__((ext_vector_type(2)));
#define MFMA32(a, b, c) __builtin_amdgcn_mfma_f32_32x32x16_bf16((a), (b), (c), 0, 0, 0)
DI unsigned cvtpk(float lo, float hi) { f32x2 v = {lo, hi}; bf16x2_t bb = __builtin_convertvector(v, bf16x2_t); return __builtin_bit_cast(unsigned, bb); }
DI float pairmax(float v) { auto rr = __builtin_amdgcn_permlane32_swap(__float_as_uint(v), __float_as_uint(v), false, false); return fmaxf(__uint_as_float(rr[0]), __uint_as_float(rr[1])); }
constexpr float LOG2E = 1.4426950408889634f, ATT_C2 = 0.125f * LOG2E, ATT_THR = 6.0f;
template <int QMASK, bool LOCAL>
DI void attn_tile(const s16x8 (&kf)[4], const s16x8 (&vf)[4], const LAS s16x8* qfp, f32x16 (&o)[2], float& m, float& l, const LAS float* brow, int djb, int lo) {
    f32x16 s; s16x8 qf[4];
#pragma unroll
    for (int ks = 0; ks < 4; ++ks) qf[ks] = qfp[ks * 64];
#pragma unroll
    for (int i = 0; i < 16; ++i) s[i] = 0.f;
#pragma unroll
    for (int ks = 0; ks < 4; ++ks) s = MFMA32(kf[ks], qf[ks], s);
    float sv[16]; float tmax = -INFINITY;
#pragma unroll
    for (int i = 0; i < 16; ++i) {
        if (!((QMASK >> (i >> 2)) & 1)) { sv[i] = -INFINITY; continue; }
        if (LOCAL) { const int dj = djb + (i & 3) + 8 * (i >> 2); const bool valid = (unsigned)(dj - lo) < 16u;
            const float x = s[i] * ATT_C2 + brow[valid ? dj : 0]; sv[i] = valid ? x : -INFINITY; }
        else sv[i] = s[i] * ATT_C2;
        tmax = fmaxf(tmax, sv[i]);
    }
    tmax = pairmax(tmax);
    if (__any(tmax > m + ATT_THR)) { const float mn = fmaxf(m, tmax), alpha = __builtin_amdgcn_exp2f(m - mn); o[0] *= alpha; o[1] *= alpha; l *= alpha; m = mn; }
    float p[16];
#pragma unroll
    for (int i = 0; i < 16; ++i) { if ((QMASK >> (i >> 2)) & 1) { p[i] = __builtin_amdgcn_exp2f(sv[i] - m); l += p[i]; } else p[i] = 0.f; }
#pragma unroll
    for (int s2 = 0; s2 < 2; ++s2) if (QMASK & (3 << (2 * s2))) {
        v4u pk; pk.x = cvtpk(p[8 * s2], p[8 * s2 + 1]); pk.y = cvtpk(p[8 * s2 + 2], p[8 * s2 + 3]); pk.z = cvtpk(p[8 * s2 + 4], p[8 * s2 + 5]); pk.w = cvtpk(p[8 * s2 + 6], p[8 * s2 + 7]);
        const s16x8 pf = __builtin_bit_cast(s16x8, pk);
        o[0] = MFMA32(vf[s2], pf, o[0]); o[1] = MFMA32(vf[2 + s2], pf, o[1]);
    }
}
DI void attn_mfma(Frame& F) {
    const bf16* QF = (const bf16*)(F.ws + WS_QF); const bf16* KF = (const bf16*)(F.ws + WS_KF); const bf16* VF = (const bf16*)(F.ws + WS_VF);
    bf16* MIX = (bf16*)(F.ws + WS_MIX); const float* rpb = F.in[10];
    LAS float* rp = (LAS float*)(F.lds);
    for (int i = F.tid; i < NHEAD * 15 * 31; i += 512) rp[i] = rpb[i] * LOG2E;
    __syncthreads();
    const int lane = F.lane, hh = lane >> 5, ql = lane & 31;
    int lo[2], djb[2][2];
#pragma unroll
    for (int qb = 0; qb < 2; ++qb) { const int qc = 32 * qb + ql, c0 = min(max(qc - 8, 0), 48); lo[qb] = c0 - qc + 15;
#pragma unroll
        for (int jb = 0; jb < 2; ++jb) djb[qb][jb] = 32 * (jb - qb) + 4 * hh - ql + 15; }
    for (int unit = F.gw; unit < NBATCH * NHEAD * 64; unit += F.NGW) {
        const int r = unit & 63, h = (unit >> 6) & 7, b = unit >> 9, bh = b * 8 + h;
        LAS s16x8* qfl = (LAS s16x8*)(F.lds + 16384 + F.wave * 8192) + lane;
#pragma unroll
        for (int qb = 0; qb < 2; ++qb)
#pragma unroll
            for (int ks = 0; ks < 4; ++ks) qfl[(qb * 4 + ks) * 64] = ((const s16x8*)(QF + (size_t)(bh * 128 + 2 * r + qb) * 2048))[ks * 64 + lane];
        f32x16 o[2][2]; float m[2], l[2];
#pragma unroll
        for (int qb = 0; qb < 2; ++qb) { m[qb] = -1e30f; l[qb] = 0.f;
#pragma unroll
            for (int dt = 0; dt < 2; ++dt)
#pragma unroll
                for (int i = 0; i < 16; ++i) o[qb][dt][i] = 0.f; }
        const int r0 = min(max(r - 4, 0), 56);
        s16x8 kf[4], vf[4], kn[4];
        { const s16x8* kp = (const s16x8*)(KF + (size_t)(bh * 136 + 128) * 2048) + lane;
#pragma unroll
          for (int j = 0; j < 4; ++j) kn[j] = kp[j * 64]; }
#pragma unroll 1
        for (int kb = 0; kb < 8; ++kb) {
            { const s16x8* vp = (const s16x8*)(VF + (size_t)(bh * 136 + 128 + kb) * 2048) + lane;
#pragma unroll
              for (int j = 0; j < 4; ++j) { kf[j] = kn[j]; vf[j] = vp[j * 64]; } }
            { const int nb = (kb < 7) ? bh * 136 + 128 + kb + 1 : bh * 136 + 2 * r0;
              const s16x8* kp = (const s16x8*)(KF + (size_t)nb * 2048) + lane;
#pragma unroll
              for (int j = 0; j < 4; ++j) kn[j] = kp[j * 64]; }
            attn_tile<15, false>(kf, vf, qfl, o[0], m[0], l[0], rp, 0, 0); __builtin_amdgcn_sched_barrier(0);
            attn_tile<15, false>(kf, vf, qfl + 256, o[1], m[1], l[1], rp, 0, 0); __builtin_amdgcn_sched_barrier(0);
        }
#pragma unroll 1
        for (int i = 0; i < 8; ++i) {
            const LAS float* brow = rp + (h * 15 + (r0 + i - r + 7)) * 31;
            { const s16x8* vp = (const s16x8*)(VF + (size_t)(bh * 136 + 2 * (r0 + i)) * 2048) + lane;
#pragma unroll
              for (int j = 0; j < 4; ++j) { kf[j] = kn[j]; vf[j] = vp[j * 64]; } }
            { const int nb = bh * 136 + 2 * (r0 + i) + 1;
              const s16x8* kp = (const s16x8*)(KF + (size_t)nb * 2048) + lane;
#pragma unroll
              for (int j = 0; j < 4; ++j) kn[j] = kp[j * 64]; }
            attn_tile<15, true>(kf, vf, qfl, o[0], m[0], l[0], brow, djb[0][0], lo[0]); __builtin_amdgcn_sched_barrier(0);
            attn_tile<8, true>(kf, vf, qfl + 256, o[1], m[1], l[1], brow, djb[1][0], lo[1]); __builtin_amdgcn_sched_barrier(0);
            { const s16x8* vp = (const s16x8*)(VF + (size_t)(bh * 136 + 2 * (r0 + i) + 1) * 2048) + lane;
#pragma unroll
              for (int j = 0; j < 4; ++j) { kf[j] = kn[j]; vf[j] = vp[j * 64]; } }
            { const int nb = bh * 136 + 2 * (r0 + ((i < 7) ? i + 1 : 0));
              const s16x8* kp = (const s16x8*)(KF + (size_t)nb * 2048) + lane;
#pragma unroll
              for (int j = 0; j < 4; ++j) kn[j] = kp[j * 64]; }
            attn_tile<1, true>(kf, vf, qfl, o[0], m[0], l[0], brow, djb[0][1], lo[0]); __builtin_amdgcn_sched_barrier(0);
            attn_tile<15, true>(kf, vf, qfl + 256, o[1], m[1], l[1], brow, djb[1][1], lo[1]); __builtin_amdgcn_sched_barrier(0);
        }
#pragma unroll
        for (int qb = 0; qb < 2; ++qb) {
            const float lt = l[qb] + __shfl_xor(l[qb], 32), inv = 1.0f / lt;
            bf16* orow = MIX + (size_t)(b * SEQ + r * GRIDW + 32 * qb + ql) * DM + 512 + h * 64 + 4 * hh;
#pragma unroll
            for (int dt = 0; dt < 2; ++dt)
#pragma unroll
                for (int g = 0; g < 4; ++g) { v2u w; w.x = pk2(o[qb][dt][4 * g] * inv, o[qb][dt][4 * g + 1] * inv); w.y = pk2(o[qb][dt][4 * g + 2] * inv, o[qb][dt][4 * g + 3] * inv);
                    *(v2u*)(orow + 32 * dt + 8 * g) = w; }
        }
    }
    __syncthreads();
}
DI void pool_mfma(Frame& F) {
    const bf16* PBF = (const bf16*)(F.ws + WS_PB); bf16* MIX = (bf16*)(F.ws + WS_MIX); const bf16* PW = (const bf16*)(F.ws + WS_POOLW); const float* pool_scale = F.in[9];
    constexpr int RS = 272;
    LAS unsigned char* ptile = F.lds + 32768;
    LAS unsigned char* atile = F.lds + 32768 + 144 * RS;
    const int lane = F.lane, hh = lane >> 5, ql = lane & 31;
    for (int tile = F.vcu; tile < NTOK / 128; tile += F.G) {
        const int tok0 = tile * 128, bstart = tok0 & ~(SEQ - 1);
#pragma unroll 1
        for (int g = 0; g < 4; ++g) {
            for (int it = F.tid; it < 144 * 16; it += 512) { const int rr = it >> 4, ch = it & 15, t = tok0 - 8 + rr;
                v4u v = (v4u){0u, 0u, 0u, 0u};
                if (t >= bstart && t < bstart + SEQ) v = *(const v4u*)(PBF + (size_t)t * 512 + g * 128 + ch * 8);
                *(LAS v4u*)(ptile + rr * RS + ch * 16) = v; }
            __syncthreads();
            { const int cp = F.tid & 63, sg = F.tid >> 6, w = 2 << g, hw = w >> 1;
              const LAS unsigned char* col = ptile + cp * 4;
              float s0 = 0.f, s1 = 0.f;
              const int tl0 = sg * 16;
              for (int rr = tl0 + 8 - hw; rr < tl0 + 8 + hw; ++rr) { const unsigned u = *(const LAS unsigned*)(col + rr * RS); s0 += bflo(u); s1 += bfhi(u); }
#pragma unroll 4
              for (int i = 0; i < 16; ++i) { const int tl = tl0 + i, sp = (tok0 + tl) & (SEQ - 1);
                  const int cnt = min(sp + hw, SEQ) - max(sp - hw, 0); const float inv = 1.0f / (float)cnt;
                  const unsigned self = *(const LAS unsigned*)(col + (tl + 8) * RS);
                  *(LAS unsigned*)(atile + tl * RS + cp * 4) = pk2(s0 * inv - bflo(self), s1 * inv - bfhi(self));
                  const unsigned un = *(const LAS unsigned*)(col + (tl + 8 + hw) * RS), uo = *(const LAS unsigned*)(col + (tl + 8 - hw) * RS);
                  s0 += bflo(un) - bflo(uo); s1 += bfhi(un) - bfhi(uo); } }
            __syncthreads();
            { const int tb = F.wave >> 1, dt0 = (F.wave & 1) * 2;
              f32x16 acc[2];
#pragma unroll
              for (int j = 0; j < 2; ++j)
#pragma unroll
                  for (int i = 0; i < 16; ++i) acc[j][i] = 0.f;
#pragma unroll
              for (int ks = 0; ks < 8; ++ks) {
                  const s16x8 bfr = *(const LAS s16x8*)(atile + (32 * tb + ql) * RS + (16 * ks + 8 * hh) * 2);
#pragma unroll
                  for (int j = 0; j < 2; ++j) { const s16x8 afr = *(const s16x8*)(PW + (size_t)g * 16384 + (32 * (dt0 + j) + ql) * 128 + 16 * ks + 8 * hh);
                      acc[j] = MFMA32(afr, bfr, acc[j]); } }
              bf16* orow = MIX + (size_t)(tok0 + 32 * tb + ql) * DM + g * 128 + 4 * hh;
#pragma unroll
              for (int j = 0; j < 2; ++j)
#pragma unroll
                  for (int q = 0; q < 4; ++q) { const int d = 32 * (dt0 + j) + 8 * q; const f32x4 sc = *(const f32x4*)(pool_scale + g * 128 + d + 4 * hh);
                      v2u wv; wv.x = pk2(acc[j][4 * q] * sc.x, acc[j][4 * q + 1] * sc.y); wv.y = pk2(acc[j][4 * q + 2] * sc.z, acc[j][4 * q + 3] * sc.w);
                      *(v2u*)(orow + d) = wv; } }
            __syncthreads();
        }
    }
}
DI int f2key(float f) { const int b = __float_as_int(f); return b ^ ((b >> 31) & 0x7fffffff); }
DI float key2f(int k) { return __int_as_float(k ^ ((k >> 31) & 0x7fffffff)); }
DI void ce_desc(int& x, int& y) { const int hi = max(x, y), lo = min(x, y); x = hi; y = lo; }
DI void sort16_desc(int (&a)[16]) {
#pragma unroll
    for (int k = 2; k <= 16; k <<= 1)
#pragma unroll
        for (int j = k >> 1; j > 0; j >>= 1)
#pragma unroll
            for (int i = 0; i < 16; ++i) { const int l = i ^ j; if (l > i) { if ((i & k) == 0) ce_desc(a[i], a[l]); else ce_desc(a[l], a[i]); } }
}
DI void merge16_desc(int (&a)[16], const int (&b)[16]) {
#pragma unroll
    for (int i = 0; i < 16; ++i) a[i] = max(a[i], b[15 - i]);
#pragma unroll
    for (int j = 8; j > 0; j >>= 1)
#pragma unroll
        for (int i = 0; i < 16; ++i) if ((i & j) == 0) ce_desc(a[i], a[i + j]);
}
DI void peer_topk_mfma(Frame& F, int tile) {
    const bf16* QP = (const bf16*)(F.ws + WS_ZX); const bf16* KEYF = (const bf16*)(F.ws + WS_KEYS);
    int* EXPERTS = (int*)(F.ws + WS_EXP); float* GATES = (float*)(F.ws + WS_GATE);
    const int lane = F.lane, hh = lane >> 5, ql = lane & 31, tb = F.wave >> 1, p = F.wave & 1;
    const int tokblk = tile * 4 + tb, tok = tokblk * 32 + ql;
#pragma unroll 1
    for (int h = 0; h < 8; ++h) {
        const int hp = 2 * h + p;
        s16x8 qf[8];
#pragma unroll
        for (int ks = 0; ks < 8; ++ks) qf[ks] = ((const s16x8*)(QP + ((size_t)tokblk * 16 + hp) * 4096))[ks * 64 + lane];
        const s16x8* kfp = (const s16x8*)(KEYF + (size_t)hp * 16384) + lane;
        int top[16];
#pragma unroll
        for (int i = 0; i < 16; ++i) top[i] = (int)0x80000000;
#pragma unroll 1
        for (int nt = 0; nt < 4; ++nt) {
            f32x16 acc;
#pragma unroll
            for (int i = 0; i < 16; ++i) acc[i] = 0.f;
#pragma unroll
            for (int ks = 0; ks < 8; ++ks) acc = MFMA32(kfp[(nt * 8 + ks) * 64], qf[ks], acc);
            int a[16];
#pragma unroll
            for (int i = 0; i < 16; ++i) { const int n = 32 * nt + (i & 3) + 8 * (i >> 2) + 4 * hh; a[i] = f2key(__int_as_float((__float_as_int(acc[i]) & ~127) | n)); }
            sort16_desc(a);
            merge16_desc(top, a);
        }
        { int oth[16];
#pragma unroll
          for (int i = 0; i < 16; ++i) oth[i] = __shfl_xor(top[i], 32);
          merge16_desc(top, oth); }
        LAS float* L = (LAS float*)(F.lds) + (h & 1) * 4096 + (tb * 2) * 512;
        if (hh == 0) {
#pragma unroll
            for (int i = 0; i < 16; ++i) L[p * 512 + i * 32 + ql] = key2f(top[i]);
        }
        __syncthreads();
        if (p == 0 && hh == 0) {
            float v0[16], v1[16];
#pragma unroll
            for (int i = 0; i < 16; ++i) { v0[i] = __int_as_float(__float_as_int(L[i * 32 + ql]) & ~127); v1[i] = __int_as_float(__float_as_int(L[512 + i * 32 + ql]) & ~127); }
            int grp[4][16]; int cnt = 0;
#pragma unroll
            for (int g = 0; g < 4; ++g)
#pragma unroll
                for (int i = 0; i < 16; ++i) grp[g][i] = (int)0x80000000;
#pragma unroll
            for (int i = 0; i < 16; ++i)
#pragma unroll
                for (int j = 0; j < 16; ++j) if ((i + 1) * (j + 1) <= 16) {
                    grp[cnt >> 4][cnt & 15] = f2key(__int_as_float((__float_as_int(v0[i] + v1[j]) & ~255) | (i * 16 + j))); ++cnt; }
#pragma unroll
            for (int g = 0; g < 4; ++g) sort16_desc(grp[g]);
            merge16_desc(grp[0], grp[1]); merge16_desc(grp[2], grp[3]); merge16_desc(grp[0], grp[2]);
            float tv[16]; float e[16]; float sum = 0.f; int eid[16];
#pragma unroll
            for (int k = 0; k < 16; ++k) { const int bits = __float_as_int(key2f(grp[0][k])); const int code = bits & 255; tv[k] = __int_as_float(bits & ~255);
                const int n0 = __float_as_int(L[(code >> 4) * 32 + ql]) & 127, n1 = __float_as_int(L[512 + (code & 15) * 32 + ql]) & 127; eid[k] = n0 * 128 + n1; }
#pragma unroll
            for (int k = 0; k < 16; ++k) { e[k] = __expf(tv[k] - tv[0]); sum += e[k]; }
            const float is = 1.0f / sum;
            int* ep = EXPERTS + (size_t)tok * 128 + h * 16; float* gp = GATES + (size_t)tok * 128 + h * 16;
#pragma unroll
            for (int k4 = 0; k4 < 4; ++k4) { *(v4u*)(ep + 4 * k4) = (v4u){(unsigned)eid[4 * k4], (unsigned)eid[4 * k4 + 1], (unsigned)eid[4 * k4 + 2], (unsigned)eid[4 * k4 + 3]};
                *(f32x4*)(gp + 4 * k4) = (f32x4){e[4 * k4] * is, e[4 * k4 + 1] * is, e[4 * k4 + 2] * is, e[4 * k4 + 3] * is}; }
        }
    }
    VM_WAIT(); __syncthreads();
}

DI float gelu_fast(float v) {
    const float av = fabsf(v), t = __builtin_amdgcn_rcpf(av * 0.2316418882f + 1.0f);
    float q = t * 0.5307027145f + (-0.7265760135f); q = q * t + 0.7107068705f; q = q * t + (-0.142248368f); q = q * t + 0.127414796f; q = q * t;
    const float e = __builtin_amdgcn_exp2f((v * v) * (-0.72134752044f));
    const float m = v * (q * e);
    return v < 0.f ? m : v - m;
}
DI float gelu_exact(float a) { return 0.5f * a * (1.0f + erff(a * 0.70710678118654752f)); }

DI void fp8x16_to_f32(const v4u r, float (&f)[16]) {
#pragma unroll
    for (int j = 0; j < 4; ++j) { const f32x2 lo = __builtin_amdgcn_cvt_pk_f32_fp8((int)r[j], false), hi = __builtin_amdgcn_cvt_pk_f32_fp8((int)r[j], true);
        f[4 * j] = lo.x; f[4 * j + 1] = lo.y; f[4 * j + 2] = hi.x; f[4 * j + 3] = hi.y; }
}
typedef __bf16 bf16x2v __attribute__((ext_vector_type(2)));
#ifndef G2_NOSORT
#define G2_NOSORT 0
#endif
#define TOK_CASE(JV, BODY) { constexpr int j = JV; BODY }
#define TOK_DISPATCHN(tk, BODY) do { if constexpr (NT == 1) TOK_CASE(0, BODY) else if constexpr (NT == 2) { if ((tk) < 1) TOK_CASE(0, BODY) else TOK_CASE(1, BODY) } \
    else { if ((tk) < 2) { if ((tk) < 1) TOK_CASE(0, BODY) else TOK_CASE(1, BODY) } else { if ((tk) < 3) TOK_CASE(2, BODY) else TOK_CASE(NT > 3 ? 3 : 0, BODY) } } } while (0)
template <int NT, bool FAKE = false> DI void gather_round(Frame& F, int tbase) {
    constexpr int NK = 2 * NT, N = 128 * NT, NB = N / 8, LPB = 8 / NK;
    const bf16* H2 = (const bf16*)(F.ws + WS_HX); const unsigned char* U = F.ws + WS_U; const unsigned char* V = F.ws + WS_V;
    const int* EXPERTS = (const int*)(F.ws + WS_EXP); const float* GATES = (const float*)(F.ws + WS_GATE); const float* MOD = (const float*)(F.ws + WS_MOD);
    const int lane = F.lane;
    int key[NK];
#pragma unroll
    for (int j = 0; j < NT; ++j)
#pragma unroll
        for (int hf = 0; hf < 2; ++hf) { const int k = hf * 64 + lane; key[j * 2 + hf] = (EXPERTS[(size_t)(tbase + j) * 128 + k] << 9) | (j << 7) | k; }
#pragma unroll
    for (int k = 2; k <= (G2_NOSORT ? 1 : N); k <<= 1)
#pragma unroll
        for (int j = k >> 1; j > 0; j >>= 1) {
            if (j < NK) {
#pragma unroll
                for (int r = 0; r < NK; ++r) if ((r & j) == 0) { const bool asc = (((lane * NK + r) & k) == 0); const int x = key[r], y = key[r | j], lo = min(x, y), hi = max(x, y);
                    key[r] = asc ? lo : hi; key[r | j] = asc ? hi : lo; }
            } else {
                const bool asc = (((lane * NK) & k) == 0), lower = ((lane & (j / NK)) == 0), takemin = (asc == lower);
#pragma unroll
                for (int r = 0; r < NK; ++r) { const int o = __shfl_xor(key[r], j / NK); key[r] = takemin ? min(key[r], o) : max(key[r], o); }
            }
        }
    LAS v4u* hL = (LAS v4u*)(F.lds + 98304) + F.wave * (NT * 64) + lane;
    float hsc[NT]; float out[NT][16];
#pragma unroll
    for (int j = 0; j < NT; ++j) { const v4u a = *((const v4u*)(H2 + (size_t)(tbase + j) * DM + lane * 16)), b = *((const v4u*)(H2 + (size_t)(tbase + j) * DM + lane * 16 + 8));
        float hv[16]; hv[0] = bflo(a.x); hv[1] = bfhi(a.x); hv[2] = bflo(a.y); hv[3] = bfhi(a.y); hv[4] = bflo(a.z); hv[5] = bfhi(a.z); hv[6] = bflo(a.w); hv[7] = bfhi(a.w);
        hv[8] = bflo(b.x); hv[9] = bfhi(b.x); hv[10] = bflo(b.y); hv[11] = bfhi(b.y); hv[12] = bflo(b.z); hv[13] = bfhi(b.z); hv[14] = bflo(b.w); hv[15] = bfhi(b.w);
        float am = 0.f;
#pragma unroll
        for (int i = 0; i < 16; ++i) am = fmaxf(am, fabsf(hv[i]));
#pragma unroll
        for (int o = 1; o < 64; o <<= 1) am = fmaxf(am, __shfl_xor(am, o));
        am = fmaxf(am, 1e-30f); hsc[j] = am * (1.0f / 127.0f);
        const float inv = 127.0f / am;
        v4u hq;
#pragma unroll
        for (int d = 0; d < 4; ++d) { const int q0 = (int)rintf(hv[4 * d] * inv), q1 = (int)rintf(hv[4 * d + 1] * inv), q2 = (int)rintf(hv[4 * d + 2] * inv), q3 = (int)rintf(hv[4 * d + 3] * inv);
            hq[d] = (unsigned)(q0 & 255) | ((unsigned)(q1 & 255) << 8) | ((unsigned)(q2 & 255) << 16) | ((unsigned)(q3 & 255) << 24); }
        hL[j * 64] = hq;
#pragma unroll
        for (int i = 0; i < 16; ++i) out[j][i] = 0.f; }
    LAS float* sgL = (LAS float*)(F.lds + 65536) + F.wave * (2 * N); LAS float* suL = sgL + N;
    const float* SU = (const float*)(F.ws + WS_SU);
#pragma unroll
    for (int r = 0; r < NK; ++r) { const int tj = (key[r] >> 7) & 3; float sc = hsc[0];
#pragma unroll
        for (int j = 1; j < NT; ++j) sc = (tj == j) ? hsc[j] : sc;
        sgL[lane * NK + r] = GATES[(size_t)(tbase + tj) * 128 + (key[r] & 127)]; suL[lane * NK + r] = SU[(key[r] >> 9) & (FAKE ? FAKE_MASK : 16383)] * sc; }
    v4u ucur[8];
#pragma unroll
    for (int r = 0; r < 8; ++r) { const int kk = __builtin_amdgcn_readlane(key[r % NK], r / NK); ucur[r] = *((const v4u*)(U + (size_t)((kk >> 9) & (FAKE ? FAKE_MASK : 16383)) * 1024) + lane); }
#pragma unroll 1
    for (int b = 0; b < NB; ++b) {
        int kk[8]; v4u vcur[8];
#pragma unroll
        for (int r = 0; r < 8; ++r) { kk[r] = __builtin_amdgcn_readlane(key[r % NK], b * LPB + r / NK); vcur[r] = *((const v4u*)(V + (size_t)((kk[r] >> 9) & (FAKE ? FAKE_MASK : 16383)) * 1024) + lane); }
        int p[8]; v4u hsel[8];
#pragma unroll
        for (int r = 0; r < 8; ++r) { hsel[r] = hL[((kk[r] >> 7) & 3) * 64]; p[r] = 0; }
#pragma unroll
        for (int q = 0; q < 4; ++q)
#pragma unroll
            for (int r = 0; r < 8; ++r) p[r] = __builtin_amdgcn_sdot4((int)ucur[r][q], (int)hsel[r][q], p[r], false);
        { const int bn = (b + 1 < NB) ? b + 1 : 0;
#pragma unroll
          for (int r = 0; r < 8; ++r) { const int kn = __builtin_amdgcn_readlane(key[r % NK], bn * LPB + r / NK); ucur[r] = *((const v4u*)(U + (size_t)((kn >> 9) & (FAKE ? FAKE_MASK : 16383)) * 1024) + lane); } }
        int psum;
        { int q4[4];
#pragma unroll
          for (int i = 0; i < 4; ++i) { auto rr = __builtin_amdgcn_permlane32_swap((unsigned)p[i], (unsigned)p[i + 4], false, false); q4[i] = (int)(rr[0] + rr[1]); }
          int q2[2];
#pragma unroll
          for (int i = 0; i < 2; ++i) { auto rr = __builtin_amdgcn_permlane16_swap((unsigned)q4[i], (unsigned)q4[i + 2], false, false); q2[i] = (int)(rr[0] + rr[1]); }
          const int t0 = q2[0] + __builtin_amdgcn_update_dpp(0, q2[0], 0x128, 0xf, 0xf, false);
          const int t1 = q2[1] + __builtin_amdgcn_update_dpp(0, q2[1], 0x128, 0xf, 0xf, false);
          int v = (lane & 8) ? t1 : t0;
          v += __builtin_amdgcn_update_dpp(0, v, 0x141, 0xf, 0xf, false);
          v += __builtin_amdgcn_update_dpp(0, v, 0x4e, 0xf, 0xf, false);
          v += __builtin_amdgcn_update_dpp(0, v, 0xb1, 0xf, 0xf, false);
          psum = v; }
        const float w = sgL[b * 8 + ((lane >> 3) & 7)] * gelu_fast((float)psum * suL[b * 8 + ((lane >> 3) & 7)]);
#pragma unroll
        for (int r = 0; r < 8; ++r) { const float wr = __builtin_bit_cast(float, __builtin_amdgcn_readlane(__builtin_bit_cast(int, w), r * 8)); float f[16]; fp8x16_to_f32(vcur[r], f);
            const int tk = (kk[r] >> 7) & 3;
#pragma unroll
            for (int j = 0; j < NT; ++j) if (tk == j) {
#pragma unroll
                for (int i = 0; i < 16; ++i) out[j][i] += wr * f[i]; } }
    }
    const float* fg = F.in[17];
#pragma unroll
    for (int j = 0; j < NT; ++j) {
        const int t = tbase + j, bb = t >> 12; const float* g2 = MOD + bb * NMOD + 5 * DM; float* xo = F.out + (size_t)t * DM;
        const bf16* x1r = (const bf16*)(F.ws + WS_X1) + (size_t)t * DM + lane * 16;
        float x2[16]; float ss = 0.f;
#pragma unroll
        for (int hq = 0; hq < 4; ++hq) { const int c = lane * 16 + hq * 4; const v2u xw = *(const v2u*)(x1r + hq * 4); const f32x4 xv = (f32x4){bflo(xw.x), bfhi(xw.x), bflo(xw.y), bfhi(xw.y)}, gv = *(const f32x4*)(g2 + c);
#pragma unroll
            for (int e = 0; e < 4; ++e) { const float y = xv[e] + gv[e] * (out[j][hq * 4 + e] * (1.0f / V_SCALE)); x2[hq * 4 + e] = y; ss += y * y; } }
        const float rinv = 1.0f / sqrtf(wave_sum(ss) * (1.f / DM) + EPS);
#pragma unroll
        for (int hq = 0; hq < 4; ++hq) { const int c = lane * 16 + hq * 4; const f32x4 fv = *(const f32x4*)(fg + c);
            f32x4 y;
#pragma unroll
            for (int e = 0; e < 4; ++e) y[e] = x2[hq * 4 + e] * rinv * fv[e];
            if (!FAKE || rinv == 12345.678f) *(f32x4*)(xo + c) = y; }
    }
}

template <int NT> DI void gather_vonly(Frame& F, int tbase) {
    constexpr bool FAKE = false;
    constexpr int NK = 2 * NT, N = 128 * NT, NB = N / 8, LPB = 8 / NK;
    const bf16* H2 = (const bf16*)(F.ws + WS_HX); const unsigned char* U = F.ws + WS_U; const unsigned char* V = F.ws + WS_V;
    const int* EXPERTS = (const int*)(F.ws + WS_EXP); const float* GATES = (const float*)(F.ws + WS_GATE); const float* MOD = (const float*)(F.ws + WS_MOD);
    const int lane = F.lane;
    int key[NK];
#pragma unroll
    for (int j = 0; j < NT; ++j)
#pragma unroll
        for (int hf = 0; hf < 2; ++hf) { const int k = hf * 64 + lane; key[j * 2 + hf] = (EXPERTS[(size_t)(tbase + j) * 128 + k] << 9) | (j << 7) | k; }
#pragma unroll
    for (int k = 2; k <= (G2_NOSORT ? 1 : N); k <<= 1)
#pragma unroll
        for (int j = k >> 1; j > 0; j >>= 1) {
            if (j < NK) {
#pragma unroll
                for (int r = 0; r < NK; ++r) if ((r & j) == 0) { const bool asc = (((lane * NK + r) & k) == 0); const int x = key[r], y = key[r | j], lo = min(x, y), hi = max(x, y);
                    key[r] = asc ? lo : hi; key[r | j] = asc ? hi : lo; }
            } else {
                const bool asc = (((lane * NK) & k) == 0), lower = ((lane & (j / NK)) == 0), takemin = (asc == lower);
#pragma unroll
                for (int r = 0; r < NK; ++r) { const int o = __shfl_xor(key[r], j / NK); key[r] = takemin ? min(key[r], o) : max(key[r], o); }
            }
        }
    LAS v4u* hL = (LAS v4u*)(F.lds + 98304) + F.wave * (NT * 64) + lane;
    float hsc[NT]; float out[NT][16];
#pragma unroll
    for (int j = 0; j < NT; ++j) { const v4u a = *((const v4u*)(H2 + (size_t)(tbase + j) * DM + lane * 16)), b = *((const v4u*)(H2 + (size_t)(tbase + j) * DM + lane * 16 + 8));
        float hv[16]; hv[0] = bflo(a.x); hv[1] = bfhi(a.x); hv[2] = bflo(a.y); hv[3] = bfhi(a.y); hv[4] = bflo(a.z); hv[5] = bfhi(a.z); hv[6] = bflo(a.w); hv[7] = bfhi(a.w);
        hv[8] = bflo(b.x); hv[9] = bfhi(b.x); hv[10] = bflo(b.y); hv[11] = bfhi(b.y); hv[12] = bflo(b.z); hv[13] = bfhi(b.z); hv[14] = bflo(b.w); hv[15] = bfhi(b.w);
        float am = 0.f;
#pragma unroll
        for (int i = 0; i < 16; ++i) am = fmaxf(am, fabsf(hv[i]));
#pragma unroll
        for (int o = 1; o < 64; o <<= 1) am = fmaxf(am, __shfl_xor(am, o));
        am = fmaxf(am, 1e-30f); hsc[j] = am * (1.0f / 127.0f);
        const float inv = 127.0f / am;
        v4u hq;
#pragma unroll
        for (int d = 0; d < 4; ++d) { const int q0 = (int)rintf(hv[4 * d] * inv), q1 = (int)rintf(hv[4 * d + 1] * inv), q2 = (int)rintf(hv[4 * d + 2] * inv), q3 = (int)rintf(hv[4 * d + 3] * inv);
            hq[d] = (unsigned)(q0 & 255) | ((unsigned)(q1 & 255) << 8) | ((unsigned)(q2 & 255) << 16) | ((unsigned)(q3 & 255) << 24); }
        hL[j * 64] = hq;
#pragma unroll
        for (int i = 0; i < 16; ++i) out[j][i] = 0.f; }
    LAS float* sgL = (LAS float*)(F.lds + 65536) + F.wave * (2 * N); LAS float* suL = sgL + N;
    const float* SU = (const float*)(F.ws + WS_SU);
#pragma unroll
    for (int r = 0; r < NK; ++r) { const int tj = (key[r] >> 7) & 3; float sc = hsc[0];
#pragma unroll
        for (int j = 1; j < NT; ++j) sc = (tj == j) ? hsc[j] : sc;
        sgL[lane * NK + r] = GATES[(size_t)(tbase + tj) * 128 + (key[r] & 127)]; suL[lane * NK + r] = SU[(key[r] >> 9) & (FAKE ? FAKE_MASK : 16383)] * sc; }
    v4u vb[2][8];
#pragma unroll
    for (int par = 0; par < 2; ++par)
#pragma unroll
        for (int r = 0; r < 8; ++r) vb[par][r] = *((const v4u*)(V + (size_t)(__builtin_amdgcn_readlane(key[r], par) >> 9) * 1024) + lane);
#pragma unroll 1
    for (int b2 = 0; b2 < NB / 2; ++b2) {
#pragma unroll
      for (int par = 0; par < 2; ++par) {
        const int b = 2 * b2 + par, bn = (b + 2 < NB) ? b + 2 : par;
        int kk[8];
#pragma unroll
        for (int r = 0; r < 8; ++r) kk[r] = __builtin_amdgcn_readlane(key[r], b);
        const float w = sgL[b * 8 + ((lane >> 3) & 7)];
#pragma unroll
        for (int r = 0; r < 8; ++r) { const float wr = __builtin_bit_cast(float, __builtin_amdgcn_readlane(__builtin_bit_cast(int, w), r * 8)); float f[16]; fp8x16_to_f32(vb[par][r], f);
            const int tk = (kk[r] >> 7) & 3;
#pragma unroll
            for (int j = 0; j < NT; ++j) if (tk == j) {
#pragma unroll
                for (int i = 0; i < 16; ++i) out[j][i] += wr * f[i]; } }
#pragma unroll
        for (int r = 0; r < 8; ++r) vb[par][r] = *((const v4u*)(V + (size_t)(__builtin_amdgcn_readlane(key[r], bn) >> 9) * 1024) + lane);
      }
    }
    const float* fg = F.in[17];
#pragma unroll
    for (int j = 0; j < NT; ++j) {
        const int t = tbase + j, bb = t >> 12; const float* g2 = MOD + bb * NMOD + 5 * DM; float* xo = F.out + (size_t)t * DM;
        const bf16* x1r = (const bf16*)(F.ws + WS_X1) + (size_t)t * DM + lane * 16;
        float x2[16]; float ss = 0.f;
#pragma unroll
        for (int hq = 0; hq < 4; ++hq) { const int c = lane * 16 + hq * 4; const v2u xw = *(const v2u*)(x1r + hq * 4); const f32x4 xv = (f32x4){bflo(xw.x), bfhi(xw.x), bflo(xw.y), bfhi(xw.y)}, gv = *(const f32x4*)(g2 + c);
#pragma unroll
            for (int e = 0; e < 4; ++e) { const float y = xv[e] + gv[e] * (out[j][hq * 4 + e] * (1.0f / V_SCALE)); x2[hq * 4 + e] = y; ss += y * y; } }
        const float rinv = 1.0f / sqrtf(wave_sum(ss) * (1.f / DM) + EPS);
#pragma unroll
        for (int hq = 0; hq < 4; ++hq) { const int c = lane * 16 + hq * 4; const f32x4 fv = *(const f32x4*)(fg + c);
            f32x4 y;
#pragma unroll
            for (int e = 0; e < 4; ++e) y[e] = x2[hq * 4 + e] * rinv * fv[e];
            if (rinv == 12345.678f) *(f32x4*)(xo + c) = y; }
    }
}

template <bool FAKE = false, bool UONLY = false> DI void gather_v4(Frame& F, int tbase) {
    constexpr int NT = 8, NK = 16, N = 1024;
    const bf16* H2 = (const bf16*)(F.ws + WS_HX); const unsigned char* U = F.ws + WS_U; const unsigned char* V = F.ws + WS_V;
    const int* EXPERTS = (const int*)(F.ws + WS_EXP); const float* GATES = (const float*)(F.ws + WS_GATE); const float* MOD = (const float*)(F.ws + WS_MOD);
    const float* SU = (const float*)(F.ws + WS_SU);
    const int lane = F.lane;
    constexpr int EM = FAKE ? FAKE_MASK : 16383;
    int key[NK];
#pragma unroll
    for (int j = 0; j < NT; ++j)
#pragma unroll
        for (int hf = 0; hf < 2; ++hf) { const int k = hf * 64 + lane; key[j * 2 + hf] = (EXPERTS[(size_t)(tbase + j) * 128 + k] << 10) | (j << 7) | k; }
#pragma unroll
    for (int k = 2; k <= N; k <<= 1)
#pragma unroll
        for (int j = k >> 1; j > 0; j >>= 1) {
            if (j < NK) {
#pragma unroll
                for (int r = 0; r < NK; ++r) if ((r & j) == 0) { const bool asc = (((lane * NK + r) & k) == 0); const int x = key[r], y = key[r | j], lo = min(x, y), hi = max(x, y);
                    key[r] = asc ? lo : hi; key[r | j] = asc ? hi : lo; }
            } else {
                const bool asc = (((lane * NK) & k) == 0), lower = ((lane & (j / NK)) == 0), takemin = (asc == lower);
#pragma unroll
                for (int r = 0; r < NK; ++r) { const int o = __shfl_xor(key[r], j / NK); key[r] = takemin ? min(key[r], o) : max(key[r], o); }
            }
        }
    LAS v4u* hL = (LAS v4u*)(F.lds) + F.wave * (NT * 64) + lane;
    LAS float* sgL = (LAS float*)(F.lds + 65536) + F.wave * (2 * N); LAS float* suL = sgL + N;
    {   float hsc[NT];
#pragma unroll
        for (int j = 0; j < NT; ++j) { const v4u a = *((const v4u*)(H2 + (size_t)(tbase + j) * DM + lane * 16)), b = *((const v4u*)(H2 + (size_t)(tbase + j) * DM + lane * 16 + 8));
            float hv[16]; hv[0] = bflo(a.x); hv[1] = bfhi(a.x); hv[2] = bflo(a.y); hv[3] = bfhi(a.y); hv[4] = bflo(a.z); hv[5] = bfhi(a.z); hv[6] = bflo(a.w); hv[7] = bfhi(a.w);
            hv[8] = bflo(b.x); hv[9] = bfhi(b.x); hv[10] = bflo(b.y); hv[11] = bfhi(b.y); hv[12] = bflo(b.z); hv[13] = bfhi(b.z); hv[14] = bflo(b.w); hv[15] = bfhi(b.w);
            float am = 0.f;
#pragma unroll
            for (int i = 0; i < 16; ++i) am = fmaxf(am, fabsf(hv[i]));
#pragma unroll
            for (int o = 1; o < 64; o <<= 1) am = fmaxf(am, __shfl_xor(am, o));
            am = fmaxf(am, 1e-30f); hsc[j] = am * (1.0f / 127.0f);
            const float inv = 127.0f / am;
            v4u hq;
#pragma unroll
            for (int d = 0; d < 4; ++d) { const int q0 = (int)rintf(hv[4 * d] * inv), q1 = (int)rintf(hv[4 * d + 1] * inv), q2 = (int)rintf(hv[4 * d + 2] * inv), q3 = (int)rintf(hv[4 * d + 3] * inv);
                hq[d] = (unsigned)(q0 & 255) | ((unsigned)(q1 & 255) << 8) | ((unsigned)(q2 & 255) << 16) | ((unsigned)(q3 & 255) << 24); }
            hL[j * 64] = hq; }
#pragma unroll
        for (int r = 0; r < NK; ++r) { const int tj = (key[r] >> 7) & 7; float sc = hsc[0];
#pragma unroll
            for (int j = 1; j < NT; ++j) sc = (tj == j) ? hsc[j] : sc;
            sgL[lane * NK + r] = GATES[(size_t)(tbase + tj) * 128 + (key[r] & 127)]; suL[lane * NK + r] = SU[(key[r] >> 10) & EM] * sc; } }
#define V4_ROW(TBL, par, ln, r) (*((const v4u*)((TBL) + (size_t)((__builtin_amdgcn_readlane(key[(par) * 8 + (r)], (ln)) >> 10) & EM) * 1024) + lane))
    {   v4u ub[2][8];
#pragma unroll
        for (int par = 0; par < 2; ++par)
#pragma unroll
            for (int r = 0; r < 8; ++r) ub[par][r] = V4_ROW(U, par, 0, r);
#pragma unroll 1
        for (int b2 = 0; b2 < 64; ++b2) {
            const int bn2 = (b2 + 1) & 63;
#pragma unroll
            for (int par = 0; par < 2; ++par) {
                int p[8]; v4u hsel[8];
#pragma unroll
                for (int r = 0; r < 8; ++r) { hsel[r] = hL[((__builtin_amdgcn_readlane(key[par * 8 + r], b2) >> 7) & 7) * 64]; p[r] = 0; }
#pragma unroll
                for (int q = 0; q < 4; ++q)
#pragma unroll
                    for (int r = 0; r < 8; ++r) p[r] = __builtin_amdgcn_sdot4((int)ub[par][r][q], (int)hsel[r][q], p[r], false);
#pragma unroll
                for (int r = 0; r < 8; ++r) ub[par][r] = V4_ROW(U, par, bn2, r);
                int psum;
                { int q4[4];
#pragma unroll
                  for (int i = 0; i < 4; ++i) { auto rr = __builtin_amdgcn_permlane32_swap((unsigned)p[i], (unsigned)p[i + 4], false, false); q4[i] = (int)(rr[0] + rr[1]); }
                  int q2[2];
#pragma unroll
                  for (int i = 0; i < 2; ++i) { auto rr = __builtin_amdgcn_permlane16_swap((unsigned)q4[i], (unsigned)q4[i + 2], false, false); q2[i] = (int)(rr[0] + rr[1]); }
                  const int t0 = q2[0] + __builtin_amdgcn_update_dpp(0, q2[0], 0x128, 0xf, 0xf, false);
                  const int t1 = q2[1] + __builtin_amdgcn_update_dpp(0, q2[1], 0x128, 0xf, 0xf, false);
                  int v = (lane & 8) ? t1 : t0;
                  v += __builtin_amdgcn_update_dpp(0, v, 0x141, 0xf, 0xf, false);
                  v += __builtin_amdgcn_update_dpp(0, v, 0x4e, 0xf, 0xf, false);
                  v += __builtin_amdgcn_update_dpp(0, v, 0xb1, 0xf, 0xf, false);
                  psum = v; }
                const int pos = (2 * b2 + par) * 8 + ((lane >> 3) & 7);
                const float w = sgL[pos] * gelu_fast((float)psum * suL[pos]);
                if ((lane & 7) == 0) sgL[pos] = w;
            }
        }
    }
    if constexpr (!UONLY) {
    LAS int* lst = (LAS int*)(F.lds) + F.wave * 2048;
    { int cnt0 = 0;
#pragma unroll
      for (int r = 0; r < NK; ++r) cnt0 += ((key[r] >> 9) & 1) ^ 1;
      int inc = cnt0;
#pragma unroll
      for (int o = 1; o < 64; o <<= 1) { const int t = __shfl_up(inc, o); if (lane >= o) inc += t; }
      int o0 = inc - cnt0, o1 = lane * NK - o0;
#pragma unroll
      for (int r = 0; r < NK; ++r) { const int g1 = (key[r] >> 9) & 1; const int ent = ((key[r] >> 10) << 13) | (((key[r] >> 7) & 3) << 11) | (lane * NK + r);
          if (g1) { lst[512 + o1] = ent; ++o1; } else { lst[o0] = ent; ++o0; } } }
    const float* fg = F.in[17];
#pragma unroll 1
    for (int g = 0; g < 2; ++g) {
        int kg[8];
#pragma unroll
        for (int r = 0; r < 8; ++r) kg[r] = lst[g * 512 + lane * 8 + r];
        float out[4][16];
#pragma unroll
        for (int j = 0; j < 4; ++j)
#pragma unroll
            for (int i = 0; i < 16; ++i) out[j][i] = 0.f;
        v4u vb[2][8];
#pragma unroll
        for (int par = 0; par < 2; ++par)
#pragma unroll
            for (int r = 0; r < 8; ++r) vb[par][r] = *((const v4u*)(V + (size_t)((__builtin_amdgcn_readlane(kg[r], par) >> 13) & EM) * 1024) + lane);
#pragma unroll 1
        for (int b2 = 0; b2 < 32; ++b2) {
#pragma unroll
            for (int par = 0; par < 2; ++par) {
                const int b = 2 * b2 + par, bn = (b + 2 < 64) ? b + 2 : par;
#pragma unroll
                for (int r = 0; r < 8; ++r) { const int kk = __builtin_amdgcn_readlane(kg[r], b); const float wr = sgL[kk & 2047]; const int tk = (kk >> 11) & 3;
                    float f[16]; fp8x16_to_f32(vb[par][r], f);
#pragma unroll
                    for (int j = 0; j < 4; ++j) if (tk == j) {
#pragma unroll
                        for (int i = 0; i < 16; ++i) out[j][i] += wr * f[i]; } }
#pragma unroll
                for (int r = 0; r < 8; ++r) vb[par][r] = *((const v4u*)(V + (size_t)((__builtin_amdgcn_readlane(kg[r], bn) >> 13) & EM) * 1024) + lane);
            }
        }
#pragma unroll
        for (int j = 0; j < 4; ++j) {
            const int t = tbase + g * 4 + j, bb = t >> 12; const float* g2 = MOD + bb * NMOD + 5 * DM; float* xo = F.out + (size_t)t * DM;
            const bf16* x1r = (const bf16*)(F.ws + WS_X1) + (size_t)t * DM + lane * 16;
            float x2[16]; float ss = 0.f;
#pragma unroll
            for (int hq = 0; hq < 4; ++hq) { const int c = lane * 16 + hq * 4; const v2u xw = *(const v2u*)(x1r + hq * 4); const f32x4 xv = (f32x4){bflo(xw.x), bfhi(xw.x), bflo(xw.y), bfhi(xw.y)}, gv = *(const f32x4*)(g2 + c);
#pragma unroll
                for (int e = 0; e < 4; ++e) { const float y = xv[e] + gv[e] * (out[j][hq * 4 + e] * (1.0f / V_SCALE)); x2[hq * 4 + e] = y; ss += y * y; } }
            const float rinv = 1.0f / sqrtf(wave_sum(ss) * (1.f / DM) + EPS);
#pragma unroll
            for (int hq = 0; hq < 4; ++hq) { const int c = lane * 16 + hq * 4; const f32x4 fv = *(const f32x4*)(fg + c);
                f32x4 y;
#pragma unroll
                for (int e = 0; e < 4; ++e) y[e] = x2[hq * 4 + e] * rinv * fv[e];
                if (!FAKE || rinv == 12345.678f) *(f32x4*)(xo + c) = y; }
        }
    }
    }
}

struct Args { const float* in[18]; float* out; unsigned char* ws; int ph_lo, ph_hi, li, pad; };
__global__ void __launch_bounds__(NWAVES * 64, 2) mk_fwd(Args args) {
    extern __shared__ __attribute__((aligned(16))) unsigned char lds[];
    Frame F;
    F.lds = (LAS unsigned char*)lds;
    F.tid = threadIdx.x; F.lane = F.tid & 63; F.wave = __builtin_amdgcn_readfirstlane(F.tid >> 6);
    F.G = gridDim.x; { const int bx = blockIdx.x; F.vcu = (F.G % 8 == 0) ? (bx % 8) * (F.G / 8) + bx / 8 : bx; }
    F.gw = F.vcu * NWAVES + F.wave; F.NGW = F.G * NWAVES;
#pragma unroll
    for (int i = 0; i < 18; ++i) F.in[i] = args.in[i];
    F.out = args.out; F.ws = args.ws;
    volatile LAS unsigned* MISC = (volatile LAS unsigned*)(F.lds + MISC_OFF);
    for (int u = F.tid; u < (LDS_BYTES - LDSCTL_OFF) / 4; u += NWAVES * 64) ((LAS unsigned*)(F.lds + LDSCTL_OFF))[u] = 0u;
    __syncthreads();
    gu32* ctl = (gu32*)(F.ws + WS_CTL);
    XcdBarrier bar; bar.bar = (unsigned*)(ctl + CW_BAR) + args.li * XCD_BAR_WORDS; bar.x = 0; bar.st = nullptr;
    const int lo = args.ph_lo, hi = args.ph_hi;
    if (hi - lo > 1) bar = xcd_barrier_post((unsigned*)(ctl + CW_BAR) + args.li * XCD_BAR_WORDS, MISC + 8);
#ifndef PROBE_MASK
#define PROBE_MASK 0
#endif
#define REP(k) for (int rep_ = 0; rep_ < 1 + ((PROBE_MASK >> (k)) & 1); ++rep_)
#define IN(k) (lo <= (k) && (k) < hi)
#ifndef PROBE_SEAMS
#define PROBE_SEAMS 1
#endif
#define SEAM(k) do { if (IN(k) && IN((k) + 1)) for (int s_ = 0; s_ < PROBE_SEAMS; ++s_) xcd_barrier(bar); } while (0)

    if (IN(0)) { REP(0) { p0_prologue(F); __syncthreads(); } SEAM(0); }
    if (IN(1)) { REP(1) norm_rows<false>(F, F.in[0], F.in[2], MROWS, F.in[6], 0, DM, (bf16*)(F.ws + WS_HX)); SEAM(1); }
    if (IN(2)) {
        pg8::Gemm g{(const bf16*)(F.ws + WS_HX), (const bf16*)(F.ws + WS_WIN), MROWS, DIN, DM}; pg8::InProjOrder S; S.init(F.G, (int)blockIdx.x);
        pg8::EpiInProj E{(bf16*)(F.ws + WS_PB), (bf16*)(F.ws + WS_QF), (bf16*)(F.ws + WS_KF), (bf16*)(F.ws + WS_VF)};
        REP(2) pg8::gemm_phase<pg8::EpiInProj, pg8::InProjOrder, true, true>(F.lds + RING_OFF, g, S, E);
        SEAM(2);
    }
    if (IN(3)) { REP(3) attn_mfma(F); REP(9) pool_mfma(F); SEAM(3); }
    if (IN(4)) {
        pg8::Gemm g{(const bf16*)(F.ws + WS_MIX), (const bf16*)(F.ws + WS_WOUT), NTOK, DM, DM}; pg8::StaticOrder S; S.init(NTOK, DM, F.G, (int)blockIdx.x);
        pg8::EpiX1 E{F.in[0], (const float*)(F.ws + WS_MOD), (bf16*)(F.ws + WS_X1)};
        REP(4) pg8::gemm_phase<pg8::EpiX1, pg8::StaticOrder, true, true>(F.lds + RING_OFF, g, S, E);
        SEAM(4);
    }
    if (IN(5)) { REP(5) norm_rows<true>(F, (const float*)(F.ws + WS_X1), nullptr, NTOK, F.in[12], 3 * DM, 4 * DM, (bf16*)(F.ws + WS_HX)); SEAM(5); }
    if (IN(6)) {
        pg8::Gemm g{(const bf16*)(F.ws + WS_HX), (const bf16*)(F.ws + WS_WQ), NTOK, 2048, DM}; pg8::StaticOrder S; S.init(NTOK, 2048, F.G, (int)blockIdx.x);
        pg8::EpiQP E{(bf16*)(F.ws + WS_ZX)};
        REP(6) pg8::gemm_phase<pg8::EpiQP, pg8::StaticOrder, true, true>(F.lds + RING_OFF, g, S, E);
        SEAM(6);
    }
    if (IN(7)) {
        for (int tile = F.vcu; tile < NTOK / 128; tile += F.G) {
            const int tok0 = tile * 128;
            REP(7) peer_topk_mfma(F, tile);
            if ((PROBE_MASK >> 8) & 1) for (int rd = 0; rd < 4; ++rd) gather_round<4, true>(F, tok0 + rd * 32 + F.wave * 4);
            if ((PROBE_MASK >> 10) & 1) for (int rd = 0; rd < 4; ++rd) gather_round<4>(F, tok0 + rd * 32 + F.wave * 4);
#ifdef GATHER_VONLY
            for (int rd = 0; rd < 4; ++rd) gather_vonly<4>(F, tok0 + rd * 32 + F.wave * 4);
            __syncthreads();
            for (int rd = 0; rd < 4; ++rd) gather_round<4>(F, tok0 + rd * 32 + F.wave * 4);
#elif defined(GATHER_V4U)
            for (int rd = 0; rd < 2; ++rd) gather_v4<false, true>(F, tok0 + rd * 64 + F.wave * 8);
            __syncthreads();
            for (int rd = 0; rd < 4; ++rd) gather_round<4>(F, tok0 + rd * 32 + F.wave * 4);
#elif defined(GATHER_V4)
            for (int rd = 0; rd < 2; ++rd) gather_v4<false>(F, tok0 + rd * 64 + F.wave * 8);
#else
            for (int rd = 0; rd < 4; ++rd) gather_round<4>(F, tok0 + rd * 32 + F.wave * 4);
#endif
        }
    }
#undef IN
#undef SEAM
}

extern "C" void kernel_launch(void* const* d_in, const int* in_sizes, int n_in, void* d_out, int out_size, void* d_ws, size_t ws_size, hipStream_t stream) {
    static int grid = 0;
    if (grid == 0) {
        if (n_in != 18 || in_sizes[0] != NTOK * DM || out_size != NTOK * DM || ws_size < WS_END) { fprintf(stderr, "kernel_launch: unexpected shapes / workspace (n_in %d, ws %zu); nothing launched\n", n_in, ws_size); grid = -1; return; }
        int dev = 0, cus = 0;
        if (hipGetDevice(&dev) != hipSuccess || hipDeviceGetAttribute(&cus, hipDeviceAttributeMultiprocessorCount, dev) != hipSuccess) { grid = -1; return; }
        if (hipFuncSetAttribute((const void*)mk_fwd, hipFuncAttributeMaxDynamicSharedMemorySize, LDS_BYTES) != hipSuccess) { fprintf(stderr, "kernel_launch: hipFuncSetAttribute failed\n"); grid = -1; return; }
        int per_cu = 0;
        if (hipOccupancyMaxActiveBlocksPerMultiprocessor(&per_cu, (const void*)mk_fwd, NWAVES * 64, LDS_BYTES) != hipSuccess || per_cu < 1) fprintf(stderr, "kernel_launch: note: occupancy query reports %d blocks per CU\n", per_cu);
        (void)hipGetLastError();
        grid = cus;
    }
    if (grid < 0) return;
    (void)hipMemsetAsync((char*)d_ws + WS_CTL, 0, CTL_ZERO_BYTES, stream);
    Args a{};
    for (int i = 0; i < 18; ++i) a.in[i] = (const float*)d_in[i];
    a.out = (float*)d_out; a.ws = (unsigned char*)d_ws;
    for (int li = 0; li < N_LAUNCHES; ++li) {
        if (N_LAUNCHES == 1) { a.ph_lo = 0; a.ph_hi = NPHASE; } else { a.ph_lo = li; a.ph_hi = li + 1; }
        a.li = (N_LAUNCHES == 1) ? 0 : 0;
        hipLaunchKernelGGL(mk_fwd, dim3(grid), dim3(NWAVES * 64), LDS_BYTES, stream, a);
    }
}
```

```cpp
#include <hip/hip_runtime.h>
#include <cstdio>
#include <cstdint>
#include <type_traits>
namespace pg8 {
#define PG8_LAS __attribute__((address_space(3)))
typedef unsigned short bf16_t;
typedef short bf16x8 __attribute__((ext_vector_type(8)));
typedef float f32x4 __attribute__((ext_vector_type(4)));
typedef unsigned u32x4 __attribute__((ext_vector_type(4)));
constexpr int BM = 256, BK = 64, HALF = 128, HTB = HALF * BK * 2  , STAGE_BYTES = 8 * HTB, NXCD = 8, WGM = 8;

__host__ __device__ __forceinline__ int lds_byte(int r, int c) { const int st = (r >> 4) * 2 + (c >> 5), rr = r & 15, cc = c & 31, ob = rr * 64 + cc * 2; return st * 1024 + (ob ^ (((ob >> 9) & 1) << 5)); }
__host__ __device__ __forceinline__ void stage_rc(int b, int& R, int& C) { const int st = b / 1024, sb = b % 1024, swz = sb ^ (((sb >> 9) & 1) << 5); R = (st >> 1) * 16 + swz / 64; C = (st & 1) * 32 + (swz % 64) / 2; }
__host__ __device__ __forceinline__ int perm32(int rho) { const int n = rho >> 4, i = rho & 15; return 8 * (i >> 2) + 4 * n + (i & 3); }

struct Unit { int pm, pn; };
struct Gemm { const bf16_t* A; const bf16_t* Bt; int M, N, K; };
struct StaticOrder {
    int nM, nN, nwg, G, c;
    __host__ __device__ void init(int M, int N, int G_, int c_) { nM = M / BM; nN = N / BM; nwg = nM * nN; G = G_; c = c_; }
    __host__ __device__ bool next(int i, Unit& u) const {
        const long L = (long)i * G + c; if (L >= nwg) return false;
        int wgid = (int)L; { const int q = nwg / NXCD, r = nwg % NXCD, xcd = wgid % NXCD, off = wgid / NXCD; wgid = (xcd < r ? xcd * (q + 1) : r * (q + 1) + (xcd - r) * q) + off; }
        const int nig = WGM * nN, gid = wgid / nig, fm = gid * WGM, gsz = (nM - fm) < WGM ? (nM - fm) : WGM;
        u.pm = fm + ((wgid % nig) % gsz); u.pn = (wgid % nig) / gsz; return true;
    }
    __device__ __forceinline__ void a_ready(const Unit&) const {}
    __device__ __forceinline__ void done(const Unit&) const {}
    __device__ __forceinline__ const char* pa(const Gemm& g, const Unit& u) const { return (const char*)g.A + (size_t)u.pm * ((size_t)BM * g.K * 2); }
    __device__ __forceinline__ const char* pb(const Gemm& g, const Unit& u) const { return (const char*)g.Bt + (size_t)u.pn * ((size_t)BM * g.K * 2); }
};
struct InProjOrder {
    StaticOrder so;
    __host__ __device__ void init(int G_, int c_) { so.init(136 * BM, 8 * BM, G_, c_); }
    __host__ __device__ bool next(int i, Unit& u) const { int cnt = -1; for (int j = 0; ; ++j) { if (!so.next(j, u)) return false; if (!(u.pm >= 128 && u.pn < 4)) { if (++cnt == i) return true; } } }
    __device__ __forceinline__ void a_ready(const Unit&) const {}
    __device__ __forceinline__ void done(const Unit&) const {}
    __device__ __forceinline__ const char* pa(const Gemm& g, const Unit& u) const { return u.pn < 6 ? (const char*)g.A + (size_t)u.pm * ((size_t)BM * g.K * 2) : (const char*)g.Bt + (size_t)u.pn * ((size_t)BM * g.K * 2); }
    __device__ __forceinline__ const char* pb(const Gemm& g, const Unit& u) const { return u.pn < 6 ? (const char*)g.Bt + (size_t)u.pn * ((size_t)BM * g.K * 2) : (const char*)g.A + (size_t)u.pm * ((size_t)BM * g.K * 2); }
};

__device__ __forceinline__ unsigned cvt_pk_bf16(float lo, float hi) { unsigned r; asm volatile("v_cvt_pk_bf16_f32 %0, %1, %2" : "=v"(r) : "v"(lo), "v"(hi)); return r; }
struct EpiBf16 {
    static constexpr bool PERM = true, AFTER_DRAIN = false;
    bf16_t* O; int ldc;
    __device__ __forceinline__ void operator()(const f32x4 (&acc)[2][2][4][2], const Unit& u, int wr, int wc, int fr, int fq) const {
        const int row0 = u.pm * BM + wr * 64 + fr, col0 = u.pn * BM + wc * 32 + 8 * fq;
#pragma unroll
        for (int ai = 0; ai < 2; ++ai)
#pragma unroll
            for (int m = 0; m < 4; ++m) { bf16_t* rowp = O + (size_t)(row0 + ai * HALF + m * 16) * ldc + col0;
#pragma unroll
                for (int bj = 0; bj < 2; ++bj) { const f32x4 v0 = acc[ai][bj][m][0], v1 = acc[ai][bj][m][1];
                    u32x4 w; w.x = cvt_pk_bf16(v0[0], v0[1]); w.y = cvt_pk_bf16(v0[2], v0[3]); w.z = cvt_pk_bf16(v1[0], v1[1]); w.w = cvt_pk_bf16(v1[2], v1[3]);
                    *(u32x4*)(rowp + bj * HALF) = w; } }
    }
};
struct EpiX1 {
    static constexpr bool PERM = true, AFTER_DRAIN = false;
    const float* x; const float* mod; bf16_t* out;
    __device__ __forceinline__ void operator()(const f32x4 (&acc)[2][2][4][2], const Unit& u, int wr, int wc, int fr, int fq) const {
        const int row0 = u.pm * BM + wr * 64 + fr, col0 = u.pn * BM + wc * 32 + 8 * fq;
        const float* g1 = mod + (size_t)((u.pm * BM) >> 12) * 6144 + 2048 + col0;
        f32x4 gv[2][2];
#pragma unroll
        for (int bj = 0; bj < 2; ++bj)
#pragma unroll
            for (int n = 0; n < 2; ++n) gv[bj][n] = *(const f32x4*)(g1 + bj * HALF + 4 * n);
#pragma unroll
        for (int ai = 0; ai < 2; ++ai)
#pragma unroll
            for (int m = 0; m < 4; ++m) { const size_t off = (size_t)(row0 + ai * HALF + m * 16) * 1024 + col0;
#pragma unroll
                for (int bj = 0; bj < 2; ++bj) { const f32x4 x0 = *(const f32x4*)(x + off + bj * HALF), x1 = *(const f32x4*)(x + off + bj * HALF + 4);
                    const f32x4 v0 = x0 + gv[bj][0] * acc[ai][bj][m][0], v1 = x1 + gv[bj][1] * acc[ai][bj][m][1];
                    u32x4 w; w.x = cvt_pk_bf16(v0[0], v0[1]); w.y = cvt_pk_bf16(v0[2], v0[3]); w.z = cvt_pk_bf16(v1[0], v1[1]); w.w = cvt_pk_bf16(v1[2], v1[3]);
                    *(u32x4*)(out + off + bj * HALF) = w; } }
    }
};


struct EpiInProj {
    static constexpr bool PERM = true, AFTER_DRAIN = false;
    bf16_t *PB, *QF, *KF, *VF;
    __device__ __forceinline__ void operator()(const f32x4 (&acc)[2][2][4][2], const Unit& u, int wr, int wc, int fr, int fq) const {
        if (u.pn < 6) {
            const int sec = u.pn >> 1, cbase = (u.pn & 1) * 256 + wc * 32 + 8 * fq;
#pragma unroll
            for (int ai = 0; ai < 2; ++ai)
#pragma unroll
                for (int m = 0; m < 4; ++m) { const int T = u.pm * BM + ai * HALF + wr * 64 + m * 16 + fr;
                    int bb, blk; if (T < 32768) { bb = T >> 12; blk = (T & 4095) >> 5; } else { const int cc = T - 32768; bb = cc >> 8; blk = 128 + ((cc & 255) >> 5); }
                    const int tl = T & 31;
#pragma unroll
                    for (int bj = 0; bj < 2; ++bj) { const int c = cbase + HALF * bj; const f32x4 v0 = acc[ai][bj][m][0], v1 = acc[ai][bj][m][1];
                        u32x4 w; w.x = cvt_pk_bf16(v0[0], v0[1]); w.y = cvt_pk_bf16(v0[2], v0[3]); w.z = cvt_pk_bf16(v1[0], v1[1]); w.w = cvt_pk_bf16(v1[2], v1[3]);
                        if (sec == 0) *(u32x4*)(PB + (size_t)T * 512 + c) = w;
                        else { const int h = c >> 6, d0 = c & 63, fo = ((d0 >> 4) * 64 + ((d0 >> 3) & 1) * 32 + tl) * 8;
                            bf16_t* dst = (sec == 1) ? QF + (size_t)((bb * 8 + h) * 128 + blk) * 2048 + fo : KF + (size_t)((bb * 8 + h) * 136 + blk) * 2048 + fo;
                            *(u32x4*)dst = w; } } }
        } else {
            typedef unsigned u32x2 __attribute__((ext_vector_type(2)));
#pragma unroll
            for (int ai = 0; ai < 2; ++ai)
#pragma unroll
                for (int m = 0; m < 4; ++m) { const int vc = (u.pn - 6) * BM + ai * HALF + wr * 64 + m * 16 + fr, h = vc >> 6, dt = (vc >> 5) & 1, dl = vc & 31;
#pragma unroll
                    for (int bj = 0; bj < 2; ++bj) { const int T0 = u.pm * BM + bj * HALF + wc * 32 + 8 * fq;
                        int bb, blk; if (T0 < 32768) { bb = T0 >> 12; blk = (T0 & 4095) >> 5; } else { const int cc = T0 - 32768; bb = cc >> 8; blk = 128 + ((cc & 255) >> 5); }
                        bf16_t* base = VF + ((size_t)(((bb * 8 + h) * 136 + blk) * 2 + dt) * 2 + (fq >> 1)) * 512 + 4 * (fq & 1);
                        const f32x4 v0 = acc[ai][bj][m][0], v1 = acc[ai][bj][m][1];
                        u32x2 w0, w1; w0.x = cvt_pk_bf16(v0[0], v0[1]); w0.y = cvt_pk_bf16(v0[2], v0[3]); w1.x = cvt_pk_bf16(v1[0], v1[1]); w1.y = cvt_pk_bf16(v1[2], v1[3]);
                        *(u32x2*)(base + dl * 8) = w0; *(u32x2*)(base + (32 + dl) * 8) = w1; } }
        }
    }
};

struct EpiQP {
    static constexpr bool PERM = true, AFTER_DRAIN = false;
    bf16_t* QP;
    __device__ __forceinline__ void operator()(const f32x4 (&acc)[2][2][4][2], const Unit& u, int wr, int wc, int fr, int fq) const {
#pragma unroll
        for (int ai = 0; ai < 2; ++ai)
#pragma unroll
            for (int m = 0; m < 4; ++m) { const int T = u.pm * BM + ai * HALF + wr * 64 + m * 16 + fr;
#pragma unroll
                for (int bj = 0; bj < 2; ++bj) { const int hp = 2 * u.pn + bj, ks = 2 * wc + (fq >> 1), hh = fq & 1;
                    const f32x4 v0 = acc[ai][bj][m][0], v1 = acc[ai][bj][m][1];
                    u32x4 w; w.x = cvt_pk_bf16(v0[0], v0[1]); w.y = cvt_pk_bf16(v0[2], v0[3]); w.z = cvt_pk_bf16(v1[0], v1[1]); w.w = cvt_pk_bf16(v1[2], v1[3]);
                    *(u32x4*)(QP + ((size_t)(T >> 5) * 16 + hp) * 4096 + (ks * 64 + hh * 32 + (T & 31)) * 8) = w; } }
    }
};
template <class Epi, class Sched, bool ALIGN_EPI = false, bool SP2 = false>
__device__ __forceinline__ void gemm_phase(PG8_LAS unsigned char* lds, const Gemm g, const Sched& S, const Epi& E) {
    const int tid = threadIdx.x, wid = __builtin_amdgcn_readfirstlane(tid >> 6), lane = tid & 63, wr = wid >> 2, wc = wid & 3, fr = lane & 15, fq = lane >> 4;
    const int K = g.K, nt = K / BK;
    unsigned voffA[2], voffB[2];
#pragma unroll
    for (int i = 0; i < 2; ++i) { int R, C; stage_rc(tid * 16 + i * 8192, R, C); const int Rb = Epi::PERM ? ((R & ~31) + perm32(R & 31)) : R;
        voffA[i] = (unsigned)(R * K + C) * 2u; voffB[i] = (unsigned)(Rb * K + C) * 2u; }
    const size_t kstep = (size_t)(BK * 2);
    const size_t hstep = (size_t)HALF * K * 2;
    const size_t tstep = 2 * hstep;
    const unsigned ldsw = (unsigned)wid * 1024u;
    const int aoff = lds_byte(wr * 64 + fr, fq * 8), boff = lds_byte(wc * 32 + fr, fq * 8);
#define PG8_SA(b, h) (((b) * 2 + (h)) * HTB)
#define PG8_SB(b, h) ((4 + (b) * 2 + (h)) * HTB)
#define PG8_STAGE(bufoff, gbase, voff) do { _Pragma("unroll") for (int _i = 0; _i < 2; ++_i) \
        __builtin_amdgcn_global_load_lds((const unsigned*)((const char*)(gbase) + (voff)[_i]), (PG8_LAS unsigned*)(lds + (bufoff) + ldsw + _i * 8192), 16, 0, 0); } while (0)
#define PG8_LDA(dst, b, h) do { _Pragma("unroll") for (int m = 0; m < 4; ++m) _Pragma("unroll") for (int k = 0; k < 2; ++k) dst[m][k] = *(const PG8_LAS bf16x8*)(lds + PG8_SA(b, h) + aoff + m * 2048 + k * 1024); } while (0)
#define PG8_LDB(dst, b, h) do { _Pragma("unroll") for (int n = 0; n < 2; ++n) _Pragma("unroll") for (int k = 0; k < 2; ++k) dst[n][k] = *(const PG8_LAS bf16x8*)(lds + PG8_SB(b, h) + boff + n * 2048 + k * 1024); } while (0)
#define PG8_MMA(ai, bj, At, Bt) do { __builtin_amdgcn_s_setprio(1); _Pragma("unroll") for (int m = 0; m < 4; ++m) _Pragma("unroll") for (int n = 0; n < 2; ++n) _Pragma("unroll") for (int k = 0; k < 2; ++k) \
        acc[ai][bj][m][n] = __builtin_amdgcn_mfma_f32_16x16x32_bf16(Bt[n][k], At[m][k], acc[ai][bj][m][n], 0, 0, 0); __builtin_amdgcn_s_setprio(0); } while (0)
#define PG8_WAIT_V(n) asm volatile("s_waitcnt vmcnt(" #n ")" ::: "memory")
#define PG8_WAIT_L(n) asm volatile("s_waitcnt lgkmcnt(" #n ")" ::: "memory")
#define PG8_BAR __builtin_amdgcn_s_barrier()
#define PG8_SCHED __builtin_amdgcn_sched_barrier(0)
    Unit cur, nxt; int ui = 0;
    if (!S.next(0, cur)) return;
    f32x4 acc[2][2][4][2];
#pragma unroll
    for (int a = 0; a < 2; ++a)
#pragma unroll
        for (int b = 0; b < 2; ++b)
#pragma unroll
            for (int m = 0; m < 4; ++m)
#pragma unroll
                for (int n = 0; n < 2; ++n) acc[a][b][m][n] = (f32x4){0.f, 0.f, 0.f, 0.f};
    bf16x8 At[4][2], B0[2][2], B1[2][2];
    const char* cA = S.pa(g, cur); const char* cB = S.pb(g, cur);
    S.a_ready(cur);
    if constexpr (SP2) {
        PG8_STAGE(PG8_SB(0, 0), cB, voffB); PG8_STAGE(PG8_SB(0, 1), cB + hstep, voffB); PG8_STAGE(PG8_SA(0, 0), cA, voffA); PG8_STAGE(PG8_SA(0, 1), cA + hstep, voffA);
        if (wr == 1) PG8_BAR;
        PG8_WAIT_V(2); PG8_BAR;
        PG8_STAGE(PG8_SB(1, 0), cB + kstep, voffB); PG8_STAGE(PG8_SA(1, 0), cA + kstep, voffA); PG8_STAGE(PG8_SB(1, 1), cB + hstep + kstep, voffB);
        PG8_WAIT_V(6); PG8_BAR;
    } else {
        PG8_STAGE(PG8_SB(0, 0), cB, voffB); PG8_STAGE(PG8_SA(0, 0), cA, voffA); PG8_STAGE(PG8_SB(0, 1), cB + hstep, voffB); PG8_STAGE(PG8_SA(0, 1), cA + hstep, voffA);
        if (wr == 1) PG8_BAR;
        PG8_WAIT_V(4); PG8_BAR;
        PG8_STAGE(PG8_SB(1, 0), cB + kstep, voffB); PG8_STAGE(PG8_SA(1, 0), cA + kstep, voffA); PG8_STAGE(PG8_SB(1, 1), cB + hstep + kstep, voffB);
        PG8_WAIT_V(6); PG8_BAR;
    }
    for (;;) {
        const bool has_next = S.next(ui + 1, nxt);
        const char* nA = has_next ? S.pa(g, nxt) : cA; const char* nB = has_next ? S.pb(g, nxt) : cB;
        for (int t = 0; t < nt; t += 2) {
            const bool last = (t == nt - 2);
            const char* a1 = cA + (size_t)(t + 1) * kstep;
            const char* a2 = last ? nA : cA + (size_t)(t + 2) * kstep; const char* b2 = last ? nB : cB + (size_t)(t + 2) * kstep;
            const char* a3 = a2 + kstep; const char* b3 = b2 + kstep;
            if (last && has_next) S.a_ready(nxt);
            if constexpr (SP2) {
            PG8_LDB(B0, 0, 0); PG8_LDB(B1, 0, 1); PG8_SCHED; PG8_LDA(At, 0, 0); PG8_STAGE(PG8_SA(1, 1), a1 + hstep, voffA);
            PG8_WAIT_V(8); PG8_WAIT_L(0); PG8_BAR; PG8_MMA(0, 0, At, B0); PG8_MMA(0, 1, At, B1); PG8_BAR; PG8_SCHED;
            PG8_LDA(At, 0, 1); PG8_STAGE(PG8_SB(0, 0), b2, voffB); PG8_STAGE(PG8_SB(0, 1), b2 + hstep, voffB); PG8_STAGE(PG8_SA(0, 0), a2, voffA);
            PG8_WAIT_V(8); PG8_WAIT_L(0); PG8_BAR; PG8_MMA(1, 0, At, B0); PG8_MMA(1, 1, At, B1); PG8_BAR; PG8_SCHED;
            PG8_LDB(B0, 1, 0); PG8_LDB(B1, 1, 1); PG8_SCHED; PG8_LDA(At, 1, 0); PG8_STAGE(PG8_SA(0, 1), a2 + hstep, voffA);
            PG8_WAIT_V(8); PG8_WAIT_L(0); PG8_BAR; PG8_MMA(0, 0, At, B0); PG8_MMA(0, 1, At, B1); PG8_BAR; PG8_SCHED;
            PG8_LDA(At, 1, 1); PG8_STAGE(PG8_SB(1, 0), b3, voffB); PG8_STAGE(PG8_SB(1, 1), b3 + hstep, voffB); PG8_STAGE(PG8_SA(1, 0), a3, voffA);
            PG8_WAIT_V(8); PG8_WAIT_L(0); PG8_BAR; PG8_MMA(1, 0, At, B0); PG8_MMA(1, 1, At, B1); PG8_BAR; PG8_SCHED;
            } else {
            PG8_LDB(B0, 0, 0); PG8_SCHED; PG8_LDA(At, 0, 0); PG8_STAGE(PG8_SA(1, 1), a1 + hstep, voffA);
            PG8_WAIT_L(8); PG8_BAR; PG8_WAIT_L(0); PG8_MMA(0, 0, At, B0); PG8_BAR; PG8_SCHED;
            PG8_LDB(B1, 0, 1); PG8_STAGE(PG8_SB(0, 0), b2, voffB);
            PG8_BAR; PG8_WAIT_L(0); PG8_MMA(0, 1, At, B1); PG8_BAR;
            PG8_LDA(At, 0, 1); PG8_STAGE(PG8_SA(0, 0), a2, voffA);
            PG8_BAR; PG8_WAIT_L(0); PG8_MMA(1, 0, At, B0); PG8_BAR; PG8_SCHED;
            PG8_STAGE(PG8_SB(0, 1), b2 + hstep, voffB);
            PG8_WAIT_V(6); PG8_BAR; PG8_MMA(1, 1, At, B1); PG8_BAR;
            PG8_LDB(B0, 1, 0); PG8_SCHED; PG8_LDA(At, 1, 0); PG8_STAGE(PG8_SA(0, 1), a2 + hstep, voffA);
            PG8_WAIT_L(8); PG8_BAR; PG8_WAIT_L(0); PG8_MMA(0, 0, At, B0); PG8_BAR; PG8_SCHED;
            PG8_LDB(B1, 1, 1); PG8_STAGE(PG8_SB(1, 0), b3, voffB);
            PG8_BAR; PG8_WAIT_L(0); PG8_MMA(0, 1, At, B1); PG8_BAR;
            PG8_LDA(At, 1, 1); PG8_STAGE(PG8_SA(1, 0), a3, voffA);
            PG8_BAR; PG8_WAIT_L(0); PG8_MMA(1, 0, At, B0); PG8_BAR; PG8_SCHED;
            PG8_STAGE(PG8_SB(1, 1), b3 + hstep, voffB);
            PG8_WAIT_V(6); PG8_BAR; PG8_MMA(1, 1, At, B1); PG8_BAR;
            }
        }
        if constexpr (ALIGN_EPI) { if (wr == 0) PG8_BAR; }
        if constexpr (!Epi::AFTER_DRAIN) { E(acc, cur, wr, wc, fr, fq); S.done(cur); }
        if (!has_next) break;
#pragma unroll
        for (int a = 0; a < 2; ++a)
#pragma unroll
            for (int b = 0; b < 2; ++b)
#pragma unroll
                for (int m = 0; m < 4; ++m)
#pragma unroll
                    for (int n = 0; n < 2; ++n) acc[a][b][m][n] = (f32x4){0.f, 0.f, 0.f, 0.f};
        cur = nxt; cA = nA; cB = nB; ++ui;
        if constexpr (ALIGN_EPI) { if (wr == 1) PG8_BAR; }
    }
    PG8_WAIT_V(0);
    if constexpr (!ALIGN_EPI) { if (wr == 0) PG8_BAR; }
    PG8_BAR;
    if constexpr (Epi::AFTER_DRAIN) { E.fused(acc, cur, wr, wc, fr, fq, lds, wid, lane); S.done(cur); }
#undef PG8_SA
#undef PG8_SB
#undef PG8_STAGE
#undef PG8_LDA
#undef PG8_LDB
#undef PG8_MMA
#undef PG8_WAIT_V
#undef PG8_WAIT_L
#undef PG8_BAR
#undef PG8_SCHED
}
}

constexpr int DM = 1024, NBATCH = 8, SEQ = 4096, NTOK = NBATCH * SEQ, CTXL = 256, NCTX = NBATCH * CTXL, MROWS = NTOK + NCTX;
constexpr int DIN = 2048, NHEAD = 8, HD = 64, GRIDW = 64, NMOD = 6 * DM;
constexpr int NEXP = 16384;
constexpr float EPS = 1e-6f;
constexpr int NWAVES = 8;
constexpr int NPHASE = 8;
constexpr float U_SCALE = 64.f, V_SCALE = 4.f;

#ifndef FAKE_MASK
#define FAKE_MASK 7
#endif
#ifndef MK_N_LAUNCHES
#define MK_N_LAUNCHES 1
#endif
constexpr int N_LAUNCHES = MK_N_LAUNCHES;

constexpr size_t MiB = 1u << 20;
constexpr size_t WS_CTL = 0, CTL_ZERO_BYTES = 64 * 1024;
constexpr size_t WS_WIN = 2 * MiB, WS_WOUT = 6 * MiB, WS_WQ = 8 * MiB, WS_KEYS = 12 * MiB, WS_POOLW = 12 * MiB + 512 * 1024, WS_MOD = 13 * MiB;
constexpr size_t WS_SU = 13 * MiB + 512 * 1024;
constexpr size_t WS_U = 14 * MiB, WS_V = 46 * MiB;
constexpr size_t WS_HX = 78 * MiB;
constexpr size_t WS_ZX = 146 * MiB;
constexpr size_t WS_PB = 146 * MiB, WS_QF = 178 * MiB, WS_KF = 210 * MiB, WS_VF = 244 * MiB;
constexpr size_t WS_MIX = 282 * MiB;
constexpr size_t WS_EXP = 346 * MiB, WS_GATE = 362 * MiB;
constexpr size_t WS_X1 = 378 * MiB;
constexpr size_t WS_END = 442 * MiB;
constexpr int CW_BAR = 4096;

constexpr int RING_OFF = 0, RING_BYTES = 131072;
constexpr int LDSCTL_OFF = RING_BYTES, MISC_OFF = LDSCTL_OFF + 320;
constexpr int LDS_BYTES = 147456;

#define GAS __attribute__((address_space(1)))
#define LAS __attribute__((address_space(3)))
#define DI __device__ __forceinline__
typedef unsigned short bf16;
typedef unsigned v4u __attribute__((ext_vector_type(4)));
typedef unsigned v2u __attribute__((ext_vector_type(2)));
typedef float f32x4 __attribute__((ext_vector_type(4)));
typedef float f32x2 __attribute__((ext_vector_type(2)));
typedef GAS unsigned gu32;
#define RLX_AGENT __ATOMIC_RELAXED, __HIP_MEMORY_SCOPE_AGENT
#define LDS_WAIT() asm volatile("s_waitcnt lgkmcnt(0)" ::: "memory")
#define VM_WAIT() asm volatile("s_waitcnt vmcnt(0)" ::: "memory")
DI unsigned f2bf(float f) { unsigned u = __builtin_bit_cast(unsigned, f); return (u + 0x7fffu + ((u >> 16) & 1u)) >> 16; }
DI unsigned pk2(float lo, float hi) { return f2bf(lo) | (f2bf(hi) << 16); }
DI float bflo(unsigned u) { return __uint_as_float(u << 16); }
DI float bfhi(unsigned u) { return __uint_as_float(u & 0xffff0000u); }
DI float wave_sum(float v) {
#pragma unroll
    for (int o = 1; o < 64; o <<= 1) v += __shfl_xor(v, o);
    return v;
}

#define XB_TMO      128
#define XB_XCNT(j)  (256  + 64 * (j))
#define XB_XSUB(j)  (1280 + 64 * (j))
#define XB_XGEN(j)  (2304 + 64 * (j))
#define XB_TOP      3328
#define XB_TOPGEN   3392
#define XCD_BAR_WORDS 3456
#define XB_SPIN_CAP (1u << 18)

__device__ __forceinline__ unsigned xb_ld(unsigned* p)              { return __hip_atomic_load(p, __ATOMIC_RELAXED, __HIP_MEMORY_SCOPE_AGENT); }
__device__ __forceinline__ unsigned xb_add(unsigned* p, unsigned v) { return __hip_atomic_fetch_add(p, v, __ATOMIC_RELAXED, __HIP_MEMORY_SCOPE_AGENT); }
__device__ __forceinline__ unsigned xb_xcc_id() { return (unsigned)__builtin_amdgcn_s_getreg((3 << 11) | 20) & 0xFu; }
#define XB_SPIN(cond, bar) do { unsigned _sp = 0; while (cond) { __builtin_amdgcn_s_sleep(1); \
    if ((++_sp & 255u) == 0u) { if (xb_ld(&(bar)[XB_TMO])) break; if (_sp > XB_SPIN_CAP) { atomicAdd(&(bar)[XB_TMO], 1u); break; } } } } while (0)

struct XcdBarrier {
    unsigned* bar; unsigned x;
    volatile LAS unsigned* st;
};

__device__ __forceinline__ XcdBarrier xcd_barrier_post(unsigned* bar, volatile LAS unsigned* st) {
    XcdBarrier b; b.bar = bar; b.x = xb_xcc_id(); b.st = st;
    if (threadIdx.x == 0) (void)xb_add(&bar[XB_XCNT(b.x)], 1u);
    return b;
}
__device__ __forceinline__ void xcd_barrier_complete(unsigned* bar, unsigned x, unsigned& nloc, unsigned& nx) {
    const unsigned G = gridDim.x * gridDim.y * gridDim.z;
    unsigned sum, cnt, mine, sp = 0u;
    for (;;) {
        sum = 0u; cnt = 0u; mine = 0u;
#pragma unroll
        for (unsigned j = 0; j < 16; ++j) { const unsigned c = xb_ld(&bar[XB_XCNT(j)]); sum += c; cnt += (c > 0u) ? 1u : 0u; mine = (j == x) ? c : mine; }
        if (sum == G) break;
        __builtin_amdgcn_s_sleep(1);
        if ((++sp & 255u) == 0u) { if (xb_ld(&bar[XB_TMO])) break; if (sp > XB_SPIN_CAP) { atomicAdd(&bar[XB_TMO], 1u); break; } }
    }
    nloc = mine > 0u ? mine : 1u; nx = cnt > 0u ? cnt : 1u;
}

__device__ __forceinline__ void xcd_barrier(const XcdBarrier& b) {
    asm volatile("s_waitcnt vmcnt(0)" ::: "memory");
    __syncthreads();
    if (threadIdx.x == 0) {
        unsigned* bar = b.bar;
        __builtin_amdgcn_s_waitcnt(0);
        unsigned nloc = b.st[0], nx = b.st[1];
        if (nloc == 0u) { xcd_barrier_complete(bar, b.x, nloc, nx); b.st[0] = nloc; b.st[1] = nx; }
        const unsigned old = xb_add(&bar[XB_XSUB(b.x)], 1u);
        const unsigned gen = old / nloc;
        if (old + 1u == (gen + 1u) * nloc) {
            __builtin_amdgcn_fence(__ATOMIC_RELEASE, "agent");
            asm volatile("s_waitcnt vmcnt(0)" ::: "memory");
            const unsigned og = xb_add(&bar[XB_TOP], 1u);
            const unsigned tg = og / nx;
            if (og + 1u == (tg + 1u) * nx) xb_add(&bar[XB_TOPGEN], 1u);
            else XB_SPIN(xb_ld(&bar[XB_TOPGEN]) == tg, bar);
            __builtin_amdgcn_fence(__ATOMIC_ACQUIRE, "agent");
            xb_add(&bar[XB_XGEN(b.x)], 1u);
            asm volatile("s_waitcnt vmcnt(0)" ::: "memory");
        } else {
            XB_SPIN(xb_ld(&bar[XB_XGEN(b.x)]) == gen, bar);
            __builtin_amdgcn_fence(__ATOMIC_ACQUIRE, "agent");
            asm volatile("s_waitcnt vmcnt(0)" ::: "memory");
        }
    }
    __syncthreads();
}


__device__ __forceinline__ void p0_transpose_item(const float* W, int K, int N, bf16* WT, int row_off, LAS float* scr, int item, int lane) {
    const int nblk = N / 32, kb = item / nblk, nb = item % nblk, k0 = 64 * kb, n0 = 32 * nb;
#pragma unroll 8
    for (int i = 0; i < 32; ++i) { const int kk = 2 * i + (lane >> 5); scr[kk * 33 + (lane & 31)] = W[(size_t)(k0 + kk) * N + n0 + (lane & 31)]; }
    LDS_WAIT(); asm volatile("" ::: "memory");
    const int c = lane & 7;
#pragma unroll
    for (int j = 0; j < 4; ++j) { const int n = (lane >> 3) + 8 * j; const LAS float* s = scr + (8 * c) * 33 + n;
        v4u o; o.x = pk2(s[0 * 33], s[1 * 33]); o.y = pk2(s[2 * 33], s[3 * 33]); o.z = pk2(s[4 * 33], s[5 * 33]); o.w = pk2(s[6 * 33], s[7 * 33]);
        *(GAS v4u*)(WT + (size_t)(row_off + n0 + n) * K + k0 + 8 * c) = o; }
    LDS_WAIT(); asm volatile("" ::: "memory");
}


struct Frame {
    LAS unsigned char* lds;
    int tid, lane, wave, vcu, G, gw, NGW;
    const float* in[18]; float* out; unsigned char* ws;
};

DI void p0_prologue(Frame& F) {
    const float* c = F.in[1]; const float* c_ctx = F.in[3]; const float* ada_w = F.in[4]; const float* ada_b = F.in[5];
    float* MOD = (float*)(F.ws + WS_MOD);
    LAS float* sl = (LAS float*)(F.lds + 73728);
    for (int i = F.tid; i < 9 * 1024; i += 512) { const int b = i >> 10, k = i & 1023; const float cv = (b < 8) ? c[b * 1024 + k] : c_ctx[k]; sl[i] = cv / (1.f + __expf(-cv)); }
    __syncthreads();
    { LAS float* part = (LAS float*)(F.lds + 110592);
      for (int cg = F.vcu; cg < NMOD / 24; cg += F.G) {
          const int c = F.lane % 24, sub = F.lane / 24, n = cg * 24 + c, k0 = F.wave * 128 + sub * 64;
          float acc[9];
#pragma unroll
          for (int b = 0; b < 9; ++b) acc[b] = 0.f;
          if (sub < 2) { const float* wp = ada_w + (size_t)k0 * NMOD + n; const LAS float* sp = sl + k0;
#pragma unroll 16
              for (int i = 0; i < 64; ++i) { const float w = wp[(size_t)i * NMOD];
#pragma unroll
                  for (int b = 0; b < 9; ++b) acc[b] += sp[b * 1024 + i] * w; } }
#pragma unroll
          for (int b = 0; b < 9; ++b) { const float o = __shfl(acc[b], (F.lane + 24) & 63); if (F.lane < 24) part[(F.wave * 9 + b) * 24 + c] = acc[b] + o; }
          __syncthreads();
          if (F.tid < 216) { const int b = F.tid / 24, cc = F.tid % 24; float t = ada_b[cg * 24 + cc];
#pragma unroll
              for (int w = 0; w < 8; ++w) t += part[(w * 9 + b) * 24 + cc];
              MOD[b * NMOD + cg * 24 + cc] = t; }
          __syncthreads();
      } }
    LAS float* scr = (LAS float*)(F.lds + F.wave * 9216);
    constexpr int I_IN = (DM / 64) * (DIN / 32), I_OUT = (DM / 64) * (DM / 32), I_Q = (DM / 64) * (2048 / 32), I_P = 4 * 8;
    for (int it = F.gw; it < I_IN + I_OUT + I_Q + I_P; it += F.NGW) {
        int r = it;
        if (r < I_IN) { p0_transpose_item(F.in[7], DM, DIN, (bf16*)(F.ws + WS_WIN), 0, scr, r, F.lane); continue; } r -= I_IN;
        if (r < I_OUT) { p0_transpose_item(F.in[11], DM, DM, (bf16*)(F.ws + WS_WOUT), 0, scr, r, F.lane); continue; } r -= I_OUT;
        if (r < I_Q) { p0_transpose_item(F.in[13], DM, 2048, (bf16*)(F.ws + WS_WQ), 0, scr, r, F.lane); continue; } r -= I_Q;
        { const int g = r >> 3; p0_transpose_item(F.in[8] + g * 16384, 128, 128, (bf16*)(F.ws + WS_POOLW) + g * 16384, 0, scr, r & 7, F.lane); }
    }
    { const float* kf = F.in[14]; bf16* kb = (bf16*)(F.ws + WS_KEYS);
      for (int it = F.gw; it < 16 * 32; it += F.NGW) { const int hp = it >> 5, nt = (it >> 3) & 3, ks = it & 7;
          const float* src = kf + ((size_t)hp * 128 + 32 * nt + (F.lane & 31)) * 128 + 16 * ks + 8 * (F.lane >> 5);
          const f32x4 a = *(const f32x4*)(src), b = *(const f32x4*)(src + 4);
          v4u w; w.x = pk2(a.x, a.y); w.y = pk2(a.z, a.w); w.z = pk2(b.x, b.y); w.w = pk2(b.z, b.w); *(v4u*)(kb + ((size_t)it * 64 + F.lane) * 8) = w; } }
    for (int it = F.gw; it < 2 * NEXP; it += F.NGW) {
        const bool isu = it < NEXP;
        const float* src = isu ? F.in[15] + (size_t)it * 1024 : F.in[16] + (size_t)(it - NEXP) * 1024;
        unsigned* dst = (unsigned*)(isu ? F.ws + WS_U + (size_t)it * 1024 : F.ws + WS_V + (size_t)(it - NEXP) * 1024) + F.lane;
        const f32x4* sp = (const f32x4*)src + F.lane;
        f32x4 a[4];
#pragma unroll
        for (int j = 0; j < 4; ++j) a[j] = sp[64 * j];
        if (isu) {
            float am = 0.f;
#pragma unroll
            for (int j = 0; j < 4; ++j) am = fmaxf(fmaxf(am, fmaxf(fabsf(a[j].x), fabsf(a[j].y))), fmaxf(fabsf(a[j].z), fabsf(a[j].w)));
#pragma unroll
            for (int o = 1; o < 64; o <<= 1) am = fmaxf(am, __shfl_xor(am, o));
            am = fmaxf(am, 1e-30f);
            const float inv = 127.0f / am;
#pragma unroll
            for (int j = 0; j < 4; ++j) { const int q0 = (int)rintf(a[j].x * inv), q1 = (int)rintf(a[j].y * inv), q2 = (int)rintf(a[j].z * inv), q3 = (int)rintf(a[j].w * inv);
                dst[64 * j] = (unsigned)(q0 & 255) | ((unsigned)(q1 & 255) << 8) | ((unsigned)(q2 & 255) << 16) | ((unsigned)(q3 & 255) << 24); }
            if (F.lane == 0) ((float*)(F.ws + WS_SU))[it] = am * (1.0f / 127.0f);
        } else {
#pragma unroll
            for (int j = 0; j < 4; ++j) { const f32x4 sv = a[j] * V_SCALE; int pk = 0; pk = __builtin_amdgcn_cvt_pk_fp8_f32(sv.x, sv.y, pk, false); pk = __builtin_amdgcn_cvt_pk_fp8_f32(sv.z, sv.w, pk, true); dst[64 * j] = (unsigned)pk; }
        }
    }
}

template <bool SRC_BF16> DI void norm_rows(Frame& F, const float* src_x, const float* src_ctx, int nrows, const float* gain, int shift_off, int scale_off, bf16* dst) {
    const float* MOD = (const float*)(F.ws + WS_MOD);
    const int per = (nrows + F.NGW - 1) / F.NGW, m_lo = F.gw * per, m_hi = min(m_lo + per, nrows);
    f32x4 gs[4], shv[4]; int cb = -1;
    for (int m = m_lo; m < m_hi; ++m) {
        const float* xrow; int b;
        if (m < NTOK) { xrow = src_x + (size_t)m * DM; b = m >> 12; } else { xrow = src_ctx + (size_t)(m - NTOK) * DM; b = 8; }
        f32x4 v[4]; float s = 0.f;
        if (SRC_BF16) { const v2u* xr = (const v2u*)((const bf16*)src_x + (size_t)m * DM) + F.lane;
#pragma unroll
            for (int j = 0; j < 4; ++j) { const v2u w = xr[64 * j]; v[j] = (f32x4){bflo(w.x), bfhi(w.x), bflo(w.y), bfhi(w.y)}; }
        } else { const f32x4* xr = (const f32x4*)xrow + F.lane;
#pragma unroll
            for (int j = 0; j < 4; ++j) v[j] = xr[64 * j]; }
        if (b != cb) { cb = b;
            const f32x4* gp = (const f32x4*)gain + F.lane; const f32x4* shp = (const f32x4*)(MOD + b * NMOD + shift_off) + F.lane; const f32x4* scp = (const f32x4*)(MOD + b * NMOD + scale_off) + F.lane;
#pragma unroll
            for (int j = 0; j < 4; ++j) { gs[j] = gp[64 * j] * (scp[64 * j] + 1.0f); shv[j] = shp[64 * j]; } }
#pragma unroll
        for (int j = 0; j < 4; ++j) s += (v[j].x * v[j].x + v[j].y * v[j].y) + (v[j].z * v[j].z + v[j].w * v[j].w);
        const float rinv = 1.0f / sqrtf(wave_sum(s) * (1.f / DM) + EPS);
        unsigned long long* o8 = (unsigned long long*)(dst + (size_t)m * DM) + F.lane;
#pragma unroll
        for (int j = 0; j < 4; ++j) { const f32x4 y = (v[j] * rinv) * gs[j] + shv[j];
            o8[64 * j] = (unsigned long long)pk2(y.x, y.y) | ((unsigned long long)pk2(y.z, y.w) << 32); }
    }
}

typedef float f32x16 __attribute__((ext_vector_type(16)));
typedef short s16x8 __attribute__((ext_vector_type(8)));
typedef __bf16 bf16x2_t __attribute__((ext_vector_type(2)));
#define MFMA32(a, b, c) __builtin_amdgcn_mfma_f32_32x32x16_bf16((a), (b), (c), 0, 0, 0)
DI unsigned cvtpk(float lo, float hi) { f32x2 v = {lo, hi}; bf16x2_t bb = __builtin_convertvector(v, bf16x2_t); return __builtin_bit_cast(unsigned, bb); }
DI float pairmax(float v) { auto rr = __builtin_amdgcn_permlane32_swap(__float_as_uint(v), __float_as_uint(v), false, false); return fmaxf(__uint_as_float(rr[0]), __uint_as_float(rr[1])); }
constexpr float LOG2E = 1.4426950408889634f, ATT_C2 = 0.125f * LOG2E, ATT_THR = 6.0f;
template <int QMASK, bool LOCAL>
DI void attn_tile(const s16x8 (&kf)[4], const s16x8 (&vf)[4], const LAS s16x8* qfp, f32x16 (&o)[2], float& m, float& l, const LAS float* brow, int djb, int lo) {
    f32x16 s; s16x8 qf[4];
#pragma unroll
    for (int ks = 0; ks < 4; ++ks) qf[ks] = qfp[ks * 64];
#pragma unroll
    for (int i = 0; i < 16; ++i) s[i] = 0.f;
#pragma unroll
    for (int ks = 0; ks < 4; ++ks) s = MFMA32(kf[ks], qf[ks], s);
    float sv[16]; float tmax = -INFINITY;
#pragma unroll
    for (int i = 0; i < 16; ++i) {
        if (!((QMASK >> (i >> 2)) & 1)) { sv[i] = -INFINITY; continue; }
        if (LOCAL) { const int dj = djb + (i & 3) + 8 * (i >> 2); const bool valid = (unsigned)(dj - lo) < 16u;
            const float x = s[i] * ATT_C2 + brow[valid ? dj : 0]; sv[i] = valid ? x : -INFINITY; }
        else sv[i] = s[i] * ATT_C2;
        tmax = fmaxf(tmax, sv[i]);
    }
    tmax = pairmax(tmax);
    if (__any(tmax > m + ATT_THR)) { const float mn = fmaxf(m, tmax), alpha = __builtin_amdgcn_exp2f(m - mn); o[0] *= alpha; o[1] *= alpha; l *= alpha; m = mn; }
    float p[16];
#pragma unroll
    for (int i = 0; i < 16; ++i) { if ((QMASK >> (i >> 2)) & 1) { p[i] = __builtin_amdgcn_exp2f(sv[i] - m); l += p[i]; } else p[i] = 0.f; }
#pragma unroll
    for (int s2 = 0; s2 < 2; ++s2) if (QMASK & (3 << (2 * s2))) {
        v4u pk; pk.x = cvtpk(p[8 * s2], p[8 * s2 + 1]); pk.y = cvtpk(p[8 * s2 + 2], p[8 * s2 + 3]); pk.z = cvtpk(p[8 * s2 + 4], p[8 * s2 + 5]); pk.w = cvtpk(p[8 * s2 + 6], p[8 * s2 + 7]);
        const s16x8 pf = __builtin_bit_cast(s16x8, pk);
        o[0] = MFMA32(vf[s2], pf, o[0]); o[1] = MFMA32(vf[2 + s2], pf, o[1]);
    }
}
DI void attn_mfma(Frame& F) {
    const bf16* QF = (const bf16*)(F.ws + WS_QF); const bf16* KF = (const bf16*)(F.ws + WS_KF); const bf16* VF = (const bf16*)(F.ws + WS_VF);
    bf16* MIX = (bf16*)(F.ws + WS_MIX); const float* rpb = F.in[10];
    LAS float* rp = (LAS float*)(F.lds);
    for (int i = F.tid; i < NHEAD * 15 * 31; i += 512) rp[i] = rpb[i] * LOG2E;
    __syncthreads();
    const int lane = F.lane, hh = lane >> 5, ql = lane & 31;
    int lo[2], djb[2][2];
#pragma unroll
    for (int qb = 0; qb < 2; ++qb) { const int qc = 32 * qb + ql, c0 = min(max(qc - 8, 0), 48); lo[qb] = c0 - qc + 15;
#pragma unroll
        for (int jb = 0; jb < 2; ++jb) djb[qb][jb] = 32 * (jb - qb) + 4 * hh - ql + 15; }
    for (int unit = F.gw; unit < NBATCH * NHEAD * 64; unit += F.NGW) {
        const int r = unit & 63, h = (unit >> 6) & 7, b = unit >> 9, bh = b * 8 + h;
        LAS s16x8* qfl = (LAS s16x8*)(F.lds + 16384 + F.wave * 8192) + lane;
#pragma unroll
        for (int qb = 0; qb < 2; ++qb)
#pragma unroll
            for (int ks = 0; ks < 4; ++ks) qfl[(qb * 4 + ks) * 64] = ((const s16x8*)(QF + (size_t)(bh * 128 + 2 * r + qb) * 2048))[ks * 64 + lane];
        f32x16 o[2][2]; float m[2], l[2];
#pragma unroll
        for (int qb = 0; qb < 2; ++qb) { m[qb] = -1e30f; l[qb] = 0.f;
#pragma unroll
            for (int dt = 0; dt < 2; ++dt)
#pragma unroll
                for (int i = 0; i < 16; ++i) o[qb][dt][i] = 0.f; }
        const int r0 = min(max(r - 4, 0), 56);
        s16x8 kf[4], vf[4], kn[4];
        { const s16x8* kp = (const s16x8*)(KF + (size_t)(bh * 136 + 128) * 2048) + lane;
#pragma unroll
          for (int j = 0; j < 4; ++j) kn[j] = kp[j * 64]; }
#pragma unroll 1
        for (int kb = 0; kb < 8; ++kb) {
            { const s16x8* vp = (const s16x8*)(VF + (size_t)(bh * 136 + 128 + kb) * 2048) + lane;
#pragma unroll
              for (int j = 0; j < 4; ++j) { kf[j] = kn[j]; vf[j] = vp[j * 64]; } }
            { const int nb = (kb < 7) ? bh * 136 + 128 + kb + 1 : bh * 136 + 2 * r0;
              const s16x8* kp = (const s16x8*)(KF + (size_t)nb * 2048) + lane;
#pragma unroll
              for (int j = 0; j < 4; ++j) kn[j] = kp[j * 64]; }
            attn_tile<15, false>(kf, vf, qfl, o[0], m[0], l[0], rp, 0, 0); __builtin_amdgcn_sched_barrier(0);
            attn_tile<15, false>(kf, vf, qfl + 256, o[1], m[1], l[1], rp, 0, 0); __builtin_amdgcn_sched_barrier(0);
        }
#pragma unroll 1
        for (int i = 0; i < 8; ++i) {
            const LAS float* brow = rp + (h * 15 + (r0 + i - r + 7)) * 31;
            { const s16x8* vp = (const s16x8*)(VF + (size_t)(bh * 136 + 2 * (r0 + i)) * 2048) + lane;
#pragma unroll
              for (int j = 0; j < 4; ++j) { kf[j] = kn[j]; vf[j] = vp[j * 64]; } }
            { const int nb = bh * 136 + 2 * (r0 + i) + 1;
              const s16x8* kp = (const s16x8*)(KF + (size_t)nb * 2048) + lane;
#pragma unroll
              for (int j = 0; j < 4; ++j) kn[j] = kp[j * 64]; }
            attn_tile<15, true>(kf, vf, qfl, o[0], m[0], l[0], brow, djb[0][0], lo[0]); __builtin_amdgcn_sched_barrier(0);
            attn_tile<8, true>(kf, vf, qfl + 256, o[1], m[1], l[1], brow, djb[1][0], lo[1]); __builtin_amdgcn_sched_barrier(0);
            { const s16x8* vp = (const s16x8*)(VF + (size_t)(bh * 136 + 2 * (r0 + i) + 1) * 2048) + lane;
#pragma unroll
              for (int j = 0; j < 4; ++j) { kf[j] = kn[j]; vf[j] = vp[j * 64]; } }
            { const int nb = bh * 136 + 2 * (r0 + ((i < 7) ? i + 1 : 0));
              const s16x8* kp = (const s16x8*)(KF + (size_t)nb * 2048) + lane;
#pragma unroll
              for (int j = 0; j < 4; ++j) kn[j] = kp[j * 64]; }
            attn_tile<1, true>(kf, vf, qfl, o[0], m[0], l[0], brow, djb[0][1], lo[0]); __builtin_amdgcn_sched_barrier(0);
            attn_tile<15, true>(kf, vf, qfl + 256, o[1], m[1], l[1], brow, djb[1][1], lo[1]); __builtin_amdgcn_sched_barrier(0);
        }
#pragma unroll
        for (int qb = 0; qb < 2; ++qb) {
            const float lt = l[qb] + __shfl_xor(l[qb], 32), inv = 1.0f / lt;
            bf16* orow = MIX + (size_t)(b * SEQ + r * GRIDW + 32 * qb + ql) * DM + 512 + h * 64 + 4 * hh;
#pragma unroll
            for (int dt = 0; dt < 2; ++dt)
#pragma unroll
                for (int g = 0; g < 4; ++g) { v2u w; w.x = pk2(o[qb][dt][4 * g] * inv, o[qb][dt][4 * g + 1] * inv); w.y = pk2(o[qb][dt][4 * g + 2] * inv, o[qb][dt][4 * g + 3] * inv);
                    *(v2u*)(orow + 32 * dt + 8 * g) = w; }
        }
    }
    __syncthreads();
}
DI void pool_mfma(Frame& F) {
    const bf16* PBF = (const bf16*)(F.ws + WS_PB); bf16* MIX = (bf16*)(F.ws + WS_MIX); const bf16* PW = (const bf16*)(F.ws + WS_POOLW); const float* pool_scale = F.in[9];
    constexpr int RS = 272;
    LAS unsigned char* ptile = F.lds + 32768;
    LAS unsigned char* atile = F.lds + 32768 + 144 * RS;
    const int lane = F.lane, hh = lane >> 5, ql = lane & 31;
    for (int tile = F.vcu; tile < NTOK / 128; tile += F.G) {
        const int tok0 = tile * 128, bstart = tok0 & ~(SEQ - 1);
#pragma unroll 1
        for (int g = 0; g < 4; ++g) {
            for (int it = F.tid; it < 144 * 16; it += 512) { const int rr = it >> 4, ch = it & 15, t = tok0 - 8 + rr;
                v4u v = (v4u){0u, 0u, 0u, 0u};
                if (t >= bstart && t < bstart + SEQ) v = *(const v4u*)(PBF + (size_t)t * 512 + g * 128 + ch * 8);
                *(LAS v4u*)(ptile + rr * RS + ch * 16) = v; }
            __syncthreads();
            { const int cp = F.tid & 63, sg = F.tid >> 6, w = 2 << g, hw = w >> 1;
              const LAS unsigned char* col = ptile + cp * 4;
              float s0 = 0.f, s1 = 0.f;
              const int tl0 = sg * 16;
              for (int rr = tl0 + 8 - hw; rr < tl0 + 8 + hw; ++rr) { const unsigned u = *(const LAS unsigned*)(col + rr * RS); s0 += bflo(u); s1 += bfhi(u); }
#pragma unroll 4
              for (int i = 0; i < 16; ++i) { const int tl = tl0 + i, sp = (tok0 + tl) & (SEQ - 1);
                  const int cnt = min(sp + hw, SEQ) - max(sp - hw, 0); const float inv = 1.0f / (float)cnt;
                  const unsigned self = *(const LAS unsigned*)(col + (tl + 8) * RS);
                  *(LAS unsigned*)(atile + tl * RS + cp * 4) = pk2(s0 * inv - bflo(self), s1 * inv - bfhi(self));
                  const unsigned un = *(const LAS unsigned*)(col + (tl + 8 + hw) * RS), uo = *(const LAS unsigned*)(col + (tl + 8 - hw) * RS);
                  s0 += bflo(un) - bflo(uo); s1 += bfhi(un) - bfhi(uo); } }
            __syncthreads();
            { const int tb = F.wave >> 1, dt0 = (F.wave & 1) * 2;
              f32x16 acc[2];
#pragma unroll
              for (int j = 0; j < 2; ++j)
#pragma unroll
                  for (int i = 0; i < 16; ++i) acc[j][i] = 0.f;
#pragma unroll
              for (int ks = 0; ks < 8; ++ks) {
                  const s16x8 bfr = *(const LAS s16x8*)(atile + (32 * tb + ql) * RS + (16 * ks + 8 * hh) * 2);
#pragma unroll
                  for (int j = 0; j < 2; ++j) { const s16x8 afr = *(const s16x8*)(PW + (size_t)g * 16384 + (32 * (dt0 + j) + ql) * 128 + 16 * ks + 8 * hh);
                      acc[j] = MFMA32(afr, bfr, acc[j]); } }
              bf16* orow = MIX + (size_t)(tok0 + 32 * tb + ql) * DM + g * 128 + 4 * hh;
#pragma unroll
              for (int j = 0; j < 2; ++j)
#pragma unroll
                  for (int q = 0; q < 4; ++q) { const int d = 32 * (dt0 + j) + 8 * q; const f32x4 sc = *(const f32x4*)(pool_scale + g * 128 + d + 4 * hh);
                      v2u wv; wv.x = pk2(acc[j][4 * q] * sc.x, acc[j][4 * q + 1] * sc.y); wv.y = pk2(acc[j][4 * q + 2] * sc.z, acc[j][4 * q + 3] * sc.w);
                      *(v2u*)(orow + d) = wv; } }
            __syncthreads();
        }
    }
}
DI int f2key(float f) { const int b = __float_as_int(f); return b ^ ((b >> 31) & 0x7fffffff); }
DI float key2f(int k) { return __int_as_float(k ^ ((k >> 31) & 0x7fffffff)); }
DI void ce_desc(int& x, int& y) { const int hi = max(x, y), lo = min(x, y); x = hi; y = lo; }
DI void sort16_desc(int (&a)[16]) {
#pragma unroll
    for (int k = 2; k <= 16; k <<= 1)
#pragma unroll
        for (int j = k >> 1; j > 0; j >>= 1)
#pragma unroll
            for (int i = 0; i < 16; ++i) { const int l = i ^ j; if (l > i) { if ((i & k) == 0) ce_desc(a[i], a[l]); else ce_desc(a[l], a[i]); } }
}
DI void merge16_desc(int (&a)[16], const int (&b)[16]) {
#pragma unroll
    for (int i = 0; i < 16; ++i) a[i] = max(a[i], b[15 - i]);
#pragma unroll
    for (int j = 8; j > 0; j >>= 1)
#pragma unroll
        for (int i = 0; i < 16; ++i) if ((i & j) == 0) ce_desc(a[i], a[i + j]);
}
DI void peer_topk_mfma(Frame& F, int tile) {
    const bf16* QP = (const bf16*)(F.ws + WS_ZX); const bf16* KEYF = (const bf16*)(F.ws + WS_KEYS);
    int* EXPERTS = (int*)(F.ws + WS_EXP); float* GATES = (float*)(F.ws + WS_GATE);
    const int lane = F.lane, hh = lane >> 5, ql = lane & 31, tb = F.wave >> 1, p = F.wave & 1;
    const int tokblk = tile * 4 + tb, tok = tokblk * 32 + ql;
#pragma unroll 1
    for (int h = 0; h < 8; ++h) {
        const int hp = 2 * h + p;
        s16x8 qf[8];
#pragma unroll
        for (int ks = 0; ks < 8; ++ks) qf[ks] = ((const s16x8*)(QP + ((size_t)tokblk * 16 + hp) * 4096))[ks * 64 + lane];
        const s16x8* kfp = (const s16x8*)(KEYF + (size_t)hp * 16384) + lane;
        int top[16];
#pragma unroll
        for (int i = 0; i < 16; ++i) top[i] = (int)0x80000000;
#pragma unroll 1
        for (int nt = 0; nt < 4; ++nt) {
            f32x16 acc;
#pragma unroll
            for (int i = 0; i < 16; ++i) acc[i] = 0.f;
#pragma unroll
            for (int ks = 0; ks < 8; ++ks) acc = MFMA32(kfp[(nt * 8 + ks) * 64], qf[ks], acc);
            int a[16];
#pragma unroll
            for (int i = 0; i < 16; ++i) { const int n = 32 * nt + (i & 3) + 8 * (i >> 2) + 4 * hh; a[i] = f2key(__int_as_float((__float_as_int(acc[i]) & ~127) | n)); }
            sort16_desc(a);
            merge16_desc(top, a);
        }
        { int oth[16];
#pragma unroll
          for (int i = 0; i < 16; ++i) oth[i] = __shfl_xor(top[i], 32);
          merge16_desc(top, oth); }
        LAS float* L = (LAS float*)(F.lds) + (h & 1) * 4096 + (tb * 2) * 512;
        if (hh == 0) {
#pragma unroll
            for (int i = 0; i < 16; ++i) L[p * 512 + i * 32 + ql] = key2f(top[i]);
        }
        __syncthreads();
        if (p == 0 && hh == 0) {
            float v0[16], v1[16];
#pragma unroll
            for (int i = 0; i < 16; ++i) { v0[i] = __int_as_float(__float_as_int(L[i * 32 + ql]) & ~127); v1[i] = __int_as_float(__float_as_int(L[512 + i * 32 + ql]) & ~127); }
            int grp[4][16]; int cnt = 0;
#pragma unroll
            for (int g = 0; g < 4; ++g)
#pragma unroll
                for (int i = 0; i < 16; ++i) grp[g][i] = (int)0x80000000;
#pragma unroll
            for (int i = 0; i < 16; ++i)
#pragma unroll
                for (int j = 0; j < 16; ++j) if ((i + 1) * (j + 1) <= 16) {
                    grp[cnt >> 4][cnt & 15] = f2key(__int_as_float((__float_as_int(v0[i] + v1[j]) & ~255) | (i * 16 + j))); ++cnt; }
#pragma unroll
            for (int g = 0; g < 4; ++g) sort16_desc(grp[g]);
            merge16_desc(grp[0], grp[1]); merge16_desc(grp[2], grp[3]); merge16_desc(grp[0], grp[2]);
            float tv[16]; float e[16]; float sum = 0.f; int eid[16];
#pragma unroll
            for (int k = 0; k < 16; ++k) { const int bits = __float_as_int(key2f(grp[0][k])); const int code = bits & 255; tv[k] = __int_as_float(bits & ~255);
                const int n0 = __float_as_int(L[(code >> 4) * 32 + ql]) & 127, n1 = __float_as_int(L[512 + (code & 15) * 32 + ql]) & 127; eid[k] = n0 * 128 + n1; }
#pragma unroll
            for (int k = 0; k < 16; ++k) { e[k] = __expf(tv[k] - tv[0]); sum += e[k]; }
            const float is = 1.0f / sum;
            int* ep = EXPERTS + (size_t)tok * 128 + h * 16; float* gp = GATES + (size_t)tok * 128 + h * 16;
#pragma unroll
            for (int k4 = 0; k4 < 4; ++k4) { *(v4u*)(ep + 4 * k4) = (v4u){(unsigned)eid[4 * k4], (unsigned)eid[4 * k4 + 1], (unsigned)eid[4 * k4 + 2], (unsigned)eid[4 * k4 + 3]};
                *(f32x4*)(gp + 4 * k4) = (f32x4){e[4 * k4] * is, e[4 * k4 + 1] * is, e[4 * k4 + 2] * is, e[4 * k4 + 3] * is}; }
        }
    }
    VM_WAIT(); __syncthreads();
}

DI float gelu_fast(float v) {
    const float av = fabsf(v), t = __builtin_amdgcn_rcpf(av * 0.2316418882f + 1.0f);
    float q = t * 0.5307027145f + (-0.7265760135f); q = q * t + 0.7107068705f; q = q * t + (-0.142248368f); q = q * t + 0.127414796f; q = q * t;
    const float e = __builtin_amdgcn_exp2f((v * v) * (-0.72134752044f));
    const float m = v * (q * e);
    return v < 0.f ? m : v - m;
}
DI float gelu_exact(float a) { return 0.5f * a * (1.0f + erff(a * 0.70710678118654752f)); }

DI void fp8x16_to_f32(const v4u r, float (&f)[16]) {
#pragma unroll
    for (int j = 0; j < 4; ++j) { const f32x2 lo = __builtin_amdgcn_cvt_pk_f32_fp8((int)r[j], false), hi = __builtin_amdgcn_cvt_pk_f32_fp8((int)r[j], true);
        f[4 * j] = lo.x; f[4 * j + 1] = lo.y; f[4 * j + 2] = hi.x; f[4 * j + 3] = hi.y; }
}
template <bool FAKE = false, bool UONLY = false> DI void gather_v4(Frame& F, int tbase) {
    constexpr int NT = 8, NK = 16, N = 1024;
    const bf16* H2 = (const bf16*)(F.ws + WS_HX); const unsigned char* U = F.ws + WS_U; const unsigned char* V = F.ws + WS_V;
    const int* EXPERTS = (const int*)(F.ws + WS_EXP); const float* GATES = (const float*)(F.ws + WS_GATE); const float* MOD = (const float*)(F.ws + WS_MOD);
    const float* SU = (const float*)(F.ws + WS_SU);
    const int lane = F.lane;
    constexpr int EM = FAKE ? FAKE_MASK : 16383;
    int key[NK];
#pragma unroll
    for (int j = 0; j < NT; ++j)
#pragma unroll
        for (int hf = 0; hf < 2; ++hf) { const int k = hf * 64 + lane; key[j * 2 + hf] = (EXPERTS[(size_t)(tbase + j) * 128 + k] << 10) | (j << 7) | k; }
#pragma unroll
    for (int k = 2; k <= N; k <<= 1)
#pragma unroll
        for (int j = k >> 1; j > 0; j >>= 1) {
            if (j < NK) {
#pragma unroll
                for (int r = 0; r < NK; ++r) if ((r & j) == 0) { const bool asc = (((lane * NK + r) & k) == 0); const int x = key[r], y = key[r | j], lo = min(x, y), hi = max(x, y);
                    key[r] = asc ? lo : hi; key[r | j] = asc ? hi : lo; }
            } else {
                const bool asc = (((lane * NK) & k) == 0), lower = ((lane & (j / NK)) == 0), takemin = (asc == lower);
#pragma unroll
                for (int r = 0; r < NK; ++r) { const int o = __shfl_xor(key[r], j / NK); key[r] = takemin ? min(key[r], o) : max(key[r], o); }
            }
        }
    LAS v4u* hL = (LAS v4u*)(F.lds) + F.wave * (NT * 64) + lane;
    LAS float* sgL = (LAS float*)(F.lds + 65536) + F.wave * (2 * N); LAS float* suL = sgL + N;
    {   float hsc[NT];
#pragma unroll
        for (int j = 0; j < NT; ++j) { const v4u a = *((const v4u*)(H2 + (size_t)(tbase + j) * DM + lane * 16)), b = *((const v4u*)(H2 + (size_t)(tbase + j) * DM + lane * 16 + 8));
            float hv[16]; hv[0] = bflo(a.x); hv[1] = bfhi(a.x); hv[2] = bflo(a.y); hv[3] = bfhi(a.y); hv[4] = bflo(a.z); hv[5] = bfhi(a.z); hv[6] = bflo(a.w); hv[7] = bfhi(a.w);
            hv[8] = bflo(b.x); hv[9] = bfhi(b.x); hv[10] = bflo(b.y); hv[11] = bfhi(b.y); hv[12] = bflo(b.z); hv[13] = bfhi(b.z); hv[14] = bflo(b.w); hv[15] = bfhi(b.w);
            float am = 0.f;
#pragma unroll
            for (int i = 0; i < 16; ++i) am = fmaxf(am, fabsf(hv[i]));
#pragma unroll
            for (int o = 1; o < 64; o <<= 1) am = fmaxf(am, __shfl_xor(am, o));
            am = fmaxf(am, 1e-30f); hsc[j] = am * (1.0f / 127.0f);
            const float inv = 127.0f / am;
            v4u hq;
#pragma unroll
            for (int d = 0; d < 4; ++d) { const int q0 = (int)rintf(hv[4 * d] * inv), q1 = (int)rintf(hv[4 * d + 1] * inv), q2 = (int)rintf(hv[4 * d + 2] * inv), q3 = (int)rintf(hv[4 * d + 3] * inv);
                hq[d] = (unsigned)(q0 & 255) | ((unsigned)(q1 & 255) << 8) | ((unsigned)(q2 & 255) << 16) | ((unsigned)(q3 & 255) << 24); }
            hL[j * 64] = hq; }
#pragma unroll
        for (int r = 0; r < NK; ++r) { const int tj = (key[r] >> 7) & 7; float sc = hsc[0];
#pragma unroll
            for (int j = 1; j < NT; ++j) sc = (tj == j) ? hsc[j] : sc;
            sgL[lane * NK + r] = GATES[(size_t)(tbase + tj) * 128 + (key[r] & 127)]; suL[lane * NK + r] = SU[(key[r] >> 10) & EM] * sc; } }
#define V4_ROW(TBL, par, ln, r) (*((const v4u*)((TBL) + (size_t)((__builtin_amdgcn_readlane(key[(par) * 8 + (r)], (ln)) >> 10) & EM) * 1024) + lane))
    {   v4u ub[4][8];
#pragma unroll
        for (int q = 0; q < 4; ++q)
#pragma unroll
            for (int r = 0; r < 8; ++r) ub[q][r] = V4_ROW(U, q & 1, q >> 1, r);
#pragma unroll 1
        for (int b4 = 0; b4 < 32; ++b4) {
#pragma unroll
            for (int q = 0; q < 4; ++q) {
                const int par = q & 1, ln = 2 * b4 + (q >> 1), lnn = (ln + 2) & 63;
                int p[8]; v4u hsel[8];
#pragma unroll
                for (int r = 0; r < 8; ++r) { hsel[r] = hL[((__builtin_amdgcn_readlane(key[par * 8 + r], ln) >> 7) & 7) * 64]; p[r] = 0; }
#pragma unroll
                for (int qq = 0; qq < 4; ++qq)
#pragma unroll
                    for (int r = 0; r < 8; ++r) p[r] = __builtin_amdgcn_sdot4((int)ub[q][r][qq], (int)hsel[r][qq], p[r], false);
#pragma unroll
                for (int r = 0; r < 8; ++r) ub[q][r] = V4_ROW(U, par, lnn, r);
                int psum;
                { int q4[4];
#pragma unroll
                  for (int i = 0; i < 4; ++i) { auto rr = __builtin_amdgcn_permlane32_swap((unsigned)p[i], (unsigned)p[i + 4], false, false); q4[i] = (int)(rr[0] + rr[1]); }
                  int q2[2];
#pragma unroll
                  for (int i = 0; i < 2; ++i) { auto rr = __builtin_amdgcn_permlane16_swap((unsigned)q4[i], (unsigned)q4[i + 2], false, false); q2[i] = (int)(rr[0] + rr[1]); }
                  const int t0 = q2[0] + __builtin_amdgcn_update_dpp(0, q2[0], 0x128, 0xf, 0xf, false);
                  const int t1 = q2[1] + __builtin_amdgcn_update_dpp(0, q2[1], 0x128, 0xf, 0xf, false);
                  int v = (lane & 8) ? t1 : t0;
                  v += __builtin_amdgcn_update_dpp(0, v, 0x141, 0xf, 0xf, false);
                  v += __builtin_amdgcn_update_dpp(0, v, 0x4e, 0xf, 0xf, false);
                  v += __builtin_amdgcn_update_dpp(0, v, 0xb1, 0xf, 0xf, false);
                  psum = v; }
                const int pos = (4 * b4 + q) * 8 + ((lane >> 3) & 7);
                const float w = sgL[pos] * gelu_fast((float)psum * suL[pos]);
                if ((lane & 7) == 0) sgL[pos] = w;
            }
        }
    }
    if constexpr (!UONLY) {
    LAS int* lst = (LAS int*)(F.lds) + F.wave * 2048;
    { int cnt0 = 0;
#pragma unroll
      for (int r = 0; r < NK; ++r) cnt0 += ((key[r] >> 9) & 1) ^ 1;
      int inc = cnt0;
#pragma unroll
      for (int o = 1; o < 64; o <<= 1) { const int t = __shfl_up(inc, o); if (lane >= o) inc += t; }
      int o0 = inc - cnt0, o1 = lane * NK - o0;
#pragma unroll
      for (int r = 0; r < NK; ++r) { const int g1 = (key[r] >> 9) & 1; const int ent = ((key[r] >> 10) << 13) | (((key[r] >> 7) & 3) << 11) | (lane * NK + r);
          if (g1) { lst[512 + o1] = ent; ++o1; } else { lst[o0] = ent; ++o0; } } }
    const float* fg = F.in[17];
#pragma unroll 1
    for (int g = 0; g < 2; ++g) {
        int kg[8];
#pragma unroll
        for (int r = 0; r < 8; ++r) kg[r] = lst[g * 512 + lane * 8 + r];
        float out[4][16];
#pragma unroll
        for (int j = 0; j < 4; ++j)
#pragma unroll
            for (int i = 0; i < 16; ++i) out[j][i] = 0.f;
        v4u vb[2][8];
#pragma unroll
        for (int par = 0; par < 2; ++par)
#pragma unroll
            for (int r = 0; r < 8; ++r) vb[par][r] = *((const v4u*)(V + (size_t)((__builtin_amdgcn_readlane(kg[r], par) >> 13) & EM) * 1024) + lane);
#pragma unroll 1
        for (int b2 = 0; b2 < 32; ++b2) {
#pragma unroll
            for (int par = 0; par < 2; ++par) {
                const int b = 2 * b2 + par, bn = (b + 2 < 64) ? b + 2 : par;
#pragma unroll
                for (int r = 0; r < 8; ++r) { const int kk = __builtin_amdgcn_readlane(kg[r], b); const float wr = sgL[kk & 2047]; const int tk = (kk >> 11) & 3;
                    float f[16]; fp8x16_to_f32(vb[par][r], f);
#pragma unroll
                    for (int j = 0; j < 4; ++j) if (tk == j) {
#pragma unroll
                        for (int i = 0; i < 16; ++i) out[j][i] += wr * f[i]; } }
#pragma unroll
                for (int r = 0; r < 8; ++r) vb[par][r] = *((const v4u*)(V + (size_t)((__builtin_amdgcn_readlane(kg[r], bn) >> 13) & EM) * 1024) + lane);
            }
        }
#pragma unroll
        for (int j = 0; j < 4; ++j) {
            const int t = tbase + g * 4 + j, bb = t >> 12; const float* g2 = MOD + bb * NMOD + 5 * DM; float* xo = F.out + (size_t)t * DM;
            const bf16* x1r = (const bf16*)(F.ws + WS_X1) + (size_t)t * DM + lane * 16;
            float x2[16]; float ss = 0.f;
#pragma unroll
            for (int hq = 0; hq < 4; ++hq) { const int c = lane * 16 + hq * 4; const v2u xw = *(const v2u*)(x1r + hq * 4); const f32x4 xv = (f32x4){bflo(xw.x), bfhi(xw.x), bflo(xw.y), bfhi(xw.y)}, gv = *(const f32x4*)(g2 + c);
#pragma unroll
                for (int e = 0; e < 4; ++e) { const float y = xv[e] + gv[e] * (out[j][hq * 4 + e] * (1.0f / V_SCALE)); x2[hq * 4 + e] = y; ss += y * y; } }
            const float rinv = 1.0f / sqrtf(wave_sum(ss) * (1.f / DM) + EPS);
#pragma unroll
            for (int hq = 0; hq < 4; ++hq) { const int c = lane * 16 + hq * 4; const f32x4 fv = *(const f32x4*)(fg + c);
                f32x4 y;
#pragma unroll
                for (int e = 0; e < 4; ++e) y[e] = x2[hq * 4 + e] * rinv * fv[e];
                if (!FAKE || rinv == 12345.678f) *(f32x4*)(xo + c) = y; }
        }
    }
    }
}

struct Args { const float* in[18]; float* out; unsigned char* ws; int ph_lo, ph_hi, li, pad; };
__global__ void __launch_bounds__(NWAVES * 64, 2) mk_fwd(Args args) {
    extern __shared__ __attribute__((aligned(16))) unsigned char lds[];
    Frame F;
    F.lds = (LAS unsigned char*)lds;
    F.tid = threadIdx.x; F.lane = F.tid & 63; F.wave = __builtin_amdgcn_readfirstlane(F.tid >> 6);
    F.G = gridDim.x; { const int bx = blockIdx.x; F.vcu = (F.G % 8 == 0) ? (bx % 8) * (F.G / 8) + bx / 8 : bx; }
    F.gw = F.vcu * NWAVES + F.wave; F.NGW = F.G * NWAVES;
#pragma unroll
    for (int i = 0; i < 18; ++i) F.in[i] = args.in[i];
    F.out = args.out; F.ws = args.ws;
    volatile LAS unsigned* MISC = (volatile LAS unsigned*)(F.lds + MISC_OFF);
    for (int u = F.tid; u < (LDS_BYTES - LDSCTL_OFF) / 4; u += NWAVES * 64) ((LAS unsigned*)(F.lds + LDSCTL_OFF))[u] = 0u;
    __syncthreads();
    gu32* ctl = (gu32*)(F.ws + WS_CTL);
    XcdBarrier bar; bar.bar = (unsigned*)(ctl + CW_BAR) + args.li * XCD_BAR_WORDS; bar.x = 0; bar.st = nullptr;
    const int lo = args.ph_lo, hi = args.ph_hi;
    if (hi - lo > 1) bar = xcd_barrier_post((unsigned*)(ctl + CW_BAR) + args.li * XCD_BAR_WORDS, MISC + 8);
#ifndef PROBE_MASK
#define PROBE_MASK 0
#endif
#define REP(k) for (int rep_ = 0; rep_ < 1 + ((PROBE_MASK >> (k)) & 1); ++rep_)
#define IN(k) (lo <= (k) && (k) < hi)
#ifndef PROBE_SEAMS
#define PROBE_SEAMS 1
#endif
#define SEAM(k) do { if (IN(k) && IN((k) + 1)) for (int s_ = 0; s_ < PROBE_SEAMS; ++s_) xcd_barrier(bar); } while (0)

    if (IN(0)) { REP(0) { p0_prologue(F); __syncthreads(); } SEAM(0); }
    if (IN(1)) { REP(1) norm_rows<false>(F, F.in[0], F.in[2], MROWS, F.in[6], 0, DM, (bf16*)(F.ws + WS_HX)); SEAM(1); }
    if (IN(2)) {
        pg8::Gemm g{(const bf16*)(F.ws + WS_HX), (const bf16*)(F.ws + WS_WIN), MROWS, DIN, DM}; pg8::InProjOrder S; S.init(F.G, (int)blockIdx.x);
        pg8::EpiInProj E{(bf16*)(F.ws + WS_PB), (bf16*)(F.ws + WS_QF), (bf16*)(F.ws + WS_KF), (bf16*)(F.ws + WS_VF)};
        REP(2) pg8::gemm_phase<pg8::EpiInProj, pg8::InProjOrder, true, true>(F.lds + RING_OFF, g, S, E);
        SEAM(2);
    }
    if (IN(3)) { REP(3) attn_mfma(F); REP(9) pool_mfma(F); SEAM(3); }
    if (IN(4)) {
        pg8::Gemm g{(const bf16*)(F.ws + WS_MIX), (const bf16*)(F.ws + WS_WOUT), NTOK, DM, DM}; pg8::StaticOrder S; S.init(NTOK, DM, F.G, (int)blockIdx.x);
        pg8::EpiX1 E{F.in[0], (const float*)(F.ws + WS_MOD), (bf16*)(F.ws + WS_X1)};
        REP(4) pg8::gemm_phase<pg8::EpiX1, pg8::StaticOrder, true, true>(F.lds + RING_OFF, g, S, E);
        SEAM(4);
    }
    if (IN(5)) { REP(5) norm_rows<true>(F, (const float*)(F.ws + WS_X1), nullptr, NTOK, F.in[12], 3 * DM, 4 * DM, (bf16*)(F.ws + WS_HX)); SEAM(5); }
    if (IN(6)) {
        pg8::Gemm g{(const bf16*)(F.ws + WS_HX), (const bf16*)(F.ws + WS_WQ), NTOK, 2048, DM}; pg8::StaticOrder S; S.init(NTOK, 2048, F.G, (int)blockIdx.x);
        pg8::EpiQP E{(bf16*)(F.ws + WS_ZX)};
        REP(6) pg8::gemm_phase<pg8::EpiQP, pg8::StaticOrder, true, true>(F.lds + RING_OFF, g, S, E);
        SEAM(6);
    }
    if (IN(7)) {
        for (int tile = F.vcu; tile < NTOK / 128; tile += F.G) {
            const int tok0 = tile * 128;
            REP(7) peer_topk_mfma(F, tile);
            if ((PROBE_MASK >> 10) & 1) for (int rd = 0; rd < 2; ++rd) gather_v4<false>(F, tok0 + rd * 64 + F.wave * 8);
            for (int rd = 0; rd < 2; ++rd) gather_v4<false>(F, tok0 + rd * 64 + F.wave * 8);
        }
    }
#undef IN
#undef SEAM
}

extern "C" void kernel_launch(void* const* d_in, const int* in_sizes, int n_in, void* d_out, int out_size, void* d_ws, size_t ws_size, hipStream_t stream) {
    static int grid = 0;
    if (grid == 0) {
        if (n_in != 18 || in_sizes[0] != NTOK * DM || out_size != NTOK * DM || ws_size < WS_END) { fprintf(stderr, "kernel_launch: unexpected shapes / workspace (n_in %d, ws %zu); nothing launched\n", n_in, ws_size); grid = -1; return; }
        int dev = 0, cus = 0;
        if (hipGetDevice(&dev) != hipSuccess || hipDeviceGetAttribute(&cus, hipDeviceAttributeMultiprocessorCount, dev) != hipSuccess) { grid = -1; return; }
        if (hipFuncSetAttribute((const void*)mk_fwd, hipFuncAttributeMaxDynamicSharedMemorySize, LDS_BYTES) != hipSuccess) { fprintf(stderr, "kernel_launch: hipFuncSetAttribute failed\n"); grid = -1; return; }
        int per_cu = 0;
        if (hipOccupancyMaxActiveBlocksPerMultiprocessor(&per_cu, (const void*)mk_fwd, NWAVES * 64, LDS_BYTES) != hipSuccess || per_cu < 1) fprintf(stderr, "kernel_launch: note: occupancy query reports %d blocks per CU\n", per_cu);
        (void)hipGetLastError();
        grid = cus;
    }
    if (grid < 0) return;
    (void)hipMemsetAsync((char*)d_ws + WS_CTL, 0, CTL_ZERO_BYTES, stream);
    Args a{};
    for (int i = 0; i < 18; ++i) a.in[i] = (const float*)d_in[i];
    a.out = (float*)d_out; a.ws = (unsigned char*)d_ws;
    for (int li = 0; li < N_LAUNCHES; ++li) {
        if (N_LAUNCHES == 1) { a.ph_lo = 0; a.ph_hi = NPHASE; } else { a.ph_lo = li; a.ph_hi = li + 1; }
        a.li = (N_LAUNCHES == 1) ? 0 : 0;
        hipLaunchKernelGGL(mk_fwd, dim3(grid), dim3(NWAVES * 64), LDS_BYTES, stream, a);
    }
}
```

```cpp
#include <hip/hip_runtime.h>
#include <cstdio>
#include <cstdint>
#include <type_traits>
namespace pg8 {
#define PG8_LAS __attribute__((address_space(3)))
typedef unsigned short bf16_t;
typedef short bf16x8 __attribute__((ext_vector_type(8)));
typedef float f32x4 __attribute__((ext_vector_type(4)));
typedef unsigned u32x4 __attribute__((ext_vector_type(4)));
constexpr int BM = 256, BK = 64, HALF = 128, HTB = HALF * BK * 2  , STAGE_BYTES = 8 * HTB, NXCD = 8, WGM = 8;

__host__ __device__ __forceinline__ int lds_byte(int r, int c) { const int st = (r >> 4) * 2 + (c >> 5), rr = r & 15, cc = c & 31, ob = rr * 64 + cc * 2; return st * 1024 + (ob ^ (((ob >> 9) & 1) << 5)); }
__host__ __device__ __forceinline__ void stage_rc(int b, int& R, int& C) { const int st = b / 1024, sb = b % 1024, swz = sb ^ (((sb >> 9) & 1) << 5); R = (st >> 1) * 16 + swz / 64; C = (st & 1) * 32 + (swz % 64) / 2; }
__host__ __device__ __forceinline__ int perm32(int rho) { const int n = rho >> 4, i = rho & 15; return 8 * (i >> 2) + 4 * n + (i & 3); }

struct Unit { int pm, pn; };
struct Gemm { const bf16_t* A; const bf16_t* Bt; int M, N, K; };
struct StaticOrder {
    int nM, nN, nwg, G, c;
    __host__ __device__ void init(int M, int N, int G_, int c_) { nM = M / BM; nN = N / BM; nwg = nM * nN; G = G_; c = c_; }
    __host__ __device__ bool next(int i, Unit& u) const {
        const long L = (long)i * G + c; if (L >= nwg) return false;
        int wgid = (int)L; { const int q = nwg / NXCD, r = nwg % NXCD, xcd = wgid % NXCD, off = wgid / NXCD; wgid = (xcd < r ? xcd * (q + 1) : r * (q + 1) + (xcd - r) * q) + off; }
        const int nig = WGM * nN, gid = wgid / nig, fm = gid * WGM, gsz = (nM - fm) < WGM ? (nM - fm) : WGM;
        u.pm = fm + ((wgid % nig) % gsz); u.pn = (wgid % nig) / gsz; return true;
    }
    __device__ __forceinline__ void a_ready(const Unit&) const {}
    __device__ __forceinline__ void done(const Unit&) const {}
    __device__ __forceinline__ const char* pa(const Gemm& g, const Unit& u) const { return (const char*)g.A + (size_t)u.pm * ((size_t)BM * g.K * 2); }
    __device__ __forceinline__ const char* pb(const Gemm& g, const Unit& u) const { return (const char*)g.Bt + (size_t)u.pn * ((size_t)BM * g.K * 2); }
};
struct InProjOrder {
    StaticOrder so;
    __host__ __device__ void init(int G_, int c_) { so.init(136 * BM, 8 * BM, G_, c_); }
    __host__ __device__ bool next(int i, Unit& u) const { int cnt = -1; for (int j = 0; ; ++j) { if (!so.next(j, u)) return false; if (!(u.pm >= 128 && u.pn < 4)) { if (++cnt == i) return true; } } }
    __device__ __forceinline__ void a_ready(const Unit&) const {}
    __device__ __forceinline__ void done(const Unit&) const {}
    __device__ __forceinline__ const char* pa(const Gemm& g, const Unit& u) const { return u.pn < 6 ? (const char*)g.A + (size_t)u.pm * ((size_t)BM * g.K * 2) : (const char*)g.Bt + (size_t)u.pn * ((size_t)BM * g.K * 2); }
    __device__ __forceinline__ const char* pb(const Gemm& g, const Unit& u) const { return u.pn < 6 ? (const char*)g.Bt + (size_t)u.pn * ((size_t)BM * g.K * 2) : (const char*)g.A + (size_t)u.pm * ((size_t)BM * g.K * 2); }
};

__device__ __forceinline__ unsigned cvt_pk_bf16(float lo, float hi) { unsigned r; asm volatile("v_cvt_pk_bf16_f32 %0, %1, %2" : "=v"(r) : "v"(lo), "v"(hi)); return r; }
struct EpiBf16 {
    static constexpr bool PERM = true, AFTER_DRAIN = false;
    bf16_t* O; int ldc;
    __device__ __forceinline__ void operator()(const f32x4 (&acc)[2][2][4][2], const Unit& u, int wr, int wc, int fr, int fq) const {
        const int row0 = u.pm * BM + wr * 64 + fr, col0 = u.pn * BM + wc * 32 + 8 * fq;
#pragma unroll
        for (int ai = 0; ai < 2; ++ai)
#pragma unroll
            for (int m = 0; m < 4; ++m) { bf16_t* rowp = O + (size_t)(row0 + ai * HALF + m * 16) * ldc + col0;
#pragma unroll
                for (int bj = 0; bj < 2; ++bj) { const f32x4 v0 = acc[ai][bj][m][0], v1 = acc[ai][bj][m][1];
                    u32x4 w; w.x = cvt_pk_bf16(v0[0], v0[1]); w.y = cvt_pk_bf16(v0[2], v0[3]); w.z = cvt_pk_bf16(v1[0], v1[1]); w.w = cvt_pk_bf16(v1[2], v1[3]);
                    *(u32x4*)(rowp + bj * HALF) = w; } }
    }
};
struct EpiX1 {
    static constexpr bool PERM = true, AFTER_DRAIN = false;
    const float* x; const float* mod; bf16_t* out;
    __device__ __forceinline__ void operator()(const f32x4 (&acc)[2][2][4][2], const Unit& u, int wr, int wc, int fr, int fq) const {
        const int row0 = u.pm * BM + wr * 64 + fr, col0 = u.pn * BM + wc * 32 + 8 * fq;
        const float* g1 = mod + (size_t)((u.pm * BM) >> 12) * 6144 + 2048 + col0;
        f32x4 gv[2][2];
#pragma unroll
        for (int bj = 0; bj < 2; ++bj)
#pragma unroll
            for (int n = 0; n < 2; ++n) gv[bj][n] = *(const f32x4*)(g1 + bj * HALF + 4 * n);
#pragma unroll
        for (int ai = 0; ai < 2; ++ai)
#pragma unroll
            for (int m = 0; m < 4; ++m) { const size_t off = (size_t)(row0 + ai * HALF + m * 16) * 1024 + col0;
#pragma unroll
                for (int bj = 0; bj < 2; ++bj) { const f32x4 x0 = *(const f32x4*)(x + off + bj * HALF), x1 = *(const f32x4*)(x + off + bj * HALF + 4);
                    const f32x4 v0 = x0 + gv[bj][0] * acc[ai][bj][m][0], v1 = x1 + gv[bj][1] * acc[ai][bj][m][1];
                    u32x4 w; w.x = cvt_pk_bf16(v0[0], v0[1]); w.y = cvt_pk_bf16(v0[2], v0[3]); w.z = cvt_pk_bf16(v1[0], v1[1]); w.w = cvt_pk_bf16(v1[2], v1[3]);
                    *(u32x4*)(out + off + bj * HALF) = w; } }
    }
};


struct EpiInProj {
    static constexpr bool PERM = true, AFTER_DRAIN = false;
    bf16_t *PB, *QF, *KF, *VF;
    __device__ __forceinline__ void operator()(const f32x4 (&acc)[2][2][4][2], const Unit& u, int wr, int wc, int fr, int fq) const {
        if (u.pn < 6) {
            const int sec = u.pn >> 1, cbase = (u.pn & 1) * 256 + wc * 32 + 8 * fq;
#pragma unroll
            for (int ai = 0; ai < 2; ++ai)
#pragma unroll
                for (int m = 0; m < 4; ++m) { const int T = u.pm * BM + ai * HALF + wr * 64 + m * 16 + fr;
                    int bb, blk; if (T < 32768) { bb = T >> 12; blk = (T & 4095) >> 5; } else { const int cc = T - 32768; bb = cc >> 8; blk = 128 + ((cc & 255) >> 5); }
                    const int tl = T & 31;
#pragma unroll
                    for (int bj = 0; bj < 2; ++bj) { const int c = cbase + HALF * bj; const f32x4 v0 = acc[ai][bj][m][0], v1 = acc[ai][bj][m][1];
                        u32x4 w; w.x = cvt_pk_bf16(v0[0], v0[1]); w.y = cvt_pk_bf16(v0[2], v0[3]); w.z = cvt_pk_bf16(v1[0], v1[1]); w.w = cvt_pk_bf16(v1[2], v1[3]);
                        if (sec == 0) *(u32x4*)(PB + (size_t)T * 512 + c) = w;
                        else { const int h = c >> 6, d0 = c & 63, fo = ((d0 >> 4) * 64 + ((d0 >> 3) & 1) * 32 + tl) * 8;
                            bf16_t* dst = (sec == 1) ? QF + (size_t)((bb * 8 + h) * 128 + blk) * 2048 + fo : KF + (size_t)((bb * 8 + h) * 136 + blk) * 2048 + fo;
                            *(u32x4*)dst = w; } } }
        } else {
            typedef unsigned u32x2 __attribute__((ext_vector_type(2)));
#pragma unroll
            for (int ai = 0; ai < 2; ++ai)
#pragma unroll
                for (int m = 0; m < 4; ++m) { const int vc = (u.pn - 6) * BM + ai * HALF + wr * 64 + m * 16 + fr, h = vc >> 6, dt = (vc >> 5) & 1, dl = vc & 31;
#pragma unroll
                    for (int bj = 0; bj < 2; ++bj) { const int T0 = u.pm * BM + bj * HALF + wc * 32 + 8 * fq;
                        int bb, blk; if (T0 < 32768) { bb = T0 >> 12; blk = (T0 & 4095) >> 5; } else { const int cc = T0 - 32768; bb = cc >> 8; blk = 128 + ((cc & 255) >> 5); }
                        bf16_t* base = VF + ((size_t)(((bb * 8 + h) * 136 + blk) * 2 + dt) * 2 + (fq >> 1)) * 512 + 4 * (fq & 1);
                        const f32x4 v0 = acc[ai][bj][m][0], v1 = acc[ai][bj][m][1];
                        u32x2 w0, w1; w0.x = cvt_pk_bf16(v0[0], v0[1]); w0.y = cvt_pk_bf16(v0[2], v0[3]); w1.x = cvt_pk_bf16(v1[0], v1[1]); w1.y = cvt_pk_bf16(v1[2], v1[3]);
                        *(u32x2*)(base + dl * 8) = w0; *(u32x2*)(base + (32 + dl) * 8) = w1; } }
        }
    }
};

struct EpiQP {
    static constexpr bool PERM = true, AFTER_DRAIN = false;
    bf16_t* QP;
    __device__ __forceinline__ void operator()(const f32x4 (&acc)[2][2][4][2], const Unit& u, int wr, int wc, int fr, int fq) const {
#pragma unroll
        for (int ai = 0; ai < 2; ++ai)
#pragma unroll
            for (int m = 0; m < 4; ++m) { const int T = u.pm * BM + ai * HALF + wr * 64 + m * 16 + fr;
#pragma unroll
                for (int bj = 0; bj < 2; ++bj) { const int hp = 2 * u.pn + bj, ks = 2 * wc + (fq >> 1), hh = fq & 1;
                    const f32x4 v0 = acc[ai][bj][m][0], v1 = acc[ai][bj][m][1];
                    u32x4 w; w.x = cvt_pk_bf16(v0[0], v0[1]); w.y = cvt_pk_bf16(v0[2], v0[3]); w.z = cvt_pk_bf16(v1[0], v1[1]); w.w = cvt_pk_bf16(v1[2], v1[3]);
                    *(u32x4*)(QP + ((size_t)(T >> 5) * 16 + hp) * 4096 + (ks * 64 + hh * 32 + (T & 31)) * 8) = w; } }
    }
};
template <class Epi, class Sched, bool ALIGN_EPI = false, bool SP2 = false>
__device__ __forceinline__ void gemm_phase(PG8_LAS unsigned char* lds, const Gemm g, const Sched& S, const Epi& E) {
    const int tid = threadIdx.x, wid = __builtin_amdgcn_readfirstlane(tid >> 6), lane = tid & 63, wr = wid >> 2, wc = wid & 3, fr = lane & 15, fq = lane >> 4;
    const int K = g.K, nt = K / BK;
    unsigned voffA[2], voffB[2];
#pragma unroll
    for (int i = 0; i < 2; ++i) { int R, C; stage_rc(tid * 16 + i * 8192, R, C); const int Rb = Epi::PERM ? ((R & ~31) + perm32(R & 31)) : R;
        voffA[i] = (unsigned)(R * K + C) * 2u; voffB[i] = (unsigned)(Rb * K + C) * 2u; }
    const size_t kstep = (size_t)(BK * 2);
    const size_t hstep = (size_t)HALF * K * 2;
    const size_t tstep = 2 * hstep;
    const unsigned ldsw = (unsigned)wid * 1024u;
    const int aoff = lds_byte(wr * 64 + fr, fq * 8), boff = lds_byte(wc * 32 + fr, fq * 8);
#define PG8_SA(b, h) (((b) * 2 + (h)) * HTB)
#define PG8_SB(b, h) ((4 + (b) * 2 + (h)) * HTB)
#define PG8_STAGE(bufoff, gbase, voff) do { _Pragma("unroll") for (int _i = 0; _i < 2; ++_i) \
        __builtin_amdgcn_global_load_lds((const unsigned*)((const char*)(gbase) + (voff)[_i]), (PG8_LAS unsigned*)(lds + (bufoff) + ldsw + _i * 8192), 16, 0, 0); } while (0)
#define PG8_LDA(dst, b, h) do { _Pragma("unroll") for (int m = 0; m < 4; ++m) _Pragma("unroll") for (int k = 0; k < 2; ++k) dst[m][k] = *(const PG8_LAS bf16x8*)(lds + PG8_SA(b, h) + aoff + m * 2048 + k * 1024); } while (0)
#define PG8_LDB(dst, b, h) do { _Pragma("unroll") for (int n = 0; n < 2; ++n) _Pragma("unroll") for (int k = 0; k < 2; ++k) dst[n][k] = *(const PG8_LAS bf16x8*)(lds + PG8_SB(b, h) + boff + n * 2048 + k * 1024); } while (0)
#define PG8_MMA(ai, bj, At, Bt) do { __builtin_amdgcn_s_setprio(1); _Pragma("unroll") for (int m = 0; m < 4; ++m) _Pragma("unroll") for (int n = 0; n < 2; ++n) _Pragma("unroll") for (int k = 0; k < 2; ++k) \
        acc[ai][bj][m][n] = __builtin_amdgcn_mfma_f32_16x16x32_bf16(Bt[n][k], At[m][k], acc[ai][bj][m][n], 0, 0, 0); __builtin_amdgcn_s_setprio(0); } while (0)
#define PG8_WAIT_V(n) asm volatile("s_waitcnt vmcnt(" #n ")" ::: "memory")
#define PG8_WAIT_L(n) asm volatile("s_waitcnt lgkmcnt(" #n ")" ::: "memory")
#define PG8_BAR __builtin_amdgcn_s_barrier()
#define PG8_SCHED __builtin_amdgcn_sched_barrier(0)
    Unit cur, nxt; int ui = 0;
    if (!S.next(0, cur)) return;
    f32x4 acc[2][2][4][2];
#pragma unroll
    for (int a = 0; a < 2; ++a)
#pragma unroll
        for (int b = 0; b < 2; ++b)
#pragma unroll
            for (int m = 0; m < 4; ++m)
#pragma unroll
                for (int n = 0; n < 2; ++n) acc[a][b][m][n] = (f32x4){0.f, 0.f, 0.f, 0.f};
    bf16x8 At[4][2], B0[2][2], B1[2][2];
    const char* cA = S.pa(g, cur); const char* cB = S.pb(g, cur);
    S.a_ready(cur);
    if constexpr (SP2) {
        PG8_STAGE(PG8_SB(0, 0), cB, voffB); PG8_STAGE(PG8_SB(0, 1), cB + hstep, voffB); PG8_STAGE(PG8_SA(0, 0), cA, voffA); PG8_STAGE(PG8_SA(0, 1), cA + hstep, voffA);
        if (wr == 1) PG8_BAR;
        PG8_WAIT_V(2); PG8_BAR;
        PG8_STAGE(PG8_SB(1, 0), cB + kstep, voffB); PG8_STAGE(PG8_SA(1, 0), cA + kstep, voffA); PG8_STAGE(PG8_SB(1, 1), cB + hstep + kstep, voffB);
        PG8_WAIT_V(6); PG8_BAR;
    } else {
        PG8_STAGE(PG8_SB(0, 0), cB, voffB); PG8_STAGE(PG8_SA(0, 0), cA, voffA); PG8_STAGE(PG8_SB(0, 1), cB + hstep, voffB); PG8_STAGE(PG8_SA(0, 1), cA + hstep, voffA);
        if (wr == 1) PG8_BAR;
        PG8_WAIT_V(4); PG8_BAR;
        PG8_STAGE(PG8_SB(1, 0), cB + kstep, voffB); PG8_STAGE(PG8_SA(1, 0), cA + kstep, voffA); PG8_STAGE(PG8_SB(1, 1), cB + hstep + kstep, voffB);
        PG8_WAIT_V(6); PG8_BAR;
    }
    for (;;) {
        const bool has_next = S.next(ui + 1, nxt);
        const char* nA = has_next ? S.pa(g, nxt) : cA; const char* nB = has_next ? S.pb(g, nxt) : cB;
        for (int t = 0; t < nt; t += 2) {
            const bool last = (t == nt - 2);
            const char* a1 = cA + (size_t)(t + 1) * kstep;
            const char* a2 = last ? nA : cA + (size_t)(t + 2) * kstep; const char* b2 = last ? nB : cB + (size_t)(t + 2) * kstep;
            const char* a3 = a2 + kstep; const char* b3 = b2 + kstep;
            if (last && has_next) S.a_ready(nxt);
            if constexpr (SP2) {
            PG8_LDB(B0, 0, 0); PG8_LDB(B1, 0, 1); PG8_SCHED; PG8_LDA(At, 0, 0); PG8_STAGE(PG8_SA(1, 1), a1 + hstep, voffA);
            PG8_WAIT_V(8); PG8_WAIT_L(0); PG8_BAR; PG8_MMA(0, 0, At, B0); PG8_MMA(0, 1, At, B1); PG8_BAR; PG8_SCHED;
            PG8_LDA(At, 0, 1); PG8_STAGE(PG8_SB(0, 0), b2, voffB); PG8_STAGE(PG8_SB(0, 1), b2 + hstep, voffB); PG8_STAGE(PG8_SA(0, 0), a2, voffA);
            PG8_WAIT_V(8); PG8_WAIT_L(0); PG8_BAR; PG8_MMA(1, 0, At, B0); PG8_MMA(1, 1, At, B1); PG8_BAR; PG8_SCHED;
            PG8_LDB(B0, 1, 0); PG8_LDB(B1, 1, 1); PG8_SCHED; PG8_LDA(At, 1, 0); PG8_STAGE(PG8_SA(0, 1), a2 + hstep, voffA);
            PG8_WAIT_V(8); PG8_WAIT_L(0); PG8_BAR; PG8_MMA(0, 0, At, B0); PG8_MMA(0, 1, At, B1); PG8_BAR; PG8_SCHED;
            PG8_LDA(At, 1, 1); PG8_STAGE(PG8_SB(1, 0), b3, voffB); PG8_STAGE(PG8_SB(1, 1), b3 + hstep, voffB); PG8_STAGE(PG8_SA(1, 0), a3, voffA);
            PG8_WAIT_V(8); PG8_WAIT_L(0); PG8_BAR; PG8_MMA(1, 0, At, B0); PG8_MMA(1, 1, At, B1); PG8_BAR; PG8_SCHED;
            } else {
            PG8_LDB(B0, 0, 0); PG8_SCHED; PG8_LDA(At, 0, 0); PG8_STAGE(PG8_SA(1, 1), a1 + hstep, voffA);
            PG8_WAIT_L(8); PG8_BAR; PG8_WAIT_L(0); PG8_MMA(0, 0, At, B0); PG8_BAR; PG8_SCHED;
            PG8_LDB(B1, 0, 1); PG8_STAGE(PG8_SB(0, 0), b2, voffB);
            PG8_BAR; PG8_WAIT_L(0); PG8_MMA(0, 1, At, B1); PG8_BAR;
            PG8_LDA(At, 0, 1); PG8_STAGE(PG8_SA(0, 0), a2, voffA);
            PG8_BAR; PG8_WAIT_L(0); PG8_MMA(1, 0, At, B0); PG8_BAR; PG8_SCHED;
            PG8_STAGE(PG8_SB(0, 1), b2 + hstep, voffB);
            PG8_WAIT_V(6); PG8_BAR; PG8_MMA(1, 1, At, B1); PG8_BAR;
            PG8_LDB(B0, 1, 0); PG8_SCHED; PG8_LDA(At, 1, 0); PG8_STAGE(PG8_SA(0, 1), a2 + hstep, voffA);
            PG8_WAIT_L(8); PG8_BAR; PG8_WAIT_L(0); PG8_MMA(0, 0, At, B0); PG8_BAR; PG8_SCHED;
            PG8_LDB(B1, 1, 1); PG8_STAGE(PG8_SB(1, 0), b3, voffB);
            PG8_BAR; PG8_WAIT_L(0); PG8_MMA(0, 1, At, B1); PG8_BAR;
            PG8_LDA(At, 1, 1); PG8_STAGE(PG8_SA(1, 0), a3, voffA);
            PG8_BAR; PG8_WAIT_L(0); PG8_MMA(1, 0, At, B0); PG8_BAR; PG8_SCHED;
            PG8_STAGE(PG8_SB(1, 1), b3 + hstep, voffB);
            PG8_WAIT_V(6); PG8_BAR; PG8_MMA(1, 1, At, B1); PG8_BAR;
            }
        }
        if constexpr (ALIGN_EPI) { if (wr == 0) PG8_BAR; }
        if constexpr (!Epi::AFTER_DRAIN) { E(acc, cur, wr, wc, fr, fq); S.done(cur); }
        if (!has_next) break;
#pragma unroll
        for (int a = 0; a < 2; ++a)
#pragma unroll
            for (int b = 0; b < 2; ++b)
#pragma unroll
                for (int m = 0; m < 4; ++m)
#pragma unroll
                    for (int n = 0; n < 2; ++n) acc[a][b][m][n] = (f32x4){0.f, 0.f, 0.f, 0.f};
        cur = nxt; cA = nA; cB = nB; ++ui;
        if constexpr (ALIGN_EPI) { if (wr == 1) PG8_BAR; }
    }
    PG8_WAIT_V(0);
    if constexpr (!ALIGN_EPI) { if (wr == 0) PG8_BAR; }
    PG8_BAR;
    if constexpr (Epi::AFTER_DRAIN) { E.fused(acc, cur, wr, wc, fr, fq, lds, wid, lane); S.done(cur); }
#undef PG8_SA
#undef PG8_SB
#undef PG8_STAGE
#undef PG8_LDA
#undef PG8_LDB
#undef PG8_MMA
#undef PG8_WAIT_V
#undef PG8_WAIT_L
#undef PG8_BAR
#undef PG8_SCHED
}
}

constexpr int DM = 1024, NBATCH = 8, SEQ = 4096, NTOK = NBATCH * SEQ, CTXL = 256, NCTX = NBATCH * CTXL, MROWS = NTOK + NCTX;
constexpr int DIN = 2048, NHEAD = 8, HD = 64, GRIDW = 64, NMOD = 6 * DM;
constexpr int NEXP = 16384;
constexpr float EPS = 1e-6f;
constexpr int NWAVES = 8;
constexpr int NPHASE = 8;
constexpr float U_SCALE = 64.f, V_SCALE = 4.f;

#ifndef FAKE_MASK
#define FAKE_MASK 7
#endif
#ifndef MK_N_LAUNCHES
#define MK_N_LAUNCHES 1
#endif
constexpr int N_LAUNCHES = MK_N_LAUNCHES;

constexpr size_t MiB = 1u << 20;
constexpr size_t WS_CTL = 0, CTL_ZERO_BYTES = 64 * 1024;
constexpr size_t WS_WIN = 2 * MiB, WS_WOUT = 6 * MiB, WS_WQ = 8 * MiB, WS_KEYS = 12 * MiB, WS_POOLW = 12 * MiB + 512 * 1024, WS_MOD = 13 * MiB;
constexpr size_t WS_SU = 13 * MiB + 512 * 1024;
constexpr size_t WS_U = 14 * MiB, WS_V = 46 * MiB;
constexpr size_t WS_HX = 78 * MiB;
constexpr size_t WS_ZX = 146 * MiB;
constexpr size_t WS_PB = 146 * MiB, WS_QF = 178 * MiB, WS_KF = 210 * MiB, WS_VF = 244 * MiB;
constexpr size_t WS_MIX = 282 * MiB;
constexpr size_t WS_EXP = 346 * MiB, WS_GATE = 362 * MiB;
constexpr size_t WS_X1 = 378 * MiB;
constexpr size_t WS_END = 442 * MiB;
constexpr int CW_BAR = 4096;

constexpr int RING_OFF = 0, RING_BYTES = 131072;
constexpr int LDSCTL_OFF = RING_BYTES, MISC_OFF = LDSCTL_OFF + 320;
constexpr int LDS_BYTES = 147456;

#define GAS __attribute__((address_space(1)))
#define LAS __attribute__((address_space(3)))
#define DI __device__ __forceinline__
typedef unsigned short bf16;
typedef unsigned v4u __attribute__((ext_vector_type(4)));
typedef unsigned v2u __attribute__((ext_vector_type(2)));
typedef float f32x4 __attribute__((ext_vector_type(4)));
typedef float f32x2 __attribute__((ext_vector_type(2)));
typedef GAS unsigned gu32;
#define RLX_AGENT __ATOMIC_RELAXED, __HIP_MEMORY_SCOPE_AGENT
#define LDS_WAIT() asm volatile("s_waitcnt lgkmcnt(0)" ::: "memory")
#define VM_WAIT() asm volatile("s_waitcnt vmcnt(0)" ::: "memory")
DI unsigned f2bf(float f) { unsigned u = __builtin_bit_cast(unsigned, f); return (u + 0x7fffu + ((u >> 16) & 1u)) >> 16; }
DI unsigned pk2(float lo, float hi) { return f2bf(lo) | (f2bf(hi) << 16); }
DI float bflo(unsigned u) { return __uint_as_float(u << 16); }
DI float bfhi(unsigned u) { return __uint_as_float(u & 0xffff0000u); }
DI float wave_sum(float v) {
#pragma unroll
    for (int o = 1; o < 64; o <<= 1) v += __shfl_xor(v, o);
    return v;
}

#define XB_TMO      128
#define XB_XCNT(j)  (256  + 64 * (j))
#define XB_XSUB(j)  (1280 + 64 * (j))
#define XB_XGEN(j)  (2304 + 64 * (j))
#define XB_TOP      3328
#define XB_TOPGEN   3392
#define XCD_BAR_WORDS 3456
#define XB_SPIN_CAP (1u << 18)

__device__ __forceinline__ unsigned xb_ld(unsigned* p)              { return __hip_atomic_load(p, __ATOMIC_RELAXED, __HIP_MEMORY_SCOPE_AGENT); }
__device__ __forceinline__ unsigned xb_add(unsigned* p, unsigned v) { return __hip_atomic_fetch_add(p, v, __ATOMIC_RELAXED, __HIP_MEMORY_SCOPE_AGENT); }
__device__ __forceinline__ unsigned xb_xcc_id() { return (unsigned)__builtin_amdgcn_s_getreg((3 << 11) | 20) & 0xFu; }
#define XB_SPIN(cond, bar) do { unsigned _sp = 0; while (cond) { __builtin_amdgcn_s_sleep(1); \
    if ((++_sp & 255u) == 0u) { if (xb_ld(&(bar)[XB_TMO])) break; if (_sp > XB_SPIN_CAP) { atomicAdd(&(bar)[XB_TMO], 1u); break; } } } } while (0)

struct XcdBarrier {
    unsigned* bar; unsigned x;
    volatile LAS unsigned* st;
};

__device__ __forceinline__ XcdBarrier xcd_barrier_post(unsigned* bar, volatile LAS unsigned* st) {
    XcdBarrier b; b.bar = bar; b.x = xb_xcc_id(); b.st = st;
    if (threadIdx.x == 0) (void)xb_add(&bar[XB_XCNT(b.x)], 1u);
    return b;
}
__device__ __forceinline__ void xcd_barrier_complete(unsigned* bar, unsigned x, unsigned& nloc, unsigned& nx) {
    const unsigned G = gridDim.x * gridDim.y * gridDim.z;
    unsigned sum, cnt, mine, sp = 0u;
    for (;;) {
        sum = 0u; cnt = 0u; mine = 0u;
#pragma unroll
        for (unsigned j = 0; j < 16; ++j) { const unsigned c = xb_ld(&bar[XB_XCNT(j)]); sum += c; cnt += (c > 0u) ? 1u : 0u; mine = (j == x) ? c : mine; }
        if (sum == G) break;
        __builtin_amdgcn_s_sleep(1);
        if ((++sp & 255u) == 0u) { if (xb_ld(&bar[XB_TMO])) break; if (sp > XB_SPIN_CAP) { atomicAdd(&bar[XB_TMO], 1u); break; } }
    }
    nloc = mine > 0u ? mine : 1u; nx = cnt > 0u ? cnt : 1u;
}

__device__ __forceinline__ void xcd_barrier(const XcdBarrier& b) {
    asm volatile("s_waitcnt vmcnt(0)" ::: "memory");
    __syncthreads();
    if (threadIdx.x == 0) {
        unsigned* bar = b.bar;
        __builtin_amdgcn_s_waitcnt(0);
        unsigned nloc = b.st[0], nx = b.st[1];
        if (nloc == 0u) { xcd_barrier_complete(bar, b.x, nloc, nx); b.st[0] = nloc; b.st[1] = nx; }
        const unsigned old = xb_add(&bar[XB_XSUB(b.x)], 1u);
        const unsigned gen = old / nloc;
        if (old + 1u == (gen + 1u) * nloc) {
            __builtin_amdgcn_fence(__ATOMIC_RELEASE, "agent");
            asm volatile("s_waitcnt vmcnt(0)" ::: "memory");
            const unsigned og = xb_add(&bar[XB_TOP], 1u);
            const unsigned tg = og / nx;
            if (og + 1u == (tg + 1u) * nx) xb_add(&bar[XB_TOPGEN], 1u);
            else XB_SPIN(xb_ld(&bar[XB_TOPGEN]) == tg, bar);
            __builtin_amdgcn_fence(__ATOMIC_ACQUIRE, "agent");
            xb_add(&bar[XB_XGEN(b.x)], 1u);
            asm volatile("s_waitcnt vmcnt(0)" ::: "memory");
        } else {
            XB_SPIN(xb_ld(&bar[XB_XGEN(b.x)]) == gen, bar);
            __builtin_amdgcn_fence(__ATOMIC_ACQUIRE, "agent");
            asm volatile("s_waitcnt vmcnt(0)" ::: "memory");
        }
    }
    __syncthreads();
}


__device__ __forceinline__ void p0_transpose_item(const float* W, int K, int N, bf16* WT, int row_off, LAS float* scr, int item, int lane) {
    const int nblk = N / 32, kb = item / nblk, nb = item % nblk, k0 = 64 * kb, n0 = 32 * nb;
#pragma unroll 8
    for (int i = 0; i < 32; ++i) { const int kk = 2 * i + (lane >> 5); scr[kk * 33 + (lane & 31)] = W[(size_t)(k0 + kk) * N + n0 + (lane & 31)]; }
    LDS_WAIT(); asm volatile("" ::: "memory");
    const int c = lane & 7;
#pragma unroll
    for (int j = 0; j < 4; ++j) { const int n = (lane >> 3) + 8 * j; const LAS float* s = scr + (8 * c) * 33 + n;
        v4u o; o.x = pk2(s[0 * 33], s[1 * 33]); o.y = pk2(s[2 * 33], s[3 * 33]); o.z = pk2(s[4 * 33], s[5 * 33]); o.w = pk2(s[6 * 33], s[7 * 33]);
        *(GAS v4u*)(WT + (size_t)(row_off + n0 + n) * K + k0 + 8 * c) = o; }
    LDS_WAIT(); asm volatile("" ::: "memory");
}


struct Frame {
    LAS unsigned char* lds;
    int tid, lane, wave, vcu, G, gw, NGW;
    const float* in[18]; float* out; unsigned char* ws;
};

DI void p0_prologue(Frame& F) {
    const float* c = F.in[1]; const float* c_ctx = F.in[3]; const float* ada_w = F.in[4]; const float* ada_b = F.in[5];
    float* MOD = (float*)(F.ws + WS_MOD);
    LAS float* sl = (LAS float*)(F.lds + 73728);
    for (int i = F.tid; i < 9 * 1024; i += 512) { const int b = i >> 10, k = i & 1023; const float cv = (b < 8) ? c[b * 1024 + k] : c_ctx[k]; sl[i] = cv / (1.f + __expf(-cv)); }
    __syncthreads();
    { LAS float* part = (LAS float*)(F.lds + 110592);
      for (int cg = F.vcu; cg < NMOD / 24; cg += F.G) {
          const int c = F.lane % 24, sub = F.lane / 24, n = cg * 24 + c, k0 = F.wave * 128 + sub * 64;
          float acc[9];
#pragma unroll
          for (int b = 0; b < 9; ++b) acc[b] = 0.f;
          if (sub < 2) { const float* wp = ada_w + (size_t)k0 * NMOD + n; const LAS float* sp = sl + k0;
#pragma unroll 16
              for (int i = 0; i < 64; ++i) { const float w = wp[(size_t)i * NMOD];
#pragma unroll
                  for (int b = 0; b < 9; ++b) acc[b] += sp[b * 1024 + i] * w; } }
#pragma unroll
          for (int b = 0; b < 9; ++b) { const float o = __shfl(acc[b], (F.lane + 24) & 63); if (F.lane < 24) part[(F.wave * 9 + b) * 24 + c] = acc[b] + o; }
          __syncthreads();
          if (F.tid < 216) { const int b = F.tid / 24, cc = F.tid % 24; float t = ada_b[cg * 24 + cc];
#pragma unroll
              for (int w = 0; w < 8; ++w) t += part[(w * 9 + b) * 24 + cc];
              MOD[b * NMOD + cg * 24 + cc] = t; }
          __syncthreads();
      } }
    LAS float* scr = (LAS float*)(F.lds + F.wave * 9216);
    constexpr int I_IN = (DM / 64) * (DIN / 32), I_OUT = (DM / 64) * (DM / 32), I_Q = (DM / 64) * (2048 / 32), I_P = 4 * 8;
    for (int it = F.gw; it < I_IN + I_OUT + I_Q + I_P; it += F.NGW) {
        int r = it;
        if (r < I_IN) { p0_transpose_item(F.in[7], DM, DIN, (bf16*)(F.ws + WS_WIN), 0, scr, r, F.lane); continue; } r -= I_IN;
        if (r < I_OUT) { p0_transpose_item(F.in[11], DM, DM, (bf16*)(F.ws + WS_WOUT), 0, scr, r, F.lane); continue; } r -= I_OUT;
        if (r < I_Q) { p0_transpose_item(F.in[13], DM, 2048, (bf16*)(F.ws + WS_WQ), 0, scr, r, F.lane); continue; } r -= I_Q;
        { const int g = r >> 3; p0_transpose_item(F.in[8] + g * 16384, 128, 128, (bf16*)(F.ws + WS_POOLW) + g * 16384, 0, scr, r & 7, F.lane); }
    }
    { const float* kf = F.in[14]; bf16* kb = (bf16*)(F.ws + WS_KEYS);
      for (int it = F.gw; it < 16 * 32; it += F.NGW) { const int hp = it >> 5, nt = (it >> 3) & 3, ks = it & 7;
          const float* src = kf + ((size_t)hp * 128 + 32 * nt + (F.lane & 31)) * 128 + 16 * ks + 8 * (F.lane >> 5);
          const f32x4 a = *(const f32x4*)(src), b = *(const f32x4*)(src + 4);
          v4u w; w.x = pk2(a.x, a.y); w.y = pk2(a.z, a.w); w.z = pk2(b.x, b.y); w.w = pk2(b.z, b.w); *(v4u*)(kb + ((size_t)it * 64 + F.lane) * 8) = w; } }
    for (int it = F.gw; it < 2 * NEXP; it += F.NGW) {
        const bool isu = it < NEXP;
        const float* src = isu ? F.in[15] + (size_t)it * 1024 : F.in[16] + (size_t)(it - NEXP) * 1024;
        unsigned* dst = (unsigned*)(isu ? F.ws + WS_U + (size_t)it * 1024 : F.ws + WS_V + (size_t)(it - NEXP) * 1024) + F.lane;
        const f32x4* sp = (const f32x4*)src + F.lane;
        f32x4 a[4];
#pragma unroll
        for (int j = 0; j < 4; ++j) a[j] = sp[64 * j];
        if (isu) {
            float am = 0.f;
#pragma unroll
            for (int j = 0; j < 4; ++j) am = fmaxf(fmaxf(am, fmaxf(fabsf(a[j].x), fabsf(a[j].y))), fmaxf(fabsf(a[j].z), fabsf(a[j].w)));
#pragma unroll
            for (int o = 1; o < 64; o <<= 1) am = fmaxf(am, __shfl_xor(am, o));
            am = fmaxf(am, 1e-30f);
            const float inv = 127.0f / am;
#pragma unroll
            for (int j = 0; j < 4; ++j) { const int q0 = (int)rintf(a[j].x * inv), q1 = (int)rintf(a[j].y * inv), q2 = (int)rintf(a[j].z * inv), q3 = (int)rintf(a[j].w * inv);
                dst[64 * j] = (unsigned)(q0 & 255) | ((unsigned)(q1 & 255) << 8) | ((unsigned)(q2 & 255) << 16) | ((unsigned)(q3 & 255) << 24); }
            if (F.lane == 0) ((float*)(F.ws + WS_SU))[it] = am * (1.0f / 127.0f);
        } else {
#pragma unroll
            for (int j = 0; j < 4; ++j) { const f32x4 sv = a[j] * V_SCALE; int pk = 0; pk = __builtin_amdgcn_cvt_pk_fp8_f32(sv.x, sv.y, pk, false); pk = __builtin_amdgcn_cvt_pk_fp8_f32(sv.z, sv.w, pk, true); dst[64 * j] = (unsigned)pk; }
        }
    }
}

template <bool SRC_BF16> DI void norm_rows(Frame& F, const float* src_x, const float* src_ctx, int nrows, const float* gain, int shift_off, int scale_off, bf16* dst) {
    const float* MOD = (const float*)(F.ws + WS_MOD);
    const int per = (nrows + F.NGW - 1) / F.NGW, m_lo = F.gw * per, m_hi = min(m_lo + per, nrows);
    f32x4 gs[4], shv[4]; int cb = -1;
    for (int m = m_lo; m < m_hi; ++m) {
        const float* xrow; int b;
        if (m < NTOK) { xrow = src_x + (size_t)m * DM; b = m >> 12; } else { xrow = src_ctx + (size_t)(m - NTOK) * DM; b = 8; }
        f32x4 v[4]; float s = 0.f;
        if (SRC_BF16) { const v2u* xr = (const v2u*)((const bf16*)src_x + (size_t)m * DM) + F.lane;
#pragma unroll
            for (int j = 0; j < 4; ++j) { const v2u w = xr[64 * j]; v[j] = (f32x4){bflo(w.x), bfhi(w.x), bflo(w.y), bfhi(w.y)}; }
        } else { const f32x4* xr = (const f32x4*)xrow + F.lane;
#pragma unroll
            for (int j = 0; j < 4; ++j) v[j] = xr[64 * j]; }
        if (b != cb) { cb = b;
            const f32x4* gp = (const f32x4*)gain + F.lane; const f32x4* shp = (const f32x4*)(MOD + b * NMOD + shift_off) + F.lane; const f32x4* scp = (const f32x4*)(MOD + b * NMOD + scale_off) + F.lane;
#pragma unroll
            for (int j = 0; j < 4; ++j) { gs[j] = gp[64 * j] * (scp[64 * j] + 1.0f); shv[j] = shp[64 * j]; } }
#pragma unroll
        for (int j = 0; j < 4; ++j) s += (v[j].x * v[j].x + v[j].y * v[j].y) + (v[j].z * v[j].z + v[j].w * v[j].w);
        const float rinv = 1.0f / sqrtf(wave_sum(s) * (1.f / DM) + EPS);
        unsigned long long* o8 = (unsigned long long*)(dst + (size_t)m * DM) + F.lane;
#pragma unroll
        for (int j = 0; j < 4; ++j) { const f32x4 y = (v[j] * rinv) * gs[j] + shv[j];
            o8[64 * j] = (unsigned long long)pk2(y.x, y.y) | ((unsigned long long)pk2(y.z, y.w) << 32); }
    }
}

typedef float f32x16 __attribute__((ext_vector_type(16)));
typedef short s16x8 __attribute__((ext_vector_type(8)));
typedef __bf16 bf16x2_t __attribute__((ext_vector_type(2)));
#define MFMA32(a, b, c) __builtin_amdgcn_mfma_f32_32x32x16_bf16((a), (b), (c), 0, 0, 0)
DI unsigned cvtpk(float lo, float hi) { f32x2 v = {lo, hi}; bf16x2_t bb = __builtin_convertvector(v, bf16x2_t); return __builtin_bit_cast(unsigned, bb); }
DI float pairmax(float v) { auto rr = __builtin_amdgcn_permlane32_swap(__float_as_uint(v), __float_as_uint(v), false, false); return fmaxf(__uint_as_float(rr[0]), __uint_as_float(rr[1])); }
constexpr float LOG2E = 1.4426950408889634f, ATT_C2 = 0.125f * LOG2E, ATT_THR = 6.0f;
template <int QMASK, bool LOCAL>
DI void attn_tile(const s16x8 (&kf)[4], const s16x8 (&vf)[4], const LAS s16x8* qfp, f32x16 (&o)[2], float& m, float& l, const LAS float* brow, int djb, int lo) {
    f32x16 s; s16x8 qf[4];
#pragma unroll
    for (int ks = 0; ks < 4; ++ks) qf[ks] = qfp[ks * 64];
#pragma unroll
    for (int i = 0; i < 16; ++i) s[i] = 0.f;
#pragma unroll
    for (int ks = 0; ks < 4; ++ks) s = MFMA32(kf[ks], qf[ks], s);
    float sv[16]; float tmax = -INFINITY;
#pragma unroll
    for (int i = 0; i < 16; ++i) {
        if (!((QMASK >> (i >> 2)) & 1)) { sv[i] = -INFINITY; continue; }
        if (LOCAL) { const int dj = djb + (i & 3) + 8 * (i >> 2); const bool valid = (unsigned)(dj - lo) < 16u;
            const float x = s[i] * ATT_C2 + brow[valid ? dj : 0]; sv[i] = valid ? x : -INFINITY; }
        else sv[i] = s[i] * ATT_C2;
        tmax = fmaxf(tmax, sv[i]);
    }
    tmax = pairmax(tmax);
    if (__any(tmax > m + ATT_THR)) { const float mn = fmaxf(m, tmax), alpha = __builtin_amdgcn_exp2f(m - mn); o[0] *= alpha; o[1] *= alpha; l *= alpha; m = mn; }
    float p[16];
#pragma unroll
    for (int i = 0; i < 16; ++i) { if ((QMASK >> (i >> 2)) & 1) { p[i] = __builtin_amdgcn_exp2f(sv[i] - m); l += p[i]; } else p[i] = 0.f; }
#pragma unroll
    for (int s2 = 0; s2 < 2; ++s2) if (QMASK & (3 << (2 * s2))) {
        v4u pk; pk.x = cvtpk(p[8 * s2], p[8 * s2 + 1]); pk.y = cvtpk(p[8 * s2 + 2], p[8 * s2 + 3]); pk.z = cvtpk(p[8 * s2 + 4], p[8 * s2 + 5]); pk.w = cvtpk(p[8 * s2 + 6], p[8 * s2 + 7]);
        const s16x8 pf = __builtin_bit_cast(s16x8, pk);
        o[0] = MFMA32(vf[s2], pf, o[0]); o[1] = MFMA32(vf[2 + s2], pf, o[1]);
    }
}
DI void attn_mfma(Frame& F) {
    const bf16* QF = (const bf16*)(F.ws + WS_QF); const bf16* KF = (const bf16*)(F.ws + WS_KF); const bf16* VF = (const bf16*)(F.ws + WS_VF);
    bf16* MIX = (bf16*)(F.ws + WS_MIX); const float* rpb = F.in[10];
    LAS float* rp = (LAS float*)(F.lds);
    for (int i = F.tid; i < NHEAD * 15 * 31; i += 512) rp[i] = rpb[i] * LOG2E;
    __syncthreads();
    const int lane = F.lane, hh = lane >> 5, ql = lane & 31;
    int lo[2], djb[2][2];
#pragma unroll
    for (int qb = 0; qb < 2; ++qb) { const int qc = 32 * qb + ql, c0 = min(max(qc - 8, 0), 48); lo[qb] = c0 - qc + 15;
#pragma unroll
        for (int jb = 0; jb < 2; ++jb) djb[qb][jb] = 32 * (jb - qb) + 4 * hh - ql + 15; }
    for (int unit = F.gw; unit < NBATCH * NHEAD * 64; unit += F.NGW) {
        const int r = unit & 63, h = (unit >> 6) & 7, b = unit >> 9, bh = b * 8 + h;
        LAS s16x8* qfl = (LAS s16x8*)(F.lds + 16384 + F.wave * 8192) + lane;
#pragma unroll
        for (int qb = 0; qb < 2; ++qb)
#pragma unroll
            for (int ks = 0; ks < 4; ++ks) qfl[(qb * 4 + ks) * 64] = ((const s16x8*)(QF + (size_t)(bh * 128 + 2 * r + qb) * 2048))[ks * 64 + lane];
        f32x16 o[2][2]; float m[2], l[2];
#pragma unroll
        for (int qb = 0; qb < 2; ++qb) { m[qb] = -1e30f; l[qb] = 0.f;
#pragma unroll
            for (int dt = 0; dt < 2; ++dt)
#pragma unroll
                for (int i = 0; i < 16; ++i) o[qb][dt][i] = 0.f; }
        const int r0 = min(max(r - 4, 0), 56);
        s16x8 kf[4], vf[4], kn[4];
        { const s16x8* kp = (const s16x8*)(KF + (size_t)(bh * 136 + 128) * 2048) + lane;
#pragma unroll
          for (int j = 0; j < 4; ++j) kn[j] = kp[j * 64]; }
#pragma unroll 1
        for (int kb = 0; kb < 8; ++kb) {
            { const s16x8* vp = (const s16x8*)(VF + (size_t)(bh * 136 + 128 + kb) * 2048) + lane;
#pragma unroll
              for (int j = 0; j < 4; ++j) { kf[j] = kn[j]; vf[j] = vp[j * 64]; } }
            { const int nb = (kb < 7) ? bh * 136 + 128 + kb + 1 : bh * 136 + 2 * r0;
              const s16x8* kp = (const s16x8*)(KF + (size_t)nb * 2048) + lane;
#pragma unroll
              for (int j = 0; j < 4; ++j) kn[j] = kp[j * 64]; }
            attn_tile<15, false>(kf, vf, qfl, o[0], m[0], l[0], rp, 0, 0); __builtin_amdgcn_sched_barrier(0);
            attn_tile<15, false>(kf, vf, qfl + 256, o[1], m[1], l[1], rp, 0, 0); __builtin_amdgcn_sched_barrier(0);
        }
#pragma unroll 1
        for (int i = 0; i < 8; ++i) {
            const LAS float* brow = rp + (h * 15 + (r0 + i - r + 7)) * 31;
            { const s16x8* vp = (const s16x8*)(VF + (size_t)(bh * 136 + 2 * (r0 + i)) * 2048) + lane;
#pragma unroll
              for (int j = 0; j < 4; ++j) { kf[j] = kn[j]; vf[j] = vp[j * 64]; } }
            { const int nb = bh * 136 + 2 * (r0 + i) + 1;
              const s16x8* kp = (const s16x8*)(KF + (size_t)nb * 2048) + lane;
#pragma unroll
              for (int j = 0; j < 4; ++j) kn[j] = kp[j * 64]; }
            attn_tile<15, true>(kf, vf, qfl, o[0], m[0], l[0], brow, djb[0][0], lo[0]); __builtin_amdgcn_sched_barrier(0);
            attn_tile<8, true>(kf, vf, qfl + 256, o[1], m[1], l[1], brow, djb[1][0], lo[1]); __builtin_amdgcn_sched_barrier(0);
            { const s16x8* vp = (const s16x8*)(VF + (size_t)(bh * 136 + 2 * (r0 + i) + 1) * 2048) + lane;
#pragma unroll
              for (int j = 0; j < 4; ++j) { kf[j] = kn[j]; vf[j] = vp[j * 64]; } }
            { const int nb = bh * 136 + 2 * (r0 + ((i < 7) ? i + 1 : 0));
              const s16x8* kp = (const s16x8*)(KF + (size_t)nb * 2048) + lane;
#pragma unroll
              for (int j = 0; j < 4; ++j) kn[j] = kp[j * 64]; }
            attn_tile<1, true>(kf, vf, qfl, o[0], m[0], l[0], brow, djb[0][1], lo[0]); __builtin_amdgcn_sched_barrier(0);
            attn_tile<15, true>(kf, vf, qfl + 256, o[1], m[1], l[1], brow, djb[1][1], lo[1]); __builtin_amdgcn_sched_barrier(0);
        }
#pragma unroll
        for (int qb = 0; qb < 2; ++qb) {
            const float lt = l[qb] + __shfl_xor(l[qb], 32), inv = 1.0f / lt;
            bf16* orow = MIX + (size_t)(b * SEQ + r * GRIDW + 32 * qb + ql) * DM + 512 + h * 64 + 4 * hh;
#pragma unroll
            for (int dt = 0; dt < 2; ++dt)
#pragma unroll
                for (int g = 0; g < 4; ++g) { v2u w; w.x = pk2(o[qb][dt][4 * g] * inv, o[qb][dt][4 * g + 1] * inv); w.y = pk2(o[qb][dt][4 * g + 2] * inv, o[qb][dt][4 * g + 3] * inv);
                    *(v2u*)(orow + 32 * dt + 8 * g) = w; }
        }
    }
    __syncthreads();
}
DI void pool_mfma(Frame& F) {
    const bf16* PBF = (const bf16*)(F.ws + WS_PB); bf16* MIX = (bf16*)(F.ws + WS_MIX); const bf16* PW = (const bf16*)(F.ws + WS_POOLW); const float* pool_scale = F.in[9];
    constexpr int RS = 272;
    LAS unsigned char* ptile = F.lds + 32768;
    LAS unsigned char* atile = F.lds + 32768 + 144 * RS;
    const int lane = F.lane, hh = lane >> 5, ql = lane & 31;
    for (int tile = F.vcu; tile < NTOK / 128; tile += F.G) {
        const int tok0 = tile * 128, bstart = tok0 & ~(SEQ - 1);
#pragma unroll 1
        for (int g = 0; g < 4; ++g) {
            for (int it = F.tid; it < 144 * 16; it += 512) { const int rr = it >> 4, ch = it & 15, t = tok0 - 8 + rr;
                v4u v = (v4u){0u, 0u, 0u, 0u};
                if (t >= bstart && t < bstart + SEQ) v = *(const v4u*)(PBF + (size_t)t * 512 + g * 128 + ch * 8);
                *(LAS v4u*)(ptile + rr * RS + ch * 16) = v; }
            __syncthreads();
            { const int cp = F.tid & 63, sg = F.tid >> 6, w = 2 << g, hw = w >> 1;
              const LAS unsigned char* col = ptile + cp * 4;
              float s0 = 0.f, s1 = 0.f;
              const int tl0 = sg * 16;
              for (int rr = tl0 + 8 - hw; rr < tl0 + 8 + hw; ++rr) { const unsigned u = *(const LAS unsigned*)(col + rr * RS); s0 += bflo(u); s1 += bfhi(u); }
#pragma unroll 4
              for (int i = 0; i < 16; ++i) { const int tl = tl0 + i, sp = (tok0 + tl) & (SEQ - 1);
                  const int cnt = min(sp + hw, SEQ) - max(sp - hw, 0); const float inv = 1.0f / (float)cnt;
                  const unsigned self = *(const LAS unsigned*)(col + (tl + 8) * RS);
                  *(LAS unsigned*)(atile + tl * RS + cp * 4) = pk2(s0 * inv - bflo(self), s1 * inv - bfhi(self));
                  const unsigned un = *(const LAS unsigned*)(col + (tl + 8 + hw) * RS), uo = *(const LAS unsigned*)(col + (tl + 8 - hw) * RS);
                  s0 += bflo(un) - bflo(uo); s1 += bfhi(un) - bfhi(uo); } }
            __syncthreads();
            { const int tb = F.wave >> 1, dt0 = (F.wave & 1) * 2;
              f32x16 acc[2];
#pragma unroll
              for (int j = 0; j < 2; ++j)
#pragma unroll
                  for (int i = 0; i < 16; ++i) acc[j][i] = 0.f;
#pragma unroll
              for (int ks = 0; ks < 8; ++ks) {
                  const s16x8 bfr = *(const LAS s16x8*)(atile + (32 * tb + ql) * RS + (16 * ks + 8 * hh) * 2);
#pragma unroll
                  for (int j = 0; j < 2; ++j) { const s16x8 afr = *(const s16x8*)(PW + (size_t)g * 16384 + (32 * (dt0 + j) + ql) * 128 + 16 * ks + 8 * hh);
                      acc[j] = MFMA32(afr, bfr, acc[j]); } }
              bf16* orow = MIX + (size_t)(tok0 + 32 * tb + ql) * DM + g * 128 + 4 * hh;
#pragma unroll
              for (int j = 0; j < 2; ++j)
#pragma unroll
                  for (int q = 0; q < 4; ++q) { const int d = 32 * (dt0 + j) + 8 * q; const f32x4 sc = *(const f32x4*)(pool_scale + g * 128 + d + 4 * hh);
                      v2u wv; wv.x = pk2(acc[j][4 * q] * sc.x, acc[j][4 * q + 1] * sc.y); wv.y = pk2(acc[j][4 * q + 2] * sc.z, acc[j][4 * q + 3] * sc.w);
                      *(v2u*)(orow + d) = wv; } }
            __syncthreads();
        }
    }
}
DI int f2key(float f) { const int b = __float_as_int(f); return b ^ ((b >> 31) & 0x7fffffff); }
DI float key2f(int k) { return __int_as_float(k ^ ((k >> 31) & 0x7fffffff)); }
DI void ce_desc(int& x, int& y) { const int hi = max(x, y), lo = min(x, y); x = hi; y = lo; }
DI void sort16_desc(int (&a)[16]) {
#pragma unroll
    for (int k = 2; k <= 16; k <<= 1)
#pragma unroll
        for (int j = k >> 1; j > 0; j >>= 1)
#pragma unroll
            for (int i = 0; i < 16; ++i) { const int l = i ^ j; if (l > i) { if ((i & k) == 0) ce_desc(a[i], a[l]); else ce_desc(a[l], a[i]); } }
}
DI void merge16_desc(int (&a)[16], const int (&b)[16]) {
#pragma unroll
    for (int i = 0; i < 16; ++i) a[i] = max(a[i], b[15 - i]);
#pragma unroll
    for (int j = 8; j > 0; j >>= 1)
#pragma unroll
        for (int i = 0; i < 16; ++i) if ((i & j) == 0) ce_desc(a[i], a[i + j]);
}
DI void peer_topk_mfma(Frame& F, int tile) {
    const bf16* QP = (const bf16*)(F.ws + WS_ZX); const bf16* KEYF = (const bf16*)(F.ws + WS_KEYS);
    int* EXPERTS = (int*)(F.ws + WS_EXP); float* GATES = (float*)(F.ws + WS_GATE);
    const int lane = F.lane, hh = lane >> 5, ql = lane & 31, tb = F.wave >> 1, p = F.wave & 1;
    const int tokblk = tile * 4 + tb, tok = tokblk * 32 + ql;
#pragma unroll 1
    for (int h = 0; h < 8; ++h) {
        const int hp = 2 * h + p;
        s16x8 qf[8];
#pragma unroll
        for (int ks = 0; ks < 8; ++ks) qf[ks] = ((const s16x8*)(QP + ((size_t)tokblk * 16 + hp) * 4096))[ks * 64 + lane];
        const s16x8* kfp = (const s16x8*)(KEYF + (size_t)hp * 16384) + lane;
        int top[16];
#pragma unroll
        for (int i = 0; i < 16; ++i) top[i] = (int)0x80000000;
#pragma unroll 1
        for (int nt = 0; nt < 4; ++nt) {
            f32x16 acc;
#pragma unroll
            for (int i = 0; i < 16; ++i) acc[i] = 0.f;
#pragma unroll
            for (int ks = 0; ks < 8; ++ks) acc = MFMA32(kfp[(nt * 8 + ks) * 64], qf[ks], acc);
            int a[16];
#pragma unroll
            for (int i = 0; i < 16; ++i) { const int n = 32 * nt + (i & 3) + 8 * (i >> 2) + 4 * hh; a[i] = f2key(__int_as_float((__float_as_int(acc[i]) & ~127) | n)); }
            sort16_desc(a);
            merge16_desc(top, a);
        }
        { int oth[16];
#pragma unroll
          for (int i = 0; i < 16; ++i) oth[i] = __shfl_xor(top[i], 32);
          merge16_desc(top, oth); }
        LAS float* L = (LAS float*)(F.lds) + (h & 1) * 4096 + (tb * 2) * 512;
        if (hh == 0) {
#pragma unroll
            for (int i = 0; i < 16; ++i) L[p * 512 + i * 32 + ql] = key2f(top[i]);
        }
        __syncthreads();
        if (p == 0 && hh == 0) {
            float v0[16], v1[16];
#pragma unroll
            for (int i = 0; i < 16; ++i) { v0[i] = __int_as_float(__float_as_int(L[i * 32 + ql]) & ~127); v1[i] = __int_as_float(__float_as_int(L[512 + i * 32 + ql]) & ~127); }
            int grp[4][16]; int cnt = 0;
#pragma unroll
            for (int g = 0; g < 4; ++g)
#pragma unroll
                for (int i = 0; i < 16; ++i) grp[g][i] = (int)0x80000000;
#pragma unroll
            for (int i = 0; i < 16; ++i)
#pragma unroll
                for (int j = 0; j < 16; ++j) if ((i + 1) * (j + 1) <= 16) {
                    grp[cnt >> 4][cnt & 15] = f2key(__int_as_float((__float_as_int(v0[i] + v1[j]) & ~255) | (i * 16 + j))); ++cnt; }
#pragma unroll
            for (int g = 0; g < 4; ++g) sort16_desc(grp[g]);
            merge16_desc(grp[0], grp[1]); merge16_desc(grp[2], grp[3]); merge16_desc(grp[0], grp[2]);
            float tv[16]; float e[16]; float sum = 0.f; int eid[16];
#pragma unroll
            for (int k = 0; k < 16; ++k) { const int bits = __float_as_int(key2f(grp[0][k])); const int code = bits & 255; tv[k] = __int_as_float(bits & ~255);
                const int n0 = __float_as_int(L[(code >> 4) * 32 + ql]) & 127, n1 = __float_as_int(L[512 + (code & 15) * 32 + ql]) & 127; eid[k] = n0 * 128 + n1; }
#pragma unroll
            for (int k = 0; k < 16; ++k) { e[k] = __expf(tv[k] - tv[0]); sum += e[k]; }
            const float is = 1.0f / sum;
            int* ep = EXPERTS + (size_t)tok * 128 + h * 16; float* gp = GATES + (size_t)tok * 128 + h * 16;
#pragma unroll
            for (int k4 = 0; k4 < 4; ++k4) { *(v4u*)(ep + 4 * k4) = (v4u){(unsigned)eid[4 * k4], (unsigned)eid[4 * k4 + 1], (unsigned)eid[4 * k4 + 2], (unsigned)eid[4 * k4 + 3]};
                *(f32x4*)(gp + 4 * k4) = (f32x4){e[4 * k4] * is, e[4 * k4 + 1] * is, e[4 * k4 + 2] * is, e[4 * k4 + 3] * is}; }
        }
    }
    VM_WAIT(); __syncthreads();
}

DI float gelu_fast(float v) {
    const float av = fabsf(v), t = __builtin_amdgcn_rcpf(av * 0.2316418882f + 1.0f);
    float q = t * 0.5307027145f + (-0.7265760135f); q = q * t + 0.7107068705f; q = q * t + (-0.142248368f); q = q * t + 0.127414796f; q = q * t;
    const float e = __builtin_amdgcn_exp2f((v * v) * (-0.72134752044f));
    const float m = v * (q * e);
    return v < 0.f ? m : v - m;
}
DI float gelu_exact(float a) { return 0.5f * a * (1.0f + erff(a * 0.70710678118654752f)); }

DI void fp8x16_to_f32(const v4u r, float (&f)[16]) {
#pragma unroll
    for (int j = 0; j < 4; ++j) { const f32x2 lo = __builtin_amdgcn_cvt_pk_f32_fp8((int)r[j], false), hi = __builtin_amdgcn_cvt_pk_f32_fp8((int)r[j], true);
        f[4 * j] = lo.x; f[4 * j + 1] = lo.y; f[4 * j + 2] = hi.x; f[4 * j + 3] = hi.y; }
}
template <bool FAKE = false, bool UONLY = false> DI void gather_v4(Frame& F, int tbase) {
    constexpr int NT = 8, NK = 16, N = 1024;
    const bf16* H2 = (const bf16*)(F.ws + WS_HX); const unsigned char* U = F.ws + WS_U; const unsigned char* V = F.ws + WS_V;
    const int* EXPERTS = (const int*)(F.ws + WS_EXP); const float* GATES = (const float*)(F.ws + WS_GATE); const float* MOD = (const float*)(F.ws + WS_MOD);
    const float* SU = (const float*)(F.ws + WS_SU);
    const int lane = F.lane;
    constexpr int EM = FAKE ? FAKE_MASK : 16383;
    int key[NK];
#pragma unroll
    for (int j = 0; j < NT; ++j)
#pragma unroll
        for (int hf = 0; hf < 2; ++hf) { const int k = hf * 64 + lane; key[j * 2 + hf] = (EXPERTS[(size_t)(tbase + j) * 128 + k] << 10) | (j << 7) | k; }
#pragma unroll
    for (int k = 2; k <= N; k <<= 1)
#pragma unroll
        for (int j = k >> 1; j > 0; j >>= 1) {
            if (j < NK) {
#pragma unroll
                for (int r = 0; r < NK; ++r) if ((r & j) == 0) { const bool asc = (((lane * NK + r) & k) == 0); const int x = key[r], y = key[r | j], lo = min(x, y), hi = max(x, y);
                    key[r] = asc ? lo : hi; key[r | j] = asc ? hi : lo; }
            } else {
                const bool asc = (((lane * NK) & k) == 0), lower = ((lane & (j / NK)) == 0), takemin = (asc == lower);
#pragma unroll
                for (int r = 0; r < NK; ++r) { const int o = __shfl_xor(key[r], j / NK); key[r] = takemin ? min(key[r], o) : max(key[r], o); }
            }
        }
    LAS v4u* hL = (LAS v4u*)(F.lds) + F.wave * (NT * 64) + lane;
    LAS int* psL = (LAS int*)(F.lds + 65536) + F.wave * N;
    float hsc[NT];
    {
#pragma unroll
        for (int j = 0; j < NT; ++j) { const v4u a = *((const v4u*)(H2 + (size_t)(tbase + j) * DM + lane * 16)), b = *((const v4u*)(H2 + (size_t)(tbase + j) * DM + lane * 16 + 8));
            float hv[16]; hv[0] = bflo(a.x); hv[1] = bfhi(a.x); hv[2] = bflo(a.y); hv[3] = bfhi(a.y); hv[4] = bflo(a.z); hv[5] = bfhi(a.z); hv[6] = bflo(a.w); hv[7] = bfhi(a.w);
            hv[8] = bflo(b.x); hv[9] = bfhi(b.x); hv[10] = bflo(b.y); hv[11] = bfhi(b.y); hv[12] = bflo(b.z); hv[13] = bfhi(b.z); hv[14] = bflo(b.w); hv[15] = bfhi(b.w);
            float am = 0.f;
#pragma unroll
            for (int i = 0; i < 16; ++i) am = fmaxf(am, fabsf(hv[i]));
#pragma unroll
            for (int o = 1; o < 64; o <<= 1) am = fmaxf(am, __shfl_xor(am, o));
            am = fmaxf(am, 1e-30f); hsc[j] = am * (1.0f / 127.0f);
            const float inv = 127.0f / am;
            v4u hq;
#pragma unroll
            for (int d = 0; d < 4; ++d) { const int q0 = (int)rintf(hv[4 * d] * inv), q1 = (int)rintf(hv[4 * d + 1] * inv), q2 = (int)rintf(hv[4 * d + 2] * inv), q3 = (int)rintf(hv[4 * d + 3] * inv);
                hq[d] = (unsigned)(q0 & 255) | ((unsigned)(q1 & 255) << 8) | ((unsigned)(q2 & 255) << 16) | ((unsigned)(q3 & 255) << 24); }
            hL[j * 64] = hq; }
    }
#define V4_ROW(TBL, par, ln, r) (*((const v4u*)((TBL) + (size_t)((__builtin_amdgcn_readlane(key[(par) * 8 + (r)], (ln)) >> 10) & EM) * 1024) + lane))
    {   v4u ub[4][8];
#pragma unroll
        for (int q = 0; q < 4; ++q)
#pragma unroll
            for (int r = 0; r < 8; ++r) ub[q][r] = V4_ROW(U, q & 1, q >> 1, r);
#pragma unroll 1
        for (int b4 = 0; b4 < 32; ++b4) {
#pragma unroll
            for (int q = 0; q < 4; ++q) {
                const int par = q & 1, ln = 2 * b4 + (q >> 1), lnn = (ln + 2) & 63;
                int p[8]; v4u hsel[8];
#pragma unroll
                for (int r = 0; r < 8; ++r) { hsel[r] = hL[((__builtin_amdgcn_readlane(key[par * 8 + r], ln) >> 7) & 7) * 64]; p[r] = 0; }
#pragma unroll
                for (int qq = 0; qq < 4; ++qq)
#pragma unroll
                    for (int r = 0; r < 8; ++r) p[r] = __builtin_amdgcn_sdot4((int)ub[q][r][qq], (int)hsel[r][qq], p[r], false);
#pragma unroll
                for (int r = 0; r < 8; ++r) ub[q][r] = V4_ROW(U, par, lnn, r);
                int psum;
                { int q4[4];
#pragma unroll
                  for (int i = 0; i < 4; ++i) { auto rr = __builtin_amdgcn_permlane32_swap((unsigned)p[i], (unsigned)p[i + 4], false, false); q4[i] = (int)(rr[0] + rr[1]); }
                  int q2[2];
#pragma unroll
                  for (int i = 0; i < 2; ++i) { auto rr = __builtin_amdgcn_permlane16_swap((unsigned)q4[i], (unsigned)q4[i + 2], false, false); q2[i] = (int)(rr[0] + rr[1]); }
                  const int t0 = q2[0] + __builtin_amdgcn_update_dpp(0, q2[0], 0x128, 0xf, 0xf, false);
                  const int t1 = q2[1] + __builtin_amdgcn_update_dpp(0, q2[1], 0x128, 0xf, 0xf, false);
                  int v = (lane & 8) ? t1 : t0;
                  v += __builtin_amdgcn_update_dpp(0, v, 0x141, 0xf, 0xf, false);
                  v += __builtin_amdgcn_update_dpp(0, v, 0x4e, 0xf, 0xf, false);
                  v += __builtin_amdgcn_update_dpp(0, v, 0xb1, 0xf, 0xf, false);
                  psum = v; }
                if ((lane & 7) == 0) psL[(4 * b4 + q) * 8 + ((lane >> 3) & 7)] = psum;
            }
        }
    }
    if constexpr (!UONLY) {
    float wv[NK];
#pragma unroll
    for (int r = 0; r < NK; ++r) { const int tj = (key[r] >> 7) & 7; float sc = hsc[0];
#pragma unroll
        for (int j = 1; j < NT; ++j) sc = (tj == j) ? hsc[j] : sc;
        const float gate = GATES[(size_t)(tbase + tj) * 128 + (key[r] & 127)], su = SU[(key[r] >> 10) & EM] * sc;
        wv[r] = gate * gelu_fast((float)psL[lane * NK + r] * su); }
    LAS int* lst = (LAS int*)(F.lds) + F.wave * 2048;
    LAS float* lwt = (LAS float*)(lst + 1024);
    { int cnt0 = 0;
#pragma unroll
      for (int r = 0; r < NK; ++r) cnt0 += ((key[r] >> 9) & 1) ^ 1;
      int inc = cnt0;
#pragma unroll
      for (int o = 1; o < 64; o <<= 1) { const int t = __shfl_up(inc, o); if (lane >= o) inc += t; }
      int o0 = inc - cnt0, o1 = lane * NK - o0;
#pragma unroll
      for (int r = 0; r < NK; ++r) { const int g1 = (key[r] >> 9) & 1; const int ent = ((key[r] >> 10) << 2) | ((key[r] >> 7) & 3);
          if (g1) { lst[512 + o1] = ent; lwt[512 + o1] = wv[r]; ++o1; } else { lst[o0] = ent; lwt[o0] = wv[r]; ++o0; } } }
    const float* fg = F.in[17];
#pragma unroll 1
    for (int g = 0; g < 2; ++g) {
        int kg[8];
#pragma unroll
        for (int r = 0; r < 8; ++r) kg[r] = lst[g * 512 + lane * 8 + r];
        float out[4][16];
#pragma unroll
        for (int j = 0; j < 4; ++j)
#pragma unroll
            for (int i = 0; i < 16; ++i) out[j][i] = 0.f;
        v4u vb[2][8];
#pragma unroll
        for (int par = 0; par < 2; ++par)
#pragma unroll
            for (int r = 0; r < 8; ++r) vb[par][r] = *((const v4u*)(V + (size_t)((__builtin_amdgcn_readlane(kg[r], par) >> 2) & EM) * 1024) + lane);
#pragma unroll 1
        for (int b2 = 0; b2 < 32; ++b2) {
#pragma unroll
            for (int par = 0; par < 2; ++par) {
                const int b = 2 * b2 + par, bn = (b + 2 < 64) ? b + 2 : par;
                const f32x4 wa = *(const LAS f32x4*)(lwt + g * 512 + b * 8), wb = *(const LAS f32x4*)(lwt + g * 512 + b * 8 + 4);
#pragma unroll
                for (int r = 0; r < 8; ++r) { const int kk = __builtin_amdgcn_readlane(kg[r], b); const float wr = (r < 4) ? wa[r & 3] : wb[r & 3]; const int tk = kk & 3;
                    float f[16]; fp8x16_to_f32(vb[par][r], f);
#pragma unroll
                    for (int j = 0; j < 4; ++j) if (tk == j) {
#pragma unroll
                        for (int i = 0; i < 16; ++i) out[j][i] += wr * f[i]; } }
#pragma unroll
                for (int r = 0; r < 8; ++r) vb[par][r] = *((const v4u*)(V + (size_t)((__builtin_amdgcn_readlane(kg[r], bn) >> 2) & EM) * 1024) + lane);
            }
        }
#pragma unroll
        for (int j = 0; j < 4; ++j) {
            const int t = tbase + g * 4 + j, bb = t >> 12; const float* g2 = MOD + bb * NMOD + 5 * DM; float* xo = F.out + (size_t)t * DM;
            const bf16* x1r = (const bf16*)(F.ws + WS_X1) + (size_t)t * DM + lane * 16;
            float x2[16]; float ss = 0.f;
#pragma unroll
            for (int hq = 0; hq < 4; ++hq) { const int c = lane * 16 + hq * 4; const v2u xw = *(const v2u*)(x1r + hq * 4); const f32x4 xv = (f32x4){bflo(xw.x), bfhi(xw.x), bflo(xw.y), bfhi(xw.y)}, gv = *(const f32x4*)(g2 + c);
#pragma unroll
                for (int e = 0; e < 4; ++e) { const float y = xv[e] + gv[e] * (out[j][hq * 4 + e] * (1.0f / V_SCALE)); x2[hq * 4 + e] = y; ss += y * y; } }
            const float rinv = 1.0f / sqrtf(wave_sum(ss) * (1.f / DM) + EPS);
#pragma unroll
            for (int hq = 0; hq < 4; ++hq) { const int c = lane * 16 + hq * 4; const f32x4 fv = *(const f32x4*)(fg + c);
                f32x4 y;
#pragma unroll
                for (int e = 0; e < 4; ++e) y[e] = x2[hq * 4 + e] * rinv * fv[e];
                if (!FAKE || rinv == 12345.678f) *(f32x4*)(xo + c) = y; }
        }
    }
    }
}

struct Args { const float* in[18]; float* out; unsigned char* ws; int ph_lo, ph_hi, li, pad; };
__global__ void __launch_bounds__(NWAVES * 64, 2) mk_fwd(Args args) {
    extern __shared__ __attribute__((aligned(16))) unsigned char lds[];
    Frame F;
    F.lds = (LAS unsigned char*)lds;
    F.tid = threadIdx.x; F.lane = F.tid & 63; F.wave = __builtin_amdgcn_readfirstlane(F.tid >> 6);
    F.G = gridDim.x; { const int bx = blockIdx.x; F.vcu = (F.G % 8 == 0) ? (bx % 8) * (F.G / 8) + bx / 8 : bx; }
    F.gw = F.vcu * NWAVES + F.wave; F.NGW = F.G * NWAVES;
#pragma unroll
    for (int i = 0; i < 18; ++i) F.in[i] = args.in[i];
    F.out = args.out; F.ws = args.ws;
    volatile LAS unsigned* MISC = (volatile LAS unsigned*)(F.lds + MISC_OFF);
    for (int u = F.tid; u < (LDS_BYTES - LDSCTL_OFF) / 4; u += NWAVES * 64) ((LAS unsigned*)(F.lds + LDSCTL_OFF))[u] = 0u;
    __syncthreads();
    gu32* ctl = (gu32*)(F.ws + WS_CTL);
    XcdBarrier bar; bar.bar = (unsigned*)(ctl + CW_BAR) + args.li * XCD_BAR_WORDS; bar.x = 0; bar.st = nullptr;
    const int lo = args.ph_lo, hi = args.ph_hi;
    if (hi - lo > 1) bar = xcd_barrier_post((unsigned*)(ctl + CW_BAR) + args.li * XCD_BAR_WORDS, MISC + 8);
#ifndef PROBE_MASK
#define PROBE_MASK 0
#endif
#define REP(k) for (int rep_ = 0; rep_ < 1 + ((PROBE_MASK >> (k)) & 1); ++rep_)
#define IN(k) (lo <= (k) && (k) < hi)
#ifndef PROBE_SEAMS
#define PROBE_SEAMS 1
#endif
#define SEAM(k) do { if (IN(k) && IN((k) + 1)) for (int s_ = 0; s_ < PROBE_SEAMS; ++s_) xcd_barrier(bar); } while (0)

    if (IN(0)) { REP(0) { p0_prologue(F); __syncthreads(); } SEAM(0); }
    if (IN(1)) { REP(1) norm_rows<false>(F, F.in[0], F.in[2], MROWS, F.in[6], 0, DM, (bf16*)(F.ws + WS_HX)); SEAM(1); }
    if (IN(2)) {
        pg8::Gemm g{(const bf16*)(F.ws + WS_HX), (const bf16*)(F.ws + WS_WIN), MROWS, DIN, DM}; pg8::InProjOrder S; S.init(F.G, (int)blockIdx.x);
        pg8::EpiInProj E{(bf16*)(F.ws + WS_PB), (bf16*)(F.ws + WS_QF), (bf16*)(F.ws + WS_KF), (bf16*)(F.ws + WS_VF)};
        REP(2) pg8::gemm_phase<pg8::EpiInProj, pg8::InProjOrder, true, true>(F.lds + RING_OFF, g, S, E);
        SEAM(2);
    }
    if (IN(3)) { REP(3) attn_mfma(F); REP(9) pool_mfma(F); SEAM(3); }
    if (IN(4)) {
        pg8::Gemm g{(const bf16*)(F.ws + WS_MIX), (const bf16*)(F.ws + WS_WOUT), NTOK, DM, DM}; pg8::StaticOrder S; S.init(NTOK, DM, F.G, (int)blockIdx.x);
        pg8::EpiX1 E{F.in[0], (const float*)(F.ws + WS_MOD), (bf16*)(F.ws + WS_X1)};
        REP(4) pg8::gemm_phase<pg8::EpiX1, pg8::StaticOrder, true, true>(F.lds + RING_OFF, g, S, E);
        SEAM(4);
    }
    if (IN(5)) { REP(5) norm_rows<true>(F, (const float*)(F.ws + WS_X1), nullptr, NTOK, F.in[12], 3 * DM, 4 * DM, (bf16*)(F.ws + WS_HX)); SEAM(5); }
    if (IN(6)) {
        pg8::Gemm g{(const bf16*)(F.ws + WS_HX), (const bf16*)(F.ws + WS_WQ), NTOK, 2048, DM}; pg8::StaticOrder S; S.init(NTOK, 2048, F.G, (int)blockIdx.x);
        pg8::EpiQP E{(bf16*)(F.ws + WS_ZX)};
        REP(6) pg8::gemm_phase<pg8::EpiQP, pg8::StaticOrder, true, true>(F.lds + RING_OFF, g, S, E);
        SEAM(6);
    }
    if (IN(7)) {
        for (int tile = F.vcu; tile < NTOK / 128; tile += F.G) {
            const int tok0 = tile * 128;
            REP(7) peer_topk_mfma(F, tile);
            if ((PROBE_MASK >> 10) & 1) for (int rd = 0; rd < 2; ++rd) gather_v4<false>(F, tok0 + rd * 64 + F.wave * 8);
            for (int rd = 0; rd < 2; ++rd) gather_v4<false>(F, tok0 + rd * 64 + F.wave * 8);
        }
    }
#undef IN
#undef SEAM
}

extern "C" void kernel_launch(void* const* d_in, const int* in_sizes, int n_in, void* d_out, int out_size, void* d_ws, size_t ws_size, hipStream_t stream) {
    static int grid = 0;
    if (grid == 0) {
        if (n_in != 18 || in_sizes[0] != NTOK * DM || out_size != NTOK * DM || ws_size < WS_END) { fprintf(stderr, "kernel_launch: unexpected shapes / workspace (n_in %d, ws %zu); nothing launched\n", n_in, ws_size); grid = -1; return; }
        int dev = 0, cus = 0;
        if (hipGetDevice(&dev) != hipSuccess || hipDeviceGetAttribute(&cus, hipDeviceAttributeMultiprocessorCount, dev) != hipSuccess) { grid = -1; return; }
        if (hipFuncSetAttribute((const void*)mk_fwd, hipFuncAttributeMaxDynamicSharedMemorySize, LDS_BYTES) != hipSuccess) { fprintf(stderr, "kernel_launch: hipFuncSetAttribute failed\n"); grid = -1; return; }
        int per_cu = 0;
        if (hipOccupancyMaxActiveBlocksPerMultiprocessor(&per_cu, (const void*)mk_fwd, NWAVES * 64, LDS_BYTES) != hipSuccess || per_cu < 1) fprintf(stderr, "kernel_launch: note: occupancy query reports %d blocks per CU\n", per_cu);
        (void)hipGetLastError();
        grid = cus;
    }
    if (grid < 0) return;
    (void)hipMemsetAsync((char*)d_ws + WS_CTL, 0, CTL_ZERO_BYTES, stream);
    Args a{};
    for (int i = 0; i < 18; ++i) a.in[i] = (const float*)d_in[i];
    a.out = (float*)d_out; a.ws = (unsigned char*)d_ws;
    for (int li = 0; li < N_LAUNCHES; ++li) {
        if (N_LAUNCHES == 1) { a.ph_lo = 0; a.ph_hi = NPHASE; } else { a.ph_lo = li; a.ph_hi = li + 1; }
        a.li = (N_LAUNCHES == 1) ? 0 : 0;
        hipLaunchKernelGGL(mk_fwd, dim3(grid), dim3(NWAVES * 64), LDS_BYTES, stream, a);
    }
}
```

```cpp
#include <hip/hip_runtime.h>
#include <cstdio>
#include <cstdint>
#include <type_traits>
namespace pg8 {
#define PG8_LAS __attribute__((address_space(3)))
typedef unsigned short bf16_t;
typedef short bf16x8 __attribute__((ext_vector_type(8)));
typedef float f32x4 __attribute__((ext_vector_type(4)));
typedef unsigned u32x4 __attribute__((ext_vector_type(4)));
constexpr int BM = 256, BK = 64, HALF = 128, HTB = HALF * BK * 2  , STAGE_BYTES = 8 * HTB, NXCD = 8, WGM = 8;

__host__ __device__ __forceinline__ int lds_byte(int r, int c) { const int st = (r >> 4) * 2 + (c >> 5), rr = r & 15, cc = c & 31, ob = rr * 64 + cc * 2; return st * 1024 + (ob ^ (((ob >> 9) & 1) << 5)); }
__host__ __device__ __forceinline__ void stage_rc(int b, int& R, int& C) { const int st = b / 1024, sb = b % 1024, swz = sb ^ (((sb >> 9) & 1) << 5); R = (st >> 1) * 16 + swz / 64; C = (st & 1) * 32 + (swz % 64) / 2; }
__host__ __device__ __forceinline__ int perm32(int rho) { const int n = rho >> 4, i = rho & 15; return 8 * (i >> 2) + 4 * n + (i & 3); }

struct Unit { int pm, pn; };
struct Gemm { const bf16_t* A; const bf16_t* Bt; int M, N, K; };
struct StaticOrder {
    int nM, nN, nwg, G, c;
    __host__ __device__ void init(int M, int N, int G_, int c_) { nM = M / BM; nN = N / BM; nwg = nM * nN; G = G_; c = c_; }
    __host__ __device__ bool next(int i, Unit& u) const {
        const long L = (long)i * G + c; if (L >= nwg) return false;
        int wgid = (int)L; { const int q = nwg / NXCD, r = nwg % NXCD, xcd = wgid % NXCD, off = wgid / NXCD; wgid = (xcd < r ? xcd * (q + 1) : r * (q + 1) + (xcd - r) * q) + off; }
        const int nig = WGM * nN, gid = wgid / nig, fm = gid * WGM, gsz = (nM - fm) < WGM ? (nM - fm) : WGM;
        u.pm = fm + ((wgid % nig) % gsz); u.pn = (wgid % nig) / gsz; return true;
    }
    __device__ __forceinline__ void a_ready(const Unit&) const {}
    __device__ __forceinline__ void done(const Unit&) const {}
    __device__ __forceinline__ const char* pa(const Gemm& g, const Unit& u) const { return (const char*)g.A + (size_t)u.pm * ((size_t)BM * g.K * 2); }
    __device__ __forceinline__ const char* pb(const Gemm& g, const Unit& u) const { return (const char*)g.Bt + (size_t)u.pn * ((size_t)BM * g.K * 2); }
};
struct InProjOrder {
    StaticOrder so;
    __host__ __device__ void init(int G_, int c_) { so.init(136 * BM, 8 * BM, G_, c_); }
    __host__ __device__ bool next(int i, Unit& u) const { int cnt = -1; for (int j = 0; ; ++j) { if (!so.next(j, u)) return false; if (!(u.pm >= 128 && u.pn < 4)) { if (++cnt == i) return true; } } }
    __device__ __forceinline__ void a_ready(const Unit&) const {}
    __device__ __forceinline__ void done(const Unit&) const {}
    __device__ __forceinline__ const char* pa(const Gemm& g, const Unit& u) const { return u.pn < 6 ? (const char*)g.A + (size_t)u.pm * ((size_t)BM * g.K * 2) : (const char*)g.Bt + (size_t)u.pn * ((size_t)BM * g.K * 2); }
    __device__ __forceinline__ const char* pb(const Gemm& g, const Unit& u) const { return u.pn < 6 ? (const char*)g.Bt + (size_t)u.pn * ((size_t)BM * g.K * 2) : (const char*)g.A + (size_t)u.pm * ((size_t)BM * g.K * 2); }
};

__device__ __forceinline__ unsigned cvt_pk_bf16(float lo, float hi) { unsigned r; asm volatile("v_cvt_pk_bf16_f32 %0, %1, %2" : "=v"(r) : "v"(lo), "v"(hi)); return r; }
struct EpiBf16 {
    static constexpr bool PERM = true, AFTER_DRAIN = false;
    bf16_t* O; int ldc;
    __device__ __forceinline__ void operator()(const f32x4 (&acc)[2][2][4][2], const Unit& u, int wr, int wc, int fr, int fq) const {
        const int row0 = u.pm * BM + wr * 64 + fr, col0 = u.pn * BM + wc * 32 + 8 * fq;
#pragma unroll
        for (int ai = 0; ai < 2; ++ai)
#pragma unroll
            for (int m = 0; m < 4; ++m) { bf16_t* rowp = O + (size_t)(row0 + ai * HALF + m * 16) * ldc + col0;
#pragma unroll
                for (int bj = 0; bj < 2; ++bj) { const f32x4 v0 = acc[ai][bj][m][0], v1 = acc[ai][bj][m][1];
                    u32x4 w; w.x = cvt_pk_bf16(v0[0], v0[1]); w.y = cvt_pk_bf16(v0[2], v0[3]); w.z = cvt_pk_bf16(v1[0], v1[1]); w.w = cvt_pk_bf16(v1[2], v1[3]);
                    *(u32x4*)(rowp + bj * HALF) = w; } }
    }
};
struct EpiX1 {
    static constexpr bool PERM = true, AFTER_DRAIN = false;
    const float* x; const float* mod; bf16_t* out;
    __device__ __forceinline__ void operator()(const f32x4 (&acc)[2][2][4][2], const Unit& u, int wr, int wc, int fr, int fq) const {
        const int row0 = u.pm * BM + wr * 64 + fr, col0 = u.pn * BM + wc * 32 + 8 * fq;
        const float* g1 = mod + (size_t)((u.pm * BM) >> 12) * 6144 + 2048 + col0;
        f32x4 gv[2][2];
#pragma unroll
        for (int bj = 0; bj < 2; ++bj)
#pragma unroll
            for (int n = 0; n < 2; ++n) gv[bj][n] = *(const f32x4*)(g1 + bj * HALF + 4 * n);
#pragma unroll
        for (int ai = 0; ai < 2; ++ai)
#pragma unroll
            for (int m = 0; m < 4; ++m) { const size_t off = (size_t)(row0 + ai * HALF + m * 16) * 1024 + col0;
#pragma unroll
                for (int bj = 0; bj < 2; ++bj) { const f32x4 x0 = *(const f32x4*)(x + off + bj * HALF), x1 = *(const f32x4*)(x + off + bj * HALF + 4);
                    const f32x4 v0 = x0 + gv[bj][0] * acc[ai][bj][m][0], v1 = x1 + gv[bj][1] * acc[ai][bj][m][1];
                    u32x4 w; w.x = cvt_pk_bf16(v0[0], v0[1]); w.y = cvt_pk_bf16(v0[2], v0[3]); w.z = cvt_pk_bf16(v1[0], v1[1]); w.w = cvt_pk_bf16(v1[2], v1[3]);
                    *(u32x4*)(out + off + bj * HALF) = w; } }
    }
};


struct EpiInProj {
    static constexpr bool PERM = true, AFTER_DRAIN = false;
    bf16_t *PB, *QF, *KF, *VF;
    __device__ __forceinline__ void operator()(const f32x4 (&acc)[2][2][4][2], const Unit& u, int wr, int wc, int fr, int fq) const {
        if (u.pn < 6) {
            const int sec = u.pn >> 1, cbase = (u.pn & 1) * 256 + wc * 32 + 8 * fq;
#pragma unroll
            for (int ai = 0; ai < 2; ++ai)
#pragma unroll
                for (int m = 0; m < 4; ++m) { const int T = u.pm * BM + ai * HALF + wr * 64 + m * 16 + fr;
                    int bb, blk; if (T < 32768) { bb = T >> 12; blk = (T & 4095) >> 5; } else { const int cc = T - 32768; bb = cc >> 8; blk = 128 + ((cc & 255) >> 5); }
                    const int tl = T & 31;
#pragma unroll
                    for (int bj = 0; bj < 2; ++bj) { const int c = cbase + HALF * bj; const f32x4 v0 = acc[ai][bj][m][0], v1 = acc[ai][bj][m][1];
                        u32x4 w; w.x = cvt_pk_bf16(v0[0], v0[1]); w.y = cvt_pk_bf16(v0[2], v0[3]); w.z = cvt_pk_bf16(v1[0], v1[1]); w.w = cvt_pk_bf16(v1[2], v1[3]);
                        if (sec == 0) *(u32x4*)(PB + (size_t)T * 512 + c) = w;
                        else { const int h = c >> 6, d0 = c & 63, fo = ((d0 >> 4) * 64 + ((d0 >> 3) & 1) * 32 + tl) * 8;
                            bf16_t* dst = (sec == 1) ? QF + (size_t)((bb * 8 + h) * 128 + blk) * 2048 + fo : KF + (size_t)((bb * 8 + h) * 136 + blk) * 2048 + fo;
                            *(u32x4*)dst = w; } } }
        } else {
            typedef unsigned u32x2 __attribute__((ext_vector_type(2)));
#pragma unroll
            for (int ai = 0; ai < 2; ++ai)
#pragma unroll
                for (int m = 0; m < 4; ++m) { const int vc = (u.pn - 6) * BM + ai * HALF + wr * 64 + m * 16 + fr, h = vc >> 6, dt = (vc >> 5) & 1, dl = vc & 31;
#pragma unroll
                    for (int bj = 0; bj < 2; ++bj) { const int T0 = u.pm * BM + bj * HALF + wc * 32 + 8 * fq;
                        int bb, blk; if (T0 < 32768) { bb = T0 >> 12; blk = (T0 & 4095) >> 5; } else { const int cc = T0 - 32768; bb = cc >> 8; blk = 128 + ((cc & 255) >> 5); }
                        bf16_t* base = VF + ((size_t)(((bb * 8 + h) * 136 + blk) * 2 + dt) * 2 + (fq >> 1)) * 512 + 4 * (fq & 1);
                        const f32x4 v0 = acc[ai][bj][m][0], v1 = acc[ai][bj][m][1];
                        u32x2 w0, w1; w0.x = cvt_pk_bf16(v0[0], v0[1]); w0.y = cvt_pk_bf16(v0[2], v0[3]); w1.x = cvt_pk_bf16(v1[0], v1[1]); w1.y = cvt_pk_bf16(v1[2], v1[3]);
                        *(u32x2*)(base + dl * 8) = w0; *(u32x2*)(base + (32 + dl) * 8) = w1; } }
        }
    }
};

struct EpiQP {
    static constexpr bool PERM = true, AFTER_DRAIN = false;
    bf16_t* QP;
    __device__ __forceinline__ void operator()(const f32x4 (&acc)[2][2][4][2], const Unit& u, int wr, int wc, int fr, int fq) const {
#pragma unroll
        for (int ai = 0; ai < 2; ++ai)
#pragma unroll
            for (int m = 0; m < 4; ++m) { const int T = u.pm * BM + ai * HALF + wr * 64 + m * 16 + fr;
#pragma unroll
                for (int bj = 0; bj < 2; ++bj) { const int hp = 2 * u.pn + bj, ks = 2 * wc + (fq >> 1), hh = fq & 1;
                    const f32x4 v0 = acc[ai][bj][m][0], v1 = acc[ai][bj][m][1];
                    u32x4 w; w.x = cvt_pk_bf16(v0[0], v0[1]); w.y = cvt_pk_bf16(v0[2], v0[3]); w.z = cvt_pk_bf16(v1[0], v1[1]); w.w = cvt_pk_bf16(v1[2], v1[3]);
                    *(u32x4*)(QP + ((size_t)(T >> 5) * 16 + hp) * 4096 + (ks * 64 + hh * 32 + (T & 31)) * 8) = w; } }
    }
};
template <class Epi, class Sched, bool ALIGN_EPI = false, bool SP2 = false>
__device__ __forceinline__ void gemm_phase(PG8_LAS unsigned char* lds, const Gemm g, const Sched& S, const Epi& E) {
    const int tid = threadIdx.x, wid = __builtin_amdgcn_readfirstlane(tid >> 6), lane = tid & 63, wr = wid >> 2, wc = wid & 3, fr = lane & 15, fq = lane >> 4;
    const int K = g.K, nt = K / BK;
    unsigned voffA[2], voffB[2];
#pragma unroll
    for (int i = 0; i < 2; ++i) { int R, C; stage_rc(tid * 16 + i * 8192, R, C); const int Rb = Epi::PERM ? ((R & ~31) + perm32(R & 31)) : R;
        voffA[i] = (unsigned)(R * K + C) * 2u; voffB[i] = (unsigned)(Rb * K + C) * 2u; }
    const size_t kstep = (size_t)(BK * 2);
    const size_t hstep = (size_t)HALF * K * 2;
    const size_t tstep = 2 * hstep;
    const unsigned ldsw = (unsigned)wid * 1024u;
    const int aoff = lds_byte(wr * 64 + fr, fq * 8), boff = lds_byte(wc * 32 + fr, fq * 8);
#define PG8_SA(b, h) (((b) * 2 + (h)) * HTB)
#define PG8_SB(b, h) ((4 + (b) * 2 + (h)) * HTB)
#define PG8_STAGE(bufoff, gbase, voff) do { _Pragma("unroll") for (int _i = 0; _i < 2; ++_i) \
        __builtin_amdgcn_global_load_lds((const unsigned*)((const char*)(gbase) + (voff)[_i]), (PG8_LAS unsigned*)(lds + (bufoff) + ldsw + _i * 8192), 16, 0, 0); } while (0)
#define PG8_LDA(dst, b, h) do { _Pragma("unroll") for (int m = 0; m < 4; ++m) _Pragma("unroll") for (int k = 0; k < 2; ++k) dst[m][k] = *(const PG8_LAS bf16x8*)(lds + PG8_SA(b, h) + aoff + m * 2048 + k * 1024); } while (0)
#define PG8_LDB(dst, b, h) do { _Pragma("unroll") for (int n = 0; n < 2; ++n) _Pragma("unroll") for (int k = 0; k < 2; ++k) dst[n][k] = *(const PG8_LAS bf16x8*)(lds + PG8_SB(b, h) + boff + n * 2048 + k * 1024); } while (0)
#define PG8_MMA(ai, bj, At, Bt) do { __builtin_amdgcn_s_setprio(1); _Pragma("unroll") for (int m = 0; m < 4; ++m) _Pragma("unroll") for (int n = 0; n < 2; ++n) _Pragma("unroll") for (int k = 0; k < 2; ++k) \
        acc[ai][bj][m][n] = __builtin_amdgcn_mfma_f32_16x16x32_bf16(Bt[n][k], At[m][k], acc[ai][bj][m][n], 0, 0, 0); __builtin_amdgcn_s_setprio(0); } while (0)
#define PG8_WAIT_V(n) asm volatile("s_waitcnt vmcnt(" #n ")" ::: "memory")
#define PG8_WAIT_L(n) asm volatile("s_waitcnt lgkmcnt(" #n ")" ::: "memory")
#define PG8_BAR __builtin_amdgcn_s_barrier()
#define PG8_SCHED __builtin_amdgcn_sched_barrier(0)
    Unit cur, nxt; int ui = 0;
    if (!S.next(0, cur)) return;
    f32x4 acc[2][2][4][2];
#pragma unroll
    for (int a = 0; a < 2; ++a)
#pragma unroll
        for (int b = 0; b < 2; ++b)
#pragma unroll
            for (int m = 0; m < 4; ++m)
#pragma unroll
                for (int n = 0; n < 2; ++n) acc[a][b][m][n] = (f32x4){0.f, 0.f, 0.f, 0.f};
    bf16x8 At[4][2], B0[2][2], B1[2][2];
    const char* cA = S.pa(g, cur); const char* cB = S.pb(g, cur);
    S.a_ready(cur);
    if constexpr (SP2) {
        PG8_STAGE(PG8_SB(0, 0), cB, voffB); PG8_STAGE(PG8_SB(0, 1), cB + hstep, voffB); PG8_STAGE(PG8_SA(0, 0), cA, voffA); PG8_STAGE(PG8_SA(0, 1), cA + hstep, voffA);
        if (wr == 1) PG8_BAR;
        PG8_WAIT_V(2); PG8_BAR;
        PG8_STAGE(PG8_SB(1, 0), cB + kstep, voffB); PG8_STAGE(PG8_SA(1, 0), cA + kstep, voffA); PG8_STAGE(PG8_SB(1, 1), cB + hstep + kstep, voffB);
        PG8_WAIT_V(6); PG8_BAR;
    } else {
        PG8_STAGE(PG8_SB(0, 0), cB, voffB); PG8_STAGE(PG8_SA(0, 0), cA, voffA); PG8_STAGE(PG8_SB(0, 1), cB + hstep, voffB); PG8_STAGE(PG8_SA(0, 1), cA + hstep, voffA);
        if (wr == 1) PG8_BAR;
        PG8_WAIT_V(4); PG8_BAR;
        PG8_STAGE(PG8_SB(1, 0), cB + kstep, voffB); PG8_STAGE(PG8_SA(1, 0), cA + kstep, voffA); PG8_STAGE(PG8_SB(1, 1), cB + hstep + kstep, voffB);
        PG8_WAIT_V(6); PG8_BAR;
    }
    for (;;) {
        const bool has_next = S.next(ui + 1, nxt);
        const char* nA = has_next ? S.pa(g, nxt) : cA; const char* nB = has_next ? S.pb(g, nxt) : cB;
        for (int t = 0; t < nt; t += 2) {
            const bool last = (t == nt - 2);
            const char* a1 = cA + (size_t)(t + 1) * kstep;
            const char* a2 = last ? nA : cA + (size_t)(t + 2) * kstep; const char* b2 = last ? nB : cB + (size_t)(t + 2) * kstep;
            const char* a3 = a2 + kstep; const char* b3 = b2 + kstep;
            if (last && has_next) S.a_ready(nxt);
            if constexpr (SP2) {
            PG8_LDB(B0, 0, 0); PG8_LDB(B1, 0, 1); PG8_SCHED; PG8_LDA(At, 0, 0); PG8_STAGE(PG8_SA(1, 1), a1 + hstep, voffA);
            PG8_WAIT_V(8); PG8_WAIT_L(0); PG8_BAR; PG8_MMA(0, 0, At, B0); PG8_MMA(0, 1, At, B1); PG8_BAR; PG8_SCHED;
            PG8_LDA(At, 0, 1); PG8_STAGE(PG8_SB(0, 0), b2, voffB); PG8_STAGE(PG8_SB(0, 1), b2 + hstep, voffB); PG8_STAGE(PG8_SA(0, 0), a2, voffA);
            PG8_WAIT_V(8); PG8_WAIT_L(0); PG8_BAR; PG8_MMA(1, 0, At, B0); PG8_MMA(1, 1, At, B1); PG8_BAR; PG8_SCHED;
            PG8_LDB(B0, 1, 0); PG8_LDB(B1, 1, 1); PG8_SCHED; PG8_LDA(At, 1, 0); PG8_STAGE(PG8_SA(0, 1), a2 + hstep, voffA);
            PG8_WAIT_V(8); PG8_WAIT_L(0); PG8_BAR; PG8_MMA(0, 0, At, B0); PG8_MMA(0, 1, At, B1); PG8_BAR; PG8_SCHED;
            PG8_LDA(At, 1, 1); PG8_STAGE(PG8_SB(1, 0), b3, voffB); PG8_STAGE(PG8_SB(1, 1), b3 + hstep, voffB); PG8_STAGE(PG8_SA(1, 0), a3, voffA);
            PG8_WAIT_V(8); PG8_WAIT_L(0); PG8_BAR; PG8_MMA(1, 0, At, B0); PG8_MMA(1, 1, At, B1); PG8_BAR; PG8_SCHED;
            } else {
            PG8_LDB(B0, 0, 0); PG8_SCHED; PG8_LDA(At, 0, 0); PG8_STAGE(PG8_SA(1, 1), a1 + hstep, voffA);
            PG8_WAIT_L(8); PG8_BAR; PG8_WAIT_L(0); PG8_MMA(0, 0, At, B0); PG8_BAR; PG8_SCHED;
            PG8_LDB(B1, 0, 1); PG8_STAGE(PG8_SB(0, 0), b2, voffB);
            PG8_BAR; PG8_WAIT_L(0); PG8_MMA(0, 1, At, B1); PG8_BAR;
            PG8_LDA(At, 0, 1); PG8_STAGE(PG8_SA(0, 0), a2, voffA);
            PG8_BAR; PG8_WAIT_L(0); PG8_MMA(1, 0, At, B0); PG8_BAR; PG8_SCHED;
            PG8_STAGE(PG8_SB(0, 1), b2 + hstep, voffB);
            PG8_WAIT_V(6); PG8_BAR; PG8_MMA(1, 1, At, B1); PG8_BAR;
            PG8_LDB(B0, 1, 0); PG8_SCHED; PG8_LDA(At, 1, 0); PG8_STAGE(PG8_SA(0, 1), a2 + hstep, voffA);
            PG8_WAIT_L(8); PG8_BAR; PG8_WAIT_L(0); PG8_MMA(0, 0, At, B0); PG8_BAR; PG8_SCHED;
            PG8_LDB(B1, 1, 1); PG8_STAGE(PG8_SB(1, 0), b3, voffB);
            PG8_BAR; PG8_WAIT_L(0); PG8_MMA(0, 1, At, B1); PG8_BAR;
            PG8_LDA(At, 1, 1); PG8_STAGE(PG8_SA(1, 0), a3, voffA);
            PG8_BAR; PG8_WAIT_L(0); PG8_MMA(1, 0, At, B0); PG8_BAR; PG8_SCHED;
            PG8_STAGE(PG8_SB(1, 1), b3 + hstep, voffB);
            PG8_WAIT_V(6); PG8_BAR; PG8_MMA(1, 1, At, B1); PG8_BAR;
            }
        }
        if constexpr (ALIGN_EPI) { if (wr == 0) PG8_BAR; }
        if constexpr (!Epi::AFTER_DRAIN) { E(acc, cur, wr, wc, fr, fq); S.done(cur); }
        if (!has_next) break;
#pragma unroll
        for (int a = 0; a < 2; ++a)
#pragma unroll
            for (int b = 0; b < 2; ++b)
#pragma unroll
                for (int m = 0; m < 4; ++m)
#pragma unroll
                    for (int n = 0; n < 2; ++n) acc[a][b][m][n] = (f32x4){0.f, 0.f, 0.f, 0.f};
        cur = nxt; cA = nA; cB = nB; ++ui;
        if constexpr (ALIGN_EPI) { if (wr == 1) PG8_BAR; }
    }
    PG8_WAIT_V(0);
    if constexpr (!ALIGN_EPI) { if (wr == 0) PG8_BAR; }
    PG8_BAR;
    if constexpr (Epi::AFTER_DRAIN) { E.fused(acc, cur, wr, wc, fr, fq, lds, wid, lane); S.done(cur); }
#undef PG8_SA
#undef PG8_SB
#undef PG8_STAGE
#undef PG8_LDA
#undef PG8_LDB
#undef PG8_MMA
#undef PG8_WAIT_V
#undef PG8_WAIT_L
#undef PG8_BAR
#undef PG8_SCHED
}
}

constexpr int DM = 1024, NBATCH = 8, SEQ = 4096, NTOK = NBATCH * SEQ, CTXL = 256, NCTX = NBATCH * CTXL, MROWS = NTOK + NCTX;
constexpr int DIN = 2048, NHEAD = 8, HD = 64, GRIDW = 64, NMOD = 6 * DM;
constexpr int NEXP = 16384;
constexpr float EPS = 1e-6f;
constexpr int NWAVES = 8;
constexpr int NPHASE = 8;
constexpr float U_SCALE = 64.f, V_SCALE = 4.f;

#ifndef FAKE_MASK
#define FAKE_MASK 7
#endif
#ifndef MK_N_LAUNCHES
#define MK_N_LAUNCHES 1
#endif
constexpr int N_LAUNCHES = MK_N_LAUNCHES;

constexpr size_t MiB = 1u << 20;
constexpr size_t WS_CTL = 0, CTL_ZERO_BYTES = 64 * 1024;
constexpr size_t WS_WIN = 2 * MiB, WS_WOUT = 6 * MiB, WS_WQ = 8 * MiB, WS_KEYS = 12 * MiB, WS_POOLW = 12 * MiB + 512 * 1024, WS_MOD = 13 * MiB;
constexpr size_t WS_SU = 13 * MiB + 512 * 1024, WS_SV = WS_SU + 64 * 1024;
constexpr size_t WS_U = 14 * MiB, WS_V = 46 * MiB;
constexpr size_t WS_HX = 78 * MiB;
constexpr size_t WS_ZX = 146 * MiB;
constexpr size_t WS_PB = 146 * MiB, WS_QF = 178 * MiB, WS_KF = 210 * MiB, WS_VF = 244 * MiB;
constexpr size_t WS_MIX = 282 * MiB;
constexpr size_t WS_EXP = 346 * MiB, WS_GATE = 362 * MiB;
constexpr size_t WS_X1 = 378 * MiB;
constexpr size_t WS_END = 442 * MiB;
constexpr int CW_BAR = 4096;

constexpr int RING_OFF = 0, RING_BYTES = 131072;
constexpr int LDSCTL_OFF = RING_BYTES, MISC_OFF = LDSCTL_OFF + 320;
constexpr int LDS_BYTES = 147456;

#define GAS __attribute__((address_space(1)))
#define LAS __attribute__((address_space(3)))
#define DI __device__ __forceinline__
typedef unsigned short bf16;
typedef unsigned v4u __attribute__((ext_vector_type(4)));
typedef unsigned v2u __attribute__((ext_vector_type(2)));
typedef float f32x4 __attribute__((ext_vector_type(4)));
typedef float f32x2 __attribute__((ext_vector_type(2)));
typedef GAS unsigned gu32;
#define RLX_AGENT __ATOMIC_RELAXED, __HIP_MEMORY_SCOPE_AGENT
#define LDS_WAIT() asm volatile("s_waitcnt lgkmcnt(0)" ::: "memory")
#define VM_WAIT() asm volatile("s_waitcnt vmcnt(0)" ::: "memory")
DI unsigned f2bf(float f) { unsigned u = __builtin_bit_cast(unsigned, f); return (u + 0x7fffu + ((u >> 16) & 1u)) >> 16; }
DI unsigned pk2(float lo, float hi) { return f2bf(lo) | (f2bf(hi) << 16); }
DI float bflo(unsigned u) { return __uint_as_float(u << 16); }
DI float bfhi(unsigned u) { return __uint_as_float(u & 0xffff0000u); }
DI float wave_sum(float v) {
#pragma unroll
    for (int o = 1; o < 64; o <<= 1) v += __shfl_xor(v, o);
    return v;
}

#define XB_TMO      128
#define XB_XCNT(j)  (256  + 64 * (j))
#define XB_XSUB(j)  (1280 + 64 * (j))
#define XB_XGEN(j)  (2304 + 64 * (j))
#define XB_TOP      3328
#define XB_TOPGEN   3392
#define XCD_BAR_WORDS 3456
#define XB_SPIN_CAP (1u << 18)

__device__ __forceinline__ unsigned xb_ld(unsigned* p)              { return __hip_atomic_load(p, __ATOMIC_RELAXED, __HIP_MEMORY_SCOPE_AGENT); }
__device__ __forceinline__ unsigned xb_add(unsigned* p, unsigned v) { return __hip_atomic_fetch_add(p, v, __ATOMIC_RELAXED, __HIP_MEMORY_SCOPE_AGENT); }
__device__ __forceinline__ unsigned xb_xcc_id() { return (unsigned)__builtin_amdgcn_s_getreg((3 << 11) | 20) & 0xFu; }
#define XB_SPIN(cond, bar) do { unsigned _sp = 0; while (cond) { __builtin_amdgcn_s_sleep(1); \
    if ((++_sp & 255u) == 0u) { if (xb_ld(&(bar)[XB_TMO])) break; if (_sp > XB_SPIN_CAP) { atomicAdd(&(bar)[XB_TMO], 1u); break; } } } } while (0)

struct XcdBarrier {
    unsigned* bar; unsigned x;
    volatile LAS unsigned* st;
};

__device__ __forceinline__ XcdBarrier xcd_barrier_post(unsigned* bar, volatile LAS unsigned* st) {
    XcdBarrier b; b.bar = bar; b.x = xb_xcc_id(); b.st = st;
    if (threadIdx.x == 0) (void)xb_add(&bar[XB_XCNT(b.x)], 1u);
    return b;
}
__device__ __forceinline__ void xcd_barrier_complete(unsigned* bar, unsigned x, unsigned& nloc, unsigned& nx) {
    const unsigned G = gridDim.x * gridDim.y * gridDim.z;
    unsigned sum, cnt, mine, sp = 0u;
    for (;;) {
        sum = 0u; cnt = 0u; mine = 0u;
#pragma unroll
        for (unsigned j = 0; j < 16; ++j) { const unsigned c = xb_ld(&bar[XB_XCNT(j)]); sum += c; cnt += (c > 0u) ? 1u : 0u; mine = (j == x) ? c : mine; }
        if (sum == G) break;
        __builtin_amdgcn_s_sleep(1);
        if ((++sp & 255u) == 0u) { if (xb_ld(&bar[XB_TMO])) break; if (sp > XB_SPIN_CAP) { atomicAdd(&bar[XB_TMO], 1u); break; } }
    }
    nloc = mine > 0u ? mine : 1u; nx = cnt > 0u ? cnt : 1u;
}

__device__ __forceinline__ void xcd_barrier(const XcdBarrier& b) {
    asm volatile("s_waitcnt vmcnt(0)" ::: "memory");
    __syncthreads();
    if (threadIdx.x == 0) {
        unsigned* bar = b.bar;
        __builtin_amdgcn_s_waitcnt(0);
        unsigned nloc = b.st[0], nx = b.st[1];
        if (nloc == 0u) { xcd_barrier_complete(bar, b.x, nloc, nx); b.st[0] = nloc; b.st[1] = nx; }
        const unsigned old = xb_add(&bar[XB_XSUB(b.x)], 1u);
        const unsigned gen = old / nloc;
        if (old + 1u == (gen + 1u) * nloc) {
            __builtin_amdgcn_fence(__ATOMIC_RELEASE, "agent");
            asm volatile("s_waitcnt vmcnt(0)" ::: "memory");
            const unsigned og = xb_add(&bar[XB_TOP], 1u);
            const unsigned tg = og / nx;
            if (og + 1u == (tg + 1u) * nx) xb_add(&bar[XB_TOPGEN], 1u);
            else XB_SPIN(xb_ld(&bar[XB_TOPGEN]) == tg, bar);
            __builtin_amdgcn_fence(__ATOMIC_ACQUIRE, "agent");
            xb_add(&bar[XB_XGEN(b.x)], 1u);
            asm volatile("s_waitcnt vmcnt(0)" ::: "memory");
        } else {
            XB_SPIN(xb_ld(&bar[XB_XGEN(b.x)]) == gen, bar);
            __builtin_amdgcn_fence(__ATOMIC_ACQUIRE, "agent");
            asm volatile("s_waitcnt vmcnt(0)" ::: "memory");
        }
    }
    __syncthreads();
}


__device__ __forceinline__ void p0_transpose_item(const float* W, int K, int N, bf16* WT, int row_off, LAS float* scr, int item, int lane) {
    const int nblk = N / 32, kb = item / nblk, nb = item % nblk, k0 = 64 * kb, n0 = 32 * nb;
#pragma unroll 8
    for (int i = 0; i < 32; ++i) { const int kk = 2 * i + (lane >> 5); scr[kk * 33 + (lane & 31)] = W[(size_t)(k0 + kk) * N + n0 + (lane & 31)]; }
    LDS_WAIT(); asm volatile("" ::: "memory");
    const int c = lane & 7;
#pragma unroll
    for (int j = 0; j < 4; ++j) { const int n = (lane >> 3) + 8 * j; const LAS float* s = scr + (8 * c) * 33 + n;
        v4u o; o.x = pk2(s[0 * 33], s[1 * 33]); o.y = pk2(s[2 * 33], s[3 * 33]); o.z = pk2(s[4 * 33], s[5 * 33]); o.w = pk2(s[6 * 33], s[7 * 33]);
        *(GAS v4u*)(WT + (size_t)(row_off + n0 + n) * K + k0 + 8 * c) = o; }
    LDS_WAIT(); asm volatile("" ::: "memory");
}


struct Frame {
    LAS unsigned char* lds;
    int tid, lane, wave, vcu, G, gw, NGW;
    const float* in[18]; float* out; unsigned char* ws;
};

DI void p0_prologue(Frame& F) {
    const float* c = F.in[1]; const float* c_ctx = F.in[3]; const float* ada_w = F.in[4]; const float* ada_b = F.in[5];
    float* MOD = (float*)(F.ws + WS_MOD);
    LAS float* sl = (LAS float*)(F.lds + 73728);
    for (int i = F.tid; i < 9 * 1024; i += 512) { const int b = i >> 10, k = i & 1023; const float cv = (b < 8) ? c[b * 1024 + k] : c_ctx[k]; sl[i] = cv / (1.f + __expf(-cv)); }
    __syncthreads();
    { LAS float* part = (LAS float*)(F.lds + 110592);
      for (int cg = F.vcu; cg < NMOD / 24; cg += F.G) {
          const int c = F.lane % 24, sub = F.lane / 24, n = cg * 24 + c, k0 = F.wave * 128 + sub * 64;
          float acc[9];
#pragma unroll
          for (int b = 0; b < 9; ++b) acc[b] = 0.f;
          if (sub < 2) { const float* wp = ada_w + (size_t)k0 * NMOD + n; const LAS float* sp = sl + k0;
#pragma unroll 16
              for (int i = 0; i < 64; ++i) { const float w = wp[(size_t)i * NMOD];
#pragma unroll
                  for (int b = 0; b < 9; ++b) acc[b] += sp[b * 1024 + i] * w; } }
#pragma unroll
          for (int b = 0; b < 9; ++b) { const float o = __shfl(acc[b], (F.lane + 24) & 63); if (F.lane < 24) part[(F.wave * 9 + b) * 24 + c] = acc[b] + o; }
          __syncthreads();
          if (F.tid < 216) { const int b = F.tid / 24, cc = F.tid % 24; float t = ada_b[cg * 24 + cc];
#pragma unroll
              for (int w = 0; w < 8; ++w) t += part[(w * 9 + b) * 24 + cc];
              MOD[b * NMOD + cg * 24 + cc] = t; }
          __syncthreads();
      } }
    LAS float* scr = (LAS float*)(F.lds + F.wave * 9216);
    constexpr int I_IN = (DM / 64) * (DIN / 32), I_OUT = (DM / 64) * (DM / 32), I_Q = (DM / 64) * (2048 / 32), I_P = 4 * 8;
    for (int it = F.gw; it < I_IN + I_OUT + I_Q + I_P; it += F.NGW) {
        int r = it;
        if (r < I_IN) { p0_transpose_item(F.in[7], DM, DIN, (bf16*)(F.ws + WS_WIN), 0, scr, r, F.lane); continue; } r -= I_IN;
        if (r < I_OUT) { p0_transpose_item(F.in[11], DM, DM, (bf16*)(F.ws + WS_WOUT), 0, scr, r, F.lane); continue; } r -= I_OUT;
        if (r < I_Q) { p0_transpose_item(F.in[13], DM, 2048, (bf16*)(F.ws + WS_WQ), 0, scr, r, F.lane); continue; } r -= I_Q;
        { const int g = r >> 3; p0_transpose_item(F.in[8] + g * 16384, 128, 128, (bf16*)(F.ws + WS_POOLW) + g * 16384, 0, scr, r & 7, F.lane); }
    }
    { const float* kf = F.in[14]; bf16* kb = (bf16*)(F.ws + WS_KEYS);
      for (int it = F.gw; it < 16 * 32; it += F.NGW) { const int hp = it >> 5, nt = (it >> 3) & 3, ks = it & 7;
          const float* src = kf + ((size_t)hp * 128 + 32 * nt + (F.lane & 31)) * 128 + 16 * ks + 8 * (F.lane >> 5);
          const f32x4 a = *(const f32x4*)(src), b = *(const f32x4*)(src + 4);
          v4u w; w.x = pk2(a.x, a.y); w.y = pk2(a.z, a.w); w.z = pk2(b.x, b.y); w.w = pk2(b.z, b.w); *(v4u*)(kb + ((size_t)it * 64 + F.lane) * 8) = w; } }
    for (int it = F.gw; it < 2 * NEXP; it += F.NGW) {
        const bool isu = it < NEXP; const int row = isu ? it : it - NEXP;
        const f32x4* sp = (const f32x4*)((isu ? F.in[15] : F.in[16]) + (size_t)row * 1024) + 2 * F.lane;
        unsigned* dst = (unsigned*)((isu ? F.ws + WS_U : F.ws + WS_V) + (size_t)row * 512) + F.lane;
        f32x4 a[4];
#pragma unroll
        for (int j = 0; j < 2; ++j) { a[2 * j] = sp[128 * j]; a[2 * j + 1] = sp[128 * j + 1]; }
        float ss = 0.f;
#pragma unroll
        for (int j = 0; j < 4; ++j) ss += a[j].x * a[j].x + a[j].y * a[j].y + a[j].z * a[j].z + a[j].w * a[j].w;
        const float rms = sqrtf(wave_sum(ss) * (1.0f / 1024.0f));
        if (isu) {
            const float step = fmaxf(0.3352f * rms, 1e-30f), inv = 1.0f / step;
#pragma unroll
            for (int j = 0; j < 2; ++j) { unsigned w = 0;
#pragma unroll
                for (int t = 0; t < 2; ++t)
#pragma unroll
                    for (int e = 0; e < 4; ++e) { const int q = max(-8, min(7, (int)floorf(a[2 * j + t][e] * inv))); w |= (unsigned)(q & 15) << (4 * (4 * t + e)); }
                dst[64 * j] = w; }
            if (F.lane == 0) ((float*)(F.ws + WS_SU))[row] = step;
        } else {
            const float sc = fmaxf(0.5f * rms, 1e-30f), inv = 1.0f / sc;
#pragma unroll
            for (int j = 0; j < 2; ++j) { unsigned pk = 0;
                pk = __builtin_amdgcn_cvt_scalef32_pk_fp4_f32(pk, a[2 * j].x * inv, a[2 * j].y * inv, 1.0f, 0);
                pk = __builtin_amdgcn_cvt_scalef32_pk_fp4_f32(pk, a[2 * j].z * inv, a[2 * j].w * inv, 1.0f, 1);
                pk = __builtin_amdgcn_cvt_scalef32_pk_fp4_f32(pk, a[2 * j + 1].x * inv, a[2 * j + 1].y * inv, 1.0f, 2);
                pk = __builtin_amdgcn_cvt_scalef32_pk_fp4_f32(pk, a[2 * j + 1].z * inv, a[2 * j + 1].w * inv, 1.0f, 3);
                dst[64 * j] = pk; }
            if (F.lane == 0) ((float*)(F.ws + WS_SV))[row] = sc;
        }
    }
}

template <bool SRC_BF16> DI void norm_rows(Frame& F, const float* src_x, const float* src_ctx, int nrows, const float* gain, int shift_off, int scale_off, bf16* dst) {
    const float* MOD = (const float*)(F.ws + WS_MOD);
    const int per = (nrows + F.NGW - 1) / F.NGW, m_lo = F.gw * per, m_hi = min(m_lo + per, nrows);
    f32x4 gs[4], shv[4]; int cb = -1;
    for (int m = m_lo; m < m_hi; ++m) {
        const float* xrow; int b;
        if (m < NTOK) { xrow = src_x + (size_t)m * DM; b = m >> 12; } else { xrow = src_ctx + (size_t)(m - NTOK) * DM; b = 8; }
        f32x4 v[4]; float s = 0.f;
        if (SRC_BF16) { const v2u* xr = (const v2u*)((const bf16*)src_x + (size_t)m * DM) + F.lane;
#pragma unroll
            for (int j = 0; j < 4; ++j) { const v2u w = xr[64 * j]; v[j] = (f32x4){bflo(w.x), bfhi(w.x), bflo(w.y), bfhi(w.y)}; }
        } else { const f32x4* xr = (const f32x4*)xrow + F.lane;
#pragma unroll
            for (int j = 0; j < 4; ++j) v[j] = xr[64 * j]; }
        if (b != cb) { cb = b;
            const f32x4* gp = (const f32x4*)gain + F.lane; const f32x4* shp = (const f32x4*)(MOD + b * NMOD + shift_off) + F.lane; const f32x4* scp = (const f32x4*)(MOD + b * NMOD + scale_off) + F.lane;
#pragma unroll
            for (int j = 0; j < 4; ++j) { gs[j] = gp[64 * j] * (scp[64 * j] + 1.0f); shv[j] = shp[64 * j]; } }
#pragma unroll
        for (int j = 0; j < 4; ++j) s += (v[j].x * v[j].x + v[j].y * v[j].y) + (v[j].z * v[j].z + v[j].w * v[j].w);
        const float rinv = 1.0f / sqrtf(wave_sum(s) * (1.f / DM) + EPS);
        unsigned long long* o8 = (unsigned long long*)(dst + (size_t)m * DM) + F.lane;
#pragma unroll
        for (int j = 0; j < 4; ++j) { const f32x4 y = (v[j] * rinv) * gs[j] + shv[j];
            o8[64 * j] = (unsigned long long)pk2(y.x, y.y) | ((unsigned long long)pk2(y.z, y.w) << 32); }
    }
}

typedef float f32x16 __attribute__((ext_vector_type(16)));
typedef short s16x8 __attribute__((ext_vector_type(8)));
typedef __bf16 bf16x2_t __attribute__((ext_vector_type(2)));
#define MFMA32(a, b, c) __builtin_amdgcn_mfma_f32_32x32x16_bf16((a), (b), (c), 0, 0, 0)
DI unsigned cvtpk(float lo, float hi) { f32x2 v = {lo, hi}; bf16x2_t bb = __builtin_convertvector(v, bf16x2_t); return __builtin_bit_cast(unsigned, bb); }
DI float pairmax(float v) { auto rr = __builtin_amdgcn_permlane32_swap(__float_as_uint(v), __float_as_uint(v), false, false); return fmaxf(__uint_as_float(rr[0]), __uint_as_float(rr[1])); }
constexpr float LOG2E = 1.4426950408889634f, ATT_C2 = 0.125f * LOG2E, ATT_THR = 6.0f;
template <int QMASK, bool LOCAL>
DI void attn_tile(const s16x8 (&kf)[4], const s16x8 (&vf)[4], const LAS s16x8* qfp, f32x16 (&o)[2], float& m, float& l, const LAS float* brow, int djb, int lo) {
    f32x16 s; s16x8 qf[4];
#pragma unroll
    for (int ks = 0; ks < 4; ++ks) qf[ks] = qfp[ks * 64];
#pragma unroll
    for (int i = 0; i < 16; ++i) s[i] = 0.f;
#pragma unroll
    for (int ks = 0; ks < 4; ++ks) s = MFMA32(kf[ks], qf[ks], s);
    float sv[16]; float tmax = -INFINITY;
#pragma unroll
    for (int i = 0; i < 16; ++i) {
        if (!((QMASK >> (i >> 2)) & 1)) { sv[i] = -INFINITY; continue; }
        if (LOCAL) { const int dj = djb + (i & 3) + 8 * (i >> 2); const bool valid = (unsigned)(dj - lo) < 16u;
            const float x = s[i] * ATT_C2 + brow[valid ? dj : 0]; sv[i] = valid ? x : -INFINITY; }
        else sv[i] = s[i] * ATT_C2;
        tmax = fmaxf(tmax, sv[i]);
    }
    tmax = pairmax(tmax);
    if (__any(tmax > m + ATT_THR)) { const float mn = fmaxf(m, tmax), alpha = __builtin_amdgcn_exp2f(m - mn); o[0] *= alpha; o[1] *= alpha; l *= alpha; m = mn; }
    float p[16];
#pragma unroll
    for (int i = 0; i < 16; ++i) { if ((QMASK >> (i >> 2)) & 1) { p[i] = __builtin_amdgcn_exp2f(sv[i] - m); l += p[i]; } else p[i] = 0.f; }
#pragma unroll
    for (int s2 = 0; s2 < 2; ++s2) if (QMASK & (3 << (2 * s2))) {
        v4u pk; pk.x = cvtpk(p[8 * s2], p[8 * s2 + 1]); pk.y = cvtpk(p[8 * s2 + 2], p[8 * s2 + 3]); pk.z = cvtpk(p[8 * s2 + 4], p[8 * s2 + 5]); pk.w = cvtpk(p[8 * s2 + 6], p[8 * s2 + 7]);
        const s16x8 pf = __builtin_bit_cast(s16x8, pk);
        o[0] = MFMA32(vf[s2], pf, o[0]); o[1] = MFMA32(vf[2 + s2], pf, o[1]);
    }
}
DI void attn_mfma(Frame& F) {
    const bf16* QF = (const bf16*)(F.ws + WS_QF); const bf16* KF = (const bf16*)(F.ws + WS_KF); const bf16* VF = (const bf16*)(F.ws + WS_VF);
    bf16* MIX = (bf16*)(F.ws + WS_MIX); const float* rpb = F.in[10];
    LAS float* rp = (LAS float*)(F.lds);
    for (int i = F.tid; i < NHEAD * 15 * 31; i += 512) rp[i] = rpb[i] * LOG2E;
    __syncthreads();
    const int lane = F.lane, hh = lane >> 5, ql = lane & 31;
    int lo[2], djb[2][2];
#pragma unroll
    for (int qb = 0; qb < 2; ++qb) { const int qc = 32 * qb + ql, c0 = min(max(qc - 8, 0), 48); lo[qb] = c0 - qc + 15;
#pragma unroll
        for (int jb = 0; jb < 2; ++jb) djb[qb][jb] = 32 * (jb - qb) + 4 * hh - ql + 15; }
    for (int unit = F.gw; unit < NBATCH * NHEAD * 64; unit += F.NGW) {
        const int r = unit & 63, h = (unit >> 6) & 7, b = unit >> 9, bh = b * 8 + h;
        LAS s16x8* qfl = (LAS s16x8*)(F.lds + 16384 + F.wave * 8192) + lane;
#pragma unroll
        for (int qb = 0; qb < 2; ++qb)
#pragma unroll
            for (int ks = 0; ks < 4; ++ks) qfl[(qb * 4 + ks) * 64] = ((const s16x8*)(QF + (size_t)(bh * 128 + 2 * r + qb) * 2048))[ks * 64 + lane];
        f32x16 o[2][2]; float m[2], l[2];
#pragma unroll
        for (int qb = 0; qb < 2; ++qb) { m[qb] = -1e30f; l[qb] = 0.f;
#pragma unroll
            for (int dt = 0; dt < 2; ++dt)
#pragma unroll
                for (int i = 0; i < 16; ++i) o[qb][dt][i] = 0.f; }
        const int r0 = min(max(r - 4, 0), 56);
        s16x8 kf[4], vf[4], kn[4];
        { const s16x8* kp = (const s16x8*)(KF + (size_t)(bh * 136 + 128) * 2048) + lane;
#pragma unroll
          for (int j = 0; j < 4; ++j) kn[j] = kp[j * 64]; }
#pragma unroll 1
        for (int kb = 0; kb < 8; ++kb) {
            { const s16x8* vp = (const s16x8*)(VF + (size_t)(bh * 136 + 128 + kb) * 2048) + lane;
#pragma unroll
              for (int j = 0; j < 4; ++j) { kf[j] = kn[j]; vf[j] = vp[j * 64]; } }
            { const int nb = (kb < 7) ? bh * 136 + 128 + kb + 1 : bh * 136 + 2 * r0;
              const s16x8* kp = (const s16x8*)(KF + (size_t)nb * 2048) + lane;
#pragma unroll
              for (int j = 0; j < 4; ++j) kn[j] = kp[j * 64]; }
            attn_tile<15, false>(kf, vf, qfl, o[0], m[0], l[0], rp, 0, 0); __builtin_amdgcn_sched_barrier(0);
            attn_tile<15, false>(kf, vf, qfl + 256, o[1], m[1], l[1], rp, 0, 0); __builtin_amdgcn_sched_barrier(0);
        }
#pragma unroll 1
        for (int i = 0; i < 8; ++i) {
            const LAS float* brow = rp + (h * 15 + (r0 + i - r + 7)) * 31;
            { const s16x8* vp = (const s16x8*)(VF + (size_t)(bh * 136 + 2 * (r0 + i)) * 2048) + lane;
#pragma unroll
              for (int j = 0; j < 4; ++j) { kf[j] = kn[j]; vf[j] = vp[j * 64]; } }
            { const int nb = bh * 136 + 2 * (r0 + i) + 1;
              const s16x8* kp = (const s16x8*)(KF + (size_t)nb * 2048) + lane;
#pragma unroll
              for (int j = 0; j < 4; ++j) kn[j] = kp[j * 64]; }
            attn_tile<15, true>(kf, vf, qfl, o[0], m[0], l[0], brow, djb[0][0], lo[0]); __builtin_amdgcn_sched_barrier(0);
            attn_tile<8, true>(kf, vf, qfl + 256, o[1], m[1], l[1], brow, djb[1][0], lo[1]); __builtin_amdgcn_sched_barrier(0);
            { const s16x8* vp = (const s16x8*)(VF + (size_t)(bh * 136 + 2 * (r0 + i) + 1) * 2048) + lane;
#pragma unroll
              for (int j = 0; j < 4; ++j) { kf[j] = kn[j]; vf[j] = vp[j * 64]; } }
            { const int nb = bh * 136 + 2 * (r0 + ((i < 7) ? i + 1 : 0));
              const s16x8* kp = (const s16x8*)(KF + (size_t)nb * 2048) + lane;
#pragma unroll
              for (int j = 0; j < 4; ++j) kn[j] = kp[j * 64]; }
            attn_tile<1, true>(kf, vf, qfl, o[0], m[0], l[0], brow, djb[0][1], lo[0]); __builtin_amdgcn_sched_barrier(0);
            attn_tile<15, true>(kf, vf, qfl + 256, o[1], m[1], l[1], brow, djb[1][1], lo[1]); __builtin_amdgcn_sched_barrier(0);
        }
#pragma unroll
        for (int qb = 0; qb < 2; ++qb) {
            const float lt = l[qb] + __shfl_xor(l[qb], 32), inv = 1.0f / lt;
            bf16* orow = MIX + (size_t)(b * SEQ + r * GRIDW + 32 * qb + ql) * DM + 512 + h * 64 + 4 * hh;
#pragma unroll
            for (int dt = 0; dt < 2; ++dt)
#pragma unroll
                for (int g = 0; g < 4; ++g) { v2u w; w.x = pk2(o[qb][dt][4 * g] * inv, o[qb][dt][4 * g + 1] * inv); w.y = pk2(o[qb][dt][4 * g + 2] * inv, o[qb][dt][4 * g + 3] * inv);
                    *(v2u*)(orow + 32 * dt + 8 * g) = w; }
        }
    }
    __syncthreads();
}
DI void pool_mfma(Frame& F) {
    const bf16* PBF = (const bf16*)(F.ws + WS_PB); bf16* MIX = (bf16*)(F.ws + WS_MIX); const bf16* PW = (const bf16*)(F.ws + WS_POOLW); const float* pool_scale = F.in[9];
    constexpr int RS = 272;
    LAS unsigned char* ptile = F.lds + 32768;
    LAS unsigned char* atile = F.lds + 32768 + 144 * RS;
    const int lane = F.lane, hh = lane >> 5, ql = lane & 31;
    for (int tile = F.vcu; tile < NTOK / 128; tile += F.G) {
        const int tok0 = tile * 128, bstart = tok0 & ~(SEQ - 1);
#pragma unroll 1
        for (int g = 0; g < 4; ++g) {
            for (int it = F.tid; it < 144 * 16; it += 512) { const int rr = it >> 4, ch = it & 15, t = tok0 - 8 + rr;
                v4u v = (v4u){0u, 0u, 0u, 0u};
                if (t >= bstart && t < bstart + SEQ) v = *(const v4u*)(PBF + (size_t)t * 512 + g * 128 + ch * 8);
                *(LAS v4u*)(ptile + rr * RS + ch * 16) = v; }
            __syncthreads();
            { const int cp = F.tid & 63, sg = F.tid >> 6, w = 2 << g, hw = w >> 1;
              const LAS unsigned char* col = ptile + cp * 4;
              float s0 = 0.f, s1 = 0.f;
              const int tl0 = sg * 16;
              for (int rr = tl0 + 8 - hw; rr < tl0 + 8 + hw; ++rr) { const unsigned u = *(const LAS unsigned*)(col + rr * RS); s0 += bflo(u); s1 += bfhi(u); }
#pragma unroll 4
              for (int i = 0; i < 16; ++i) { const int tl = tl0 + i, sp = (tok0 + tl) & (SEQ - 1);
                  const int cnt = min(sp + hw, SEQ) - max(sp - hw, 0); const float inv = 1.0f / (float)cnt;
                  const unsigned self = *(const LAS unsigned*)(col + (tl + 8) * RS);
                  *(LAS unsigned*)(atile + tl * RS + cp * 4) = pk2(s0 * inv - bflo(self), s1 * inv - bfhi(self));
                  const unsigned un = *(const LAS unsigned*)(col + (tl + 8 + hw) * RS), uo = *(const LAS unsigned*)(col + (tl + 8 - hw) * RS);
                  s0 += bflo(un) - bflo(uo); s1 += bfhi(un) - bfhi(uo); } }
            __syncthreads();
            { const int tb = F.wave >> 1, dt0 = (F.wave & 1) * 2;
              f32x16 acc[2];
#pragma unroll
              for (int j = 0; j < 2; ++j)
#pragma unroll
                  for (int i = 0; i < 16; ++i) acc[j][i] = 0.f;
#pragma unroll
              for (int ks = 0; ks < 8; ++ks) {
                  const s16x8 bfr = *(const LAS s16x8*)(atile + (32 * tb + ql) * RS + (16 * ks + 8 * hh) * 2);
#pragma unroll
                  for (int j = 0; j < 2; ++j) { const s16x8 afr = *(const s16x8*)(PW + (size_t)g * 16384 + (32 * (dt0 + j) + ql) * 128 + 16 * ks + 8 * hh);
                      acc[j] = MFMA32(afr, bfr, acc[j]); } }
              bf16* orow = MIX + (size_t)(tok0 + 32 * tb + ql) * DM + g * 128 + 4 * hh;
#pragma unroll
              for (int j = 0; j < 2; ++j)
#pragma unroll
                  for (int q = 0; q < 4; ++q) { const int d = 32 * (dt0 + j) + 8 * q; const f32x4 sc = *(const f32x4*)(pool_scale + g * 128 + d + 4 * hh);
                      v2u wv; wv.x = pk2(acc[j][4 * q] * sc.x, acc[j][4 * q + 1] * sc.y); wv.y = pk2(acc[j][4 * q + 2] * sc.z, acc[j][4 * q + 3] * sc.w);
                      *(v2u*)(orow + d) = wv; } }
            __syncthreads();
        }
    }
}
DI int f2key(float f) { const int b = __float_as_int(f); return b ^ ((b >> 31) & 0x7fffffff); }
DI float key2f(int k) { return __int_as_float(k ^ ((k >> 31) & 0x7fffffff)); }
DI void ce_desc(int& x, int& y) { const int hi = max(x, y), lo = min(x, y); x = hi; y = lo; }
DI void sort16_desc(int (&a)[16]) {
#pragma unroll
    for (int k = 2; k <= 16; k <<= 1)
#pragma unroll
        for (int j = k >> 1; j > 0; j >>= 1)
#pragma unroll
            for (int i = 0; i < 16; ++i) { const int l = i ^ j; if (l > i) { if ((i & k) == 0) ce_desc(a[i], a[l]); else ce_desc(a[l], a[i]); } }
}
DI void merge16_desc(int (&a)[16], const int (&b)[16]) {
#pragma unroll
    for (int i = 0; i < 16; ++i) a[i] = max(a[i], b[15 - i]);
#pragma unroll
    for (int j = 8; j > 0; j >>= 1)
#pragma unroll
        for (int i = 0; i < 16; ++i) if ((i & j) == 0) ce_desc(a[i], a[i + j]);
}
DI void peer_topk_mfma(Frame& F, int tile) {
    const bf16* QP = (const bf16*)(F.ws + WS_ZX); const bf16* KEYF = (const bf16*)(F.ws + WS_KEYS);
    int* EXPERTS = (int*)(F.ws + WS_EXP); float* GATES = (float*)(F.ws + WS_GATE);
    const int lane = F.lane, hh = lane >> 5, ql = lane & 31, tb = F.wave >> 1, p = F.wave & 1;
    const int tokblk = tile * 4 + tb, tok = tokblk * 32 + ql;
#pragma unroll 1
    for (int h = 0; h < 8; ++h) {
        const int hp = 2 * h + p;
        s16x8 qf[8];
#pragma unroll
        for (int ks = 0; ks < 8; ++ks) qf[ks] = ((const s16x8*)(QP + ((size_t)tokblk * 16 + hp) * 4096))[ks * 64 + lane];
        const s16x8* kfp = (const s16x8*)(KEYF + (size_t)hp * 16384) + lane;
        int top[16];
#pragma unroll
        for (int i = 0; i < 16; ++i) top[i] = (int)0x80000000;
#pragma unroll 1
        for (int nt = 0; nt < 4; ++nt) {
            f32x16 acc;
#pragma unroll
            for (int i = 0; i < 16; ++i) acc[i] = 0.f;
#pragma unroll
            for (int ks = 0; ks < 8; ++ks) acc = MFMA32(kfp[(nt * 8 + ks) * 64], qf[ks], acc);
            int a[16];
#pragma unroll
            for (int i = 0; i < 16; ++i) { const int n = 32 * nt + (i & 3) + 8 * (i >> 2) + 4 * hh; a[i] = f2key(__int_as_float((__float_as_int(acc[i]) & ~127) | n)); }
            sort16_desc(a);
            merge16_desc(top, a);
        }
        { int oth[16];
#pragma unroll
          for (int i = 0; i < 16; ++i) oth[i] = __shfl_xor(top[i], 32);
          merge16_desc(top, oth); }
        LAS float* L = (LAS float*)(F.lds) + (h & 1) * 4096 + (tb * 2) * 512;
        if (hh == 0) {
#pragma unroll
            for (int i = 0; i < 16; ++i) L[p * 512 + i * 32 + ql] = key2f(top[i]);
        }
        __syncthreads();
        if (p == 0 && hh == 0) {
            float v0[16], v1[16];
#pragma unroll
            for (int i = 0; i < 16; ++i) { v0[i] = __int_as_float(__float_as_int(L[i * 32 + ql]) & ~127); v1[i] = __int_as_float(__float_as_int(L[512 + i * 32 + ql]) & ~127); }
            int grp[4][16]; int cnt = 0;
#pragma unroll
            for (int g = 0; g < 4; ++g)
#pragma unroll
                for (int i = 0; i < 16; ++i) grp[g][i] = (int)0x80000000;
#pragma unroll
            for (int i = 0; i < 16; ++i)
#pragma unroll
                for (int j = 0; j < 16; ++j) if ((i + 1) * (j + 1) <= 16) {
                    grp[cnt >> 4][cnt & 15] = f2key(__int_as_float((__float_as_int(v0[i] + v1[j]) & ~255) | (i * 16 + j))); ++cnt; }
#pragma unroll
            for (int g = 0; g < 4; ++g) sort16_desc(grp[g]);
            merge16_desc(grp[0], grp[1]); merge16_desc(grp[2], grp[3]); merge16_desc(grp[0], grp[2]);
            float tv[16]; float e[16]; float sum = 0.f; int eid[16];
#pragma unroll
            for (int k = 0; k < 16; ++k) { const int bits = __float_as_int(key2f(grp[0][k])); const int code = bits & 255; tv[k] = __int_as_float(bits & ~255);
                const int n0 = __float_as_int(L[(code >> 4) * 32 + ql]) & 127, n1 = __float_as_int(L[512 + (code & 15) * 32 + ql]) & 127; eid[k] = n0 * 128 + n1; }
#pragma unroll
            for (int k = 0; k < 16; ++k) { e[k] = __expf(tv[k] - tv[0]); sum += e[k]; }
            const float is = 1.0f / sum;
            int* ep = EXPERTS + (size_t)tok * 128 + h * 16; float* gp = GATES + (size_t)tok * 128 + h * 16;
#pragma unroll
            for (int k4 = 0; k4 < 4; ++k4) { *(v4u*)(ep + 4 * k4) = (v4u){(unsigned)eid[4 * k4], (unsigned)eid[4 * k4 + 1], (unsigned)eid[4 * k4 + 2], (unsigned)eid[4 * k4 + 3]};
                *(f32x4*)(gp + 4 * k4) = (f32x4){e[4 * k4] * is, e[4 * k4 + 1] * is, e[4 * k4 + 2] * is, e[4 * k4 + 3] * is}; }
        }
    }
    VM_WAIT(); __syncthreads();
}

DI float gelu_fast(float v) {
    const float av = fabsf(v), t = __builtin_amdgcn_rcpf(av * 0.2316418882f + 1.0f);
    float q = t * 0.5307027145f + (-0.7265760135f); q = q * t + 0.7107068705f; q = q * t + (-0.142248368f); q = q * t + 0.127414796f; q = q * t;
    const float e = __builtin_amdgcn_exp2f((v * v) * (-0.72134752044f));
    const float m = v * (q * e);
    return v < 0.f ? m : v - m;
}
DI float gelu_exact(float a) { return 0.5f * a * (1.0f + erff(a * 0.70710678118654752f)); }

DI void fp8x16_to_f32(const v4u r, float (&f)[16]) {
#pragma unroll
    for (int j = 0; j < 4; ++j) { const f32x2 lo = __builtin_amdgcn_cvt_pk_f32_fp8((int)r[j], false), hi = __builtin_amdgcn_cvt_pk_f32_fp8((int)r[j], true);
        f[4 * j] = lo.x; f[4 * j + 1] = lo.y; f[4 * j + 2] = hi.x; f[4 * j + 3] = hi.y; }
}
template <bool FAKE = false, bool UONLY = false> DI void gather_v4(Frame& F, int tbase) {
    constexpr int NT = 8, NK = 16, N = 1024;
    const bf16* H2 = (const bf16*)(F.ws + WS_HX); const unsigned char* U = F.ws + WS_U; const unsigned char* V = F.ws + WS_V;
    const int* EXPERTS = (const int*)(F.ws + WS_EXP); const float* GATES = (const float*)(F.ws + WS_GATE); const float* MOD = (const float*)(F.ws + WS_MOD);
    const float* SU = (const float*)(F.ws + WS_SU);
    const int lane = F.lane;
    constexpr int EM = FAKE ? FAKE_MASK : 16383;
    int key[NK];
#pragma unroll
    for (int j = 0; j < NT; ++j)
#pragma unroll
        for (int hf = 0; hf < 2; ++hf) { const int k = hf * 64 + lane; key[j * 2 + hf] = (EXPERTS[(size_t)(tbase + j) * 128 + k] << 10) | (j << 7) | k; }
#pragma unroll
    for (int k = 2; k <= N; k <<= 1)
#pragma unroll
        for (int j = k >> 1; j > 0; j >>= 1) {
            if (j < NK) {
#pragma unroll
                for (int r = 0; r < NK; ++r) if ((r & j) == 0) { const bool asc = (((lane * NK + r) & k) == 0); const int x = key[r], y = key[r | j], lo = min(x, y), hi = max(x, y);
                    key[r] = asc ? lo : hi; key[r | j] = asc ? hi : lo; }
            } else {
                const bool asc = (((lane * NK) & k) == 0), lower = ((lane & (j / NK)) == 0), takemin = (asc == lower);
#pragma unroll
                for (int r = 0; r < NK; ++r) { const int o = __shfl_xor(key[r], j / NK); key[r] = takemin ? min(key[r], o) : max(key[r], o); }
            }
        }
    LAS v4u* hL = (LAS v4u*)(F.lds) + F.wave * (NT * 64) + lane;
    LAS int* psL = (LAS int*)(F.lds + 65536) + F.wave * N;
    float hsc[NT];
    {
#pragma unroll
        for (int j = 0; j < NT; ++j) { const v4u a = *((const v4u*)(H2 + (size_t)(tbase + j) * DM + lane * 16)), b = *((const v4u*)(H2 + (size_t)(tbase + j) * DM + lane * 16 + 8));
            float hv[16]; hv[0] = bflo(a.x); hv[1] = bfhi(a.x); hv[2] = bflo(a.y); hv[3] = bfhi(a.y); hv[4] = bflo(a.z); hv[5] = bfhi(a.z); hv[6] = bflo(a.w); hv[7] = bfhi(a.w);
            hv[8] = bflo(b.x); hv[9] = bfhi(b.x); hv[10] = bflo(b.y); hv[11] = bfhi(b.y); hv[12] = bflo(b.z); hv[13] = bfhi(b.z); hv[14] = bflo(b.w); hv[15] = bfhi(b.w);
            float am = 0.f;
#pragma unroll
            for (int i = 0; i < 16; ++i) am = fmaxf(am, fabsf(hv[i]));
#pragma unroll
            for (int o = 1; o < 64; o <<= 1) am = fmaxf(am, __shfl_xor(am, o));
            am = fmaxf(am, 1e-30f); hsc[j] = am * (1.0f / 127.0f);
            const float inv = 127.0f / am;
            v4u hq;
#pragma unroll
            for (int d = 0; d < 4; ++d) { const int q0 = (int)rintf(hv[4 * d] * inv), q1 = (int)rintf(hv[4 * d + 1] * inv), q2 = (int)rintf(hv[4 * d + 2] * inv), q3 = (int)rintf(hv[4 * d + 3] * inv);
                hq[d] = (unsigned)(q0 & 255) | ((unsigned)(q1 & 255) << 8) | ((unsigned)(q2 & 255) << 16) | ((unsigned)(q3 & 255) << 24); }
            hL[j * 64] = hq; }
    }
#define V4_ROW(TBL, par, ln, r) (*((const v4u*)((TBL) + (size_t)((__builtin_amdgcn_readlane(key[(par) * 8 + (r)], (ln)) >> 10) & EM) * 1024) + lane))
    {   v4u ub[4][8];
#pragma unroll
        for (int q = 0; q < 4; ++q)
#pragma unroll
            for (int r = 0; r < 8; ++r) ub[q][r] = V4_ROW(U, q & 1, q >> 1, r);
#pragma unroll 1
        for (int b4 = 0; b4 < 32; ++b4) {
#pragma unroll
            for (int q = 0; q < 4; ++q) {
                const int par = q & 1, ln = 2 * b4 + (q >> 1), lnn = (ln + 2) & 63;
                int p[8]; v4u hsel[8];
#pragma unroll
                for (int r = 0; r < 8; ++r) { hsel[r] = hL[((__builtin_amdgcn_readlane(key[par * 8 + r], ln) >> 7) & 7) * 64]; p[r] = 0; }
#pragma unroll
                for (int qq = 0; qq < 4; ++qq)
#pragma unroll
                    for (int r = 0; r < 8; ++r) p[r] = __builtin_amdgcn_sdot4((int)ub[q][r][qq], (int)hsel[r][qq], p[r], false);
#pragma unroll
                for (int r = 0; r < 8; ++r) ub[q][r] = V4_ROW(U, par, lnn, r);
                int psum;
                { int q4[4];
#pragma unroll
                  for (int i = 0; i < 4; ++i) { auto rr = __builtin_amdgcn_permlane32_swap((unsigned)p[i], (unsigned)p[i + 4], false, false); q4[i] = (int)(rr[0] + rr[1]); }
                  int q2[2];
#pragma unroll
                  for (int i = 0; i < 2; ++i) { auto rr = __builtin_amdgcn_permlane16_swap((unsigned)q4[i], (unsigned)q4[i + 2], false, false); q2[i] = (int)(rr[0] + rr[1]); }
                  const int t0 = q2[0] + __builtin_amdgcn_update_dpp(0, q2[0], 0x128, 0xf, 0xf, false);
                  const int t1 = q2[1] + __builtin_amdgcn_update_dpp(0, q2[1], 0x128, 0xf, 0xf, false);
                  int v = (lane & 8) ? t1 : t0;
                  v += __builtin_amdgcn_update_dpp(0, v, 0x141, 0xf, 0xf, false);
                  v += __builtin_amdgcn_update_dpp(0, v, 0x4e, 0xf, 0xf, false);
                  v += __builtin_amdgcn_update_dpp(0, v, 0xb1, 0xf, 0xf, false);
                  psum = v; }
                if ((lane & 7) == 0) psL[(4 * b4 + q) * 8 + ((lane >> 3) & 7)] = psum;
            }
        }
    }
    if constexpr (!UONLY) {
    float wv[NK];
#pragma unroll
    for (int r = 0; r < NK; ++r) { const int tj = (key[r] >> 7) & 7; float sc = hsc[0];
#pragma unroll
        for (int j = 1; j < NT; ++j) sc = (tj == j) ? hsc[j] : sc;
        const float gate = GATES[(size_t)(tbase + tj) * 128 + (key[r] & 127)], su = SU[(key[r] >> 10) & EM] * sc;
        wv[r] = gate * gelu_fast((float)psL[lane * NK + r] * su); }
    LAS int* lst = (LAS int*)(F.lds) + F.wave * 2048;
    LAS float* lwt = (LAS float*)(lst + 1024);
    { int cnt0 = 0;
#pragma unroll
      for (int r = 0; r < NK; ++r) cnt0 += ((key[r] >> 9) & 1) ^ 1;
      int inc = cnt0;
#pragma unroll
      for (int o = 1; o < 64; o <<= 1) { const int t = __shfl_up(inc, o); if (lane >= o) inc += t; }
      int o0 = inc - cnt0, o1 = lane * NK - o0;
#pragma unroll
      for (int r = 0; r < NK; ++r) { const int g1 = (key[r] >> 9) & 1; const int ent = ((key[r] >> 10) << 2) | ((key[r] >> 7) & 3);
          if (g1) { lst[512 + o1] = ent; lwt[512 + o1] = wv[r]; ++o1; } else { lst[o0] = ent; lwt[o0] = wv[r]; ++o0; } } }
    const float* fg = F.in[17];
#pragma unroll 1
    for (int g = 0; g < 2; ++g) {
        int kg[8];
#pragma unroll
        for (int r = 0; r < 8; ++r) kg[r] = lst[g * 512 + lane * 8 + r];
        float out[4][16];
#pragma unroll
        for (int j = 0; j < 4; ++j)
#pragma unroll
            for (int i = 0; i < 16; ++i) out[j][i] = 0.f;
        v4u vb[2][8];
#pragma unroll
        for (int par = 0; par < 2; ++par)
#pragma unroll
            for (int r = 0; r < 8; ++r) vb[par][r] = *((const v4u*)(V + (size_t)((__builtin_amdgcn_readlane(kg[r], par) >> 2) & EM) * 1024) + lane);
#pragma unroll 1
        for (int b2 = 0; b2 < 32; ++b2) {
#pragma unroll
            for (int par = 0; par < 2; ++par) {
                const int b = 2 * b2 + par, bn = (b + 2 < 64) ? b + 2 : par;
                const f32x4 wa = *(const LAS f32x4*)(lwt + g * 512 + b * 8), wb = *(const LAS f32x4*)(lwt + g * 512 + b * 8 + 4);
#pragma unroll
                for (int r = 0; r < 8; ++r) { const int kk = __builtin_amdgcn_readlane(kg[r], b); const float wr = (r < 4) ? wa[r & 3] : wb[r & 3]; const int tk = kk & 3;
                    float f[16]; fp8x16_to_f32(vb[par][r], f);
#pragma unroll
                    for (int j = 0; j < 4; ++j) if (tk == j) {
#pragma unroll
                        for (int i = 0; i < 16; ++i) out[j][i] += wr * f[i]; } }
#pragma unroll
                for (int r = 0; r < 8; ++r) vb[par][r] = *((const v4u*)(V + (size_t)((__builtin_amdgcn_readlane(kg[r], bn) >> 2) & EM) * 1024) + lane);
            }
        }
#pragma unroll
        for (int j = 0; j < 4; ++j) {
            const int t = tbase + g * 4 + j, bb = t >> 12; const float* g2 = MOD + bb * NMOD + 5 * DM; float* xo = F.out + (size_t)t * DM;
            const bf16* x1r = (const bf16*)(F.ws + WS_X1) + (size_t)t * DM + lane * 16;
            float x2[16]; float ss = 0.f;
#pragma unroll
            for (int hq = 0; hq < 4; ++hq) { const int c = lane * 16 + hq * 4; const v2u xw = *(const v2u*)(x1r + hq * 4); const f32x4 xv = (f32x4){bflo(xw.x), bfhi(xw.x), bflo(xw.y), bfhi(xw.y)}, gv = *(const f32x4*)(g2 + c);
#pragma unroll
                for (int e = 0; e < 4; ++e) { const float y = xv[e] + gv[e] * (out[j][hq * 4 + e] * (1.0f / V_SCALE)); x2[hq * 4 + e] = y; ss += y * y; } }
            const float rinv = 1.0f / sqrtf(wave_sum(ss) * (1.f / DM) + EPS);
#pragma unroll
            for (int hq = 0; hq < 4; ++hq) { const int c = lane * 16 + hq * 4; const f32x4 fv = *(const f32x4*)(fg + c);
                f32x4 y;
#pragma unroll
                for (int e = 0; e < 4; ++e) y[e] = x2[hq * 4 + e] * rinv * fv[e];
                if (!FAKE || rinv == 12345.678f) *(f32x4*)(xo + c) = y; }
        }
    }
    }
}

template <bool FAKE = false> DI void gather_v6(Frame& F, int tbase) {
    constexpr int NT = 8;
    const bf16* H2 = (const bf16*)(F.ws + WS_HX); const unsigned char* U = F.ws + WS_U; const unsigned char* V = F.ws + WS_V;
    const int* EXPERTS = (const int*)(F.ws + WS_EXP); const float* GATES = (const float*)(F.ws + WS_GATE); const float* MOD = (const float*)(F.ws + WS_MOD);
    const float* SU = (const float*)(F.ws + WS_SU);
    const int lane = F.lane;
    constexpr int EM = FAKE ? FAKE_MASK : 16383;
    int key[NT][2];
#pragma unroll
    for (int j = 0; j < NT; ++j) {
#pragma unroll
        for (int r = 0; r < 2; ++r) { const int k = r * 64 + lane; key[j][r] = (EXPERTS[(size_t)(tbase + j) * 128 + k] << 7) | k; }
#pragma unroll
        for (int k = 2; k <= 128; k <<= 1)
#pragma unroll
            for (int jj = k >> 1; jj > 0; jj >>= 1) {
                if (jj < 2) { const bool asc = (((lane * 2) & k) == 0); const int x = key[j][0], y = key[j][1], lo = min(x, y), hi = max(x, y); key[j][0] = asc ? lo : hi; key[j][1] = asc ? hi : lo; }
                else { const bool asc = (((lane * 2) & k) == 0), lower = ((lane & (jj / 2)) == 0), takemin = (asc == lower);
#pragma unroll
                    for (int r = 0; r < 2; ++r) { const int o = __shfl_xor(key[j][r], jj / 2); key[j][r] = takemin ? min(key[j][r], o) : max(key[j][r], o); } }
            }
    }
    LAS int* psL = (LAS int*)(F.lds + 65536) + F.wave * 1024;
    float hsc[NT];
#define V6_ROW(TBL, jj, bb, r) (*((const v4u*)((TBL) + (size_t)((__builtin_amdgcn_readlane(key[jj][(r) & 1], (bb) * 4 + ((r) >> 1)) >> 7) & EM) * 1024) + lane))
    {
        unsigned hsq[NT][4];
#pragma unroll
        for (int j = 0; j < NT; ++j) { const v4u a = *((const v4u*)(H2 + (size_t)(tbase + j) * DM + lane * 16)), b = *((const v4u*)(H2 + (size_t)(tbase + j) * DM + lane * 16 + 8));
            float hv[16]; hv[0] = bflo(a.x); hv[1] = bfhi(a.x); hv[2] = bflo(a.y); hv[3] = bfhi(a.y); hv[4] = bflo(a.z); hv[5] = bfhi(a.z); hv[6] = bflo(a.w); hv[7] = bfhi(a.w);
            hv[8] = bflo(b.x); hv[9] = bfhi(b.x); hv[10] = bflo(b.y); hv[11] = bfhi(b.y); hv[12] = bflo(b.z); hv[13] = bfhi(b.z); hv[14] = bflo(b.w); hv[15] = bfhi(b.w);
            float am = 0.f;
#pragma unroll
            for (int i = 0; i < 16; ++i) am = fmaxf(am, fabsf(hv[i]));
#pragma unroll
            for (int o = 1; o < 64; o <<= 1) am = fmaxf(am, __shfl_xor(am, o));
            am = fmaxf(am, 1e-30f); hsc[j] = am * (1.0f / 127.0f);
            const float inv = 127.0f / am;
#pragma unroll
            for (int d = 0; d < 4; ++d) { const int q0 = (int)rintf(hv[4 * d] * inv), q1 = (int)rintf(hv[4 * d + 1] * inv), q2 = (int)rintf(hv[4 * d + 2] * inv), q3 = (int)rintf(hv[4 * d + 3] * inv);
                hsq[j][d] = (unsigned)(q0 & 255) | ((unsigned)(q1 & 255) << 8) | ((unsigned)(q2 & 255) << 16) | ((unsigned)(q3 & 255) << 24); } }
        v4u ub[4][8];
#pragma unroll
        for (int q = 0; q < 4; ++q)
#pragma unroll
            for (int r = 0; r < 8; ++r) ub[q][r] = V6_ROW(U, q, 0, r);
#pragma unroll 1
        for (int b = 0; b < 16; ++b) {
            const int bnx = (b + 1) & 15;
#pragma unroll
            for (int j = 0; j < NT; ++j) {
                int p[8];
#pragma unroll
                for (int r = 0; r < 8; ++r) p[r] = 0;
#pragma unroll
                for (int q = 0; q < 4; ++q)
#pragma unroll
                    for (int r = 0; r < 8; ++r) p[r] = __builtin_amdgcn_sdot4((int)ub[j & 3][r][q], (int)hsq[j][q], p[r], false);
#pragma unroll
                for (int r = 0; r < 8; ++r) ub[j & 3][r] = V6_ROW(U, (j + 4) & 7, (j < 4) ? b : bnx, r);
                int psum;
                { int q4[4];
#pragma unroll
                  for (int i = 0; i < 4; ++i) { auto rr = __builtin_amdgcn_permlane32_swap((unsigned)p[i], (unsigned)p[i + 4], false, false); q4[i] = (int)(rr[0] + rr[1]); }
                  int q2[2];
#pragma unroll
                  for (int i = 0; i < 2; ++i) { auto rr = __builtin_amdgcn_permlane16_swap((unsigned)q4[i], (unsigned)q4[i + 2], false, false); q2[i] = (int)(rr[0] + rr[1]); }
                  const int t0 = q2[0] + __builtin_amdgcn_update_dpp(0, q2[0], 0x128, 0xf, 0xf, false);
                  const int t1 = q2[1] + __builtin_amdgcn_update_dpp(0, q2[1], 0x128, 0xf, 0xf, false);
                  int v = (lane & 8) ? t1 : t0;
                  v += __builtin_amdgcn_update_dpp(0, v, 0x141, 0xf, 0xf, false);
                  v += __builtin_amdgcn_update_dpp(0, v, 0x4e, 0xf, 0xf, false);
                  v += __builtin_amdgcn_update_dpp(0, v, 0xb1, 0xf, 0xf, false);
                  psum = v; }
                if ((lane & 7) == 0) psL[j * 128 + b * 8 + ((lane >> 3) & 7)] = psum;
            }
        }
    }
    LAS float* wL = (LAS float*)psL;
#pragma unroll
    for (int j = 0; j < NT; ++j)
#pragma unroll
        for (int r = 0; r < 2; ++r) { const float gate = GATES[(size_t)(tbase + j) * 128 + (key[j][r] & 127)], su = SU[(key[j][r] >> 7) & EM] * hsc[j];
            const int ps = psL[j * 128 + lane * 2 + r]; wL[j * 128 + lane * 2 + r] = gate * gelu_fast((float)ps * su); }
    const float* fg = F.in[17];
#pragma unroll
    for (int g = 0; g < 2; ++g) {
        float out[4][16];
#pragma unroll
        for (int j = 0; j < 4; ++j)
#pragma unroll
            for (int i = 0; i < 16; ++i) out[j][i] = 0.f;
        v4u vb[2][8];
#pragma unroll
        for (int q = 0; q < 2; ++q)
#pragma unroll
            for (int r = 0; r < 8; ++r) vb[q][r] = V6_ROW(V, 4 * g + q, 0, r);
#pragma unroll 1
        for (int b = 0; b < 16; ++b) {
            const int bnx = (b + 1) & 15;
#pragma unroll
            for (int jj = 0; jj < 4; ++jj) {
                const int j = 4 * g + jj;
                const f32x4 wa = *(const LAS f32x4*)(wL + j * 128 + b * 8), wb = *(const LAS f32x4*)(wL + j * 128 + b * 8 + 4);
#pragma unroll
                for (int r = 0; r < 8; ++r) { const float wr = (r < 4) ? wa[r & 3] : wb[r & 3];
#pragma unroll
                    for (int q = 0; q < 4; ++q) { const f32x2 lo = __builtin_amdgcn_cvt_pk_f32_fp8((int)vb[jj & 1][r][q], false), hi = __builtin_amdgcn_cvt_pk_f32_fp8((int)vb[jj & 1][r][q], true);
                        out[jj][4 * q] += wr * lo.x; out[jj][4 * q + 1] += wr * lo.y; out[jj][4 * q + 2] += wr * hi.x; out[jj][4 * q + 3] += wr * hi.y; } }
#pragma unroll
                for (int r = 0; r < 8; ++r) vb[jj & 1][r] = V6_ROW(V, 4 * g + ((jj + 2) & 3), (jj < 2) ? b : bnx, r);
            }
        }
#pragma unroll
        for (int jj = 0; jj < 4; ++jj) {
            const int t = tbase + g * 4 + jj, bb = t >> 12; const float* g2 = MOD + bb * NMOD + 5 * DM; float* xo = F.out + (size_t)t * DM;
            const bf16* x1r = (const bf16*)(F.ws + WS_X1) + (size_t)t * DM + lane * 16;
            float x2[16]; float ss = 0.f;
#pragma unroll
            for (int hq = 0; hq < 4; ++hq) { const int c = lane * 16 + hq * 4; const v2u xw = *(const v2u*)(x1r + hq * 4); const f32x4 xv = (f32x4){bflo(xw.x), bfhi(xw.x), bflo(xw.y), bfhi(xw.y)}, gv = *(const f32x4*)(g2 + c);
#pragma unroll
                for (int e = 0; e < 4; ++e) { const float y = xv[e] + gv[e] * (out[jj][hq * 4 + e] * (1.0f / V_SCALE)); x2[hq * 4 + e] = y; ss += y * y; } }
            const float rinv = 1.0f / sqrtf(wave_sum(ss) * (1.f / DM) + EPS);
#pragma unroll
            for (int hq = 0; hq < 4; ++hq) { const int c = lane * 16 + hq * 4; const f32x4 fv = *(const f32x4*)(fg + c);
                f32x4 y;
#pragma unroll
                for (int e = 0; e < 4; ++e) y[e] = x2[hq * 4 + e] * rinv * fv[e];
                if (!FAKE || rinv == 12345.678f) *(f32x4*)(xo + c) = y; }
            asm volatile("" ::: "memory");
        }
    }
#undef V6_ROW
}

typedef _Float16 h2 __attribute__((ext_vector_type(2)));
DI void gather_v7(Frame& F, int tbase) {
    constexpr int NT = 8;
    const bf16* H2 = (const bf16*)(F.ws + WS_HX); const unsigned char* U = F.ws + WS_U; const unsigned char* V = F.ws + WS_V;
    const int* EXPERTS = (const int*)(F.ws + WS_EXP); const float* GATES = (const float*)(F.ws + WS_GATE); const float* MOD = (const float*)(F.ws + WS_MOD);
    const float* SU = (const float*)(F.ws + WS_SU); const float* SV = (const float*)(F.ws + WS_SV);
    const int lane = F.lane, l31 = lane & 31; const unsigned hi01 = (unsigned)lane >> 5, l31x16 = (unsigned)l31 << 4;
    int key[NT][2];
#pragma unroll
    for (int j = 0; j < NT; ++j) {
#pragma unroll
        for (int r = 0; r < 2; ++r) { const int k = r * 64 + lane; key[j][r] = (EXPERTS[(size_t)(tbase + j) * 128 + k] << 7) | k; }
#pragma unroll
        for (int k = 2; k <= 128; k <<= 1)
#pragma unroll
            for (int jj = k >> 1; jj > 0; jj >>= 1) {
                if (jj < 2) { const bool asc = (((lane * 2) & k) == 0); const int x = key[j][0], y = key[j][1], lo = min(x, y), hi = max(x, y); key[j][0] = asc ? lo : hi; key[j][1] = asc ? hi : lo; }
                else { const bool asc = (((lane * 2) & k) == 0), lower = ((lane & (jj / 2)) == 0), takemin = (asc == lower);
#pragma unroll
                    for (int r = 0; r < 2; ++r) { const int o = __shfl_xor(key[j][r], jj / 2); key[j][r] = takemin ? min(key[j][r], o) : max(key[j][r], o); } }
            }
    }
    LAS int* psL = (LAS int*)(F.lds + 65536) + F.wave * 1024;
    float hsc[NT], hoff[NT];
#define V7_E(jj, bb, r) (__builtin_amdgcn_readlane(key[jj][(r) & 1], (bb) * 4 + ((r) >> 1)) >> 7)
#define V7_ROW2(TBL, jj, bb, i) (*(const v4u*)((TBL) + ((size_t)V7_E(jj, bb, i) << 9) + (__umul24(hi01, (unsigned)(V7_E(jj, bb, (i) + 4) - V7_E(jj, bb, i)) << 9) + l31x16)))
    {
        unsigned ha[NT][4], hb[NT][4];
#pragma unroll
        for (int j = 0; j < NT; ++j) { const v4u* hp = (const v4u*)(H2 + (size_t)(tbase + j) * DM + l31 * 32);
            float hv[32];
#pragma unroll
            for (int q = 0; q < 4; ++q) { const v4u a = hp[q]; hv[8 * q] = bflo(a.x); hv[8 * q + 1] = bfhi(a.x); hv[8 * q + 2] = bflo(a.y); hv[8 * q + 3] = bfhi(a.y); hv[8 * q + 4] = bflo(a.z); hv[8 * q + 5] = bfhi(a.z); hv[8 * q + 6] = bflo(a.w); hv[8 * q + 7] = bfhi(a.w); }
            float am = 0.f;
#pragma unroll
            for (int i = 0; i < 32; ++i) am = fmaxf(am, fabsf(hv[i]));
#pragma unroll
            for (int o = 1; o < 32; o <<= 1) am = fmaxf(am, __shfl_xor(am, o));
            am = fmaxf(am, 1e-30f); hsc[j] = am * (1.0f / 119.0f);
            const float inv = 119.0f / am; int hs = 0;
#pragma unroll
            for (int q = 0; q < 4; ++q) { unsigned wa = 0, wb = 0;
#pragma unroll
                for (int i = 0; i < 8; ++i) { const int h = (int)rintf(hv[8 * q + i] * inv), a = (h + 8) >> 4, b = h - 16 * a; hs += h; wa |= (unsigned)(a & 15) << (4 * i); wb |= (unsigned)(b & 15) << (4 * i); }
                ha[j][q] = wa; hb[j][q] = wb; }
#pragma unroll
            for (int o = 1; o < 32; o <<= 1) hs += __shfl_xor(hs, o);
            hoff[j] = 0.5f * (float)hs; }
        v4u ub[4][4];
#pragma unroll
        for (int q = 0; q < 4; ++q)
#pragma unroll
            for (int i = 0; i < 4; ++i) ub[q][i] = V7_ROW2(U, q, 0, i);
#pragma unroll 1
        for (int b = 0; b < 16; ++b) {
            const int bnx = (b + 1) & 15;
#pragma unroll
            for (int j = 0; j < NT; ++j) {
                int pa[4], pb[4];
#pragma unroll
                for (int i = 0; i < 4; ++i) { pa[i] = 0; pb[i] = 0; }
#pragma unroll
                for (int q = 0; q < 4; ++q)
#pragma unroll
                    for (int i = 0; i < 4; ++i) { pa[i] = __builtin_amdgcn_sdot8((int)ub[j & 3][i][q], (int)ha[j][q], pa[i], false); pb[i] = __builtin_amdgcn_sdot8((int)ub[j & 3][i][q], (int)hb[j][q], pb[i], false); }
#pragma unroll
                for (int i = 0; i < 4; ++i) ub[j & 3][i] = V7_ROW2(U, (j + 4) & 7, (j < 4) ? b : bnx, i);
                int psum;
                { int p[4];
#pragma unroll
                  for (int i = 0; i < 4; ++i) p[i] = (pa[i] << 4) + pb[i];
                  int q2[2];
#pragma unroll
                  for (int i = 0; i < 2; ++i) { auto rr = __builtin_amdgcn_permlane16_swap((unsigned)p[i], (unsigned)p[i + 2], false, false); q2[i] = (int)(rr[0] + rr[1]); }
                  const int t0 = q2[0] + __builtin_amdgcn_update_dpp(0, q2[0], 0x128, 0xf, 0xf, false);
                  const int t1 = q2[1] + __builtin_amdgcn_update_dpp(0, q2[1], 0x128, 0xf, 0xf, false);
                  int v = (lane & 8) ? t1 : t0;
                  v += __builtin_amdgcn_update_dpp(0, v, 0x141, 0xf, 0xf, false);
                  v += __builtin_amdgcn_update_dpp(0, v, 0x4e, 0xf, 0xf, false);
                  v += __builtin_amdgcn_update_dpp(0, v, 0xb1, 0xf, 0xf, false);
                  psum = v; }
                if ((lane & 7) == 0) psL[j * 128 + b * 8 + (lane >> 3)] = psum;
            }
        }
    }
    float wmax[NT];
#pragma unroll
    for (int j = 0; j < NT; ++j) { float w[2];
#pragma unroll
        for (int r = 0; r < 2; ++r) { const int e = key[j][r] >> 7; const float gate = GATES[(size_t)(tbase + j) * 128 + (key[j][r] & 127)], su = SU[e] * hsc[j], sv = SV[e];
            const int ps = psL[j * 128 + lane * 2 + r];
#ifdef DBG_UEXACT
            float sd = 0.f; { const float* ur = F.in[15] + (size_t)e * 1024; const bf16* hr = H2 + (size_t)(tbase + j) * DM;
#pragma unroll 8
              for (int d = 0; d < 1024; ++d) sd += ur[d] * __uint_as_float((unsigned)hr[d] << 16); }
            w[r] = gate * gelu_fast(sd) * sv; (void)ps; (void)su; }
#else
            w[r] = gate * gelu_fast(((float)ps + hoff[j]) * su) * sv; }
#endif
        float m = fmaxf(fabsf(w[0]), fabsf(w[1]));
#pragma unroll
        for (int o = 1; o < 64; o <<= 1) m = fmaxf(m, __shfl_xor(m, o));
        m = fmaxf(m, 1e-30f); wmax[j] = m; const float rm = 1.0f / m;
#pragma unroll
        for (int r = 0; r < 2; ++r) { const _Float16 hw = (_Float16)(w[r] * rm); const h2 pw = {hw, hw}; psL[j * 128 + lane * 2 + r] = __builtin_bit_cast(int, pw); } }
    const float* fg = F.in[17];
    const int d0 = l31 * 32 + (int)hi01 * 16;
#pragma unroll
    for (int g = 0; g < 2; ++g) {
        h2 out[4][16];
#pragma unroll
        for (int j = 0; j < 4; ++j)
#pragma unroll
            for (int i = 0; i < 16; ++i) out[j][i] = (h2){(_Float16)0.f, (_Float16)0.f};
        v4u vb[4][4];
#pragma unroll
        for (int q = 0; q < 4; ++q)
#pragma unroll
            for (int i = 0; i < 4; ++i) vb[q][i] = V7_ROW2(V, 4 * g + q, 0, i);
#pragma unroll 1
        for (int b = 0; b < 16; ++b) {
            const int bnx = (b + 1) & 15;
#pragma unroll
            for (int jj = 0; jj < 4; ++jj) {
                const int j = 4 * g + jj;
                const v4u wq = *(const LAS v4u*)(psL + j * 128 + b * 8 + (int)hi01 * 4);
#pragma unroll
                for (int i = 0; i < 4; ++i) { const unsigned wi = wq[i]; const h2 w = __builtin_bit_cast(h2, wi);
#pragma unroll
                    for (int q = 0; q < 4; ++q) {
                        out[jj][4 * q + 0] = __builtin_elementwise_fma(__builtin_bit_cast(h2, __builtin_amdgcn_cvt_scalef32_pk_f16_fp4(vb[jj][i][q], 1.0f, 0)), w, out[jj][4 * q + 0]);
                        out[jj][4 * q + 1] = __builtin_elementwise_fma(__builtin_bit_cast(h2, __builtin_amdgcn_cvt_scalef32_pk_f16_fp4(vb[jj][i][q], 1.0f, 1)), w, out[jj][4 * q + 1]);
                        out[jj][4 * q + 2] = __builtin_elementwise_fma(__builtin_bit_cast(h2, __builtin_amdgcn_cvt_scalef32_pk_f16_fp4(vb[jj][i][q], 1.0f, 2)), w, out[jj][4 * q + 2]);
                        out[jj][4 * q + 3] = __builtin_elementwise_fma(__builtin_bit_cast(h2, __builtin_amdgcn_cvt_scalef32_pk_f16_fp4(vb[jj][i][q], 1.0f, 3)), w, out[jj][4 * q + 3]); } }
#pragma unroll
                for (int i = 0; i < 4; ++i) vb[jj][i] = V7_ROW2(V, j, bnx, i);
            }
        }
#pragma unroll
        for (int jj = 0; jj < 4; ++jj) {
            const int t = tbase + g * 4 + jj, bb = t >> 12; const float* g2 = MOD + bb * NMOD + 5 * DM; float* xo = F.out + (size_t)t * DM;
            const bf16* x1r = (const bf16*)(F.ws + WS_X1) + (size_t)t * DM + d0;
            const float wm = wmax[g * 4 + jj];
            float x2[16]; float ss = 0.f;
            float ov[16];
#pragma unroll
            for (int i = 0; i < 8; ++i) { auto rr = __builtin_amdgcn_permlane32_swap(__builtin_bit_cast(unsigned, out[jj][i]), __builtin_bit_cast(unsigned, out[jj][i + 8]), false, false);
                const unsigned r0 = rr[0], r1 = rr[1]; const h2 sm = __builtin_bit_cast(h2, r0) + __builtin_bit_cast(h2, r1); ov[2 * i] = (float)sm.x * wm; ov[2 * i + 1] = (float)sm.y * wm; }
#pragma unroll
            for (int hq = 0; hq < 4; ++hq) { const int c = d0 + hq * 4; const v2u xw = *(const v2u*)(x1r + hq * 4); const f32x4 xv = (f32x4){bflo(xw.x), bfhi(xw.x), bflo(xw.y), bfhi(xw.y)}, gv = *(const f32x4*)(g2 + c);
#pragma unroll
                for (int e = 0; e < 4; ++e) { const float y = xv[e] + gv[e] * ov[hq * 4 + e]; x2[hq * 4 + e] = y; ss += y * y; } }
            const float rinv = 1.0f / sqrtf(wave_sum(ss) * (1.f / DM) + EPS);
#pragma unroll
            for (int hq = 0; hq < 4; ++hq) { const int c = d0 + hq * 4; const f32x4 fv = *(const f32x4*)(fg + c);
                f32x4 y;
#pragma unroll
                for (int e = 0; e < 4; ++e) y[e] = x2[hq * 4 + e] * rinv * fv[e];
                *(f32x4*)(xo + c) = y; }
            asm volatile("" ::: "memory");
        }
    }
#undef V7_ROW2
#undef V7_E
}

#ifndef PROBE_MODE
#define PROBE_MODE 0
#endif
template <int MODE> DI void probe_sweep(Frame& F, int tbase) {
    constexpr int NT = 8;
    const unsigned char* U = F.ws + WS_U;
    const int* EXPERTS = (const int*)(F.ws + WS_EXP);
    int lane = F.lane; asm volatile("" : "+v"(lane));
    int key[NT][2];
#pragma unroll
    for (int j = 0; j < NT; ++j) {
#pragma unroll
        for (int r = 0; r < 2; ++r) { const int k = r * 64 + lane; key[j][r] = ((EXPERTS[(size_t)(tbase + j) * 128 + k] ^ 0x1555) << 7) | k; }
#pragma unroll
        for (int k = 2; k <= 128; k <<= 1)
#pragma unroll
            for (int jj = k >> 1; jj > 0; jj >>= 1) {
                if (jj < 2) { const bool asc = (((lane * 2) & k) == 0); const int x = key[j][0], y = key[j][1], lo = min(x, y), hi = max(x, y); key[j][0] = asc ? lo : hi; key[j][1] = asc ? hi : lo; }
                else { const bool asc = (((lane * 2) & k) == 0), lower = ((lane & (jj / 2)) == 0), takemin = (asc == lower);
#pragma unroll
                    for (int r = 0; r < 2; ++r) { const int o = __shfl_xor(key[j][r], jj / 2); key[j][r] = takemin ? min(key[j][r], o) : max(key[j][r], o); } }
            }
    }
    LAS int* psL = (LAS int*)(F.lds + 65536) + F.wave * 1024;
    unsigned acc = 0;
#define PR_E(jj, bb, r) ((__builtin_amdgcn_readlane(key[jj][(r) & 1], (bb) * 4 + ((r) >> 1)) >> 7) & 16383)
    if constexpr (MODE == 0) {
#pragma unroll
        for (int j = 0; j < NT; ++j) acc ^= (unsigned)(key[j][0] ^ key[j][1]);
    } else if constexpr (MODE == 1) {
#define PR_ROW(jj, bb, r) (*((const v4u*)(U + (size_t)PR_E(jj, bb, r) * 1024) + lane))
        v4u ub[4][8];
#pragma unroll
        for (int q = 0; q < 4; ++q)
#pragma unroll
            for (int r = 0; r < 8; ++r) ub[q][r] = PR_ROW(q, 0, r);
#pragma unroll 1
        for (int b = 0; b < 16; ++b) { const int bnx = (b + 1) & 15;
#pragma unroll
            for (int j = 0; j < NT; ++j) {
#pragma unroll
                for (int r = 0; r < 8; ++r) acc ^= ub[j & 3][r].x ^ ub[j & 3][r].y ^ ub[j & 3][r].z ^ ub[j & 3][r].w;
#pragma unroll
                for (int r = 0; r < 8; ++r) ub[j & 3][r] = PR_ROW((j + 4) & 7, (j < 4) ? b : bnx, r);
            } }
#undef PR_ROW
    } else if constexpr (MODE == 2) {
#define PR_ROW(jj, bb, i) (*(const v4u*)(U + (unsigned)((((lane < 32) ? PR_E(jj, bb, 2 * (i)) : PR_E(jj, bb, 2 * (i) + 1)) << 10) | ((lane & 31) << 4))))
        v4u ub[4][4];
#pragma unroll
        for (int q = 0; q < 4; ++q)
#pragma unroll
            for (int r = 0; r < 4; ++r) ub[q][r] = PR_ROW(q, 0, r);
#pragma unroll 1
        for (int b = 0; b < 16; ++b) { const int bnx = (b + 1) & 15;
#pragma unroll
            for (int j = 0; j < NT; ++j) {
#pragma unroll
                for (int r = 0; r < 4; ++r) acc ^= ub[j & 3][r].x ^ ub[j & 3][r].y ^ ub[j & 3][r].z ^ ub[j & 3][r].w;
#pragma unroll
                for (int r = 0; r < 4; ++r) ub[j & 3][r] = PR_ROW((j + 4) & 7, (j < 4) ? b : bnx, r);
            } }
#undef PR_ROW
    } else if constexpr (MODE == 3) {
#define PR_ROW(jj, bb, r) (*((const v2u*)(U + (size_t)PR_E(jj, bb, r) * 1024) + lane))
        v2u ub[4][8];
#pragma unroll
        for (int q = 0; q < 4; ++q)
#pragma unroll
            for (int r = 0; r < 8; ++r) ub[q][r] = PR_ROW(q, 0, r);
#pragma unroll 1
        for (int b = 0; b < 16; ++b) { const int bnx = (b + 1) & 15;
#pragma unroll
            for (int j = 0; j < NT; ++j) {
#pragma unroll
                for (int r = 0; r < 8; ++r) acc ^= ub[j & 3][r].x ^ ub[j & 3][r].y;
#pragma unroll
                for (int r = 0; r < 8; ++r) ub[j & 3][r] = PR_ROW((j + 4) & 7, (j < 4) ? b : bnx, r);
            } }
#undef PR_ROW
    }
#undef PR_E
    if (acc == 0x12345678u) psL[lane] = (int)acc;
}

struct Args { const float* in[18]; float* out; unsigned char* ws; int ph_lo, ph_hi, li, pad; };
__global__ void __launch_bounds__(NWAVES * 64, 2) mk_fwd(Args args) {
    extern __shared__ __attribute__((aligned(16))) unsigned char lds[];
    Frame F;
    F.lds = (LAS unsigned char*)lds;
    F.tid = threadIdx.x; F.lane = F.tid & 63; F.wave = __builtin_amdgcn_readfirstlane(F.tid >> 6);
    F.G = gridDim.x; { const int bx = blockIdx.x; F.vcu = (F.G % 8 == 0) ? (bx % 8) * (F.G / 8) + bx / 8 : bx; }
    F.gw = F.vcu * NWAVES + F.wave; F.NGW = F.G * NWAVES;
#pragma unroll
    for (int i = 0; i < 18; ++i) F.in[i] = args.in[i];
    F.out = args.out; F.ws = args.ws;
    volatile LAS unsigned* MISC = (volatile LAS unsigned*)(F.lds + MISC_OFF);
    for (int u = F.tid; u < (LDS_BYTES - LDSCTL_OFF) / 4; u += NWAVES * 64) ((LAS unsigned*)(F.lds + LDSCTL_OFF))[u] = 0u;
    __syncthreads();
    gu32* ctl = (gu32*)(F.ws + WS_CTL);
    XcdBarrier bar; bar.bar = (unsigned*)(ctl + CW_BAR) + args.li * XCD_BAR_WORDS; bar.x = 0; bar.st = nullptr;
    const int lo = args.ph_lo, hi = args.ph_hi;
    if (hi - lo > 1) bar = xcd_barrier_post((unsigned*)(ctl + CW_BAR) + args.li * XCD_BAR_WORDS, MISC + 8);
#ifndef PROBE_MASK
#define PROBE_MASK 0
#endif
#define REP(k) for (int rep_ = 0; rep_ < 1 + ((PROBE_MASK >> (k)) & 1); ++rep_)
#define IN(k) (lo <= (k) && (k) < hi)
#ifndef PROBE_SEAMS
#define PROBE_SEAMS 1
#endif
#define SEAM(k) do { if (IN(k) && IN((k) + 1)) for (int s_ = 0; s_ < PROBE_SEAMS; ++s_) xcd_barrier(bar); } while (0)

    if (IN(0)) { REP(0) { p0_prologue(F); __syncthreads(); } SEAM(0); }
    if (IN(1)) { REP(1) norm_rows<false>(F, F.in[0], F.in[2], MROWS, F.in[6], 0, DM, (bf16*)(F.ws + WS_HX)); SEAM(1); }
    if (IN(2)) {
        pg8::Gemm g{(const bf16*)(F.ws + WS_HX), (const bf16*)(F.ws + WS_WIN), MROWS, DIN, DM}; pg8::InProjOrder S; S.init(F.G, (int)blockIdx.x);
        pg8::EpiInProj E{(bf16*)(F.ws + WS_PB), (bf16*)(F.ws + WS_QF), (bf16*)(F.ws + WS_KF), (bf16*)(F.ws + WS_VF)};
        REP(2) pg8::gemm_phase<pg8::EpiInProj, pg8::InProjOrder, true, true>(F.lds + RING_OFF, g, S, E);
        SEAM(2);
    }
    if (IN(3)) { REP(3) attn_mfma(F); REP(9) pool_mfma(F); SEAM(3); }
    if (IN(4)) {
        pg8::Gemm g{(const bf16*)(F.ws + WS_MIX), (const bf16*)(F.ws + WS_WOUT), NTOK, DM, DM}; pg8::StaticOrder S; S.init(NTOK, DM, F.G, (int)blockIdx.x);
        pg8::EpiX1 E{F.in[0], (const float*)(F.ws + WS_MOD), (bf16*)(F.ws + WS_X1)};
        REP(4) pg8::gemm_phase<pg8::EpiX1, pg8::StaticOrder, true, true>(F.lds + RING_OFF, g, S, E);
        SEAM(4);
    }
    if (IN(5)) { REP(5) norm_rows<true>(F, (const float*)(F.ws + WS_X1), nullptr, NTOK, F.in[12], 3 * DM, 4 * DM, (bf16*)(F.ws + WS_HX)); SEAM(5); }
    if (IN(6)) {
        pg8::Gemm g{(const bf16*)(F.ws + WS_HX), (const bf16*)(F.ws + WS_WQ), NTOK, 2048, DM}; pg8::StaticOrder S; S.init(NTOK, 2048, F.G, (int)blockIdx.x);
        pg8::EpiQP E{(bf16*)(F.ws + WS_ZX)};
        REP(6) pg8::gemm_phase<pg8::EpiQP, pg8::StaticOrder, true, true>(F.lds + RING_OFF, g, S, E);
        SEAM(6);
    }
    if (IN(7)) {
        for (int tile = F.vcu; tile < NTOK / 128; tile += F.G) {
            const int tok0 = tile * 128;
            REP(7) peer_topk_mfma(F, tile);
            if ((PROBE_MASK >> 10) & 1) for (int rd = 0; rd < 2; ++rd) gather_v4<false>(F, tok0 + rd * 64 + F.wave * 8);
            for (int rd = 0; rd < 2; ++rd) gather_v7(F, tok0 + rd * 64 + F.wave * 8);
        }
        if ((PROBE_MASK >> 11) & 1) { __syncthreads(); for (int tile = F.vcu; tile < NTOK / 128; tile += F.G) for (int rd = 0; rd < 2; ++rd) probe_sweep<PROBE_MODE>(F, tile * 128 + rd * 64 + F.wave * 8); }
    }
#undef IN
#undef SEAM
}

extern "C" void kernel_launch(void* const* d_in, const int* in_sizes, int n_in, void* d_out, int out_size, void* d_ws, size_t ws_size, hipStream_t stream) {
    static int grid = 0;
    if (grid == 0) {
        if (n_in != 18 || in_sizes[0] != NTOK * DM || out_size != NTOK * DM || ws_size < WS_END) { fprintf(stderr, "kernel_launch: unexpected shapes / workspace (n_in %d, ws %zu); nothing launched\n", n_in, ws_size); grid = -1; return; }
        int dev = 0, cus = 0;
        if (hipGetDevice(&dev) != hipSuccess || hipDeviceGetAttribute(&cus, hipDeviceAttributeMultiprocessorCount, dev) != hipSuccess) { grid = -1; return; }
        if (hipFuncSetAttribute((const void*)mk_fwd, hipFuncAttributeMaxDynamicSharedMemorySize, LDS_BYTES) != hipSuccess) { fprintf(stderr, "kernel_launch: hipFuncSetAttribute failed\n"); grid = -1; return; }
        int per_cu = 0;
        if (hipOccupancyMaxActiveBlocksPerMultiprocessor(&per_cu, (const void*)mk_fwd, NWAVES * 64, LDS_BYTES) != hipSuccess || per_cu < 1) fprintf(stderr, "kernel_launch: note: occupancy query reports %d blocks per CU\n", per_cu);
        (void)hipGetLastError();
        grid = cus;
    }
    if (grid < 0) return;
    (void)hipMemsetAsync((char*)d_ws + WS_CTL, 0, CTL_ZERO_BYTES, stream);
    Args a{};
    for (int i = 0; i < 18; ++i) a.in[i] = (const float*)d_in[i];
    a.out = (float*)d_out; a.ws = (unsigned char*)d_ws;
    for (int li = 0; li < N_LAUNCHES; ++li) {
        if (N_LAUNCHES == 1) { a.ph_lo = 0; a.ph_hi = NPHASE; } else { a.ph_lo = li; a.ph_hi = li + 1; }
        a.li = (N_LAUNCHES == 1) ? 0 : 0;
        hipLaunchKernelGGL(mk_fwd, dim3(grid), dim3(NWAVES * 64), LDS_BYTES, stream, a);
    }
}
```

```cpp
#include <hip/hip_runtime.h>
#include <cstdio>
#include <cstdint>
#include <type_traits>
namespace pg8 {
#define PG8_LAS __attribute__((address_space(3)))
typedef unsigned short bf16_t;
typedef short bf16x8 __attribute__((ext_vector_type(8)));
typedef float f32x4 __attribute__((ext_vector_type(4)));
typedef unsigned u32x4 __attribute__((ext_vector_type(4)));
constexpr int BM = 256, BK = 64, HALF = 128, HTB = HALF * BK * 2  , STAGE_BYTES = 8 * HTB, NXCD = 8, WGM = 8;

__host__ __device__ __forceinline__ int lds_byte(int r, int c) { const int st = (r >> 4) * 2 + (c >> 5), rr = r & 15, cc = c & 31, ob = rr * 64 + cc * 2; return st * 1024 + (ob ^ (((ob >> 9) & 1) << 5)); }
__host__ __device__ __forceinline__ void stage_rc(int b, int& R, int& C) { const int st = b / 1024, sb = b % 1024, swz = sb ^ (((sb >> 9) & 1) << 5); R = (st >> 1) * 16 + swz / 64; C = (st & 1) * 32 + (swz % 64) / 2; }
__host__ __device__ __forceinline__ int perm32(int rho) { const int n = rho >> 4, i = rho & 15; return 8 * (i >> 2) + 4 * n + (i & 3); }

struct Unit { int pm, pn; };
struct Gemm { const bf16_t* A; const bf16_t* Bt; int M, N, K; };
struct StaticOrder {
    int nM, nN, nwg, G, c;
    __host__ __device__ void init(int M, int N, int G_, int c_) { nM = M / BM; nN = N / BM; nwg = nM * nN; G = G_; c = c_; }
    __host__ __device__ bool next(int i, Unit& u) const {
        const long L = (long)i * G + c; if (L >= nwg) return false;
        int wgid = (int)L; { const int q = nwg / NXCD, r = nwg % NXCD, xcd = wgid % NXCD, off = wgid / NXCD; wgid = (xcd < r ? xcd * (q + 1) : r * (q + 1) + (xcd - r) * q) + off; }
        const int nig = WGM * nN, gid = wgid / nig, fm = gid * WGM, gsz = (nM - fm) < WGM ? (nM - fm) : WGM;
        u.pm = fm + ((wgid % nig) % gsz); u.pn = (wgid % nig) / gsz; return true;
    }
    __device__ __forceinline__ void a_ready(const Unit&) const {}
    __device__ __forceinline__ void done(const Unit&) const {}
    __device__ __forceinline__ const char* pa(const Gemm& g, const Unit& u) const { return (const char*)g.A + (size_t)u.pm * ((size_t)BM * g.K * 2); }
    __device__ __forceinline__ const char* pb(const Gemm& g, const Unit& u) const { return (const char*)g.Bt + (size_t)u.pn * ((size_t)BM * g.K * 2); }
};
struct BatchBOrder {
    StaticOrder so; size_t bstride;
    __host__ __device__ void init(int M, int N, int G_, int c_, size_t bstride_) { so.init(M, N, G_, c_); bstride = bstride_; }
    __host__ __device__ bool next(int i, Unit& u) const { return so.next(i, u); }
    __device__ __forceinline__ void a_ready(const Unit&) const {}
    __device__ __forceinline__ void done(const Unit&) const {}
    __device__ __forceinline__ const char* pa(const Gemm& g, const Unit& u) const { return so.pa(g, u); }
    __device__ __forceinline__ const char* pb(const Gemm& g, const Unit& u) const { return so.pb(g, u) + (size_t)((u.pm * BM) >> 12) * bstride; }
};
struct InProjOrder {
    StaticOrder so;
    __host__ __device__ void init(int G_, int c_) { so.init(136 * BM, 8 * BM, G_, c_); }
    __host__ __device__ bool next(int i, Unit& u) const { int cnt = -1; for (int j = 0; ; ++j) { if (!so.next(j, u)) return false; if (!(u.pm >= 128 && u.pn < 4)) { if (++cnt == i) return true; } } }
    __device__ __forceinline__ void a_ready(const Unit&) const {}
    __device__ __forceinline__ void done(const Unit&) const {}
    __device__ __forceinline__ const char* pa(const Gemm& g, const Unit& u) const { return u.pn < 6 ? (const char*)g.A + (size_t)u.pm * ((size_t)BM * g.K * 2) : (const char*)g.Bt + (size_t)u.pn * ((size_t)BM * g.K * 2); }
    __device__ __forceinline__ const char* pb(const Gemm& g, const Unit& u) const { return u.pn < 6 ? (const char*)g.Bt + (size_t)u.pn * ((size_t)BM * g.K * 2) : (const char*)g.A + (size_t)u.pm * ((size_t)BM * g.K * 2); }
};

__device__ __forceinline__ unsigned cvt_pk_bf16(float lo, float hi) { unsigned r; asm volatile("v_cvt_pk_bf16_f32 %0, %1, %2" : "=v"(r) : "v"(lo), "v"(hi)); return r; }
struct EpiBf16 {
    static constexpr bool PERM = true, AFTER_DRAIN = false;
    bf16_t* O; int ldc;
    __device__ __forceinline__ void operator()(const f32x4 (&acc)[2][2][4][2], const Unit& u, int wr, int wc, int fr, int fq) const {
        const int row0 = u.pm * BM + wr * 64 + fr, col0 = u.pn * BM + wc * 32 + 8 * fq;
#pragma unroll
        for (int ai = 0; ai < 2; ++ai)
#pragma unroll
            for (int m = 0; m < 4; ++m) { bf16_t* rowp = O + (size_t)(row0 + ai * HALF + m * 16) * ldc + col0;
#pragma unroll
                for (int bj = 0; bj < 2; ++bj) { const f32x4 v0 = acc[ai][bj][m][0], v1 = acc[ai][bj][m][1];
                    u32x4 w; w.x = cvt_pk_bf16(v0[0], v0[1]); w.y = cvt_pk_bf16(v0[2], v0[3]); w.z = cvt_pk_bf16(v1[0], v1[1]); w.w = cvt_pk_bf16(v1[2], v1[3]);
                    *(u32x4*)(rowp + bj * HALF) = w; } }
    }
};
struct EpiX1 {
    static constexpr bool PERM = true, AFTER_DRAIN = false;
    const float* x; const float* mod; bf16_t* out; unsigned* rss;
    __device__ __forceinline__ void operator()(const f32x4 (&acc)[2][2][4][2], const Unit& u, int wr, int wc, int fr, int fq) const {
        const int row0 = u.pm * BM + wr * 64 + fr, col0 = u.pn * BM + wc * 32 + 8 * fq;
        const float* g1 = mod + (size_t)((u.pm * BM) >> 12) * 6144 + 2048 + col0;
        f32x4 gv[2][2];
#pragma unroll
        for (int bj = 0; bj < 2; ++bj)
#pragma unroll
            for (int n = 0; n < 2; ++n) gv[bj][n] = *(const f32x4*)(g1 + bj * HALF + 4 * n);
#pragma unroll
        for (int ai = 0; ai < 2; ++ai) {
            f32x4 xv[4][2][2];
#pragma unroll
            for (int m = 0; m < 4; ++m)
#pragma unroll
                for (int bj = 0; bj < 2; ++bj) { const size_t off = (size_t)(row0 + ai * HALF + m * 16) * 1024 + col0 + bj * HALF; xv[m][bj][0] = *(const f32x4*)(x + off); xv[m][bj][1] = *(const f32x4*)(x + off + 4); }
            __builtin_amdgcn_sched_barrier(0);
#pragma unroll
            for (int m = 0; m < 4; ++m) { const int row = row0 + ai * HALF + m * 16; const size_t off = (size_t)row * 1024 + col0; float ss = 0.f;
#pragma unroll
                for (int bj = 0; bj < 2; ++bj) {
                    const f32x4 v0 = xv[m][bj][0] + gv[bj][0] * acc[ai][bj][m][0], v1 = xv[m][bj][1] + gv[bj][1] * acc[ai][bj][m][1];
                    ss += (v0[0] * v0[0] + v0[1] * v0[1]) + (v0[2] * v0[2] + v0[3] * v0[3]) + (v1[0] * v1[0] + v1[1] * v1[1]) + (v1[2] * v1[2] + v1[3] * v1[3]);
                    u32x4 w; w.x = cvt_pk_bf16(v0[0], v0[1]); w.y = cvt_pk_bf16(v0[2], v0[3]); w.z = cvt_pk_bf16(v1[0], v1[1]); w.w = cvt_pk_bf16(v1[2], v1[3]);
                    *(u32x4*)(out + off + bj * HALF) = w; }
                { auto r16 = __builtin_amdgcn_permlane16_swap(__builtin_bit_cast(unsigned, ss), __builtin_bit_cast(unsigned, ss), false, false); const unsigned a0 = r16[0], a1 = r16[1];
                  ss = __builtin_bit_cast(float, a0) + __builtin_bit_cast(float, a1);
                  auto r32 = __builtin_amdgcn_permlane32_swap(__builtin_bit_cast(unsigned, ss), __builtin_bit_cast(unsigned, ss), false, false); const unsigned b0 = r32[0], b1 = r32[1];
                  ss = __builtin_bit_cast(float, b0) + __builtin_bit_cast(float, b1); }
                if (fq == 0) atomicAdd(rss + row, (unsigned)(ss * 64.0f + 0.5f)); }
            __builtin_amdgcn_sched_barrier(0);
        }
    }
};

struct EpiInProj {
    static constexpr bool PERM = true, AFTER_DRAIN = false;
    bf16_t *PB, *QF, *KF, *VF;
    __device__ __forceinline__ void operator()(const f32x4 (&acc)[2][2][4][2], const Unit& u, int wr, int wc, int fr, int fq) const {
        if (u.pn < 6) {
            const int sec = u.pn >> 1, cbase = (u.pn & 1) * 256 + wc * 32 + 8 * fq;
#pragma unroll
            for (int ai = 0; ai < 2; ++ai)
#pragma unroll
                for (int m = 0; m < 4; ++m) { const int T = u.pm * BM + ai * HALF + wr * 64 + m * 16 + fr;
                    int bb, blk; if (T < 32768) { bb = T >> 12; blk = (T & 4095) >> 5; } else { const int cc = T - 32768; bb = cc >> 8; blk = 128 + ((cc & 255) >> 5); }
                    const int tl = T & 31;
#pragma unroll
                    for (int bj = 0; bj < 2; ++bj) { const int c = cbase + HALF * bj; const f32x4 v0 = acc[ai][bj][m][0], v1 = acc[ai][bj][m][1];
                        u32x4 w; w.x = cvt_pk_bf16(v0[0], v0[1]); w.y = cvt_pk_bf16(v0[2], v0[3]); w.z = cvt_pk_bf16(v1[0], v1[1]); w.w = cvt_pk_bf16(v1[2], v1[3]);
                        if (sec == 0) *(u32x4*)(PB + (size_t)T * 512 + c) = w;
                        else { const int h = c >> 6, d0 = c & 63, fo = ((d0 >> 4) * 64 + ((d0 >> 3) & 1) * 32 + tl) * 8;
                            bf16_t* dst = (sec == 1) ? QF + (size_t)((bb * 8 + h) * 128 + blk) * 2048 + fo : KF + (size_t)((bb * 8 + h) * 136 + blk) * 2048 + fo;
                            *(u32x4*)dst = w; } } }
        } else {
            typedef unsigned u32x2 __attribute__((ext_vector_type(2)));
#pragma unroll
            for (int ai = 0; ai < 2; ++ai)
#pragma unroll
                for (int m = 0; m < 4; ++m) { const int vc = (u.pn - 6) * BM + ai * HALF + wr * 64 + m * 16 + fr, h = vc >> 6, dt = (vc >> 5) & 1, dl = vc & 31;
#pragma unroll
                    for (int bj = 0; bj < 2; ++bj) { const int T0 = u.pm * BM + bj * HALF + wc * 32 + 8 * fq;
                        int bb, blk; if (T0 < 32768) { bb = T0 >> 12; blk = (T0 & 4095) >> 5; } else { const int cc = T0 - 32768; bb = cc >> 8; blk = 128 + ((cc & 255) >> 5); }
                        bf16_t* base = VF + ((size_t)(((bb * 8 + h) * 136 + blk) * 2 + dt) * 2 + (fq >> 1)) * 512 + 4 * (fq & 1);
                        const f32x4 v0 = acc[ai][bj][m][0], v1 = acc[ai][bj][m][1];
                        u32x2 w0, w1; w0.x = cvt_pk_bf16(v0[0], v0[1]); w0.y = cvt_pk_bf16(v0[2], v0[3]); w1.x = cvt_pk_bf16(v1[0], v1[1]); w1.y = cvt_pk_bf16(v1[2], v1[3]);
                        *(u32x2*)(base + dl * 8) = w0; *(u32x2*)(base + (32 + dl) * 8) = w1; } }
        }
    }
};

struct EpiQP {
    static constexpr bool PERM = true, AFTER_DRAIN = false;
    bf16_t* QP; const unsigned* rss; const float* c2;
    __device__ __forceinline__ void operator()(const f32x4 (&acc)[2][2][4][2], const Unit& u, int wr, int wc, int fr, int fq) const {
        const float* cp = c2 + (size_t)((u.pm * BM) >> 12) * 2048 + u.pn * BM + wc * 32 + 8 * fq;
        f32x4 cv[2][2];
#pragma unroll
        for (int bj = 0; bj < 2; ++bj)
#pragma unroll
            for (int n = 0; n < 2; ++n) cv[bj][n] = *(const f32x4*)(cp + bj * HALF + 4 * n);
        unsigned rq[2][4];
#pragma unroll
        for (int ai = 0; ai < 2; ++ai)
#pragma unroll
            for (int m = 0; m < 4; ++m) rq[ai][m] = rss[u.pm * BM + ai * HALF + wr * 64 + m * 16 + fr];
        __builtin_amdgcn_sched_barrier(0);
#pragma unroll
        for (int ai = 0; ai < 2; ++ai)
#pragma unroll
            for (int m = 0; m < 4; ++m) { const int T = u.pm * BM + ai * HALF + wr * 64 + m * 16 + fr; const float rinv = 1.0f / sqrtf((float)rq[ai][m] * (1.0f / (1024.0f * 64.0f)) + 1e-6f);
#pragma unroll
                for (int bj = 0; bj < 2; ++bj) { const int hp = 2 * u.pn + bj, ks = 2 * wc + (fq >> 1), hh = fq & 1;
                    const f32x4 v0 = acc[ai][bj][m][0] * rinv + cv[bj][0], v1 = acc[ai][bj][m][1] * rinv + cv[bj][1];
                    u32x4 w; w.x = cvt_pk_bf16(v0[0], v0[1]); w.y = cvt_pk_bf16(v0[2], v0[3]); w.z = cvt_pk_bf16(v1[0], v1[1]); w.w = cvt_pk_bf16(v1[2], v1[3]);
                    *(u32x4*)(QP + ((size_t)(T >> 5) * 16 + hp) * 4096 + (ks * 64 + hh * 32 + (T & 31)) * 8) = w; } }
    }
};
template <class Epi, class Sched, bool ALIGN_EPI = false, bool SP2 = false>
__device__ __forceinline__ void gemm_phase(PG8_LAS unsigned char* lds, const Gemm g, const Sched& S, const Epi& E) {
    const int tid = threadIdx.x, wid = __builtin_amdgcn_readfirstlane(tid >> 6), lane = tid & 63, wr = wid >> 2, wc = wid & 3, fr = lane & 15, fq = lane >> 4;
    const int K = g.K, nt = K / BK;
    unsigned voffA[2], voffB[2];
#pragma unroll
    for (int i = 0; i < 2; ++i) { int R, C; stage_rc(tid * 16 + i * 8192, R, C); const int Rb = Epi::PERM ? ((R & ~31) + perm32(R & 31)) : R;
        voffA[i] = (unsigned)(R * K + C) * 2u; voffB[i] = (unsigned)(Rb * K + C) * 2u; }
    const size_t kstep = (size_t)(BK * 2);
    const size_t hstep = (size_t)HALF * K * 2;
    const size_t tstep = 2 * hstep;
    const unsigned ldsw = (unsigned)wid * 1024u;
    const int aoff = lds_byte(wr * 64 + fr, fq * 8), boff = lds_byte(wc * 32 + fr, fq * 8);
#define PG8_SA(b, h) (((b) * 2 + (h)) * HTB)
#define PG8_SB(b, h) ((4 + (b) * 2 + (h)) * HTB)
#define PG8_STAGE(bufoff, gbase, voff) do { _Pragma("unroll") for (int _i = 0; _i < 2; ++_i) \
        __builtin_amdgcn_global_load_lds((const unsigned*)((const char*)(gbase) + (voff)[_i]), (PG8_LAS unsigned*)(lds + (bufoff) + ldsw + _i * 8192), 16, 0, 0); } while (0)
#define PG8_LDA(dst, b, h) do { _Pragma("unroll") for (int m = 0; m < 4; ++m) _Pragma("unroll") for (int k = 0; k < 2; ++k) dst[m][k] = *(const PG8_LAS bf16x8*)(lds + PG8_SA(b, h) + aoff + m * 2048 + k * 1024); } while (0)
#define PG8_LDB(dst, b, h) do { _Pragma("unroll") for (int n = 0; n < 2; ++n) _Pragma("unroll") for (int k = 0; k < 2; ++k) dst[n][k] = *(const PG8_LAS bf16x8*)(lds + PG8_SB(b, h) + boff + n * 2048 + k * 1024); } while (0)
#define PG8_MMA(ai, bj, At, Bt) do { __builtin_amdgcn_s_setprio(1); _Pragma("unroll") for (int m = 0; m < 4; ++m) _Pragma("unroll") for (int n = 0; n < 2; ++n) _Pragma("unroll") for (int k = 0; k < 2; ++k) \
        acc[ai][bj][m][n] = __builtin_amdgcn_mfma_f32_16x16x32_bf16(Bt[n][k], At[m][k], acc[ai][bj][m][n], 0, 0, 0); __builtin_amdgcn_s_setprio(0); } while (0)
#define PG8_WAIT_V(n) asm volatile("s_waitcnt vmcnt(" #n ")" ::: "memory")
#define PG8_WAIT_L(n) asm volatile("s_waitcnt lgkmcnt(" #n ")" ::: "memory")
#define PG8_BAR __builtin_amdgcn_s_barrier()
#define PG8_SCHED __builtin_amdgcn_sched_barrier(0)
    Unit cur, nxt; int ui = 0;
    if (!S.next(0, cur)) return;
    f32x4 acc[2][2][4][2];
#pragma unroll
    for (int a = 0; a < 2; ++a)
#pragma unroll
        for (int b = 0; b < 2; ++b)
#pragma unroll
            for (int m = 0; m < 4; ++m)
#pragma unroll
                for (int n = 0; n < 2; ++n) acc[a][b][m][n] = (f32x4){0.f, 0.f, 0.f, 0.f};
    bf16x8 At[4][2], B0[2][2], B1[2][2];
    const char* cA = S.pa(g, cur); const char* cB = S.pb(g, cur);
    S.a_ready(cur);
    if constexpr (SP2) {
        PG8_STAGE(PG8_SB(0, 0), cB, voffB); PG8_STAGE(PG8_SB(0, 1), cB + hstep, voffB); PG8_STAGE(PG8_SA(0, 0), cA, voffA); PG8_STAGE(PG8_SA(0, 1), cA + hstep, voffA);
        if (wr == 1) PG8_BAR;
        PG8_WAIT_V(2); PG8_BAR;
        PG8_STAGE(PG8_SB(1, 0), cB + kstep, voffB); PG8_STAGE(PG8_SA(1, 0), cA + kstep, voffA); PG8_STAGE(PG8_SB(1, 1), cB + hstep + kstep, voffB);
        PG8_WAIT_V(6); PG8_BAR;
    } else {
        PG8_STAGE(PG8_SB(0, 0), cB, voffB); PG8_STAGE(PG8_SA(0, 0), cA, voffA); PG8_STAGE(PG8_SB(0, 1), cB + hstep, voffB); PG8_STAGE(PG8_SA(0, 1), cA + hstep, voffA);
        if (wr == 1) PG8_BAR;
        PG8_WAIT_V(4); PG8_BAR;
        PG8_STAGE(PG8_SB(1, 0), cB + kstep, voffB); PG8_STAGE(PG8_SA(1, 0), cA + kstep, voffA); PG8_STAGE(PG8_SB(1, 1), cB + hstep + kstep, voffB);
        PG8_WAIT_V(6); PG8_BAR;
    }
    for (;;) {
        const bool has_next = S.next(ui + 1, nxt);
        const char* nA = has_next ? S.pa(g, nxt) : cA; const char* nB = has_next ? S.pb(g, nxt) : cB;
        for (int t = 0; t < nt; t += 2) {
            const bool last = (t == nt - 2);
            const char* a1 = cA + (size_t)(t + 1) * kstep;
            const char* a2 = last ? nA : cA + (size_t)(t + 2) * kstep; const char* b2 = last ? nB : cB + (size_t)(t + 2) * kstep;
            const char* a3 = a2 + kstep; const char* b3 = b2 + kstep;
            if (last && has_next) S.a_ready(nxt);
            if constexpr (SP2) {
            PG8_LDB(B0, 0, 0); PG8_LDB(B1, 0, 1); PG8_SCHED; PG8_LDA(At, 0, 0); PG8_STAGE(PG8_SA(1, 1), a1 + hstep, voffA);
            PG8_WAIT_V(8); PG8_WAIT_L(0); PG8_BAR; PG8_MMA(0, 0, At, B0); PG8_MMA(0, 1, At, B1); PG8_BAR; PG8_SCHED;
            PG8_LDA(At, 0, 1); PG8_STAGE(PG8_SB(0, 0), b2, voffB); PG8_STAGE(PG8_SB(0, 1), b2 + hstep, voffB); PG8_STAGE(PG8_SA(0, 0), a2, voffA);
            PG8_WAIT_V(8); PG8_WAIT_L(0); PG8_BAR; PG8_MMA(1, 0, At, B0); PG8_MMA(1, 1, At, B1); PG8_BAR; PG8_SCHED;
            PG8_LDB(B0, 1, 0); PG8_LDB(B1, 1, 1); PG8_SCHED; PG8_LDA(At, 1, 0); PG8_STAGE(PG8_SA(0, 1), a2 + hstep, voffA);
            PG8_WAIT_V(8); PG8_WAIT_L(0); PG8_BAR; PG8_MMA(0, 0, At, B0); PG8_MMA(0, 1, At, B1); PG8_BAR; PG8_SCHED;
            PG8_LDA(At, 1, 1); PG8_STAGE(PG8_SB(1, 0), b3, voffB); PG8_STAGE(PG8_SB(1, 1), b3 + hstep, voffB); PG8_STAGE(PG8_SA(1, 0), a3, voffA);
            PG8_WAIT_V(8); PG8_WAIT_L(0); PG8_BAR; PG8_MMA(1, 0, At, B0); PG8_MMA(1, 1, At, B1); PG8_BAR; PG8_SCHED;
            } else {
            PG8_LDB(B0, 0, 0); PG8_SCHED; PG8_LDA(At, 0, 0); PG8_STAGE(PG8_SA(1, 1), a1 + hstep, voffA);
            PG8_WAIT_L(8); PG8_BAR; PG8_WAIT_L(0); PG8_MMA(0, 0, At, B0); PG8_BAR; PG8_SCHED;
            PG8_LDB(B1, 0, 1); PG8_STAGE(PG8_SB(0, 0), b2, voffB);
            PG8_BAR; PG8_WAIT_L(0); PG8_MMA(0, 1, At, B1); PG8_BAR;
            PG8_LDA(At, 0, 1); PG8_STAGE(PG8_SA(0, 0), a2, voffA);
            PG8_BAR; PG8_WAIT_L(0); PG8_MMA(1, 0, At, B0); PG8_BAR; PG8_SCHED;
            PG8_STAGE(PG8_SB(0, 1), b2 + hstep, voffB);
            PG8_WAIT_V(6); PG8_BAR; PG8_MMA(1, 1, At, B1); PG8_BAR;
            PG8_LDB(B0, 1, 0); PG8_SCHED; PG8_LDA(At, 1, 0); PG8_STAGE(PG8_SA(0, 1), a2 + hstep, voffA);
            PG8_WAIT_L(8); PG8_BAR; PG8_WAIT_L(0); PG8_MMA(0, 0, At, B0); PG8_BAR; PG8_SCHED;
            PG8_LDB(B1, 1, 1); PG8_STAGE(PG8_SB(1, 0), b3, voffB);
            PG8_BAR; PG8_WAIT_L(0); PG8_MMA(0, 1, At, B1); PG8_BAR;
            PG8_LDA(At, 1, 1); PG8_STAGE(PG8_SA(1, 0), a3, voffA);
            PG8_BAR; PG8_WAIT_L(0); PG8_MMA(1, 0, At, B0); PG8_BAR; PG8_SCHED;
            PG8_STAGE(PG8_SB(1, 1), b3 + hstep, voffB);
            PG8_WAIT_V(6); PG8_BAR; PG8_MMA(1, 1, At, B1); PG8_BAR;
            }
        }
        if constexpr (ALIGN_EPI) { if (wr == 0) PG8_BAR; }
        if constexpr (!Epi::AFTER_DRAIN) { E(acc, cur, wr, wc, fr, fq); S.done(cur); }
        if (!has_next) break;
#pragma unroll
        for (int a = 0; a < 2; ++a)
#pragma unroll
            for (int b = 0; b < 2; ++b)
#pragma unroll
                for (int m = 0; m < 4; ++m)
#pragma unroll
                    for (int n = 0; n < 2; ++n) acc[a][b][m][n] = (f32x4){0.f, 0.f, 0.f, 0.f};
        cur = nxt; cA = nA; cB = nB; ++ui;
        if constexpr (ALIGN_EPI) { if (wr == 1) PG8_BAR; }
    }
    PG8_WAIT_V(0);
    if constexpr (!ALIGN_EPI) { if (wr == 0) PG8_BAR; }
    PG8_BAR;
    if constexpr (Epi::AFTER_DRAIN) { E.fused(acc, cur, wr, wc, fr, fq, lds, wid, lane); S.done(cur); }
#undef PG8_SA
#undef PG8_SB
#undef PG8_STAGE
#undef PG8_LDA
#undef PG8_LDB
#undef PG8_MMA
#undef PG8_WAIT_V
#undef PG8_WAIT_L
#undef PG8_BAR
#undef PG8_SCHED
}
}

constexpr int DM = 1024, NBATCH = 8, SEQ = 4096, NTOK = NBATCH * SEQ, CTXL = 256, NCTX = NBATCH * CTXL, MROWS = NTOK + NCTX;
constexpr int DIN = 2048, NHEAD = 8, HD = 64, GRIDW = 64, NMOD = 6 * DM;
constexpr int NEXP = 16384;
constexpr float EPS = 1e-6f;
constexpr int NWAVES = 8;
constexpr int NPHASE = 8;
constexpr float U_SCALE = 64.f, V_SCALE = 4.f;

#ifndef P2_SP2
#define P2_SP2 true
#endif
#ifndef FAKE_MASK
#define FAKE_MASK 7
#endif
#ifndef MK_N_LAUNCHES
#define MK_N_LAUNCHES 1
#endif
constexpr int N_LAUNCHES = MK_N_LAUNCHES;

constexpr size_t MiB = 1u << 20;
constexpr size_t WS_CTL = 0, CTL_ZERO_BYTES = 64 * 1024;
constexpr size_t WS_WIN = 2 * MiB, WS_WOUT = 6 * MiB, WS_WQ = 8 * MiB, WS_KEYS = 12 * MiB, WS_POOLW = 12 * MiB + 512 * 1024, WS_MOD = 13 * MiB;
constexpr size_t WS_SU = 13 * MiB + 512 * 1024, WS_SV = WS_SU + 64 * 1024;
constexpr size_t WS_RSS = WS_SV + 64 * 1024, WS_C2 = WS_RSS + 128 * 1024, WS_GS2 = WS_C2 + 64 * 1024;
constexpr float RSS_FIX = 64.0f, RSS_UNFIX = 1.0f / 64.0f;
constexpr size_t WS_U = 14 * MiB, WS_V = 46 * MiB;
constexpr size_t WS_HX = 78 * MiB;
constexpr size_t WS_ZX = 146 * MiB;
constexpr size_t WS_PB = 146 * MiB, WS_QF = 178 * MiB, WS_KF = 210 * MiB, WS_VF = 244 * MiB;
constexpr size_t WS_MIX = 282 * MiB;
constexpr size_t WS_EXP = 346 * MiB, WS_GATE = 362 * MiB;
constexpr size_t WS_X1 = 378 * MiB;
constexpr size_t WS_WQB = 442 * MiB;
constexpr size_t WS_END = 474 * MiB;
constexpr int CW_BAR = 4096;

constexpr int RING_OFF = 0, RING_BYTES = 131072;
constexpr int LDSCTL_OFF = RING_BYTES, MISC_OFF = LDSCTL_OFF + 320;
constexpr int LDS_BYTES = 147456;

#define GAS __attribute__((address_space(1)))
#define LAS __attribute__((address_space(3)))
#define DI __device__ __forceinline__
typedef unsigned short bf16;
typedef unsigned v4u __attribute__((ext_vector_type(4)));
typedef unsigned v2u __attribute__((ext_vector_type(2)));
typedef float f32x4 __attribute__((ext_vector_type(4)));
typedef float f32x2 __attribute__((ext_vector_type(2)));
typedef GAS unsigned gu32;
#define RLX_AGENT __ATOMIC_RELAXED, __HIP_MEMORY_SCOPE_AGENT
#define LDS_WAIT() asm volatile("s_waitcnt lgkmcnt(0)" ::: "memory")
#define VM_WAIT() asm volatile("s_waitcnt vmcnt(0)" ::: "memory")
DI unsigned f2bf(float f) { unsigned u = __builtin_bit_cast(unsigned, f); return (u + 0x7fffu + ((u >> 16) & 1u)) >> 16; }
DI unsigned pk2(float lo, float hi) { return f2bf(lo) | (f2bf(hi) << 16); }
DI float bflo(unsigned u) { return __uint_as_float(u << 16); }
DI float bfhi(unsigned u) { return __uint_as_float(u & 0xffff0000u); }
DI float wave_sum(float v) {
#pragma unroll
    for (int o = 1; o < 64; o <<= 1) v += __shfl_xor(v, o);
    return v;
}

DI int xorlane(int v, int d, bool x4sel, int lane) {
    switch (d) {
    case 1: return __builtin_amdgcn_update_dpp(0, v, 0xb1, 0xf, 0xf, false);
    case 2: return __builtin_amdgcn_update_dpp(0, v, 0x4e, 0xf, 0xf, false);
    case 4: { const int a = __builtin_amdgcn_update_dpp(0, v, 0x124, 0xf, 0xf, false), b = __builtin_amdgcn_update_dpp(0, v, 0x12c, 0xf, 0xf, false); return x4sel ? a : b; }
    case 8: return __builtin_amdgcn_update_dpp(0, v, 0x128, 0xf, 0xf, false);
    case 16: { auto rr = __builtin_amdgcn_permlane16_swap((unsigned)v, (unsigned)v, false, false); const unsigned r0 = rr[0], r1 = rr[1]; return (int)((lane & 16) ? r0 : r1); }
    default: { auto rr = __builtin_amdgcn_permlane32_swap((unsigned)v, (unsigned)v, false, false); const unsigned r0 = rr[0], r1 = rr[1]; return (int)((lane & 32) ? r0 : r1); }
    }
}
DI bool xor4_sel(int lane) { return __builtin_amdgcn_update_dpp(0, lane, 0x124, 0xf, 0xf, false) == (lane ^ 4); }
DI float xorlane_f(float v, int d, bool x4sel, int lane) { return __int_as_float(xorlane(__float_as_int(v), d, x4sel, lane)); }
template <int N> DI float lanes_max(float v, bool x4sel, int lane) {
#pragma unroll
    for (int o = 1; o < N; o <<= 1) v = fmaxf(v, xorlane_f(v, o, x4sel, lane));
    return v;
}
template <int N> DI float lanes_sum(float v, bool x4sel, int lane) {
#pragma unroll
    for (int o = 1; o < N; o <<= 1) v += xorlane_f(v, o, x4sel, lane);
    return v;
}
template <int N> DI int lanes_sum_i(int v, bool x4sel, int lane) {
#pragma unroll
    for (int o = 1; o < N; o <<= 1) v += xorlane(v, o, x4sel, lane);
    return v;
}

#define XB_TMO      128
#define XB_XCNT(j)  (256  + 64 * (j))
#define XB_XSUB(j)  (1280 + 64 * (j))
#define XB_XGEN(j)  (2304 + 64 * (j))
#define XB_TOP      3328
#define XB_TOPGEN   3392
#define XCD_BAR_WORDS 3456
#define XB_SPIN_CAP (1u << 18)

__device__ __forceinline__ unsigned xb_ld(unsigned* p)              { return __hip_atomic_load(p, __ATOMIC_RELAXED, __HIP_MEMORY_SCOPE_AGENT); }
__device__ __forceinline__ unsigned xb_add(unsigned* p, unsigned v) { return __hip_atomic_fetch_add(p, v, __ATOMIC_RELAXED, __HIP_MEMORY_SCOPE_AGENT); }
__device__ __forceinline__ unsigned xb_xcc_id() { return (unsigned)__builtin_amdgcn_s_getreg((3 << 11) | 20) & 0xFu; }
#define XB_SPIN(cond, bar) do { unsigned _sp = 0; while (cond) { __builtin_amdgcn_s_sleep(1); \
    if ((++_sp & 255u) == 0u) { if (xb_ld(&(bar)[XB_TMO])) break; if (_sp > XB_SPIN_CAP) { atomicAdd(&(bar)[XB_TMO], 1u); break; } } } } while (0)

struct XcdBarrier {
    unsigned* bar; unsigned x;
    volatile LAS unsigned* st;
};

__device__ __forceinline__ XcdBarrier xcd_barrier_post(unsigned* bar, volatile LAS unsigned* st) {
    XcdBarrier b; b.bar = bar; b.x = xb_xcc_id(); b.st = st;
    if (threadIdx.x == 0) (void)xb_add(&bar[XB_XCNT(b.x)], 1u);
    return b;
}
__device__ __forceinline__ void xcd_barrier_complete(unsigned* bar, unsigned x, unsigned& nloc, unsigned& nx) {
    const unsigned G = gridDim.x * gridDim.y * gridDim.z;
    unsigned sum, cnt, mine, sp = 0u;
    for (;;) {
        sum = 0u; cnt = 0u; mine = 0u;
#pragma unroll
        for (unsigned j = 0; j < 16; ++j) { const unsigned c = xb_ld(&bar[XB_XCNT(j)]); sum += c; cnt += (c > 0u) ? 1u : 0u; mine = (j == x) ? c : mine; }
        if (sum == G) break;
        __builtin_amdgcn_s_sleep(1);
        if ((++sp & 255u) == 0u) { if (xb_ld(&bar[XB_TMO])) break; if (sp > XB_SPIN_CAP) { atomicAdd(&bar[XB_TMO], 1u); break; } }
    }
    nloc = mine > 0u ? mine : 1u; nx = cnt > 0u ? cnt : 1u;
}

__device__ __forceinline__ void xcd_barrier(const XcdBarrier& b) {
    asm volatile("s_waitcnt vmcnt(0)" ::: "memory");
    __syncthreads();
    if (threadIdx.x == 0) {
        unsigned* bar = b.bar;
        __builtin_amdgcn_s_waitcnt(0);
        unsigned nloc = b.st[0], nx = b.st[1];
        if (nloc == 0u) { xcd_barrier_complete(bar, b.x, nloc, nx); b.st[0] = nloc; b.st[1] = nx; }
        const unsigned old = xb_add(&bar[XB_XSUB(b.x)], 1u);
        const unsigned gen = old / nloc;
        if (old + 1u == (gen + 1u) * nloc) {
            __builtin_amdgcn_fence(__ATOMIC_RELEASE, "agent");
            asm volatile("s_waitcnt vmcnt(0)" ::: "memory");
            const unsigned og = xb_add(&bar[XB_TOP], 1u);
            const unsigned tg = og / nx;
            if (og + 1u == (tg + 1u) * nx) xb_add(&bar[XB_TOPGEN], 1u);
            else XB_SPIN(xb_ld(&bar[XB_TOPGEN]) == tg, bar);
            __builtin_amdgcn_fence(__ATOMIC_ACQUIRE, "agent");
            xb_add(&bar[XB_XGEN(b.x)], 1u);
            asm volatile("s_waitcnt vmcnt(0)" ::: "memory");
        } else {
            XB_SPIN(xb_ld(&bar[XB_XGEN(b.x)]) == gen, bar);
            __builtin_amdgcn_fence(__ATOMIC_ACQUIRE, "agent");
            asm volatile("s_waitcnt vmcnt(0)" ::: "memory");
        }
    }
    __syncthreads();
}


__device__ __forceinline__ void p0_transpose_item(const float* W, int K, int N, bf16* WT, int row_off, LAS float* scr, int item, int lane, const float* kg = nullptr, const float* ksc = nullptr) {
    const int nblk = N / 32, kb = item / nblk, nb = item % nblk, k0 = 64 * kb, n0 = 32 * nb;
    float wv[32];
#pragma unroll
    for (int i = 0; i < 32; ++i) wv[i] = W[(size_t)(k0 + 2 * i + (lane >> 5)) * N + n0 + (lane & 31)];
    if (kg) {
#pragma unroll
        for (int i = 0; i < 32; ++i) { const int kk = 2 * i + (lane >> 5); wv[i] *= kg[k0 + kk] * (1.0f + ksc[k0 + kk]); } }
#pragma unroll
    for (int i = 0; i < 32; ++i) scr[(2 * i + (lane >> 5)) * 33 + (lane & 31)] = wv[i];
    LDS_WAIT(); asm volatile("" ::: "memory");
    const int c = lane & 7;
#pragma unroll
    for (int j = 0; j < 4; ++j) { const int n = (lane >> 3) + 8 * j; const LAS float* s = scr + (8 * c) * 33 + n;
        v4u o; o.x = pk2(s[0 * 33], s[1 * 33]); o.y = pk2(s[2 * 33], s[3 * 33]); o.z = pk2(s[4 * 33], s[5 * 33]); o.w = pk2(s[6 * 33], s[7 * 33]);
        *(GAS v4u*)(WT + (size_t)(row_off + n0 + n) * K + k0 + 8 * c) = o; }
    LDS_WAIT(); asm volatile("" ::: "memory");
}


struct Frame {
    LAS unsigned char* lds;
    int tid, lane, wave, vcu, G, gw, NGW;
    const float* in[18]; float* out; unsigned char* ws;
};

template <int PM = 15> DI void p0_prologue(Frame& F) {
    const float* c = F.in[1]; const float* c_ctx = F.in[3]; const float* ada_w = F.in[4]; const float* ada_b = F.in[5];
    float* MOD = (float*)(F.ws + WS_MOD);
    LAS float* sl = (LAS float*)(F.lds + 73728);
    for (int i = F.tid; i < 9 * 1024; i += 512) { const int b = i >> 10, k = i & 1023; const float cv = (b < 8) ? c[b * 1024 + k] : c_ctx[k]; sl[i] = cv / (1.f + __expf(-cv)); }
    __syncthreads();
    if (PM & 1)
    { LAS float* part = (LAS float*)(F.lds + 110592);
      for (int cg = F.vcu; cg < NMOD / 24; cg += F.G) {
          const int c = F.lane % 24, sub = F.lane / 24, n = cg * 24 + c, k0 = F.wave * 128 + sub * 64;
          float acc[9];
#pragma unroll
          for (int b = 0; b < 9; ++b) acc[b] = 0.f;
          if (sub < 2) { const float* wp = ada_w + (size_t)k0 * NMOD + n; const LAS float* sp = sl + k0;
#pragma unroll 16
              for (int i = 0; i < 64; ++i) { const float w = wp[(size_t)i * NMOD];
#pragma unroll
                  for (int b = 0; b < 9; ++b) acc[b] += sp[b * 1024 + i] * w; } }
#pragma unroll
          for (int b = 0; b < 9; ++b) { const float o = __shfl(acc[b], (F.lane + 24) & 63); if (F.lane < 24) part[(F.wave * 9 + b) * 24 + c] = acc[b] + o; }
          __syncthreads();
          if (F.tid < 216) { const int b = F.tid / 24, cc = F.tid % 24; float t = ada_b[cg * 24 + cc];
#pragma unroll
              for (int w = 0; w < 8; ++w) t += part[(w * 9 + b) * 24 + cc];
              MOD[b * NMOD + cg * 24 + cc] = t; }
          __syncthreads();
      } }
    for (int i = F.vcu * 512 + F.tid; i < NTOK; i += F.G * 512) ((unsigned*)(F.ws + WS_RSS))[i] = 0u;
    LAS float* scr = (LAS float*)(F.lds + F.wave * 9216);
    constexpr int I_IN = (DM / 64) * (DIN / 32), I_OUT = (DM / 64) * (DM / 32), I_Q = (DM / 64) * (2048 / 32), I_P = 4 * 8;
    if (PM & 2)
    for (int it = F.gw; it < I_IN + I_OUT + I_Q + I_P; it += F.NGW) {
        int r = it;
        if (r < I_IN) { p0_transpose_item(F.in[7], DM, DIN, (bf16*)(F.ws + WS_WIN), 0, scr, r, F.lane); continue; } r -= I_IN;
        if (r < I_OUT) { p0_transpose_item(F.in[11], DM, DM, (bf16*)(F.ws + WS_WOUT), 0, scr, r, F.lane); continue; } r -= I_OUT;
        if (r < I_Q) { p0_transpose_item(F.in[13], DM, 2048, (bf16*)(F.ws + WS_WQ), 0, scr, r, F.lane); continue; } r -= I_Q;
        { const int g = r >> 3; p0_transpose_item(F.in[8] + g * 16384, 128, 128, (bf16*)(F.ws + WS_POOLW) + g * 16384, 0, scr, r & 7, F.lane); }
    }
    if (PM & 4)
    { const float* kf = F.in[14]; bf16* kb = (bf16*)(F.ws + WS_KEYS);
      for (int it = F.gw; it < 16 * 32; it += F.NGW) { const int hp = it >> 5, nt = (it >> 3) & 3, ks = it & 7;
          const float* src = kf + ((size_t)hp * 128 + 32 * nt + (F.lane & 31)) * 128 + 16 * ks + 8 * (F.lane >> 5);
          const f32x4 a = *(const f32x4*)(src), b = *(const f32x4*)(src + 4);
          v4u w; w.x = pk2(a.x, a.y); w.y = pk2(a.z, a.w); w.z = pk2(b.x, b.y); w.w = pk2(b.z, b.w); *(v4u*)(kb + ((size_t)it * 64 + F.lane) * 8) = w; } }
    if (PM & 8) {
    const bool x4 = xor4_sel(F.lane);
    f32x4 nx[4];
#define P0D_SRC(it_) ((const f32x4*)(((it_) < NEXP ? F.in[15] : F.in[16]) + (size_t)((it_) < NEXP ? (it_) : (it_) - NEXP) * 1024) + 2 * F.lane)
    if (F.gw < 2 * NEXP) { const f32x4* sp = P0D_SRC(F.gw);
#pragma unroll
        for (int j = 0; j < 2; ++j) { nx[2 * j] = sp[128 * j]; nx[2 * j + 1] = sp[128 * j + 1]; } }
    for (int it = F.gw; it < 2 * NEXP; it += F.NGW) {
        const bool isu = it < NEXP; const int row = isu ? it : it - NEXP;
        unsigned* dst = (unsigned*)((isu ? F.ws + WS_U : F.ws + WS_V) + (size_t)row * 512) + F.lane;
        f32x4 a[4];
#pragma unroll
        for (int j = 0; j < 4; ++j) a[j] = nx[j];
        if (it + F.NGW < 2 * NEXP) { const f32x4* sp = P0D_SRC(it + F.NGW);
#pragma unroll
            for (int j = 0; j < 2; ++j) { nx[2 * j] = sp[128 * j]; nx[2 * j + 1] = sp[128 * j + 1]; } }
        float ss = 0.f;
#pragma unroll
        for (int j = 0; j < 4; ++j) ss += a[j].x * a[j].x + a[j].y * a[j].y + a[j].z * a[j].z + a[j].w * a[j].w;
        const float rms = sqrtf(lanes_sum<64>(ss, x4, F.lane) * (1.0f / 1024.0f));
        if (isu) {
            const float step = fmaxf(0.3352f * rms, 1e-30f), inv = 1.0f / step;
#pragma unroll
            for (int j = 0; j < 2; ++j) { unsigned w = 0;
#pragma unroll
                for (int t = 0; t < 2; ++t)
#pragma unroll
                    for (int e = 0; e < 4; ++e) { const int q = max(-8, min(7, (int)floorf(a[2 * j + t][e] * inv))); w |= (unsigned)(q & 15) << (4 * (2 * e + 1 - t)); }
                dst[64 * j] = w; }
            if (F.lane == 0) ((float*)(F.ws + WS_SU))[2 * row] = step;
        } else {
            const float sc = fmaxf(0.5f * rms, 1e-30f), inv = 1.0f / sc;
#pragma unroll
            for (int j = 0; j < 2; ++j) { unsigned pk = 0;
                pk = __builtin_amdgcn_cvt_scalef32_pk_fp4_f32(pk, a[2 * j].x * inv, a[2 * j].y * inv, 1.0f, 0);
                pk = __builtin_amdgcn_cvt_scalef32_pk_fp4_f32(pk, a[2 * j].z * inv, a[2 * j].w * inv, 1.0f, 1);
                pk = __builtin_amdgcn_cvt_scalef32_pk_fp4_f32(pk, a[2 * j + 1].x * inv, a[2 * j + 1].y * inv, 1.0f, 2);
                pk = __builtin_amdgcn_cvt_scalef32_pk_fp4_f32(pk, a[2 * j + 1].z * inv, a[2 * j + 1].w * inv, 1.0f, 3);
                dst[64 * j] = pk; }
            if (F.lane == 0) ((float*)(F.ws + WS_SU))[2 * row + 1] = sc;
        }
    }
#undef P0D_SRC
    }
}

DI void norm2_consts(Frame& F) {
    const float* MOD = (const float*)(F.ws + WS_MOD); const float* g2n = F.in[12];
    float* GS2 = (float*)(F.ws + WS_GS2); float* C2 = (float*)(F.ws + WS_C2);
    for (int i = F.vcu * 512 + F.tid; i < 8 * DM; i += F.G * 512) { const int b = i >> 10, d = i & 1023; GS2[i] = g2n[d] * (1.0f + MOD[b * NMOD + 4 * DM + d]); }
    { LAS float* scr = (LAS float*)(F.lds + F.wave * 9216); constexpr int I_Q = (DM / 64) * (2048 / 32);
      for (int it = F.gw; it < 8 * I_Q; it += F.NGW) { const int b = it / I_Q;
          p0_transpose_item(F.in[13], DM, 2048, (bf16*)(F.ws + WS_WQB) + (size_t)b * 2048 * DM, 0, scr, it % I_Q, F.lane, g2n, MOD + b * NMOD + 4 * DM); } }
    const bool x4 = xor4_sel(F.lane);
    for (int n = F.gw; n < 2048; n += F.NGW) {
        const v4u* wr = (const v4u*)((const bf16*)(F.ws + WS_WQ) + (size_t)n * DM + F.lane * 16);
        const v4u w0 = wr[0], w1 = wr[1];
        float wv[16]; wv[0] = bflo(w0.x); wv[1] = bfhi(w0.x); wv[2] = bflo(w0.y); wv[3] = bfhi(w0.y); wv[4] = bflo(w0.z); wv[5] = bfhi(w0.z); wv[6] = bflo(w0.w); wv[7] = bfhi(w0.w);
        wv[8] = bflo(w1.x); wv[9] = bfhi(w1.x); wv[10] = bflo(w1.y); wv[11] = bfhi(w1.y); wv[12] = bflo(w1.z); wv[13] = bfhi(w1.z); wv[14] = bflo(w1.w); wv[15] = bfhi(w1.w);
#pragma unroll 1
        for (int b = 0; b < 8; ++b) { const f32x4* sp = (const f32x4*)(MOD + b * NMOD + 3 * DM + F.lane * 16); float acc = 0.f;
#pragma unroll
            for (int q = 0; q < 4; ++q) { const f32x4 sv = sp[q]; acc += sv.x * wv[4 * q] + sv.y * wv[4 * q + 1] + sv.z * wv[4 * q + 2] + sv.w * wv[4 * q + 3]; }
            acc = lanes_sum<64>(acc, x4, F.lane);
            if (F.lane == 0) C2[b * 2048 + n] = acc; }
    }
}

template <bool SRC_BF16> DI void norm_rows(Frame& F, const float* src_x, const float* src_ctx, int nrows, const float* gain, int shift_off, int scale_off, bf16* dst) {
    const float* MOD = (const float*)(F.ws + WS_MOD);
    const int per = (nrows + F.NGW - 1) / F.NGW, m_lo = F.gw * per, m_hi = min(m_lo + per, nrows);
    const bool x4 = xor4_sel(F.lane);
    f32x4 gs[4], shv[4]; int cb = -1;
    f32x4 rf[4]; v2u rb[4];
#define NR_LOAD(m_) do { const int mm_ = (m_); if (SRC_BF16) { const v2u* xr_ = (const v2u*)((const bf16*)src_x + (size_t)mm_ * DM) + F.lane; _Pragma("unroll") for (int j = 0; j < 4; ++j) rb[j] = xr_[64 * j]; } \
        else { const f32x4* xr_ = (const f32x4*)(mm_ < NTOK ? src_x + (size_t)mm_ * DM : src_ctx + (size_t)(mm_ - NTOK) * DM) + F.lane; _Pragma("unroll") for (int j = 0; j < 4; ++j) rf[j] = xr_[64 * j]; } } while (0)
    if (m_lo < m_hi) NR_LOAD(m_lo);
    for (int m = m_lo; m < m_hi; ++m) {
        const int b = (m < NTOK) ? (m >> 12) : 8;
        f32x4 v[4]; float s = 0.f;
#pragma unroll
        for (int j = 0; j < 4; ++j) v[j] = SRC_BF16 ? (f32x4){bflo(rb[j].x), bfhi(rb[j].x), bflo(rb[j].y), bfhi(rb[j].y)} : rf[j];
        if (m + 1 < m_hi) NR_LOAD(m + 1);
        if (b != cb) { cb = b;
            const f32x4* gp = (const f32x4*)gain + F.lane; const f32x4* shp = (const f32x4*)(MOD + b * NMOD + shift_off) + F.lane; const f32x4* scp = (const f32x4*)(MOD + b * NMOD + scale_off) + F.lane;
#pragma unroll
            for (int j = 0; j < 4; ++j) { gs[j] = gp[64 * j] * (scp[64 * j] + 1.0f); shv[j] = shp[64 * j]; } }
#pragma unroll
        for (int j = 0; j < 4; ++j) s += (v[j].x * v[j].x + v[j].y * v[j].y) + (v[j].z * v[j].z + v[j].w * v[j].w);
        const float rinv = 1.0f / sqrtf(lanes_sum<64>(s, x4, F.lane) * (1.f / DM) + EPS);
        unsigned long long* o8 = (unsigned long long*)(dst + (size_t)m * DM) + F.lane;
#pragma unroll
        for (int j = 0; j < 4; ++j) { const f32x4 y = (v[j] * rinv) * gs[j] + shv[j];
            o8[64 * j] = (unsigned long long)pk2(y.x, y.y) | ((unsigned long long)pk2(y.z, y.w) << 32); }
    }
#undef NR_LOAD
}

typedef float f32x16 __attribute__((ext_vector_type(16)));
typedef short s16x8 __attribute__((ext_vector_type(8)));
typedef __bf16 bf16x2_t __attribute__((ext_vector_type(2)));
#define MFMA32(a, b, c) __builtin_amdgcn_mfma_f32_32x32x16_bf16((a), (b), (c), 0, 0, 0)
DI unsigned cvtpk(float lo, float hi) { f32x2 v = {lo, hi}; bf16x2_t bb = __builtin_convertvector(v, bf16x2_t); return __builtin_bit_cast(unsigned, bb); }
DI float pairmax(float v) { auto rr = __builtin_amdgcn_permlane32_swap(__float_as_uint(v), __float_as_uint(v), false, false); return fmaxf(__uint_as_float(rr[0]), __uint_as_float(rr[1])); }
constexpr float LOG2E = 1.4426950408889634f, ATT_C2 = 0.125f * LOG2E, ATT_THR = 6.0f;
template <int QMASK, bool LOCAL>
DI void attn_tile(const s16x8 (&kf)[4], const s16x8 (&vf)[4], const LAS s16x8* qfp, f32x16 (&o)[2], float& m, float& l, const LAS float* brow, int djb, int lo) {
    f32x16 s; s16x8 qf[4];
#pragma unroll
    for (int ks = 0; ks < 4; ++ks) qf[ks] = qfp[ks * 64];
#pragma unroll
    for (int i = 0; i < 16; ++i) s[i] = 0.f;
#pragma unroll
    for (int ks = 0; ks < 4; ++ks) s = MFMA32(kf[ks], qf[ks], s);
    float sv[16]; float tmax = -INFINITY;
#pragma unroll
    for (int i = 0; i < 16; ++i) {
        if (!((QMASK >> (i >> 2)) & 1)) { sv[i] = -INFINITY; continue; }
        if (LOCAL) { const int dj = djb + (i & 3) + 8 * (i >> 2); const bool valid = (unsigned)(dj - lo) < 16u;
            const float x = s[i] * ATT_C2 + brow[dj & 31]; sv[i] = valid ? x : -INFINITY; }
        else sv[i] = s[i] * ATT_C2;
        tmax = fmaxf(tmax, sv[i]);
    }
    tmax = pairmax(tmax);
    if (__any(tmax > m + ATT_THR)) { const float mn = fmaxf(m, tmax), alpha = __builtin_amdgcn_exp2f(m - mn); o[0] *= alpha; o[1] *= alpha; l *= alpha; m = mn; }
    float p[16];
#pragma unroll
    for (int i = 0; i < 16; ++i) { if ((QMASK >> (i >> 2)) & 1) { p[i] = __builtin_amdgcn_exp2f(sv[i] - m); l += p[i]; } else p[i] = 0.f; }
#pragma unroll
    for (int s2 = 0; s2 < 2; ++s2) if (QMASK & (3 << (2 * s2))) {
        v4u pk; pk.x = cvtpk(p[8 * s2], p[8 * s2 + 1]); pk.y = cvtpk(p[8 * s2 + 2], p[8 * s2 + 3]); pk.z = cvtpk(p[8 * s2 + 4], p[8 * s2 + 5]); pk.w = cvtpk(p[8 * s2 + 6], p[8 * s2 + 7]);
        const s16x8 pf = __builtin_bit_cast(s16x8, pk);
        o[0] = MFMA32(vf[s2], pf, o[0]); o[1] = MFMA32(vf[2 + s2], pf, o[1]);
    }
}
DI void attn_mfma(Frame& F) {
    const bf16* QF = (const bf16*)(F.ws + WS_QF); const bf16* KF = (const bf16*)(F.ws + WS_KF); const bf16* VF = (const bf16*)(F.ws + WS_VF);
    bf16* MIX = (bf16*)(F.ws + WS_MIX); const float* rpb = F.in[10];
    LAS float* rp = (LAS float*)(F.lds);
    for (int i = F.tid; i < NHEAD * 15 * 31; i += 512) rp[i] = rpb[i] * LOG2E;
    __syncthreads();
    const int lane = F.lane, hh = lane >> 5, ql = lane & 31;
    int lo[2], djb[2][2];
#pragma unroll
    for (int qb = 0; qb < 2; ++qb) { const int qc = 32 * qb + ql, c0 = min(max(qc - 8, 0), 48); lo[qb] = c0 - qc + 15;
#pragma unroll
        for (int jb = 0; jb < 2; ++jb) djb[qb][jb] = 32 * (jb - qb) + 4 * hh - ql + 15; }
    for (int unit = F.gw; unit < NBATCH * NHEAD * 64; unit += F.NGW) {
        const int r = unit & 63, h = (unit >> 6) & 7, b = unit >> 9, bh = b * 8 + h;
        LAS s16x8* qfl = (LAS s16x8*)(F.lds + 16384 + F.wave * 8192) + lane;
        { s16x8 qtmp[8];
#pragma unroll
          for (int qb = 0; qb < 2; ++qb)
#pragma unroll
              for (int ks = 0; ks < 4; ++ks) qtmp[qb * 4 + ks] = ((const s16x8*)(QF + (size_t)(bh * 128 + 2 * r + qb) * 2048))[ks * 64 + lane];

#pragma unroll
          for (int i = 0; i < 8; ++i) qfl[i * 64] = qtmp[i]; }
        f32x16 o[2][2]; float m[2], l[2];
#pragma unroll
        for (int qb = 0; qb < 2; ++qb) { m[qb] = -1e30f; l[qb] = 0.f;
#pragma unroll
            for (int dt = 0; dt < 2; ++dt)
#pragma unroll
                for (int i = 0; i < 16; ++i) o[qb][dt][i] = 0.f; }
        const int r0 = min(max(r - 4, 0), 56);
        s16x8 kf[4], vf[4], kn[4];
        { const s16x8* kp = (const s16x8*)(KF + (size_t)(bh * 136 + 128) * 2048) + lane;
#pragma unroll
          for (int j = 0; j < 4; ++j) kn[j] = kp[j * 64]; }
#pragma unroll 1
        for (int kb = 0; kb < 8; ++kb) {
            { const s16x8* vp = (const s16x8*)(VF + (size_t)(bh * 136 + 128 + kb) * 2048) + lane;
#pragma unroll
              for (int j = 0; j < 4; ++j) { kf[j] = kn[j]; vf[j] = vp[j * 64]; } }
            { const int nb = (kb < 7) ? bh * 136 + 128 + kb + 1 : bh * 136 + 2 * r0;
              const s16x8* kp = (const s16x8*)(KF + (size_t)nb * 2048) + lane;
#pragma unroll
              for (int j = 0; j < 4; ++j) kn[j] = kp[j * 64]; }
            attn_tile<15, false>(kf, vf, qfl, o[0], m[0], l[0], rp, 0, 0);
            attn_tile<15, false>(kf, vf, qfl + 256, o[1], m[1], l[1], rp, 0, 0);
        }
#pragma unroll 1
        for (int i = 0; i < 8; ++i) {
            const LAS float* brow = rp + (h * 15 + (r0 + i - r + 7)) * 31;
            { const s16x8* vp = (const s16x8*)(VF + (size_t)(bh * 136 + 2 * (r0 + i)) * 2048) + lane;
#pragma unroll
              for (int j = 0; j < 4; ++j) { kf[j] = kn[j]; vf[j] = vp[j * 64]; } }
            { const int nb = bh * 136 + 2 * (r0 + i) + 1;
              const s16x8* kp = (const s16x8*)(KF + (size_t)nb * 2048) + lane;
#pragma unroll
              for (int j = 0; j < 4; ++j) kn[j] = kp[j * 64]; }
            attn_tile<15, true>(kf, vf, qfl, o[0], m[0], l[0], brow, djb[0][0], lo[0]);
            attn_tile<8, true>(kf, vf, qfl + 256, o[1], m[1], l[1], brow, djb[1][0], lo[1]);
            { const s16x8* vp = (const s16x8*)(VF + (size_t)(bh * 136 + 2 * (r0 + i) + 1) * 2048) + lane;
#pragma unroll
              for (int j = 0; j < 4; ++j) { kf[j] = kn[j]; vf[j] = vp[j * 64]; } }
            { const int nb = bh * 136 + 2 * (r0 + ((i < 7) ? i + 1 : 0));
              const s16x8* kp = (const s16x8*)(KF + (size_t)nb * 2048) + lane;
#pragma unroll
              for (int j = 0; j < 4; ++j) kn[j] = kp[j * 64]; }
            attn_tile<1, true>(kf, vf, qfl, o[0], m[0], l[0], brow, djb[0][1], lo[0]);
            attn_tile<15, true>(kf, vf, qfl + 256, o[1], m[1], l[1], brow, djb[1][1], lo[1]);
        }
#pragma unroll
        for (int qb = 0; qb < 2; ++qb) {
            const float lt = l[qb] + __shfl_xor(l[qb], 32), inv = 1.0f / lt;
            bf16* orow = MIX + (size_t)(b * SEQ + r * GRIDW + 32 * qb + ql) * DM + 512 + h * 64 + 4 * hh;
#pragma unroll
            for (int dt = 0; dt < 2; ++dt)
#pragma unroll
                for (int g = 0; g < 4; ++g) { v2u w; w.x = pk2(o[qb][dt][4 * g] * inv, o[qb][dt][4 * g + 1] * inv); w.y = pk2(o[qb][dt][4 * g + 2] * inv, o[qb][dt][4 * g + 3] * inv);
                    *(v2u*)(orow + 32 * dt + 8 * g) = w; }
        }
    }
    __syncthreads();
}
DI void pool_mfma(Frame& F) {
    const bf16* PBF = (const bf16*)(F.ws + WS_PB); bf16* MIX = (bf16*)(F.ws + WS_MIX); const bf16* PW = (const bf16*)(F.ws + WS_POOLW); const float* pool_scale = F.in[9];
    constexpr int RS = 272;
    LAS unsigned char* ptile = F.lds + 32768;
    LAS unsigned char* atile = F.lds + 32768 + 144 * RS;
    const int lane = F.lane, hh = lane >> 5, ql = lane & 31;
    for (int tile = F.vcu; tile < NTOK / 128; tile += F.G) {
        const int tok0 = tile * 128, bstart = tok0 & ~(SEQ - 1);
        v4u pre[5];
#define POOL_FETCH(g_) do { _Pragma("unroll") for (int k_ = 0; k_ < 5; ++k_) { const int it_ = F.tid + 512 * k_; const int rr_ = it_ >> 4, ch_ = it_ & 15, t_ = tok0 - 8 + rr_; \
            pre[k_] = (v4u){0u, 0u, 0u, 0u}; if (it_ < 144 * 16 && t_ >= bstart && t_ < bstart + SEQ) pre[k_] = *(const v4u*)(PBF + (size_t)t_ * 512 + (g_) * 128 + ch_ * 8); } } while (0)
        v4u pw[4];
#define POOL_WFETCH(g_) do { _Pragma("unroll") for (int k_ = 0; k_ < 4; ++k_) pw[k_] = *(const v4u*)(PW + (size_t)(g_) * 16384 + (size_t)(F.tid + 512 * k_) * 8); } while (0)
        POOL_FETCH(0); POOL_WFETCH(0);
#pragma unroll 1
        for (int g = 0; g < 4; ++g) {
#pragma unroll
            for (int k = 0; k < 5; ++k) { const int it = F.tid + 512 * k; if (it < 144 * 16) *(LAS v4u*)(ptile + (it >> 4) * RS + (it & 15) * 16) = pre[k]; }
            __syncthreads();
#pragma unroll
            for (int k = 0; k < 4; ++k) { const int pc = F.tid + 512 * k, row = pc >> 4, c16 = pc & 15; *(LAS v4u*)(F.lds + row * 256 + ((c16 ^ (row & 15)) << 4)) = pw[k]; }
            if (g + 1 < 4) { POOL_FETCH(g + 1); POOL_WFETCH(g + 1); }
            const int tb = F.wave >> 1, dt0 = (F.wave & 1) * 2;
            f32x4 scv[2][4];
#pragma unroll
            for (int j = 0; j < 2; ++j)
#pragma unroll
                for (int q = 0; q < 4; ++q) scv[j][q] = *(const f32x4*)(pool_scale + g * 128 + 32 * (dt0 + j) + 8 * q + 4 * hh);
            { const int co = F.tid & 15, sg = F.tid >> 4, w = 2 << g, hw = w >> 1;
              const LAS unsigned char* col = ptile + co * 16;
              float sa[8];
#pragma unroll
              for (int c = 0; c < 8; ++c) sa[c] = 0.f;
              const int tl0 = sg * 4;
#define POOL_ACC(u_, sgn_) do { sa[0] += sgn_ bflo(u_.x); sa[1] += sgn_ bfhi(u_.x); sa[2] += sgn_ bflo(u_.y); sa[3] += sgn_ bfhi(u_.y); sa[4] += sgn_ bflo(u_.z); sa[5] += sgn_ bfhi(u_.z); sa[6] += sgn_ bflo(u_.w); sa[7] += sgn_ bfhi(u_.w); } while (0)
              for (int rr = tl0 + 8 - hw; rr < tl0 + 8 + hw; ++rr) { const v4u u = *(const LAS v4u*)(col + rr * RS); POOL_ACC(u, +); }
#pragma unroll
              for (int i = 0; i < 4; ++i) { const int tl = tl0 + i, sp = (tok0 + tl) & (SEQ - 1);
                  const int cnt = min(sp + hw, SEQ) - max(sp - hw, 0); const float inv = __builtin_amdgcn_rcpf((float)cnt);
                  const v4u self = *(const LAS v4u*)(col + (tl + 8) * RS);
                  v4u o; o.x = pk2(sa[0] * inv - bflo(self.x), sa[1] * inv - bfhi(self.x)); o.y = pk2(sa[2] * inv - bflo(self.y), sa[3] * inv - bfhi(self.y));
                  o.z = pk2(sa[4] * inv - bflo(self.z), sa[5] * inv - bfhi(self.z)); o.w = pk2(sa[6] * inv - bflo(self.w), sa[7] * inv - bfhi(self.w));
                  *(LAS v4u*)(atile + tl * RS + co * 16) = o;
                  const v4u un = *(const LAS v4u*)(col + (tl + 8 + hw) * RS), uo = *(const LAS v4u*)(col + (tl + 8 - hw) * RS);
                  POOL_ACC(un, +); POOL_ACC(uo, -); }
#undef POOL_ACC
            }
            __syncthreads();
            { f32x16 acc[2];
#pragma unroll
              for (int j = 0; j < 2; ++j)
#pragma unroll
                  for (int i = 0; i < 16; ++i) acc[j][i] = 0.f;
#pragma unroll
              for (int ks = 0; ks < 8; ++ks) {
                  const s16x8 bfr = *(const LAS s16x8*)(atile + (32 * tb + ql) * RS + (16 * ks + 8 * hh) * 2);
#pragma unroll
                  for (int j = 0; j < 2; ++j) { const int wrow = 32 * (dt0 + j) + ql; const s16x8 afr = *(const LAS s16x8*)(F.lds + wrow * 256 + (((2 * ks + hh) ^ (wrow & 15)) << 4)); acc[j] = MFMA32(afr, bfr, acc[j]); } }
              bf16* orow = MIX + (size_t)(tok0 + 32 * tb + ql) * DM + g * 128 + 4 * hh;
#pragma unroll
              for (int j = 0; j < 2; ++j)
#pragma unroll
                  for (int q = 0; q < 4; ++q) { const int d = 32 * (dt0 + j) + 8 * q; const f32x4 sc = scv[j][q];
                      v2u wv; wv.x = pk2(acc[j][4 * q] * sc.x, acc[j][4 * q + 1] * sc.y); wv.y = pk2(acc[j][4 * q + 2] * sc.z, acc[j][4 * q + 3] * sc.w);
                      *(v2u*)(orow + d) = wv; } }
        }
        __syncthreads();
#undef POOL_FETCH
#undef POOL_WFETCH
    }
}
constexpr float TOPK_OFF = 64.0f;
DI int f2key(float f) { const int b = __float_as_int(f); return b ^ ((b >> 31) & 0x7fffffff); }
DI float key2f(int k) { return __int_as_float(k ^ ((k >> 31) & 0x7fffffff)); }
DI void ce_desc(int& x, int& y) { const int hi = max(x, y), lo = min(x, y); x = hi; y = lo; }
DI void sort16_desc(int (&a)[16]) {
#pragma unroll
    for (int p = 1; p < 16; p <<= 1)
#pragma unroll
        for (int k = p; k >= 1; k >>= 1)
#pragma unroll
            for (int j = k % p; j <= 15 - k; j += 2 * k)
#pragma unroll
                for (int i = 0; i < k; ++i) if (i + j + k <= 15 && (i + j) / (2 * p) == (i + j + k) / (2 * p)) ce_desc(a[i + j], a[i + j + k]);
}
DI void merge16_desc(int (&a)[16], const int (&b)[16]) {
#pragma unroll
    for (int i = 0; i < 16; ++i) a[i] = max(a[i], b[15 - i]);
#pragma unroll
    for (int j = 8; j > 0; j >>= 1)
#pragma unroll
        for (int i = 0; i < 16; ++i) if ((i & j) == 0) ce_desc(a[i], a[i + j]);
}
DI void peer_topk_mfma(Frame& F, int tile) {
    const bf16* QP = (const bf16*)(F.ws + WS_ZX); const bf16* KEYF = (const bf16*)(F.ws + WS_KEYS);
    int* EXPERTS = (int*)(F.ws + WS_EXP); float* GATES = (float*)(F.ws + WS_GATE);
    #ifdef TOPK_OLDMAP
    const int lane = F.lane, hh = lane >> 5, ql = lane & 31, tb = F.wave >> 1, p = F.wave & 1;
#else
    const int lane = F.lane, hh = lane >> 5, ql = lane & 31, tb = F.wave & 3, p = F.wave >> 2;
#endif
    const int tokblk = tile * 4 + tb, tok = tokblk * 32 + ql;
    s16x8 qf[8], kf[8];
#pragma unroll
    for (int ks = 0; ks < 8; ++ks) qf[ks] = ((const s16x8*)(QP + ((size_t)tokblk * 16 + p) * 4096))[ks * 64 + lane];
    LAS v4u* KL = (LAS v4u*)(F.lds + 32768);
    v4u kp[8];
#define TK_KFETCH(h_) do { const v4u* kg_ = (const v4u*)(KEYF + (size_t)(2 * (h_)) * 16384) + F.tid; _Pragma("unroll") for (int k_ = 0; k_ < 8; ++k_) kp[k_] = kg_[512 * k_]; } while (0)
#define TK_KSTAGE() do { _Pragma("unroll") for (int k_ = 0; k_ < 8; ++k_) KL[F.tid + 512 * k_] = kp[k_]; } while (0)
    TK_KFETCH(0); TK_KSTAGE(); __syncthreads(); TK_KFETCH(1);
    const LAS s16x8* klp = (const LAS s16x8*)(F.lds + 32768 + p * 32768) + lane;
#pragma unroll 1
    for (int h = 0; h < 8; ++h) {
        const int hp = 2 * h + p, hpn = (h < 7) ? hp + 2 : hp;
#pragma unroll
        for (int ks = 0; ks < 8; ++ks) kf[ks] = klp[ks * 64];
        s16x8 qn[8];
#pragma unroll
        for (int ks = 0; ks < 8; ++ks) qn[ks] = ((const s16x8*)(QP + ((size_t)tokblk * 16 + hpn) * 4096))[ks * 64 + lane];
        __builtin_amdgcn_sched_barrier(0);
        int top[16];
#pragma unroll
        for (int i = 0; i < 16; ++i) top[i] = 0;
#pragma unroll 1
        for (int nt = 0; nt < 4; ++nt) {
            f32x16 acc;
#pragma unroll
            for (int i = 0; i < 16; ++i) acc[i] = TOPK_OFF;
#pragma unroll
            for (int ks = 0; ks < 8; ++ks) acc = MFMA32(kf[ks], qf[ks], acc);
            if (nt < 3) {
#pragma unroll
              for (int ks = 0; ks < 8; ++ks) kf[ks] = klp[((nt + 1) * 8 + ks) * 64]; }
            __builtin_amdgcn_sched_barrier(0);
            int a[16];
#pragma unroll
            for (int i = 0; i < 16; ++i) { const int n = 32 * nt + (i & 3) + 8 * (i >> 2) + 4 * hh; a[i] = (__float_as_int(acc[i]) & ~127) | n; }
            sort16_desc(a);
            merge16_desc(top, a);
        }
#pragma unroll
        for (int ks = 0; ks < 8; ++ks) qf[ks] = qn[ks];
        { int oth[16];
#pragma unroll
          for (int i = 0; i < 16; ++i) oth[i] = __shfl_xor(top[i], 32);
          merge16_desc(top, oth); }
        LAS float* L = (LAS float*)(F.lds) + (h & 1) * 4096 + (tb * 2) * 512;
        if (hh == 0) {
#pragma unroll
            for (int i = 0; i < 16; ++i) L[p * 512 + i * 32 + ql] = __int_as_float(top[i]);
        }
        __syncthreads();
        if (h < 7) { TK_KSTAGE(); if (h < 6) TK_KFETCH(h + 2); }
        __syncthreads();
        if (p == 0 && hh == 0) {
            float v0[16], v1[16];
#pragma unroll
            for (int i = 0; i < 16; ++i) { v0[i] = __int_as_float(__float_as_int(L[i * 32 + ql]) & ~127); v1[i] = __int_as_float(__float_as_int(L[512 + i * 32 + ql]) & ~127); }
#define TK_KEY(i_, j_) ((__float_as_int(v0[i_] + v1[j_]) & ~255) | ((15 - (i_)) * 16 + (15 - (j_))))
            int g0[16], g1[16], g2[16], g3[16]; int cnt = 0;
#pragma unroll
            for (int j = 0; j < 16; ++j) g0[j] = TK_KEY(0, j);
#pragma unroll
            for (int i = 1; i < 16; ++i) g1[i - 1] = TK_KEY(i, 0);
            g1[15] = 0;
#pragma unroll
            for (int i = 0; i < 16; ++i) g3[i] = 0;
#pragma unroll
            for (int i = 1; i < 16; ++i)
#pragma unroll
                for (int j = 1; j < 16; ++j) if ((i + 1) * (j + 1) <= 16) { if (cnt < 16) g2[cnt] = TK_KEY(i, j); else g3[cnt - 16] = TK_KEY(i, j); ++cnt; }
#undef TK_KEY
            merge16_desc(g0, g1);
            sort16_desc(g2);
            ce_desc(g3[0], g3[1]); ce_desc(g3[1], g3[2]); ce_desc(g3[0], g3[1]);
            merge16_desc(g2, g3); merge16_desc(g0, g2);
            float tv[16]; float e[16]; float sum = 0.f; int eid[16];
#pragma unroll
            for (int k = 0; k < 16; ++k) { const int bits = g0[k]; const int code = 255 - (bits & 255); tv[k] = __int_as_float(bits & ~255);
                const int n0 = __float_as_int(L[(code >> 4) * 32 + ql]) & 127, n1 = __float_as_int(L[512 + (code & 15) * 32 + ql]) & 127; eid[k] = n0 * 128 + n1; }
#pragma unroll
            for (int k = 0; k < 16; ++k) { e[k] = __expf(tv[k] - tv[0]); sum += e[k]; }
            const float is = 1.0f / sum;
            v2u* rp2 = (v2u*)EXPERTS + (size_t)tok * 128 + h * 16;
            (void)GATES;
#pragma unroll
            for (int k2 = 0; k2 < 8; ++k2) *(v4u*)(rp2 + 2 * k2) = (v4u){(unsigned)eid[2 * k2], __float_as_uint(e[2 * k2] * is), (unsigned)eid[2 * k2 + 1], __float_as_uint(e[2 * k2 + 1] * is)};
        }
    }
#undef TK_KFETCH
#undef TK_KSTAGE
    VM_WAIT(); __syncthreads();
}

DI float gelu_fast(float v) {
    const float av = fabsf(v), t = __builtin_amdgcn_rcpf(av * 0.2316418882f + 1.0f);
    float q = t * 0.5307027145f + (-0.7265760135f); q = q * t + 0.7107068705f; q = q * t + (-0.142248368f); q = q * t + 0.127414796f; q = q * t;
    const float e = __builtin_amdgcn_exp2f((v * v) * (-0.72134752044f));
    const float m = v * (q * e);
    return v < 0.f ? m : v - m;
}
DI float gelu_exact(float a) { return 0.5f * a * (1.0f + erff(a * 0.70710678118654752f)); }

DI void fp8x16_to_f32(const v4u r, float (&f)[16]) {
#pragma unroll
    for (int j = 0; j < 4; ++j) { const f32x2 lo = __builtin_amdgcn_cvt_pk_f32_fp8((int)r[j], false), hi = __builtin_amdgcn_cvt_pk_f32_fp8((int)r[j], true);
        f[4 * j] = lo.x; f[4 * j + 1] = lo.y; f[4 * j + 2] = hi.x; f[4 * j + 3] = hi.y; }
}
template <bool FAKE = false, bool UONLY = false> DI void gather_v4(Frame& F, int tbase) {
    constexpr int NT = 8, NK = 16, N = 1024;
    const bf16* H2 = (const bf16*)(F.ws + WS_HX); const unsigned char* U = F.ws + WS_U; const unsigned char* V = F.ws + WS_V;
    const int* EXPERTS = (const int*)(F.ws + WS_EXP); const float* GATES = (const float*)(F.ws + WS_GATE); const float* MOD = (const float*)(F.ws + WS_MOD);
    const float* SU = (const float*)(F.ws + WS_SU);
    const int lane = F.lane;
    constexpr int EM = FAKE ? FAKE_MASK : 16383;
    int key[NK];
#pragma unroll
    for (int j = 0; j < NT; ++j)
#pragma unroll
        for (int hf = 0; hf < 2; ++hf) { const int k = hf * 64 + lane; key[j * 2 + hf] = (EXPERTS[(size_t)(tbase + j) * 128 + k] << 10) | (j << 7) | k; }
#pragma unroll
    for (int k = 2; k <= N; k <<= 1)
#pragma unroll
        for (int j = k >> 1; j > 0; j >>= 1) {
            if (j < NK) {
#pragma unroll
                for (int r = 0; r < NK; ++r) if ((r & j) == 0) { const bool asc = (((lane * NK + r) & k) == 0); const int x = key[r], y = key[r | j], lo = min(x, y), hi = max(x, y);
                    key[r] = asc ? lo : hi; key[r | j] = asc ? hi : lo; }
            } else {
                const bool asc = (((lane * NK) & k) == 0), lower = ((lane & (j / NK)) == 0), takemin = (asc == lower);
#pragma unroll
                for (int r = 0; r < NK; ++r) { const int o = __shfl_xor(key[r], j / NK); key[r] = takemin ? min(key[r], o) : max(key[r], o); }
            }
        }
    LAS v4u* hL = (LAS v4u*)(F.lds) + F.wave * (NT * 64) + lane;
    LAS int* psL = (LAS int*)(F.lds + 65536) + F.wave * N;
    float hsc[NT];
    {
#pragma unroll
        for (int j = 0; j < NT; ++j) { const v4u a = *((const v4u*)(H2 + (size_t)(tbase + j) * DM + lane * 16)), b = *((const v4u*)(H2 + (size_t)(tbase + j) * DM + lane * 16 + 8));
            float hv[16]; hv[0] = bflo(a.x); hv[1] = bfhi(a.x); hv[2] = bflo(a.y); hv[3] = bfhi(a.y); hv[4] = bflo(a.z); hv[5] = bfhi(a.z); hv[6] = bflo(a.w); hv[7] = bfhi(a.w);
            hv[8] = bflo(b.x); hv[9] = bfhi(b.x); hv[10] = bflo(b.y); hv[11] = bfhi(b.y); hv[12] = bflo(b.z); hv[13] = bfhi(b.z); hv[14] = bflo(b.w); hv[15] = bfhi(b.w);
            float am = 0.f;
#pragma unroll
            for (int i = 0; i < 16; ++i) am = fmaxf(am, fabsf(hv[i]));
#pragma unroll
            for (int o = 1; o < 64; o <<= 1) am = fmaxf(am, __shfl_xor(am, o));
            am = fmaxf(am, 1e-30f); hsc[j] = am * (1.0f / 127.0f);
            const float inv = 127.0f / am;
            v4u hq;
#pragma unroll
            for (int d = 0; d < 4; ++d) { const int q0 = (int)rintf(hv[4 * d] * inv), q1 = (int)rintf(hv[4 * d + 1] * inv), q2 = (int)rintf(hv[4 * d + 2] * inv), q3 = (int)rintf(hv[4 * d + 3] * inv);
                hq[d] = (unsigned)(q0 & 255) | ((unsigned)(q1 & 255) << 8) | ((unsigned)(q2 & 255) << 16) | ((unsigned)(q3 & 255) << 24); }
            hL[j * 64] = hq; }
    }
#define V4_ROW(TBL, par, ln, r) (*((const v4u*)((TBL) + (size_t)((__builtin_amdgcn_readlane(key[(par) * 8 + (r)], (ln)) >> 10) & EM) * 1024) + lane))
    {   v4u ub[4][8];
#pragma unroll
        for (int q = 0; q < 4; ++q)
#pragma unroll
            for (int r = 0; r < 8; ++r) ub[q][r] = V4_ROW(U, q & 1, q >> 1, r);
#pragma unroll 1
        for (int b4 = 0; b4 < 32; ++b4) {
#pragma unroll
            for (int q = 0; q < 4; ++q) {
                const int par = q & 1, ln = 2 * b4 + (q >> 1), lnn = (ln + 2) & 63;
                int p[8]; v4u hsel[8];
#pragma unroll
                for (int r = 0; r < 8; ++r) { hsel[r] = hL[((__builtin_amdgcn_readlane(key[par * 8 + r], ln) >> 7) & 7) * 64]; p[r] = 0; }
#pragma unroll
                for (int qq = 0; qq < 4; ++qq)
#pragma unroll
                    for (int r = 0; r < 8; ++r) p[r] = __builtin_amdgcn_sdot4((int)ub[q][r][qq], (int)hsel[r][qq], p[r], false);
#pragma unroll
                for (int r = 0; r < 8; ++r) ub[q][r] = V4_ROW(U, par, lnn, r);
                int psum;
                { int q4[4];
#pragma unroll
                  for (int i = 0; i < 4; ++i) { auto rr = __builtin_amdgcn_permlane32_swap((unsigned)p[i], (unsigned)p[i + 4], false, false); q4[i] = (int)(rr[0] + rr[1]); }
                  int q2[2];
#pragma unroll
                  for (int i = 0; i < 2; ++i) { auto rr = __builtin_amdgcn_permlane16_swap((unsigned)q4[i], (unsigned)q4[i + 2], false, false); q2[i] = (int)(rr[0] + rr[1]); }
                  const int t0 = q2[0] + __builtin_amdgcn_update_dpp(0, q2[0], 0x128, 0xf, 0xf, false);
                  const int t1 = q2[1] + __builtin_amdgcn_update_dpp(0, q2[1], 0x128, 0xf, 0xf, false);
                  int v = (lane & 8) ? t1 : t0;
                  v += __builtin_amdgcn_update_dpp(0, v, 0x141, 0xf, 0xf, false);
                  v += __builtin_amdgcn_update_dpp(0, v, 0x4e, 0xf, 0xf, false);
                  v += __builtin_amdgcn_update_dpp(0, v, 0xb1, 0xf, 0xf, false);
                  psum = v; }
                if ((lane & 7) == 0) psL[(4 * b4 + q) * 8 + ((lane >> 3) & 7)] = psum;
            }
        }
    }
    if constexpr (!UONLY) {
    float wv[NK];
#pragma unroll
    for (int r = 0; r < NK; ++r) { const int tj = (key[r] >> 7) & 7; float sc = hsc[0];
#pragma unroll
        for (int j = 1; j < NT; ++j) sc = (tj == j) ? hsc[j] : sc;
        const float gate = GATES[(size_t)(tbase + tj) * 128 + (key[r] & 127)], su = SU[(key[r] >> 10) & EM] * sc;
        wv[r] = gate * gelu_fast((float)psL[lane * NK + r] * su); }
    LAS int* lst = (LAS int*)(F.lds) + F.wave * 2048;
    LAS float* lwt = (LAS float*)(lst + 1024);
    { int cnt0 = 0;
#pragma unroll
      for (int r = 0; r < NK; ++r) cnt0 += ((key[r] >> 9) & 1) ^ 1;
      int inc = cnt0;
#pragma unroll
      for (int o = 1; o < 64; o <<= 1) { const int t = __shfl_up(inc, o); if (lane >= o) inc += t; }
      int o0 = inc - cnt0, o1 = lane * NK - o0;
#pragma unroll
      for (int r = 0; r < NK; ++r) { const int g1 = (key[r] >> 9) & 1; const int ent = ((key[r] >> 10) << 2) | ((key[r] >> 7) & 3);
          if (g1) { lst[512 + o1] = ent; lwt[512 + o1] = wv[r]; ++o1; } else { lst[o0] = ent; lwt[o0] = wv[r]; ++o0; } } }
    const float* fg = F.in[17];
#pragma unroll 1
    for (int g = 0; g < 2; ++g) {
        int kg[8];
#pragma unroll
        for (int r = 0; r < 8; ++r) kg[r] = lst[g * 512 + lane * 8 + r];
        float out[4][16];
#pragma unroll
        for (int j = 0; j < 4; ++j)
#pragma unroll
            for (int i = 0; i < 16; ++i) out[j][i] = 0.f;
        v4u vb[2][8];
#pragma unroll
        for (int par = 0; par < 2; ++par)
#pragma unroll
            for (int r = 0; r < 8; ++r) vb[par][r] = *((const v4u*)(V + (size_t)((__builtin_amdgcn_readlane(kg[r], par) >> 2) & EM) * 1024) + lane);
#pragma unroll 1
        for (int b2 = 0; b2 < 32; ++b2) {
#pragma unroll
            for (int par = 0; par < 2; ++par) {
                const int b = 2 * b2 + par, bn = (b + 2 < 64) ? b + 2 : par;
                const f32x4 wa = *(const LAS f32x4*)(lwt + g * 512 + b * 8), wb = *(const LAS f32x4*)(lwt + g * 512 + b * 8 + 4);
#pragma unroll
                for (int r = 0; r < 8; ++r) { const int kk = __builtin_amdgcn_readlane(kg[r], b); const float wr = (r < 4) ? wa[r & 3] : wb[r & 3]; const int tk = kk & 3;
                    float f[16]; fp8x16_to_f32(vb[par][r], f);
#pragma unroll
                    for (int j = 0; j < 4; ++j) if (tk == j) {
#pragma unroll
                        for (int i = 0; i < 16; ++i) out[j][i] += wr * f[i]; } }
#pragma unroll
                for (int r = 0; r < 8; ++r) vb[par][r] = *((const v4u*)(V + (size_t)((__builtin_amdgcn_readlane(kg[r], bn) >> 2) & EM) * 1024) + lane);
            }
        }
#pragma unroll
        for (int j = 0; j < 4; ++j) {
            const int t = tbase + g * 4 + j, bb = t >> 12; const float* g2 = MOD + bb * NMOD + 5 * DM; float* xo = F.out + (size_t)t * DM;
            const bf16* x1r = (const bf16*)(F.ws + WS_X1) + (size_t)t * DM + lane * 16;
            float x2[16]; float ss = 0.f;
#pragma unroll
            for (int hq = 0; hq < 4; ++hq) { const int c = lane * 16 + hq * 4; const v2u xw = *(const v2u*)(x1r + hq * 4); const f32x4 xv = (f32x4){bflo(xw.x), bfhi(xw.x), bflo(xw.y), bfhi(xw.y)}, gv = *(const f32x4*)(g2 + c);
#pragma unroll
                for (int e = 0; e < 4; ++e) { const float y = xv[e] + gv[e] * (out[j][hq * 4 + e] * (1.0f / V_SCALE)); x2[hq * 4 + e] = y; ss += y * y; } }
            const float rinv = 1.0f / sqrtf(wave_sum(ss) * (1.f / DM) + EPS);
#pragma unroll
            for (int hq = 0; hq < 4; ++hq) { const int c = lane * 16 + hq * 4; const f32x4 fv = *(const f32x4*)(fg + c);
                f32x4 y;
#pragma unroll
                for (int e = 0; e < 4; ++e) y[e] = x2[hq * 4 + e] * rinv * fv[e];
                if (!FAKE || rinv == 12345.678f) *(f32x4*)(xo + c) = y; }
        }
    }
    }
}

template <bool FAKE = false> DI void gather_v6(Frame& F, int tbase) {
    constexpr int NT = 8;
    const bf16* H2 = (const bf16*)(F.ws + WS_HX); const unsigned char* U = F.ws + WS_U; const unsigned char* V = F.ws + WS_V;
    const int* EXPERTS = (const int*)(F.ws + WS_EXP); const float* GATES = (const float*)(F.ws + WS_GATE); const float* MOD = (const float*)(F.ws + WS_MOD);
    const float* SU = (const float*)(F.ws + WS_SU);
    const int lane = F.lane;
    constexpr int EM = FAKE ? FAKE_MASK : 16383;
    int key[NT][2];
#pragma unroll
    for (int j = 0; j < NT; ++j) {
#pragma unroll
        for (int r = 0; r < 2; ++r) { const int k = r * 64 + lane; key[j][r] = (EXPERTS[(size_t)(tbase + j) * 128 + k] << 7) | k; }
#pragma unroll
        for (int k = 2; k <= 128; k <<= 1)
#pragma unroll
            for (int jj = k >> 1; jj > 0; jj >>= 1) {
                if (jj < 2) { const bool asc = (((lane * 2) & k) == 0); const int x = key[j][0], y = key[j][1], lo = min(x, y), hi = max(x, y); key[j][0] = asc ? lo : hi; key[j][1] = asc ? hi : lo; }
                else { const bool asc = (((lane * 2) & k) == 0), lower = ((lane & (jj / 2)) == 0), takemin = (asc == lower);
#pragma unroll
                    for (int r = 0; r < 2; ++r) { const int o = __shfl_xor(key[j][r], jj / 2); key[j][r] = takemin ? min(key[j][r], o) : max(key[j][r], o); } }
            }
    }
    LAS int* psL = (LAS int*)(F.lds + 65536) + F.wave * 1024;
    float hsc[NT];
#define V6_ROW(TBL, jj, bb, r) (*((const v4u*)((TBL) + (size_t)((__builtin_amdgcn_readlane(key[jj][(r) & 1], (bb) * 4 + ((r) >> 1)) >> 7) & EM) * 1024) + lane))
    {
        unsigned hsq[NT][4];
#pragma unroll
        for (int j = 0; j < NT; ++j) { const v4u a = *((const v4u*)(H2 + (size_t)(tbase + j) * DM + lane * 16)), b = *((const v4u*)(H2 + (size_t)(tbase + j) * DM + lane * 16 + 8));
            float hv[16]; hv[0] = bflo(a.x); hv[1] = bfhi(a.x); hv[2] = bflo(a.y); hv[3] = bfhi(a.y); hv[4] = bflo(a.z); hv[5] = bfhi(a.z); hv[6] = bflo(a.w); hv[7] = bfhi(a.w);
            hv[8] = bflo(b.x); hv[9] = bfhi(b.x); hv[10] = bflo(b.y); hv[11] = bfhi(b.y); hv[12] = bflo(b.z); hv[13] = bfhi(b.z); hv[14] = bflo(b.w); hv[15] = bfhi(b.w);
            float am = 0.f;
#pragma unroll
            for (int i = 0; i < 16; ++i) am = fmaxf(am, fabsf(hv[i]));
#pragma unroll
            for (int o = 1; o < 64; o <<= 1) am = fmaxf(am, __shfl_xor(am, o));
            am = fmaxf(am, 1e-30f); hsc[j] = am * (1.0f / 127.0f);
            const float inv = 127.0f / am;
#pragma unroll
            for (int d = 0; d < 4; ++d) { const int q0 = (int)rintf(hv[4 * d] * inv), q1 = (int)rintf(hv[4 * d + 1] * inv), q2 = (int)rintf(hv[4 * d + 2] * inv), q3 = (int)rintf(hv[4 * d + 3] * inv);
                hsq[j][d] = (unsigned)(q0 & 255) | ((unsigned)(q1 & 255) << 8) | ((unsigned)(q2 & 255) << 16) | ((unsigned)(q3 & 255) << 24); } }
        v4u ub[4][8];
#pragma unroll
        for (int q = 0; q < 4; ++q)
#pragma unroll
            for (int r = 0; r < 8; ++r) ub[q][r] = V6_ROW(U, q, 0, r);
#pragma unroll 1
        for (int b = 0; b < 16; ++b) {
            const int bnx = (b + 1) & 15;
#pragma unroll
            for (int j = 0; j < NT; ++j) {
                int p[8];
#pragma unroll
                for (int r = 0; r < 8; ++r) p[r] = 0;
#pragma unroll
                for (int q = 0; q < 4; ++q)
#pragma unroll
                    for (int r = 0; r < 8; ++r) p[r] = __builtin_amdgcn_sdot4((int)ub[j & 3][r][q], (int)hsq[j][q], p[r], false);
#pragma unroll
                for (int r = 0; r < 8; ++r) ub[j & 3][r] = V6_ROW(U, (j + 4) & 7, (j < 4) ? b : bnx, r);
                int psum;
                { int q4[4];
#pragma unroll
                  for (int i = 0; i < 4; ++i) { auto rr = __builtin_amdgcn_permlane32_swap((unsigned)p[i], (unsigned)p[i + 4], false, false); q4[i] = (int)(rr[0] + rr[1]); }
                  int q2[2];
#pragma unroll
                  for (int i = 0; i < 2; ++i) { auto rr = __builtin_amdgcn_permlane16_swap((unsigned)q4[i], (unsigned)q4[i + 2], false, false); q2[i] = (int)(rr[0] + rr[1]); }
                  const int t0 = q2[0] + __builtin_amdgcn_update_dpp(0, q2[0], 0x128, 0xf, 0xf, false);
                  const int t1 = q2[1] + __builtin_amdgcn_update_dpp(0, q2[1], 0x128, 0xf, 0xf, false);
                  int v = (lane & 8) ? t1 : t0;
                  v += __builtin_amdgcn_update_dpp(0, v, 0x141, 0xf, 0xf, false);
                  v += __builtin_amdgcn_update_dpp(0, v, 0x4e, 0xf, 0xf, false);
                  v += __builtin_amdgcn_update_dpp(0, v, 0xb1, 0xf, 0xf, false);
                  psum = v; }
                if ((lane & 7) == 0) psL[j * 128 + b * 8 + ((lane >> 3) & 7)] = psum;
            }
        }
    }
    LAS float* wL = (LAS float*)psL;
#pragma unroll
    for (int j = 0; j < NT; ++j)
#pragma unroll
        for (int r = 0; r < 2; ++r) { const float gate = GATES[(size_t)(tbase + j) * 128 + (key[j][r] & 127)], su = SU[(key[j][r] >> 7) & EM] * hsc[j];
            const int ps = psL[j * 128 + lane * 2 + r]; wL[j * 128 + lane * 2 + r] = gate * gelu_fast((float)ps * su); }
    const float* fg = F.in[17];
#pragma unroll
    for (int g = 0; g < 2; ++g) {
        float out[4][16];
#pragma unroll
        for (int j = 0; j < 4; ++j)
#pragma unroll
            for (int i = 0; i < 16; ++i) out[j][i] = 0.f;
        v4u vb[2][8];
#pragma unroll
        for (int q = 0; q < 2; ++q)
#pragma unroll
            for (int r = 0; r < 8; ++r) vb[q][r] = V6_ROW(V, 4 * g + q, 0, r);
#pragma unroll 1
        for (int b = 0; b < 16; ++b) {
            const int bnx = (b + 1) & 15;
#pragma unroll
            for (int jj = 0; jj < 4; ++jj) {
                const int j = 4 * g + jj;
                const f32x4 wa = *(const LAS f32x4*)(wL + j * 128 + b * 8), wb = *(const LAS f32x4*)(wL + j * 128 + b * 8 + 4);
#pragma unroll
                for (int r = 0; r < 8; ++r) { const float wr = (r < 4) ? wa[r & 3] : wb[r & 3];
#pragma unroll
                    for (int q = 0; q < 4; ++q) { const f32x2 lo = __builtin_amdgcn_cvt_pk_f32_fp8((int)vb[jj & 1][r][q], false), hi = __builtin_amdgcn_cvt_pk_f32_fp8((int)vb[jj & 1][r][q], true);
                        out[jj][4 * q] += wr * lo.x; out[jj][4 * q + 1] += wr * lo.y; out[jj][4 * q + 2] += wr * hi.x; out[jj][4 * q + 3] += wr * hi.y; } }
#pragma unroll
                for (int r = 0; r < 8; ++r) vb[jj & 1][r] = V6_ROW(V, 4 * g + ((jj + 2) & 3), (jj < 2) ? b : bnx, r);
            }
        }
#pragma unroll
        for (int jj = 0; jj < 4; ++jj) {
            const int t = tbase + g * 4 + jj, bb = t >> 12; const float* g2 = MOD + bb * NMOD + 5 * DM; float* xo = F.out + (size_t)t * DM;
            const bf16* x1r = (const bf16*)(F.ws + WS_X1) + (size_t)t * DM + lane * 16;
            float x2[16]; float ss = 0.f;
#pragma unroll
            for (int hq = 0; hq < 4; ++hq) { const int c = lane * 16 + hq * 4; const v2u xw = *(const v2u*)(x1r + hq * 4); const f32x4 xv = (f32x4){bflo(xw.x), bfhi(xw.x), bflo(xw.y), bfhi(xw.y)}, gv = *(const f32x4*)(g2 + c);
#pragma unroll
                for (int e = 0; e < 4; ++e) { const float y = xv[e] + gv[e] * (out[jj][hq * 4 + e] * (1.0f / V_SCALE)); x2[hq * 4 + e] = y; ss += y * y; } }
            const float rinv = 1.0f / sqrtf(wave_sum(ss) * (1.f / DM) + EPS);
#pragma unroll
            for (int hq = 0; hq < 4; ++hq) { const int c = lane * 16 + hq * 4; const f32x4 fv = *(const f32x4*)(fg + c);
                f32x4 y;
#pragma unroll
                for (int e = 0; e < 4; ++e) y[e] = x2[hq * 4 + e] * rinv * fv[e];
                if (!FAKE || rinv == 12345.678f) *(f32x4*)(xo + c) = y; }
            asm volatile("" ::: "memory");
        }
    }
#undef V6_ROW
}

typedef _Float16 h2 __attribute__((ext_vector_type(2)));
template <int PARTS = 3> DI void gather_v7(Frame& F, int tbase) {
    constexpr int NT = 8;
    const bf16* H2 = (const bf16*)(F.ws + WS_HX); const unsigned char* U = F.ws + WS_U; const unsigned char* V = F.ws + WS_V;
    const int* EXPERTS = (const int*)(F.ws + WS_EXP); const float* GATES = (const float*)(F.ws + WS_GATE); const float* MOD = (const float*)(F.ws + WS_MOD);
    const float* SU = (const float*)(F.ws + WS_SU); const float* SV = (const float*)(F.ws + WS_SV);
    const int lane = F.lane, l31 = lane & 31; const unsigned hi01 = (unsigned)lane >> 5, l31x16 = (unsigned)l31 << 4;
    int key[NT][2];
#pragma unroll
    for (int j = 0; j < NT; ++j) {
#pragma unroll
        for (int r = 0; r < 2; ++r) { const int k = r * 64 + lane; key[j][r] = (EXPERTS[(size_t)(tbase + j) * 128 + k] << 7) | k; }
#pragma unroll
        for (int k = 2; k <= 128; k <<= 1)
#pragma unroll
            for (int jj = k >> 1; jj > 0; jj >>= 1) {
                if (jj < 2) { const bool asc = (((lane * 2) & k) == 0); const int x = key[j][0], y = key[j][1], lo = min(x, y), hi = max(x, y); key[j][0] = asc ? lo : hi; key[j][1] = asc ? hi : lo; }
                else { const bool asc = (((lane * 2) & k) == 0), lower = ((lane & (jj / 2)) == 0), takemin = (asc == lower);
#pragma unroll
                    for (int r = 0; r < 2; ++r) { const int o = __shfl_xor(key[j][r], jj / 2); key[j][r] = takemin ? min(key[j][r], o) : max(key[j][r], o); } }
            }
    }
    LAS int* psL = (LAS int*)(F.lds + 65536) + F.wave * 1024;
    float hsc[NT], hoff[NT];
#define V7_E(jj, bb, r) (__builtin_amdgcn_readlane(key[jj][(r) & 1], (bb) * 4 + ((r) >> 1)) >> 7)
#define V7_ROW2(TBL, jj, bb, i) (*(const v4u*)((TBL) + ((size_t)V7_E(jj, bb, i) << 9) + (__umul24(hi01, (unsigned)(V7_E(jj, bb, (i) + 4) - V7_E(jj, bb, i)) << 9) + l31x16)))
    if (PARTS & 1) {
        unsigned ha[NT][4], hb[NT][4];
#pragma unroll
        for (int j = 0; j < NT; ++j) { const v4u* hp = (const v4u*)(H2 + (size_t)(tbase + j) * DM + l31 * 32);
            float hv[32];
#pragma unroll
            for (int q = 0; q < 4; ++q) { const v4u a = hp[q]; hv[8 * q] = bflo(a.x); hv[8 * q + 1] = bfhi(a.x); hv[8 * q + 2] = bflo(a.y); hv[8 * q + 3] = bfhi(a.y); hv[8 * q + 4] = bflo(a.z); hv[8 * q + 5] = bfhi(a.z); hv[8 * q + 6] = bflo(a.w); hv[8 * q + 7] = bfhi(a.w); }
            float am = 0.f;
#pragma unroll
            for (int i = 0; i < 32; ++i) am = fmaxf(am, fabsf(hv[i]));
#pragma unroll
            for (int o = 1; o < 32; o <<= 1) am = fmaxf(am, __shfl_xor(am, o));
            am = fmaxf(am, 1e-30f); hsc[j] = am * (1.0f / 119.0f);
            const float inv = 119.0f / am; int hs = 0;
#pragma unroll
            for (int q = 0; q < 4; ++q) { unsigned wa = 0, wb = 0;
#pragma unroll
                for (int i = 0; i < 8; ++i) { const int h = (int)rintf(hv[8 * q + i] * inv), a = (h + 8) >> 4, b = h - 16 * a; hs += h; wa |= (unsigned)(a & 15) << (4 * i); wb |= (unsigned)(b & 15) << (4 * i); }
                ha[j][q] = wa; hb[j][q] = wb; }
#pragma unroll
            for (int o = 1; o < 32; o <<= 1) hs += __shfl_xor(hs, o);
            hoff[j] = 0.5f * (float)hs; }
        v4u ub[4][4];
#pragma unroll
        for (int q = 0; q < 4; ++q)
#pragma unroll
            for (int i = 0; i < 4; ++i) ub[q][i] = V7_ROW2(U, q, 0, i);
#pragma unroll 1
        for (int b = 0; b < 16; ++b) {
            const int bnx = (b + 1) & 15;
#pragma unroll
            for (int j = 0; j < NT; ++j) {
                int pa[4], pb[4];
#pragma unroll
                for (int i = 0; i < 4; ++i) { pa[i] = 0; pb[i] = 0; }
#pragma unroll
                for (int q = 0; q < 4; ++q)
#pragma unroll
                    for (int i = 0; i < 4; ++i) { pa[i] = __builtin_amdgcn_sdot8((int)ub[j & 3][i][q], (int)ha[j][q], pa[i], false); pb[i] = __builtin_amdgcn_sdot8((int)ub[j & 3][i][q], (int)hb[j][q], pb[i], false); }
#pragma unroll
                for (int i = 0; i < 4; ++i) ub[j & 3][i] = V7_ROW2(U, (j + 4) & 7, (j < 4) ? b : bnx, i);
                int psum;
                { int p[4];
#pragma unroll
                  for (int i = 0; i < 4; ++i) p[i] = (pa[i] << 4) + pb[i];
                  int q2[2];
#pragma unroll
                  for (int i = 0; i < 2; ++i) { auto rr = __builtin_amdgcn_permlane16_swap((unsigned)p[i], (unsigned)p[i + 2], false, false); q2[i] = (int)(rr[0] + rr[1]); }
                  const int t0 = q2[0] + __builtin_amdgcn_update_dpp(0, q2[0], 0x128, 0xf, 0xf, false);
                  const int t1 = q2[1] + __builtin_amdgcn_update_dpp(0, q2[1], 0x128, 0xf, 0xf, false);
                  int v = (lane & 8) ? t1 : t0;
                  v += __builtin_amdgcn_update_dpp(0, v, 0x141, 0xf, 0xf, false);
                  v += __builtin_amdgcn_update_dpp(0, v, 0x4e, 0xf, 0xf, false);
                  v += __builtin_amdgcn_update_dpp(0, v, 0xb1, 0xf, 0xf, false);
                  psum = v; }
                if ((lane & 7) == 0) psL[j * 128 + b * 8 + (lane >> 3)] = psum;
            }
        }
    }
    if (!(PARTS & 1)) {
#pragma unroll
        for (int j = 0; j < NT; ++j) { hsc[j] = 1.f; hoff[j] = 0.f; } }
    float wmax[NT];
#pragma unroll
    for (int j = 0; j < NT; ++j) { float w[2];
#pragma unroll
        for (int r = 0; r < 2; ++r) { const int e = key[j][r] >> 7; const float gate = GATES[(size_t)(tbase + j) * 128 + (key[j][r] & 127)], su = SU[e] * hsc[j], sv = SV[e];
            const int ps = psL[j * 128 + lane * 2 + r];
#ifdef DBG_UEXACT
            float sd = 0.f; { const float* ur = F.in[15] + (size_t)e * 1024; const bf16* hr = H2 + (size_t)(tbase + j) * DM;
#pragma unroll 8
              for (int d = 0; d < 1024; ++d) sd += ur[d] * __uint_as_float((unsigned)hr[d] << 16); }
            w[r] = gate * gelu_fast(sd) * sv; (void)ps; (void)su; }
#else
            w[r] = gate * gelu_fast(((float)ps + hoff[j]) * su) * sv; }
#endif
        float m = fmaxf(fabsf(w[0]), fabsf(w[1]));
#pragma unroll
        for (int o = 1; o < 64; o <<= 1) m = fmaxf(m, __shfl_xor(m, o));
        m = fmaxf(m, 1e-30f); wmax[j] = m; const float rm = 1.0f / m;
#pragma unroll
        for (int r = 0; r < 2; ++r) { const _Float16 hw = (_Float16)(w[r] * rm); const h2 pw = {hw, hw}; psL[j * 128 + lane * 2 + r] = __builtin_bit_cast(int, pw); } }
    const float* fg = F.in[17];
    const int d0 = l31 * 32 + (int)hi01 * 16;
#pragma unroll
    for (int g = 0; g < ((PARTS & 2) ? 2 : 0); ++g) {
        h2 out[4][16];
#pragma unroll
        for (int j = 0; j < 4; ++j)
#pragma unroll
            for (int i = 0; i < 16; ++i) out[j][i] = (h2){(_Float16)0.f, (_Float16)0.f};
        v4u vb[4][4];
#pragma unroll
        for (int q = 0; q < 4; ++q)
#pragma unroll
            for (int i = 0; i < 4; ++i) vb[q][i] = V7_ROW2(V, 4 * g + q, 0, i);
#pragma unroll 1
        for (int b = 0; b < 16; ++b) {
            const int bnx = (b + 1) & 15;
#pragma unroll
            for (int jj = 0; jj < 4; ++jj) {
                const int j = 4 * g + jj;
                const v4u wq = *(const LAS v4u*)(psL + j * 128 + b * 8 + (int)hi01 * 4);
#pragma unroll
                for (int i = 0; i < 4; ++i) { const unsigned wi = wq[i]; const h2 w = __builtin_bit_cast(h2, wi);
#pragma unroll
                    for (int q = 0; q < 4; ++q) {
                        out[jj][4 * q + 0] = __builtin_elementwise_fma(__builtin_bit_cast(h2, __builtin_amdgcn_cvt_scalef32_pk_f16_fp4(vb[jj][i][q], 1.0f, 0)), w, out[jj][4 * q + 0]);
                        out[jj][4 * q + 1] = __builtin_elementwise_fma(__builtin_bit_cast(h2, __builtin_amdgcn_cvt_scalef32_pk_f16_fp4(vb[jj][i][q], 1.0f, 1)), w, out[jj][4 * q + 1]);
                        out[jj][4 * q + 2] = __builtin_elementwise_fma(__builtin_bit_cast(h2, __builtin_amdgcn_cvt_scalef32_pk_f16_fp4(vb[jj][i][q], 1.0f, 2)), w, out[jj][4 * q + 2]);
                        out[jj][4 * q + 3] = __builtin_elementwise_fma(__builtin_bit_cast(h2, __builtin_amdgcn_cvt_scalef32_pk_f16_fp4(vb[jj][i][q], 1.0f, 3)), w, out[jj][4 * q + 3]); } }
#pragma unroll
                for (int i = 0; i < 4; ++i) vb[jj][i] = V7_ROW2(V, j, bnx, i);
            }
        }
#pragma unroll
        for (int jj = 0; jj < 4; ++jj) {
            const int t = tbase + g * 4 + jj, bb = t >> 12; const float* g2 = MOD + bb * NMOD + 5 * DM; float* xo = F.out + (size_t)t * DM;
            const bf16* x1r = (const bf16*)(F.ws + WS_X1) + (size_t)t * DM + d0;
            const float wm = wmax[g * 4 + jj];
            float x2[16]; float ss = 0.f;
            float ov[16];
#pragma unroll
            for (int i = 0; i < 8; ++i) { auto rr = __builtin_amdgcn_permlane32_swap(__builtin_bit_cast(unsigned, out[jj][i]), __builtin_bit_cast(unsigned, out[jj][i + 8]), false, false);
                const unsigned r0 = rr[0], r1 = rr[1]; const h2 sm = __builtin_bit_cast(h2, r0) + __builtin_bit_cast(h2, r1); ov[2 * i] = (float)sm.x * wm; ov[2 * i + 1] = (float)sm.y * wm; }
#pragma unroll
            for (int hq = 0; hq < 4; ++hq) { const int c = d0 + hq * 4; const v2u xw = *(const v2u*)(x1r + hq * 4); const f32x4 xv = (f32x4){bflo(xw.x), bfhi(xw.x), bflo(xw.y), bfhi(xw.y)}, gv = *(const f32x4*)(g2 + c);
#pragma unroll
                for (int e = 0; e < 4; ++e) { const float y = xv[e] + gv[e] * ov[hq * 4 + e]; x2[hq * 4 + e] = y; ss += y * y; } }
            const float rinv = 1.0f / sqrtf(wave_sum(ss) * (1.f / DM) + EPS);
#pragma unroll
            for (int hq = 0; hq < 4; ++hq) { const int c = d0 + hq * 4; const f32x4 fv = *(const f32x4*)(fg + c);
                f32x4 y;
#pragma unroll
                for (int e = 0; e < 4; ++e) y[e] = x2[hq * 4 + e] * rinv * fv[e];
                if (PARTS == 3 || rinv == 12345.678f) *(f32x4*)(xo + c) = y; }
            asm volatile("" ::: "memory");
        }
    }
    if (!(PARTS & 2)) { if (wmax[0] + wmax[1] + wmax[2] + wmax[3] + wmax[4] + wmax[5] + wmax[6] + wmax[7] == 12345.678f) F.out[lane] = 0.f; }
#undef V7_ROW2
#undef V7_E
}

constexpr int V8_VEC_OFF = 98304;
constexpr int V8_SLOT_WORDS = 4 * 128 + 32 + 4 * 128;
#ifndef V8_LAG
#define V8_LAG (F.wave >> 2)
#endif
DI void gv8_front(Frame& F, int tb, LAS unsigned* ent) {
    constexpr int NT = 4;
    const bf16* H2 = (const bf16*)(F.ws + WS_X1); const unsigned char* U = F.ws + WS_U;
    const int* EXPERTS = (const int*)(F.ws + WS_EXP);
    const float* SU = (const float*)(F.ws + WS_SU); const float* SV = (const float*)(F.ws + WS_SV);
    const int lane = F.lane, l31 = lane & 31; const unsigned hi01 = (unsigned)lane >> 5, l31x16 = (unsigned)l31 << 4;
    const bool x4 = xor4_sel(lane);
    int key[NT][2];
    v4u hraw[NT][2]; unsigned rssq[NT]; f32x4 shq[4], gsq[4];
#pragma unroll
    for (int j = 0; j < NT; ++j)
#pragma unroll
        for (int r = 0; r < 2; ++r) { const int k = r * 64 + lane; const v2u rc = ((const v2u*)EXPERTS)[(size_t)(tb + j) * 128 + k]; key[j][r] = ((int)rc.x << 7) | k;
            ent[544 + j * 128 + k] = rc.y; }
#pragma unroll
    for (int j = 0; j < NT; ++j) { const v4u* hp = (const v4u*)(H2 + (size_t)(tb + j) * DM + l31 * 32 + (int)hi01 * 16); rssq[j] = ((const unsigned*)(F.ws + WS_RSS))[tb + j];
#pragma unroll
        for (int q = 0; q < 2; ++q) hraw[j][q] = hp[q]; }
    { const int bb = tb >> 12;
      (void)bb; const LAS f32x4* shp = (const LAS f32x4*)(F.lds + V8_VEC_OFF + 0 * 4096 + (l31 * 32 + (int)hi01 * 16) * 4); const LAS f32x4* gsp = (const LAS f32x4*)(F.lds + V8_VEC_OFF + 1 * 4096 + (l31 * 32 + (int)hi01 * 16) * 4);
#pragma unroll
      for (int q = 0; q < 4; ++q) { shq[q] = shp[q]; gsq[q] = gsp[q]; } }
    __builtin_amdgcn_sched_barrier(0);
#pragma unroll
    for (int j = 0; j < NT; ++j) {
#pragma unroll
        for (int k = 2; k <= 128; k <<= 1)
#pragma unroll
            for (int jj = k >> 1; jj > 0; jj >>= 1) {
                if (jj < 2) { const bool asc = (((lane * 2) & k) == 0); const int x = key[j][0], y = key[j][1], lo = min(x, y), hi = max(x, y); key[j][0] = asc ? lo : hi; key[j][1] = asc ? hi : lo; }
                else { const bool asc = (((lane * 2) & k) == 0), lower = ((lane & (jj / 2)) == 0), takemin = (asc == lower);
#pragma unroll
                    for (int r = 0; r < 2; ++r) { const int o = xorlane(key[j][r], jj / 2, x4, lane); key[j][r] = takemin ? min(key[j][r], o) : max(key[j][r], o); } }
            }
        *(LAS v2u*)(ent + j * 128 + lane * 2) = (v2u){(unsigned)(key[j][0] >> 7), (unsigned)(key[j][1] >> 7)};
    }
    float hsc[NT], hoff[NT];
    unsigned ha[NT][4], hb[NT][4];
#pragma unroll
    for (int j = 0; j < NT; ++j) {
        float hv[16];
#pragma unroll
        for (int q = 0; q < 2; ++q) { const v4u a = hraw[j][q]; hv[8 * q] = bflo(a.x); hv[8 * q + 1] = bfhi(a.x); hv[8 * q + 2] = bflo(a.y); hv[8 * q + 3] = bfhi(a.y); hv[8 * q + 4] = bflo(a.z); hv[8 * q + 5] = bfhi(a.z); hv[8 * q + 6] = bflo(a.w); hv[8 * q + 7] = bfhi(a.w); }
        { const float rinv = 1.0f / sqrtf((float)rssq[j] * (RSS_UNFIX / DM) + EPS);
#pragma unroll
          for (int q = 0; q < 4; ++q) { const f32x4 sh = shq[q], gs = gsq[q]; hv[4 * q] = hv[4 * q] * rinv * gs.x + sh.x; hv[4 * q + 1] = hv[4 * q + 1] * rinv * gs.y + sh.y; hv[4 * q + 2] = hv[4 * q + 2] * rinv * gs.z + sh.z; hv[4 * q + 3] = hv[4 * q + 3] * rinv * gs.w + sh.w; } }
        float am = 0.f;
#pragma unroll
        for (int i = 0; i < 16; ++i) am = fmaxf(am, fabsf(hv[i]));
        am = lanes_max<64>(am, x4, lane);
        am = fmaxf(am, 1e-30f); hsc[j] = am * (1.0f / 119.0f);
        const float inv = 119.0f / am;
        unsigned D[4], hsum = 0;
#pragma unroll
        for (int q2 = 0; q2 < 4; ++q2) { unsigned bq[4];
#pragma unroll
            for (int i = 0; i < 4; ++i) bq[i] = __float_as_uint(__builtin_fmaf(hv[4 * q2 + i], inv, 12583048.0f));
            const unsigned p01 = __builtin_amdgcn_perm(bq[1], bq[0], 0x0c0c0400u), p23 = __builtin_amdgcn_perm(bq[3], bq[2], 0x0c0c0400u), d = __builtin_amdgcn_perm(p23, p01, 0x05040100u);
            hsum = __builtin_amdgcn_sad_u8(d, 0u, hsum); D[q2] = d ^ 0x88888888u; }
#pragma unroll
        for (int qq = 0; qq < 2; ++qq) {
            const unsigned pa_ = (D[2 * qq] & 0xF0F0F0F0u) | ((D[2 * qq + 1] >> 4) & 0x0F0F0F0Fu), pb_ = ((D[2 * qq] << 4) & 0xF0F0F0F0u) | (D[2 * qq + 1] & 0x0F0F0F0Fu);
            { auto rr = __builtin_amdgcn_permlane32_swap(pa_, pa_, false, false); const unsigned lo_ = rr[0], hi_ = rr[1]; ha[j][qq] = lo_; ha[j][2 + qq] = hi_; }
            { auto rr = __builtin_amdgcn_permlane32_swap(pb_, pb_, false, false); const unsigned lo_ = rr[0], hi_ = rr[1]; hb[j][qq] = lo_; hb[j][2 + qq] = hi_; } }
        int hs = (int)hsum - 16 * 136;
        hs = lanes_sum_i<64>(hs, x4, lane);
        hoff[j] = 0.5f * (float)hs; }
    const LAS v4u* ent4 = (const LAS v4u*)ent;
#define V8_UROW(x) (*(const v4u*)(U + (((x) << 9) | l31x16)))
#ifndef V8_NBU
#define V8_NBU 2
#endif
    constexpr int NBU = V8_NBU;
    v4u ub[NBU][4];
#pragma unroll
    for (int s0 = 0; s0 < NBU; ++s0) { const v4u en = ent4[(s0 & 3) * 32 + (s0 >> 2) * 2 + hi01];
#pragma unroll
        for (int i = 0; i < 4; ++i) { const unsigned x = en[i]; ub[s0][i] = V8_UROW(x); } }
#pragma unroll 1
    for (int b = 0; b < 16; ++b) {
#pragma unroll
        for (int j = 0; j < NT; ++j) {
            const bool past = b + ((j + NBU) >> 2) > 15;
            const int sl = j % NBU, jn = past ? j : ((j + NBU) & 3), bn = past ? 15 : b + ((j + NBU) >> 2);
            const v4u nx = ent4[jn * 32 + bn * 2 + hi01];
            int pa[4], pb[4];
#pragma unroll
            for (int i = 0; i < 4; ++i) { pa[i] = 0; pb[i] = 0; }
#pragma unroll
            for (int q = 0; q < 4; ++q)
#pragma unroll
                for (int i = 0; i < 4; ++i) { pa[i] = __builtin_amdgcn_sdot8((int)ub[sl][i][q], (int)ha[j][q], pa[i], false); pb[i] = __builtin_amdgcn_sdot8((int)ub[sl][i][q], (int)hb[j][q], pb[i], false); }
#pragma unroll
            for (int i = 0; i < 4; ++i) { const unsigned x = nx[i]; ub[sl][i] = V8_UROW(x); }
            int psum;
            { int p[4];
#pragma unroll
              for (int i = 0; i < 4; ++i) p[i] = (pa[i] << 4) + pb[i];
              int q2[2];
#pragma unroll
              for (int i = 0; i < 2; ++i) { auto rr = __builtin_amdgcn_permlane16_swap((unsigned)p[i], (unsigned)p[i + 2], false, false); q2[i] = (int)(rr[0] + rr[1]); }
              const int t0 = q2[0] + __builtin_amdgcn_update_dpp(0, q2[0], 0x128, 0xf, 0xf, false);
              const int t1 = q2[1] + __builtin_amdgcn_update_dpp(0, q2[1], 0x128, 0xf, 0xf, false);
              int v = (lane & 8) ? t1 : t0;
              v += __builtin_amdgcn_update_dpp(0, v, 0x141, 0xf, 0xf, false);
              v += __builtin_amdgcn_update_dpp(0, v, 0x4e, 0xf, 0xf, false);
              v += __builtin_amdgcn_update_dpp(0, v, 0xb1, 0xf, 0xf, false);
              psum = v; }
            if ((lane & 7) == 0) ent[j * 128 + b * 8 + (lane >> 3)] = (unsigned)psum;
        }
    }
#undef V8_UROW
    float gq[NT][2], suq[NT][2], svq[NT][2];
#pragma unroll
    for (int j = 0; j < NT; ++j)
#pragma unroll
        for (int r = 0; r < 2; ++r) { const int e = key[j][r] >> 7; gq[j][r] = __uint_as_float(ent[544 + j * 128 + (key[j][r] & 127)]); { const f32x2 sq = *(const f32x2*)(SU + 2 * e); suq[j][r] = sq.x; svq[j][r] = sq.y; } }
    __builtin_amdgcn_sched_barrier(0);
#pragma unroll
    for (int j = 0; j < NT; ++j) { float w[2];
#pragma unroll
        for (int r = 0; r < 2; ++r) { const float gate = gq[j][r], su = suq[j][r] * hsc[j], sv = svq[j][r];
            const int ps = (int)ent[j * 128 + lane * 2 + r]; w[r] = gate * gelu_fast(((float)ps + hoff[j]) * su) * sv; }
        float m = fmaxf(fabsf(w[0]), fabsf(w[1]));
        m = lanes_max<64>(m, x4, lane);
        m = fmaxf(m, 1e-30f); const float rm = 1.0f / m;
        unsigned wd[2];
#pragma unroll
        for (int r = 0; r < 2; ++r) { const _Float16 hw = (_Float16)(w[r] * rm); const h2 pw = {hw, hw}; wd[r] = __builtin_bit_cast(unsigned, pw); }
        *(LAS v2u*)(ent + j * 128 + lane * 2) = (v2u){(unsigned)(key[j][0] >> 7) << 9, (unsigned)(key[j][1] >> 7) << 9};
        *(LAS v2u*)(ent + 544 + j * 128 + lane * 2) = (v2u){wd[0], wd[1]};
        if (lane == 0) ((LAS float*)(ent + 512))[j] = m; }
}

template <int BMODE = 0> DI void gv8_back(Frame& F, int tb, const LAS unsigned* ent) {
    const unsigned char* V = F.ws + WS_V; const float* MOD = (const float*)(F.ws + WS_MOD); const float* fg = F.in[17];
    const int lane = F.lane, l31 = lane & 31; const unsigned hi01 = (unsigned)lane >> 5, l31x16 = (unsigned)l31 << 4;
    const int d0 = l31 * 32 + (int)hi01 * 16;
    const LAS v4u* ent4 = (const LAS v4u*)ent;
#define V8_VROW(x) (*(const v4u*)(V + ((x) | l31x16)))
    h2 out[4][16];
#pragma unroll
    for (int j = 0; j < 4; ++j)
#pragma unroll
        for (int i = 0; i < 16; ++i) out[j][i] = (h2){(_Float16)0.f, (_Float16)0.f};
#ifndef V8_NB
#define V8_NB 2
#endif
    constexpr int NB = V8_NB;
    const LAS v4u* wgt4 = (const LAS v4u*)(ent + 544);
    v4u en[NB], vb[NB][4];
#pragma unroll
    for (int s0 = 0; s0 < NB; ++s0) { const v4u eo = ent4[(s0 & 3) * 32 + (s0 >> 2) * 2 + hi01]; en[s0] = wgt4[(s0 & 3) * 32 + (s0 >> 2) * 2 + hi01];
#pragma unroll
        for (int i = 0; i < 4; ++i) { const unsigned x = eo[i]; vb[s0][i] = V8_VROW(x); } }
#pragma unroll 1
    for (int b = 0; b < 16; b += (NB > 4 ? 2 : 1)) {
#pragma unroll
        for (int bi = 0; bi < (NB > 4 ? 2 : 1); ++bi)
#pragma unroll
        for (int jj = 0; jj < 4; ++jj) {
            constexpr int dummy = 0; (void)dummy;
            const int sl = (bi * 4 + jj) % NB;
            const int jn = (jj + NB) & 3, bnx = min(b + bi + ((jj + NB) >> 2), 15);
            const v4u nx = ent4[jn * 32 + bnx * 2 + hi01], nw = wgt4[jn * 32 + bnx * 2 + hi01];
            __builtin_amdgcn_sched_barrier(0);
#pragma unroll
            for (int i = 0; i < 4; ++i) { const unsigned wi = en[sl][i]; const h2 w = __builtin_bit_cast(h2, wi);
                if (BMODE == 1 || BMODE == 4) { out[jj][i] = __builtin_bit_cast(h2, __builtin_bit_cast(unsigned, out[jj][i]) ^ vb[sl][i][0] ^ vb[sl][i][1] ^ vb[sl][i][2] ^ vb[sl][i][3] ^ wi); }
                else {
#pragma unroll
                for (int q = 0; q < 4; ++q) {
                    out[jj][4 * q + 0] = __builtin_elementwise_fma(__builtin_bit_cast(h2, __builtin_amdgcn_cvt_scalef32_pk_f16_fp4(vb[sl][i][q], 1.0f, 0)), w, out[jj][4 * q + 0]);
                    out[jj][4 * q + 1] = __builtin_elementwise_fma(__builtin_bit_cast(h2, __builtin_amdgcn_cvt_scalef32_pk_f16_fp4(vb[sl][i][q], 1.0f, 1)), w, out[jj][4 * q + 1]);
                    out[jj][4 * q + 2] = __builtin_elementwise_fma(__builtin_bit_cast(h2, __builtin_amdgcn_cvt_scalef32_pk_f16_fp4(vb[sl][i][q], 1.0f, 2)), w, out[jj][4 * q + 2]);
                    out[jj][4 * q + 3] = __builtin_elementwise_fma(__builtin_bit_cast(h2, __builtin_amdgcn_cvt_scalef32_pk_f16_fp4(vb[sl][i][q], 1.0f, 3)), w, out[jj][4 * q + 3]); } }
                if (BMODE != 2) { const unsigned x = nx[i]; vb[sl][i] = V8_VROW(x); }
                else {
#pragma unroll
                    for (int q = 0; q < 4; ++q) vb[sl][i][q] += nx[i]; }
                __builtin_amdgcn_sched_barrier(0);
            }
            en[sl] = nw;
        }
    }
#undef V8_VROW
    const float* g2 = MOD + (tb >> 12) * NMOD + 5 * DM;
    f32x4 gvq[4], fvq[4]; v2u xq[4][4]; float wmq[4];
#pragma unroll
    for (int hq = 0; hq < 4; ++hq) { gvq[hq] = *(const LAS f32x4*)(F.lds + V8_VEC_OFF + 2 * 4096 + (d0 + hq * 4) * 4); fvq[hq] = *(const LAS f32x4*)(F.lds + V8_VEC_OFF + 3 * 4096 + (d0 + hq * 4) * 4); }
    (void)g2; (void)fg;
#pragma unroll
    for (int jj = 0; jj < 4; ++jj) { const bf16* x1r = (const bf16*)(F.ws + WS_X1) + (size_t)(tb + jj) * DM + d0; wmq[jj] = ((const LAS float*)(ent + 512))[jj];
#pragma unroll
        for (int hq = 0; hq < 2; ++hq) { const v4u t4 = *(const v4u*)(x1r + hq * 8); xq[jj][2 * hq] = (v2u){t4.x, t4.y}; xq[jj][2 * hq + 1] = (v2u){t4.z, t4.w}; } }
    __builtin_amdgcn_sched_barrier(0);
#pragma unroll
    for (int jj = 0; jj < 4; ++jj) {
        float* xo = F.out + (size_t)(tb + jj) * DM;
        const float wm = wmq[jj];
        float x2[16], ov[16]; float ss = 0.f;
#pragma unroll
        for (int i = 0; i < 8; ++i) { auto rr = __builtin_amdgcn_permlane32_swap(__builtin_bit_cast(unsigned, out[jj][i]), __builtin_bit_cast(unsigned, out[jj][i + 8]), false, false);
            const unsigned r0 = rr[0], r1 = rr[1]; const h2 sm = __builtin_bit_cast(h2, r0) + __builtin_bit_cast(h2, r1); ov[2 * i] = (float)sm.x * wm; ov[2 * i + 1] = (float)sm.y * wm; }
#pragma unroll
        for (int hq = 0; hq < 4; ++hq) { const v2u xw = xq[jj][hq]; const f32x4 xv = (f32x4){bflo(xw.x), bfhi(xw.x), bflo(xw.y), bfhi(xw.y)}, gv = gvq[hq];
#pragma unroll
            for (int e = 0; e < 4; ++e) { const float y = xv[e] + gv[e] * ov[hq * 4 + e]; x2[hq * 4 + e] = y; ss += y * y; } }
        const float rinv = 1.0f / sqrtf(lanes_sum<64>(ss, xor4_sel(lane), lane) * (1.f / DM) + EPS);
#pragma unroll
        for (int hq = 0; hq < 4; ++hq) { const int c = d0 + hq * 4; const f32x4 fv = fvq[hq];
            f32x4 y;
#pragma unroll
            for (int e = 0; e < 4; ++e) y[e] = x2[hq * 4 + e] * rinv * fv[e];
            if (BMODE == 0 || rinv == 12345.678f) *(f32x4*)(xo + c) = y; }
        asm volatile("" ::: "memory");
    }
}

#ifndef PROBE_MODE
#define PROBE_MODE 0
#endif
template <int MODE> DI void probe_sweep(Frame& F, int tbase) {
    constexpr int NT = 8;
    const unsigned char* U = F.ws + WS_U;
    const int* EXPERTS = (const int*)(F.ws + WS_EXP);
    int lane = F.lane; asm volatile("" : "+v"(lane));
    int key[NT][2];
#pragma unroll
    for (int j = 0; j < NT; ++j) {
#pragma unroll
        for (int r = 0; r < 2; ++r) { const int k = r * 64 + lane; key[j][r] = ((EXPERTS[(size_t)(tbase + j) * 128 + k] ^ 0x1555) << 7) | k; }
#pragma unroll
        for (int k = 2; k <= 128; k <<= 1)
#pragma unroll
            for (int jj = k >> 1; jj > 0; jj >>= 1) {
                if (jj < 2) { const bool asc = (((lane * 2) & k) == 0); const int x = key[j][0], y = key[j][1], lo = min(x, y), hi = max(x, y); key[j][0] = asc ? lo : hi; key[j][1] = asc ? hi : lo; }
                else { const bool asc = (((lane * 2) & k) == 0), lower = ((lane & (jj / 2)) == 0), takemin = (asc == lower);
#pragma unroll
                    for (int r = 0; r < 2; ++r) { const int o = __shfl_xor(key[j][r], jj / 2); key[j][r] = takemin ? min(key[j][r], o) : max(key[j][r], o); } }
            }
    }
    LAS int* psL = (LAS int*)(F.lds + 65536) + F.wave * 1024;
    unsigned acc = 0;
#define PR_E(jj, bb, r) ((__builtin_amdgcn_readlane(key[jj][(r) & 1], (bb) * 4 + ((r) >> 1)) >> 7) & 16383)
    if constexpr (MODE == 0) {
#pragma unroll
        for (int j = 0; j < NT; ++j) acc ^= (unsigned)(key[j][0] ^ key[j][1]);
    } else if constexpr (MODE == 1) {
#define PR_ROW(jj, bb, r) (*((const v4u*)(U + (size_t)PR_E(jj, bb, r) * 1024) + lane))
        v4u ub[4][8];
#pragma unroll
        for (int q = 0; q < 4; ++q)
#pragma unroll
            for (int r = 0; r < 8; ++r) ub[q][r] = PR_ROW(q, 0, r);
#pragma unroll 1
        for (int b = 0; b < 16; ++b) { const int bnx = (b + 1) & 15;
#pragma unroll
            for (int j = 0; j < NT; ++j) {
#pragma unroll
                for (int r = 0; r < 8; ++r) acc ^= ub[j & 3][r].x ^ ub[j & 3][r].y ^ ub[j & 3][r].z ^ ub[j & 3][r].w;
#pragma unroll
                for (int r = 0; r < 8; ++r) ub[j & 3][r] = PR_ROW((j + 4) & 7, (j < 4) ? b : bnx, r);
            } }
#undef PR_ROW
    } else if constexpr (MODE == 2) {
#define PR_ROW(jj, bb, i) (*(const v4u*)(U + (unsigned)((((lane < 32) ? PR_E(jj, bb, 2 * (i)) : PR_E(jj, bb, 2 * (i) + 1)) << 10) | ((lane & 31) << 4))))
        v4u ub[4][4];
#pragma unroll
        for (int q = 0; q < 4; ++q)
#pragma unroll
            for (int r = 0; r < 4; ++r) ub[q][r] = PR_ROW(q, 0, r);
#pragma unroll 1
        for (int b = 0; b < 16; ++b) { const int bnx = (b + 1) & 15;
#pragma unroll
            for (int j = 0; j < NT; ++j) {
#pragma unroll
                for (int r = 0; r < 4; ++r) acc ^= ub[j & 3][r].x ^ ub[j & 3][r].y ^ ub[j & 3][r].z ^ ub[j & 3][r].w;
#pragma unroll
                for (int r = 0; r < 4; ++r) ub[j & 3][r] = PR_ROW((j + 4) & 7, (j < 4) ? b : bnx, r);
            } }
#undef PR_ROW
    } else if constexpr (MODE == 3) {
#define PR_ROW(jj, bb, r) (*((const v2u*)(U + (size_t)PR_E(jj, bb, r) * 1024) + lane))
        v2u ub[4][8];
#pragma unroll
        for (int q = 0; q < 4; ++q)
#pragma unroll
            for (int r = 0; r < 8; ++r) ub[q][r] = PR_ROW(q, 0, r);
#pragma unroll 1
        for (int b = 0; b < 16; ++b) { const int bnx = (b + 1) & 15;
#pragma unroll
            for (int j = 0; j < NT; ++j) {
#pragma unroll
                for (int r = 0; r < 8; ++r) acc ^= ub[j & 3][r].x ^ ub[j & 3][r].y;
#pragma unroll
                for (int r = 0; r < 8; ++r) ub[j & 3][r] = PR_ROW((j + 4) & 7, (j < 4) ? b : bnx, r);
            } }
#undef PR_ROW
    }
#undef PR_E
    if (acc == 0x12345678u) psL[lane] = (int)acc;
}

#ifndef UB_MODE
#define UB_MODE 0
#endif
#ifndef UB_ITERS
#define UB_ITERS 4000
#endif
#ifndef UB_STREAM
#define UB_STREAM 600
#endif
#define UB16(INS) asm volatile(INS(0) INS(1) INS(2) INS(3) INS(4) INS(5) INS(6) INS(7) INS(8) INS(9) INS(10) INS(11) INS(12) INS(13) INS(14) INS(15) : "+v"(x[0]), "+v"(x[1]), "+v"(x[2]), "+v"(x[3]), "+v"(x[4]), "+v"(x[5]), "+v"(x[6]), "+v"(x[7]), "+v"(x[8]), "+v"(x[9]), "+v"(x[10]), "+v"(x[11]), "+v"(x[12]), "+v"(x[13]), "+v"(x[14]), "+v"(x[15]) : "v"(a), "v"(b))
#define UBI_FMA(i) "v_fma_f32 %" #i ", %16, %17, %" #i "\n"
#define UBI_PKFMAH(i) "v_pk_fma_f16 %" #i ", %16, %17, %" #i "\n"
#define UBI_CVTH(i) "v_cvt_scalef32_pk_f16_fp4 %" #i ", %16, 1.0\n"
#define UBI_DOT8(i) "v_dot8c_i32_i4 %" #i ", %16, %17\n"
#define UBI_DOT2H(i) "v_dot2c_f32_f16 %" #i ", %16, %17\n"
#define UBI_PKMULH(i) "v_pk_mul_f16 %" #i ", %16, %" #i "\n"
#define UBI_ANDOR(i) "v_and_or_b32 %" #i ", %16, %17, %" #i "\n"
#define UBI_PERM(i) "v_perm_b32 %" #i ", %16, %" #i ", %17\n"
#define UBI_CVTF(i) "v_cvt_scalef32_pk_f16_fp4 %" #i ", %16, 1.0 op_sel:[1,1,0]\n"
#define UBI_MADMIX(i) "v_fma_mix_f32 %" #i ", %16, %17, %" #i " op_sel_hi:[1,1,0]\n"
#define UBI_PKADDH(i) "v_pk_add_f16 %" #i ", %16, %" #i "\n"
DI void ubench(Frame& F) {
#if UB_MODE == 22
    if (((F.vcu & 1) == 0) == (F.wave >= 4)) return;
#endif
#if UB_MODE == 26 || UB_MODE == 27
    if (F.wave >= 4) {
        unsigned a0 = (unsigned)F.lane * 16u;
#pragma unroll 1
        for (int it = 0; it < UB_STREAM; ++it) {
#if UB_MODE == 26
            a0 = (*(const LAS unsigned*)(F.lds + 65536 + (a0 & 0x3ff0u))) & 0x3ff0u;
#else
            __builtin_amdgcn_s_sleep(8);
#endif
        }
        if (a0 == 0x12345678u) F.out[F.lane] = 0.f;
        return;
    }
#endif
#if UB_MODE == 25
    if (F.wave >= 4) {
        const unsigned char* basep = F.ws + 64 * MiB + F.lane * 16;
        unsigned idx = (unsigned)(F.vcu * 4 + (F.wave - 4)) * 40503u; v4u accv = (v4u){0u, 0u, 0u, 0u};
        LAS unsigned char* ring = F.lds + 65536 + (F.wave - 4) * 16384;
#pragma unroll 1
        for (int it = 0; it < UB_STREAM; ++it) { const int par = (it & 1) * 8192;
#pragma unroll
            for (int k = 0; k < 8; ++k) { idx = idx * 1664525u + 1013904223u;
                __builtin_amdgcn_global_load_lds((const unsigned*)(basep + (size_t)((idx >> 10) & 0x3ffffu) * 1024), (LAS unsigned*)(ring + par + k * 1024), 16, 0, 0); }
            asm volatile("s_waitcnt vmcnt(8)" ::: "memory");
#pragma unroll
            for (int k = 0; k < 8; ++k) accv += *(const LAS v4u*)(ring + (par ^ 8192) + k * 1024 + F.lane * 16);
        }
        asm volatile("s_waitcnt vmcnt(0)" ::: "memory");
        if (accv.x + accv.y + accv.z + accv.w == 0x12345678u) F.out[F.lane] = 0.f;
        return;
    }
#endif
#if UB_MODE == 23 || UB_MODE == 24
    if (F.wave >= 4) {
        const unsigned char* basep = F.ws + 64 * MiB + F.lane * 16;
        unsigned idx = (unsigned)(F.vcu * 4 + (F.wave - 4)) * 40503u;
#pragma unroll 1
        for (int it = 0; it < UB_STREAM; ++it) {
#pragma unroll
            for (int k = 0; k < 8; ++k) { idx = idx * 1664525u + 1013904223u;
                __builtin_amdgcn_global_load_lds((const unsigned*)(basep + (size_t)((idx >> 10) & 0x3ffffu) * 1024), (LAS unsigned*)(F.lds + 65536 + (F.wave - 4) * 8192 + k * 1024), 16, 0, 0); }
        }
        asm volatile("s_waitcnt vmcnt(0)" ::: "memory");
        return;
    }
#if UB_MODE == 24
    return;
#endif
#endif
#if UB_MODE == 20 || UB_MODE == 21 || UB_MODE == 22
    if (F.wave >= 4) {
        v4u accv = (v4u){0u, 0u, 0u, 0u};
        const v4u* basep = (const v4u*)(F.ws + 64 * MiB) + F.lane;
        unsigned idx = (unsigned)(F.vcu * 4 + (F.wave - 4)) * 40503u;
#pragma unroll 1
        for (int it = 0; it < UB_STREAM; ++it) {
#pragma unroll
            for (int k = 0; k < 8; ++k) { idx = idx * 1664525u + 1013904223u; const v4u t = basep[(size_t)((idx >> 10) & 0x3ffffu) * 64]; accv += t; }
        }
        if (accv.x + accv.y + accv.z + accv.w == 0x12345678u) F.out[F.lane] = 0.f;
        return;
    }
#if UB_MODE == 21
    return;
#endif
#endif
    unsigned x[16]; unsigned a = 0x3c003c00u ^ (unsigned)F.lane, b = 0x38003800u + (unsigned)F.lane, t0 = 0, t1 = 0;
    if ((UB_MODE == 10 || UB_MODE == 11 || UB_MODE == 14 || UB_MODE == 15) && F.wave >= 4) return;
#pragma unroll
    for (int i = 0; i < 16; ++i) x[i] = (unsigned)(F.lane * 17 + i);
#ifdef UB_PRIO
    if (F.wave < 4) __builtin_amdgcn_s_setprio(3);
#endif
#pragma unroll 1
    for (int it = 0; it < UB_ITERS; ++it) {
#if UB_MODE == 0
        UB16(UBI_FMA);
#elif UB_MODE == 1
        UB16(UBI_PKFMAH);
#elif UB_MODE == 2
        UB16(UBI_CVTH);
#elif UB_MODE == 3
        UB16(UBI_DOT8);
#elif UB_MODE == 4
        UB16(UBI_DOT2H);
#elif UB_MODE == 5
        UB16(UBI_PKMULH);
#elif UB_MODE == 6
        UB16(UBI_ANDOR);
#elif UB_MODE == 7
        UB16(UBI_PERM);
#elif UB_MODE == 8
        UB16(UBI_MADMIX);
#elif UB_MODE == 9
        UB16(UBI_PKADDH);
#elif UB_MODE == 14 || UB_MODE == 20 || UB_MODE == 22 || UB_MODE == 23 || UB_MODE == 25 || UB_MODE == 26 || UB_MODE == 27
        UB16(UBI_FMA);
#elif UB_MODE == 15
        UB16(UBI_CVTH);
#elif UB_MODE == 10 || UB_MODE == 12
        UB16(UBI_PKFMAH);
#elif UB_MODE == 11 || UB_MODE == 13
        asm volatile(
            "v_cvt_scalef32_pk_f16_fp4 %16, %18, 1.0\n v_pk_fma_f16 %0, %16, %19, %0\n v_cvt_scalef32_pk_f16_fp4 %17, %18, 1.0 op_sel:[1,0,0]\n v_pk_fma_f16 %1, %17, %19, %1\n"
            "v_cvt_scalef32_pk_f16_fp4 %16, %18, 1.0 op_sel:[0,1,0]\n v_pk_fma_f16 %2, %16, %19, %2\n v_cvt_scalef32_pk_f16_fp4 %17, %18, 1.0 op_sel:[1,1,0]\n v_pk_fma_f16 %3, %17, %19, %3\n"
            "v_cvt_scalef32_pk_f16_fp4 %16, %18, 1.0\n v_pk_fma_f16 %4, %16, %19, %4\n v_cvt_scalef32_pk_f16_fp4 %17, %18, 1.0 op_sel:[1,0,0]\n v_pk_fma_f16 %5, %17, %19, %5\n"
            "v_cvt_scalef32_pk_f16_fp4 %16, %18, 1.0 op_sel:[0,1,0]\n v_pk_fma_f16 %6, %16, %19, %6\n v_cvt_scalef32_pk_f16_fp4 %17, %18, 1.0 op_sel:[1,1,0]\n v_pk_fma_f16 %7, %17, %19, %7\n"
            : "+v"(x[0]), "+v"(x[1]), "+v"(x[2]), "+v"(x[3]), "+v"(x[4]), "+v"(x[5]), "+v"(x[6]), "+v"(x[7]), "+v"(x[8]), "+v"(x[9]), "+v"(x[10]), "+v"(x[11]), "+v"(x[12]), "+v"(x[13]), "+v"(x[14]), "+v"(x[15]), "+v"(t0), "+v"(t1) : "v"(a), "v"(b));
#endif
    }
#ifdef UB_PRIO
    __builtin_amdgcn_s_setprio(0);
#endif
    unsigned acc = 0;
#pragma unroll
    for (int i = 0; i < 16; ++i) acc ^= x[i];
    acc ^= t0 ^ t1;
    if (acc == 0x12345678u) F.out[F.lane] = 0.f;
}

struct Args { const float* in[18]; float* out; unsigned char* ws; int ph_lo, ph_hi, li, pad; };
__global__ void __launch_bounds__(NWAVES * 64, 2) mk_fwd(Args args) {
    extern __shared__ __attribute__((aligned(16))) unsigned char lds[];
    Frame F;
    F.lds = (LAS unsigned char*)lds;
    F.tid = threadIdx.x; F.lane = F.tid & 63; F.wave = __builtin_amdgcn_readfirstlane(F.tid >> 6);
    F.G = gridDim.x; { const int bx = blockIdx.x; F.vcu = (F.G % 8 == 0) ? (bx % 8) * (F.G / 8) + bx / 8 : bx; }
    F.gw = F.vcu * NWAVES + F.wave; F.NGW = F.G * NWAVES;
#pragma unroll
    for (int i = 0; i < 18; ++i) F.in[i] = args.in[i];
    F.out = args.out; F.ws = args.ws;
    volatile LAS unsigned* MISC = (volatile LAS unsigned*)(F.lds + MISC_OFF);
    for (int u = F.tid; u < (LDS_BYTES - LDSCTL_OFF) / 4; u += NWAVES * 64) ((LAS unsigned*)(F.lds + LDSCTL_OFF))[u] = 0u;
    __syncthreads();
    gu32* ctl = (gu32*)(F.ws + WS_CTL);
    XcdBarrier bar; bar.bar = (unsigned*)(ctl + CW_BAR) + args.li * XCD_BAR_WORDS; bar.x = 0; bar.st = nullptr;
    const int lo = args.ph_lo, hi = args.ph_hi;
    if (hi - lo > 1) bar = xcd_barrier_post((unsigned*)(ctl + CW_BAR) + args.li * XCD_BAR_WORDS, MISC + 8);
#ifndef PROBE_MASK
#define PROBE_MASK 0
#endif
#define REP(k) for (int rep_ = 0; rep_ < 1 + ((PROBE_MASK >> (k)) & 1); ++rep_)
#define IN(k) (lo <= (k) && (k) < hi)
#ifndef PROBE_SEAMS
#define PROBE_SEAMS 1
#endif
#define SEAM(k) do { if (IN(k) && IN((k) + 1)) for (int s_ = 0; s_ < PROBE_SEAMS; ++s_) xcd_barrier(bar); } while (0)

#ifdef PROBE_P0
    if (IN(0)) { p0_prologue<PROBE_P0>(F); __syncthreads(); }
#endif
    if (IN(0)) { REP(0) { p0_prologue<15>(F); __syncthreads(); } SEAM(0); }
    if (IN(1)) { norm2_consts(F); REP(1) norm_rows<false>(F, F.in[0], F.in[2], MROWS, F.in[6], 0, DM, (bf16*)(F.ws + WS_HX)); SEAM(1); }
    if (IN(2)) {
        pg8::Gemm g{(const bf16*)(F.ws + WS_HX), (const bf16*)(F.ws + WS_WIN), MROWS, DIN, DM}; pg8::InProjOrder S; S.init(F.G, (int)blockIdx.x);
        pg8::EpiInProj E{(bf16*)(F.ws + WS_PB), (bf16*)(F.ws + WS_QF), (bf16*)(F.ws + WS_KF), (bf16*)(F.ws + WS_VF)};
        REP(2) pg8::gemm_phase<pg8::EpiInProj, pg8::InProjOrder, true, P2_SP2>(F.lds + RING_OFF, g, S, E);
        SEAM(2);
    }
    if (IN(3)) { REP(3) attn_mfma(F); REP(9) pool_mfma(F); SEAM(3); }
    if (IN(4)) {
        pg8::Gemm g{(const bf16*)(F.ws + WS_MIX), (const bf16*)(F.ws + WS_WOUT), NTOK, DM, DM}; pg8::StaticOrder S; S.init(NTOK, DM, F.G, (int)blockIdx.x);
        pg8::EpiX1 E{F.in[0], (const float*)(F.ws + WS_MOD), (bf16*)(F.ws + WS_X1), (unsigned*)(F.ws + WS_RSS)};
        REP(4) pg8::gemm_phase<pg8::EpiX1, pg8::StaticOrder, true, true>(F.lds + RING_OFF, g, S, E);
        SEAM(4);
    }
    if (IN(6)) {
        pg8::Gemm g{(const bf16*)(F.ws + WS_X1), (const bf16*)(F.ws + WS_WQB), NTOK, 2048, DM}; pg8::BatchBOrder S; S.init(NTOK, 2048, F.G, (int)blockIdx.x, (size_t)2048 * DM * 2);
        pg8::EpiQP E{(bf16*)(F.ws + WS_ZX), (const unsigned*)(F.ws + WS_RSS), (const float*)(F.ws + WS_C2)};
        REP(6) pg8::gemm_phase<pg8::EpiQP, pg8::BatchBOrder, true, true>(F.lds + RING_OFF, g, S, E);
        SEAM(6);
    }
    if (IN(7)) {
        for (int tile = F.vcu; tile < NTOK / 128; tile += F.G) {
            const int tok0 = tile * 128;
            REP(7) peer_topk_mfma(F, tile);
            if ((PROBE_MASK >> 10) & 1) for (int rd = 0; rd < 2; ++rd) gather_v4<false>(F, tok0 + rd * 64 + F.wave * 8);
#ifdef GATHER_V7
#ifdef PROBE_PARTS
            for (int rd = 0; rd < 2; ++rd) gather_v7<PROBE_PARTS>(F, tok0 + rd * 64 + F.wave * 8);
#endif
            for (int rd = 0; rd < 2; ++rd) gather_v7<3>(F, tok0 + rd * 64 + F.wave * 8);
#else
#ifdef V8_TLBWARM
            { unsigned accw = 0; for (int p = F.tid; p < 4096; p += NWAVES * 64) accw += *(const unsigned*)(F.ws + (p < 2048 ? WS_U : WS_V - 2048 * 4096) + (size_t)p * 4096); if (accw == 0x12345678u) F.out[F.tid] = 0.f; }
#endif
            {
#ifdef V8_PRIO
              if (F.wave < 4) __builtin_amdgcn_s_setprio(V8_PRIO);
#endif
              { const int bb = tok0 >> 12; const float* MODp = (const float*)(F.ws + WS_MOD);
                const float* srcs[4] = {MODp + bb * NMOD + 3 * DM, (const float*)(F.ws + WS_GS2) + bb * DM, MODp + bb * NMOD + 5 * DM, F.in[17]};
#pragma unroll
                for (int v = 0; v < 4; ++v) { if (F.tid < 256) *(LAS f32x4*)(F.lds + V8_VEC_OFF + v * 4096 + F.tid * 16) = *(const f32x4*)(srcs[v] + F.tid * 4); }
                __syncthreads(); }
              const int tb0 = tok0 + F.wave * 16, lag = V8_LAG;
              LAS unsigned* slots = (LAS unsigned*)F.lds + F.wave * (2 * V8_SLOT_WORDS);
#ifndef PROBE_GREP
#define PROBE_GREP 1
#endif
#pragma unroll 1
              for (int grep_ = 0; grep_ < PROBE_GREP; ++grep_)
#pragma unroll 1
              for (int st = 0; st < 5; ++st) {
#ifdef V8_BLOCKSYNC
                  __syncthreads();
#endif
#ifdef V8_GRIDSYNC
                  xcd_barrier(bar);
#endif
                  if (st < 4) gv8_front(F, tb0 + 4 * st, slots + (st & 1) * V8_SLOT_WORDS);
                  const int rb = st - lag;
#ifdef PROBE_BMODE
                  if (rb >= 0 && rb < 4) gv8_back<PROBE_BMODE>(F, tb0 + 4 * rb, slots + (rb & 1) * V8_SLOT_WORDS);
#endif
                  if (rb >= 0 && rb < 4) gv8_back<0>(F, tb0 + 4 * rb, slots + (rb & 1) * V8_SLOT_WORDS);
              } }
#endif
        }
        if ((PROBE_MASK >> 12) & 1) ubench(F);
        if ((PROBE_MASK >> 11) & 1) { __syncthreads(); for (int tile = F.vcu; tile < NTOK / 128; tile += F.G) for (int rd = 0; rd < 2; ++rd) probe_sweep<PROBE_MODE>(F, tile * 128 + rd * 64 + F.wave * 8); }
    }
#undef IN
#undef SEAM
}

extern "C" void kernel_launch(void* const* d_in, const int* in_sizes, int n_in, void* d_out, int out_size, void* d_ws, size_t ws_size, hipStream_t stream) {
    static int grid = 0;
    if (grid == 0) {
        if (n_in != 18 || in_sizes[0] != NTOK * DM || out_size != NTOK * DM || ws_size < WS_END) { fprintf(stderr, "kernel_launch: unexpected shapes / workspace (n_in %d, ws %zu); nothing launched\n", n_in, ws_size); grid = -1; return; }
        int dev = 0, cus = 0;
        if (hipGetDevice(&dev) != hipSuccess || hipDeviceGetAttribute(&cus, hipDeviceAttributeMultiprocessorCount, dev) != hipSuccess) { grid = -1; return; }
        if (hipFuncSetAttribute((const void*)mk_fwd, hipFuncAttributeMaxDynamicSharedMemorySize, LDS_BYTES) != hipSuccess) { fprintf(stderr, "kernel_launch: hipFuncSetAttribute failed\n"); grid = -1; return; }
        int per_cu = 0;
        if (hipOccupancyMaxActiveBlocksPerMultiprocessor(&per_cu, (const void*)mk_fwd, NWAVES * 64, LDS_BYTES) != hipSuccess || per_cu < 1) fprintf(stderr, "kernel_launch: note: occupancy query reports %d blocks per CU\n", per_cu);
        (void)hipGetLastError();
        grid = cus;
    }
    if (grid < 0) return;
    (void)hipMemsetAsync((char*)d_ws + WS_CTL, 0, CTL_ZERO_BYTES, stream);
    Args a{};
    for (int i = 0; i < 18; ++i) a.in[i] = (const float*)d_in[i];
    a.out = (float*)d_out; a.ws = (unsigned char*)d_ws;
    for (int li = 0; li < N_LAUNCHES; ++li) {
        if (N_LAUNCHES == 1) { a.ph_lo = 0; a.ph_hi = NPHASE; } else { a.ph_lo = li; a.ph_hi = li + 1; }
        a.li = (N_LAUNCHES == 1) ? 0 : 0;
        hipLaunchKernelGGL(mk_fwd, dim3(grid), dim3(NWAVES * 64), LDS_BYTES, stream, a);
    }
}
```
